# Optimizing an MI355X kernel written in HIP

```python
import math
import jax, jax.numpy as jnp
from jax import lax
import numpy as np

D_MODEL = 1024
BATCH = 8
SEQ = 2048
DEPTH = 2

BLOCK = 128
RET_HEADS = 4
RET_DK = 64
RET_DV = 128
RET_QK = RET_HEADS * RET_DK
RET_WIDTH = RET_HEADS * RET_DV
FOX_HEADS = 8
FOX_DH = 64
FOX_WIDTH = FOX_HEADS * FOX_DH
GM_GROUPS = 4
GM_DG = 128
GM_WIDTH = GM_GROUPS * GM_DG
BRANCH_WIDTH = 512
N_BRANCH = 3
COL_SIZES = (RET_QK, RET_QK, RET_WIDTH, RET_WIDTH,
             FOX_WIDTH, FOX_WIDTH, FOX_WIDTH, FOX_HEADS,
             GM_WIDTH, GM_WIDTH, N_BRANCH * D_MODEL)
N_IN = sum(COL_SIZES)
D_FF_DENSE = 2816
N_EXPERTS = 8
TOP_K = 2
D_FF_EXPERT = 3584
N_DENSE = (DEPTH + 1) // 2
N_MOE = DEPTH // 2
ROPE_BASE = 10000.0
LN_EPS = 1e-5
GN_EPS = 1e-6
ALPHA = (2 * DEPTH) ** 0.25
BETA = (8 * DEPTH) ** -0.25

kernel_name = "hybrid_retention_fox_gmlp_moe_deepnorm"


def layer_norm(x, g, b, eps=LN_EPS):
    xf = x.astype(jnp.float32)
    mu = xf.mean(-1, keepdims=True)
    var = jnp.square(xf - mu).mean(-1, keepdims=True)
    return ((xf - mu) * lax.rsqrt(var + eps)).astype(x.dtype) * g + b


def head_group_norm(y):
    yf = y.astype(jnp.float32)
    mu = yf.mean(-1, keepdims=True)
    var = jnp.square(yf - mu).mean(-1, keepdims=True)
    return ((yf - mu) * lax.rsqrt(var + GN_EPS)).astype(y.dtype)


def rotary(x, pos):
    half = x.shape[-1] // 2
    inv_freq = ROPE_BASE ** (-jnp.arange(half, dtype=jnp.float32) / half)
    ang = pos.astype(jnp.float32)[:, None] * inv_freq[None, :]
    cos = jnp.cos(ang)[None, :, None, :].astype(x.dtype)
    sin = jnp.sin(ang)[None, :, None, :].astype(x.dtype)
    x1, x2 = x[..., :half], x[..., half:]
    return jnp.concatenate([x1 * cos - x2 * sin, x1 * sin + x2 * cos], axis=-1)


def retention_chunkwise(q, k, v):
    bsz, s, h, dk = q.shape
    dv = v.shape[-1]
    n = s // BLOCK
    dt = q.dtype
    log_gamma = jnp.log1p(-jnp.exp2(-5.0 - jnp.arange(h, dtype=jnp.float32)))
    idx = jnp.arange(BLOCK, dtype=jnp.float32)
    rel = idx[:, None] - idx[None, :]
    causal = rel >= 0
    decay_in = jnp.where(causal[None], jnp.exp(log_gamma[:, None, None] * jnp.where(causal, rel, 0.0)[None]), 0.0).astype(dt)
    q_dec = jnp.exp(log_gamma[:, None] * (idx + 1.0)).astype(dt)
    k_dec = jnp.exp(log_gamma[:, None] * (BLOCK - 1.0 - idx)).astype(dt)
    chunk_dec = jnp.exp(log_gamma * BLOCK).astype(dt)

    def to_chunks(t):
        return t.reshape(bsz, n, BLOCK, h, t.shape[-1]).transpose(1, 0, 3, 2, 4)

    qc, kc, vc = to_chunks(q), to_chunks(k), to_chunks(v)

    def step(state, inp):
        qi, ki, vi = inp
        scores = jnp.einsum('bhid,bhjd->bhij', qi, ki) * decay_in
        inner = jnp.einsum('bhij,bhjv->bhiv', scores, vi)
        cross = jnp.einsum('bhid,bhdv->bhiv', qi * q_dec[:, :, None], state)
        new_state = state * chunk_dec[:, None, None] + jnp.einsum('bhjd,bhjv->bhdv', ki * k_dec[:, :, None], vi)
        return new_state, inner + cross

    state0 = jnp.zeros((bsz, h, dk, dv), dt)
    _, out = lax.scan(step, state0, (qc, kc, vc))
    return out.transpose(1, 0, 3, 2, 4).reshape(bsz, s, h, dv)


def forgetting_attention(q, k, v, log_f):
    s = q.shape[1]
    scale = q.shape[-1] ** -0.5
    c = jnp.cumsum(log_f, axis=1).transpose(0, 2, 1)
    outs = []
    for i in range(s // BLOCK):
        lo, hi = i * BLOCK, (i + 1) * BLOCK
        qb = q[:, lo:hi]
        kb, vb = k[:, :hi], v[:, :hi]
        logits = jnp.einsum('bqhd,bkhd->bhqk', qb, kb).astype(jnp.float32) * scale
        bias = c[:, :, lo:hi, None] - c[:, :, None, :hi]
        mask = jnp.arange(lo, hi)[:, None] >= jnp.arange(hi)[None, :]
        logits = jnp.where(mask, logits + bias, -jnp.inf)
        p = jax.nn.softmax(logits, axis=-1).astype(v.dtype)
        outs.append(jnp.einsum('bhqk,bkhd->bqhd', p, vb))
    return jnp.concatenate(outs, axis=1)


def chunked_spatial_gating(u, v, w_s, b_s):
    bsz, s, _ = u.shape
    n = s // BLOCK
    causal = jnp.tril(jnp.ones((BLOCK, BLOCK), dtype=bool))
    w = jnp.where(causal[None], w_s, 0.0)
    vc = v.reshape(bsz, n, BLOCK, GM_GROUPS, GM_DG)
    sp = jnp.einsum('gij,bnjgc->bnigc', w, vc) + b_s.T[None, None, :, :, None]
    return u * sp.reshape(bsz, s, GM_WIDTH)


def split_columns(proj):
    outs, start = [], 0
    for size in COL_SIZES:
        outs.append(proj[..., start:start + size])
        start += size
    return outs


def hybrid_mixer(x, pos, w_in, fox_b_f, gate_b, gm_w_s, gm_b_s, gm_ln_g, gm_ln_b, w_branch, w_out):
    bsz, s, _ = x.shape
    proj = x @ w_in
    (rq, rk, rv, rg, fq, fk, fv, fl, gu, gv, gl) = split_columns(proj)
    q = rotary(rq.reshape(bsz, s, RET_HEADS, RET_DK), pos)
    k = rotary(rk.reshape(bsz, s, RET_HEADS, RET_DK), pos) * (RET_DK ** -0.5)
    ret = retention_chunkwise(q, k, rv.reshape(bsz, s, RET_HEADS, RET_DV))
    y_a = jax.nn.silu(rg) * head_group_norm(ret).reshape(bsz, s, RET_WIDTH)
    log_f = jax.nn.log_sigmoid(fl.astype(jnp.float32) + fox_b_f.astype(jnp.float32))
    y_b = forgetting_attention(fq.reshape(bsz, s, FOX_HEADS, FOX_DH),
                               fk.reshape(bsz, s, FOX_HEADS, FOX_DH),
                               fv.reshape(bsz, s, FOX_HEADS, FOX_DH), log_f).reshape(bsz, s, FOX_WIDTH)
    u = jax.nn.gelu(gu)
    v = layer_norm(jax.nn.gelu(gv), gm_ln_g, gm_ln_b)
    y_c = chunked_spatial_gating(u, v, gm_w_s, gm_b_s)
    gates = jax.nn.sigmoid(gl + gate_b).reshape(bsz, s, N_BRANCH, D_MODEL)
    yb = jnp.stack([y_a, y_b, y_c], axis=2)
    branch = jnp.einsum('bsnw,nwd->bsnd', yb, w_branch)
    merged = jnp.einsum('bsnd,bsnd->bsd', gates, branch)
    return merged @ w_out


def swiglu(x, w_up, w_down):
    a, b = jnp.split(x @ w_up, 2, axis=-1)
    return (jax.nn.silu(a) * b) @ w_down


def moe_swiglu(x, w_router, w_up, w_down):
    bsz, s, d = x.shape
    t = x.reshape(-1, d)
    logits = (t @ w_router).astype(jnp.float32)
    top_val, top_idx = lax.top_k(logits, TOP_K)
    top_w = jax.nn.softmax(top_val, axis=-1)
    gate = jnp.sum(jax.nn.one_hot(top_idx, N_EXPERTS, dtype=jnp.float32) * top_w[..., None], axis=1).astype(x.dtype)
    out = jnp.zeros_like(t)
    for e in range(N_EXPERTS):
        out = out + gate[:, e:e + 1] * swiglu(t, w_up[e], w_down[e])
    return out.reshape(bsz, s, d)


def setup_inputs(seed: int = 0) -> dict:
    key = jax.random.key(seed)
    ks = jax.random.split(key, 20)
    f32 = jnp.float32
    nrm = lambda k, shape, sc: jax.random.normal(k, shape, f32) * sc
    return {
        "x": nrm(ks[0], (BATCH, SEQ, D_MODEL), 1.0),
        "w_in": nrm(ks[1], (DEPTH, D_MODEL, N_IN), D_MODEL ** -0.5),
        "fox_b_f": jax.random.uniform(ks[2], (DEPTH, FOX_HEADS), f32, 1.0, 4.0),
        "gate_b": nrm(ks[3], (DEPTH, N_BRANCH * D_MODEL), 0.02),
        "gm_w_s": nrm(ks[4], (DEPTH, GM_GROUPS, BLOCK, BLOCK), BLOCK ** -0.5),
        "gm_b_s": 1.0 + nrm(ks[5], (DEPTH, GM_GROUPS, BLOCK), 0.02),
        "gm_ln_g": 1.0 + nrm(ks[6], (DEPTH, GM_WIDTH), 0.02),
        "gm_ln_b": nrm(ks[7], (DEPTH, GM_WIDTH), 0.02),
        "w_branch": nrm(ks[8], (DEPTH, N_BRANCH, BRANCH_WIDTH, D_MODEL), BRANCH_WIDTH ** -0.5),
        "w_out": nrm(ks[9], (DEPTH, D_MODEL, D_MODEL), BETA * D_MODEL ** -0.5),
        "ln_g": 1.0 + nrm(ks[10], (DEPTH, 2, D_MODEL), 0.02),
        "ln_b": nrm(ks[11], (DEPTH, 2, D_MODEL), 0.02),
        "dense_w_up": nrm(ks[12], (N_DENSE, D_MODEL, 2 * D_FF_DENSE), D_MODEL ** -0.5),
        "dense_w_down": nrm(ks[13], (N_DENSE, D_FF_DENSE, D_MODEL), BETA * D_FF_DENSE ** -0.5),
        "moe_router": nrm(ks[14], (N_MOE, D_MODEL, N_EXPERTS), D_MODEL ** -0.5),
        "moe_w_up": nrm(ks[15], (N_MOE, N_EXPERTS, D_MODEL, 2 * D_FF_EXPERT), D_MODEL ** -0.5),
        "moe_w_down": nrm(ks[16], (N_MOE, N_EXPERTS, D_FF_EXPERT, D_MODEL), BETA * D_FF_EXPERT ** -0.5),
    }


def reference(x, w_in, fox_b_f, gate_b, gm_w_s, gm_b_s, gm_ln_g, gm_ln_b, w_branch, w_out,
              ln_g, ln_b, dense_w_up, dense_w_down, moe_router, moe_w_up, moe_w_down):
    pos = jnp.arange(x.shape[1], dtype=jnp.int32)
    for l in range(DEPTH):
        h = hybrid_mixer(x, pos, w_in[l], fox_b_f[l], gate_b[l], gm_w_s[l], gm_b_s[l],
                         gm_ln_g[l], gm_ln_b[l], w_branch[l], w_out[l])
        x = layer_norm(ALPHA * x + h, ln_g[l, 0], ln_b[l, 0])
        if l % 2 == 0:
            f = swiglu(x, dense_w_up[l // 2], dense_w_down[l // 2])
        else:
            f = moe_swiglu(x, moe_router[l // 2], moe_w_up[l // 2], moe_w_down[l // 2])
        x = layer_norm(ALPHA * x + f, ln_g[l, 1], ln_b[l, 1])
    return x
```

```cpp
#include <hip/hip_runtime.h>
#include <cstdio>
#include <cstdint>

#ifndef MK_N_LAUNCHES
#define MK_N_LAUNCHES 0
#endif
#ifndef NAIVE_MIX
#define NAIVE_MIX 1
#endif

namespace pg8 {
#define PG8_LAS __attribute__((address_space(3)))
typedef unsigned short bf16_t;
typedef short bf16x8 __attribute__((ext_vector_type(8)));
typedef float f32x4 __attribute__((ext_vector_type(4)));
typedef float f32x2 __attribute__((ext_vector_type(2)));
typedef unsigned u32x4 __attribute__((ext_vector_type(4)));
typedef unsigned u32x2 __attribute__((ext_vector_type(2)));
constexpr int BM = 256, BK = 64, HALF = 128, HTB = HALF * BK * 2  , STAGE_BYTES = 8 * HTB, NXCD = 8, WGM = 8;

__host__ __device__ __forceinline__ int lds_byte(int r, int c) { const int st = (r >> 4) * 2 + (c >> 5), rr = r & 15, cc = c & 31, ob = rr * 64 + cc * 2; return st * 1024 + (ob ^ (((ob >> 9) & 1) << 5)); }
__host__ __device__ __forceinline__ void stage_rc(int b, int& R, int& C) { const int st = b / 1024, sb = b % 1024, swz = sb ^ (((sb >> 9) & 1) << 5); R = (st >> 1) * 16 + swz / 64; C = (st & 1) * 32 + (swz % 64) / 2; }
__host__ __device__ __forceinline__ int perm32(int rho) { const int n = rho >> 4, i = rho & 15; return 8 * (i >> 2) + 4 * n + (i & 3); }

struct Unit { int pm, pn; };

struct TileOrder {
    int nM, nN, nwg, G, c;
    __device__ __forceinline__ void init(int nM_, int nN_, int G_, int c_) { nM = nM_; nN = nN_; nwg = nM * nN; G = G_; c = c_; }
    __device__ __forceinline__ bool next(int i, Unit& u) const {
        const long L = (long)i * G + c; if (L >= nwg) return false;
        int wgid = (int)L; { const int q = nwg / NXCD, r = nwg % NXCD, xcd = wgid % NXCD, off = wgid / NXCD; wgid = (xcd < r ? xcd * (q + 1) : r * (q + 1) + (xcd - r) * q) + off; }
        const int nig = WGM * nN, gid = wgid / nig, fm = gid * WGM, gsz = (nM - fm) < WGM ? (nM - fm) : WGM;
        u.pm = fm + ((wgid % nig) % gsz); u.pn = (wgid % nig) / gsz; return true;
    }
};
struct PlainSched : TileOrder {
    static constexpr bool GATHER = false;
    const bf16_t* A; const bf16_t* Bt; int K;
    __device__ __forceinline__ const char* abase(const Unit& u) const { return (const char*)A + (size_t)u.pm * BM * K * 2; }
    __device__ __forceinline__ void aoffs(const Unit&, const int (&R)[2], const int (&C)[2], unsigned (&o)[2][2]) const {
#pragma unroll
        for (int h = 0; h < 2; ++h)
#pragma unroll
            for (int i = 0; i < 2; ++i) o[h][i] = (unsigned)((R[i] + h * HALF) * K + C[i]) * 2u; }
    __device__ __forceinline__ const char* bbase(const Unit& u) const { return (const char*)Bt + (size_t)u.pn * BM * K * 2; }
};

__device__ __forceinline__ unsigned cvt_pk_bf16(float lo, float hi) { unsigned r; asm volatile("v_cvt_pk_bf16_f32 %0, %1, %2" : "=v"(r) : "v"(lo), "v"(hi)); return r; }

template <class Epi, class Sched>
__device__ __forceinline__ void gemm_phase(PG8_LAS unsigned char* lds, const int K, const Sched& S, const Epi& E) {
    int tid_ = threadIdx.x; asm volatile("" : "+v"(tid_));
    const int tid = tid_, wid = __builtin_amdgcn_readfirstlane(tid >> 6), lane = tid & 63, wr = wid >> 2, wc = wid & 3, fr = lane & 15, fq = lane >> 4;
    const int nt = K / BK;
    int Rs[2], Cs[2]; unsigned voffA[2], voffB[2];
#pragma unroll
    for (int i = 0; i < 2; ++i) { int R, C; stage_rc(tid * 16 + i * 8192, R, C); Rs[i] = R; Cs[i] = C; const int Rb = Epi::PERM ? ((R & ~31) + perm32(R & 31)) : R;
        voffA[i] = (unsigned)(R * K + C) * 2u; voffB[i] = (unsigned)(Rb * K + C) * 2u; }
    const size_t kstep = (size_t)(BK * 2);
    const size_t hstep = (size_t)HALF * K * 2;
    const unsigned ldsw = (unsigned)wid * 1024u;
    const int aoff = lds_byte(wr * 64 + fr, fq * 8), boff = lds_byte(wc * 32 + fr, fq * 8);
#define PG8_SA(b, h) (((b) * 2 + (h)) * HTB)
#define PG8_SB(b, h) ((4 + (b) * 2 + (h)) * HTB)
#define PG8_STAGE(bufoff, gbase, voff) do { _Pragma("unroll") for (int _i = 0; _i < 2; ++_i) \
        __builtin_amdgcn_global_load_lds((const unsigned*)((const char*)(gbase) + (voff)[_i]), (PG8_LAS unsigned*)(lds + (bufoff) + ldsw + _i * 8192), 16, 0, 0); } while (0)
#define PG8_STA(bufoff, gbase, h, nx) do { if constexpr (Sched::GATHER) { _Pragma("unroll") for (int _i = 0; _i < 2; ++_i) { const unsigned o_ = (nx) ? nof[h][_i] : cof[h][_i]; \
        __builtin_amdgcn_global_load_lds((const unsigned*)((const char*)(gbase) + o_), (PG8_LAS unsigned*)(lds + (bufoff) + ldsw + _i * 8192), 16, 0, 0); } } \
        else { PG8_STAGE(bufoff, (gbase) + (h) * hstep, voffA); } } while (0)
#define PG8_LDA(dst, b, h) do { _Pragma("unroll") for (int m = 0; m < 4; ++m) _Pragma("unroll") for (int k = 0; k < 2; ++k) dst[m][k] = *(const PG8_LAS bf16x8*)(lds + PG8_SA(b, h) + aoff + m * 2048 + k * 1024); } while (0)
#define PG8_LDB(dst, b, h) do { _Pragma("unroll") for (int n = 0; n < 2; ++n) _Pragma("unroll") for (int k = 0; k < 2; ++k) dst[n][k] = *(const PG8_LAS bf16x8*)(lds + PG8_SB(b, h) + boff + n * 2048 + k * 1024); } while (0)
#define PG8_MMA(ai, bj, At, Bt) do { __builtin_amdgcn_s_setprio(1); _Pragma("unroll") for (int m = 0; m < 4; ++m) _Pragma("unroll") for (int n = 0; n < 2; ++n) _Pragma("unroll") for (int k = 0; k < 2; ++k) \
        acc[ai][bj][m][n] = __builtin_amdgcn_mfma_f32_16x16x32_bf16(Bt[n][k], At[m][k], acc[ai][bj][m][n], 0, 0, 0); __builtin_amdgcn_s_setprio(0); } while (0)
#define PG8_WAIT_V(n) asm volatile("s_waitcnt vmcnt(" #n ")" ::: "memory")
#define PG8_WAIT_L(n) asm volatile("s_waitcnt lgkmcnt(" #n ")" ::: "memory")
#define PG8_BAR __builtin_amdgcn_s_barrier()
#define PG8_SCHED __builtin_amdgcn_sched_barrier(0)
    Unit cur, nxt; int ui = 0;
    if (!S.next(0, cur)) return;
    f32x4 acc[2][2][4][2];
#pragma unroll
    for (int a = 0; a < 2; ++a)
#pragma unroll
        for (int b = 0; b < 2; ++b)
#pragma unroll
            for (int m = 0; m < 4; ++m)
#pragma unroll
                for (int n = 0; n < 2; ++n) acc[a][b][m][n] = (f32x4){0.f, 0.f, 0.f, 0.f};
    bf16x8 At[4][2], B0[2][2], B1[2][2];
    unsigned cof[2][2], nof[2][2];
    const char* cA = S.abase(cur); if constexpr (Sched::GATHER) S.aoffs(cur, Rs, Cs, cof); const char* cB = S.bbase(cur);
    PG8_STAGE(PG8_SB(0, 0), cB, voffB); PG8_STAGE(PG8_SB(0, 1), cB + hstep, voffB); PG8_STA(PG8_SA(0, 0), cA, 0, false); PG8_STA(PG8_SA(0, 1), cA, 1, false);
    if (wr == 1) PG8_BAR;
    PG8_WAIT_V(2); PG8_BAR;
    PG8_STAGE(PG8_SB(1, 0), cB + kstep, voffB); PG8_STA(PG8_SA(1, 0), cA + kstep, 0, false); PG8_STAGE(PG8_SB(1, 1), cB + hstep + kstep, voffB);
    PG8_WAIT_V(6); PG8_BAR;
    for (;;) {
        const bool has_next = S.next(ui + 1, nxt);
        const char* nA = cA; const char* nB = cB;
        if constexpr (Sched::GATHER) {
#pragma unroll
            for (int h = 0; h < 2; ++h)
#pragma unroll
                for (int i = 0; i < 2; ++i) nof[h][i] = cof[h][i]; }
        if (has_next) { nA = S.abase(nxt); if constexpr (Sched::GATHER) S.aoffs(nxt, Rs, Cs, nof); nB = S.bbase(nxt); }
        for (int t = 0; t < nt; t += 2) {
            const bool last = (t == nt - 2);
            if constexpr (Epi::HOOK) { PG8_SCHED; E.khook(acc, cur, t, wr, wc, fr, fq); PG8_SCHED; }
            const char* a1 = cA + (size_t)(t + 1) * kstep;
            const char* a2 = last ? nA : cA + (size_t)(t + 2) * kstep; const char* b2 = last ? nB : cB + (size_t)(t + 2) * kstep;
            const char* a3 = a2 + kstep; const char* b3 = b2 + kstep;
            PG8_LDB(B0, 0, 0); PG8_LDB(B1, 0, 1); PG8_SCHED; PG8_LDA(At, 0, 0); PG8_STA(PG8_SA(1, 1), a1, 1, false);
            PG8_WAIT_V(8); PG8_WAIT_L(0); PG8_BAR; PG8_MMA(0, 0, At, B0); PG8_MMA(0, 1, At, B1); PG8_BAR; PG8_SCHED;
            PG8_LDA(At, 0, 1); PG8_STAGE(PG8_SB(0, 0), b2, voffB); PG8_STAGE(PG8_SB(0, 1), b2 + hstep, voffB); PG8_STA(PG8_SA(0, 0), a2, 0, last);
            PG8_WAIT_V(8); PG8_WAIT_L(0); PG8_BAR; PG8_MMA(1, 0, At, B0); PG8_MMA(1, 1, At, B1); PG8_BAR; PG8_SCHED;
            PG8_LDB(B0, 1, 0); PG8_LDB(B1, 1, 1); PG8_SCHED; PG8_LDA(At, 1, 0); PG8_STA(PG8_SA(0, 1), a2, 1, last);
            PG8_WAIT_V(8); PG8_WAIT_L(0); PG8_BAR; PG8_MMA(0, 0, At, B0); PG8_MMA(0, 1, At, B1); PG8_BAR; PG8_SCHED;
            PG8_LDA(At, 1, 1); PG8_STAGE(PG8_SB(1, 0), b3, voffB); PG8_STAGE(PG8_SB(1, 1), b3 + hstep, voffB); PG8_STA(PG8_SA(1, 0), a3, 0, last);
            PG8_WAIT_V(8); PG8_WAIT_L(0); PG8_BAR; PG8_MMA(1, 0, At, B0); PG8_MMA(1, 1, At, B1); PG8_BAR; PG8_SCHED;
        }
        if (wr == 0) PG8_BAR;
        E(acc, cur, wr, wc, fr, fq);
        if (!has_next) break;
#pragma unroll
        for (int a = 0; a < 2; ++a)
#pragma unroll
            for (int b = 0; b < 2; ++b)
#pragma unroll
                for (int m = 0; m < 4; ++m)
#pragma unroll
                    for (int n = 0; n < 2; ++n) acc[a][b][m][n] = (f32x4){0.f, 0.f, 0.f, 0.f};
        cur = nxt; cA = nA; cB = nB; ++ui;
        if constexpr (Sched::GATHER) {
#pragma unroll
            for (int h = 0; h < 2; ++h)
#pragma unroll
                for (int i = 0; i < 2; ++i) cof[h][i] = nof[h][i]; }
        if (wr == 1) PG8_BAR;
    }
    PG8_WAIT_V(0);
    PG8_BAR;
#undef PG8_SA
#undef PG8_SB
#undef PG8_STAGE
#undef PG8_STA
#undef PG8_LDA
#undef PG8_LDB
#undef PG8_MMA
#undef PG8_WAIT_V
#undef PG8_WAIT_L
#undef PG8_BAR
#undef PG8_SCHED
}
}

constexpr int NWAVES = 8;
constexpr int D = 1024, BATCH = 8, SEQ = 2048, M = BATCH * SEQ;
constexpr int N_INSRC = 7176, N_INV = 7168;
constexpr int FL_COL = 3072;
constexpr int DFF_D = 2816, DFF_E = 3584, NEXP = 8;
constexpr float LN_EPS = 1e-5f, GN_EPS = 1e-6f;
constexpr float ALPHA = 1.4142135623730951f;
constexpr float LOG2E = 1.4426950408889634f;
constexpr float C2 = 0.125f * LOG2E;

constexpr size_t MiB = 1u << 20;
constexpr size_t WS_CTL = 0, CTL_ZERO_BYTES = 1 * MiB;
constexpr size_t WS_CS = 1 * MiB;
constexpr size_t WS_LIST = 2 * MiB;
constexpr size_t WS_GATEW = 2 * MiB + 512 * 1024;
constexpr size_t WS_LOGF = 3 * MiB;
constexpr size_t WS_WIN = 4 * MiB;
constexpr size_t WS_WBR = 32 * MiB;
constexpr size_t WS_WOUT = 38 * MiB;
constexpr size_t WS_WDU = 42 * MiB;
constexpr size_t WS_WDD = 53 * MiB;
constexpr size_t WS_WMU = 59 * MiB;
constexpr size_t WS_WMD = 171 * MiB;
constexpr size_t WS_XB = 227 * MiB;
constexpr size_t WS_XF = 259 * MiB;
constexpr size_t WS_YPRE = 323 * MiB;
constexpr size_t WS_C1 = 387 * MiB;
constexpr size_t WS_MRG = 451 * MiB;
constexpr size_t WS_RQ = 483 * MiB, WS_RK = 491 * MiB, WS_RV = 499 * MiB, WS_RG = 515 * MiB, WS_FQ = 531 * MiB, WS_FK = 547 * MiB, WS_FV = 563 * MiB,
                 WS_GU = 579 * MiB, WS_GV = 595 * MiB, WS_GT = 611 * MiB, WS_YB = 707 * MiB, WS_END = 755 * MiB;
constexpr size_t WS_HID = 483 * MiB;
static_assert((size_t)34816 * DFF_E * 2 <= WS_END - WS_HID, "MoE hidden fits its overlay");
constexpr int CW_TMO = 0, CW_CODE = 1;
constexpr int CW_CNT = 64;
constexpr int CW_BAR = 4096;

constexpr int RING_OFF = 0, RING_BYTES = 135168;
constexpr int LDSCTL_OFF = RING_BYTES, MISC_OFF = LDSCTL_OFF + 320;
constexpr int LDS_BYTES = 147456;
static_assert(MISC_OFF + 128 <= LDS_BYTES, "LDS map");

#define GAS __attribute__((address_space(1)))
#define LAS __attribute__((address_space(3)))
typedef unsigned short bf16;
typedef unsigned v4u __attribute__((ext_vector_type(4)));
typedef unsigned v2u __attribute__((ext_vector_type(2)));
typedef float f32x4 __attribute__((ext_vector_type(4)));
typedef GAS unsigned gu32;
#define RLX_AGENT __ATOMIC_RELAXED, __HIP_MEMORY_SCOPE_AGENT
#define LDS_WAIT() asm volatile("s_waitcnt lgkmcnt(0)" ::: "memory")
#define VM_WAIT() asm volatile("s_waitcnt vmcnt(0)" ::: "memory")
__device__ __forceinline__ unsigned f2bf(float f) { unsigned u = __builtin_bit_cast(unsigned, f); return (u + 0x7fffu + ((u >> 16) & 1u)) >> 16; }
__device__ __forceinline__ unsigned pk2(float lo, float hi) { return f2bf(lo) | (f2bf(hi) << 16); }
__device__ __forceinline__ float bf2f(unsigned short h) { return __builtin_bit_cast(float, (unsigned)h << 16); }
__device__ __forceinline__ float bflo(unsigned w) { return __builtin_bit_cast(float, w << 16); }
__device__ __forceinline__ float bfhi(unsigned w) { return __builtin_bit_cast(float, w & 0xffff0000u); }
__device__ __forceinline__ float fsigmoid(float x) { return __builtin_amdgcn_rcpf(1.0f + __builtin_amdgcn_exp2f(-x * LOG2E)); }
__device__ __forceinline__ float fsilu(float x) { return x * fsigmoid(x); }
__device__ __forceinline__ float fgelu_tanh(float x) { const float u = 0.7978845608028654f * (x + 0.044715f * x * x * x); return x * fsigmoid(2.0f * u); }

#define XB_TMO      128
#define XB_XCNT(j)  (256  + 64 * (j))
#define XB_XSUB(j)  (1280 + 64 * (j))
#define XB_XGEN(j)  (2304 + 64 * (j))
#define XB_TOP      3328
#define XB_TOPGEN   3392
#define XCD_BAR_WORDS 3456
#define XB_SPIN_CAP (1u << 18)
__device__ __forceinline__ unsigned xb_ld(unsigned* p)              { return __hip_atomic_load(p, __ATOMIC_RELAXED, __HIP_MEMORY_SCOPE_AGENT); }
__device__ __forceinline__ unsigned xb_add(unsigned* p, unsigned v) { return __hip_atomic_fetch_add(p, v, __ATOMIC_RELAXED, __HIP_MEMORY_SCOPE_AGENT); }
__device__ __forceinline__ unsigned xb_xcc_id() { return (unsigned)__builtin_amdgcn_s_getreg((3 << 11) | 20) & 0xFu; }
#define XB_SPIN(cond, bar) do { unsigned _sp = 0; while (cond) { __builtin_amdgcn_s_sleep(1); \
    if ((++_sp & 255u) == 0u) { if (xb_ld(&(bar)[XB_TMO])) break; if (_sp > XB_SPIN_CAP) { atomicAdd(&(bar)[XB_TMO], 1u); break; } } } } while (0)
struct XcdBarrier { unsigned* bar; unsigned x; volatile LAS unsigned* st; };
__device__ __forceinline__ XcdBarrier xcd_barrier_post(unsigned* bar, volatile LAS unsigned* st) {
    XcdBarrier b; b.bar = bar; b.x = xb_xcc_id(); b.st = st;
    if (threadIdx.x == 0) (void)xb_add(&bar[XB_XCNT(b.x)], 1u);
    return b;
}
__device__ __forceinline__ void xcd_barrier_complete(unsigned* bar, unsigned x, unsigned& nloc, unsigned& nx) {
    const unsigned G = gridDim.x * gridDim.y * gridDim.z;
    unsigned sum, cnt, mine, sp = 0u;
    for (;;) {
        sum = 0u; cnt = 0u; mine = 0u;
#pragma unroll
        for (unsigned j = 0; j < 16; ++j) { const unsigned c = xb_ld(&bar[XB_XCNT(j)]); sum += c; cnt += (c > 0u) ? 1u : 0u; mine = (j == x) ? c : mine; }
        if (sum == G) break;
        __builtin_amdgcn_s_sleep(1);
        if ((++sp & 255u) == 0u) { if (xb_ld(&bar[XB_TMO])) break; if (sp > XB_SPIN_CAP) { atomicAdd(&bar[XB_TMO], 1u); break; } }
    }
    nloc = mine > 0u ? mine : 1u; nx = cnt > 0u ? cnt : 1u;
}
__device__ __forceinline__ void xcd_barrier(const XcdBarrier& b) {
    asm volatile("s_waitcnt vmcnt(0)" ::: "memory");
    __syncthreads();
    if (threadIdx.x == 0) {
        unsigned* bar = b.bar;
        __builtin_amdgcn_s_waitcnt(0);
        unsigned nloc = b.st[0], nx = b.st[1];
        if (nloc == 0u) { xcd_barrier_complete(bar, b.x, nloc, nx); b.st[0] = nloc; b.st[1] = nx; }
        const unsigned old = xb_add(&bar[XB_XSUB(b.x)], 1u);
        const unsigned gen = old / nloc;
        if (old + 1u == (gen + 1u) * nloc) {
            __builtin_amdgcn_fence(__ATOMIC_RELEASE, "agent");
            asm volatile("s_waitcnt vmcnt(0)" ::: "memory");
            const unsigned og = xb_add(&bar[XB_TOP], 1u);
            const unsigned tg = og / nx;
            if (og + 1u == (tg + 1u) * nx) xb_add(&bar[XB_TOPGEN], 1u);
            else XB_SPIN(xb_ld(&bar[XB_TOPGEN]) == tg, bar);
            __builtin_amdgcn_fence(__ATOMIC_ACQUIRE, "agent");
            xb_add(&bar[XB_XGEN(b.x)], 1u);
            asm volatile("s_waitcnt vmcnt(0)" ::: "memory");
        } else {
            XB_SPIN(xb_ld(&bar[XB_XGEN(b.x)]) == gen, bar);
            __builtin_amdgcn_fence(__ATOMIC_ACQUIRE, "agent");
            asm volatile("s_waitcnt vmcnt(0)" ::: "memory");
        }
    }
    __syncthreads();
}

using pg8::Unit; using pg8::bf16_t;
#define ACC_T const pg8::f32x4 (&acc)[2][2][4][2]

struct EpiProj {
    static constexpr bool PERM = true, HOOK = false;
    unsigned char* ws; const float* gate_b; const float* cs;
    __device__ __forceinline__ void operator()(ACC_T, const Unit& u, int wr, int wc, int fr, int fq) const {
        const int pn = u.pn, row0 = u.pm * 256 + wr * 64 + fr, lc = wc * 32 + 8 * fq;
        if (pn < 2) {
            bf16_t* dst = (bf16_t*)(ws + (pn == 0 ? WS_RQ : WS_RK)); const float sc = pn == 0 ? 1.0f : 0.125f;
            const int d1 = 16 * (wc & 1) + 4 * fq;
#pragma unroll
            for (int ai = 0; ai < 2; ++ai)
#pragma unroll
                for (int m = 0; m < 4; ++m) { const int row = row0 + ai * 128 + m * 16, pos = row & (SEQ - 1);
                    const f32x4 c4 = *(const f32x4*)(cs + pos * 32 + d1), s4 = *(const f32x4*)(cs + 65536 + pos * 32 + d1);
#pragma unroll
                    for (int bj = 0; bj < 2; ++bj) { const int head = bj * 2 + (wc >> 1); const f32x4 x1 = acc[ai][bj][m][0], x2 = acc[ai][bj][m][1];
                        const f32x4 o1 = (x1 * c4 - x2 * s4) * sc, o2 = (x1 * s4 + x2 * c4) * sc;
                        bf16_t* p = dst + (size_t)row * 256 + head * 64 + d1;
                        v2u w1, w2; w1.x = pg8::cvt_pk_bf16(o1[0], o1[1]); w1.y = pg8::cvt_pk_bf16(o1[2], o1[3]); w2.x = pg8::cvt_pk_bf16(o2[0], o2[1]); w2.y = pg8::cvt_pk_bf16(o2[2], o2[3]);
                        *(v2u*)p = w1; *(v2u*)(p + 32) = w2; } }
            return;
        }
        size_t off; int pitch, coff, act;
        if (pn < 4) { off = WS_RV; pitch = 512; coff = (pn - 2) * 256; act = 0; }
        else if (pn < 6) { off = WS_RG; pitch = 512; coff = (pn - 4) * 256; act = 1; }
        else if (pn < 8) { off = WS_FQ; pitch = 512; coff = (pn - 6) * 256; act = 2; }
        else if (pn < 10) { off = WS_FK; pitch = 512; coff = (pn - 8) * 256; act = 0; }
        else if (pn < 12) { off = WS_FV; pitch = 512; coff = (pn - 10) * 256; act = 0; }
        else if (pn < 14) { off = WS_GU; pitch = 512; coff = (pn - 12) * 256; act = 3; }
        else if (pn < 16) { off = WS_GV; pitch = 512; coff = (pn - 14) * 256; act = 3; }
        else { off = WS_GT; pitch = 3072; coff = (pn - 16) * 256; act = 4; }
        bf16_t* dst = (bf16_t*)(ws + off);
        f32x4 bv[2][2];
#pragma unroll
        for (int bj = 0; bj < 2; ++bj)
#pragma unroll
            for (int n = 0; n < 2; ++n) bv[bj][n] = (act == 4) ? *(const f32x4*)(gate_b + coff + bj * 128 + lc + 4 * n) : (f32x4){0.f, 0.f, 0.f, 0.f};
#pragma unroll
        for (int ai = 0; ai < 2; ++ai)
#pragma unroll
            for (int m = 0; m < 4; ++m) { bf16_t* rowp = dst + (size_t)(row0 + ai * 128 + m * 16) * pitch + coff + lc;
#pragma unroll
                for (int bj = 0; bj < 2; ++bj) { float v[8];
#pragma unroll
                    for (int j = 0; j < 4; ++j) { v[j] = acc[ai][bj][m][0][j] + bv[bj][0][j]; v[4 + j] = acc[ai][bj][m][1][j] + bv[bj][1][j]; }
#pragma unroll
                    for (int j = 0; j < 8; ++j) { float x = v[j];
                        if (act == 1) x = fsilu(x); else if (act == 2) x = x * C2; else if (act == 3) x = fgelu_tanh(x); else if (act == 4) x = fsigmoid(x);
                        v[j] = x; }
                    v4u w; w.x = pg8::cvt_pk_bf16(v[0], v[1]); w.y = pg8::cvt_pk_bf16(v[2], v[3]); w.z = pg8::cvt_pk_bf16(v[4], v[5]); w.w = pg8::cvt_pk_bf16(v[6], v[7]);
                    *(v4u*)(rowp + bj * 128) = w; } }
    }
};

struct EpiMerge {
    static constexpr bool PERM = true, HOOK = true;
    const bf16_t* GT; bf16_t* MRG;
    __device__ __forceinline__ void gate8(float (&g)[8], int row, int col, int n) const {
        const v4u w = *(const v4u*)(GT + (size_t)row * 3072 + n * 1024 + col);
        g[0] = bflo(w.x); g[1] = bfhi(w.x); g[2] = bflo(w.y); g[3] = bfhi(w.y); g[4] = bflo(w.z); g[5] = bfhi(w.z); g[6] = bflo(w.w); g[7] = bfhi(w.w);
#pragma unroll
        for (int j = 0; j < 8; ++j) g[j] = fmaxf(g[j], 1e-30f);
    }
    __device__ __forceinline__ void khook(pg8::f32x4 (&acc)[2][2][4][2], const Unit& u, int t, int wr, int wc, int fr, int fq) const {
        if (t != 8 && t != 16) return;
        const int np = (t == 8) ? 0 : 1; int row0 = u.pm * 256 + wr * 64 + fr; const int col0 = u.pn * 256 + wc * 32 + 8 * fq;
        asm volatile("" : "+v"(row0));
#pragma unroll
        for (int ai = 0; ai < 2; ++ai)
#pragma unroll
            for (int m = 0; m < 4; ++m)
#pragma unroll
                for (int bj = 0; bj < 2; ++bj) { float gp[8], gn[8]; const int row = row0 + ai * 128 + m * 16, col = col0 + bj * 128;
                    gate8(gp, row, col, np); gate8(gn, row, col, np + 1);
#pragma unroll
                    for (int j = 0; j < 4; ++j) { acc[ai][bj][m][0][j] *= gp[j] * __builtin_amdgcn_rcpf(gn[j]); acc[ai][bj][m][1][j] *= gp[4 + j] * __builtin_amdgcn_rcpf(gn[4 + j]); }
                    asm volatile("" : "+v"(acc[ai][bj][m][0]), "+v"(acc[ai][bj][m][1]) :: "memory"); }
    }
    __device__ __forceinline__ void operator()(ACC_T, const Unit& u, int wr, int wc, int fr, int fq) const {
        const int row0 = u.pm * 256 + wr * 64 + fr, col0 = u.pn * 256 + wc * 32 + 8 * fq;
#pragma unroll
        for (int ai = 0; ai < 2; ++ai)
#pragma unroll
            for (int m = 0; m < 4; ++m)
#pragma unroll
                for (int bj = 0; bj < 2; ++bj) { float g[8]; const int row = row0 + ai * 128 + m * 16, col = col0 + bj * 128; gate8(g, row, col, 2);
                    v4u w; w.x = pg8::cvt_pk_bf16(acc[ai][bj][m][0][0] * g[0], acc[ai][bj][m][0][1] * g[1]); w.y = pg8::cvt_pk_bf16(acc[ai][bj][m][0][2] * g[2], acc[ai][bj][m][0][3] * g[3]);
                    w.z = pg8::cvt_pk_bf16(acc[ai][bj][m][1][0] * g[4], acc[ai][bj][m][1][1] * g[5]); w.w = pg8::cvt_pk_bf16(acc[ai][bj][m][1][2] * g[6], acc[ai][bj][m][1][3] * g[7]);
                    *(v4u*)(MRG + (size_t)row * 1024 + col) = w; asm volatile("" ::: "memory"); }
    }
};

struct EpiResid {
    static constexpr bool PERM = false, HOOK = false;
    const float* res; float* out;
    __device__ __forceinline__ void operator()(ACC_T, const Unit& u, int wr, int wc, int fr, int fq) const {
        const int row0 = u.pm * 256 + wr * 64 + fr, col0 = u.pn * 256 + wc * 32 + 4 * fq;
#pragma unroll
        for (int ai = 0; ai < 2; ++ai)
#pragma unroll
            for (int m = 0; m < 4; ++m) { const size_t off = (size_t)(row0 + ai * 128 + m * 16) * 1024 + col0;
#pragma unroll
                for (int bj = 0; bj < 2; ++bj)
#pragma unroll
                    for (int n = 0; n < 2; ++n) { const f32x4 r = *(const f32x4*)(res + off + bj * 128 + n * 16); *(f32x4*)(out + off + bj * 128 + n * 16) = r * ALPHA + acc[ai][bj][m][n]; } }
    }
};

struct EpiSwiglu {
    static constexpr bool PERM = true, HOOK = false;
    bf16_t* H; int ldh;
    __device__ __forceinline__ void operator()(ACC_T, const Unit& u, int wr, int wc, int fr, int fq) const {
        const int row0 = u.pm * 256 + wr * 64 + fr, col0 = u.pn * 128 + wc * 16 + 4 * fq;
#pragma unroll
        for (int ai = 0; ai < 2; ++ai)
#pragma unroll
            for (int m = 0; m < 4; ++m) { bf16_t* rowp = H + (size_t)(row0 + ai * 128 + m * 16) * ldh + col0;
#pragma unroll
                for (int bj = 0; bj < 2; ++bj) { const f32x4 a = acc[ai][bj][m][0], b = acc[ai][bj][m][1];
                    v2u w; w.x = pg8::cvt_pk_bf16(fsilu(a[0]) * b[0], fsilu(a[1]) * b[1]); w.y = pg8::cvt_pk_bf16(fsilu(a[2]) * b[2], fsilu(a[3]) * b[3]);
                    *(v2u*)(rowp + bj * 64) = w; } }
    }
};

struct MoeTiles {
    int cnt[NEXP]; int toff[NEXP + 1];
    __device__ __forceinline__ void init(const gu32* ctl) {
        int t = 0;
#pragma unroll
        for (int e = 0; e < NEXP; ++e) { cnt[e] = __builtin_amdgcn_readfirstlane((int)__hip_atomic_load(ctl + CW_CNT + 64 * e, RLX_AGENT)); toff[e] = t; t += (cnt[e] + 255) >> 8; }
        toff[NEXP] = t;
    }
    __device__ __forceinline__ void find(int pm, int& e, int& slot0, int& n) const {
        int ee = 0;
#pragma unroll
        for (int j = 1; j < NEXP; ++j) if (pm >= toff[j]) ee = j;
        int c = 0, t0 = 0;
#pragma unroll
        for (int j = 0; j < NEXP; ++j) if (j == ee) { c = cnt[j]; t0 = toff[j]; }
        e = ee; slot0 = (pm - t0) * 256; n = c;
    }
};
struct MoeUpSched : pg8::TileOrder {
    static constexpr bool GATHER = true;
    const bf16_t* A; const bf16_t* Bt; const unsigned* list; MoeTiles mt;
    __device__ __forceinline__ const char* abase(const Unit&) const { return (const char*)A; }
    __device__ __forceinline__ void aoffs(const Unit& u, const int (&R)[2], const int (&C)[2], unsigned (&o)[2][2]) const {
        int e, s0, n; mt.find(u.pm, e, s0, n);
#pragma unroll
        for (int h = 0; h < 2; ++h)
#pragma unroll
            for (int i = 0; i < 2; ++i) { const int slot = s0 + R[i] + h * 128; unsigned tok = 0u; if (slot < n) tok = list[e * 16384 + slot] & 0x7fffffffu; o[h][i] = (tok * 1024u + (unsigned)C[i]) * 2u; }
    }
    __device__ __forceinline__ const char* bbase(const Unit& u) const { int e, s0, n; mt.find(u.pm, e, s0, n); return (const char*)Bt + ((size_t)e * (2 * DFF_E) + (size_t)u.pn * 256) * 1024 * 2; }
};
struct MoeDownSched : pg8::TileOrder {
    static constexpr bool GATHER = false;
    const bf16_t* A; const bf16_t* Bt; MoeTiles mt;
    __device__ __forceinline__ const char* abase(const Unit& u) const { return (const char*)A + (size_t)u.pm * 256 * DFF_E * 2; }
    __device__ __forceinline__ void aoffs(const Unit&, const int (&R)[2], const int (&C)[2], unsigned (&o)[2][2]) const {
#pragma unroll
        for (int h = 0; h < 2; ++h)
#pragma unroll
            for (int i = 0; i < 2; ++i) o[h][i] = (unsigned)((R[i] + h * 128) * DFF_E + C[i]) * 2u; }
    __device__ __forceinline__ const char* bbase(const Unit& u) const { int e, s0, n; mt.find(u.pm, e, s0, n); return (const char*)Bt + ((size_t)e * 1024 + (size_t)u.pn * 256) * DFF_E * 2; }
};
struct EpiMoeDown {
    static constexpr bool PERM = false, HOOK = false;
    float* c0; float* c1; const unsigned* list; const float* gatew; MoeTiles mt;
    __device__ __forceinline__ void operator()(ACC_T, const Unit& u, int wr, int wc, int fr, int fq) const {
        int e, s0, n; mt.find(u.pm, e, s0, n);
        const int col0 = u.pn * 256 + wc * 32 + 4 * fq;
#pragma unroll
        for (int ai = 0; ai < 2; ++ai)
#pragma unroll
            for (int m = 0; m < 4; ++m) { const int slot = s0 + ai * 128 + wr * 64 + m * 16 + fr;
                if (slot < n) { const unsigned ent = list[e * 16384 + slot]; const float g = gatew[e * 16384 + slot];
                    float* dst = ((ent >> 31) ? c1 : c0) + (size_t)(ent & 0x7fffffffu) * 1024 + col0;
#pragma unroll
                    for (int bj = 0; bj < 2; ++bj)
#pragma unroll
                        for (int n2 = 0; n2 < 2; ++n2) *(f32x4*)(dst + bj * 128 + n2 * 16) = acc[ai][bj][m][n2] * g; } }
    }
};

struct Frame {
    LAS unsigned char* lds;
    volatile LAS unsigned* MISC;
    gu32* ctl;
    int tid, lane, wave;
    int vcu, G;
    unsigned char* ws;
};
__device__ __forceinline__ float wave_sum(float v) {
#pragma unroll
    for (int o = 1; o < 64; o <<= 1) v += __shfl_xor(v, o);
    return v;
}

__device__ __forceinline__ int mapcol(int kind, int dff, int v) {
    if (kind == 0) return v;
    if (kind == 1) {
        if (v < 512) { const int w = v & 63; return (v & ~63) + 32 * ((w >> 2) & 1) + 4 * (w >> 3) + (w & 3); }
        return v < FL_COL ? v : v + 8;
    }
    const int tile = v >> 8, vl = v & 255, n = (vl >> 2) & 1, j = tile * 128 + (vl >> 3) * 4 + (vl & 3);
    return n ? dff + j : j;
}
__device__ __forceinline__ void cvt_item(const float* W, int Nsrc, bf16* dst, int dpitch, int koff, int kind, int dff, int k0, int v0, LAS float* scr, int lane) {
    const int sc = mapcol(kind, dff, v0 + lane);
    const float* src = W + (size_t)k0 * Nsrc + sc;
#pragma unroll 8
    for (int kk = 0; kk < 64; ++kk) scr[kk * 65 + lane] = src[(size_t)kk * Nsrc];
    LDS_WAIT(); asm volatile("" ::: "memory");
    const int c = lane & 7;
#pragma unroll
    for (int j = 0; j < 8; ++j) { const int n = (lane >> 3) + 8 * j; const LAS float* s = scr + (8 * c) * 65 + n;
        v4u o; o.x = pk2(s[0 * 65], s[1 * 65]); o.y = pk2(s[2 * 65], s[3 * 65]); o.z = pk2(s[4 * 65], s[5 * 65]); o.w = pk2(s[6 * 65], s[7 * 65]);
        *(GAS v4u*)(dst + (size_t)(v0 + n) * dpitch + koff + k0 + 8 * c) = o; }
    LDS_WAIT(); asm volatile("" ::: "memory");
}
struct CvtJob { const float* W; int K, Nsrc, Nv; bf16* dst; int dpitch, koff, kind, dff; };
__device__ __forceinline__ bool cvt_run(const CvtJob& j, int& r, LAS float* scr, int lane) {
    const int nvb = j.Nv / 64, items = (j.K / 64) * nvb;
    if (r >= items) { r -= items; return false; }
    cvt_item(j.W, j.Nsrc, j.dst, j.dpitch, j.koff, j.kind, j.dff, 64 * (r / nvb), 64 * (r % nvb), scr, lane);
    return true;
}

__device__ __forceinline__ float row_dot8(const f32x4 (&v)[4], const LAS float* wT, int lane) {
    float r = 0.f;
#pragma unroll 1
    for (int h = 0; h < 8; ++h) { float s = 0.f;
#pragma unroll
        for (int j = 0; j < 4; ++j) { const f32x4 w = *(const LAS f32x4*)(wT + h * 1024 + 256 * j + 4 * lane); s += (v[j].x * w.x + v[j].y * w.y) + (v[j].z * w.z + v[j].w * w.w); }
        s = wave_sum(s); if (lane == h) r = s; }
    return r;
}
__device__ __forceinline__ void stage_w8(Frame& F, const float* W, int pitch, int col0) {
    LAS float* wT = (LAS float*)(F.lds + RING_OFF);
    for (int i = F.tid; i < 8192; i += NWAVES * 64) { const int d = i >> 3, h = i & 7; wT[h * 1024 + d] = W[(size_t)d * pitch + col0 + h]; }
    LDS_WAIT(); __syncthreads();
}
__device__ __forceinline__ float log_sigmoid(float x) { return fminf(x, 0.f) - log1pf(expf(-fabsf(x))); }

__device__ __forceinline__ void p0_rows(Frame& F, const float* x, const float* w_in0, const float* fox_b) {
    stage_w8(F, w_in0, N_INSRC, FL_COL);
    const LAS float* wT = (const LAS float*)(F.lds + RING_OFF);
    const int gw = F.vcu * NWAVES + F.wave, NGW = F.G * NWAVES;
    bf16* XB = (bf16*)(F.ws + WS_XB); float* LOGF = (float*)(F.ws + WS_LOGF);
#pragma unroll 1
    for (int m = gw; m < M; m += NGW) {
        const GAS f32x4* xr = (const GAS f32x4*)(x + (size_t)m * D) + F.lane; f32x4 v[4];
#pragma unroll
        for (int j = 0; j < 4; ++j) v[j] = xr[64 * j];
        GAS unsigned long long* o8 = (GAS unsigned long long*)(XB + (size_t)m * D) + F.lane;
#pragma unroll
        for (int j = 0; j < 4; ++j) o8[64 * j] = (unsigned long long)pk2(v[j].x, v[j].y) | ((unsigned long long)pk2(v[j].z, v[j].w) << 32);
        const float r = row_dot8(v, wT, F.lane);
        if (F.lane < 8) LOGF[(size_t)m * 8 + F.lane] = log_sigmoid(r + fox_b[F.lane]);
    }
    __syncthreads();
}

template <int AUX>
__device__ __forceinline__ void ln_pass(Frame& F, const float* src, const float* add1, const float* add2, float add1_scale, const float* g, const float* b, float* outf, bf16* outb,
                                        const float* w8, int w8pitch, int w8col, const float* fox_b) {
    if (AUX != 0) stage_w8(F, w8, w8pitch, w8col);
    const LAS float* wT = (const LAS float*)(F.lds + RING_OFF);
    const int gw = F.vcu * NWAVES + F.wave, NGW = F.G * NWAVES;
    f32x4 gv[4], bv[4];
#pragma unroll
    for (int j = 0; j < 4; ++j) { gv[j] = *((const f32x4*)g + F.lane + 64 * j); bv[j] = *((const f32x4*)b + F.lane + 64 * j); }
#pragma unroll 1
    for (int m = gw; m < M; m += NGW) {
        f32x4 v[4]; float s = 0.f;
#pragma unroll
        for (int j = 0; j < 4; ++j) { v[j] = *((const GAS f32x4*)(src + (size_t)m * D) + F.lane + 64 * j);
            if (add1) v[j] = v[j] + *((const GAS f32x4*)(add1 + (size_t)m * D) + F.lane + 64 * j) * add1_scale;
            if (add2) v[j] = v[j] + *((const GAS f32x4*)(add2 + (size_t)m * D) + F.lane + 64 * j);
            s += (v[j].x + v[j].y) + (v[j].z + v[j].w); }
        const float mean = wave_sum(s) * (1.f / D); float s2 = 0.f;
#pragma unroll
        for (int j = 0; j < 4; ++j) { v[j] = v[j] - mean; s2 += (v[j].x * v[j].x + v[j].y * v[j].y) + (v[j].z * v[j].z + v[j].w * v[j].w); }
        const float rstd = 1.f / sqrtf(wave_sum(s2) * (1.f / D) + LN_EPS);
#pragma unroll
        for (int j = 0; j < 4; ++j) v[j] = v[j] * rstd * gv[j] + bv[j];
        if (outf) {
#pragma unroll
            for (int j = 0; j < 4; ++j) *((GAS f32x4*)(outf + (size_t)m * D) + F.lane + 64 * j) = v[j]; }
        if (outb) { GAS unsigned long long* o8 = (GAS unsigned long long*)(outb + (size_t)m * D) + F.lane;
#pragma unroll
            for (int j = 0; j < 4; ++j) o8[64 * j] = (unsigned long long)pk2(v[j].x, v[j].y) | ((unsigned long long)pk2(v[j].z, v[j].w) << 32); }
        if (AUX == 1) {
            const float r = row_dot8(v, wT, F.lane);
            if (F.lane < 8) ((float*)(F.ws + WS_LOGF))[(size_t)m * 8 + F.lane] = log_sigmoid(r + fox_b[F.lane]);
        }
        if (AUX == 2) {
            const float rl = row_dot8(v, wT, F.lane); float lg[8];
#pragma unroll
            for (int e = 0; e < 8; ++e) lg[e] = __shfl(rl, e);
            if (F.lane == 0) {
                int i1 = 0; float v1 = lg[0];
#pragma unroll
                for (int e = 1; e < 8; ++e) if (lg[e] > v1) { v1 = lg[e]; i1 = e; }
                int i2 = -1; float v2 = -INFINITY;
#pragma unroll
                for (int e = 0; e < 8; ++e) if (e != i1 && lg[e] > v2) { v2 = lg[e]; i2 = e; }
                const float w1 = 1.0f / (1.0f + expf(v2 - v1)), w2 = 1.0f - w1;
                unsigned* list = (unsigned*)(F.ws + WS_LIST); float* gw8 = (float*)(F.ws + WS_GATEW);
                const unsigned s1 = __hip_atomic_fetch_add(F.ctl + CW_CNT + 64 * i1, 1u, RLX_AGENT);
                const unsigned s2i = __hip_atomic_fetch_add(F.ctl + CW_CNT + 64 * i2, 1u, RLX_AGENT);
                list[i1 * 16384 + s1] = (unsigned)m; gw8[i1 * 16384 + s1] = w1;
                list[i2 * 16384 + s2i] = (unsigned)m | 0x80000000u; gw8[i2 * 16384 + s2i] = w2;
            }
        }
    }
    __syncthreads();
}

__device__ __forceinline__ void fox_bias_table(Frame& F, int b, int h, LAS float* tab, LAS float* wtot) {
    const float* lf = (const float*)(F.ws + WS_LOGF) + (size_t)b * SEQ * 8 + h;
    float v[4];
#pragma unroll
    for (int j = 0; j < 4; ++j) v[j] = lf[(size_t)(4 * F.tid + j) * 8];
    const float s1 = v[0], s2 = s1 + v[1], s3 = s2 + v[2], s4 = s3 + v[3];
    float x = s4;
#pragma unroll
    for (int o = 1; o < 64; o <<= 1) { const float y = __shfl_up(x, o); if (F.lane >= o) x += y; }
    __syncthreads();
    if (F.lane == 63) wtot[F.wave] = x;
    LDS_WAIT(); __syncthreads();
    float base = 0.f;
#pragma unroll
    for (int w = 0; w < 8; ++w) if (w < F.wave) base += wtot[w];
    const float ex = base + x - s4;
    tab[4 * F.tid + 0] = -(ex + s1) * LOG2E; tab[4 * F.tid + 1] = -(ex + s2) * LOG2E; tab[4 * F.tid + 2] = -(ex + s3) * LOG2E; tab[4 * F.tid + 3] = -(ex + s4) * LOG2E;
    LDS_WAIT(); __syncthreads();
}

#if NAIVE_MIX
__device__ __forceinline__ void naive_fox_row(Frame& F, int b, int h, int t, const LAS float* tab) {
    const bf16* FQ = (const bf16*)(F.ws + WS_FQ); const bf16* FK = (const bf16*)(F.ws + WS_FK); const bf16* FV = (const bf16*)(F.ws + WS_FV); bf16* YB = (bf16*)(F.ws + WS_YB);
    const size_t rb = (size_t)b * SEQ;
    float q[64];
    { const v4u* qp = (const v4u*)(FQ + (rb + t) * 512 + h * 64);
#pragma unroll
      for (int c = 0; c < 8; ++c) { const v4u w = qp[c]; q[8 * c + 0] = bflo(w.x); q[8 * c + 1] = bfhi(w.x); q[8 * c + 2] = bflo(w.y); q[8 * c + 3] = bfhi(w.y); q[8 * c + 4] = bflo(w.z); q[8 * c + 5] = bfhi(w.z); q[8 * c + 6] = bflo(w.w); q[8 * c + 7] = bfhi(w.w); } }
    float mx = -INFINITY, l = 0.f, o = 0.f;
    for (int s0 = 0; s0 <= t; s0 += 64) {
        const int s = s0 + F.lane; float sc = -INFINITY;
        if (s <= t) { const v4u* kp = (const v4u*)(FK + (rb + s) * 512 + h * 64); float a = 0.f;
#pragma unroll
            for (int c = 0; c < 8; ++c) { const v4u w = kp[c]; a += q[8 * c + 0] * bflo(w.x) + q[8 * c + 1] * bfhi(w.x) + q[8 * c + 2] * bflo(w.y) + q[8 * c + 3] * bfhi(w.y) + q[8 * c + 4] * bflo(w.z) + q[8 * c + 5] * bfhi(w.z) + q[8 * c + 6] * bflo(w.w) + q[8 * c + 7] * bfhi(w.w); }
            sc = a + tab[s]; }
        float cm = sc;
#pragma unroll
        for (int of = 1; of < 64; of <<= 1) cm = fmaxf(cm, __shfl_xor(cm, of));
        const float nm = fmaxf(mx, cm), f = __builtin_amdgcn_exp2f(mx - nm); const float p = __builtin_amdgcn_exp2f(sc - nm);
        l = l * f + wave_sum(p); o *= f; mx = nm;
        const int ne = (t - s0 + 1) < 64 ? (t - s0 + 1) : 64;
        for (int j = 0; j < ne; ++j) { const float pj = __shfl(p, j); o += pj * bf2f(FV[(rb + s0 + j) * 512 + h * 64 + F.lane]); }
    }
    YB[(rb + t) * 1536 + 512 + h * 64 + F.lane] = (bf16)f2bf(o / l);
}
__device__ __forceinline__ void naive_ret_row(Frame& F, int b, int h, int t) {
    const bf16* RQ = (const bf16*)(F.ws + WS_RQ); const bf16* RK = (const bf16*)(F.ws + WS_RK); const bf16* RV = (const bf16*)(F.ws + WS_RV); const bf16* RG = (const bf16*)(F.ws + WS_RG); bf16* YB = (bf16*)(F.ws + WS_YB);
    const size_t rb = (size_t)b * SEQ;
    const float l2g = log2f(1.0f - exp2f(-5.0f - (float)h));
    float q[64];
    { const v4u* qp = (const v4u*)(RQ + (rb + t) * 256 + h * 64);
#pragma unroll
      for (int c = 0; c < 8; ++c) { const v4u w = qp[c]; q[8 * c + 0] = bflo(w.x); q[8 * c + 1] = bfhi(w.x); q[8 * c + 2] = bflo(w.y); q[8 * c + 3] = bfhi(w.y); q[8 * c + 4] = bflo(w.z); q[8 * c + 5] = bfhi(w.z); q[8 * c + 6] = bflo(w.w); q[8 * c + 7] = bfhi(w.w); } }
    float o0 = 0.f, o1 = 0.f;
    for (int s0 = 0; s0 <= t; s0 += 64) {
        const int s = s0 + F.lane; float sc = 0.f;
        if (s <= t) { const v4u* kp = (const v4u*)(RK + (rb + s) * 256 + h * 64); float a = 0.f;
#pragma unroll
            for (int c = 0; c < 8; ++c) { const v4u w = kp[c]; a += q[8 * c + 0] * bflo(w.x) + q[8 * c + 1] * bfhi(w.x) + q[8 * c + 2] * bflo(w.y) + q[8 * c + 3] * bfhi(w.y) + q[8 * c + 4] * bflo(w.z) + q[8 * c + 5] * bfhi(w.z) + q[8 * c + 6] * bflo(w.w) + q[8 * c + 7] * bfhi(w.w); }
            sc = a * exp2f(l2g * (float)(t - s)); }
        const int ne = (t - s0 + 1) < 64 ? (t - s0 + 1) : 64;
        for (int j = 0; j < ne; ++j) { const float pj = __shfl(sc, j); const bf16* vp = RV + (rb + s0 + j) * 512 + h * 128; o0 += pj * bf2f(vp[F.lane]); o1 += pj * bf2f(vp[F.lane + 64]); }
    }
    const float mean = wave_sum(o0 + o1) * (1.f / 128.f); const float d0 = o0 - mean, d1 = o1 - mean;
    const float rstd = 1.f / sqrtf(wave_sum(d0 * d0 + d1 * d1) * (1.f / 128.f) + GN_EPS);
    const bf16* gp = RG + (rb + t) * 512 + h * 128; bf16* yp = YB + (rb + t) * 1536 + h * 128;
    yp[F.lane] = (bf16)f2bf(bf2f(gp[F.lane]) * d0 * rstd); yp[F.lane + 64] = (bf16)f2bf(bf2f(gp[F.lane + 64]) * d1 * rstd);
}
__device__ __forceinline__ void naive_gmlp_unit(Frame& F, int b, int n, int g, const float* w_s, const float* b_s, const float* lng, const float* lnb) {
    const bf16* GU = (const bf16*)(F.ws + WS_GU); const bf16* GV = (const bf16*)(F.ws + WS_GV); bf16* YB = (bf16*)(F.ws + WS_YB);
    LAS float* st = (LAS float*)(F.lds + RING_OFF);
    const size_t r0 = (size_t)b * SEQ + n * 128;
    __syncthreads();
    for (int r = F.wave; r < 128; r += NWAVES) {
        const v4u w = *((const v4u*)(GV + (r0 + r) * 512) + F.lane);
        float x[8] = {bflo(w.x), bfhi(w.x), bflo(w.y), bfhi(w.y), bflo(w.z), bfhi(w.z), bflo(w.w), bfhi(w.w)};
        float s = 0.f;
#pragma unroll
        for (int j = 0; j < 8; ++j) s += x[j];
        const float mean = wave_sum(s) * (1.f / 512.f); float s2 = 0.f;
#pragma unroll
        for (int j = 0; j < 8; ++j) { const float d = x[j] - mean; s2 += d * d; }
        const float rstd = 1.f / sqrtf(wave_sum(s2) * (1.f / 512.f) + LN_EPS);
        if (F.lane == 0) { st[2 * r] = mean; st[2 * r + 1] = rstd; }
    }
    LDS_WAIT(); __syncthreads();
    const int c = F.tid & 127; const float gam = lng[g * 128 + c], bet = lnb[g * 128 + c];
    for (int i = F.tid >> 7; i < 128; i += 4) {
        float a = 0.f; const float* wr = w_s + ((size_t)g * 128 + i) * 128;
        for (int j = 0; j <= i; ++j) { const float vn = (bf2f(GV[(r0 + j) * 512 + g * 128 + c]) - st[2 * j]) * st[2 * j + 1] * gam + bet; a += wr[j] * vn; }
        const float sp = a + b_s[g * 128 + i];
        YB[(r0 + i) * 1536 + 1024 + g * 128 + c] = (bf16)f2bf(bf2f(GU[(r0 + i) * 512 + g * 128 + c]) * sp);
    }
    __syncthreads();
}
#endif

struct Args { const float* in[17]; float* out; unsigned char* ws; int ph_lo, ph_hi; };
constexpr int N_PHASES = 17;

__global__ void __launch_bounds__(NWAVES * 64, 2) mega_fwd(Args args) {
    extern __shared__ __attribute__((aligned(16))) unsigned char lds[];
    Frame F;
    F.lds = (LAS unsigned char*)lds;
    F.MISC = (volatile LAS unsigned*)(F.lds + MISC_OFF);
    F.tid = threadIdx.x; F.lane = F.tid & 63; F.wave = __builtin_amdgcn_readfirstlane(F.tid >> 6);
    F.G = gridDim.x; { const int bx = blockIdx.x; F.vcu = (F.G % 8 == 0) ? (bx % 8) * (F.G / 8) + bx / 8 : bx; }
    F.ws = args.ws; F.ctl = (gu32*)(args.ws + WS_CTL);
    unsigned char* ws = args.ws;
    for (int u = F.tid; u < (LDS_BYTES - LDSCTL_OFF) / 4; u += NWAVES * 64) ((LAS unsigned*)(F.lds + LDSCTL_OFF))[u] = 0u;
    __syncthreads();
    XcdBarrier bar; bar.bar = (unsigned*)(F.ctl + CW_BAR); bar.x = 0; bar.st = nullptr;
#if MK_N_LAUNCHES == 1
    bar = xcd_barrier_post((unsigned*)(F.ctl + CW_BAR), F.MISC + 8);
#define GRID_BAR() xcd_barrier(bar)
#else
#define GRID_BAR() do { } while (0)
#endif
    const int lo = args.ph_lo, hi = args.ph_hi;
#ifndef PH_MASK
#define PH_MASK 0x1ff
#endif
#define IN(k) (lo <= (k) && (k) < hi)
#define PHASE_BEGIN() do { int t_ = threadIdx.x; asm volatile("" : "+v"(t_)); F.tid = t_; F.lane = t_ & 63; F.wave = __builtin_amdgcn_readfirstlane(t_ >> 6); } while (0)
#define ON(j) (((PH_MASK) >> (j)) & 1)
#define SEAM(k) do { if (IN(k) && IN((k) + 1)) GRID_BAR(); } while (0)

    const float* x_in = args.in[0]; const float* w_in = args.in[1]; const float* fox_b = args.in[2]; const float* gate_b = args.in[3];
    const float* gm_w_s = args.in[4]; const float* gm_b_s = args.in[5]; const float* gm_ln_g = args.in[6]; const float* gm_ln_b = args.in[7];
    const float* w_branch = args.in[8]; const float* w_out = args.in[9]; const float* ln_g = args.in[10]; const float* ln_b = args.in[11];
    const float* dense_up = args.in[12]; const float* dense_down = args.in[13]; const float* moe_router = args.in[14]; const float* moe_up = args.in[15]; const float* moe_down = args.in[16];
    bf16* XB = (bf16*)(ws + WS_XB); float* XF = (float*)(ws + WS_XF); float* YPRE = (float*)(ws + WS_YPRE); float* C1B = (float*)(ws + WS_C1); bf16* MRG = (bf16*)(ws + WS_MRG);
    bf16* YB = (bf16*)(ws + WS_YB); bf16* HID = (bf16*)(ws + WS_HID);
    const float* CS = (const float*)(ws + WS_CS);

    if (ON(0) && IN(0)) { PHASE_BEGIN();
        LAS float* scr = (LAS float*)(F.lds + RING_OFF + F.wave * 16640);
        const int gw = F.vcu * NWAVES + F.wave, NGW = F.G * NWAVES;
        constexpr int I_IN = 16 * 112, I_BR = 8 * 16, I_OUT = 16 * 16, I_DU = 16 * 88, I_DD = 44 * 16, I_MU = 16 * 112, I_MD = 56 * 16;
        constexpr int NITEMS = 2 * I_IN + 6 * I_BR + 2 * I_OUT + I_DU + I_DD + 8 * I_MU + 8 * I_MD;
        for (int it = gw; it < NITEMS; it += NGW) {
            int r = it; bool done = false;
#pragma unroll 1
            for (int e = 0; e < 8 && !done; ++e) { CvtJob j{moe_up + (size_t)e * 1024 * 7168, 1024, 7168, 7168, (bf16*)(ws + WS_WMU) + (size_t)e * 7168 * 1024, 1024, 0, 2, DFF_E}; done = cvt_run(j, r, scr, F.lane); }
#pragma unroll 1
            for (int e = 0; e < 8 && !done; ++e) { CvtJob j{moe_down + (size_t)e * 3584 * 1024, 3584, 1024, 1024, (bf16*)(ws + WS_WMD) + (size_t)e * 1024 * 3584, 3584, 0, 0, 0}; done = cvt_run(j, r, scr, F.lane); }
#pragma unroll 1
            for (int l = 0; l < 2 && !done; ++l) { CvtJob j{w_in + (size_t)l * 1024 * N_INSRC, 1024, N_INSRC, N_INV, (bf16*)(ws + WS_WIN) + (size_t)l * N_INV * 1024, 1024, 0, 1, 0}; done = cvt_run(j, r, scr, F.lane); }
#pragma unroll 1
            for (int q = 0; q < 6 && !done; ++q) { const int l = q / 3, n = q % 3; CvtJob j{w_branch + (size_t)q * 512 * 1024, 512, 1024, 1024, (bf16*)(ws + WS_WBR) + (size_t)l * 1024 * 1536, 1536, n * 512, 0, 0}; done = cvt_run(j, r, scr, F.lane); }
#pragma unroll 1
            for (int l = 0; l < 2 && !done; ++l) { CvtJob j{w_out + (size_t)l * 1024 * 1024, 1024, 1024, 1024, (bf16*)(ws + WS_WOUT) + (size_t)l * 1024 * 1024, 1024, 0, 0, 0}; done = cvt_run(j, r, scr, F.lane); }
            if (!done) { CvtJob j{dense_up, 1024, 2 * DFF_D, 2 * DFF_D, (bf16*)(ws + WS_WDU), 1024, 0, 2, DFF_D}; done = cvt_run(j, r, scr, F.lane); }
            if (!done) { CvtJob j{dense_down, DFF_D, 1024, 1024, (bf16*)(ws + WS_WDD), DFF_D, 0, 0, 0}; done = cvt_run(j, r, scr, F.lane); }
        }
        __syncthreads();
        { float* cs = (float*)(ws + WS_CS);
          for (int i = F.vcu * 512 + F.tid; i < SEQ * 32; i += F.G * 512) { const int pos = i >> 5, d = i & 31;
              const double rev = (double)pos * exp(-(double)d / 32.0 * 9.210340371976184) * 0.15915494309189535; const float fr_ = (float)(rev - floor(rev));
              cs[i] = __builtin_amdgcn_cosf(fr_); cs[65536 + i] = __builtin_amdgcn_sinf(fr_); } }
        p0_rows(F, x_in, w_in, fox_b);
    }
    SEAM(0);

#pragma unroll 1
    for (int l = 0; l < 2; ++l) {
        const int pb = 1 + 8 * l;
        const float* xres = (l == 0) ? x_in : XF;
        if (ON(1) && IN(pb + 0)) { PHASE_BEGIN();
            pg8::PlainSched S; S.init(M / 256, N_INV / 256, F.G, (int)blockIdx.x); S.A = XB; S.Bt = (const bf16*)(ws + WS_WIN) + (size_t)l * N_INV * 1024; S.K = 1024;
            EpiProj E{ws, gate_b + l * 3072, CS};
            pg8::gemm_phase<EpiProj, pg8::PlainSched>(F.lds + RING_OFF, 1024, S, E);
        }
        SEAM(pb + 0);
        if (ON(2) && IN(pb + 1)) { PHASE_BEGIN();
#if NAIVE_MIX
            LAS float* tab = (LAS float*)(F.lds + RING_OFF + 4096); LAS float* wtot = (LAS float*)(F.lds + RING_OFF + 4096 + 8192);
            for (int uu = F.vcu; uu < 64 * 8; uu += F.G) {
                const int bh = uu >> 3, qb = uu & 7, b = bh >> 3, h = bh & 7;
                fox_bias_table(F, b, h, tab, wtot);
                for (int r = F.wave; r < 256; r += NWAVES) naive_fox_row(F, b, h, qb * 256 + r, tab);
                __syncthreads();
            }
            { const int gw = F.vcu * NWAVES + F.wave, NGW = F.G * NWAVES;
              for (int idx = gw; idx < BATCH * 4 * SEQ; idx += NGW) { const int t = idx & (SEQ - 1), bh = idx >> 11; naive_ret_row(F, bh >> 2, bh & 3, t); } }
            for (int uu = F.vcu; uu < BATCH * 16 * 4; uu += F.G) { const int g = uu & 3, n = (uu >> 2) & 15, b = uu >> 6;
                naive_gmlp_unit(F, b, n, g, gm_w_s + (size_t)l * 4 * 128 * 128, gm_b_s + l * 512, gm_ln_g + l * 512, gm_ln_b + l * 512); }
#endif
        }
        SEAM(pb + 1);
        if (ON(3) && IN(pb + 2)) { PHASE_BEGIN();
            pg8::PlainSched S; S.init(M / 256, 4, F.G, (int)blockIdx.x); S.A = YB; S.Bt = (const bf16*)(ws + WS_WBR) + (size_t)l * 1024 * 1536; S.K = 1536;
            EpiMerge E{(const bf16*)(ws + WS_GT), MRG};
            pg8::gemm_phase<EpiMerge, pg8::PlainSched>(F.lds + RING_OFF, 1536, S, E);
        }
        SEAM(pb + 2);
        if (ON(4) && IN(pb + 3)) { PHASE_BEGIN();
            pg8::PlainSched S; S.init(M / 256, 4, F.G, (int)blockIdx.x); S.A = MRG; S.Bt = (const bf16*)(ws + WS_WOUT) + (size_t)l * 1024 * 1024; S.K = 1024;
            EpiResid E{xres, YPRE};
            pg8::gemm_phase<EpiResid, pg8::PlainSched>(F.lds + RING_OFF, 1024, S, E);
        }
        SEAM(pb + 3);
        if (ON(5) && IN(pb + 4)) { PHASE_BEGIN();
            if (l == 0) ln_pass<0>(F, YPRE, nullptr, nullptr, 0.f, ln_g + (l * 2 + 0) * 1024, ln_b + (l * 2 + 0) * 1024, XF, XB, nullptr, 0, 0, nullptr);
            else ln_pass<2>(F, YPRE, nullptr, nullptr, 0.f, ln_g + (l * 2 + 0) * 1024, ln_b + (l * 2 + 0) * 1024, XF, XB, moe_router, 8, 0, nullptr);
        }
        SEAM(pb + 4);
        if (ON(6) && IN(pb + 5)) { PHASE_BEGIN();
            if (l == 0) {
                pg8::PlainSched S; S.init(M / 256, 2 * DFF_D / 256, F.G, (int)blockIdx.x); S.A = XB; S.Bt = (const bf16*)(ws + WS_WDU); S.K = 1024;
                EpiSwiglu E{HID, DFF_D};
                pg8::gemm_phase<EpiSwiglu, pg8::PlainSched>(F.lds + RING_OFF, 1024, S, E);
            } else {
                MoeTiles mt; mt.init(F.ctl);
                MoeUpSched S; S.init(mt.toff[NEXP], 2 * DFF_E / 256, F.G, (int)blockIdx.x); S.A = XB; S.Bt = (const bf16*)(ws + WS_WMU); S.list = (const unsigned*)(ws + WS_LIST); S.mt = mt;
                EpiSwiglu E{HID, DFF_E};
                pg8::gemm_phase<EpiSwiglu, MoeUpSched>(F.lds + RING_OFF, 1024, S, E);
            }
        }
        SEAM(pb + 5);
        if (ON(7) && IN(pb + 6)) { PHASE_BEGIN();
            if (l == 0) {
                pg8::PlainSched S; S.init(M / 256, 4, F.G, (int)blockIdx.x); S.A = HID; S.Bt = (const bf16*)(ws + WS_WDD); S.K = DFF_D;
                EpiResid E{XF, YPRE};
                pg8::gemm_phase<EpiResid, pg8::PlainSched>(F.lds + RING_OFF, DFF_D, S, E);
            } else {
                MoeTiles mt; mt.init(F.ctl);
                MoeDownSched S; S.init(mt.toff[NEXP], 4, F.G, (int)blockIdx.x); S.A = HID; S.Bt = (const bf16*)(ws + WS_WMD); S.mt = mt;
                EpiMoeDown E{YPRE, C1B, (const unsigned*)(ws + WS_LIST), (const float*)(ws + WS_GATEW), mt};
                pg8::gemm_phase<EpiMoeDown, MoeDownSched>(F.lds + RING_OFF, DFF_E, S, E);
            }
        }
        SEAM(pb + 6);
        if (ON(8) && IN(pb + 7)) { PHASE_BEGIN();
            if (l == 0) ln_pass<1>(F, YPRE, nullptr, nullptr, 0.f, ln_g + (l * 2 + 1) * 1024, ln_b + (l * 2 + 1) * 1024, XF, XB, w_in + (size_t)1 * 1024 * N_INSRC, N_INSRC, FL_COL, fox_b + 8);
            else ln_pass<0>(F, YPRE, XF, C1B, ALPHA, ln_g + (l * 2 + 1) * 1024, ln_b + (l * 2 + 1) * 1024, args.out, nullptr, nullptr, 0, 0, nullptr);
        }
        if (l == 0) SEAM(pb + 7);
    }
#undef IN
#undef SEAM
}

extern "C" void kernel_launch(void* const* d_in, const int* in_sizes, int n_in, void* d_out, int out_size, void* d_ws, size_t ws_size, hipStream_t stream) {
    static int grid = 0;
    if (grid == 0) {
        if (n_in != 17 || in_sizes[0] != M * D || out_size != M * D || ws_size < WS_END) { fprintf(stderr, "kernel_launch: unexpected shapes / workspace (%zu)\n", ws_size); grid = -1; return; }
        int dev = 0, cus = 0, per_cu = 0;
        if (hipGetDevice(&dev) != hipSuccess || hipDeviceGetAttribute(&cus, hipDeviceAttributeMultiprocessorCount, dev) != hipSuccess) { grid = -1; return; }
        if (hipFuncSetAttribute((const void*)mega_fwd, hipFuncAttributeMaxDynamicSharedMemorySize, LDS_BYTES) != hipSuccess) { grid = -1; return; }
        if (hipOccupancyMaxActiveBlocksPerMultiprocessor(&per_cu, (const void*)mega_fwd, NWAVES * 64, LDS_BYTES) != hipSuccess || per_cu < 1) { fprintf(stderr, "kernel_launch: occupancy query says %d\n", per_cu); }
        (void)hipGetLastError();
        grid = cus;
    }
    if (grid < 0) return;
    if (hipMemsetAsync((char*)d_ws + WS_CTL, 0, CTL_ZERO_BYTES, stream) != hipSuccess) return;
    Args a{};
    for (int i = 0; i < 17; ++i) a.in[i] = (const float*)d_in[i];
    a.out = (float*)d_out; a.ws = (unsigned char*)d_ws;
#if MK_N_LAUNCHES == 1
    a.ph_lo = 0; a.ph_hi = N_PHASES;
    hipLaunchKernelGGL(mega_fwd, dim3(grid), dim3(NWAVES * 64), LDS_BYTES, stream, a);
#else
    for (int p = 0; p < N_PHASES; ++p) { a.ph_lo = p; a.ph_hi = p + 1; hipLaunchKernelGGL(mega_fwd, dim3(grid), dim3(NWAVES * 64), LDS_BYTES, stream, a); }
#endif
}
```

```cpp
#include <hip/hip_runtime.h>
#include <cstdio>
#include <cstdint>
#include <hip/hip_bf16.h>
#include <cmath>

#ifndef MK_N_LAUNCHES
#define MK_N_LAUNCHES 1
#endif
#ifndef DENSE_FP8
#define DENSE_FP8 0
#endif
#ifndef GATES_FP8
#define GATES_FP8 2
#endif
#ifndef NAIVE_FOX
#define NAIVE_FOX 0
#endif
#ifndef NAIVE_RET
#define NAIVE_RET 0
#endif
#ifndef NAIVE_GMLP
#define NAIVE_GMLP 0
#endif

namespace pg8 {
#define PG8_LAS __attribute__((address_space(3)))
typedef unsigned short bf16_t;
typedef short bf16x8 __attribute__((ext_vector_type(8)));
typedef float f32x4 __attribute__((ext_vector_type(4)));
typedef float f32x2 __attribute__((ext_vector_type(2)));
typedef unsigned u32x4 __attribute__((ext_vector_type(4)));
typedef unsigned u32x2 __attribute__((ext_vector_type(2)));
constexpr int BM = 256, BK = 64, HALF = 128, HTB = HALF * BK * 2  , STAGE_BYTES = 8 * HTB, NXCD = 8, WGM = 4;

__host__ __device__ __forceinline__ int lds_byte(int r, int c) { const int st = (r >> 4) * 2 + (c >> 5), rr = r & 15, cc = c & 31, ob = rr * 64 + cc * 2; return st * 1024 + (ob ^ (((ob >> 9) & 1) << 5)); }
__host__ __device__ __forceinline__ void stage_rc(int b, int& R, int& C) { const int st = b / 1024, sb = b % 1024, swz = sb ^ (((sb >> 9) & 1) << 5); R = (st >> 1) * 16 + swz / 64; C = (st & 1) * 32 + (swz % 64) / 2; }
__host__ __device__ __forceinline__ int perm32(int rho) { const int n = rho >> 4, i = rho & 15; return 8 * (i >> 2) + 4 * n + (i & 3); }

struct Unit { int pm, pn; };

struct TileOrder {
    int nM, nN, nwg, G, c;
    __device__ __forceinline__ void init(int nM_, int nN_, int G_, int c_) { nM = nM_; nN = nN_; nwg = nM * nN; G = G_; c = c_; }
    __device__ __forceinline__ bool next(int i, Unit& u) const {
        const long L = (long)i * G + c; if (L >= nwg) return false;
        int wgid = (int)L; { const int q = nwg / NXCD, r = nwg % NXCD, xcd = wgid % NXCD, off = wgid / NXCD; wgid = (xcd < r ? xcd * (q + 1) : r * (q + 1) + (xcd - r) * q) + off; }
        const int nig = WGM * nN, gid = wgid / nig, fm = gid * WGM, gsz = (nM - fm) < WGM ? (nM - fm) : WGM;
        u.pm = fm + ((wgid % nig) % gsz); u.pn = (wgid % nig) / gsz; return true;
    }
};
struct PlainSched : TileOrder {
    static constexpr bool GATHER = false;
    const bf16_t* A; const bf16_t* Bt; int K; int esz = 2;
    __device__ __forceinline__ const char* abase(const Unit& u) const { return (const char*)A + (size_t)u.pm * BM * K * esz; }
    __device__ __forceinline__ void aoffs_load(const Unit&, const int (&)[2], PG8_LAS unsigned*) const {}
    __device__ __forceinline__ void aoffs_fin(const Unit&, const int (&)[2], const int (&)[2], const PG8_LAS unsigned*, int, unsigned (&)[2][2]) const {}
    __device__ __forceinline__ void aoffs(const Unit&, const int (&R)[2], const int (&C)[2], unsigned (&o)[2][2]) const {
#pragma unroll
        for (int h = 0; h < 2; ++h)
#pragma unroll
            for (int i = 0; i < 2; ++i) o[h][i] = (unsigned)((R[i] + h * HALF) * K + C[i]) * 2u; }
    __device__ __forceinline__ const char* bbase(const Unit& u) const { return (const char*)Bt + (size_t)u.pn * BM * K * esz; }
};

typedef __bf16 bf16x2_v __attribute__((ext_vector_type(2)));
__device__ __forceinline__ unsigned cvt_pk_bf16(float lo, float hi) { f32x2 v = {lo, hi}; bf16x2_v b = __builtin_convertvector(v, bf16x2_v); return __builtin_bit_cast(unsigned, b); }

typedef float f32x2_pk __attribute__((ext_vector_type(2)));
__device__ __forceinline__ f32x4 zero4() { f32x2_pk lo, hi; asm volatile("v_pk_mov_b32 %0, 0, 0" : "=v"(lo)); asm volatile("v_pk_mov_b32 %0, 0, 0" : "=v"(hi)); return __builtin_shufflevector(lo, hi, 0, 1, 2, 3); }
typedef int v4i_t __attribute__((ext_vector_type(4)));
typedef int v8i_t __attribute__((ext_vector_type(8)));
__host__ __device__ __forceinline__ int lds_byte8(int r, int g) { const int st = (r >> 4) * 2 + (g >> 1), ob = (r & 15) * 64 + 32 * (g & 1); return st * 1024 + (ob ^ (((ob >> 9) & 1) << 5)); }
template <class Epi, class Sched, unsigned FP8S = 0u>
__device__ __forceinline__ void gemm_phase(PG8_LAS unsigned char* lds, const int K, const Sched& S, const Epi& E) {
    constexpr bool F8 = FP8S != 0u;
    int tid_ = threadIdx.x; asm volatile("" : "+v"(tid_));
    const int tid = tid_, wid = __builtin_amdgcn_readfirstlane(tid >> 6), lane = tid & 63, wr = wid >> 2, wc = wid & 3, fr = lane & 15, fq = lane >> 4;
    const int nt = F8 ? K / 128 : K / BK;
    int Rs[2], Cs[2]; unsigned voffA[2], voffB[2];
#pragma unroll
    for (int i = 0; i < 2; ++i) { int R, C; stage_rc(tid * 16 + i * 8192, R, C); Rs[i] = R; Cs[i] = C; const int Rb = Epi::PERM ? ((R & ~31) + perm32(R & 31)) : R;
        voffA[i] = F8 ? (unsigned)(R * K + 2 * C) : (unsigned)(R * K + C) * 2u; voffB[i] = F8 ? (unsigned)(Rb * K + 2 * C) : (unsigned)(Rb * K + C) * 2u; }
    const size_t kstep = (size_t)(BK * 2);
    const size_t hstep = (size_t)HALF * K * (F8 ? 1 : 2);
    const unsigned ldsw = (unsigned)wid * 1024u;
    const int aoff = F8 ? lds_byte8(wr * 64 + fr, fq) : lds_byte(wr * 64 + fr, fq * 8), boff = F8 ? lds_byte8(wc * 32 + fr, fq) : lds_byte(wc * 32 + fr, fq * 8);
#define PG8_SA(b, h) (((b) * 2 + (h)) * HTB)
#define PG8_SB(b, h) ((4 + (b) * 2 + (h)) * HTB)
#define PG8_STAGE(bufoff, gbase, voff) do { _Pragma("unroll") for (int _i = 0; _i < 2; ++_i) \
        __builtin_amdgcn_global_load_lds((const unsigned*)((const char*)(gbase) + (voff)[_i]), (PG8_LAS unsigned*)(lds + (bufoff) + ldsw + _i * 8192), 16, 0, 0); } while (0)
#define PG8_STA(bufoff, gbase, h, nx) do { if constexpr (Sched::GATHER) { _Pragma("unroll") for (int _i = 0; _i < 2; ++_i) { const unsigned o_ = (nx) ? nof[h][_i] : cof[h][_i]; \
        __builtin_amdgcn_global_load_lds((const unsigned*)((const char*)(gbase) + o_), (PG8_LAS unsigned*)(lds + (bufoff) + ldsw + _i * 8192), 16, 0, 0); } } \
        else { PG8_STAGE(bufoff, (gbase) + (h) * hstep, voffA); } } while (0)
#define PG8_LDA(dst, b, h) do { _Pragma("unroll") for (int m = 0; m < 4; ++m) _Pragma("unroll") for (int k = 0; k < 2; ++k) dst[m][k] = *(const PG8_LAS bf16x8*)(lds + PG8_SA(b, h) + aoff + m * 2048 + k * 1024); } while (0)
#define PG8_LDB(dst, b, h) do { _Pragma("unroll") for (int n = 0; n < 2; ++n) _Pragma("unroll") for (int k = 0; k < 2; ++k) dst[n][k] = *(const PG8_LAS bf16x8*)(lds + PG8_SB(b, h) + boff + n * 2048 + k * 1024); } while (0)
#define PG8_MMA(ai, bj, At, Bt) do { __builtin_amdgcn_s_setprio(1); _Pragma("unroll") for (int m = 0; m < 4; ++m) _Pragma("unroll") for (int n = 0; n < 2; ++n) _Pragma("unroll") for (int k = 0; k < 2; ++k) \
        acc[ai][bj][m][n] = __builtin_amdgcn_mfma_f32_16x16x32_bf16(Bt[n][k], At[m][k], acc[ai][bj][m][n], 0, 0, 0); __builtin_amdgcn_s_setprio(0); } while (0)
#define PG8_LD32(p) __builtin_shufflevector(*(const PG8_LAS v4i_t*)(p), *(const PG8_LAS v4i_t*)((p) + 16), 0, 1, 2, 3, 4, 5, 6, 7)
#define PG8_LDA8(dst, b, h) do { _Pragma("unroll") for (int m = 0; m < 4; ++m) dst[m] = PG8_LD32(lds + PG8_SA(b, h) + aoff + m * 2048); } while (0)
#define PG8_LDB8(dst, b, h) do { _Pragma("unroll") for (int n = 0; n < 2; ++n) dst[n] = PG8_LD32(lds + PG8_SB(b, h) + boff + n * 2048); } while (0)
#define PG8_MMA8(ai, bj, At, Bt) do { __builtin_amdgcn_s_setprio(1); _Pragma("unroll") for (int m = 0; m < 4; ++m) _Pragma("unroll") for (int n = 0; n < 2; ++n) \
        asm volatile("v_mfma_scale_f32_16x16x128_f8f6f4 %0, %1, %2, %0, %3, %4 op_sel_hi:[0,0,0]" : "+v"(acc[ai][bj][m][n]) : "v"(Bt[n]), "v"(At[m]), "v"(scl_w), "v"(scl_1)); __builtin_amdgcn_s_setprio(0); } while (0)
#define PG8_XLDA(b, h) do { if constexpr (F8) PG8_LDA8(At8, b, h); else PG8_LDA(At, b, h); } while (0)
#define PG8_XLDB0(b, h) do { if constexpr (F8) PG8_LDB8(B08, b, h); else PG8_LDB(B0, b, h); } while (0)
#define PG8_XLDB1(b, h) do { if constexpr (F8) PG8_LDB8(B18, b, h); else PG8_LDB(B1, b, h); } while (0)
#define PG8_XMMA0(ai, bj) do { if constexpr (F8) PG8_MMA8(ai, bj, At8, B08); else PG8_MMA(ai, bj, At, B0); } while (0)
#define PG8_XMMA1(ai, bj) do { if constexpr (F8) PG8_MMA8(ai, bj, At8, B18); else PG8_MMA(ai, bj, At, B1); } while (0)
#define PG8_WAIT_V(n) asm volatile("s_waitcnt vmcnt(" #n ")" ::: "memory")
#define PG8_WAIT_L(n) asm volatile("s_waitcnt lgkmcnt(" #n ")" ::: "memory")
#define PG8_BAR __builtin_amdgcn_s_barrier()
#define PG8_SCHED __builtin_amdgcn_sched_barrier(0)
    Unit cur, nxt; int ui = 0;
    if (!S.next(0, cur)) return;
    f32x4 acc[2][2][4][2];
#pragma unroll
    for (int a = 0; a < 2; ++a)
#pragma unroll
        for (int b = 0; b < 2; ++b)
#pragma unroll
            for (int m = 0; m < 4; ++m)
#pragma unroll
                for (int n = 0; n < 2; ++n) acc[a][b][m][n] = zero4();
    bf16x8 At[4][2], B0[2][2], B1[2][2]; v8i_t At8[4], B08[2], B18[2];
    int scl_w = (int)FP8S, scl_1 = 0x7f7f7f7f; if constexpr (F8) asm volatile("" : "+v"(scl_w), "+v"(scl_1));
    unsigned cof[2][2], nof[2][2];
    PG8_LAS unsigned* gscr = (PG8_LAS unsigned*)(lds + 8 * HTB + wid * 1024);
    const char* cA = S.abase(cur); if constexpr (Sched::GATHER) { S.aoffs_load(cur, Rs, gscr); asm volatile("s_waitcnt vmcnt(0)" ::: "memory"); S.aoffs_fin(cur, Rs, Cs, gscr, lane, cof); } const char* cB = S.bbase(cur);
    PG8_STAGE(PG8_SB(0, 0), cB, voffB); PG8_STAGE(PG8_SB(0, 1), cB + hstep, voffB); PG8_STA(PG8_SA(0, 0), cA, 0, false); PG8_STA(PG8_SA(0, 1), cA, 1, false);
    if (wr == 1) PG8_BAR;
    PG8_WAIT_V(2); PG8_BAR;
    PG8_STAGE(PG8_SB(1, 0), cB + kstep, voffB); PG8_STA(PG8_SA(1, 0), cA + kstep, 0, false); PG8_STAGE(PG8_SB(1, 1), cB + hstep + kstep, voffB);
    PG8_WAIT_V(6); PG8_BAR;
    for (;;) {
        const bool has_next = S.next(ui + 1, nxt);
        const char* nA = cA; const char* nB = cB;
        if constexpr (Sched::GATHER) {
#pragma unroll
            for (int h = 0; h < 2; ++h)
#pragma unroll
                for (int i = 0; i < 2; ++i) nof[h][i] = cof[h][i]; }
        if (has_next) { nA = S.abase(nxt); if constexpr (Sched::GATHER) S.aoffs_load(nxt, Rs, gscr); nB = S.bbase(nxt); }
#pragma unroll 1
        for (int t = 0; t < nt; t += 2) {
            const bool last = (t == nt - 2);
            const bool skipw = (t == 0) && (ui > 0) && !Sched::GATHER;
            if constexpr (Sched::GATHER) { if (last && has_next) S.aoffs_fin(nxt, Rs, Cs, gscr, lane, nof); }
            if constexpr (Epi::HOOK) { PG8_SCHED; E.khook(acc, cur, t, wr, wc, fr, fq); PG8_SCHED; }
            const char* a1 = cA + (size_t)(t + 1) * kstep;
            const char* a2 = last ? nA : cA + (size_t)(t + 2) * kstep; const char* b2 = last ? nB : cB + (size_t)(t + 2) * kstep;
            const char* a3 = a2 + kstep; const char* b3 = b2 + kstep;
            PG8_XLDB0(0, 0); PG8_XLDB1(0, 1); PG8_SCHED; PG8_XLDA(0, 0); PG8_STA(PG8_SA(1, 1), a1, 1, false);
            if (!skipw) PG8_WAIT_V(8);
            PG8_WAIT_L(0); PG8_BAR; PG8_XMMA0(0, 0); PG8_XMMA1(0, 1); PG8_BAR; PG8_SCHED;
            PG8_XLDA(0, 1); PG8_STAGE(PG8_SB(0, 0), b2, voffB); PG8_STAGE(PG8_SB(0, 1), b2 + hstep, voffB); PG8_STA(PG8_SA(0, 0), a2, 0, last);
            if (!skipw) PG8_WAIT_V(8);
            PG8_WAIT_L(0); PG8_BAR; PG8_XMMA0(1, 0); PG8_XMMA1(1, 1); PG8_BAR; PG8_SCHED;
            PG8_XLDB0(1, 0); PG8_XLDB1(1, 1); PG8_SCHED; PG8_XLDA(1, 0); PG8_STA(PG8_SA(0, 1), a2, 1, last);
            PG8_WAIT_V(8); PG8_WAIT_L(0); PG8_BAR; PG8_XMMA0(0, 0); PG8_XMMA1(0, 1); PG8_BAR; PG8_SCHED;
            PG8_XLDA(1, 1); PG8_STAGE(PG8_SB(1, 0), b3, voffB); PG8_STAGE(PG8_SB(1, 1), b3 + hstep, voffB); PG8_STA(PG8_SA(1, 0), a3, 0, last);
            PG8_WAIT_V(8); PG8_WAIT_L(0); PG8_BAR; PG8_XMMA0(1, 0); PG8_XMMA1(1, 1); PG8_BAR; PG8_SCHED;
        }
        if constexpr (!Sched::GATHER) PG8_WAIT_V(0);
        if constexpr (F8) {
            asm volatile("s_nop 15\n\ts_nop 15\n\ts_nop 15\n\ts_nop 15\n\ts_nop 15" ::: "memory");
#pragma unroll
            for (int a = 0; a < 2; ++a)
#pragma unroll
                for (int b = 0; b < 2; ++b)
#pragma unroll
                    for (int m = 0; m < 4; ++m) asm volatile("" : "+v"(acc[a][b][m][0]), "+v"(acc[a][b][m][1]));
        }
        if (wr == 0) PG8_BAR;
        E(acc, cur, wr, wc, fr, fq);
#ifdef EPI_DUP
        if (Epi::DUPME) { asm volatile("" ::: "memory"); E(acc, cur, wr, wc, fr, fq); }
#endif
        if (!has_next) break;
#pragma unroll
        for (int a = 0; a < 2; ++a)
#pragma unroll
            for (int b = 0; b < 2; ++b)
#pragma unroll
                for (int m = 0; m < 4; ++m)
#pragma unroll
                    for (int n = 0; n < 2; ++n) acc[a][b][m][n] = zero4();
        cur = nxt; cA = nA; cB = nB; ++ui;
        if constexpr (Sched::GATHER) {
#pragma unroll
            for (int h = 0; h < 2; ++h)
#pragma unroll
                for (int i = 0; i < 2; ++i) cof[h][i] = nof[h][i]; }
        if (wr == 1) PG8_BAR;
    }
    PG8_WAIT_V(0);
    PG8_BAR;
#undef PG8_SA
#undef PG8_SB
#undef PG8_STAGE
#undef PG8_STA
#undef PG8_LDA
#undef PG8_LDB
#undef PG8_MMA
#undef PG8_LD32
#undef PG8_LDA8
#undef PG8_LDB8
#undef PG8_MMA8
#undef PG8_XLDA
#undef PG8_XLDB0
#undef PG8_XLDB1
#undef PG8_XMMA0
#undef PG8_XMMA1
#undef PG8_WAIT_V
#undef PG8_WAIT_L
#undef PG8_BAR
#undef PG8_SCHED
}
}

namespace attn_body {
using bf16=__hip_bfloat16;
using bf16x8=__attribute__((ext_vector_type(8)))short;
using s16x4=__attribute__((ext_vector_type(4)))short;
using f32x16=__attribute__((ext_vector_type(16)))float;
using u32x4=__attribute__((ext_vector_type(4)))unsigned;
constexpr int BATCH=8,NHEAD=8,SEQ=2048,D=64,DM=NHEAD*D,PO=1536,OCOL=512;
constexpr int NW=8,QBLK=32,QB=QBLK*NW,KVBLK=64,NQB=SEQ/QB;
constexpr int ATTN_PITCH=DM, ATTN_UNIT_ROWS=QB;
__device__ __forceinline__ int crow(int r,int hi){return (r&3)+8*(r>>2)+4*hi;}
#define SBAR() __builtin_amdgcn_sched_barrier(0)
__device__ __forceinline__ void cmask(f32x16&p0,f32x16&p1,int jb,int qrel,int hi){
  const float NEG=-INFINITY; int kb=64*jb+4*hi;
  #pragma unroll
  for(int r=0;r<16;++r){int kv=kb+(r&3)+8*(r>>2); if(kv>qrel)p0[r]=NEG; if(kv+32>qrel)p1[r]=NEG;}
}

constexpr int NSLOT=3, SLOTB=8192;
constexpr int LDS_K=0, LDS_V=NSLOT*SLOTB, LDS_WS=2*NSLOT*SLOTB, LDS_OST=LDS_WS+NW*64*4, LDS_BYTES=LDS_OST+NW*4096;
constexpr float C2=0.125f*1.4426950408889634f;
__device__ __forceinline__ void glds16(const void*gsrc,unsigned lds_dst){unsigned keep;
  asm volatile("s_mov_b32 %0, m0\n\ts_mov_b32 m0, %2\n\ts_nop 0\n\tglobal_load_lds_dwordx4 %1, off\n\ts_mov_b32 m0, %0":"=&s"(keep):"v"(gsrc),"s"(lds_dst):"memory");}
__device__ __forceinline__ float max3f(float a,float b,float c){float r;asm("v_max3_f32 %0, %1, %2, %3":"=v"(r):"v"(a),"v"(b),"v"(c));return r;}
__device__ __forceinline__ float max2f(float a,float b){float r;asm("v_max_f32_e32 %0, %1, %2":"=v"(r):"v"(a),"v"(b));return r;}
__device__ __forceinline__ float fadd_s(float a,float b){float r;asm("v_add_f32_e32 %0, %1, %2":"=v"(r):"v"(a),"v"(b));return r;}
__device__ __forceinline__ float fsub_s(float a,float b){float r;asm("v_sub_f32_e32 %0, %1, %2":"=v"(r):"v"(a),"v"(b));return r;}
typedef float f32x2_t __attribute__((ext_vector_type(2))); typedef __bf16 bf16x2_t __attribute__((ext_vector_type(2)));
__device__ __forceinline__ unsigned cvtpk_s(float lo,float hi){f32x2_t v={lo,hi};bf16x2_t b=__builtin_convertvector(v,bf16x2_t);return __builtin_bit_cast(unsigned,b);}
#define WAIT_BAR(N) asm volatile("s_waitcnt vmcnt(" #N ") lgkmcnt(0)\n\ts_barrier":::"memory")

__device__ __forceinline__ void qkt(f32x16&p0,f32x16&p1,const char*Kslot,const bf16x8*qr,bf16x8 ka0,bf16x8 ka1,bf16x8 qaug,int r32,int hi){
  const char*kb=Kslot+hi*1024+r32*16;
  p0=__builtin_amdgcn_mfma_f32_32x32x16_bf16(ka0,qaug,f32x16{},0,0,0);p1=__builtin_amdgcn_mfma_f32_32x32x16_bf16(ka1,qaug,f32x16{},0,0,0);
  #pragma unroll
  for(int d0=0;d0<4;++d0){
    const bf16x8 b0=*reinterpret_cast<const bf16x8*>(kb+d0*2048);
    const bf16x8 b1=*reinterpret_cast<const bf16x8*>(kb+d0*2048+512);
    p0=__builtin_amdgcn_mfma_f32_32x32x16_bf16(b0,qr[d0],p0,0,0,0);p1=__builtin_amdgcn_mfma_f32_32x32x16_bf16(b1,qr[d0],p1,0,0,0);}
}
typedef __attribute__((address_space(3))) const char* lds_cptr;
typedef short v4i16_t __attribute__((ext_vector_type(4)));
__device__ __forceinline__ void kload8(bf16x8*kf,lds_cptr kp){
  kf[0]=*(const __attribute__((address_space(3))) bf16x8*)(kp);      kf[1]=*(const __attribute__((address_space(3))) bf16x8*)(kp+512);
  kf[2]=*(const __attribute__((address_space(3))) bf16x8*)(kp+2048); kf[3]=*(const __attribute__((address_space(3))) bf16x8*)(kp+2560);
  kf[4]=*(const __attribute__((address_space(3))) bf16x8*)(kp+4096); kf[5]=*(const __attribute__((address_space(3))) bf16x8*)(kp+4608);
  kf[6]=*(const __attribute__((address_space(3))) bf16x8*)(kp+6144); kf[7]=*(const __attribute__((address_space(3))) bf16x8*)(kp+6656);
}
__device__ __forceinline__ void kload2(bf16x8*kf,lds_cptr kp,int j){ kf[2*j]=*(const __attribute__((address_space(3))) bf16x8*)(kp+j*2048); kf[2*j+1]=*(const __attribute__((address_space(3))) bf16x8*)(kp+j*2048+512); }
__device__ __forceinline__ s16x4 vtr(lds_cptr p){ return __builtin_bit_cast(s16x4,__builtin_amdgcn_ds_read_tr16_b64_v4i16((__attribute__((address_space(3))) v4i16_t*)p)); }
__device__ __forceinline__ float rowmax(const f32x16&p0,const f32x16&p1){
  float a=max3f(p0[0],p0[1],p1[0]),b=max3f(p0[2],p0[3],p1[1]);a=max3f(a,p1[2],p1[3]);
  #pragma unroll
  for(int r=4;r<16;r+=4){a=max3f(a,p0[r],p0[r+1]);b=max3f(b,p0[r+2],p0[r+3]);a=max3f(a,p1[r],p1[r+1]);b=max3f(b,p1[r+2],p1[r+3]);}
  const float m=max2f(a,b);
  auto rr=__builtin_amdgcn_permlane32_swap(__float_as_uint(m),__float_as_uint(m),false,false);
  return max2f(__uint_as_float(rr[0]),__uint_as_float(rr[1]));
}
__device__ __forceinline__ void pv(f32x16*o,int vb,bf16x8 pa0,bf16x8 pa1,bf16x8 pa2,bf16x8 pa3){
  #pragma unroll
  for(int d0=0;d0<2;++d0){s16x4 lo[4],hi[4];
    #pragma unroll
    for(int ks=0;ks<4;++ks){
      asm volatile("ds_read_b64_tr_b16 %0,%1 offset:%c2":"=&v"(lo[ks]):"v"(vb),"i"(d0*4096+ks*1024):"memory");
      asm volatile("ds_read_b64_tr_b16 %0,%1 offset:%c2":"=&v"(hi[ks]):"v"(vb),"i"(d0*4096+ks*1024+512):"memory");}
    asm volatile("s_waitcnt lgkmcnt(0)":::"memory");SBAR();
    #define PK(k) (bf16x8){lo[k][0],lo[k][1],lo[k][2],lo[k][3],hi[k][0],hi[k][1],hi[k][2],hi[k][3]}
    o[d0]=__builtin_amdgcn_mfma_f32_32x32x16_bf16(pa0,PK(0),o[d0],0,0,0);
    o[d0]=__builtin_amdgcn_mfma_f32_32x32x16_bf16(pa1,PK(1),o[d0],0,0,0);
    o[d0]=__builtin_amdgcn_mfma_f32_32x32x16_bf16(pa2,PK(2),o[d0],0,0,0);
    o[d0]=__builtin_amdgcn_mfma_f32_32x32x16_bf16(pa3,PK(3),o[d0],0,0,0);
    #undef PK
  }
}

#ifndef ATTN_STORE16
#define ATTN_STORE16(p,v) (*(u32x4*)(p)=(v))
#endif
typedef __attribute__((address_space(3))) const u32x4* lds_tabptr;
__device__ __forceinline__ bf16x8 make_qaug(float mhat,int hi){
  const float nm=-mhat; const unsigned h=cvtpk_s(nm,0.f)&0xffffu; const float r1=nm-__uint_as_float(h<<16);
  const unsigned m=cvtpk_s(r1,0.f)&0xffffu; const float r2=r1-__uint_as_float(m<<16); const unsigned l=cvtpk_s(r2,0.f)&0xffffu;
  u32x4 w; w.x=hi?0u:0x3F803F80u; w.y=hi?0u:(0x3F80u|(h<<16)); w.z=hi?0u:(m|(l<<16)); w.w=0u; return __builtin_bit_cast(bf16x8,w);
}
template<int THRL> __device__ __forceinline__ void attn_unit(int b,int h,int qb,const bf16*Q,const bf16*__restrict__ K,const bf16*__restrict__ V,bf16*O,char*shm,lds_tabptr tab){
  int tid_=threadIdx.x; asm volatile("":"+v"(tid_));
  const int tid=tid_,lane=tid&63,r32=lane&31,hi=lane>>5; const int wid=__builtin_amdgcn_readfirstlane(tid>>6);
  const long rowbase=(long)b*SEQ; const int q0=qb*QB;
  const bf16*Qw=Q+(rowbase+q0+wid*QBLK)*DM+h*D;
  const bf16*Kh=K+rowbase*DM+h*D,*Vh=V+rowbase*DM+h*D;
  const unsigned lds0=(unsigned)(uintptr_t)shm;
  float*wsf=(float*)(shm+LDS_WS)+wid*64;
  const bf16*ksrc=Kh+(long)lane*DM+wid*8;
  const bf16*vsrc=Vh+(long)(16*(wid&3)+(lane>>2))*DM+(wid>>2)*32+(lane&3)*8;
  const unsigned kdst=lds0+LDS_K+wid*1024, vdst=lds0+LDS_V+wid*1024;
  #define DMA_K(t,slot) glds16(ksrc+(long)(t)*KVBLK*DM,(unsigned)__builtin_amdgcn_readfirstlane(kdst+(slot)))
  #define DMA_V(t,slot) glds16(vsrc+(long)(t)*KVBLK*DM,(unsigned)__builtin_amdgcn_readfirstlane(vdst+(slot)))
  const int vb0=(int)(lds0+LDS_V)+((lane>>4)&1)*32+(lane&3)*8+(4*hi+((lane&15)>>2))*64;
  const char*Kbase=shm+LDS_K; bf16x8 kf[8];
  const lds_cptr shm3=(lds_cptr)shm; const lds_cptr kp0=shm3+LDS_K+hi*1024+r32*16; const lds_cptr vp0=shm3+LDS_V+((lane>>4)&1)*32+(lane&3)*8+(4*hi+((lane&15)>>2))*64;
  const int NT=(q0+QB)/KVBLK;
  DMA_K(0,0);DMA_V(0,0);DMA_K(1,SLOTB);
  bf16x8 qr[4];
  #pragma unroll
  for(int d0=0;d0<4;++d0)qr[d0]=*reinterpret_cast<const bf16x8*>(&Qw[(long)r32*DM+d0*16+hi*8]);
  float mhat=0.f,l_reg=0.f;f32x16 o[2];o[0]=f32x16{};o[1]=f32x16{};bf16x8 qaug=make_qaug(0.f,hi);asm volatile("":"+v"(qaug));
  const int qrel=wid*QBLK+r32;
  #define CMASK(P0,P1,t) do{int jb_=(t)-(NT-4); if(jb_>=0)cmask(P0,P1,jb_,qrel,hi);}while(0)
  bool resc=false;
  #define START(P0,P1) do{ const float rm=rowmax(P0,P1); resc=false; \
    { const float dl=rm; mhat=fadd_s(mhat,dl); \
      _Pragma("unroll") for(int r=0;r<16;++r){P0[r]=fsub_s(P0[r],dl);P1[r]=fsub_s(P1[r],dl);} \
      qaug=make_qaug(mhat,hi); asm volatile("":"+v"(qaug)); } \
    _Pragma("unroll") for(int r=0;r<16;++r)P0[r]=__builtin_amdgcn_exp2f(P0[r]); }while(0)
  #define RESC() do{ if(resc){ asm volatile("s_waitcnt lgkmcnt(0)":::"memory"); \
      _Pragma("unroll") for(int d_=0;d_<2;++d_) _Pragma("unroll") for(int r=0;r<16;++r)o[d_][r]*=wsf[crow(r,hi)]; } }while(0)
  f32x16 pA0,pA1,pB0,pB1;
  int sl_prev=0,sl_cur=0,sl_next=SLOTB;
  #define ROT() do{sl_prev=sl_cur;sl_cur=sl_next;sl_next=(sl_next==(NSLOT-1)*SLOTB)?0:sl_next+SLOTB;}while(0)
  DMA_K(2,2*SLOTB);
  WAIT_BAR(3);
  qkt(pA0,pA1,Kbase,qr,__builtin_bit_cast(bf16x8,tab[r32]),__builtin_bit_cast(bf16x8,tab[32+r32]),qaug,r32,hi);asm volatile("s_nop 15\n\ts_nop 7":"+v"(pA0),"+v"(pA1));CMASK(pA0,pA1,0);
  START(pA0,pA1);
  _Pragma("unroll") for(int r=0;r<16;++r)pA1[r]=__builtin_amdgcn_exp2f(pA1[r]);
  WAIT_BAR(0);
  DMA_K(3,0);DMA_V(1,SLOTB);
  ROT();
  kload8(kf,kp0+sl_cur);
  WAIT_BAR(2);
  s16x4 vlo[8],vhi[8]; u32x4 pw0,pw1,pw2,pw3;
  #define PKW(P,B) cvtpk_s(P[B],P[B+1])
  #define PAF(k) __builtin_bit_cast(bf16x8,pw##k)
  #define VFR(i) (bf16x8){vlo[i][0],vlo[i][1],vlo[i][2],vlo[i][3],vhi[i][0],vhi[i][1],vhi[i][2],vhi[i][3]}
  #define PIN(x) asm volatile("":"+v"(x))
  #define MX3(a,b,c) __builtin_fmaxf(__builtin_fmaxf((a),(b)),(c))
  #define GAPA(MF,A0,A1,A2,A3,W0,W1,PW) do{ MF; sacc+=A0; sacc+=A1; sacc+=A2; sacc+=A3; PIN(sacc); W0; W1; PIN(PW); SBAR(); }while(0)
  #define EX(v) __builtin_amdgcn_exp2f(v)
  #define GAPB(MF,X,B) do{ MF; X[B]=EX(X[B]); X[B+1]=EX(X[B+1]); X[B+2]=EX(X[B+2]); X[B+3]=EX(X[B+3]); PIN(X); SBAR(); }while(0)
  #define VRD(i) do{ vlo[i]=vtr(vp_+(((i)>>2)*4096+((i)&3)*1024)); vhi[i]=vtr(vp_+(((i)>>2)*4096+((i)&3)*1024+512)); }while(0)
  #define KRD(G,j) do{ if(G){ kload2(kf,kp0+sl_next,j); SBAR(); } }while(0)
  #define STEP(C0,C1,P0,P1,t,GK,GV,GL) do{ SBAR(); \
    const lds_cptr vp_=vp0+sl_prev; \
    const bf16x8 ka0_=__builtin_bit_cast(bf16x8,tab[64*(t)+r32]), ka1_=__builtin_bit_cast(bf16x8,tab[64*(t)+32+r32]); \
    VRD(0); SBAR(); float sacc=(P0[0]+P0[1]); \
    GAPA(C0=__builtin_amdgcn_mfma_f32_32x32x16_bf16(kf[0],qr[0],f32x16{},0,0,0), P0[2],P0[3],P0[4],P0[5],     pw0[0]=PKW(P0,0), pw0[1]=PKW(P0,2), pw0); \
    VRD(4); SBAR(); GAPA(C1=__builtin_amdgcn_mfma_f32_32x32x16_bf16(kf[1],qr[0],f32x16{},0,0,0), P0[6],P0[7],P0[8],P0[9],     pw0[2]=PKW(P0,4), pw0[3]=PKW(P0,6), pw0); \
    VRD(1); SBAR(); GAPA(C0=__builtin_amdgcn_mfma_f32_32x32x16_bf16(kf[2],qr[1],C0,0,0,0),   P0[10],P0[11],P0[12],P0[13], pw1[0]=PKW(P0,8), pw1[1]=PKW(P0,10), pw1); \
    VRD(5); SBAR(); GAPA(C1=__builtin_amdgcn_mfma_f32_32x32x16_bf16(kf[3],qr[1],C1,0,0,0),   P0[14],P0[15],P1[0],P1[1],   pw1[2]=PKW(P0,12),pw1[3]=PKW(P0,14), pw1); \
    VRD(2); SBAR(); GAPA(C0=__builtin_amdgcn_mfma_f32_32x32x16_bf16(kf[4],qr[2],C0,0,0,0),   P1[2],P1[3],P1[4],P1[5],     pw2[0]=PKW(P1,0), pw2[1]=PKW(P1,2), pw2); \
    VRD(6); SBAR(); GAPA(C1=__builtin_amdgcn_mfma_f32_32x32x16_bf16(kf[5],qr[2],C1,0,0,0),   P1[6],P1[7],P1[8],P1[9],     pw2[2]=PKW(P1,4), pw2[3]=PKW(P1,6), pw2); \
    VRD(3); SBAR(); GAPA(C0=__builtin_amdgcn_mfma_f32_32x32x16_bf16(kf[6],qr[3],C0,0,0,0),   P1[10],P1[11],P1[12],P1[13], pw3[0]=PKW(P1,8), pw3[1]=PKW(P1,10), pw3); \
    VRD(7); SBAR(); GAPA(C1=__builtin_amdgcn_mfma_f32_32x32x16_bf16(kf[7],qr[3],C1,0,0,0),   P1[14],P1[15],0.f,0.f,       pw3[2]=PKW(P1,12),pw3[3]=PKW(P1,14), pw3); \
    C0=__builtin_amdgcn_mfma_f32_32x32x16_bf16(ka0_,qaug,C0,0,0,0); C1=__builtin_amdgcn_mfma_f32_32x32x16_bf16(ka1_,qaug,C1,0,0,0); SBAR(); \
    l_reg+=sacc; \
    if(GK){DMA_K((t)+3,sl_cur);} if(GV){DMA_V((t)+1,sl_next);} \
    CMASK(C0,C1,t); \
    { float a=MX3(C0[0],C0[1],C1[0]),b=MX3(C0[2],C0[3],C1[1]); a=MX3(a,C1[2],C1[3]); \
      _Pragma("unroll") for(int r=4;r<16;r+=4){a=MX3(a,C0[r],C0[r+1]);b=MX3(b,C0[r+2],C0[r+3]);a=MX3(a,C1[r],C1[r+1]);b=MX3(b,C1[r+2],C1[r+3]);} \
      float rm=__builtin_fmaxf(a,b); { auto rr=__builtin_amdgcn_permlane32_swap(__float_as_uint(rm),__float_as_uint(rm),false,false); rm=__builtin_fmaxf(__uint_as_float(rr[0]),__uint_as_float(rr[1])); } \
      resc=false; \
      if(__builtin_expect(__any(rm>(float)THRL),0)){ const float dl=__builtin_fmaxf(rm,0.f); mhat+=dl; \
        _Pragma("unroll") for(int r=0;r<16;++r){C0[r]-=dl;C1[r]-=dl;} \
        qaug=make_qaug(mhat,hi); asm volatile("":"+v"(qaug)); \
        const float f=__builtin_amdgcn_exp2f(-dl); l_reg*=f; if(hi==0)wsf[r32]=f; resc=true; } } \
    SBAR(); \
    GAPB(o[0]=__builtin_amdgcn_mfma_f32_32x32x16_bf16(PAF(0),VFR(0),o[0],0,0,0), C0,0); \
    GAPB(o[1]=__builtin_amdgcn_mfma_f32_32x32x16_bf16(PAF(0),VFR(4),o[1],0,0,0), C0,4); \
    KRD(GL,0); GAPB(o[0]=__builtin_amdgcn_mfma_f32_32x32x16_bf16(PAF(1),VFR(1),o[0],0,0,0), C0,8); \
    KRD(GL,1); GAPB(o[1]=__builtin_amdgcn_mfma_f32_32x32x16_bf16(PAF(1),VFR(5),o[1],0,0,0), C0,12); \
    KRD(GL,2); GAPB(o[0]=__builtin_amdgcn_mfma_f32_32x32x16_bf16(PAF(2),VFR(2),o[0],0,0,0), C1,0); \
    KRD(GL,3); GAPB(o[1]=__builtin_amdgcn_mfma_f32_32x32x16_bf16(PAF(2),VFR(6),o[1],0,0,0), C1,4); \
    GAPB(o[0]=__builtin_amdgcn_mfma_f32_32x32x16_bf16(PAF(3),VFR(3),o[0],0,0,0), C1,8); \
    GAPB(o[1]=__builtin_amdgcn_mfma_f32_32x32x16_bf16(PAF(3),VFR(7),o[1],0,0,0), C1,12); \
    }while(0)
  int t=1;
  #undef CMASK
  #define CMASK(P0,P1,t) do{}while(0)
  for(;t+5<NT;t+=2){
    STEP(pB0,pB1,pA0,pA1,t,true,true,true);     WAIT_BAR(2); RESC(); ROT();
    STEP(pA0,pA1,pB0,pB1,t+1,true,true,true);   WAIT_BAR(2); RESC(); ROT();
  }
  #undef CMASK
  #define CMASK(P0,P1,t) do{int jb_=(t)-(NT-4); if(jb_>=0)cmask(P0,P1,jb_,qrel,hi);}while(0)
  #define ENDW(tt) do{ if((tt)+3<NT){WAIT_BAR(2);} else if((tt)+2<NT){WAIT_BAR(1);} else {WAIT_BAR(0);} }while(0)
  for(;t+1<NT;t+=2){
    STEP(pB0,pB1,pA0,pA1,t,(t+3<NT),(t+1<NT),(t+1<NT));       ENDW(t);   RESC(); ROT();
    STEP(pA0,pA1,pB0,pB1,t+1,(t+4<NT),(t+2<NT),(t+2<NT));     ENDW(t+1); RESC(); ROT();
  }
  STEP(pB0,pB1,pA0,pA1,NT-1,false,false,false); RESC();
  { float sacc=pB0[0]+pB0[1]; _Pragma("unroll") for(int r=2;r<16;++r)sacc+=pB0[r]; _Pragma("unroll") for(int r=0;r<16;++r)sacc+=pB1[r]; l_reg+=sacc;
    pw0=(u32x4){PKW(pB0,0),PKW(pB0,2),PKW(pB0,4),PKW(pB0,6)};pw1=(u32x4){PKW(pB0,8),PKW(pB0,10),PKW(pB0,12),PKW(pB0,14)};pw2=(u32x4){PKW(pB1,0),PKW(pB1,2),PKW(pB1,4),PKW(pB1,6)};pw3=(u32x4){PKW(pB1,8),PKW(pB1,10),PKW(pB1,12),PKW(pB1,14)};
    SBAR(); pv(o,vb0+sl_cur,PAF(0),PAF(1),PAF(2),PAF(3)); }
  #undef PKW
  #undef PAF
  #undef VFR
  #undef PIN
  #undef MX3
  #undef GAPA
  #undef GAPB
  #undef EX
  #undef VRD
  #undef KRD
  #undef STEP
  #undef ENDW
  {auto rr=__builtin_amdgcn_permlane32_swap(__float_as_uint(l_reg),__float_as_uint(l_reg),false,false);l_reg=__uint_as_float(rr[0])+__uint_as_float(rr[1]);}
  if(hi==0)wsf[32+r32]=l_reg;asm volatile("s_waitcnt lgkmcnt(0)":::"memory");
  float rli[16];
  #pragma unroll
  for(int r=0;r<16;++r)rli[r]=__builtin_amdgcn_rcpf(wsf[32+crow(r,hi)]);
  bf16*Ow=O+(rowbase+q0+wid*QBLK)*PO+OCOL+h*D;
  { bf16*stg=(bf16*)(shm+LDS_OST)+wid*2048;
    #pragma unroll
    for(int r=0;r<16;++r){const int orow=crow(r,hi);
      #pragma unroll
      for(int d0=0;d0<2;++d0)stg[orow*64+d0*32+r32]=__float2bfloat16(o[d0][r]*rli[r]);}
    asm volatile("s_waitcnt lgkmcnt(0)":::"memory");
    #pragma unroll
    for(int i=0;i<4;++i){const int row=i*8+(lane>>3),ch=lane&7; const u32x4 v=*(const u32x4*)(stg+row*64+ch*8); ATTN_STORE16(Ow+(long)row*PO+ch*8,v);} }
  asm volatile("s_waitcnt lgkmcnt(0)\n\ts_barrier":::"memory");
  #undef DMA_K
  #undef DMA_V
  #undef CMASK
  #undef START
  #undef RESC
  #undef ROT
}
constexpr int ATTN_LDS_BYTES=LDS_BYTES;
#undef SBAR
#undef WAIT_BAR
}
constexpr int NWAVES = 8;
constexpr int D = 1024, BATCH = 8, SEQ = 2048, M = BATCH * SEQ;
constexpr int N_INSRC = 7176, N_INV = 7168;
constexpr int FL_COL = 3072;
constexpr int DFF_D = 2816, DFF_E = 3584, NEXP = 8;
constexpr float LN_EPS = 1e-5f, GN_EPS = 1e-6f;
constexpr float ALPHA = 1.4142135623730951f;
constexpr float LOG2E = 1.4426950408889634f;
constexpr float C2 = 0.125f * LOG2E;

constexpr size_t MiB = 1u << 20;
constexpr size_t WS_CTL = 0, CTL_ZERO_BYTES = 192 * 1024;
constexpr size_t WS_CS = 1 * MiB;
constexpr size_t WS_LIST = 2 * MiB;
constexpr size_t WS_GATEW = 2 * MiB + 512 * 1024;
constexpr size_t WS_LOGF = 3 * MiB;
constexpr size_t WS_GST = 3 * MiB + 512 * 1024;
constexpr size_t WS_WIN = 4 * MiB;
constexpr size_t WS_WBR = 32 * MiB;
constexpr size_t WS_WOUT = 38 * MiB;
constexpr size_t WS_WDU = 42 * MiB;
constexpr size_t WS_WDD = 53 * MiB;
constexpr size_t WS_WMU = 59 * MiB;
constexpr size_t WS_WMD = 171 * MiB;
constexpr size_t WS_XB = 227 * MiB;
constexpr size_t WS_XF = 259 * MiB;
constexpr size_t WS_YPRE = 323 * MiB;
constexpr size_t WS_C1 = 387 * MiB;
constexpr size_t WS_MRG = 451 * MiB;
constexpr size_t WS_RQ = 483 * MiB, WS_RK = 491 * MiB, WS_RV = 499 * MiB, WS_RG = 515 * MiB, WS_FQ = 531 * MiB, WS_FK = 547 * MiB, WS_FV = 563 * MiB,
                 WS_GU = 579 * MiB, WS_GV = 595 * MiB, WS_GT = 611 * MiB, WS_YB = 707 * MiB, WS_KV = 755 * MiB  , WS_X8IN = 771 * MiB  , WS_WIN8 = 787 * MiB  , WS_END = 793 * MiB;
constexpr size_t WS_HID = 483 * MiB;
static_assert((size_t)34816 * DFF_E <= WS_KV - WS_HID, "MoE hidden fits its overlay");
constexpr int CW_TMO = 0, CW_CODE = 1;
constexpr int CW_CNT = 64;
constexpr int CW_BAR = 4096;

constexpr int RING_OFF = 0, RING_BYTES = 141312;
constexpr int LDSCTL_OFF = RING_BYTES, MISC_OFF = LDSCTL_OFF + 320, PTAB_OFF = LDSCTL_OFF + 1024;
constexpr int LDS_BYTES = 147456;
static_assert(MISC_OFF + 128 <= PTAB_OFF && PTAB_OFF + 20 * 8 <= LDS_BYTES, "LDS map");

#define GAS __attribute__((address_space(1)))
#define LAS __attribute__((address_space(3)))
typedef unsigned short bf16;
typedef unsigned v4u __attribute__((ext_vector_type(4)));
typedef unsigned v2u __attribute__((ext_vector_type(2)));
typedef float f32x4 __attribute__((ext_vector_type(4)));
typedef GAS unsigned gu32;
#define RLX_AGENT __ATOMIC_RELAXED, __HIP_MEMORY_SCOPE_AGENT
#define LDS_WAIT() asm volatile("s_waitcnt lgkmcnt(0)" ::: "memory")
#define VM_WAIT() asm volatile("s_waitcnt vmcnt(0)" ::: "memory")
__device__ __forceinline__ unsigned f2bf(float f) { unsigned u = __builtin_bit_cast(unsigned, f); return (u + 0x7fffu + ((u >> 16) & 1u)) >> 16; }
__device__ __forceinline__ unsigned pk2(float lo, float hi) { return f2bf(lo) | (f2bf(hi) << 16); }
__device__ __forceinline__ float bf2f(unsigned short h) { return __builtin_bit_cast(float, (unsigned)h << 16); }
__device__ __forceinline__ float bflo(unsigned w) { return __builtin_bit_cast(float, w << 16); }
__device__ __forceinline__ float bfhi(unsigned w) { return __builtin_bit_cast(float, w & 0xffff0000u); }
constexpr float SC_X8 = 16.f, SC_WU8 = 32.f, SC_H8 = 8.f, SC_WD8 = 128.f;
constexpr float SWI_A = 1.4426950408889634f, SWI_B = SC_H8 / 1.4426950408889634f;
constexpr unsigned E8_UP = 0x76767676u  , E8_DN = 0x75757575u  ;
__device__ __forceinline__ float clamp448(float x) { return fminf(fmaxf(x, -448.f), 448.f); }
__device__ __forceinline__ unsigned pk4_fp8(float a, float b, float c, float d) {
    int w = __builtin_amdgcn_cvt_pk_fp8_f32(clamp448(a), clamp448(b), 0, false); w = __builtin_amdgcn_cvt_pk_fp8_f32(clamp448(c), clamp448(d), w, true); return (unsigned)w; }
__device__ __forceinline__ float fsigmoid(float x) { return __builtin_amdgcn_rcpf(1.0f + __builtin_amdgcn_exp2f(-x * LOG2E)); }
__device__ __forceinline__ float fsilu(float x) { return x * fsigmoid(x); }
typedef float f2v __attribute__((ext_vector_type(2)));
__device__ __forceinline__ f2v fsigmoid2(f2v x) { const f2v t = x * (-LOG2E); f2v e; e.x = __builtin_amdgcn_exp2f(t.x); e.y = __builtin_amdgcn_exp2f(t.y); const f2v d = e + 1.0f; f2v r; r.x = __builtin_amdgcn_rcpf(d.x); r.y = __builtin_amdgcn_rcpf(d.y); return r; }
__device__ __forceinline__ f2v fsilu2(f2v x) { return x * fsigmoid2(x); }
__device__ __forceinline__ f2v fgelu_tanh2(f2v x) {
    const f2v t = x * (x * x * (-0.0713548163f * LOG2E) + (-1.5957691216f * LOG2E)); f2v e; e.x = __builtin_amdgcn_exp2f(t.x); e.y = __builtin_amdgcn_exp2f(t.y);
    const f2v d = e + 1.0f; f2v r; r.x = __builtin_amdgcn_rcpf(d.x); r.y = __builtin_amdgcn_rcpf(d.y); return x * r; }
__device__ __forceinline__ float fgelu_tanh(float x) { const float u = 0.7978845608028654f * (x + 0.044715f * x * x * x); return x * fsigmoid(2.0f * u); }

#define XB_TMO      128
#define XB_XCNT(j)  (256  + 64 * (j))
#define XB_XSUB(j)  (1280 + 64 * (j))
#define XB_XGEN(j)  (2304 + 64 * (j))
#define XB_TOP      3328
#define XB_TOPGEN   3392
#define XCD_BAR_WORDS 3456
#define XB_SPIN_CAP (1u << 18)
__device__ __forceinline__ unsigned xb_ld(unsigned* p)              { return __hip_atomic_load(p, __ATOMIC_RELAXED, __HIP_MEMORY_SCOPE_AGENT); }
__device__ __forceinline__ unsigned xb_add(unsigned* p, unsigned v) { return __hip_atomic_fetch_add(p, v, __ATOMIC_RELAXED, __HIP_MEMORY_SCOPE_AGENT); }
__device__ __forceinline__ unsigned xb_xcc_id() { return (unsigned)__builtin_amdgcn_s_getreg((3 << 11) | 20) & 0xFu; }
#define XB_SPIN(cond, bar) do { unsigned _sp = 0; while (cond) { __builtin_amdgcn_s_sleep(1); \
    if ((++_sp & 255u) == 0u) { if (xb_ld(&(bar)[XB_TMO])) break; if (_sp > XB_SPIN_CAP) { atomicAdd(&(bar)[XB_TMO], 1u); break; } } } } while (0)
struct XcdBarrier { unsigned* bar; unsigned x; volatile LAS unsigned* st; unsigned total; unsigned lite; };
__device__ __forceinline__ XcdBarrier xcd_barrier_post(unsigned* bar, volatile LAS unsigned* st, unsigned total, unsigned lite) {
    XcdBarrier b; b.bar = bar; b.x = xb_xcc_id(); b.st = st; b.total = total; b.lite = lite;
    if (threadIdx.x == 0) (void)xb_add(&bar[XB_XCNT(b.x)], 1u);
    return b;
}
__device__ __forceinline__ void xcd_barrier_complete(unsigned* bar, unsigned x, unsigned G, unsigned& nloc, unsigned& nx) {
    unsigned sum, cnt, mine, sp = 0u;
    for (;;) {
        sum = 0u; cnt = 0u; mine = 0u;
#pragma unroll
        for (unsigned j = 0; j < 16; ++j) { const unsigned c = xb_ld(&bar[XB_XCNT(j)]); sum += c; cnt += (c > 0u) ? 1u : 0u; mine = (j == x) ? c : mine; }
        if (sum == G) break;
        __builtin_amdgcn_s_sleep(1);
        if ((++sp & 255u) == 0u) { if (xb_ld(&bar[XB_TMO])) break; if (sp > XB_SPIN_CAP) { atomicAdd(&bar[XB_TMO], 1u); break; } }
    }
    nloc = mine > 0u ? mine : 1u; nx = cnt > 0u ? cnt : 1u;
}
__device__ __forceinline__ void xcd_barrier(const XcdBarrier& b) {
    asm volatile("s_waitcnt vmcnt(0)" ::: "memory");
    __syncthreads();
    if (threadIdx.x == 0) {
        unsigned* bar = b.bar;
        __builtin_amdgcn_s_waitcnt(0);
        unsigned nloc = b.st[0], nx = b.st[1];
        if (nloc == 0u) { xcd_barrier_complete(bar, b.x, b.total, nloc, nx); b.st[0] = nloc; b.st[1] = nx; }
        const unsigned old = xb_add(&bar[XB_XSUB(b.x)], 1u);
        const unsigned gen = old / nloc;
        if (old + 1u == (gen + 1u) * nloc) {
            if (!(b.lite != 0u && nx == 1u)) {
                __builtin_amdgcn_fence(__ATOMIC_RELEASE, "agent");
                asm volatile("s_waitcnt vmcnt(0)" ::: "memory");
            }
            if (nx != 1u) {
                const unsigned og = xb_add(&bar[XB_TOP], 1u);
                const unsigned tg = og / nx;
                if (og + 1u == (tg + 1u) * nx) xb_add(&bar[XB_TOPGEN], 1u);
                else XB_SPIN(xb_ld(&bar[XB_TOPGEN]) == tg, bar);
            }
            __builtin_amdgcn_fence(__ATOMIC_ACQUIRE, "agent");
            xb_add(&bar[XB_XGEN(b.x)], 1u);
            asm volatile("s_waitcnt vmcnt(0)" ::: "memory");
        } else {
            XB_SPIN(xb_ld(&bar[XB_XGEN(b.x)]) == gen, bar);
            __builtin_amdgcn_fence(__ATOMIC_ACQUIRE, "agent");
            asm volatile("s_waitcnt vmcnt(0)" ::: "memory");
        }
    }
    __syncthreads();
}

using pg8::Unit; using pg8::bf16_t;
#define ACC_T const pg8::f32x4 (&acc)[2][2][4][2]

struct ProjSched : pg8::PlainSched {
    __device__ __forceinline__ bool next(int i, Unit& u) const { if (!pg8::PlainSched::next(i, u)) return false; if (nN == 16 && ((u.pm >> 2) & 1)) u.pn ^= 6; return true; }
};
struct EpiProj {
    static constexpr bool PERM = true, HOOK = false, DUPME = true;
    unsigned char* ws; const float* gate_b; const float* cs;
    __device__ __forceinline__ void operator()(ACC_T, const Unit& u, int wr, int wc, int fr, int fq) const {
        const int pn = u.pn, row0 = u.pm * 256 + wr * 64 + fr, lc = wc * 32 + 8 * fq;
        if (pn < 2) {
            bf16_t* dst = (bf16_t*)(ws + (pn == 0 ? WS_RQ : WS_RK)); const float sc = pn == 0 ? 1.0f : 0.125f;
            const int d1 = 16 * (wc & 1) + 4 * fq;
#pragma unroll
            for (int ai = 0; ai < 2; ++ai)
#pragma unroll
                for (int m = 0; m < 4; ++m) { const int row = row0 + ai * 128 + m * 16, pos = row & (SEQ - 1);
                    const f32x4 c4 = *(const f32x4*)(cs + pos * 32 + d1), s4 = *(const f32x4*)(cs + 65536 + pos * 32 + d1);
#pragma unroll
                    for (int bj = 0; bj < 2; ++bj) { const int head = bj * 2 + (wc >> 1); const f32x4 x1 = acc[ai][bj][m][0], x2 = acc[ai][bj][m][1];
                        const f32x4 o1 = (x1 * c4 - x2 * s4) * sc, o2 = (x1 * s4 + x2 * c4) * sc;
                        bf16_t* p = dst + (size_t)row * 256 + head * 64 + d1;
                        v2u w1, w2; w1.x = pg8::cvt_pk_bf16(o1[0], o1[1]); w1.y = pg8::cvt_pk_bf16(o1[2], o1[3]); w2.x = pg8::cvt_pk_bf16(o2[0], o2[1]); w2.y = pg8::cvt_pk_bf16(o2[2], o2[3]);
                        *(v2u*)p = w1; *(v2u*)(p + 32) = w2; } }
            return;
        }
        if (pn < 4) store_act<0>(acc, WS_RV, 512, (pn - 2) * 256, row0, lc);
        else if (pn < 6) store_act<1>(acc, WS_RG, 512, (pn - 4) * 256, row0, lc);
        else if (pn < 8) store_act<2>(acc, WS_FQ, 512, (pn - 6) * 256, row0, lc);
        else if (pn < 10) store_act<0>(acc, WS_FK, 512, (pn - 8) * 256, row0, lc);
        else if (pn < 12) store_act<0>(acc, WS_FV, 512, (pn - 10) * 256, row0, lc);
        else if (pn < 14) store_act<3>(acc, WS_GU, 512, (pn - 12) * 256, row0, lc);
        else if (pn < 16) store_act<3>(acc, WS_GV, 512, (pn - 14) * 256, row0, lc);
        else store_act<4>(acc, WS_GT, 3072, (pn - 16) * 256, row0, lc);
    }
    template <int ACT>
    __device__ __forceinline__ void store_act(ACC_T, size_t off, int pitch, int coff, int row0, int lc) const {
        bf16_t* dst = (bf16_t*)(ws + off);
        f32x4 bv[2][2];
#pragma unroll
        for (int bj = 0; bj < 2; ++bj)
#pragma unroll
            for (int n = 0; n < 2; ++n) bv[bj][n] = (ACT == 4) ? *(const f32x4*)(gate_b + coff + bj * 128 + lc + 4 * n) : (f32x4){0.f, 0.f, 0.f, 0.f};
#pragma unroll
        for (int ai = 0; ai < 2; ++ai)
#pragma unroll
            for (int m = 0; m < 4; ++m) { bf16_t* rowp = dst + (size_t)(row0 + ai * 128 + m * 16) * pitch + coff + lc;
#pragma unroll
                for (int bj = 0; bj < 2; ++bj) { f2v v[4];
#pragma unroll
                    for (int n = 0; n < 2; ++n) { const f32x4 a = acc[ai][bj][m][n]; v[2 * n] = __builtin_shufflevector(a, a, 0, 1); v[2 * n + 1] = __builtin_shufflevector(a, a, 2, 3);
                        if (ACT == 4) { v[2 * n] += __builtin_shufflevector(bv[bj][n], bv[bj][n], 0, 1); v[2 * n + 1] += __builtin_shufflevector(bv[bj][n], bv[bj][n], 2, 3); } }
#pragma unroll
                    for (int j = 0; j < 4; ++j) { f2v x = v[j];
                        if (ACT == 1) x = fsilu2(x); else if (ACT == 2) x = x * C2; else if (ACT == 3) x = fgelu_tanh2(x); else if (ACT == 4) x = fsigmoid2(x);
                        v[j] = x; }
                    v4u w; w.x = pg8::cvt_pk_bf16(v[0].x, v[0].y); w.y = pg8::cvt_pk_bf16(v[1].x, v[1].y); w.z = pg8::cvt_pk_bf16(v[2].x, v[2].y); w.w = pg8::cvt_pk_bf16(v[3].x, v[3].y);
                    *(v4u*)(rowp + bj * 128) = w; } }
    }
};

struct EpiGate8 {
    static constexpr bool PERM = true, HOOK = false, DUPME = false;
    bf16_t* GT; const float* gate_b;
    __device__ __forceinline__ void operator()(ACC_T, const Unit& u, int wr, int wc, int fr, int fq) const {
        const int row0 = u.pm * 256 + wr * 64 + fr, lc = wc * 32 + 8 * fq, coff = u.pn * 256;
        f32x4 bv[2][2];
#pragma unroll
        for (int bj = 0; bj < 2; ++bj)
#pragma unroll
            for (int n = 0; n < 2; ++n) bv[bj][n] = *(const f32x4*)(gate_b + coff + bj * 128 + lc + 4 * n);
#pragma unroll
        for (int ai = 0; ai < 2; ++ai)
#pragma unroll
            for (int m = 0; m < 4; ++m) { bf16_t* rowp = GT + (size_t)(row0 + ai * 128 + m * 16) * 3072 + coff + lc;
#pragma unroll
                for (int bj = 0; bj < 2; ++bj) { f2v v[4];
#pragma unroll
                    for (int n = 0; n < 2; ++n) { const f32x4 a = acc[ai][bj][m][n] + bv[bj][n]; v[2 * n] = fsigmoid2(__builtin_shufflevector(a, a, 0, 1)); v[2 * n + 1] = fsigmoid2(__builtin_shufflevector(a, a, 2, 3)); }
                    v4u w; w.x = pg8::cvt_pk_bf16(v[0].x, v[0].y); w.y = pg8::cvt_pk_bf16(v[1].x, v[1].y); w.z = pg8::cvt_pk_bf16(v[2].x, v[2].y); w.w = pg8::cvt_pk_bf16(v[3].x, v[3].y);
                    *(v4u*)(rowp + bj * 128) = w; } }
    }
};

struct EpiMerge {
    static constexpr bool PERM = true, HOOK = true, DUPME = false;
    const bf16_t* GT; bf16_t* MRG;
    __device__ __forceinline__ void unpackg(const v4u w, float (&g)[8]) const {
        g[0] = bflo(w.x); g[1] = bfhi(w.x); g[2] = bflo(w.y); g[3] = bfhi(w.y); g[4] = bflo(w.z); g[5] = bfhi(w.z); g[6] = bflo(w.w); g[7] = bfhi(w.w);
#pragma unroll
        for (int j = 0; j < 8; ++j) g[j] = fmaxf(g[j], 1e-30f);
    }
    __device__ __forceinline__ void khook(pg8::f32x4 (&acc)[2][2][4][2], const Unit& u, int t, int wr, int wc, int fr, int fq) const {
        if (t != 8 && t != 16) return;
        const int np = (t == 8) ? 0 : 1; int row0 = u.pm * 256 + wr * 64 + fr; const int col0 = u.pn * 256 + wc * 32 + 8 * fq;
        asm volatile("" : "+v"(row0));
#pragma unroll
        for (int ai = 0; ai < 2; ++ai) {
            v4u wp[4][2], wn[4][2];
#pragma unroll
            for (int m = 0; m < 4; ++m)
#pragma unroll
                for (int bj = 0; bj < 2; ++bj) { const bf16_t* p = GT + (size_t)(row0 + ai * 128 + m * 16) * 3072 + np * 1024 + col0 + bj * 128; wp[m][bj] = *(const v4u*)p; wn[m][bj] = *(const v4u*)(p + 1024); }
#pragma unroll
            for (int m = 0; m < 4; ++m)
#pragma unroll
                for (int bj = 0; bj < 2; ++bj) { const unsigned pw[4] = {wp[m][bj].x, wp[m][bj].y, wp[m][bj].z, wp[m][bj].w}, nw[4] = {wn[m][bj].x, wn[m][bj].y, wn[m][bj].z, wn[m][bj].w};
#pragma unroll
                    for (int q = 0; q < 4; ++q) {
                        f2v gp2, gn2; gp2.x = bflo(pw[q]); gp2.y = bfhi(pw[q]); gn2.x = fmaxf(bflo(nw[q]), 1e-30f); gn2.y = fmaxf(bfhi(nw[q]), 1e-30f);
                        f2v r2; r2.x = __builtin_amdgcn_rcpf(gn2.x); r2.y = __builtin_amdgcn_rcpf(gn2.y); const f2v ratio = gp2 * r2;
                        pg8::f32x4& a4 = acc[ai][bj][m][q >> 1];
                        if (q & 1) { a4.z *= ratio.x; a4.w *= ratio.y; } else { a4.x *= ratio.x; a4.y *= ratio.y; } } }
            asm volatile("" ::: "memory");
        }
    }
    __device__ __forceinline__ void operator()(ACC_T, const Unit& u, int wr, int wc, int fr, int fq) const {
        const int row0 = u.pm * 256 + wr * 64 + fr, col0 = u.pn * 256 + wc * 32 + 8 * fq;
#pragma unroll
        for (int ai = 0; ai < 2; ++ai) {
            v4u wg[4][2];
#pragma unroll
            for (int m = 0; m < 4; ++m)
#pragma unroll
                for (int bj = 0; bj < 2; ++bj) wg[m][bj] = *(const v4u*)(GT + (size_t)(row0 + ai * 128 + m * 16) * 3072 + 2048 + col0 + bj * 128);
#pragma unroll
            for (int m = 0; m < 4; ++m)
#pragma unroll
                for (int bj = 0; bj < 2; ++bj) { const unsigned gw[4] = {wg[m][bj].x, wg[m][bj].y, wg[m][bj].z, wg[m][bj].w}; unsigned o[4];
#pragma unroll
                    for (int q = 0; q < 4; ++q) { f2v g2; g2.x = bflo(gw[q]); g2.y = bfhi(gw[q]); const pg8::f32x4 a4 = acc[ai][bj][m][q >> 1];
                        f2v a2; if (q & 1) { a2.x = a4.z; a2.y = a4.w; } else { a2.x = a4.x; a2.y = a4.y; } const f2v p = a2 * g2; o[q] = pg8::cvt_pk_bf16(p.x, p.y); }
                    v4u w; w.x = o[0]; w.y = o[1]; w.z = o[2]; w.w = o[3];
                    *(v4u*)(MRG + (size_t)(row0 + ai * 128 + m * 16) * 1024 + col0 + bj * 128) = w; }
            asm volatile("" ::: "memory");
        }
    }
};

struct EpiResid {
    static constexpr bool PERM = false, HOOK = false, DUPME = false;
    const float* res; float* out;
    __device__ __forceinline__ void operator()(ACC_T, const Unit& u, int wr, int wc, int fr, int fq) const {
        const int row0 = u.pm * 256 + wr * 64 + fr, col0 = u.pn * 256 + wc * 32 + 4 * fq;
#pragma unroll
        for (int ai = 0; ai < 2; ++ai)
#pragma unroll
            for (int m = 0; m < 4; ++m) { const size_t off = (size_t)(row0 + ai * 128 + m * 16) * 1024 + col0;
#pragma unroll
                for (int bj = 0; bj < 2; ++bj)
#pragma unroll
                    for (int n = 0; n < 2; ++n) { const f32x4 r = *(const f32x4*)(res + off + bj * 128 + n * 16); *(f32x4*)(out + off + bj * 128 + n * 16) = r * ALPHA + acc[ai][bj][m][n]; } }
    }
};

struct EpiSwiglu {
    static constexpr bool PERM = true, HOOK = false, DUPME = false;
    bf16_t* H; int ldh;
    __device__ __forceinline__ void operator()(ACC_T, const Unit& u, int wr, int wc, int fr, int fq) const {
        const int row0 = u.pm * 256 + wr * 64 + fr, col0 = u.pn * 128 + wc * 16 + 4 * fq;
#pragma unroll
        for (int ai = 0; ai < 2; ++ai)
#pragma unroll
            for (int m = 0; m < 4; ++m) { bf16_t* rowp = H + (size_t)(row0 + ai * 128 + m * 16) * ldh + col0;
#pragma unroll
                for (int bj = 0; bj < 2; ++bj) { const f32x4 a = acc[ai][bj][m][0], b = acc[ai][bj][m][1];
                    const f2v o01 = fsilu2(__builtin_shufflevector(a, a, 0, 1)) * __builtin_shufflevector(b, b, 0, 1), o23 = fsilu2(__builtin_shufflevector(a, a, 2, 3)) * __builtin_shufflevector(b, b, 2, 3);
                    v2u w; w.x = pg8::cvt_pk_bf16(o01.x, o01.y); w.y = pg8::cvt_pk_bf16(o23.x, o23.y);
                    *(v2u*)(rowp + bj * 64) = w; } }
    }
};

struct MoeTiles {
    int cnt[NEXP]; int toff[NEXP + 1];
    __device__ __forceinline__ void init(const gu32* ctl) {
        int t = 0;
#pragma unroll
        for (int e = 0; e < NEXP; ++e) { cnt[e] = __builtin_amdgcn_readfirstlane((int)__hip_atomic_load(ctl + CW_CNT + 64 * e, RLX_AGENT)); toff[e] = t; t += (cnt[e] + 255) >> 8; }
        toff[NEXP] = t;
    }
    __device__ __forceinline__ void find(int pm, int& e, int& slot0, int& n) const {
        int ee = 0;
#pragma unroll
        for (int j = 1; j < NEXP; ++j) if (pm >= toff[j]) ee = j;
        int c = 0, t0 = 0;
#pragma unroll
        for (int j = 0; j < NEXP; ++j) if (j == ee) { c = cnt[j]; t0 = toff[j]; }
        e = ee; slot0 = (pm - t0) * 256; n = c;
    }
    __device__ __forceinline__ int nfull_total() const { int a = 0;
#pragma unroll
        for (int j = 0; j < NEXP; ++j) a += cnt[j] >> 8;
        return a; }
    __device__ __forceinline__ void findfull(int pmf, int& e, int& lt, int& htile) const {
        int a = 0, ee = 0, ll = 0, hh = 0;
#pragma unroll
        for (int j = 0; j < NEXP; ++j) { const int nf = cnt[j] >> 8; if (pmf >= a && pmf < a + nf) { ee = j; ll = pmf - a; hh = toff[j] + ll; } a += nf; }
        e = ee; lt = ll; htile = hh;
    }
    __device__ __forceinline__ void expert(int e, int& c, int& t0) const { int cc = 0, tt = 0;
#pragma unroll
        for (int j = 0; j < NEXP; ++j) if (j == e) { cc = cnt[j]; tt = toff[j]; }
        c = cc; t0 = tt; }
};
struct MoeUpSched : pg8::TileOrder {
    static constexpr bool GATHER = true;
    const unsigned char* A; const unsigned char* Bt; const unsigned* list; MoeTiles mt;
    __device__ __forceinline__ const char* abase(const Unit&) const { return (const char*)A; }
    __device__ __forceinline__ void aoffs_load(const Unit& u, const int (&R)[2], PG8_LAS unsigned* scr) const {
        int e, s0, n; mt.find(u.pm, e, s0, n);
#pragma unroll
        for (int h = 0; h < 2; ++h)
#pragma unroll
            for (int i = 0; i < 2; ++i) { int slot = s0 + R[i] + h * 128; slot = slot < 16383 ? slot : 16383;
                __builtin_amdgcn_global_load_lds(list + e * 16384 + slot, scr + (h * 2 + i) * 64, 4, 0, 0); }
    }
    __device__ __forceinline__ void aoffs_fin(const Unit& u, const int (&R)[2], const int (&C)[2], const PG8_LAS unsigned* scr, int lane, unsigned (&o)[2][2]) const {
        int e, s0, n; mt.find(u.pm, e, s0, n);
#pragma unroll
        for (int h = 0; h < 2; ++h)
#pragma unroll
            for (int i = 0; i < 2; ++i) { const int slot = s0 + R[i] + h * 128; const unsigned w = scr[(h * 2 + i) * 64 + lane]; const unsigned tok = slot < n ? (w & 0x7fffffffu) : 0u; o[h][i] = tok * 1024u + 2u * (unsigned)C[i]; }
    }
    __device__ __forceinline__ const char* bbase(const Unit& u) const { int e, s0, n; mt.find(u.pm, e, s0, n); return (const char*)Bt + ((size_t)e * (2 * DFF_E) + (size_t)u.pn * 256) * 1024; }
};
struct MoeDownSched : pg8::TileOrder {
    static constexpr bool GATHER = false;
    const unsigned char* A; const unsigned char* Bt; MoeTiles mt;
    __device__ __forceinline__ const char* abase(const Unit& u) const { int e, lt, ht; mt.findfull(u.pm, e, lt, ht); return (const char*)A + (size_t)ht * 256 * DFF_E; }
    __device__ __forceinline__ void aoffs_load(const Unit&, const int (&)[2], PG8_LAS unsigned*) const {}
    __device__ __forceinline__ void aoffs_fin(const Unit&, const int (&)[2], const int (&)[2], const PG8_LAS unsigned*, int, unsigned (&)[2][2]) const {}
    __device__ __forceinline__ const char* bbase(const Unit& u) const { int e, lt, ht; mt.findfull(u.pm, e, lt, ht); return (const char*)Bt + ((size_t)e * 1024 + (size_t)u.pn * 256) * DFF_E; }
};
struct EpiSwiglu8 {
    static constexpr bool PERM = true, HOOK = false, DUPME = false;
    unsigned char* H; int ldh;
    static __device__ __forceinline__ f2v swi8x2(f2v a, f2v b) {
        f2v e; e.x = __builtin_amdgcn_exp2f(-a.x); e.y = __builtin_amdgcn_exp2f(-a.y); const f2v d = e + 1.0f; f2v r; r.x = __builtin_amdgcn_rcpf(d.x); r.y = __builtin_amdgcn_rcpf(d.y); return (a * b) * r; }
    static __device__ __forceinline__ float swi8(float a, float b) { return (a * b) * __builtin_amdgcn_rcpf(1.0f + __builtin_amdgcn_exp2f(-a)); }
    __device__ __forceinline__ void operator()(ACC_T, const Unit& u, int wr, int wc, int fr, int fq) const {
        const int row0 = u.pm * 256 + wr * 64 + fr, col0 = u.pn * 128 + wc * 16;
#pragma unroll
        for (int ai = 0; ai < 2; ++ai)
#pragma unroll
            for (int bj = 0; bj < 2; ++bj) { unsigned x[4];
#pragma unroll
                for (int m = 0; m < 4; ++m) { const f32x4 a = acc[ai][bj][m][0], b = acc[ai][bj][m][1];
                    const f2v o01 = swi8x2(__builtin_shufflevector(a, a, 0, 1), __builtin_shufflevector(b, b, 0, 1)), o23 = swi8x2(__builtin_shufflevector(a, a, 2, 3), __builtin_shufflevector(b, b, 2, 3));
                    x[m] = pk4_fp8(o01.x, o01.y, o23.x, o23.y); }
                const auto p01 = __builtin_amdgcn_permlane16_swap(x[0], x[1], false, false), p23 = __builtin_amdgcn_permlane16_swap(x[2], x[3], false, false);
                const auto q02 = __builtin_amdgcn_permlane32_swap(p01[0], p23[0], false, false), q13 = __builtin_amdgcn_permlane32_swap(p01[1], p23[1], false, false);
                v4u w; w.x = q02[0]; w.y = q13[0]; w.z = q02[1]; w.w = q13[1];
                *(v4u*)(H + (size_t)(row0 + ai * 128 + fq * 16) * ldh + col0 + bj * 64) = w; }
    }
};
struct EpiMoeDown {
    static constexpr bool PERM = true, HOOK = false, DUPME = false;
    bf16_t* c0; bf16_t* c1; const unsigned* list; const float* gatew; MoeTiles mt;
    __device__ __forceinline__ void operator()(ACC_T, const Unit& u, int wr, int wc, int fr, int fq) const {
        int e, lt, ht; mt.findfull(u.pm, e, lt, ht); const int s0 = lt * 256;
        const int col0 = u.pn * 256 + wc * 32 + 8 * fq;
        unsigned ent[2][4]; float gg[2][4];
#pragma unroll
        for (int ai = 0; ai < 2; ++ai)
#pragma unroll
            for (int m = 0; m < 4; ++m) { const int slot = s0 + ai * 128 + wr * 64 + m * 16 + fr; ent[ai][m] = list[e * 16384 + slot]; gg[ai][m] = gatew[e * 16384 + slot]; }
#pragma unroll
        for (int ai = 0; ai < 2; ++ai)
#pragma unroll
            for (int m = 0; m < 4; ++m) { const float g = gg[ai][m];
                bf16_t* dst = ((ent[ai][m] >> 31) ? c1 : c0) + (size_t)(ent[ai][m] & 0x7fffffffu) * 1024 + col0;
#pragma unroll
                for (int bj = 0; bj < 2; ++bj) { const pg8::f32x4 a = acc[ai][bj][m][0] * g, b = acc[ai][bj][m][1] * g;
                    v4u w; w.x = pg8::cvt_pk_bf16(a[0], a[1]); w.y = pg8::cvt_pk_bf16(a[2], a[3]); w.z = pg8::cvt_pk_bf16(b[0], b[1]); w.w = pg8::cvt_pk_bf16(b[2], b[3]);
                    *(v4u*)(dst + bj * 128) = w; } }
    }
};

struct Frame {
    LAS unsigned char* lds;
    volatile LAS unsigned* MISC;
    gu32* ctl;
    int tid, lane, wave;
    int vcu, G;
    unsigned char* ws;
};
__device__ __forceinline__ float wave_sum(float v) {
#pragma unroll
    for (int o = 1; o < 64; o <<= 1) v += __shfl_xor(v, o);
    return v;
}

__device__ __forceinline__ int mapcol(int kind, int dff, int v) {
    if (kind == 0) return v;
    if (kind == 1) {
        if (v < 512) { const int w = v & 63; return (v & ~63) + 32 * ((w >> 2) & 1) + 4 * (w >> 3) + (w & 3); }
        return v < FL_COL ? v : v + 8;
    }
    const int tile = v >> 8, vl = v & 255, n = (vl >> 2) & 1, j = tile * 128 + (vl >> 3) * 4 + (vl & 3);
    return n ? dff + j : j;
}
__device__ __forceinline__ void cvt_item(const float* W, int Nsrc, bf16* dst, int dpitch, int koff, int kind, int dff, int k0, int v0, LAS float* scr, int lane, float f8scale, int vbase) {
    const int v4 = lane & 15, kq = lane >> 4;
    const float* src = W + (size_t)(k0 + kq) * Nsrc + mapcol(kind, dff, vbase + v0 + 4 * v4);
    f32x4 t[16];
#pragma unroll
    for (int it = 0; it < 16; ++it) t[it] = *(const f32x4*)(src + (size_t)(4 * it) * Nsrc);
#pragma unroll
    for (int it = 0; it < 16; ++it) *(LAS f32x4*)(scr + (kq + 4 * it) * 68 + 4 * v4) = t[it];
    LDS_WAIT(); asm volatile("" ::: "memory");
    if (f8scale != 0.f) {
        const int c = lane & 3; unsigned char* d8 = (unsigned char*)dst;
        if (kind == 2) f8scale *= (lane & 16) ? SWI_B : SWI_A;
#pragma unroll
        for (int j = 0; j < 4; ++j) { const int n = (lane >> 2) + 16 * j; const LAS float* s = scr + (16 * c) * 68 + n;
            v4u o; o.x = pk4_fp8(s[0 * 68] * f8scale, s[1 * 68] * f8scale, s[2 * 68] * f8scale, s[3 * 68] * f8scale); o.y = pk4_fp8(s[4 * 68] * f8scale, s[5 * 68] * f8scale, s[6 * 68] * f8scale, s[7 * 68] * f8scale);
            o.z = pk4_fp8(s[8 * 68] * f8scale, s[9 * 68] * f8scale, s[10 * 68] * f8scale, s[11 * 68] * f8scale); o.w = pk4_fp8(s[12 * 68] * f8scale, s[13 * 68] * f8scale, s[14 * 68] * f8scale, s[15 * 68] * f8scale);
            *(GAS v4u*)(d8 + (size_t)(v0 + n) * dpitch + koff + k0 + 16 * c) = o; }
    } else {
    const int c = lane & 7;
#pragma unroll
    for (int j = 0; j < 8; ++j) { const int n = (lane >> 3) + 8 * j; const LAS float* s = scr + (8 * c) * 68 + n;
        v4u o; o.x = pk2(s[0 * 68], s[1 * 68]); o.y = pk2(s[2 * 68], s[3 * 68]); o.z = pk2(s[4 * 68], s[5 * 68]); o.w = pk2(s[6 * 68], s[7 * 68]);
        *(GAS v4u*)(dst + (size_t)(v0 + n) * dpitch + koff + k0 + 8 * c) = o; }
    }
    LDS_WAIT(); asm volatile("" ::: "memory");
}
struct CvtJob { const float* W; int K, Nsrc, Nv; bf16* dst; int dpitch, koff, kind, dff; float f8scale; int vbase = 0; };
__device__ __forceinline__ bool cvt_run(const CvtJob& j, int& r, LAS float* scr, int lane) {
    const int nvb = j.Nv / 64, items = (j.K / 64) * nvb;
    if (r >= items) { r -= items; return false; }
    cvt_item(j.W, j.Nsrc, j.dst, j.dpitch, j.koff, j.kind, j.dff, 64 * (r / nvb), 64 * (r % nvb), scr, lane, j.f8scale, j.vbase);
    return true;
}

__device__ __forceinline__ float row_dot8(const f32x4 (&v)[4], const LAS float* wT, int lane) {
    float p[8];
#pragma unroll
    for (int h = 0; h < 8; ++h) { float s = 0.f;
#pragma unroll
        for (int j = 0; j < 4; ++j) { const f32x4 w = *(const LAS f32x4*)(wT + h * 1024 + 256 * j + 4 * lane); s += (v[j].x * w.x + v[j].y * w.y) + (v[j].z * w.z + v[j].w * w.w); }
        p[h] = s; }
    const bool b0 = lane & 1, b1 = lane & 2, b2 = lane & 4;
    float q[4], r[2];
#pragma unroll
    for (int k = 0; k < 4; ++k) { const float a = p[2 * k], b = p[2 * k + 1]; q[k] = (b0 ? b : a) + __shfl_xor(b0 ? a : b, 1); }
#pragma unroll
    for (int k = 0; k < 2; ++k) { const float a = q[2 * k], b = q[2 * k + 1]; r[k] = (b1 ? b : a) + __shfl_xor(b1 ? a : b, 2); }
    float t = (b2 ? r[1] : r[0]) + __shfl_xor(b2 ? r[0] : r[1], 4);
    t += __shfl_xor(t, 8); t += __shfl_xor(t, 16); t += __shfl_xor(t, 32);
    return t;
}
__device__ __forceinline__ void stage_w8(Frame& F, const float* W, int pitch, int col0) {
    LAS float* wT = (LAS float*)(F.lds + RING_OFF);
    float t[16];
#pragma unroll
    for (int k = 0; k < 16; ++k) { const int i = F.tid + 512 * k, d = i >> 3, h = i & 7; t[k] = W[(size_t)d * pitch + col0 + h]; }
#pragma unroll
    for (int k = 0; k < 16; ++k) { const int i = F.tid + 512 * k, d = i >> 3, h = i & 7; wT[h * 1024 + d] = t[k]; }
    LDS_WAIT(); __syncthreads();
}
__device__ __forceinline__ float log_sigmoid(float x) {
    const float y = __builtin_amdgcn_exp2f(-fabsf(x) * LOG2E); const float l = (y < 1e-2f) ? y * (1.f - y * (0.5f - y * 0.33333334f)) : __builtin_amdgcn_logf(1.f + y) * 0.6931471805599453f;
    return fminf(x, 0.f) - l; }

__device__ __forceinline__ void p0_rows(Frame& F, const float* x, const float* w_in0, const float* fox_b) {
    stage_w8(F, w_in0, N_INSRC, FL_COL);
    const LAS float* wT = (const LAS float*)(F.lds + RING_OFF);
    const int gw = F.vcu * NWAVES + F.wave, NGW = F.G * NWAVES;
    bf16* XB = (bf16*)(F.ws + WS_XB); float* LOGF = (float*)(F.ws + WS_LOGF);
    f32x4 nx[4];
    if (gw < M) {
#pragma unroll
        for (int j = 0; j < 4; ++j) nx[j] = *((const GAS f32x4*)(x + (size_t)gw * D) + F.lane + 64 * j); }
#pragma unroll 1
    for (int m = gw; m < M; m += NGW) {
        f32x4 v[4];
#pragma unroll
        for (int j = 0; j < 4; ++j) v[j] = nx[j];
        if (m + NGW < M) {
#pragma unroll
            for (int j = 0; j < 4; ++j) nx[j] = *((const GAS f32x4*)(x + (size_t)(m + NGW) * D) + F.lane + 64 * j); }
        GAS unsigned long long* o8 = (GAS unsigned long long*)(XB + (size_t)m * D) + F.lane;
#pragma unroll
        for (int j = 0; j < 4; ++j) o8[64 * j] = (unsigned long long)pk2(v[j].x, v[j].y) | ((unsigned long long)pk2(v[j].z, v[j].w) << 32);
#if GATES_FP8 == 2
#pragma unroll
        for (int j = 0; j < 4; ++j) *((GAS unsigned*)(F.ws + WS_X8IN + (size_t)m * D) + F.lane + 64 * j) = pk4_fp8(v[j].x * SC_X8, v[j].y * SC_X8, v[j].z * SC_X8, v[j].w * SC_X8);
#endif
        const float r = row_dot8(v, wT, F.lane);
        if (F.lane < 8) LOGF[(size_t)m * 8 + F.lane] = log_sigmoid(r + fox_b[F.lane]);
    }
    __syncthreads();
}

template <int AUX>
__device__ __forceinline__ void ln_pass(Frame& F, const float* src, float src_scale, const bf16* addb1, const bf16* addb2, const float* g, const float* b, float* outf, bf16* outb, unsigned char* out8,
                                        const float* w8, int w8pitch, int w8col, const float* fox_b, bool grp) {
    if (AUX != 0) stage_w8(F, w8, w8pitch, w8col);
    const LAS float* wT = (const LAS float*)(F.lds + RING_OFF);
    const int gw = F.vcu * NWAVES + F.wave, NGW = F.G * NWAVES;
    f32x4 gv[4], bv[4];
#pragma unroll
    for (int j = 0; j < 4; ++j) { gv[j] = *((const f32x4*)g + F.lane + 64 * j); bv[j] = *((const f32x4*)b + F.lane + 64 * j); }
    int nbuf = 0, r_i1 = 0, r_i2 = 0, r_m = 0; float r_w1 = 0.f;
#define ROUTER_FLUSH() do { const bool vld_ = F.lane < nbuf; const unsigned long long lt_ = (1ull << F.lane) - 1ull; unsigned n_e_ = 0u, rk1_ = 0u, rk2_ = 0u; \
        _Pragma("unroll") for (int e_ = 0; e_ < 8; ++e_) { const unsigned long long b1_ = __ballot(vld_ && r_i1 == e_), b2_ = __ballot(vld_ && r_i2 == e_); \
            const unsigned c1_ = (unsigned)__popcll(b1_), c2_ = (unsigned)__popcll(b2_); if (F.lane == e_) n_e_ = c1_ + c2_; \
            if (r_i1 == e_) rk1_ = (unsigned)__popcll(b1_ & lt_); if (r_i2 == e_) rk2_ = c1_ + (unsigned)__popcll(b2_ & lt_); } \
        unsigned base_ = 0u; if (F.lane < 8 && n_e_ != 0u) base_ = __hip_atomic_fetch_add(F.ctl + CW_CNT + 64 * F.lane, n_e_, RLX_AGENT); \
        const unsigned s1_ = (unsigned)__shfl((int)base_, r_i1) + rk1_, s2_ = (unsigned)__shfl((int)base_, r_i2) + rk2_; \
        if (vld_) { unsigned* list_ = (unsigned*)(F.ws + WS_LIST); float* gw8_ = (float*)(F.ws + WS_GATEW); \
            list_[r_i1 * 16384 + s1_] = (unsigned)r_m; gw8_[r_i1 * 16384 + s1_] = r_w1; list_[r_i2 * 16384 + s2_] = (unsigned)r_m | 0x80000000u; gw8_[r_i2 * 16384 + s2_] = 1.0f - r_w1; } } while (0)
    const int m0 = grp ? (F.vcu >> 5) * SEQ + (F.vcu & 31) * NWAVES + F.wave : gw, mstep = grp ? 32 * NWAVES : NGW, mend = grp ? ((F.vcu >> 5) + 1) * SEQ : M;
    f32x4 nx[4]; v2u na[4], nc[4];
#define LN_LOAD(mm) do { _Pragma("unroll") for (int j = 0; j < 4; ++j) { nx[j] = *((const GAS f32x4*)(src + (size_t)(mm) * D) + F.lane + 64 * j); \
        if (addb1) { na[j] = *((const GAS v2u*)(addb1 + (size_t)(mm) * D) + F.lane + 64 * j); nc[j] = *((const GAS v2u*)(addb2 + (size_t)(mm) * D) + F.lane + 64 * j); } } } while (0)
    if (m0 < mend) LN_LOAD(m0);
#pragma unroll 1
    for (int m = m0; m < mend; m += mstep) {
        f32x4 v[4]; float s = 0.f;
#pragma unroll
        for (int j = 0; j < 4; ++j) { v[j] = nx[j];
            if (addb1) { v[j] = v[j] * src_scale; const v2u a = na[j], c = nc[j];
                v[j].x += bflo(a.x) + bflo(c.x); v[j].y += bfhi(a.x) + bfhi(c.x); v[j].z += bflo(a.y) + bflo(c.y); v[j].w += bfhi(a.y) + bfhi(c.y); }
            s += (v[j].x + v[j].y) + (v[j].z + v[j].w); }
        if (m + mstep < mend) LN_LOAD(m + mstep);
        float lm = s * (1.f / 16.f), m2 = 0.f;
#pragma unroll
        for (int j = 0; j < 4; ++j) { const f32x4 d = v[j] - lm; m2 += (d.x * d.x + d.y * d.y) + (d.z * d.z + d.w * d.w); }
        { float cnt2 = 8.f;
#pragma unroll
          for (int o = 1; o < 64; o <<= 1) { const float om = __shfl_xor(lm, o), o2 = __shfl_xor(m2, o); const float dl = om - lm; m2 = m2 + o2 + dl * dl * cnt2; lm = 0.5f * (lm + om); cnt2 *= 2.f; } }
        const float mean = lm;
#pragma unroll
        for (int j = 0; j < 4; ++j) v[j] = v[j] - mean;
        const float rstd = 1.f / sqrtf(m2 * (1.f / D) + LN_EPS);
#pragma unroll
        for (int j = 0; j < 4; ++j) v[j] = v[j] * rstd * gv[j] + bv[j];
        if (outf) {
#pragma unroll
            for (int j = 0; j < 4; ++j) *((GAS f32x4*)(outf + (size_t)m * D) + F.lane + 64 * j) = v[j]; }
        if (outb) { GAS unsigned long long* o8 = (GAS unsigned long long*)(outb + (size_t)m * D) + F.lane;
#pragma unroll
            for (int j = 0; j < 4; ++j) o8[64 * j] = (unsigned long long)pk2(v[j].x, v[j].y) | ((unsigned long long)pk2(v[j].z, v[j].w) << 32); }
        if (out8) {
#pragma unroll
            for (int j = 0; j < 4; ++j) *((GAS unsigned*)(out8 + (size_t)m * D) + F.lane + 64 * j) = pk4_fp8(v[j].x * SC_X8, v[j].y * SC_X8, v[j].z * SC_X8, v[j].w * SC_X8); }
        if (AUX == 1) {
            const float r = row_dot8(v, wT, F.lane);
            if (F.lane < 8) ((float*)(F.ws + WS_LOGF))[(size_t)m * 8 + F.lane] = log_sigmoid(r + fox_b[F.lane]);
        }
        if (AUX == 2) {
            const float rl = row_dot8(v, wT, F.lane); float lg[8];
#pragma unroll
            for (int e = 0; e < 8; ++e) lg[e] = __shfl(rl, e);
            int i1 = 0; float v1 = lg[0];
#pragma unroll
            for (int e = 1; e < 8; ++e) if (lg[e] > v1) { v1 = lg[e]; i1 = e; }
            int i2 = -1; float v2 = -INFINITY;
#pragma unroll
            for (int e = 0; e < 8; ++e) if (e != i1 && lg[e] > v2) { v2 = lg[e]; i2 = e; }
            const float w1 = 1.0f / (1.0f + expf(v2 - v1));
            if (F.lane == nbuf) { r_i1 = i1; r_i2 = i2; r_w1 = w1; r_m = m; }
            if (++nbuf == 64) { ROUTER_FLUSH(); nbuf = 0; }
        }
    }
    if (AUX == 2) { if (nbuf) { ROUTER_FLUSH(); } }
#undef ROUTER_FLUSH
#undef LN_LOAD
    __syncthreads();
}

__device__ __forceinline__ void split3(float b, unsigned& h, unsigned& m, unsigned& l) { h = f2bf(b); const float r1 = b - bf2f((unsigned short)h); m = f2bf(r1); const float r2 = r1 - bf2f((unsigned short)m); l = f2bf(r2); }
template <bool AUG>
__device__ __forceinline__ void fox_bias_table(Frame& F, int b, int h, LAS float* tab, LAS float* wtot) {
    int tid = threadIdx.x; asm volatile("" : "+v"(tid));
    const int lane = tid & 63, wave = __builtin_amdgcn_readfirstlane(tid >> 6);
    const float* lf = (const float*)(F.ws + WS_LOGF) + (size_t)b * SEQ * 8 + h;
    float v[4];
#pragma unroll
    for (int j = 0; j < 4; ++j) v[j] = lf[(size_t)(4 * tid + j) * 8];
    float sj[4]; sj[0] = v[0]; sj[1] = sj[0] + v[1]; sj[2] = sj[1] + v[2]; sj[3] = sj[2] + v[3];
    float x = sj[3];
#pragma unroll
    for (int o = 1; o < 64; o <<= 1) { const float y = __shfl_up(x, o); if (lane >= o) x += y; }
    __syncthreads();
    if (lane == 63) wtot[wave] = x;
    LDS_WAIT(); __syncthreads();
    float base = 0.f;
#pragma unroll
    for (int w = 0; w < 8; ++w) if (w < wave) base += wtot[w];
    const float ex = base + x - sj[3];
#pragma unroll
    for (int j = 0; j < 4; ++j) { const float bv = -(ex + sj[j]) * LOG2E;
        if (AUG) { unsigned hh, mm, ll; split3(bv, hh, mm, ll); v4u w; w.x = hh | (mm << 16); w.y = ll | (0x3F80u << 16); w.z = 0x3F803F80u; w.w = 0u; ((LAS v4u*)tab)[4 * tid + j] = w; }
        else tab[4 * tid + j] = bv; }
    LDS_WAIT(); __syncthreads();
}

#if 1
__device__ __forceinline__ void naive_fox_row(Frame& F, int b, int h, int t, const LAS float* tab) {
    const bf16* FQ = (const bf16*)(F.ws + WS_FQ); const bf16* FK = (const bf16*)(F.ws + WS_FK); const bf16* FV = (const bf16*)(F.ws + WS_FV); bf16* YB = (bf16*)(F.ws + WS_YB);
    const size_t rb = (size_t)b * SEQ;
    float q[64];
    { const v4u* qp = (const v4u*)(FQ + (rb + t) * 512 + h * 64);
#pragma unroll
      for (int c = 0; c < 8; ++c) { const v4u w = qp[c]; q[8 * c + 0] = bflo(w.x); q[8 * c + 1] = bfhi(w.x); q[8 * c + 2] = bflo(w.y); q[8 * c + 3] = bfhi(w.y); q[8 * c + 4] = bflo(w.z); q[8 * c + 5] = bfhi(w.z); q[8 * c + 6] = bflo(w.w); q[8 * c + 7] = bfhi(w.w); } }
    float mx = -INFINITY, l = 0.f, o = 0.f;
    for (int s0 = 0; s0 <= t; s0 += 64) {
        const int s = s0 + F.lane; float sc = -INFINITY;
        if (s <= t) { const v4u* kp = (const v4u*)(FK + (rb + s) * 512 + h * 64); float a = 0.f;
#pragma unroll
            for (int c = 0; c < 8; ++c) { const v4u w = kp[c]; a += q[8 * c + 0] * bflo(w.x) + q[8 * c + 1] * bfhi(w.x) + q[8 * c + 2] * bflo(w.y) + q[8 * c + 3] * bfhi(w.y) + q[8 * c + 4] * bflo(w.z) + q[8 * c + 5] * bfhi(w.z) + q[8 * c + 6] * bflo(w.w) + q[8 * c + 7] * bfhi(w.w); }
            sc = a + tab[s]; }
        float cm = sc;
#pragma unroll
        for (int of = 1; of < 64; of <<= 1) cm = fmaxf(cm, __shfl_xor(cm, of));
        const float nm = fmaxf(mx, cm), f = __builtin_amdgcn_exp2f(mx - nm); const float p = __builtin_amdgcn_exp2f(sc - nm);
        l = l * f + wave_sum(p); o *= f; mx = nm;
        const int ne = (t - s0 + 1) < 64 ? (t - s0 + 1) : 64;
        for (int j = 0; j < ne; ++j) { const float pj = __shfl(p, j); o += pj * bf2f(FV[(rb + s0 + j) * 512 + h * 64 + F.lane]); }
    }
    YB[(rb + t) * 1536 + 512 + h * 64 + F.lane] = (bf16)f2bf(o / l);
}
__device__ __forceinline__ void naive_ret_row(Frame& F, int b, int h, int t) {
    const bf16* RQ = (const bf16*)(F.ws + WS_RQ); const bf16* RK = (const bf16*)(F.ws + WS_RK); const bf16* RV = (const bf16*)(F.ws + WS_RV); const bf16* RG = (const bf16*)(F.ws + WS_RG); bf16* YB = (bf16*)(F.ws + WS_YB);
    const size_t rb = (size_t)b * SEQ;
    const float l2g = log2f(1.0f - exp2f(-5.0f - (float)h));
    float q[64];
    { const v4u* qp = (const v4u*)(RQ + (rb + t) * 256 + h * 64);
#pragma unroll
      for (int c = 0; c < 8; ++c) { const v4u w = qp[c]; q[8 * c + 0] = bflo(w.x); q[8 * c + 1] = bfhi(w.x); q[8 * c + 2] = bflo(w.y); q[8 * c + 3] = bfhi(w.y); q[8 * c + 4] = bflo(w.z); q[8 * c + 5] = bfhi(w.z); q[8 * c + 6] = bflo(w.w); q[8 * c + 7] = bfhi(w.w); } }
    float o0 = 0.f, o1 = 0.f;
    for (int s0 = 0; s0 <= t; s0 += 64) {
        const int s = s0 + F.lane; float sc = 0.f;
        if (s <= t) { const v4u* kp = (const v4u*)(RK + (rb + s) * 256 + h * 64); float a = 0.f;
#pragma unroll
            for (int c = 0; c < 8; ++c) { const v4u w = kp[c]; a += q[8 * c + 0] * bflo(w.x) + q[8 * c + 1] * bfhi(w.x) + q[8 * c + 2] * bflo(w.y) + q[8 * c + 3] * bfhi(w.y) + q[8 * c + 4] * bflo(w.z) + q[8 * c + 5] * bfhi(w.z) + q[8 * c + 6] * bflo(w.w) + q[8 * c + 7] * bfhi(w.w); }
            sc = a * exp2f(l2g * (float)(t - s)); }
        const int ne = (t - s0 + 1) < 64 ? (t - s0 + 1) : 64;
        for (int j = 0; j < ne; ++j) { const float pj = __shfl(sc, j); const bf16* vp = RV + (rb + s0 + j) * 512 + h * 128; o0 += pj * bf2f(vp[F.lane]); o1 += pj * bf2f(vp[F.lane + 64]); }
    }
    const float mean = wave_sum(o0 + o1) * (1.f / 128.f); const float d0 = o0 - mean, d1 = o1 - mean;
    const float rstd = 1.f / sqrtf(wave_sum(d0 * d0 + d1 * d1) * (1.f / 128.f) + GN_EPS);
    const bf16* gp = RG + (rb + t) * 512 + h * 128; bf16* yp = YB + (rb + t) * 1536 + h * 128;
    yp[F.lane] = (bf16)f2bf(bf2f(gp[F.lane]) * d0 * rstd); yp[F.lane + 64] = (bf16)f2bf(bf2f(gp[F.lane + 64]) * d1 * rstd);
}
__device__ __forceinline__ void naive_gmlp_unit(Frame& F, int b, int n, int g, const float* w_s, const float* b_s, const float* lng, const float* lnb) {
    const bf16* GU = (const bf16*)(F.ws + WS_GU); const bf16* GV = (const bf16*)(F.ws + WS_GV); bf16* YB = (bf16*)(F.ws + WS_YB);
    LAS float* st = (LAS float*)(F.lds + RING_OFF);
    const size_t r0 = (size_t)b * SEQ + n * 128;
    __syncthreads();
    for (int r = F.wave; r < 128; r += NWAVES) {
        const v4u w = *((const v4u*)(GV + (r0 + r) * 512) + F.lane);
        float x[8] = {bflo(w.x), bfhi(w.x), bflo(w.y), bfhi(w.y), bflo(w.z), bfhi(w.z), bflo(w.w), bfhi(w.w)};
        float s = 0.f;
#pragma unroll
        for (int j = 0; j < 8; ++j) s += x[j];
        const float mean = wave_sum(s) * (1.f / 512.f); float s2 = 0.f;
#pragma unroll
        for (int j = 0; j < 8; ++j) { const float d = x[j] - mean; s2 += d * d; }
        const float rstd = 1.f / sqrtf(wave_sum(s2) * (1.f / 512.f) + LN_EPS);
        if (F.lane == 0) { st[2 * r] = mean; st[2 * r + 1] = rstd; }
    }
    LDS_WAIT(); __syncthreads();
    const int c = F.tid & 127; const float gam = lng[g * 128 + c], bet = lnb[g * 128 + c];
    for (int i = F.tid >> 7; i < 128; i += 4) {
        float a = 0.f; const float* wr = w_s + ((size_t)g * 128 + i) * 128;
        for (int j = 0; j <= i; ++j) { const float vn = (bf2f(GV[(r0 + j) * 512 + g * 128 + c]) - st[2 * j]) * st[2 * j + 1] * gam + bet; a += wr[j] * vn; }
        const float sp = a + b_s[g * 128 + i];
        YB[(r0 + i) * 1536 + 1024 + g * 128 + c] = (bf16)f2bf(bf2f(GU[(r0 + i) * 512 + g * 128 + c]) * sp);
    }
    __syncthreads();
}
#endif

__device__ __forceinline__ GAS void* lds_ptr(LAS unsigned char* lds, int k) {
    const v2u w = *(const LAS v2u*)(lds + PTAB_OFF + 8 * k);
    const unsigned lo = __builtin_amdgcn_readfirstlane(w.x), hi = __builtin_amdgcn_readfirstlane(w.y);
    return (GAS void*)(((unsigned long long)hi << 32) | lo);
}

typedef short bf16x8_t __attribute__((ext_vector_type(8)));
typedef float f32x16_t __attribute__((ext_vector_type(16)));
#define MFMA32(a, b, c) __builtin_amdgcn_mfma_f32_32x32x16_bf16((a), (b), (c), 0, 0, 0)
__device__ __forceinline__ bf16x8_t ldfrag(const LAS bf16* base, int row, int pitch, int kk, int h2) { return *(const LAS bf16x8_t*)(base + row * pitch + 16 * kk + 8 * h2); }
__device__ __forceinline__ int crow32(int reg, int h2) { return (reg & 3) + 8 * (reg >> 2) + 4 * h2; }
constexpr int RP128 = 136, RP64 = 72;
constexpr int R_QS = 0, R_KS = 4608, R_KDT = 23040, R_VT = 40448, R_SS = 75264, R_ST = 83968, R_OS = 102400, R_END = 119296;
static_assert(R_END <= RING_BYTES, "retention LDS map");
__device__ __forceinline__ void unpack8(const v4u w, float (&x)[8]) { x[0] = bflo(w.x); x[1] = bfhi(w.x); x[2] = bflo(w.y); x[3] = bfhi(w.y); x[4] = bflo(w.z); x[5] = bfhi(w.z); x[6] = bflo(w.w); x[7] = bfhi(w.w); }

__device__ __forceinline__ void ret_unit(Frame& F, int b, int h, int rq) {
    int tid_ = threadIdx.x; asm volatile("" : "+v"(tid_));
    const int tid = tid_, lane = tid & 63, wid = __builtin_amdgcn_readfirstlane(tid >> 6), r = lane & 31, h2 = lane >> 5;
    const float l2g = log2f(1.0f - exp2f(-5.0f - (float)h));
    const float chunk_dec = exp2f(l2g * 128.0f);
    LAS bf16* Qs = (LAS bf16*)(F.lds + RING_OFF + R_QS); LAS bf16* Ks = (LAS bf16*)(F.lds + RING_OFF + R_KS); LAS bf16* KdT = (LAS bf16*)(F.lds + RING_OFF + R_KDT);
    LAS bf16* VT = (LAS bf16*)(F.lds + RING_OFF + R_VT); LAS bf16* Ss = (LAS bf16*)(F.lds + RING_OFF + R_SS); LAS bf16* ST = (LAS bf16*)(F.lds + RING_OFF + R_ST);
    LAS float* Os = (LAS float*)(F.lds + RING_OFF + R_OS);
    const bf16* RQ = (const bf16*)(F.ws + WS_RQ); const bf16* RK = (const bf16*)(F.ws + WS_RK); const bf16* RV = (const bf16*)(F.ws + WS_RV); const bf16* RG = (const bf16*)(F.ws + WS_RG); bf16* YB = (bf16*)(F.ws + WS_YB);
    const size_t rb = (size_t)b * SEQ;
    __syncthreads();
    for (int i = tid; i < 128 * RP64 / 2; i += NWAVES * 64) ((LAS unsigned*)ST)[i] = 0u;
    f32x16_t st = {0.f, 0.f, 0.f, 0.f, 0.f, 0.f, 0.f, 0.f, 0.f, 0.f, 0.f, 0.f, 0.f, 0.f, 0.f, 0.f};
    const int sj = tid & 127, cq = tid >> 7, qi = tid & 31, qc = tid >> 5, gi = tid >> 4, gs = tid & 15;
    v4u qreg = {0u, 0u, 0u, 0u}, kreg[2], vreg[4], greg;
#define RET_LOAD(n) do { const size_t r0_ = rb + (size_t)(n) * 128; \
        if (tid < 256) qreg = *(const v4u*)(RQ + (r0_ + 32 * rq + qi) * 256 + h * 64 + 8 * qc); \
        _Pragma("unroll") for (int c_ = 0; c_ < 2; ++c_) kreg[c_] = *(const v4u*)(RK + (r0_ + sj) * 256 + h * 64 + 16 * cq + 8 * c_); \
        _Pragma("unroll") for (int c_ = 0; c_ < 4; ++c_) vreg[c_] = *(const v4u*)(RV + (r0_ + sj) * 512 + h * 128 + 32 * cq + 8 * c_); \
        greg = *(const v4u*)(RG + (r0_ + 32 * rq + gi) * 512 + h * 128 + 8 * gs); } while (0)
    RET_LOAD(0);
    const float kdec = exp2f(l2g * (float)(127 - sj));
#pragma unroll 1
    for (int n = 0; n < 16; ++n) {
        if (tid < 256) *(LAS v4u*)(Qs + qi * RP64 + 8 * qc) = qreg;
#pragma unroll
        for (int c = 0; c < 2; ++c) { *(LAS v4u*)(Ks + sj * RP64 + 16 * cq + 8 * c) = kreg[c]; float x[8]; unpack8(kreg[c], x);
#pragma unroll
            for (int e = 0; e < 8; ++e) KdT[(16 * cq + 8 * c + e) * RP128 + sj] = (bf16)f2bf(x[e] * kdec); }
#pragma unroll
        for (int c = 0; c < 4; ++c) { const v4u w = vreg[c]; const unsigned ww[4] = {w.x, w.y, w.z, w.w};
#pragma unroll
            for (int e = 0; e < 8; ++e) VT[(32 * cq + 8 * c + e) * RP128 + sj] = (bf16)((e & 1) ? (ww[e >> 1] >> 16) : (ww[e >> 1] & 0xffffu)); }
        const v4u gcur = greg;
        LDS_WAIT(); __syncthreads();
        if (n + 1 < 16) RET_LOAD(n + 1);
        f32x16_t x = {0.f, 0.f, 0.f, 0.f, 0.f, 0.f, 0.f, 0.f, 0.f, 0.f, 0.f, 0.f, 0.f, 0.f, 0.f, 0.f};
        if (wid < 4) {
#pragma unroll
            for (int kk = 0; kk < 4; ++kk) x = MFMA32(ldfrag(Qs, r, RP64, kk, h2), ldfrag(Ks, 32 * wid + r, RP64, kk, h2), x);
            const int jabs = 32 * wid + r;
#pragma unroll
            for (int reg = 0; reg < 16; ++reg) { const int i = crow32(reg, h2), diff = 32 * rq + i - jabs;
                const float val = diff >= 0 ? x[reg] * exp2f(l2g * (float)diff) : 0.f; Ss[i * RP128 + jabs] = (bf16)f2bf(val); }
        } else {
#pragma unroll
            for (int kk = 0; kk < 4; ++kk) x = MFMA32(ldfrag(Qs, r, RP64, kk, h2), ldfrag(ST, 32 * (wid - 4) + r, RP64, kk, h2), x);
#pragma unroll
            for (int reg = 0; reg < 16; ++reg) x[reg] *= exp2f(l2g * (float)(32 * rq + crow32(reg, h2) + 1));
        }
        { const int db = wid >> 2, vb2 = wid & 3;
#pragma unroll
          for (int reg = 0; reg < 16; ++reg) st[reg] *= chunk_dec;
#pragma unroll
          for (int kk = 0; kk < 8; ++kk) st = MFMA32(ldfrag(KdT, 32 * db + r, RP128, kk, h2), ldfrag(VT, 32 * vb2 + r, RP128, kk, h2), st); }
        LDS_WAIT(); __syncthreads();
        { const int db = wid >> 2, vb2 = wid & 3;
#pragma unroll
          for (int g = 0; g < 4; ++g) { v2u w; w.x = pk2(st[4 * g], st[4 * g + 1]); w.y = pk2(st[4 * g + 2], st[4 * g + 3]); *(LAS v2u*)(ST + (32 * vb2 + r) * RP64 + 32 * db + 8 * g + 4 * h2) = w; } }
        if (wid >= 4) {
#pragma unroll
            for (int kk = 0; kk < 8; ++kk) x = MFMA32(ldfrag(Ss, r, RP128, kk, h2), ldfrag(VT, 32 * (wid - 4) + r, RP128, kk, h2), x);
#pragma unroll
            for (int reg = 0; reg < 16; ++reg) Os[crow32(reg, h2) * 132 + 32 * (wid - 4) + r] = x[reg];
        }
        LDS_WAIT(); __syncthreads();
        { const f32x4 a0 = *(const LAS f32x4*)(Os + gi * 132 + 8 * gs), a1 = *(const LAS f32x4*)(Os + gi * 132 + 8 * gs + 4);
          float sm = (a0.x + a0.y) + (a0.z + a0.w) + (a1.x + a1.y) + (a1.z + a1.w);
#pragma unroll
          for (int o = 1; o < 16; o <<= 1) sm += __shfl_xor(sm, o);
          const float mean = sm * (1.f / 128.f); const f32x4 d0 = a0 - mean, d1 = a1 - mean;
          float sq = (d0.x * d0.x + d0.y * d0.y) + (d0.z * d0.z + d0.w * d0.w) + (d1.x * d1.x + d1.y * d1.y) + (d1.z * d1.z + d1.w * d1.w);
#pragma unroll
          for (int o = 1; o < 16; o <<= 1) sq += __shfl_xor(sq, o);
          const float rstd = 1.f / sqrtf(sq * (1.f / 128.f) + GN_EPS); float gt[8]; unpack8(gcur, gt);
          v4u w; w.x = pk2(gt[0] * d0.x * rstd, gt[1] * d0.y * rstd); w.y = pk2(gt[2] * d0.z * rstd, gt[3] * d0.w * rstd); w.z = pk2(gt[4] * d1.x * rstd, gt[5] * d1.y * rstd); w.w = pk2(gt[6] * d1.z * rstd, gt[7] * d1.w * rstd);
          *(v4u*)(YB + (rb + (size_t)n * 128 + 32 * rq + gi) * 1536 + h * 128 + 8 * gs) = w; }
    }
#undef RET_LOAD
    __syncthreads();
}


#define MFMA16(a, b, c) __builtin_amdgcn_mfma_f32_16x16x32_bf16((a), (b), (c), 0, 0, 0)
__device__ __forceinline__ bf16x8_t ldfrag16(const LAS bf16* base, int row, int pitch, int ks, int q4) { return *(const LAS bf16x8_t*)(base + row * pitch + 32 * ks + 8 * q4); }
__device__ __forceinline__ void ret_kv_unit(Frame& F, int b, int h, int n) {
    int tid_ = threadIdx.x; asm volatile("" : "+v"(tid_));
    const int tid = tid_, lane = tid & 63, wid = __builtin_amdgcn_readfirstlane(tid >> 6), r = lane & 31, h2 = lane >> 5;
    const float l2g = log2f(1.0f - exp2f(-5.0f - (float)h));
    LAS bf16* KdT = (LAS bf16*)(F.lds + RING_OFF); LAS bf16* VT = (LAS bf16*)(F.lds + RING_OFF + 17408);
    const bf16* RK = (const bf16*)(F.ws + WS_RK); const bf16* RV = (const bf16*)(F.ws + WS_RV);
    const size_t r0 = (size_t)b * SEQ + (size_t)n * 128;
    const int sj = tid & 127, cq = tid >> 7; const float kdec = exp2f(l2g * (float)(127 - sj));
    v4u kreg[2], vreg[4];
#pragma unroll
    for (int c = 0; c < 2; ++c) kreg[c] = *(const v4u*)(RK + (r0 + sj) * 256 + h * 64 + 16 * cq + 8 * c);
#pragma unroll
    for (int c = 0; c < 4; ++c) vreg[c] = *(const v4u*)(RV + (r0 + sj) * 512 + h * 128 + 32 * cq + 8 * c);
    __syncthreads();
#pragma unroll
    for (int c = 0; c < 2; ++c) { float x[8]; unpack8(kreg[c], x);
#pragma unroll
        for (int e = 0; e < 8; ++e) KdT[(16 * cq + 8 * c + e) * RP128 + sj] = (bf16)f2bf(x[e] * kdec); }
#pragma unroll
    for (int c = 0; c < 4; ++c) { const v4u w = vreg[c]; const unsigned ww[4] = {w.x, w.y, w.z, w.w};
#pragma unroll
        for (int e = 0; e < 8; ++e) VT[(32 * cq + 8 * c + e) * RP128 + sj] = (bf16)((e & 1) ? (ww[e >> 1] >> 16) : (ww[e >> 1] & 0xffffu)); }
    LDS_WAIT(); __syncthreads();
    const int db = wid >> 2, vb = wid & 3;
    f32x16_t st = {0.f, 0.f, 0.f, 0.f, 0.f, 0.f, 0.f, 0.f, 0.f, 0.f, 0.f, 0.f, 0.f, 0.f, 0.f, 0.f};
#pragma unroll
    for (int kk = 0; kk < 8; ++kk) st = MFMA32(ldfrag(KdT, 32 * db + r, RP128, kk, h2), ldfrag(VT, 32 * vb + r, RP128, kk, h2), st);
    float* KV = (float*)(F.ws + WS_KV) + ((size_t)((b * 4 + h) * 16 + n)) * 8192;
#pragma unroll
    for (int reg = 0; reg < 16; ++reg) KV[(32 * db + crow32(reg, h2)) * 128 + 32 * vb + r] = st[reg];
    __syncthreads();
}
constexpr int RB_QS = 0, RB_KS = 18432, RB_VT = 36864, RB_ST = 71680, RB_SW = 90112, RB_END = 124928;
static_assert(RB_END <= RING_BYTES, "retention pass B LDS map");
__device__ __forceinline__ void ret_out_unit(Frame& F, int b, int h, int n) {
    int tid_ = threadIdx.x; asm volatile("" : "+v"(tid_));
    const int tid = tid_, lane = tid & 63, wid = __builtin_amdgcn_readfirstlane(tid >> 6), l15 = lane & 15, q4 = lane >> 4;
    const float l2g = log2f(1.0f - exp2f(-5.0f - (float)h));
    const float chunk_dec = exp2f(l2g * 128.0f);
    LAS bf16* Qs = (LAS bf16*)(F.lds + RING_OFF + RB_QS); LAS bf16* Ks = (LAS bf16*)(F.lds + RING_OFF + RB_KS); LAS bf16* VT = (LAS bf16*)(F.lds + RING_OFF + RB_VT);
    LAS bf16* ST = (LAS bf16*)(F.lds + RING_OFF + RB_ST); LAS bf16* Sw = (LAS bf16*)(F.lds + RING_OFF + RB_SW) + wid * (16 * RP128);
    const bf16* RQ = (const bf16*)(F.ws + WS_RQ); const bf16* RK = (const bf16*)(F.ws + WS_RK); const bf16* RV = (const bf16*)(F.ws + WS_RV); const bf16* RG = (const bf16*)(F.ws + WS_RG); bf16* YB = (bf16*)(F.ws + WS_YB);
    const size_t r0 = (size_t)b * SEQ + (size_t)n * 128;
    const int sj = tid & 127, cq = tid >> 7;
    v4u qreg[2], kreg[2], vreg[4];
#pragma unroll
    for (int c = 0; c < 2; ++c) { qreg[c] = *(const v4u*)(RQ + (r0 + sj) * 256 + h * 64 + 16 * cq + 8 * c); kreg[c] = *(const v4u*)(RK + (r0 + sj) * 256 + h * 64 + 16 * cq + 8 * c); }
#pragma unroll
    for (int c = 0; c < 4; ++c) vreg[c] = *(const v4u*)(RV + (r0 + sj) * 512 + h * 128 + 32 * cq + 8 * c);
    f32x4 sa[4] = {{0.f, 0.f, 0.f, 0.f}, {0.f, 0.f, 0.f, 0.f}, {0.f, 0.f, 0.f, 0.f}, {0.f, 0.f, 0.f, 0.f}};
    { const float* KV = (const float*)(F.ws + WS_KV) + ((size_t)((b * 4 + h) * 16)) * 8192 + (size_t)tid * 16;
#pragma unroll 4
      for (int m = 0; m < n; ++m) {
#pragma unroll
          for (int c = 0; c < 4; ++c) { const f32x4 kv = *(const f32x4*)(KV + (size_t)m * 8192 + 4 * c); sa[c] = sa[c] * chunk_dec + kv; } } }
    __syncthreads();
    { const int d = tid >> 3, v0 = 16 * (tid & 7);
#pragma unroll
      for (int c = 0; c < 4; ++c)
#pragma unroll
          for (int e = 0; e < 4; ++e) ST[(v0 + 4 * c + e) * RP64 + d] = (bf16)f2bf(sa[c][e]); }
#pragma unroll
    for (int c = 0; c < 2; ++c) { *(LAS v4u*)(Qs + sj * RP64 + 16 * cq + 8 * c) = qreg[c]; *(LAS v4u*)(Ks + sj * RP64 + 16 * cq + 8 * c) = kreg[c]; }
#pragma unroll
    for (int c = 0; c < 4; ++c) { const v4u w = vreg[c]; const unsigned ww[4] = {w.x, w.y, w.z, w.w};
#pragma unroll
        for (int e = 0; e < 8; ++e) VT[(32 * cq + 8 * c + e) * RP128 + sj] = (bf16)((e & 1) ? (ww[e >> 1] >> 16) : (ww[e >> 1] & 0xffffu)); }
    LDS_WAIT(); __syncthreads();
    const int i0 = 16 * wid;
    const bf16x8_t qa0 = ldfrag16(Qs, i0 + l15, RP64, 0, q4), qa1 = ldfrag16(Qs, i0 + l15, RP64, 1, q4);
#pragma unroll 1
    for (int kb = 0; kb <= (wid | 1); kb += 2) {
        f32x4 sc[2];
#pragma unroll
        for (int u = 0; u < 2; ++u) { sc[u] = (f32x4){0.f, 0.f, 0.f, 0.f};
            sc[u] = MFMA16(qa0, ldfrag16(Ks, 16 * (kb + u) + l15, RP64, 0, q4), sc[u]); sc[u] = MFMA16(qa1, ldfrag16(Ks, 16 * (kb + u) + l15, RP64, 1, q4), sc[u]); }
#pragma unroll
        for (int u = 0; u < 2; ++u) { const int j = 16 * (kb + u) + l15;
#pragma unroll
            for (int reg = 0; reg < 4; ++reg) { const int il = 4 * q4 + reg, diff = i0 + il - j; Sw[il * RP128 + j] = (bf16)f2bf(diff >= 0 ? sc[u][reg] * __builtin_amdgcn_exp2f(l2g * (float)diff) : 0.f); } }
    }
    LDS_WAIT();
    float qd[4];
#pragma unroll
    for (int reg = 0; reg < 4; ++reg) qd[reg] = __builtin_amdgcn_exp2f(l2g * (float)(i0 + 4 * q4 + reg + 1));
    f32x4 o[8];
    const int nks = (wid + 2) >> 1;
#pragma unroll
    for (int vb = 0; vb < 8; ++vb) {
        f32x4 x = {0.f, 0.f, 0.f, 0.f};
        x = MFMA16(qa0, ldfrag16(ST, 16 * vb + l15, RP64, 0, q4), x); x = MFMA16(qa1, ldfrag16(ST, 16 * vb + l15, RP64, 1, q4), x);
#pragma unroll
        for (int reg = 0; reg < 4; ++reg) x[reg] *= qd[reg];
        o[vb] = x;
    }
#pragma unroll 1
    for (int ks = 0; ks < nks; ++ks) {
        const bf16x8_t a = ldfrag16(Sw, l15, RP128, ks, q4);
#pragma unroll
        for (int vb = 0; vb < 8; ++vb) o[vb] = MFMA16(a, ldfrag16(VT, 16 * vb + l15, RP128, ks, q4), o[vb]);
    }
    float mean[4], rstd[4];
#pragma unroll
    for (int reg = 0; reg < 4; ++reg) { float sm = 0.f;
#pragma unroll
        for (int vb = 0; vb < 8; ++vb) sm += o[vb][reg];
#pragma unroll
        for (int of = 1; of < 16; of <<= 1) sm += __shfl_xor(sm, of);
        mean[reg] = sm * (1.f / 128.f); float sq = 0.f;
#pragma unroll
        for (int vb = 0; vb < 8; ++vb) { const float d = o[vb][reg] - mean[reg]; sq += d * d; }
#pragma unroll
        for (int of = 1; of < 16; of <<= 1) sq += __shfl_xor(sq, of);
        rstd[reg] = 1.f / sqrtf(sq * (1.f / 128.f) + GN_EPS); }
#pragma unroll
    for (int vb = 0; vb < 8; ++vb)
#pragma unroll
        for (int reg = 0; reg < 4; ++reg) Sw[(4 * q4 + reg) * RP128 + 16 * vb + l15] = (bf16)f2bf((o[vb][reg] - mean[reg]) * rstd[reg]);
    LDS_WAIT();
#pragma unroll
    for (int c = 0; c < 4; ++c) { const int ch = c * 64 + lane, row = ch >> 4, cc = ch & 15;
        float xn[8], gt[8]; unpack8(*(const LAS v4u*)(Sw + row * RP128 + 8 * cc), xn); unpack8(*(const v4u*)(RG + (r0 + i0 + row) * 512 + h * 128 + 8 * cc), gt);
        v4u w; w.x = pk2(xn[0] * gt[0], xn[1] * gt[1]); w.y = pk2(xn[2] * gt[2], xn[3] * gt[3]); w.z = pk2(xn[4] * gt[4], xn[5] * gt[5]); w.w = pk2(xn[6] * gt[6], xn[7] * gt[7]);
        *(v4u*)(YB + (r0 + i0 + row) * 1536 + h * 128 + 8 * cc) = w; }
    __syncthreads();
}

constexpr int G_WS = 0, G_VNT = 34816, G_STAT = 69632, G_END = 70656;
__device__ __forceinline__ void gmlp_unit(Frame& F, int b, int n, int g, const float* w_s, const float* b_s, const float* lng, const float* lnb) {
    int tid_ = threadIdx.x; asm volatile("" : "+v"(tid_));
    const int tid = tid_, lane = tid & 63, wid = __builtin_amdgcn_readfirstlane(tid >> 6), r = lane & 31, h2 = lane >> 5;
    const bf16* GU = (const bf16*)(F.ws + WS_GU); const bf16* GV = (const bf16*)(F.ws + WS_GV); bf16* YB = (bf16*)(F.ws + WS_YB);
    LAS bf16* Ws = (LAS bf16*)(F.lds + RING_OFF + G_WS); LAS bf16* VnT = (LAS bf16*)(F.lds + RING_OFF + G_VNT); LAS float* stt = (LAS float*)(F.lds + RING_OFF + G_STAT);
    const size_t r0 = (size_t)b * SEQ + (size_t)n * 128;
    __syncthreads();
    for (int rr = wid; rr < 128; rr += NWAVES) {
        float x[8]; unpack8(*((const v4u*)(GV + (r0 + rr) * 512) + lane), x);
        float s = 0.f;
#pragma unroll
        for (int j = 0; j < 8; ++j) s += x[j];
        const float mean = wave_sum(s) * (1.f / 512.f); float s2 = 0.f;
#pragma unroll
        for (int j = 0; j < 8; ++j) { const float d = x[j] - mean; s2 += d * d; }
        const float rstd = 1.f / sqrtf(wave_sum(s2) * (1.f / 512.f) + LN_EPS);
        if (lane == 0) { stt[2 * rr] = mean; stt[2 * rr + 1] = rstd; }
    }
    { const int i = tid >> 2, jq = tid & 3; const float* wr = w_s + ((size_t)g * 128 + i) * 128 + 32 * jq;
#pragma unroll
      for (int c = 0; c < 4; ++c) { const f32x4 a = *(const f32x4*)(wr + 8 * c), bq = *(const f32x4*)(wr + 8 * c + 4); const int j0 = 32 * jq + 8 * c;
          v4u w; w.x = pk2(j0 + 0 <= i ? a.x : 0.f, j0 + 1 <= i ? a.y : 0.f); w.y = pk2(j0 + 2 <= i ? a.z : 0.f, j0 + 3 <= i ? a.w : 0.f);
          w.z = pk2(j0 + 4 <= i ? bq.x : 0.f, j0 + 5 <= i ? bq.y : 0.f); w.w = pk2(j0 + 6 <= i ? bq.z : 0.f, j0 + 7 <= i ? bq.w : 0.f);
          *(LAS v4u*)(Ws + i * RP128 + j0) = w; } }
    LDS_WAIT(); __syncthreads();
    { const int sj = tid & 127, cq = tid >> 7; const float mu = stt[2 * sj], rs = stt[2 * sj + 1];
#pragma unroll
      for (int c = 0; c < 4; ++c) { float x[8]; unpack8(*(const v4u*)(GV + (r0 + sj) * 512 + g * 128 + 32 * cq + 8 * c), x);
          const f32x4 ga = *(const f32x4*)(lng + g * 128 + 32 * cq + 8 * c), gb = *(const f32x4*)(lng + g * 128 + 32 * cq + 8 * c + 4);
          const f32x4 ba = *(const f32x4*)(lnb + g * 128 + 32 * cq + 8 * c), bb = *(const f32x4*)(lnb + g * 128 + 32 * cq + 8 * c + 4);
          const float gm[8] = {ga.x, ga.y, ga.z, ga.w, gb.x, gb.y, gb.z, gb.w}, bt[8] = {ba.x, ba.y, ba.z, ba.w, bb.x, bb.y, bb.z, bb.w};
#pragma unroll
          for (int e = 0; e < 8; ++e) VnT[(32 * cq + 8 * c + e) * RP128 + sj] = (bf16)f2bf((x[e] - mu) * rs * gm[e] + bt[e]); } }
    LDS_WAIT(); __syncthreads();
    { const int ib = wid >> 1;
#pragma unroll
      for (int cc = 0; cc < 2; ++cc) { const int cb = 2 * (wid & 1) + cc;
          f32x16_t x = {0.f, 0.f, 0.f, 0.f, 0.f, 0.f, 0.f, 0.f, 0.f, 0.f, 0.f, 0.f, 0.f, 0.f, 0.f, 0.f};
#pragma unroll
          for (int kk = 0; kk < 8; ++kk) x = MFMA32(ldfrag(Ws, 32 * ib + r, RP128, kk, h2), ldfrag(VnT, 32 * cb + r, RP128, kk, h2), x);
          const int c = g * 128 + 32 * cb + r;
#pragma unroll
          for (int reg = 0; reg < 16; ++reg) { const int i = 32 * ib + crow32(reg, h2); const float sp = x[reg] + b_s[g * 128 + i];
              YB[(r0 + i) * 1536 + 1024 + c] = (bf16)f2bf(bf2f(GU[(r0 + i) * 512 + c]) * sp); } } }
    __syncthreads();
}


__device__ __forceinline__ void gmlp_stat_unit(Frame& F, int b, int n) {
    int tid_ = threadIdx.x; asm volatile("" : "+v"(tid_));
    const int tid = tid_, row = tid >> 2, qt = tid & 3;
    const bf16* GV = (const bf16*)(F.ws + WS_GV); float* GST = (float*)(F.ws + WS_GST);
    const size_t r = (size_t)b * SEQ + (size_t)n * 128 + row;
    v4u w[16];
#pragma unroll
    for (int c = 0; c < 16; ++c) w[c] = *(const v4u*)(GV + r * 512 + 128 * qt + 8 * c);
    float s = 0.f;
#pragma unroll
    for (int c = 0; c < 16; ++c) { float x[8]; unpack8(w[c], x); s += ((x[0] + x[1]) + (x[2] + x[3])) + ((x[4] + x[5]) + (x[6] + x[7])); }
    s += __shfl_xor(s, 1); s += __shfl_xor(s, 2);
    const float mean = s * (1.f / 512.f); float s2 = 0.f;
#pragma unroll
    for (int c = 0; c < 16; ++c) { float x[8]; unpack8(w[c], x);
#pragma unroll
        for (int e = 0; e < 8; ++e) { const float d = x[e] - mean; s2 += d * d; } }
    s2 += __shfl_xor(s2, 1); s2 += __shfl_xor(s2, 2);
    if (qt == 0) { GST[2 * r] = mean; GST[2 * r + 1] = 1.f / sqrtf(s2 * (1.f / 512.f) + LN_EPS); }
}
constexpr int G2_WS = 0, G2_VNT = 34816, G2_SW = 69632, G2_END = 104448;
__device__ __forceinline__ void gmlp_unit2(Frame& F, int b, int n, int g, const float* w_s, const float* b_s, const float* lng, const float* lnb) {
    int tid_ = threadIdx.x; asm volatile("" : "+v"(tid_));
    const int tid = tid_, lane = tid & 63, wid = __builtin_amdgcn_readfirstlane(tid >> 6), l15 = lane & 15, q4 = lane >> 4;
    const bf16* GU = (const bf16*)(F.ws + WS_GU); const bf16* GV = (const bf16*)(F.ws + WS_GV); bf16* YB = (bf16*)(F.ws + WS_YB); const float* GST = (const float*)(F.ws + WS_GST);
    LAS bf16* Ws = (LAS bf16*)(F.lds + RING_OFF + G2_WS); LAS bf16* VnT = (LAS bf16*)(F.lds + RING_OFF + G2_VNT); LAS bf16* Sw = (LAS bf16*)(F.lds + RING_OFF + G2_SW) + wid * (16 * RP128);
    const size_t r0 = (size_t)b * SEQ + (size_t)n * 128;
    const int sj = tid & 127, cq = tid >> 7, wi = tid >> 2, jq = tid & 3;
    v4u vreg[4]; f32x4 wreg[8];
#pragma unroll
    for (int c = 0; c < 4; ++c) vreg[c] = *(const v4u*)(GV + (r0 + sj) * 512 + g * 128 + 32 * cq + 8 * c);
    const float mu = GST[2 * (r0 + sj)], rs = GST[2 * (r0 + sj) + 1];
    { const float* wr = w_s + ((size_t)g * 128 + wi) * 128 + 32 * jq;
#pragma unroll
      for (int c = 0; c < 8; ++c) wreg[c] = *(const f32x4*)(wr + 4 * c); }
    __syncthreads();
#pragma unroll
    for (int c = 0; c < 4; ++c) { const int j0 = 32 * jq + 8 * c; const f32x4 a = wreg[2 * c], bq = wreg[2 * c + 1];
        v4u w; w.x = pk2(j0 + 0 <= wi ? a.x : 0.f, j0 + 1 <= wi ? a.y : 0.f); w.y = pk2(j0 + 2 <= wi ? a.z : 0.f, j0 + 3 <= wi ? a.w : 0.f);
        w.z = pk2(j0 + 4 <= wi ? bq.x : 0.f, j0 + 5 <= wi ? bq.y : 0.f); w.w = pk2(j0 + 6 <= wi ? bq.z : 0.f, j0 + 7 <= wi ? bq.w : 0.f);
        *(LAS v4u*)(Ws + wi * RP128 + j0) = w; }
#pragma unroll
    for (int c = 0; c < 4; ++c) { float x[8]; unpack8(vreg[c], x);
        const f32x4 ga = *(const f32x4*)(lng + g * 128 + 32 * cq + 8 * c), gb = *(const f32x4*)(lng + g * 128 + 32 * cq + 8 * c + 4);
        const f32x4 ba = *(const f32x4*)(lnb + g * 128 + 32 * cq + 8 * c), bb = *(const f32x4*)(lnb + g * 128 + 32 * cq + 8 * c + 4);
        const float gm[8] = {ga.x, ga.y, ga.z, ga.w, gb.x, gb.y, gb.z, gb.w}, bt[8] = {ba.x, ba.y, ba.z, ba.w, bb.x, bb.y, bb.z, bb.w};
#pragma unroll
        for (int e = 0; e < 8; ++e) VnT[(32 * cq + 8 * c + e) * RP128 + sj] = (bf16)f2bf((x[e] - mu) * rs * gm[e] + bt[e]); }
    LDS_WAIT(); __syncthreads();
    const int i0 = 16 * wid, nks = (wid + 2) >> 1;
    float bs[4];
#pragma unroll
    for (int reg = 0; reg < 4; ++reg) bs[reg] = b_s[g * 128 + i0 + 4 * q4 + reg];
    { f32x4 x[8];
#pragma unroll
      for (int cb = 0; cb < 8; ++cb) x[cb] = (f32x4){0.f, 0.f, 0.f, 0.f};
#pragma unroll 1
      for (int ks = 0; ks < nks; ++ks) {
          const bf16x8_t a = ldfrag16(Ws, i0 + l15, RP128, ks, q4);
#pragma unroll
          for (int cb = 0; cb < 8; ++cb) x[cb] = MFMA16(a, ldfrag16(VnT, 16 * cb + l15, RP128, ks, q4), x[cb]);
      }
#pragma unroll
      for (int cb = 0; cb < 8; ++cb)
#pragma unroll
          for (int reg = 0; reg < 4; ++reg) Sw[(4 * q4 + reg) * RP128 + 16 * cb + l15] = (bf16)f2bf(x[cb][reg] + bs[reg]);
    }
    LDS_WAIT();
#pragma unroll
    for (int c = 0; c < 4; ++c) { const int ch = c * 64 + lane, row = ch >> 4, cc = ch & 15;
        float sp[8], gu[8]; unpack8(*(const LAS v4u*)(Sw + row * RP128 + 8 * cc), sp); unpack8(*(const v4u*)(GU + (r0 + i0 + row) * 512 + g * 128 + 8 * cc), gu);
        v4u w; w.x = pk2(sp[0] * gu[0], sp[1] * gu[1]); w.y = pk2(sp[2] * gu[2], sp[3] * gu[3]); w.z = pk2(sp[4] * gu[4], sp[5] * gu[5]); w.w = pk2(sp[6] * gu[6], sp[7] * gu[7]);
        *(v4u*)(YB + (r0 + i0 + row) * 1536 + 1024 + g * 128 + 8 * cc) = w; }
    __syncthreads();
}


constexpr int GP_WS = 0, GP_VNT = 69632;
__device__ __forceinline__ void gmlp_pair(Frame& F, int b, int n, int g0, const float* w_s, const float* b_s, const float* lng, const float* lnb) {
    int tid_ = threadIdx.x; asm volatile("" : "+v"(tid_));
    const int tid = tid_, lane = tid & 63, wid = __builtin_amdgcn_readfirstlane(tid >> 6), l15 = lane & 15, q4 = lane >> 4;
    const bf16* GU = (const bf16*)(F.ws + WS_GU); const bf16* GV = (const bf16*)(F.ws + WS_GV); bf16* YB = (bf16*)(F.ws + WS_YB); const float* GST = (const float*)(F.ws + WS_GST);
    LAS bf16* WsB = (LAS bf16*)(F.lds + RING_OFF + GP_WS); LAS bf16* VnTB = (LAS bf16*)(F.lds + RING_OFF + GP_VNT);
    const size_t r0 = (size_t)b * SEQ + (size_t)n * 128;
    const int sj = tid & 127, cq = tid >> 7, wi = tid >> 2, jq = tid & 3;
    v4u vreg[2][4]; f32x4 wreg[2][8];
#pragma unroll
    for (int u = 0; u < 2; ++u)
#pragma unroll
        for (int c = 0; c < 4; ++c) vreg[u][c] = *(const v4u*)(GV + (r0 + sj) * 512 + (g0 + u) * 128 + 32 * cq + 8 * c);
    const float mu = GST[2 * (r0 + sj)], rs = GST[2 * (r0 + sj) + 1];
#pragma unroll
    for (int u = 0; u < 2; ++u) { const float* wr = w_s + ((size_t)(g0 + u) * 128 + wi) * 128 + 32 * jq;
#pragma unroll
        for (int c = 0; c < 8; ++c) wreg[u][c] = *(const f32x4*)(wr + 4 * c); }
    __syncthreads();
#pragma unroll
    for (int u = 0; u < 2; ++u) { const int g = g0 + u; LAS bf16* Ws = WsB + u * (128 * RP128); LAS bf16* VnT = VnTB + u * (128 * RP128);
#pragma unroll
        for (int c = 0; c < 4; ++c) { const int j0 = 32 * jq + 8 * c; const f32x4 a = wreg[u][2 * c], bq = wreg[u][2 * c + 1];
            v4u w; w.x = pk2(j0 + 0 <= wi ? a.x : 0.f, j0 + 1 <= wi ? a.y : 0.f); w.y = pk2(j0 + 2 <= wi ? a.z : 0.f, j0 + 3 <= wi ? a.w : 0.f);
            w.z = pk2(j0 + 4 <= wi ? bq.x : 0.f, j0 + 5 <= wi ? bq.y : 0.f); w.w = pk2(j0 + 6 <= wi ? bq.z : 0.f, j0 + 7 <= wi ? bq.w : 0.f);
            *(LAS v4u*)(Ws + wi * RP128 + j0) = w; }
#pragma unroll
        for (int c = 0; c < 4; ++c) { float x[8]; unpack8(vreg[u][c], x);
            const f32x4 ga = *(const f32x4*)(lng + g * 128 + 32 * cq + 8 * c), gb = *(const f32x4*)(lng + g * 128 + 32 * cq + 8 * c + 4);
            const f32x4 ba = *(const f32x4*)(lnb + g * 128 + 32 * cq + 8 * c), bb = *(const f32x4*)(lnb + g * 128 + 32 * cq + 8 * c + 4);
            const float gm[8] = {ga.x, ga.y, ga.z, ga.w, gb.x, gb.y, gb.z, gb.w}, bt[8] = {ba.x, ba.y, ba.z, ba.w, bb.x, bb.y, bb.z, bb.w};
#pragma unroll
            for (int e = 0; e < 8; ++e) VnT[(32 * cq + 8 * c + e) * RP128 + sj] = (bf16)f2bf((x[e] - mu) * rs * gm[e] + bt[e]); }
    }
    LDS_WAIT(); __syncthreads();
    const int i0 = 16 * wid, nks = (wid + 2) >> 1;
#pragma unroll
    for (int u = 0; u < 2; ++u) { const int g = g0 + u; LAS bf16* Ws = WsB + u * (128 * RP128); LAS bf16* VnT = VnTB + u * (128 * RP128); LAS bf16* Sw = Ws + i0 * RP128;
        float bs[4];
#pragma unroll
        for (int reg = 0; reg < 4; ++reg) bs[reg] = b_s[g * 128 + i0 + 4 * q4 + reg];
        v4u gur[4];
#pragma unroll
        for (int c = 0; c < 4; ++c) { const int ch = c * 64 + lane, row = ch >> 4, cc = ch & 15; gur[c] = *(const v4u*)(GU + (r0 + i0 + row) * 512 + g * 128 + 8 * cc); }
        f32x4 x[8];
#pragma unroll
        for (int cb = 0; cb < 8; ++cb) x[cb] = (f32x4){0.f, 0.f, 0.f, 0.f};
#pragma unroll 1
        for (int ks = 0; ks < nks; ++ks) {
            const bf16x8_t a = ldfrag16(Ws, i0 + l15, RP128, ks, q4);
#pragma unroll
            for (int cb = 0; cb < 8; ++cb) x[cb] = MFMA16(a, ldfrag16(VnT, 16 * cb + l15, RP128, ks, q4), x[cb]);
        }
#pragma unroll
        for (int cb = 0; cb < 8; ++cb)
#pragma unroll
            for (int reg = 0; reg < 4; ++reg) Sw[(4 * q4 + reg) * RP128 + 16 * cb + l15] = (bf16)f2bf(x[cb][reg] + bs[reg]);
        LDS_WAIT();
#pragma unroll
        for (int c = 0; c < 4; ++c) { const int ch = c * 64 + lane, row = ch >> 4, cc = ch & 15;
            float sp[8], gu[8]; unpack8(*(const LAS v4u*)(Sw + row * RP128 + 8 * cc), sp); unpack8(gur[c], gu);
            v4u w; w.x = pk2(sp[0] * gu[0], sp[1] * gu[1]); w.y = pk2(sp[2] * gu[2], sp[3] * gu[3]); w.z = pk2(sp[4] * gu[4], sp[5] * gu[5]); w.w = pk2(sp[6] * gu[6], sp[7] * gu[7]);
            *(v4u*)(YB + (r0 + i0 + row) * 1536 + 1024 + g * 128 + 8 * cc) = w; }
    }
    __syncthreads();
}


__device__ __forceinline__ void moe_tail_unit(Frame& F, const MoeTiles& mt, int e, int rb, int cb) {
    int cnt, t0; mt.expert(e, cnt, t0);
    const int re = cnt & 255, nfull = cnt >> 8;
    if (64 * rb >= re) return;
    int tid_ = threadIdx.x; asm volatile("" : "+v"(tid_));
    const int tid = tid_, lane = tid & 63, wid = __builtin_amdgcn_readfirstlane(tid >> 6), l15 = lane & 15, q4 = lane >> 4;
    const int rl = 16 * (wid & 3), cl = 64 * (wid >> 2), srow = tid >> 3, sch = tid & 7;
    const unsigned char* Ag = (const unsigned char*)(F.ws + WS_HID) + ((size_t)(t0 + nfull) * 256 + 64 * rb + srow) * DFF_E + 16 * sch;
    const unsigned char* Bg = (const unsigned char*)(F.ws + WS_WMD) + ((size_t)e * 1024 + 128 * cb + srow) * DFF_E + 16 * sch;
    constexpr int TP = 272;
    LAS unsigned char* As = F.lds + RING_OFF; LAS unsigned char* Bs = F.lds + RING_OFF + 2 * 64 * TP;
    f32x4 acc[4] = {{0.f, 0.f, 0.f, 0.f}, {0.f, 0.f, 0.f, 0.f}, {0.f, 0.f, 0.f, 0.f}, {0.f, 0.f, 0.f, 0.f}};
    v4u ra[2][2], rbv[2][4];
#define TAIL_LOAD(s_, kt) do { ra[s_][0] = *(const v4u*)(Ag + 256 * (kt)); ra[s_][1] = *(const v4u*)(Ag + 256 * (kt) + 128); rbv[s_][0] = *(const v4u*)(Bg + 256 * (kt)); rbv[s_][1] = *(const v4u*)(Bg + 256 * (kt) + 128); \
        rbv[s_][2] = *(const v4u*)(Bg + (size_t)64 * DFF_E + 256 * (kt)); rbv[s_][3] = *(const v4u*)(Bg + (size_t)64 * DFF_E + 256 * (kt) + 128); } while (0)
#define TAIL_STEP(s_, kt) do { LAS unsigned char* as = As + (s_) * (64 * TP); LAS unsigned char* bs = Bs + (s_) * (128 * TP); \
        *(LAS v4u*)(as + srow * TP + 16 * sch) = ra[s_][0]; *(LAS v4u*)(as + srow * TP + 128 + 16 * sch) = ra[s_][1]; \
        *(LAS v4u*)(bs + srow * TP + 16 * sch) = rbv[s_][0]; *(LAS v4u*)(bs + srow * TP + 128 + 16 * sch) = rbv[s_][1]; \
        *(LAS v4u*)(bs + (srow + 64) * TP + 16 * sch) = rbv[s_][2]; *(LAS v4u*)(bs + (srow + 64) * TP + 128 + 16 * sch) = rbv[s_][3]; \
        LDS_WAIT(); __syncthreads(); \
        if ((kt) + 2 < DFF_E / 256) TAIL_LOAD(s_, (kt) + 2); \
        _Pragma("unroll") for (int kk = 0; kk < 2; ++kk) { \
            const LAS unsigned char* ap = as + (rl + l15) * TP + 128 * kk + 32 * q4; \
            const pg8::v8i_t a = __builtin_shufflevector(*(const LAS pg8::v4i_t*)ap, *(const LAS pg8::v4i_t*)(ap + 16), 0, 1, 2, 3, 4, 5, 6, 7); \
            _Pragma("unroll") for (int j = 0; j < 4; ++j) { const LAS unsigned char* bp = bs + (cl + 16 * j + l15) * TP + 128 * kk + 32 * q4; \
                const pg8::v8i_t b = __builtin_shufflevector(*(const LAS pg8::v4i_t*)bp, *(const LAS pg8::v4i_t*)(bp + 16), 0, 1, 2, 3, 4, 5, 6, 7); \
                acc[j] = __builtin_amdgcn_mfma_scale_f32_16x16x128_f8f6f4(a, b, acc[j], 0, 0, 0, 0x7f7f7f7f, 0, (int)E8_DN); } } } while (0)
    TAIL_LOAD(0, 0); TAIL_LOAD(1, 1);
    __syncthreads();
#pragma unroll 1
    for (int kt = 0; kt < DFF_E / 256; kt += 2) { TAIL_STEP(0, kt); TAIL_STEP(1, kt + 1); }
    static_assert((DFF_E / 256) % 2 == 0, "even number of K-steps");
#undef TAIL_LOAD
#undef TAIL_STEP
    const unsigned* list = (const unsigned*)(F.ws + WS_LIST); const float* gatew = (const float*)(F.ws + WS_GATEW);
    bf16* c0 = (bf16*)(F.ws + WS_YPRE); bf16* c1 = (bf16*)(F.ws + WS_C1);
#pragma unroll
    for (int reg = 0; reg < 4; ++reg) { const int r = 64 * rb + rl + 4 * q4 + reg;
        if (r < re) { const int slot = nfull * 256 + r; const unsigned ent = list[e * 16384 + slot]; const float g = gatew[e * 16384 + slot];
            bf16* dst = ((ent >> 31) ? c1 : c0) + (size_t)(ent & 0x7fffffffu) * 1024 + 128 * cb + cl + l15;
#pragma unroll
            for (int j = 0; j < 4; ++j) dst[16 * j] = (bf16)f2bf(acc[j][reg] * g); } }
    __syncthreads();
}


constexpr int CV_I_IN = 16 * 112, CV_I_BR = 8 * 16, CV_I_OUT = 16 * 16, CV_I_DU = 16 * 88, CV_I_DD = 44 * 16, CV_I_MU = 16 * 112, CV_I_MD = 56 * 16;
constexpr int CV_I_G8 = 16 * 48;
constexpr int CV_NITEMS = 2 * CV_I_IN + 6 * CV_I_BR + 2 * CV_I_OUT + CV_I_DU + CV_I_DD + 8 * CV_I_MU + 8 * CV_I_MD + (GATES_FP8 ? 2 * CV_I_G8 : 0);
constexpr int CV_MD0 = 8 * CV_I_MU, CV_MD1 = 8 * CV_I_MU + 8 * CV_I_MD;
constexpr int CV_DEFER = 5 * CV_I_MU;
__device__ __forceinline__ void cvt_global_item(Frame& F, int it, LAS float* scr, int lane) {
    int r = it; bool done = false;
#pragma unroll 1
    for (int e = 0; e < 8 && !done; ++e) { CvtJob j{(const float*)(const GAS float*)lds_ptr(F.lds, 15) + (size_t)e * 1024 * 7168, 1024, 7168, 7168, (bf16*)(F.ws + WS_WMU + (size_t)e * 7168 * 1024), 1024, 0, 2, DFF_E, SC_WU8}; done = cvt_run(j, r, scr, lane); }
#pragma unroll 1
    for (int e = 0; e < 8 && !done; ++e) { CvtJob j{(const float*)(const GAS float*)lds_ptr(F.lds, 16) + (size_t)e * 3584 * 1024, 3584, 1024, 1024, (bf16*)(F.ws + WS_WMD + (size_t)e * 1024 * 3584), 3584, 0, 0, 0, SC_WD8}; done = cvt_run(j, r, scr, lane); }
#pragma unroll 1
    for (int l = 0; l < 2 && !done; ++l) { CvtJob j{(const float*)(const GAS float*)lds_ptr(F.lds, 1) + (size_t)l * 1024 * N_INSRC, 1024, N_INSRC, N_INV, (bf16*)(F.ws + WS_WIN) + (size_t)l * N_INV * 1024, 1024, 0, 1, 0, 0.f}; done = cvt_run(j, r, scr, lane); }
#pragma unroll 1
    for (int q = 0; q < 6 && !done; ++q) { const int l = q / 3, n = q % 3; CvtJob j{(const float*)(const GAS float*)lds_ptr(F.lds, 8) + (size_t)q * 512 * 1024, 512, 1024, 1024, (bf16*)(F.ws + WS_WBR) + (size_t)l * 1024 * 1536, 1536, n * 512, 0, 0, 0.f}; done = cvt_run(j, r, scr, lane); }
#pragma unroll 1
    for (int l = 0; l < 2 && !done; ++l) { CvtJob j{(const float*)(const GAS float*)lds_ptr(F.lds, 9) + (size_t)l * 1024 * 1024, 1024, 1024, 1024, (bf16*)(F.ws + WS_WOUT) + (size_t)l * 1024 * 1024, 1024, 0, 0, 0, 0.f}; done = cvt_run(j, r, scr, lane); }
    if (!done) { CvtJob j{(const float*)(const GAS float*)lds_ptr(F.lds, 12), 1024, 2 * DFF_D, 2 * DFF_D, (bf16*)(F.ws + WS_WDU), 1024, 0, 2, DFF_D, (DENSE_FP8 == 1 || DENSE_FP8 == 2) ? SC_WU8 : 0.f}; done = cvt_run(j, r, scr, lane); }
    if (!done) { CvtJob j{(const float*)(const GAS float*)lds_ptr(F.lds, 13), DFF_D, 1024, 1024, (bf16*)(F.ws + WS_WDD), DFF_D, 0, 0, 0, (DENSE_FP8 == 1 || DENSE_FP8 == 3) ? SC_WD8 : 0.f}; done = cvt_run(j, r, scr, lane); }
#if GATES_FP8
#pragma unroll 1
    for (int l = 0; l < 2 && !done; ++l) { CvtJob j{(const float*)(const GAS float*)lds_ptr(F.lds, 1) + (size_t)l * 1024 * N_INSRC, 1024, N_INSRC, 3072, (bf16*)(F.ws + WS_WIN8 + (size_t)l * 3072 * 1024), 1024, 0, 1, 0, SC_WU8, 4096}; done = cvt_run(j, r, scr, lane); }
#endif
}

struct Args { const float* in[17]; float* out; unsigned char* ws; int ph_lo, ph_hi; };
constexpr int N_PHASES = 17;

__global__ void __launch_bounds__(NWAVES * 64, 2) mega_fwd(Args args) {
    extern __shared__ __attribute__((aligned(16))) unsigned char lds[];
    asm volatile("s_nop 0\n\ts_nop 0\n\ts_nop 0\n\ts_nop 0\n\ts_nop 0\n\ts_nop 0\n\ts_nop 0\n\ts_nop 0\n\ts_nop 0");
    Frame F;
    F.lds = (LAS unsigned char*)lds;
    F.MISC = (volatile LAS unsigned*)(F.lds + MISC_OFF);
    F.tid = threadIdx.x; F.lane = F.tid & 63; F.wave = __builtin_amdgcn_readfirstlane(F.tid >> 6);
    F.G = gridDim.x; { const int bx = blockIdx.x; F.vcu = (F.G % 8 == 0) ? (bx % 8) * (F.G / 8) + bx / 8 : bx; }
    F.ws = args.ws; F.ctl = (gu32*)(args.ws + WS_CTL);
    for (int u = F.tid; u < (LDS_BYTES - LDSCTL_OFF) / 4; u += NWAVES * 64) ((LAS unsigned*)(F.lds + LDSCTL_OFF))[u] = 0u;
    __syncthreads();
    XcdBarrier bar = xcd_barrier_post((unsigned*)(F.ctl + CW_BAR), F.MISC + 8, gridDim.x, 0u);
    const bool grp = (F.G == 256);
    XcdBarrier gbar = bar;
    if (grp) gbar = xcd_barrier_post((unsigned*)(F.ctl + CW_BAR) + (1 + (blockIdx.x & 7)) * XCD_BAR_WORDS, F.MISC + 10, 32u, 1u);
#define GRID_BAR() xcd_barrier(bar)
#define GRP_BAR() do { if (grp) xcd_barrier(gbar); else xcd_barrier(bar); } while (0)
    const int lo = args.ph_lo, hi = args.ph_hi;
#ifndef PH_MASK
#define PH_MASK 0x1ff
#endif
#define IN(k) (lo <= (k) && (k) < hi)
#ifndef DUP_PHASE
#define DUP_PHASE (-1)
#endif
#define REPS(k) (((k) == DUP_PHASE) ? 2 : 1)
#ifndef P2DUP
#define P2DUP 0
#endif
#define PHASE_BEGIN() do { int t_ = threadIdx.x; asm volatile("" : "+v"(t_)); F.tid = t_; F.lane = t_ & 63; F.wave = __builtin_amdgcn_readfirstlane(t_ >> 6); } while (0)
#define ON(j) (((PH_MASK) >> (j)) & 1)
#define SEAM(k) do { if (IN(k) && IN((k) + 1)) GRID_BAR(); } while (0)
#define SEAMG(k) do { if (IN(k) && IN((k) + 1)) GRP_BAR(); } while (0)

    if (F.tid == 0) { LAS unsigned long long* pt = (LAS unsigned long long*)(F.lds + PTAB_OFF);
#pragma unroll
        for (int i = 0; i < 17; ++i) pt[i] = (unsigned long long)args.in[i];
        pt[17] = (unsigned long long)args.out; }
    LDS_WAIT(); __syncthreads();
#define INP(k) ((const float*)(const GAS float*)lds_ptr(F.lds, (k)))
    if (ON(0) && IN(0)) { for (int rep_ = 0; rep_ < REPS(0); ++rep_) { PHASE_BEGIN();
        LAS float* scr = (LAS float*)(F.lds + RING_OFF + F.wave * 17408);
        static_assert(NWAVES * 17408 <= RING_BYTES, "conversion tiles fit the phase scratch");
        const int gw = F.vcu * NWAVES + F.wave, NGW = F.G * NWAVES;
        for (int it = CV_DEFER + gw; it < CV_NITEMS - (CV_MD1 - CV_MD0); it += NGW) { const int jt = it < CV_MD0 ? it : it + (CV_MD1 - CV_MD0); cvt_global_item(F, jt, scr, F.lane); }
        __syncthreads();
        { float* cs = (float*)(F.ws + WS_CS);
          for (int i = F.vcu * 512 + F.tid; i < SEQ * 32; i += F.G * 512) { const int pos = i >> 5, d = i & 31;
              const double rev = (double)pos * exp(-(double)d / 32.0 * 9.210340371976184) * 0.15915494309189535; const float fr_ = (float)(rev - floor(rev));
              cs[i] = __builtin_amdgcn_cosf(fr_); cs[65536 + i] = __builtin_amdgcn_sinf(fr_); } }
        p0_rows(F, INP(0), INP(1), INP(2));
    } }
    SEAM(0);

#pragma unroll 1
    for (int l = 0; l < 2; ++l) {
        const int pb = 1 + 8 * l;
        const float* xres = (l == 0) ? INP(0) : ((float*)(F.ws + WS_XF));
        if (ON(1) && IN(pb + 0)) { for (int rep_ = 0; rep_ < REPS(pb + 0); ++rep_) { PHASE_BEGIN();
            const bool g8 = (GATES_FP8 == 2) || (GATES_FP8 == 1 && l == 1);
            ProjSched S; S.init(M / 256, g8 ? 16 : N_INV / 256, F.G, (int)blockIdx.x); S.A = ((bf16*)(F.ws + WS_XB)); S.Bt = (const bf16*)(F.ws + WS_WIN) + (size_t)l * N_INV * 1024; S.K = 1024;
            EpiProj E{F.ws, INP(3) + l * 3072, ((const float*)(F.ws + WS_CS))};
            pg8::gemm_phase<EpiProj, ProjSched>(F.lds + RING_OFF, 1024, S, E);
#if GATES_FP8
            if (g8) {
                pg8::PlainSched S8; S8.init(M / 256, 12, F.G, (int)blockIdx.x); S8.A = (const bf16*)(F.ws + WS_X8IN); S8.Bt = (const bf16*)(F.ws + WS_WIN8 + (size_t)l * 3072 * 1024); S8.K = 1024; S8.esz = 1;
                EpiGate8 E8{(bf16*)(F.ws + WS_GT), INP(3) + l * 3072};
                pg8::gemm_phase<EpiGate8, pg8::PlainSched, E8_UP>(F.lds + RING_OFF, 1024, S8, E8);
            }
#endif
        } }
        SEAMG(pb + 0);
        if (ON(2) && IN(pb + 1)) { for (int rep_ = 0; rep_ < REPS(pb + 1); ++rep_) { PHASE_BEGIN();
            {
#if NAIVE_FOX
            LAS float* tab = (LAS float*)(F.lds + RING_OFF + 4096); LAS float* wtot = (LAS float*)(F.lds + RING_OFF + 4096 + 8192);
            for (int uu = F.vcu; uu < 64 * 8; uu += F.G) {
                const int bh = uu >> 3, qb = uu & 7, b = bh >> 3, h = bh & 7;
                fox_bias_table<false>(F, b, h, tab, wtot);
                for (int r = F.wave; r < 256; r += NWAVES) naive_fox_row(F, b, h, qb * 256 + r, tab);
                __syncthreads();
            }
#else
            LAS float* tab = (LAS float*)(F.lds + RING_OFF + 86016); LAS float* wtot = (LAS float*)(F.lds + RING_OFF + 86016 + 32768);
            static_assert(attn_body::ATTN_LDS_BYTES <= 86016 && 86016 + 32768 + 64 <= RING_BYTES, "attention scratch below the bias rows");
            for (int d_ = 0; d_ < ((P2DUP & 1) ? 2 : 1); ++d_)
            for (int pp = F.vcu; pp < 256; pp += F.G) {
                const int bh = pp >> 2, sq = pp & 3, b = bh >> 3, h = bh & 7;
                fox_bias_table<true>(F, b, h, tab, wtot);
#pragma unroll 1
                for (int i = 0; i < 2; ++i)
                    attn_body::attn_unit<8>(b, h, i ? 7 - sq : sq, (const attn_body::bf16*)(F.ws + WS_FQ), (const attn_body::bf16*)(F.ws + WS_FK), (const attn_body::bf16*)(F.ws + WS_FV), (attn_body::bf16*)(F.ws + WS_YB), (char*)lds + RING_OFF, (attn_body::lds_tabptr)tab);
            }
            __syncthreads();
#endif
            }
#if NAIVE_RET == 1
            { const int gw = F.vcu * NWAVES + F.wave, NGW = F.G * NWAVES;
              for (int idx = gw; idx < BATCH * 4 * SEQ; idx += NGW) { const int t = idx & (SEQ - 1), bh = idx >> 11; naive_ret_row(F, bh >> 2, bh & 3, t); } }
#endif
#if NAIVE_GMLP == 1
            for (int uu = F.vcu; uu < BATCH * 16 * 4; uu += F.G) { const int g = uu & 3, n = (uu >> 2) & 15, b = uu >> 6;
                naive_gmlp_unit(F, b, n, g, INP(4) + (size_t)l * 4 * 128 * 128, INP(5) + l * 512, INP(6) + l * 512, INP(7) + l * 512); }
#endif
#if MK_N_LAUNCHES == 1 && NAIVE_RET == 0 && NAIVE_GMLP == 0
            for (int d_ = 0; d_ < ((P2DUP & 2) ? 2 : 1); ++d_)
            for (int uu = 2 * F.vcu; uu < 512; uu += 2 * F.G) {
#pragma unroll 1
                for (int q = 0; q < 2; ++q) { const int un = uu + q, bh = un >> 4; ret_kv_unit(F, bh >> 2, bh & 3, un & 15); } }
            if (grp) { if ((F.vcu & 31) < 16) gmlp_stat_unit(F, F.vcu >> 5, F.vcu & 31); }
            else for (int uu = F.vcu; uu < 128; uu += F.G) gmlp_stat_unit(F, uu >> 4, uu & 15);
            GRP_BAR();
            for (int d_ = 0; d_ < ((P2DUP & 4) ? 2 : 1); ++d_)
            for (int pp = F.vcu; pp < 256; pp += F.G) { const int bh = pp >> 3, sq = pp & 7;
#pragma unroll 1
                for (int q = 0; q < 2; ++q) ret_out_unit(F, bh >> 2, bh & 3, q ? 15 - sq : sq); }
            for (int d_ = 0; d_ < ((P2DUP & 8) ? 2 : 1); ++d_)
            for (int uu = F.vcu; uu < 256; uu += F.G) gmlp_pair(F, uu >> 5, (uu >> 1) & 15, (uu & 1) * 2, INP(4) + (size_t)l * 4 * 128 * 128, INP(5) + l * 512, INP(6) + l * 512, INP(7) + l * 512);
#else
            for (int uu = F.vcu; uu < 256; uu += F.G) {
                if (uu < 128) {
#if NAIVE_RET == 0
                    ret_unit(F, uu >> 4, (uu >> 2) & 3, uu & 3);
#endif
                } else {
#if NAIVE_GMLP == 0
#pragma unroll 1
                    for (int q = 0; q < 4; ++q) { const int gu = (uu - 128) * 4 + q; gmlp_unit(F, gu >> 6, (gu >> 2) & 15, gu & 3, INP(4) + (size_t)l * 4 * 128 * 128, INP(5) + l * 512, INP(6) + l * 512, INP(7) + l * 512); }
#endif
                }
            }
#endif
        } }
        SEAMG(pb + 1);
        if (ON(3) && IN(pb + 2)) { for (int rep_ = 0; rep_ < REPS(pb + 2); ++rep_) { PHASE_BEGIN();
            pg8::PlainSched S; S.init(M / 256, 4, F.G, (int)blockIdx.x); S.A = ((bf16*)(F.ws + WS_YB)); S.Bt = (const bf16*)(F.ws + WS_WBR) + (size_t)l * 1024 * 1536; S.K = 1536;
            EpiMerge E{(const bf16*)(F.ws + WS_GT), ((bf16*)(F.ws + WS_MRG))};
            pg8::gemm_phase<EpiMerge, pg8::PlainSched>(F.lds + RING_OFF, 1536, S, E);
        } }
        SEAMG(pb + 2);
        if (ON(4) && IN(pb + 3)) { for (int rep_ = 0; rep_ < REPS(pb + 3); ++rep_) { PHASE_BEGIN();
            pg8::PlainSched S; S.init(M / 256, 4, F.G, (int)blockIdx.x); S.A = ((bf16*)(F.ws + WS_MRG)); S.Bt = (const bf16*)(F.ws + WS_WOUT) + (size_t)l * 1024 * 1024; S.K = 1024;
            EpiResid E{xres, ((float*)(F.ws + WS_YPRE))};
            pg8::gemm_phase<EpiResid, pg8::PlainSched>(F.lds + RING_OFF, 1024, S, E);
        } }
        SEAMG(pb + 3);
        if (ON(5) && IN(pb + 4)) { for (int rep_ = 0; rep_ < REPS(pb + 4); ++rep_) { PHASE_BEGIN();
            if (l == 0) ln_pass<0>(F, ((float*)(F.ws + WS_YPRE)), 1.f, nullptr, nullptr, INP(10) + (l * 2 + 0) * 1024, INP(11) + (l * 2 + 0) * 1024, ((float*)(F.ws + WS_XF)), (DENSE_FP8 == 1 || DENSE_FP8 == 2) ? nullptr : ((bf16*)(F.ws + WS_XB)), (DENSE_FP8 == 1 || DENSE_FP8 == 2) ? (unsigned char*)(F.ws + WS_XB) : nullptr, nullptr, 0, 0, nullptr, grp);
            else ln_pass<2>(F, ((float*)(F.ws + WS_YPRE)), 1.f, nullptr, nullptr, INP(10) + (l * 2 + 0) * 1024, INP(11) + (l * 2 + 0) * 1024, ((float*)(F.ws + WS_XF)), nullptr, (unsigned char*)(F.ws + WS_XB), INP(14), 8, 0, nullptr, grp);
        } }
        if (l == 0) SEAMG(pb + 4); else SEAM(pb + 4);
        if (ON(6) && IN(pb + 5)) { for (int rep_ = 0; rep_ < REPS(pb + 5); ++rep_) { PHASE_BEGIN();
            if (l == 0) {
                pg8::PlainSched S; S.init(M / 256, 2 * DFF_D / 256, F.G, (int)blockIdx.x); S.A = ((bf16*)(F.ws + WS_XB)); S.Bt = (const bf16*)(F.ws + WS_WDU); S.K = 1024;
#if DENSE_FP8 == 1
                S.esz = 1; EpiSwiglu8 E{(unsigned char*)(F.ws + WS_HID), DFF_D};
                pg8::gemm_phase<EpiSwiglu8, pg8::PlainSched, E8_UP>(F.lds + RING_OFF, 1024, S, E);
#elif DENSE_FP8 == 2
                S.esz = 1; EpiSwiglu E{((bf16*)(F.ws + WS_HID)), DFF_D};
                pg8::gemm_phase<EpiSwiglu, pg8::PlainSched, E8_UP>(F.lds + RING_OFF, 1024, S, E);
#elif DENSE_FP8 == 3
                EpiSwiglu8 E{(unsigned char*)(F.ws + WS_HID), DFF_D};
                pg8::gemm_phase<EpiSwiglu8, pg8::PlainSched>(F.lds + RING_OFF, 1024, S, E);
#else
                EpiSwiglu E{((bf16*)(F.ws + WS_HID)), DFF_D};
                pg8::gemm_phase<EpiSwiglu, pg8::PlainSched>(F.lds + RING_OFF, 1024, S, E);
#endif
                if (F.G == 256 && blockIdx.x >= 128) {
                    LAS float* scr = (LAS float*)(F.lds + RING_OFF + F.wave * 17408);
                    for (int it = ((int)blockIdx.x - 128) * NWAVES + F.wave; it < CV_DEFER; it += 128 * NWAVES) cvt_global_item(F, it, scr, F.lane);
                } else if (F.G != 256) {
                    LAS float* scr = (LAS float*)(F.lds + RING_OFF + F.wave * 17408);
                    for (int it = F.vcu * NWAVES + F.wave; it < CV_DEFER; it += F.G * NWAVES) cvt_global_item(F, it, scr, F.lane);
                }
                __syncthreads();
            } else {
                MoeTiles mt; mt.init(F.ctl);
                MoeUpSched S; S.init(mt.toff[NEXP], 2 * DFF_E / 256, F.G, (int)blockIdx.x); S.A = (const unsigned char*)(F.ws + WS_XB); S.Bt = (const unsigned char*)(F.ws + WS_WMU); S.list = (const unsigned*)(F.ws + WS_LIST); S.mt = mt;
                EpiSwiglu8 E{(unsigned char*)(F.ws + WS_HID), DFF_E};
                pg8::gemm_phase<EpiSwiglu8, MoeUpSched, E8_UP>(F.lds + RING_OFF, 1024, S, E);
                {
                    LAS float* scr = (LAS float*)(F.lds + RING_OFF + F.wave * 17408);
                    const int nwg = mt.toff[NEXP] * (2 * DFF_E / 256), rounds = (nwg + F.G - 1) / F.G, rem = nwg - (rounds - 1) * F.G, nidle = F.G - rem;
                    constexpr int NMD = CV_MD1 - CV_MD0;
                    int q = 0; if (nidle > 0) { q = (NMD + nidle * NWAVES - 1) / (nidle * NWAVES); if (q > 6) q = 6; }
                    int first = nidle * NWAVES * q; if (first > NMD) first = NMD;
                    if ((int)blockIdx.x >= rem) for (int it = ((int)blockIdx.x - rem) * NWAVES + F.wave; it < first; it += nidle * NWAVES) cvt_global_item(F, CV_MD0 + it, scr, F.lane);
                    for (int it = first + (int)blockIdx.x * NWAVES + F.wave; it < NMD; it += F.G * NWAVES) cvt_global_item(F, CV_MD0 + it, scr, F.lane);
                    __syncthreads();
                }
            }
        } }
        if (l == 0) SEAMG(pb + 5); else SEAM(pb + 5);
        if (ON(7) && IN(pb + 6)) { for (int rep_ = 0; rep_ < REPS(pb + 6); ++rep_) { PHASE_BEGIN();
            if (l == 0) {
                pg8::PlainSched S; S.init(M / 256, 4, F.G, (int)blockIdx.x); S.A = ((bf16*)(F.ws + WS_HID)); S.Bt = (const bf16*)(F.ws + WS_WDD); S.K = DFF_D;
                EpiResid E{((float*)(F.ws + WS_XF)), ((float*)(F.ws + WS_YPRE))};
#if DENSE_FP8 == 1 || DENSE_FP8 == 3
                S.esz = 1; pg8::gemm_phase<EpiResid, pg8::PlainSched, E8_DN>(F.lds + RING_OFF, DFF_D, S, E);
#else
                pg8::gemm_phase<EpiResid, pg8::PlainSched>(F.lds + RING_OFF, DFF_D, S, E);
#endif
            } else {
                MoeTiles mt; mt.init(F.ctl);
                MoeDownSched S; S.init(mt.nfull_total(), 4, F.G, (int)blockIdx.x); S.A = (const unsigned char*)(F.ws + WS_HID); S.Bt = (const unsigned char*)(F.ws + WS_WMD); S.mt = mt;
                EpiMoeDown E{((bf16*)(F.ws + WS_YPRE)), ((bf16*)(F.ws + WS_C1)), (const unsigned*)(F.ws + WS_LIST), (const float*)(F.ws + WS_GATEW), mt};
                pg8::gemm_phase<EpiMoeDown, MoeDownSched, E8_DN>(F.lds + RING_OFF, DFF_E, S, E);
                for (int tu = F.vcu; tu < 256; tu += F.G) moe_tail_unit(F, mt, tu >> 5, (tu >> 3) & 3, tu & 7);
            }
        } }
        if (l == 0) SEAMG(pb + 6); else SEAM(pb + 6);
        if (ON(8) && IN(pb + 7)) { for (int rep_ = 0; rep_ < REPS(pb + 7); ++rep_) { PHASE_BEGIN();
            if (l == 0) ln_pass<1>(F, ((float*)(F.ws + WS_YPRE)), 1.f, nullptr, nullptr, INP(10) + (l * 2 + 1) * 1024, INP(11) + (l * 2 + 1) * 1024, ((float*)(F.ws + WS_XF)), ((bf16*)(F.ws + WS_XB)), GATES_FP8 ? (unsigned char*)(F.ws + WS_X8IN) : nullptr, INP(1) + (size_t)1 * 1024 * N_INSRC, N_INSRC, FL_COL, INP(2) + 8, grp);
            else ln_pass<0>(F, ((float*)(F.ws + WS_XF)), ALPHA, (const bf16*)(F.ws + WS_YPRE), (const bf16*)(F.ws + WS_C1), INP(10) + (l * 2 + 1) * 1024, INP(11) + (l * 2 + 1) * 1024, (float*)(GAS float*)lds_ptr(F.lds, 17), nullptr, nullptr, nullptr, 0, 0, nullptr, grp);
        } }
        if (l == 0) SEAMG(pb + 7);
    }
#undef IN
#undef SEAM
}

extern "C" void kernel_launch(void* const* d_in, const int* in_sizes, int n_in, void* d_out, int out_size, void* d_ws, size_t ws_size, hipStream_t stream) {
    static int grid = 0;
    if (grid == 0) {
        if (n_in != 17 || in_sizes[0] != M * D || out_size != M * D || ws_size < WS_END) { fprintf(stderr, "kernel_launch: unexpected shapes / workspace (%zu)\n", ws_size); grid = -1; return; }
        int dev = 0, cus = 0, per_cu = 0;
        if (hipGetDevice(&dev) != hipSuccess || hipDeviceGetAttribute(&cus, hipDeviceAttributeMultiprocessorCount, dev) != hipSuccess) { grid = -1; return; }
        if (hipFuncSetAttribute((const void*)mega_fwd, hipFuncAttributeMaxDynamicSharedMemorySize, LDS_BYTES) != hipSuccess) { grid = -1; return; }
        if (hipOccupancyMaxActiveBlocksPerMultiprocessor(&per_cu, (const void*)mega_fwd, NWAVES * 64, LDS_BYTES) != hipSuccess || per_cu < 1) { fprintf(stderr, "kernel_launch: occupancy query says %d\n", per_cu); }
        (void)hipGetLastError();
        grid = cus;
    }
    if (grid < 0) return;
    if (hipMemsetAsync((char*)d_ws + WS_CTL, 0, CTL_ZERO_BYTES, stream) != hipSuccess) return;
    Args a{};
    for (int i = 0; i < 17; ++i) a.in[i] = (const float*)d_in[i];
    a.out = (float*)d_out; a.ws = (unsigned char*)d_ws;
#if MK_N_LAUNCHES == 1
    a.ph_lo = 0; a.ph_hi = N_PHASES;
    hipLaunchKernelGGL(mega_fwd, dim3(grid), dim3(NWAVES * 64), LDS_BYTES, stream, a);
#else
    for (int p = 0; p < N_PHASES; ++p) { a.ph_lo = p; a.ph_hi = p + 1; hipLaunchKernelGGL(mega_fwd, dim3(grid), dim3(NWAVES * 64), LDS_BYTES, stream, a); }
#endif
}
```

```cpp
#include <hip/hip_runtime.h>
#include <cstdio>
#include <cstdint>
#include <hip/hip_bf16.h>
#include <cmath>

#ifndef MK_N_LAUNCHES
#define MK_N_LAUNCHES 1
#endif
#ifndef DENSE_FP8
#define DENSE_FP8 4
#endif
#ifndef GATES_FP8
#define GATES_FP8 2
#endif
#ifndef NAIVE_FOX
#define NAIVE_FOX 0
#endif
#ifndef NAIVE_RET
#define NAIVE_RET 0
#endif
#ifndef NAIVE_GMLP
#define NAIVE_GMLP 0
#endif

namespace pg8 {
#define PG8_LAS __attribute__((address_space(3)))
typedef unsigned short bf16_t;
typedef short bf16x8 __attribute__((ext_vector_type(8)));
typedef float f32x4 __attribute__((ext_vector_type(4)));
typedef float f32x2 __attribute__((ext_vector_type(2)));
typedef unsigned u32x4 __attribute__((ext_vector_type(4)));
typedef unsigned u32x2 __attribute__((ext_vector_type(2)));
constexpr int BM = 256, BK = 64, HALF = 128, HTB = HALF * BK * 2  , STAGE_BYTES = 8 * HTB, NXCD = 8, WGM = 4;

__host__ __device__ __forceinline__ int lds_byte(int r, int c) { const int st = (r >> 4) * 2 + (c >> 5), rr = r & 15, cc = c & 31, ob = rr * 64 + cc * 2; return st * 1024 + (ob ^ (((ob >> 9) & 1) << 5)); }
__host__ __device__ __forceinline__ void stage_rc(int b, int& R, int& C) { const int st = b / 1024, sb = b % 1024, swz = sb ^ (((sb >> 9) & 1) << 5); R = (st >> 1) * 16 + swz / 64; C = (st & 1) * 32 + (swz % 64) / 2; }
__host__ __device__ __forceinline__ int perm32(int rho) { const int n = rho >> 4, i = rho & 15; return 8 * (i >> 2) + 4 * n + (i & 3); }

struct Unit { int pm, pn; };

struct TileOrder {
    int nM, nN, nwg, G, c;
    __device__ __forceinline__ void init(int nM_, int nN_, int G_, int c_) { nM = nM_; nN = nN_; nwg = nM * nN; G = G_; c = c_; }
    __device__ __forceinline__ bool next(int i, Unit& u) const {
        const long L = (long)i * G + c; if (L >= nwg) return false;
        int wgid = (int)L; { const int q = nwg / NXCD, r = nwg % NXCD, xcd = wgid % NXCD, off = wgid / NXCD; wgid = (xcd < r ? xcd * (q + 1) : r * (q + 1) + (xcd - r) * q) + off; }
        const int nig = WGM * nN, gid = wgid / nig, fm = gid * WGM, gsz = (nM - fm) < WGM ? (nM - fm) : WGM;
        u.pm = fm + ((wgid % nig) % gsz); u.pn = (wgid % nig) / gsz; return true;
    }
};
struct PlainSched : TileOrder {
    static constexpr bool GATHER = false;
    const bf16_t* A; const bf16_t* Bt; int K; int esz = 2;
    __device__ __forceinline__ const char* abase(const Unit& u) const { return (const char*)A + (size_t)u.pm * BM * K * esz; }
    __device__ __forceinline__ void aoffs_load(const Unit&, const int (&)[2], PG8_LAS unsigned*) const {}
    __device__ __forceinline__ void aoffs_fin(const Unit&, const int (&)[2], const int (&)[2], const PG8_LAS unsigned*, int, unsigned (&)[2][2]) const {}
    __device__ __forceinline__ void aoffs(const Unit&, const int (&R)[2], const int (&C)[2], unsigned (&o)[2][2]) const {
#pragma unroll
        for (int h = 0; h < 2; ++h)
#pragma unroll
            for (int i = 0; i < 2; ++i) o[h][i] = (unsigned)((R[i] + h * HALF) * K + C[i]) * 2u; }
    __device__ __forceinline__ const char* bbase(const Unit& u) const { return (const char*)Bt + (size_t)u.pn * BM * K * esz; }
};

typedef __bf16 bf16x2_v __attribute__((ext_vector_type(2)));
__device__ __forceinline__ unsigned cvt_pk_bf16(float lo, float hi) { f32x2 v = {lo, hi}; bf16x2_v b = __builtin_convertvector(v, bf16x2_v); return __builtin_bit_cast(unsigned, b); }

typedef float f32x2_pk __attribute__((ext_vector_type(2)));
__device__ __forceinline__ f32x4 zero4() { f32x2_pk lo, hi; asm volatile("v_pk_mov_b32 %0, 0, 0" : "=v"(lo)); asm volatile("v_pk_mov_b32 %0, 0, 0" : "=v"(hi)); return __builtin_shufflevector(lo, hi, 0, 1, 2, 3); }
typedef int v4i_t __attribute__((ext_vector_type(4)));
typedef int v8i_t __attribute__((ext_vector_type(8)));
__host__ __device__ __forceinline__ int lds_byte8(int r, int g) { const int st = (r >> 4) * 2 + (g >> 1), ob = (r & 15) * 64 + 32 * (g & 1); return st * 1024 + (ob ^ (((ob >> 9) & 1) << 5)); }
template <class Epi, class Sched, unsigned FP8S = 0u>
__device__ __forceinline__ void gemm_phase(PG8_LAS unsigned char* lds, const int K, const Sched& S, const Epi& E) {
    constexpr bool F8 = FP8S != 0u;
    constexpr bool I8 = FP8S == 1u;
    int tid_ = threadIdx.x; asm volatile("" : "+v"(tid_));
    const int tid = tid_, wid = __builtin_amdgcn_readfirstlane(tid >> 6), lane = tid & 63, wr = wid >> 2, wc = wid & 3, fr = lane & 15, fq = lane >> 4;
    const int nt = F8 ? K / 128 : K / BK;
    int Rs[2], Cs[2]; unsigned voffA[2], voffB[2];
#pragma unroll
    for (int i = 0; i < 2; ++i) { int R, C; stage_rc(tid * 16 + i * 8192, R, C); Rs[i] = R; Cs[i] = C; const int Rb = Epi::PERM ? ((R & ~31) + perm32(R & 31)) : R;
        voffA[i] = F8 ? (unsigned)(R * K + 2 * C) : (unsigned)(R * K + C) * 2u; voffB[i] = F8 ? (unsigned)(Rb * K + 2 * C) : (unsigned)(Rb * K + C) * 2u; }
    const size_t kstep = (size_t)(BK * 2);
    const size_t hstep = (size_t)HALF * K * (F8 ? 1 : 2);
    const unsigned ldsw = (unsigned)wid * 1024u;
    const int aoff = F8 ? lds_byte8(wr * 64 + fr, fq) : lds_byte(wr * 64 + fr, fq * 8), boff = F8 ? lds_byte8(wc * 32 + fr, fq) : lds_byte(wc * 32 + fr, fq * 8);
#define PG8_SA(b, h) (((b) * 2 + (h)) * HTB)
#define PG8_SB(b, h) ((4 + (b) * 2 + (h)) * HTB)
#define PG8_STAGE(bufoff, gbase, voff) do { _Pragma("unroll") for (int _i = 0; _i < 2; ++_i) \
        __builtin_amdgcn_global_load_lds((const unsigned*)((const char*)(gbase) + (voff)[_i]), (PG8_LAS unsigned*)(lds + (bufoff) + ldsw + _i * 8192), 16, 0, 0); } while (0)
#define PG8_STA(bufoff, gbase, h, nx) do { if constexpr (Sched::GATHER) { _Pragma("unroll") for (int _i = 0; _i < 2; ++_i) { const unsigned o_ = (nx) ? nof[h][_i] : cof[h][_i]; \
        __builtin_amdgcn_global_load_lds((const unsigned*)((const char*)(gbase) + o_), (PG8_LAS unsigned*)(lds + (bufoff) + ldsw + _i * 8192), 16, 0, 0); } } \
        else { PG8_STAGE(bufoff, (gbase) + (h) * hstep, voffA); } } while (0)
#define PG8_LDA(dst, b, h) do { _Pragma("unroll") for (int m = 0; m < 4; ++m) _Pragma("unroll") for (int k = 0; k < 2; ++k) dst[m][k] = *(const PG8_LAS bf16x8*)(lds + PG8_SA(b, h) + aoff + m * 2048 + k * 1024); } while (0)
#define PG8_LDB(dst, b, h) do { _Pragma("unroll") for (int n = 0; n < 2; ++n) _Pragma("unroll") for (int k = 0; k < 2; ++k) dst[n][k] = *(const PG8_LAS bf16x8*)(lds + PG8_SB(b, h) + boff + n * 2048 + k * 1024); } while (0)
#define PG8_MMA(ai, bj, At, Bt) do { __builtin_amdgcn_s_setprio(1); _Pragma("unroll") for (int m = 0; m < 4; ++m) _Pragma("unroll") for (int n = 0; n < 2; ++n) _Pragma("unroll") for (int k = 0; k < 2; ++k) \
        acc[ai][bj][m][n] = __builtin_amdgcn_mfma_f32_16x16x32_bf16(Bt[n][k], At[m][k], acc[ai][bj][m][n], 0, 0, 0); __builtin_amdgcn_s_setprio(0); } while (0)
#define PG8_LD32(p) __builtin_shufflevector(*(const PG8_LAS v4i_t*)(p), *(const PG8_LAS v4i_t*)((p) + 16), 0, 1, 2, 3, 4, 5, 6, 7)
#define PG8_LDA8(dst, b, h) do { _Pragma("unroll") for (int m = 0; m < 4; ++m) dst[m] = PG8_LD32(lds + PG8_SA(b, h) + aoff + m * 2048); } while (0)
#define PG8_LDB8(dst, b, h) do { _Pragma("unroll") for (int n = 0; n < 2; ++n) dst[n] = PG8_LD32(lds + PG8_SB(b, h) + boff + n * 2048); } while (0)
#define PG8_MMA8(ai, bj, At, Bt) do { __builtin_amdgcn_s_setprio(1); \
        if constexpr (I8) {   \
            _Pragma("unroll") for (int m = 0; m < 4; ++m) _Pragma("unroll") for (int n = 0; n < 2; ++n) \
                asm volatile("v_mfma_i32_16x16x64_i8 %0, %1, %2, %0" : "+v"(acc[ai][bj][m][n]) : "v"(__builtin_shufflevector(Bt[n], Bt[n], 0, 1, 2, 3)), "v"(__builtin_shufflevector(At[m], At[m], 0, 1, 2, 3))); \
            _Pragma("unroll") for (int m = 0; m < 4; ++m) _Pragma("unroll") for (int n = 0; n < 2; ++n) \
                asm volatile("v_mfma_i32_16x16x64_i8 %0, %1, %2, %0" : "+v"(acc[ai][bj][m][n]) : "v"(__builtin_shufflevector(Bt[n], Bt[n], 4, 5, 6, 7)), "v"(__builtin_shufflevector(At[m], At[m], 4, 5, 6, 7))); \
        } else { _Pragma("unroll") for (int m = 0; m < 4; ++m) _Pragma("unroll") for (int n = 0; n < 2; ++n) \
        asm volatile("v_mfma_scale_f32_16x16x128_f8f6f4 %0, %1, %2, %0, %3, %4 op_sel_hi:[0,0,0]" : "+v"(acc[ai][bj][m][n]) : "v"(Bt[n]), "v"(At[m]), "v"(scl_w), "v"(scl_1)); } __builtin_amdgcn_s_setprio(0); } while (0)
#define PG8_XLDA(b, h) do { if constexpr (F8) PG8_LDA8(At8, b, h); else PG8_LDA(At, b, h); } while (0)
#define PG8_XLDB0(b, h) do { if constexpr (F8) PG8_LDB8(B08, b, h); else PG8_LDB(B0, b, h); } while (0)
#define PG8_XLDB1(b, h) do { if constexpr (F8) PG8_LDB8(B18, b, h); else PG8_LDB(B1, b, h); } while (0)
#define PG8_XMMA0(ai, bj) do { if constexpr (F8) PG8_MMA8(ai, bj, At8, B08); else PG8_MMA(ai, bj, At, B0); } while (0)
#define PG8_XMMA1(ai, bj) do { if constexpr (F8) PG8_MMA8(ai, bj, At8, B18); else PG8_MMA(ai, bj, At, B1); } while (0)
#define PG8_WAIT_V(n) asm volatile("s_waitcnt vmcnt(" #n ")" ::: "memory")
#define PG8_WAIT_L(n) asm volatile("s_waitcnt lgkmcnt(" #n ")" ::: "memory")
#define PG8_BAR __builtin_amdgcn_s_barrier()
#define PG8_SCHED __builtin_amdgcn_sched_barrier(0)
    Unit cur, nxt; int ui = 0;
    if (!S.next(0, cur)) return;
    f32x4 acc[2][2][4][2];
#pragma unroll
    for (int a = 0; a < 2; ++a)
#pragma unroll
        for (int b = 0; b < 2; ++b)
#pragma unroll
            for (int m = 0; m < 4; ++m)
#pragma unroll
                for (int n = 0; n < 2; ++n) acc[a][b][m][n] = zero4();
    bf16x8 At[4][2], B0[2][2], B1[2][2]; v8i_t At8[4], B08[2], B18[2];
    int scl_w = (int)FP8S, scl_1 = 0x7f7f7f7f; if constexpr (F8) asm volatile("" : "+v"(scl_w), "+v"(scl_1));
    unsigned cof[2][2], nof[2][2];
    PG8_LAS unsigned* gscr = (PG8_LAS unsigned*)(lds + 8 * HTB + wid * 1024);
    const char* cA = S.abase(cur); if constexpr (Sched::GATHER) { S.aoffs_load(cur, Rs, gscr); asm volatile("s_waitcnt vmcnt(0)" ::: "memory"); S.aoffs_fin(cur, Rs, Cs, gscr, lane, cof); } const char* cB = S.bbase(cur);
    PG8_STAGE(PG8_SB(0, 0), cB, voffB); PG8_STAGE(PG8_SB(0, 1), cB + hstep, voffB); PG8_STA(PG8_SA(0, 0), cA, 0, false); PG8_STA(PG8_SA(0, 1), cA, 1, false);
    if (wr == 1) PG8_BAR;
    PG8_WAIT_V(2); PG8_BAR;
    PG8_STAGE(PG8_SB(1, 0), cB + kstep, voffB); PG8_STA(PG8_SA(1, 0), cA + kstep, 0, false); PG8_STAGE(PG8_SB(1, 1), cB + hstep + kstep, voffB);
    PG8_WAIT_V(6); PG8_BAR;
    for (;;) {
        const bool has_next = S.next(ui + 1, nxt);
        const char* nA = cA; const char* nB = cB;
        if constexpr (Sched::GATHER) {
#pragma unroll
            for (int h = 0; h < 2; ++h)
#pragma unroll
                for (int i = 0; i < 2; ++i) nof[h][i] = cof[h][i]; }
        if (has_next) { nA = S.abase(nxt); if constexpr (Sched::GATHER) S.aoffs_load(nxt, Rs, gscr); nB = S.bbase(nxt); }
#pragma unroll 1
        for (int t = 0; t < nt; t += 2) {
            const bool last = (t == nt - 2);
            const bool skipw = (t == 0) && (ui > 0) && !Sched::GATHER;
            if constexpr (Sched::GATHER) { if (last && has_next) S.aoffs_fin(nxt, Rs, Cs, gscr, lane, nof); }
            if constexpr (Epi::HOOK) { PG8_SCHED; E.khook(acc, cur, t, wr, wc, fr, fq); PG8_SCHED; }
            const char* a1 = cA + (size_t)(t + 1) * kstep;
            const char* a2 = last ? nA : cA + (size_t)(t + 2) * kstep; const char* b2 = last ? nB : cB + (size_t)(t + 2) * kstep;
            const char* a3 = a2 + kstep; const char* b3 = b2 + kstep;
            PG8_XLDB0(0, 0); PG8_XLDB1(0, 1); PG8_SCHED; PG8_XLDA(0, 0); PG8_STA(PG8_SA(1, 1), a1, 1, false);
            if (!skipw) PG8_WAIT_V(8);
            PG8_WAIT_L(0); PG8_BAR; PG8_XMMA0(0, 0); PG8_XMMA1(0, 1); PG8_BAR; PG8_SCHED;
            PG8_XLDA(0, 1); PG8_STAGE(PG8_SB(0, 0), b2, voffB); PG8_STAGE(PG8_SB(0, 1), b2 + hstep, voffB); PG8_STA(PG8_SA(0, 0), a2, 0, last);
            if (!skipw) PG8_WAIT_V(8);
            PG8_WAIT_L(0); PG8_BAR; PG8_XMMA0(1, 0); PG8_XMMA1(1, 1); PG8_BAR; PG8_SCHED;
            PG8_XLDB0(1, 0); PG8_XLDB1(1, 1); PG8_SCHED; PG8_XLDA(1, 0); PG8_STA(PG8_SA(0, 1), a2, 1, last);
            PG8_WAIT_V(8); PG8_WAIT_L(0); PG8_BAR; PG8_XMMA0(0, 0); PG8_XMMA1(0, 1); PG8_BAR; PG8_SCHED;
            PG8_XLDA(1, 1); PG8_STAGE(PG8_SB(1, 0), b3, voffB); PG8_STAGE(PG8_SB(1, 1), b3 + hstep, voffB); PG8_STA(PG8_SA(1, 0), a3, 0, last);
            PG8_WAIT_V(8); PG8_WAIT_L(0); PG8_BAR; PG8_XMMA0(1, 0); PG8_XMMA1(1, 1); PG8_BAR; PG8_SCHED;
        }
        if constexpr (!Sched::GATHER) PG8_WAIT_V(0);
        if constexpr (F8) {
            asm volatile("s_nop 15\n\ts_nop 15\n\ts_nop 15\n\ts_nop 15\n\ts_nop 15" ::: "memory");
#pragma unroll
            for (int a = 0; a < 2; ++a)
#pragma unroll
                for (int b = 0; b < 2; ++b)
#pragma unroll
                    for (int m = 0; m < 4; ++m) asm volatile("" : "+v"(acc[a][b][m][0]), "+v"(acc[a][b][m][1]));
        }
        if (wr == 0) PG8_BAR;
        E(acc, cur, wr, wc, fr, fq);
#ifdef EPI_DUP
        if (Epi::DUPME) { asm volatile("" ::: "memory"); E(acc, cur, wr, wc, fr, fq); }
#endif
        if (!has_next) break;
#pragma unroll
        for (int a = 0; a < 2; ++a)
#pragma unroll
            for (int b = 0; b < 2; ++b)
#pragma unroll
                for (int m = 0; m < 4; ++m)
#pragma unroll
                    for (int n = 0; n < 2; ++n) acc[a][b][m][n] = zero4();
        cur = nxt; cA = nA; cB = nB; ++ui;
        if constexpr (Sched::GATHER) {
#pragma unroll
            for (int h = 0; h < 2; ++h)
#pragma unroll
                for (int i = 0; i < 2; ++i) cof[h][i] = nof[h][i]; }
        if (wr == 1) PG8_BAR;
    }
    PG8_WAIT_V(0);
    PG8_BAR;
#undef PG8_SA
#undef PG8_SB
#undef PG8_STAGE
#undef PG8_STA
#undef PG8_LDA
#undef PG8_LDB
#undef PG8_MMA
#undef PG8_LD32
#undef PG8_LDA8
#undef PG8_LDB8
#undef PG8_MMA8
#undef PG8_XLDA
#undef PG8_XLDB0
#undef PG8_XLDB1
#undef PG8_XMMA0
#undef PG8_XMMA1
#undef PG8_WAIT_V
#undef PG8_WAIT_L
#undef PG8_BAR
#undef PG8_SCHED
}
}

namespace attn_body {
using bf16=__hip_bfloat16;
using bf16x8=__attribute__((ext_vector_type(8)))short;
using s16x4=__attribute__((ext_vector_type(4)))short;
using f32x16=__attribute__((ext_vector_type(16)))float;
using u32x4=__attribute__((ext_vector_type(4)))unsigned;
constexpr int BATCH=8,NHEAD=8,SEQ=2048,D=64,DM=NHEAD*D,PO=1536,OCOL=512;
constexpr int NW=8,QBLK=32,QB=QBLK*NW,KVBLK=64,NQB=SEQ/QB;
constexpr int ATTN_PITCH=DM, ATTN_UNIT_ROWS=QB;
__device__ __forceinline__ int crow(int r,int hi){return (r&3)+8*(r>>2)+4*hi;}
#define SBAR() __builtin_amdgcn_sched_barrier(0)
__device__ __forceinline__ void cmask(f32x16&p0,f32x16&p1,int jb,int qrel,int hi){
  const float NEG=-INFINITY; int kb=64*jb+4*hi;
  #pragma unroll
  for(int r=0;r<16;++r){int kv=kb+(r&3)+8*(r>>2); if(kv>qrel)p0[r]=NEG; if(kv+32>qrel)p1[r]=NEG;}
}

constexpr int NSLOT=3, SLOTB=8192;
constexpr int LDS_K=0, LDS_V=NSLOT*SLOTB, LDS_WS=2*NSLOT*SLOTB, LDS_OST=LDS_WS+NW*64*4, LDS_BYTES=LDS_OST+NW*4096;
constexpr float C2=0.125f*1.4426950408889634f;
__device__ __forceinline__ void glds16(const void*gsrc,unsigned lds_dst){unsigned keep;
  asm volatile("s_mov_b32 %0, m0\n\ts_mov_b32 m0, %2\n\ts_nop 0\n\tglobal_load_lds_dwordx4 %1, off\n\ts_mov_b32 m0, %0":"=&s"(keep):"v"(gsrc),"s"(lds_dst):"memory");}
__device__ __forceinline__ float max3f(float a,float b,float c){float r;asm("v_max3_f32 %0, %1, %2, %3":"=v"(r):"v"(a),"v"(b),"v"(c));return r;}
__device__ __forceinline__ float max2f(float a,float b){float r;asm("v_max_f32_e32 %0, %1, %2":"=v"(r):"v"(a),"v"(b));return r;}
__device__ __forceinline__ float fadd_s(float a,float b){float r;asm("v_add_f32_e32 %0, %1, %2":"=v"(r):"v"(a),"v"(b));return r;}
__device__ __forceinline__ float fsub_s(float a,float b){float r;asm("v_sub_f32_e32 %0, %1, %2":"=v"(r):"v"(a),"v"(b));return r;}
typedef float f32x2_t __attribute__((ext_vector_type(2))); typedef __bf16 bf16x2_t __attribute__((ext_vector_type(2)));
__device__ __forceinline__ unsigned cvtpk_s(float lo,float hi){f32x2_t v={lo,hi};bf16x2_t b=__builtin_convertvector(v,bf16x2_t);return __builtin_bit_cast(unsigned,b);}
#define WAIT_BAR(N) asm volatile("s_waitcnt vmcnt(" #N ") lgkmcnt(0)\n\ts_barrier":::"memory")

__device__ __forceinline__ void qkt(f32x16&p0,f32x16&p1,const char*Kslot,const bf16x8*qr,bf16x8 ka0,bf16x8 ka1,bf16x8 qaug,int r32,int hi){
  const char*kb=Kslot+hi*1024+r32*16;
  p0=__builtin_amdgcn_mfma_f32_32x32x16_bf16(ka0,qaug,f32x16{},0,0,0);p1=__builtin_amdgcn_mfma_f32_32x32x16_bf16(ka1,qaug,f32x16{},0,0,0);
  #pragma unroll
  for(int d0=0;d0<4;++d0){
    const bf16x8 b0=*reinterpret_cast<const bf16x8*>(kb+d0*2048);
    const bf16x8 b1=*reinterpret_cast<const bf16x8*>(kb+d0*2048+512);
    p0=__builtin_amdgcn_mfma_f32_32x32x16_bf16(b0,qr[d0],p0,0,0,0);p1=__builtin_amdgcn_mfma_f32_32x32x16_bf16(b1,qr[d0],p1,0,0,0);}
}
typedef __attribute__((address_space(3))) const char* lds_cptr;
typedef short v4i16_t __attribute__((ext_vector_type(4)));
__device__ __forceinline__ void kload8(bf16x8*kf,lds_cptr kp){
  kf[0]=*(const __attribute__((address_space(3))) bf16x8*)(kp);      kf[1]=*(const __attribute__((address_space(3))) bf16x8*)(kp+512);
  kf[2]=*(const __attribute__((address_space(3))) bf16x8*)(kp+2048); kf[3]=*(const __attribute__((address_space(3))) bf16x8*)(kp+2560);
  kf[4]=*(const __attribute__((address_space(3))) bf16x8*)(kp+4096); kf[5]=*(const __attribute__((address_space(3))) bf16x8*)(kp+4608);
  kf[6]=*(const __attribute__((address_space(3))) bf16x8*)(kp+6144); kf[7]=*(const __attribute__((address_space(3))) bf16x8*)(kp+6656);
}
__device__ __forceinline__ void kload2(bf16x8*kf,lds_cptr kp,int j){ kf[2*j]=*(const __attribute__((address_space(3))) bf16x8*)(kp+j*2048); kf[2*j+1]=*(const __attribute__((address_space(3))) bf16x8*)(kp+j*2048+512); }
__device__ __forceinline__ s16x4 vtr(lds_cptr p){ return __builtin_bit_cast(s16x4,__builtin_amdgcn_ds_read_tr16_b64_v4i16((__attribute__((address_space(3))) v4i16_t*)p)); }
__device__ __forceinline__ float rowmax(const f32x16&p0,const f32x16&p1){
  float a=max3f(p0[0],p0[1],p1[0]),b=max3f(p0[2],p0[3],p1[1]);a=max3f(a,p1[2],p1[3]);
  #pragma unroll
  for(int r=4;r<16;r+=4){a=max3f(a,p0[r],p0[r+1]);b=max3f(b,p0[r+2],p0[r+3]);a=max3f(a,p1[r],p1[r+1]);b=max3f(b,p1[r+2],p1[r+3]);}
  const float m=max2f(a,b);
  auto rr=__builtin_amdgcn_permlane32_swap(__float_as_uint(m),__float_as_uint(m),false,false);
  return max2f(__uint_as_float(rr[0]),__uint_as_float(rr[1]));
}
__device__ __forceinline__ void pv(f32x16*o,int vb,bf16x8 pa0,bf16x8 pa1,bf16x8 pa2,bf16x8 pa3){
  #pragma unroll
  for(int d0=0;d0<2;++d0){s16x4 lo[4],hi[4];
    #pragma unroll
    for(int ks=0;ks<4;++ks){
      asm volatile("ds_read_b64_tr_b16 %0,%1 offset:%c2":"=&v"(lo[ks]):"v"(vb),"i"(d0*4096+ks*1024):"memory");
      asm volatile("ds_read_b64_tr_b16 %0,%1 offset:%c2":"=&v"(hi[ks]):"v"(vb),"i"(d0*4096+ks*1024+512):"memory");}
    asm volatile("s_waitcnt lgkmcnt(0)":::"memory");SBAR();
    #define PK(k) (bf16x8){lo[k][0],lo[k][1],lo[k][2],lo[k][3],hi[k][0],hi[k][1],hi[k][2],hi[k][3]}
    o[d0]=__builtin_amdgcn_mfma_f32_32x32x16_bf16(pa0,PK(0),o[d0],0,0,0);
    o[d0]=__builtin_amdgcn_mfma_f32_32x32x16_bf16(pa1,PK(1),o[d0],0,0,0);
    o[d0]=__builtin_amdgcn_mfma_f32_32x32x16_bf16(pa2,PK(2),o[d0],0,0,0);
    o[d0]=__builtin_amdgcn_mfma_f32_32x32x16_bf16(pa3,PK(3),o[d0],0,0,0);
    #undef PK
  }
}

#ifndef ATTN_STORE16
#define ATTN_STORE16(p,v) (*(u32x4*)(p)=(v))
#endif
typedef __attribute__((address_space(3))) const u32x4* lds_tabptr;
__device__ __forceinline__ bf16x8 make_qaug(float mhat,int hi){
  const float nm=-mhat; const unsigned h=cvtpk_s(nm,0.f)&0xffffu; const float r1=nm-__uint_as_float(h<<16);
  const unsigned m=cvtpk_s(r1,0.f)&0xffffu; const float r2=r1-__uint_as_float(m<<16); const unsigned l=cvtpk_s(r2,0.f)&0xffffu;
  u32x4 w; w.x=hi?0u:0x3F803F80u; w.y=hi?0u:(0x3F80u|(h<<16)); w.z=hi?0u:(m|(l<<16)); w.w=0u; return __builtin_bit_cast(bf16x8,w);
}
template<int THRL> __device__ __forceinline__ void attn_unit(int b,int h,int qb,const bf16*Q,const bf16*__restrict__ K,const bf16*__restrict__ V,bf16*O,char*shm,lds_tabptr tab){
  int tid_=threadIdx.x; asm volatile("":"+v"(tid_));
  const int tid=tid_,lane=tid&63,r32=lane&31,hi=lane>>5; const int wid=__builtin_amdgcn_readfirstlane(tid>>6);
  const long rowbase=(long)b*SEQ; const int q0=qb*QB;
  const bf16*Qw=Q+(rowbase+q0+wid*QBLK)*DM+h*D;
  const bf16*Kh=K+rowbase*DM+h*D,*Vh=V+rowbase*DM+h*D;
  const unsigned lds0=(unsigned)(uintptr_t)shm;
  float*wsf=(float*)(shm+LDS_WS)+wid*64;
  const bf16*ksrc=Kh+(long)lane*DM+wid*8;
  const bf16*vsrc=Vh+(long)(16*(wid&3)+(lane>>2))*DM+(wid>>2)*32+(lane&3)*8;
  const unsigned kdst=lds0+LDS_K+wid*1024, vdst=lds0+LDS_V+wid*1024;
  #define DMA_K(t,slot) glds16(ksrc+(long)(t)*KVBLK*DM,(unsigned)__builtin_amdgcn_readfirstlane(kdst+(slot)))
  #define DMA_V(t,slot) glds16(vsrc+(long)(t)*KVBLK*DM,(unsigned)__builtin_amdgcn_readfirstlane(vdst+(slot)))
  const int vb0=(int)(lds0+LDS_V)+((lane>>4)&1)*32+(lane&3)*8+(4*hi+((lane&15)>>2))*64;
  const char*Kbase=shm+LDS_K; bf16x8 kf[8];
  const lds_cptr shm3=(lds_cptr)shm; const lds_cptr kp0=shm3+LDS_K+hi*1024+r32*16; const lds_cptr vp0=shm3+LDS_V+((lane>>4)&1)*32+(lane&3)*8+(4*hi+((lane&15)>>2))*64;
  const int NT=(q0+QB)/KVBLK;
  DMA_K(0,0);DMA_V(0,0);DMA_K(1,SLOTB);
  bf16x8 qr[4];
  #pragma unroll
  for(int d0=0;d0<4;++d0)qr[d0]=*reinterpret_cast<const bf16x8*>(&Qw[(long)r32*DM+d0*16+hi*8]);
  float mhat=0.f,l_reg=0.f;f32x16 o[2];o[0]=f32x16{};o[1]=f32x16{};bf16x8 qaug=make_qaug(0.f,hi);asm volatile("":"+v"(qaug));
  const int qrel=wid*QBLK+r32;
  #define CMASK(P0,P1,t) do{int jb_=(t)-(NT-4); if(jb_>=0)cmask(P0,P1,jb_,qrel,hi);}while(0)
  bool resc=false;
  #define START(P0,P1) do{ const float rm=rowmax(P0,P1); resc=false; \
    { const float dl=rm; mhat=fadd_s(mhat,dl); \
      _Pragma("unroll") for(int r=0;r<16;++r){P0[r]=fsub_s(P0[r],dl);P1[r]=fsub_s(P1[r],dl);} \
      qaug=make_qaug(mhat,hi); asm volatile("":"+v"(qaug)); } \
    _Pragma("unroll") for(int r=0;r<16;++r)P0[r]=__builtin_amdgcn_exp2f(P0[r]); }while(0)
  #define RESC() do{ if(resc){ asm volatile("s_waitcnt lgkmcnt(0)":::"memory"); \
      _Pragma("unroll") for(int d_=0;d_<2;++d_) _Pragma("unroll") for(int r=0;r<16;++r)o[d_][r]*=wsf[crow(r,hi)]; } }while(0)
  f32x16 pA0,pA1,pB0,pB1;
  int sl_prev=0,sl_cur=0,sl_next=SLOTB;
  #define ROT() do{sl_prev=sl_cur;sl_cur=sl_next;sl_next=(sl_next==(NSLOT-1)*SLOTB)?0:sl_next+SLOTB;}while(0)
  DMA_K(2,2*SLOTB);
  WAIT_BAR(3);
  qkt(pA0,pA1,Kbase,qr,__builtin_bit_cast(bf16x8,tab[r32]),__builtin_bit_cast(bf16x8,tab[32+r32]),qaug,r32,hi);asm volatile("s_nop 15\n\ts_nop 7":"+v"(pA0),"+v"(pA1));CMASK(pA0,pA1,0);
  START(pA0,pA1);
  _Pragma("unroll") for(int r=0;r<16;++r)pA1[r]=__builtin_amdgcn_exp2f(pA1[r]);
  WAIT_BAR(0);
  DMA_K(3,0);DMA_V(1,SLOTB);
  ROT();
  kload8(kf,kp0+sl_cur);
  WAIT_BAR(2);
  s16x4 vlo[8],vhi[8]; u32x4 pw0,pw1,pw2,pw3;
  #define PKW(P,B) cvtpk_s(P[B],P[B+1])
  #define PAF(k) __builtin_bit_cast(bf16x8,pw##k)
  #define VFR(i) (bf16x8){vlo[i][0],vlo[i][1],vlo[i][2],vlo[i][3],vhi[i][0],vhi[i][1],vhi[i][2],vhi[i][3]}
  #define PIN(x) asm volatile("":"+v"(x))
  #define MX3(a,b,c) __builtin_fmaxf(__builtin_fmaxf((a),(b)),(c))
  #define GAPA(MF,A0,A1,A2,A3,W0,W1,PW) do{ MF; sacc+=A0; sacc+=A1; sacc+=A2; sacc+=A3; PIN(sacc); W0; W1; PIN(PW); SBAR(); }while(0)
  #define EX(v) __builtin_amdgcn_exp2f(v)
  #define GAPB(MF,X,B) do{ MF; X[B]=EX(X[B]); X[B+1]=EX(X[B+1]); X[B+2]=EX(X[B+2]); X[B+3]=EX(X[B+3]); PIN(X); SBAR(); }while(0)
  #define VRD(i) do{ vlo[i]=vtr(vp_+(((i)>>2)*4096+((i)&3)*1024)); vhi[i]=vtr(vp_+(((i)>>2)*4096+((i)&3)*1024+512)); }while(0)
  #define KRD(G,j) do{ if(G){ kload2(kf,kp0+sl_next,j); SBAR(); } }while(0)
  #define STEP(C0,C1,P0,P1,t,GK,GV,GL) do{ SBAR(); \
    const lds_cptr vp_=vp0+sl_prev; \
    const bf16x8 ka0_=__builtin_bit_cast(bf16x8,tab[64*(t)+r32]), ka1_=__builtin_bit_cast(bf16x8,tab[64*(t)+32+r32]); \
    VRD(0); SBAR(); float sacc=(P0[0]+P0[1]); \
    GAPA(C0=__builtin_amdgcn_mfma_f32_32x32x16_bf16(kf[0],qr[0],f32x16{},0,0,0), P0[2],P0[3],P0[4],P0[5],     pw0[0]=PKW(P0,0), pw0[1]=PKW(P0,2), pw0); \
    VRD(4); SBAR(); GAPA(C1=__builtin_amdgcn_mfma_f32_32x32x16_bf16(kf[1],qr[0],f32x16{},0,0,0), P0[6],P0[7],P0[8],P0[9],     pw0[2]=PKW(P0,4), pw0[3]=PKW(P0,6), pw0); \
    VRD(1); SBAR(); GAPA(C0=__builtin_amdgcn_mfma_f32_32x32x16_bf16(kf[2],qr[1],C0,0,0,0),   P0[10],P0[11],P0[12],P0[13], pw1[0]=PKW(P0,8), pw1[1]=PKW(P0,10), pw1); \
    VRD(5); SBAR(); GAPA(C1=__builtin_amdgcn_mfma_f32_32x32x16_bf16(kf[3],qr[1],C1,0,0,0),   P0[14],P0[15],P1[0],P1[1],   pw1[2]=PKW(P0,12),pw1[3]=PKW(P0,14), pw1); \
    VRD(2); SBAR(); GAPA(C0=__builtin_amdgcn_mfma_f32_32x32x16_bf16(kf[4],qr[2],C0,0,0,0),   P1[2],P1[3],P1[4],P1[5],     pw2[0]=PKW(P1,0), pw2[1]=PKW(P1,2), pw2); \
    VRD(6); SBAR(); GAPA(C1=__builtin_amdgcn_mfma_f32_32x32x16_bf16(kf[5],qr[2],C1,0,0,0),   P1[6],P1[7],P1[8],P1[9],     pw2[2]=PKW(P1,4), pw2[3]=PKW(P1,6), pw2); \
    VRD(3); SBAR(); GAPA(C0=__builtin_amdgcn_mfma_f32_32x32x16_bf16(kf[6],qr[3],C0,0,0,0),   P1[10],P1[11],P1[12],P1[13], pw3[0]=PKW(P1,8), pw3[1]=PKW(P1,10), pw3); \
    VRD(7); SBAR(); GAPA(C1=__builtin_amdgcn_mfma_f32_32x32x16_bf16(kf[7],qr[3],C1,0,0,0),   P1[14],P1[15],0.f,0.f,       pw3[2]=PKW(P1,12),pw3[3]=PKW(P1,14), pw3); \
    C0=__builtin_amdgcn_mfma_f32_32x32x16_bf16(ka0_,qaug,C0,0,0,0); C1=__builtin_amdgcn_mfma_f32_32x32x16_bf16(ka1_,qaug,C1,0,0,0); SBAR(); \
    l_reg+=sacc; \
    if(GK){DMA_K((t)+3,sl_cur);} if(GV){DMA_V((t)+1,sl_next);} \
    CMASK(C0,C1,t); \
    { float a=MX3(C0[0],C0[1],C1[0]),b=MX3(C0[2],C0[3],C1[1]); a=MX3(a,C1[2],C1[3]); \
      _Pragma("unroll") for(int r=4;r<16;r+=4){a=MX3(a,C0[r],C0[r+1]);b=MX3(b,C0[r+2],C0[r+3]);a=MX3(a,C1[r],C1[r+1]);b=MX3(b,C1[r+2],C1[r+3]);} \
      float rm=__builtin_fmaxf(a,b); { auto rr=__builtin_amdgcn_permlane32_swap(__float_as_uint(rm),__float_as_uint(rm),false,false); rm=__builtin_fmaxf(__uint_as_float(rr[0]),__uint_as_float(rr[1])); } \
      resc=false; \
      if(__builtin_expect(__any(rm>(float)THRL),0)){ const float dl=__builtin_fmaxf(rm,0.f); mhat+=dl; \
        _Pragma("unroll") for(int r=0;r<16;++r){C0[r]-=dl;C1[r]-=dl;} \
        qaug=make_qaug(mhat,hi); asm volatile("":"+v"(qaug)); \
        const float f=__builtin_amdgcn_exp2f(-dl); l_reg*=f; if(hi==0)wsf[r32]=f; resc=true; } } \
    SBAR(); \
    GAPB(o[0]=__builtin_amdgcn_mfma_f32_32x32x16_bf16(PAF(0),VFR(0),o[0],0,0,0), C0,0); \
    GAPB(o[1]=__builtin_amdgcn_mfma_f32_32x32x16_bf16(PAF(0),VFR(4),o[1],0,0,0), C0,4); \
    KRD(GL,0); GAPB(o[0]=__builtin_amdgcn_mfma_f32_32x32x16_bf16(PAF(1),VFR(1),o[0],0,0,0), C0,8); \
    KRD(GL,1); GAPB(o[1]=__builtin_amdgcn_mfma_f32_32x32x16_bf16(PAF(1),VFR(5),o[1],0,0,0), C0,12); \
    KRD(GL,2); GAPB(o[0]=__builtin_amdgcn_mfma_f32_32x32x16_bf16(PAF(2),VFR(2),o[0],0,0,0), C1,0); \
    KRD(GL,3); GAPB(o[1]=__builtin_amdgcn_mfma_f32_32x32x16_bf16(PAF(2),VFR(6),o[1],0,0,0), C1,4); \
    GAPB(o[0]=__builtin_amdgcn_mfma_f32_32x32x16_bf16(PAF(3),VFR(3),o[0],0,0,0), C1,8); \
    GAPB(o[1]=__builtin_amdgcn_mfma_f32_32x32x16_bf16(PAF(3),VFR(7),o[1],0,0,0), C1,12); \
    }while(0)
  int t=1;
  #undef CMASK
  #define CMASK(P0,P1,t) do{}while(0)
  for(;t+5<NT;t+=2){
    STEP(pB0,pB1,pA0,pA1,t,true,true,true);     WAIT_BAR(2); RESC(); ROT();
    STEP(pA0,pA1,pB0,pB1,t+1,true,true,true);   WAIT_BAR(2); RESC(); ROT();
  }
  #undef CMASK
  #define CMASK(P0,P1,t) do{int jb_=(t)-(NT-4); if(jb_>=0)cmask(P0,P1,jb_,qrel,hi);}while(0)
  #define ENDW(tt) do{ if((tt)+3<NT){WAIT_BAR(2);} else if((tt)+2<NT){WAIT_BAR(1);} else {WAIT_BAR(0);} }while(0)
  for(;t+1<NT;t+=2){
    STEP(pB0,pB1,pA0,pA1,t,(t+3<NT),(t+1<NT),(t+1<NT));       ENDW(t);   RESC(); ROT();
    STEP(pA0,pA1,pB0,pB1,t+1,(t+4<NT),(t+2<NT),(t+2<NT));     ENDW(t+1); RESC(); ROT();
  }
  STEP(pB0,pB1,pA0,pA1,NT-1,false,false,false); RESC();
  { float sacc=pB0[0]+pB0[1]; _Pragma("unroll") for(int r=2;r<16;++r)sacc+=pB0[r]; _Pragma("unroll") for(int r=0;r<16;++r)sacc+=pB1[r]; l_reg+=sacc;
    pw0=(u32x4){PKW(pB0,0),PKW(pB0,2),PKW(pB0,4),PKW(pB0,6)};pw1=(u32x4){PKW(pB0,8),PKW(pB0,10),PKW(pB0,12),PKW(pB0,14)};pw2=(u32x4){PKW(pB1,0),PKW(pB1,2),PKW(pB1,4),PKW(pB1,6)};pw3=(u32x4){PKW(pB1,8),PKW(pB1,10),PKW(pB1,12),PKW(pB1,14)};
    SBAR(); pv(o,vb0+sl_cur,PAF(0),PAF(1),PAF(2),PAF(3)); }
  #undef PKW
  #undef PAF
  #undef VFR
  #undef PIN
  #undef MX3
  #undef GAPA
  #undef GAPB
  #undef EX
  #undef VRD
  #undef KRD
  #undef STEP
  #undef ENDW
  {auto rr=__builtin_amdgcn_permlane32_swap(__float_as_uint(l_reg),__float_as_uint(l_reg),false,false);l_reg=__uint_as_float(rr[0])+__uint_as_float(rr[1]);}
  if(hi==0)wsf[32+r32]=l_reg;asm volatile("s_waitcnt lgkmcnt(0)":::"memory");
  float rli[16];
  #pragma unroll
  for(int r=0;r<16;++r)rli[r]=__builtin_amdgcn_rcpf(wsf[32+crow(r,hi)]);
  bf16*Ow=O+(rowbase+q0+wid*QBLK)*PO+OCOL+h*D;
  { bf16*stg=(bf16*)(shm+LDS_OST)+wid*2048;
    #pragma unroll
    for(int r=0;r<16;++r){const int orow=crow(r,hi);
      #pragma unroll
      for(int d0=0;d0<2;++d0)stg[orow*64+d0*32+r32]=__float2bfloat16(o[d0][r]*rli[r]);}
    asm volatile("s_waitcnt lgkmcnt(0)":::"memory");
    #pragma unroll
    for(int i=0;i<4;++i){const int row=i*8+(lane>>3),ch=lane&7; const u32x4 v=*(const u32x4*)(stg+row*64+ch*8); ATTN_STORE16(Ow+(long)row*PO+ch*8,v);} }
  asm volatile("s_waitcnt lgkmcnt(0)\n\ts_barrier":::"memory");
  #undef DMA_K
  #undef DMA_V
  #undef CMASK
  #undef START
  #undef RESC
  #undef ROT
}
constexpr int ATTN_LDS_BYTES=LDS_BYTES;
#undef SBAR
#undef WAIT_BAR
}
constexpr int NWAVES = 8;
constexpr int D = 1024, BATCH = 8, SEQ = 2048, M = BATCH * SEQ;
constexpr int N_INSRC = 7176, N_INV = 7168;
constexpr int FL_COL = 3072;
constexpr int DFF_D = 2816, DFF_E = 3584, NEXP = 8;
constexpr float LN_EPS = 1e-5f, GN_EPS = 1e-6f;
constexpr float ALPHA = 1.4142135623730951f;
constexpr float LOG2E = 1.4426950408889634f;
constexpr float C2 = 0.125f * LOG2E;

constexpr size_t MiB = 1u << 20;
constexpr size_t WS_CTL = 0, CTL_ZERO_BYTES = 192 * 1024;
constexpr size_t WS_CS = 1 * MiB;
constexpr size_t WS_LIST = 2 * MiB;
constexpr size_t WS_GATEW = 2 * MiB + 512 * 1024;
constexpr size_t WS_LOGF = 3 * MiB;
constexpr size_t WS_GST = 3 * MiB + 512 * 1024;
constexpr size_t WS_WIN = 4 * MiB;
constexpr size_t WS_WBR = 32 * MiB;
constexpr size_t WS_WOUT = 38 * MiB;
constexpr size_t WS_WDU = 42 * MiB;
constexpr size_t WS_WDD = 53 * MiB;
constexpr size_t WS_WMU = 59 * MiB;
constexpr size_t WS_WMD = 171 * MiB;
constexpr size_t WS_XB = 227 * MiB;
constexpr size_t WS_XF = 259 * MiB;
constexpr size_t WS_YPRE = 323 * MiB;
constexpr size_t WS_C1 = 387 * MiB;
constexpr size_t WS_MRG = 451 * MiB;
constexpr size_t WS_RQ = 483 * MiB, WS_RK = 491 * MiB, WS_RV = 499 * MiB, WS_RG = 515 * MiB, WS_FQ = 531 * MiB, WS_FK = 547 * MiB, WS_FV = 563 * MiB,
                 WS_GU = 579 * MiB, WS_GV = 595 * MiB, WS_GT = 611 * MiB, WS_YB = 707 * MiB, WS_KV = 755 * MiB  , WS_X8IN = 771 * MiB  , WS_WIN8 = 787 * MiB  , WS_END = 793 * MiB;
constexpr size_t WS_HID = 483 * MiB;
static_assert((size_t)34816 * DFF_E <= WS_KV - WS_HID, "MoE hidden fits its overlay");
constexpr int CW_TMO = 0, CW_CODE = 1;
constexpr int CW_CNT = 64;
constexpr int CW_BAR = 4096;

constexpr int RING_OFF = 0, RING_BYTES = 141312;
constexpr int LDSCTL_OFF = RING_BYTES, MISC_OFF = LDSCTL_OFF + 320, PTAB_OFF = LDSCTL_OFF + 1024;
constexpr int LDS_BYTES = 147456;
static_assert(MISC_OFF + 128 <= PTAB_OFF && PTAB_OFF + 20 * 8 <= LDS_BYTES, "LDS map");

#define GAS __attribute__((address_space(1)))
#define LAS __attribute__((address_space(3)))
typedef unsigned short bf16;
typedef unsigned v4u __attribute__((ext_vector_type(4)));
typedef unsigned v2u __attribute__((ext_vector_type(2)));
typedef float f32x4 __attribute__((ext_vector_type(4)));
typedef GAS unsigned gu32;
#define RLX_AGENT __ATOMIC_RELAXED, __HIP_MEMORY_SCOPE_AGENT
#define LDS_WAIT() asm volatile("s_waitcnt lgkmcnt(0)" ::: "memory")
#define VM_WAIT() asm volatile("s_waitcnt vmcnt(0)" ::: "memory")
__device__ __forceinline__ unsigned f2bf(float f) { unsigned u = __builtin_bit_cast(unsigned, f); return (u + 0x7fffu + ((u >> 16) & 1u)) >> 16; }
__device__ __forceinline__ unsigned pk2(float lo, float hi) { return f2bf(lo) | (f2bf(hi) << 16); }
__device__ __forceinline__ float bf2f(unsigned short h) { return __builtin_bit_cast(float, (unsigned)h << 16); }
__device__ __forceinline__ float bflo(unsigned w) { return __builtin_bit_cast(float, w << 16); }
__device__ __forceinline__ float bfhi(unsigned w) { return __builtin_bit_cast(float, w & 0xffff0000u); }
constexpr float SC_X8 = 16.f, SC_WU8 = 32.f, SC_H8 = 8.f, SC_WD8 = 128.f;
constexpr float SWI_A = 1.4426950408889634f, SWI_B = SC_H8 / 1.4426950408889634f;
constexpr unsigned E8_UP = 0x76767676u  , E8_DN = 0x75757575u  ;
__device__ __forceinline__ float clamp448(float x) { return fminf(fmaxf(x, -448.f), 448.f); }
__device__ __forceinline__ unsigned pk4_fp8(float a, float b, float c, float d) {
    int w = __builtin_amdgcn_cvt_pk_fp8_f32(clamp448(a), clamp448(b), 0, false); w = __builtin_amdgcn_cvt_pk_fp8_f32(clamp448(c), clamp448(d), w, true); return (unsigned)w; }
constexpr float SC_XI8 = 20.f, SC_WI8 = 127.f * 32.f / 5.f;
__device__ __forceinline__ unsigned pk4_i8(float a, float b, float c, float d) {
    unsigned w = 0u;
    w = __builtin_amdgcn_cvt_pk_u8_f32(__builtin_rintf(a) + 128.f, 0u, w); w = __builtin_amdgcn_cvt_pk_u8_f32(__builtin_rintf(b) + 128.f, 1u, w);
    w = __builtin_amdgcn_cvt_pk_u8_f32(__builtin_rintf(c) + 128.f, 2u, w); w = __builtin_amdgcn_cvt_pk_u8_f32(__builtin_rintf(d) + 128.f, 3u, w);
    return w ^ 0x80808080u; }
__device__ __forceinline__ float fsigmoid(float x) { return __builtin_amdgcn_rcpf(1.0f + __builtin_amdgcn_exp2f(-x * LOG2E)); }
__device__ __forceinline__ float fsilu(float x) { return x * fsigmoid(x); }
typedef float f2v __attribute__((ext_vector_type(2)));
__device__ __forceinline__ f2v fsigmoid2(f2v x) { const f2v t = x * (-LOG2E); f2v e; e.x = __builtin_amdgcn_exp2f(t.x); e.y = __builtin_amdgcn_exp2f(t.y); const f2v d = e + 1.0f; f2v r; r.x = __builtin_amdgcn_rcpf(d.x); r.y = __builtin_amdgcn_rcpf(d.y); return r; }
__device__ __forceinline__ f2v fsilu2(f2v x) { return x * fsigmoid2(x); }
__device__ __forceinline__ f2v swi_folded2(f2v a, f2v b) { f2v e; e.x = __builtin_amdgcn_exp2f(-a.x); e.y = __builtin_amdgcn_exp2f(-a.y); const f2v d = e + 1.0f; f2v r; r.x = __builtin_amdgcn_rcpf(d.x); r.y = __builtin_amdgcn_rcpf(d.y); return (a * b) * r; }
__device__ __forceinline__ f2v fgelu_tanh2(f2v x) {
    const f2v t = x * (x * x * (-0.0713548163f * LOG2E) + (-1.5957691216f * LOG2E)); f2v e; e.x = __builtin_amdgcn_exp2f(t.x); e.y = __builtin_amdgcn_exp2f(t.y);
    const f2v d = e + 1.0f; f2v r; r.x = __builtin_amdgcn_rcpf(d.x); r.y = __builtin_amdgcn_rcpf(d.y); return x * r; }
__device__ __forceinline__ float fgelu_tanh(float x) { const float u = 0.7978845608028654f * (x + 0.044715f * x * x * x); return x * fsigmoid(2.0f * u); }

#define XB_TMO      128
#define XB_XCNT(j)  (256  + 64 * (j))
#define XB_XSUB(j)  (1280 + 64 * (j))
#define XB_XGEN(j)  (2304 + 64 * (j))
#define XB_TOP      3328
#define XB_TOPGEN   3392
#define XCD_BAR_WORDS 3456
#define XB_SPIN_CAP (1u << 18)
__device__ __forceinline__ unsigned xb_ld(unsigned* p)              { return __hip_atomic_load(p, __ATOMIC_RELAXED, __HIP_MEMORY_SCOPE_AGENT); }
__device__ __forceinline__ unsigned xb_add(unsigned* p, unsigned v) { return __hip_atomic_fetch_add(p, v, __ATOMIC_RELAXED, __HIP_MEMORY_SCOPE_AGENT); }
__device__ __forceinline__ unsigned xb_xcc_id() { return (unsigned)__builtin_amdgcn_s_getreg((3 << 11) | 20) & 0xFu; }
#define XB_SPIN(cond, bar) do { unsigned _sp = 0; while (cond) { __builtin_amdgcn_s_sleep(1); \
    if ((++_sp & 255u) == 0u) { if (xb_ld(&(bar)[XB_TMO])) break; if (_sp > XB_SPIN_CAP) { atomicAdd(&(bar)[XB_TMO], 1u); break; } } } } while (0)
struct XcdBarrier { unsigned* bar; unsigned x; volatile LAS unsigned* st; unsigned total; unsigned lite; };
__device__ __forceinline__ XcdBarrier xcd_barrier_post(unsigned* bar, volatile LAS unsigned* st, unsigned total, unsigned lite) {
    XcdBarrier b; b.bar = bar; b.x = xb_xcc_id(); b.st = st; b.total = total; b.lite = lite;
    if (threadIdx.x == 0) (void)xb_add(&bar[XB_XCNT(b.x)], 1u);
    return b;
}
__device__ __forceinline__ void xcd_barrier_complete(unsigned* bar, unsigned x, unsigned G, unsigned& nloc, unsigned& nx) {
    unsigned sum, cnt, mine, sp = 0u;
    for (;;) {
        sum = 0u; cnt = 0u; mine = 0u;
#pragma unroll
        for (unsigned j = 0; j < 16; ++j) { const unsigned c = xb_ld(&bar[XB_XCNT(j)]); sum += c; cnt += (c > 0u) ? 1u : 0u; mine = (j == x) ? c : mine; }
        if (sum == G) break;
        __builtin_amdgcn_s_sleep(1);
        if ((++sp & 255u) == 0u) { if (xb_ld(&bar[XB_TMO])) break; if (sp > XB_SPIN_CAP) { atomicAdd(&bar[XB_TMO], 1u); break; } }
    }
    nloc = mine > 0u ? mine : 1u; nx = cnt > 0u ? cnt : 1u;
}
__device__ __forceinline__ void xcd_barrier(const XcdBarrier& b) {
    asm volatile("s_waitcnt vmcnt(0)" ::: "memory");
    __syncthreads();
    if (threadIdx.x == 0) {
        unsigned* bar = b.bar;
        __builtin_amdgcn_s_waitcnt(0);
        unsigned nloc = b.st[0], nx = b.st[1];
        if (nloc == 0u) { xcd_barrier_complete(bar, b.x, b.total, nloc, nx); b.st[0] = nloc; b.st[1] = nx; }
        const unsigned old = xb_add(&bar[XB_XSUB(b.x)], 1u);
        const unsigned gen = old / nloc;
        if (old + 1u == (gen + 1u) * nloc) {
            if (!(b.lite != 0u && nx == 1u)) {
                __builtin_amdgcn_fence(__ATOMIC_RELEASE, "agent");
                asm volatile("s_waitcnt vmcnt(0)" ::: "memory");
            }
            if (nx != 1u) {
                const unsigned og = xb_add(&bar[XB_TOP], 1u);
                const unsigned tg = og / nx;
                if (og + 1u == (tg + 1u) * nx) xb_add(&bar[XB_TOPGEN], 1u);
                else XB_SPIN(xb_ld(&bar[XB_TOPGEN]) == tg, bar);
            }
            __builtin_amdgcn_fence(__ATOMIC_ACQUIRE, "agent");
            xb_add(&bar[XB_XGEN(b.x)], 1u);
            asm volatile("s_waitcnt vmcnt(0)" ::: "memory");
        } else {
            XB_SPIN(xb_ld(&bar[XB_XGEN(b.x)]) == gen, bar);
            __builtin_amdgcn_fence(__ATOMIC_ACQUIRE, "agent");
            asm volatile("s_waitcnt vmcnt(0)" ::: "memory");
        }
    }
    __syncthreads();
}

using pg8::Unit; using pg8::bf16_t;
#define ACC_T const pg8::f32x4 (&acc)[2][2][4][2]

struct ProjSched : pg8::PlainSched {
    __device__ __forceinline__ bool next(int i, Unit& u) const { if (!pg8::PlainSched::next(i, u)) return false; if (nN == 16 && ((u.pm >> 2) & 1)) u.pn = (u.pn + 4) & 15; return true; }
};
struct EpiProj {
    static constexpr bool PERM = true, HOOK = false, DUPME = true;
    unsigned char* ws; const float* gate_b; const float* cs;
    __device__ __forceinline__ void operator()(ACC_T, const Unit& u, int wr, int wc, int fr, int fq) const {
        const int pn = u.pn, row0 = u.pm * 256 + wr * 64 + fr, lc = wc * 32 + 8 * fq;
        if (pn < 2) {
            bf16_t* dst = (bf16_t*)(ws + (pn == 0 ? WS_RQ : WS_RK)); const float sc = pn == 0 ? 1.0f : 0.125f;
            const int d1 = 16 * (wc & 1) + 4 * fq;
#pragma unroll
            for (int ai = 0; ai < 2; ++ai)
#pragma unroll
                for (int m = 0; m < 4; ++m) { const int row = row0 + ai * 128 + m * 16, pos = row & (SEQ - 1);
                    const f32x4 c4 = *(const f32x4*)(cs + pos * 32 + d1), s4 = *(const f32x4*)(cs + 65536 + pos * 32 + d1);
#pragma unroll
                    for (int bj = 0; bj < 2; ++bj) { const int head = bj * 2 + (wc >> 1); const f32x4 x1 = acc[ai][bj][m][0], x2 = acc[ai][bj][m][1];
                        const f32x4 o1 = (x1 * c4 - x2 * s4) * sc, o2 = (x1 * s4 + x2 * c4) * sc;
                        bf16_t* p = dst + (size_t)row * 256 + head * 64 + d1;
                        v2u w1, w2; w1.x = pg8::cvt_pk_bf16(o1[0], o1[1]); w1.y = pg8::cvt_pk_bf16(o1[2], o1[3]); w2.x = pg8::cvt_pk_bf16(o2[0], o2[1]); w2.y = pg8::cvt_pk_bf16(o2[2], o2[3]);
                        *(v2u*)p = w1; *(v2u*)(p + 32) = w2; } }
            return;
        }
        if (pn < 4) store_act<0>(acc, WS_RV, 512, (pn - 2) * 256, row0, lc);
        else if (pn < 6) store_act<1>(acc, WS_RG, 512, (pn - 4) * 256, row0, lc);
        else if (pn < 8) store_act<2>(acc, WS_FQ, 512, (pn - 6) * 256, row0, lc);
        else if (pn < 10) store_act<0>(acc, WS_FK, 512, (pn - 8) * 256, row0, lc);
        else if (pn < 12) store_act<0>(acc, WS_FV, 512, (pn - 10) * 256, row0, lc);
        else if (pn < 14) store_act<3>(acc, WS_GU, 512, (pn - 12) * 256, row0, lc);
        else if (pn < 16) store_act<3>(acc, WS_GV, 512, (pn - 14) * 256, row0, lc);
        else store_act<4>(acc, WS_GT, 3072, (pn - 16) * 256, row0, lc);
    }
    template <int ACT>
    __device__ __forceinline__ void store_act(ACC_T, size_t off, int pitch, int coff, int row0, int lc) const {
        bf16_t* dst = (bf16_t*)(ws + off);
        f32x4 bv[2][2];
#pragma unroll
        for (int bj = 0; bj < 2; ++bj)
#pragma unroll
            for (int n = 0; n < 2; ++n) bv[bj][n] = (ACT == 4) ? *(const f32x4*)(gate_b + coff + bj * 128 + lc + 4 * n) : (f32x4){0.f, 0.f, 0.f, 0.f};
#pragma unroll
        for (int ai = 0; ai < 2; ++ai)
#pragma unroll
            for (int m = 0; m < 4; ++m) { bf16_t* rowp = dst + (size_t)(row0 + ai * 128 + m * 16) * pitch + coff + lc;
#pragma unroll
                for (int bj = 0; bj < 2; ++bj) { f2v v[4];
#pragma unroll
                    for (int n = 0; n < 2; ++n) { const f32x4 a = acc[ai][bj][m][n]; v[2 * n] = __builtin_shufflevector(a, a, 0, 1); v[2 * n + 1] = __builtin_shufflevector(a, a, 2, 3);
                        if (ACT == 4) { v[2 * n] += __builtin_shufflevector(bv[bj][n], bv[bj][n], 0, 1); v[2 * n + 1] += __builtin_shufflevector(bv[bj][n], bv[bj][n], 2, 3); } }
#pragma unroll
                    for (int j = 0; j < 4; ++j) { f2v x = v[j];
                        if (ACT == 1) x = fsilu2(x); else if (ACT == 2) x = x * C2; else if (ACT == 3) x = fgelu_tanh2(x); else if (ACT == 4) x = fsigmoid2(x);
                        v[j] = x; }
                    v4u w; w.x = pg8::cvt_pk_bf16(v[0].x, v[0].y); w.y = pg8::cvt_pk_bf16(v[1].x, v[1].y); w.z = pg8::cvt_pk_bf16(v[2].x, v[2].y); w.w = pg8::cvt_pk_bf16(v[3].x, v[3].y);
                    *(v4u*)(rowp + bj * 128) = w; } }
    }
};

struct EpiGate8 {
    static constexpr bool PERM = true, HOOK = false, DUPME = false;
    bf16_t* GT; const float* gate_b;
    __device__ __forceinline__ void operator()(ACC_T, const Unit& u, int wr, int wc, int fr, int fq) const {
        const int row0 = u.pm * 256 + wr * 64 + fr, lc = wc * 32 + 8 * fq, coff = u.pn * 256;
        f32x4 bv[2][2];
#pragma unroll
        for (int bj = 0; bj < 2; ++bj)
#pragma unroll
            for (int n = 0; n < 2; ++n) bv[bj][n] = *(const f32x4*)(gate_b + coff + bj * 128 + lc + 4 * n);
#pragma unroll
        for (int ai = 0; ai < 2; ++ai)
#pragma unroll
            for (int m = 0; m < 4; ++m) { bf16_t* rowp = GT + (size_t)(row0 + ai * 128 + m * 16) * 3072 + coff + lc;
#pragma unroll
                for (int bj = 0; bj < 2; ++bj) { f2v v[4];
#pragma unroll
                    for (int n = 0; n < 2; ++n) { const f32x4 a = acc[ai][bj][m][n] + bv[bj][n]; v[2 * n] = fsigmoid2(__builtin_shufflevector(a, a, 0, 1)); v[2 * n + 1] = fsigmoid2(__builtin_shufflevector(a, a, 2, 3)); }
                    v4u w; w.x = pg8::cvt_pk_bf16(v[0].x, v[0].y); w.y = pg8::cvt_pk_bf16(v[1].x, v[1].y); w.z = pg8::cvt_pk_bf16(v[2].x, v[2].y); w.w = pg8::cvt_pk_bf16(v[3].x, v[3].y);
                    *(v4u*)(rowp + bj * 128) = w; } }
    }
};

struct EpiMerge {
    static constexpr bool PERM = true, HOOK = true, DUPME = false;
    const bf16_t* GT; bf16_t* MRG;
    __device__ __forceinline__ void unpackg(const v4u w, float (&g)[8]) const {
        g[0] = bflo(w.x); g[1] = bfhi(w.x); g[2] = bflo(w.y); g[3] = bfhi(w.y); g[4] = bflo(w.z); g[5] = bfhi(w.z); g[6] = bflo(w.w); g[7] = bfhi(w.w);
#pragma unroll
        for (int j = 0; j < 8; ++j) g[j] = fmaxf(g[j], 1e-30f);
    }
    __device__ __forceinline__ void khook(pg8::f32x4 (&acc)[2][2][4][2], const Unit& u, int t, int wr, int wc, int fr, int fq) const {
        if (t != 8 && t != 16) return;
        const int np = (t == 8) ? 0 : 1; int row0 = u.pm * 256 + wr * 64 + fr; const int col0 = u.pn * 256 + wc * 32 + 8 * fq;
        asm volatile("" : "+v"(row0));
#pragma unroll
        for (int ai = 0; ai < 2; ++ai) {
            v4u wp[4][2], wn[4][2];
#pragma unroll
            for (int m = 0; m < 4; ++m)
#pragma unroll
                for (int bj = 0; bj < 2; ++bj) { const bf16_t* p = GT + (size_t)(row0 + ai * 128 + m * 16) * 3072 + np * 1024 + col0 + bj * 128; wp[m][bj] = *(const v4u*)p; wn[m][bj] = *(const v4u*)(p + 1024); }
#pragma unroll
            for (int m = 0; m < 4; ++m)
#pragma unroll
                for (int bj = 0; bj < 2; ++bj) { const unsigned pw[4] = {wp[m][bj].x, wp[m][bj].y, wp[m][bj].z, wp[m][bj].w}, nw[4] = {wn[m][bj].x, wn[m][bj].y, wn[m][bj].z, wn[m][bj].w};
#pragma unroll
                    for (int q = 0; q < 4; ++q) {
                        f2v gp2, gn2; gp2.x = bflo(pw[q]); gp2.y = bfhi(pw[q]); gn2.x = fmaxf(bflo(nw[q]), 1e-30f); gn2.y = fmaxf(bfhi(nw[q]), 1e-30f);
                        f2v r2; r2.x = __builtin_amdgcn_rcpf(gn2.x); r2.y = __builtin_amdgcn_rcpf(gn2.y); const f2v ratio = gp2 * r2;
                        pg8::f32x4& a4 = acc[ai][bj][m][q >> 1];
                        if (q & 1) { a4.z *= ratio.x; a4.w *= ratio.y; } else { a4.x *= ratio.x; a4.y *= ratio.y; } } }
            asm volatile("" ::: "memory");
        }
    }
    __device__ __forceinline__ void operator()(ACC_T, const Unit& u, int wr, int wc, int fr, int fq) const {
        const int row0 = u.pm * 256 + wr * 64 + fr, col0 = u.pn * 256 + wc * 32 + 8 * fq;
#pragma unroll
        for (int ai = 0; ai < 2; ++ai) {
            v4u wg[4][2];
#pragma unroll
            for (int m = 0; m < 4; ++m)
#pragma unroll
                for (int bj = 0; bj < 2; ++bj) wg[m][bj] = *(const v4u*)(GT + (size_t)(row0 + ai * 128 + m * 16) * 3072 + 2048 + col0 + bj * 128);
#pragma unroll
            for (int m = 0; m < 4; ++m)
#pragma unroll
                for (int bj = 0; bj < 2; ++bj) { const unsigned gw[4] = {wg[m][bj].x, wg[m][bj].y, wg[m][bj].z, wg[m][bj].w}; unsigned o[4];
#pragma unroll
                    for (int q = 0; q < 4; ++q) { f2v g2; g2.x = bflo(gw[q]); g2.y = bfhi(gw[q]); const pg8::f32x4 a4 = acc[ai][bj][m][q >> 1];
                        f2v a2; if (q & 1) { a2.x = a4.z; a2.y = a4.w; } else { a2.x = a4.x; a2.y = a4.y; } const f2v p = a2 * g2; o[q] = pg8::cvt_pk_bf16(p.x, p.y); }
                    v4u w; w.x = o[0]; w.y = o[1]; w.z = o[2]; w.w = o[3];
                    *(v4u*)(MRG + (size_t)(row0 + ai * 128 + m * 16) * 1024 + col0 + bj * 128) = w; }
            asm volatile("" ::: "memory");
        }
    }
};

struct EpiResid {
    static constexpr bool PERM = false, HOOK = false, DUPME = false;
    const float* res; float* out;
    __device__ __forceinline__ void operator()(ACC_T, const Unit& u, int wr, int wc, int fr, int fq) const {
        const int row0 = u.pm * 256 + wr * 64 + fr, col0 = u.pn * 256 + wc * 32 + 4 * fq;
#pragma unroll
        for (int ai = 0; ai < 2; ++ai)
#pragma unroll
            for (int m = 0; m < 4; ++m) { const size_t off = (size_t)(row0 + ai * 128 + m * 16) * 1024 + col0;
#pragma unroll
                for (int bj = 0; bj < 2; ++bj)
#pragma unroll
                    for (int n = 0; n < 2; ++n) { const f32x4 r = *(const f32x4*)(res + off + bj * 128 + n * 16); *(f32x4*)(out + off + bj * 128 + n * 16) = r * ALPHA + acc[ai][bj][m][n]; } }
    }
};

struct EpiSwiglu {
    static constexpr bool PERM = true, HOOK = false, DUPME = false;
    bf16_t* H; int ldh;
    __device__ __forceinline__ void operator()(ACC_T, const Unit& u, int wr, int wc, int fr, int fq) const {
        const int row0 = u.pm * 256 + wr * 64 + fr, col0 = u.pn * 128 + wc * 16 + 4 * fq;
#pragma unroll
        for (int ai = 0; ai < 2; ++ai)
#pragma unroll
            for (int m = 0; m < 4; ++m) { bf16_t* rowp = H + (size_t)(row0 + ai * 128 + m * 16) * ldh + col0;
#pragma unroll
                for (int bj = 0; bj < 2; ++bj) { const f32x4 a = acc[ai][bj][m][0], b = acc[ai][bj][m][1];
                    const f2v o01 = fsilu2(__builtin_shufflevector(a, a, 0, 1)) * __builtin_shufflevector(b, b, 0, 1), o23 = fsilu2(__builtin_shufflevector(a, a, 2, 3)) * __builtin_shufflevector(b, b, 2, 3);
                    v2u w; w.x = pg8::cvt_pk_bf16(o01.x, o01.y); w.y = pg8::cvt_pk_bf16(o23.x, o23.y);
                    *(v2u*)(rowp + bj * 64) = w; } }
    }
};

struct EpiSwigluI8 {
    static constexpr bool PERM = true, HOOK = false, DUPME = false;
    bf16_t* H; int ldh;
    __device__ __forceinline__ void operator()(ACC_T, const Unit& u, int wr, int wc, int fr, int fq) const {
        typedef int i32x4_t __attribute__((ext_vector_type(4)));
        constexpr float CA = LOG2E / (SC_XI8 * SC_WI8), CB = 1.0f / (SC_XI8 * SC_WI8 * LOG2E);
        const int row0 = u.pm * 256 + wr * 64 + fr, col0 = u.pn * 128 + wc * 16 + 4 * fq;
#pragma unroll
        for (int ai = 0; ai < 2; ++ai)
#pragma unroll
            for (int m = 0; m < 4; ++m) { bf16_t* rowp = H + (size_t)(row0 + ai * 128 + m * 16) * ldh + col0;
#pragma unroll
                for (int bj = 0; bj < 2; ++bj) {
                    const f32x4 a = __builtin_convertvector(__builtin_bit_cast(i32x4_t, acc[ai][bj][m][0]), f32x4) * CA, b = __builtin_convertvector(__builtin_bit_cast(i32x4_t, acc[ai][bj][m][1]), f32x4) * CB;
                    const f2v o01 = swi_folded2(__builtin_shufflevector(a, a, 0, 1), __builtin_shufflevector(b, b, 0, 1)), o23 = swi_folded2(__builtin_shufflevector(a, a, 2, 3), __builtin_shufflevector(b, b, 2, 3));
                    v2u w; w.x = pg8::cvt_pk_bf16(o01.x, o01.y); w.y = pg8::cvt_pk_bf16(o23.x, o23.y);
                    *(v2u*)(rowp + bj * 64) = w; } }
    }
};

struct MoeTiles {
    int cnt[NEXP]; int toff[NEXP + 1];
    __device__ __forceinline__ void init(const gu32* ctl) {
        int t = 0;
#pragma unroll
        for (int e = 0; e < NEXP; ++e) { cnt[e] = __builtin_amdgcn_readfirstlane((int)__hip_atomic_load(ctl + CW_CNT + 64 * e, RLX_AGENT)); toff[e] = t; t += (cnt[e] + 255) >> 8; }
        toff[NEXP] = t;
    }
    __device__ __forceinline__ void find(int pm, int& e, int& slot0, int& n) const {
        int ee = 0;
#pragma unroll
        for (int j = 1; j < NEXP; ++j) if (pm >= toff[j]) ee = j;
        int c = 0, t0 = 0;
#pragma unroll
        for (int j = 0; j < NEXP; ++j) if (j == ee) { c = cnt[j]; t0 = toff[j]; }
        e = ee; slot0 = (pm - t0) * 256; n = c;
    }
    __device__ __forceinline__ int nfull_total() const { int a = 0;
#pragma unroll
        for (int j = 0; j < NEXP; ++j) a += cnt[j] >> 8;
        return a; }
    __device__ __forceinline__ void findfull(int pmf, int& e, int& lt, int& htile) const {
        int a = 0, ee = 0, ll = 0, hh = 0;
#pragma unroll
        for (int j = 0; j < NEXP; ++j) { const int nf = cnt[j] >> 8; if (pmf >= a && pmf < a + nf) { ee = j; ll = pmf - a; hh = toff[j] + ll; } a += nf; }
        e = ee; lt = ll; htile = hh;
    }
    __device__ __forceinline__ void expert(int e, int& c, int& t0) const { int cc = 0, tt = 0;
#pragma unroll
        for (int j = 0; j < NEXP; ++j) if (j == e) { cc = cnt[j]; tt = toff[j]; }
        c = cc; t0 = tt; }
};
struct MoeUpSched : pg8::TileOrder {
    static constexpr bool GATHER = true;
    const unsigned char* A; const unsigned char* Bt; const unsigned* list; MoeTiles mt;
    __device__ __forceinline__ const char* abase(const Unit&) const { return (const char*)A; }
    __device__ __forceinline__ void aoffs_load(const Unit& u, const int (&R)[2], PG8_LAS unsigned* scr) const {
        int e, s0, n; mt.find(u.pm, e, s0, n);
#pragma unroll
        for (int h = 0; h < 2; ++h)
#pragma unroll
            for (int i = 0; i < 2; ++i) { int slot = s0 + R[i] + h * 128; slot = slot < 16383 ? slot : 16383;
                __builtin_amdgcn_global_load_lds(list + e * 16384 + slot, scr + (h * 2 + i) * 64, 4, 0, 0); }
    }
    __device__ __forceinline__ void aoffs_fin(const Unit& u, const int (&R)[2], const int (&C)[2], const PG8_LAS unsigned* scr, int lane, unsigned (&o)[2][2]) const {
        int e, s0, n; mt.find(u.pm, e, s0, n);
#pragma unroll
        for (int h = 0; h < 2; ++h)
#pragma unroll
            for (int i = 0; i < 2; ++i) { const int slot = s0 + R[i] + h * 128; const unsigned w = scr[(h * 2 + i) * 64 + lane]; const unsigned tok = slot < n ? (w & 0x7fffffffu) : 0u; o[h][i] = tok * 1024u + 2u * (unsigned)C[i]; }
    }
    __device__ __forceinline__ const char* bbase(const Unit& u) const { int e, s0, n; mt.find(u.pm, e, s0, n); return (const char*)Bt + ((size_t)e * (2 * DFF_E) + (size_t)u.pn * 256) * 1024; }
};
struct MoeDownSched : pg8::TileOrder {
    static constexpr bool GATHER = false;
    const unsigned char* A; const unsigned char* Bt; MoeTiles mt;
    __device__ __forceinline__ const char* abase(const Unit& u) const { int e, lt, ht; mt.findfull(u.pm, e, lt, ht); return (const char*)A + (size_t)ht * 256 * DFF_E; }
    __device__ __forceinline__ void aoffs_load(const Unit&, const int (&)[2], PG8_LAS unsigned*) const {}
    __device__ __forceinline__ void aoffs_fin(const Unit&, const int (&)[2], const int (&)[2], const PG8_LAS unsigned*, int, unsigned (&)[2][2]) const {}
    __device__ __forceinline__ const char* bbase(const Unit& u) const { int e, lt, ht; mt.findfull(u.pm, e, lt, ht); return (const char*)Bt + ((size_t)e * 1024 + (size_t)u.pn * 256) * DFF_E; }
};
struct EpiSwiglu8 {
    static constexpr bool PERM = true, HOOK = false, DUPME = false;
    unsigned char* H; int ldh;
    static __device__ __forceinline__ f2v swi8x2(f2v a, f2v b) {
        f2v e; e.x = __builtin_amdgcn_exp2f(-a.x); e.y = __builtin_amdgcn_exp2f(-a.y); const f2v d = e + 1.0f; f2v r; r.x = __builtin_amdgcn_rcpf(d.x); r.y = __builtin_amdgcn_rcpf(d.y); return (a * b) * r; }
    static __device__ __forceinline__ float swi8(float a, float b) { return (a * b) * __builtin_amdgcn_rcpf(1.0f + __builtin_amdgcn_exp2f(-a)); }
    __device__ __forceinline__ void operator()(ACC_T, const Unit& u, int wr, int wc, int fr, int fq) const {
        const int row0 = u.pm * 256 + wr * 64 + fr, col0 = u.pn * 128 + wc * 16;
#pragma unroll
        for (int ai = 0; ai < 2; ++ai)
#pragma unroll
            for (int bj = 0; bj < 2; ++bj) { unsigned x[4];
#pragma unroll
                for (int m = 0; m < 4; ++m) { const f32x4 a = acc[ai][bj][m][0], b = acc[ai][bj][m][1];
                    const f2v o01 = swi8x2(__builtin_shufflevector(a, a, 0, 1), __builtin_shufflevector(b, b, 0, 1)), o23 = swi8x2(__builtin_shufflevector(a, a, 2, 3), __builtin_shufflevector(b, b, 2, 3));
                    x[m] = pk4_fp8(o01.x, o01.y, o23.x, o23.y); }
                const auto p01 = __builtin_amdgcn_permlane16_swap(x[0], x[1], false, false), p23 = __builtin_amdgcn_permlane16_swap(x[2], x[3], false, false);
                const auto q02 = __builtin_amdgcn_permlane32_swap(p01[0], p23[0], false, false), q13 = __builtin_amdgcn_permlane32_swap(p01[1], p23[1], false, false);
                v4u w; w.x = q02[0]; w.y = q13[0]; w.z = q02[1]; w.w = q13[1];
                *(v4u*)(H + (size_t)(row0 + ai * 128 + fq * 16) * ldh + col0 + bj * 64) = w; }
    }
};
struct EpiMoeDown {
    static constexpr bool PERM = true, HOOK = false, DUPME = false;
    bf16_t* c0; bf16_t* c1; const unsigned* list; const float* gatew; MoeTiles mt;
    __device__ __forceinline__ void operator()(ACC_T, const Unit& u, int wr, int wc, int fr, int fq) const {
        int e, lt, ht; mt.findfull(u.pm, e, lt, ht); const int s0 = lt * 256;
        const int col0 = u.pn * 256 + wc * 32 + 8 * fq;
        unsigned ent[2][4]; float gg[2][4];
#pragma unroll
        for (int ai = 0; ai < 2; ++ai)
#pragma unroll
            for (int m = 0; m < 4; ++m) { const int slot = s0 + ai * 128 + wr * 64 + m * 16 + fr; ent[ai][m] = list[e * 16384 + slot]; gg[ai][m] = gatew[e * 16384 + slot]; }
#pragma unroll
        for (int ai = 0; ai < 2; ++ai)
#pragma unroll
            for (int m = 0; m < 4; ++m) { const float g = gg[ai][m];
                bf16_t* dst = ((ent[ai][m] >> 31) ? c1 : c0) + (size_t)(ent[ai][m] & 0x7fffffffu) * 1024 + col0;
#pragma unroll
                for (int bj = 0; bj < 2; ++bj) { const pg8::f32x4 a = acc[ai][bj][m][0] * g, b = acc[ai][bj][m][1] * g;
                    v4u w; w.x = pg8::cvt_pk_bf16(a[0], a[1]); w.y = pg8::cvt_pk_bf16(a[2], a[3]); w.z = pg8::cvt_pk_bf16(b[0], b[1]); w.w = pg8::cvt_pk_bf16(b[2], b[3]);
                    *(v4u*)(dst + bj * 128) = w; } }
    }
};

struct Frame {
    LAS unsigned char* lds;
    volatile LAS unsigned* MISC;
    gu32* ctl;
    int tid, lane, wave;
    int vcu, G;
    unsigned char* ws;
};
__device__ __forceinline__ float wave_sum(float v) {
#pragma unroll
    for (int o = 1; o < 64; o <<= 1) v += __shfl_xor(v, o);
    return v;
}

__device__ __forceinline__ int mapcol(int kind, int dff, int v) {
    if (kind == 0) return v;
    if (kind == 1) {
        if (v < 512) { const int w = v & 63; return (v & ~63) + 32 * ((w >> 2) & 1) + 4 * (w >> 3) + (w & 3); }
        return v < FL_COL ? v : v + 8;
    }
    const int tile = v >> 8, vl = v & 255, n = (vl >> 2) & 1, j = tile * 128 + (vl >> 3) * 4 + (vl & 3);
    return n ? dff + j : j;
}
__device__ __forceinline__ void cvt_item(const float* W, int Nsrc, bf16* dst, int dpitch, int koff, int kind, int dff, int k0, int v0, LAS float* scr, int lane, float f8scale, int vbase) {
    const int v4 = lane & 15, kq = lane >> 4;
    const float* src = W + (size_t)(k0 + kq) * Nsrc + mapcol(kind, dff, vbase + v0 + 4 * v4);
    f32x4 t[16];
#pragma unroll
    for (int it = 0; it < 16; ++it) t[it] = *(const f32x4*)(src + (size_t)(4 * it) * Nsrc);
#pragma unroll
    for (int it = 0; it < 16; ++it) *(LAS f32x4*)(scr + (kq + 4 * it) * 68 + 4 * v4) = t[it];
    LDS_WAIT(); asm volatile("" ::: "memory");
    if (f8scale != 0.f) {
        const int c = lane & 3; unsigned char* d8 = (unsigned char*)dst;
        if (f8scale < 0.f) {
#pragma unroll
            for (int j = 0; j < 4; ++j) { const int n = (lane >> 2) + 16 * j; const LAS float* s = scr + (16 * c) * 68 + n; const float q = -f8scale;
                v4u o; o.x = pk4_i8(s[0 * 68] * q, s[1 * 68] * q, s[2 * 68] * q, s[3 * 68] * q); o.y = pk4_i8(s[4 * 68] * q, s[5 * 68] * q, s[6 * 68] * q, s[7 * 68] * q);
                o.z = pk4_i8(s[8 * 68] * q, s[9 * 68] * q, s[10 * 68] * q, s[11 * 68] * q); o.w = pk4_i8(s[12 * 68] * q, s[13 * 68] * q, s[14 * 68] * q, s[15 * 68] * q);
                *(GAS v4u*)(d8 + (size_t)(v0 + n) * dpitch + koff + k0 + 16 * c) = o; }
            LDS_WAIT(); asm volatile("" ::: "memory"); return; }
        if (kind == 2) f8scale *= (lane & 16) ? SWI_B : SWI_A;
#pragma unroll
        for (int j = 0; j < 4; ++j) { const int n = (lane >> 2) + 16 * j; const LAS float* s = scr + (16 * c) * 68 + n;
            v4u o; o.x = pk4_fp8(s[0 * 68] * f8scale, s[1 * 68] * f8scale, s[2 * 68] * f8scale, s[3 * 68] * f8scale); o.y = pk4_fp8(s[4 * 68] * f8scale, s[5 * 68] * f8scale, s[6 * 68] * f8scale, s[7 * 68] * f8scale);
            o.z = pk4_fp8(s[8 * 68] * f8scale, s[9 * 68] * f8scale, s[10 * 68] * f8scale, s[11 * 68] * f8scale); o.w = pk4_fp8(s[12 * 68] * f8scale, s[13 * 68] * f8scale, s[14 * 68] * f8scale, s[15 * 68] * f8scale);
            *(GAS v4u*)(d8 + (size_t)(v0 + n) * dpitch + koff + k0 + 16 * c) = o; }
    } else {
    const int c = lane & 7;
#pragma unroll
    for (int j = 0; j < 8; ++j) { const int n = (lane >> 3) + 8 * j; const LAS float* s = scr + (8 * c) * 68 + n;
        v4u o; o.x = pk2(s[0 * 68], s[1 * 68]); o.y = pk2(s[2 * 68], s[3 * 68]); o.z = pk2(s[4 * 68], s[5 * 68]); o.w = pk2(s[6 * 68], s[7 * 68]);
        *(GAS v4u*)(dst + (size_t)(v0 + n) * dpitch + koff + k0 + 8 * c) = o; }
    }
    LDS_WAIT(); asm volatile("" ::: "memory");
}
struct CvtJob { const float* W; int K, Nsrc, Nv; bf16* dst; int dpitch, koff, kind, dff; float f8scale; int vbase = 0; };
__device__ __forceinline__ bool cvt_run(const CvtJob& j, int& r, LAS float* scr, int lane) {
    const int nvb = j.Nv / 64, items = (j.K / 64) * nvb;
    if (r >= items) { r -= items; return false; }
    cvt_item(j.W, j.Nsrc, j.dst, j.dpitch, j.koff, j.kind, j.dff, 64 * (r / nvb), 64 * (r % nvb), scr, lane, j.f8scale, j.vbase);
    return true;
}

__device__ __forceinline__ float row_dot8(const f32x4 (&v)[4], const LAS float* wT, int lane) {
    float p[8];
#pragma unroll
    for (int h = 0; h < 8; ++h) { float s = 0.f;
#pragma unroll
        for (int j = 0; j < 4; ++j) { const f32x4 w = *(const LAS f32x4*)(wT + h * 1024 + 256 * j + 4 * lane); s += (v[j].x * w.x + v[j].y * w.y) + (v[j].z * w.z + v[j].w * w.w); }
        p[h] = s; }
    const bool b0 = lane & 1, b1 = lane & 2, b2 = lane & 4;
    float q[4], r[2];
#pragma unroll
    for (int k = 0; k < 4; ++k) { const float a = p[2 * k], b = p[2 * k + 1]; q[k] = (b0 ? b : a) + __shfl_xor(b0 ? a : b, 1); }
#pragma unroll
    for (int k = 0; k < 2; ++k) { const float a = q[2 * k], b = q[2 * k + 1]; r[k] = (b1 ? b : a) + __shfl_xor(b1 ? a : b, 2); }
    float t = (b2 ? r[1] : r[0]) + __shfl_xor(b2 ? r[0] : r[1], 4);
    t += __shfl_xor(t, 8); t += __shfl_xor(t, 16); t += __shfl_xor(t, 32);
    return t;
}
__device__ __forceinline__ void stage_w8(Frame& F, const float* W, int pitch, int col0) {
    LAS float* wT = (LAS float*)(F.lds + RING_OFF);
    float t[16];
#pragma unroll
    for (int k = 0; k < 16; ++k) { const int i = F.tid + 512 * k, d = i >> 3, h = i & 7; t[k] = W[(size_t)d * pitch + col0 + h]; }
#pragma unroll
    for (int k = 0; k < 16; ++k) { const int i = F.tid + 512 * k, d = i >> 3, h = i & 7; wT[h * 1024 + d] = t[k]; }
    LDS_WAIT(); __syncthreads();
}
__device__ __forceinline__ float log_sigmoid(float x) {
    const float y = __builtin_amdgcn_exp2f(-fabsf(x) * LOG2E); const float l = (y < 1e-2f) ? y * (1.f - y * (0.5f - y * 0.33333334f)) : __builtin_amdgcn_logf(1.f + y) * 0.6931471805599453f;
    return fminf(x, 0.f) - l; }

__device__ __forceinline__ void p0_rows(Frame& F, const float* x, const float* w_in0, const float* fox_b) {
    stage_w8(F, w_in0, N_INSRC, FL_COL);
    const LAS float* wT = (const LAS float*)(F.lds + RING_OFF);
    const int gw = F.vcu * NWAVES + F.wave, NGW = F.G * NWAVES;
    bf16* XB = (bf16*)(F.ws + WS_XB); float* LOGF = (float*)(F.ws + WS_LOGF);
    f32x4 nx[4];
    if (gw < M) {
#pragma unroll
        for (int j = 0; j < 4; ++j) nx[j] = *((const GAS f32x4*)(x + (size_t)gw * D) + F.lane + 64 * j); }
#pragma unroll 1
    for (int m = gw; m < M; m += NGW) {
        f32x4 v[4];
#pragma unroll
        for (int j = 0; j < 4; ++j) v[j] = nx[j];
        if (m + NGW < M) {
#pragma unroll
            for (int j = 0; j < 4; ++j) nx[j] = *((const GAS f32x4*)(x + (size_t)(m + NGW) * D) + F.lane + 64 * j); }
        GAS unsigned long long* o8 = (GAS unsigned long long*)(XB + (size_t)m * D) + F.lane;
#pragma unroll
        for (int j = 0; j < 4; ++j) o8[64 * j] = (unsigned long long)pk2(v[j].x, v[j].y) | ((unsigned long long)pk2(v[j].z, v[j].w) << 32);
#if GATES_FP8 == 2
#pragma unroll
        for (int j = 0; j < 4; ++j) *((GAS unsigned*)(F.ws + WS_X8IN + (size_t)m * D) + F.lane + 64 * j) = pk4_fp8(v[j].x * SC_X8, v[j].y * SC_X8, v[j].z * SC_X8, v[j].w * SC_X8);
#endif
        const float r = row_dot8(v, wT, F.lane);
        if (F.lane < 8) LOGF[(size_t)m * 8 + F.lane] = log_sigmoid(r + fox_b[F.lane]);
    }
    __syncthreads();
}

template <int AUX>
__device__ __forceinline__ void ln_pass(Frame& F, const float* src, float src_scale, const bf16* addb1, const bf16* addb2, const float* g, const float* b, float* outf, bf16* outb, unsigned char* out8,
                                        const float* w8, int w8pitch, int w8col, const float* fox_b, bool grp, float o8s = SC_X8) {
    if (AUX != 0) stage_w8(F, w8, w8pitch, w8col);
    const LAS float* wT = (const LAS float*)(F.lds + RING_OFF);
    const int gw = F.vcu * NWAVES + F.wave, NGW = F.G * NWAVES;
    f32x4 gv[4], bv[4];
#pragma unroll
    for (int j = 0; j < 4; ++j) { gv[j] = *((const f32x4*)g + F.lane + 64 * j); bv[j] = *((const f32x4*)b + F.lane + 64 * j); }
    int nbuf = 0, r_i1 = 0, r_i2 = 0, r_m = 0; float r_w1 = 0.f;
#define ROUTER_FLUSH() do { const bool vld_ = F.lane < nbuf; const unsigned long long lt_ = (1ull << F.lane) - 1ull; unsigned n_e_ = 0u, rk1_ = 0u, rk2_ = 0u; \
        _Pragma("unroll") for (int e_ = 0; e_ < 8; ++e_) { const unsigned long long b1_ = __ballot(vld_ && r_i1 == e_), b2_ = __ballot(vld_ && r_i2 == e_); \
            const unsigned c1_ = (unsigned)__popcll(b1_), c2_ = (unsigned)__popcll(b2_); if (F.lane == e_) n_e_ = c1_ + c2_; \
            if (r_i1 == e_) rk1_ = (unsigned)__popcll(b1_ & lt_); if (r_i2 == e_) rk2_ = c1_ + (unsigned)__popcll(b2_ & lt_); } \
        unsigned base_ = 0u; if (F.lane < 8 && n_e_ != 0u) base_ = __hip_atomic_fetch_add(F.ctl + CW_CNT + 64 * F.lane, n_e_, RLX_AGENT); \
        const unsigned s1_ = (unsigned)__shfl((int)base_, r_i1) + rk1_, s2_ = (unsigned)__shfl((int)base_, r_i2) + rk2_; \
        if (vld_) { unsigned* list_ = (unsigned*)(F.ws + WS_LIST); float* gw8_ = (float*)(F.ws + WS_GATEW); \
            list_[r_i1 * 16384 + s1_] = (unsigned)r_m; gw8_[r_i1 * 16384 + s1_] = r_w1; list_[r_i2 * 16384 + s2_] = (unsigned)r_m | 0x80000000u; gw8_[r_i2 * 16384 + s2_] = 1.0f - r_w1; } } while (0)
    const int m0 = grp ? (F.vcu >> 5) * SEQ + (F.vcu & 31) * NWAVES + F.wave : gw, mstep = grp ? 32 * NWAVES : NGW, mend = grp ? ((F.vcu >> 5) + 1) * SEQ : M;
    f32x4 nx[4]; v2u na[4], nc[4];
#define LN_LOAD(mm) do { _Pragma("unroll") for (int j = 0; j < 4; ++j) { nx[j] = *((const GAS f32x4*)(src + (size_t)(mm) * D) + F.lane + 64 * j); \
        if (addb1) { na[j] = *((const GAS v2u*)(addb1 + (size_t)(mm) * D) + F.lane + 64 * j); nc[j] = *((const GAS v2u*)(addb2 + (size_t)(mm) * D) + F.lane + 64 * j); } } } while (0)
    if (m0 < mend) LN_LOAD(m0);
#pragma unroll 1
    for (int m = m0; m < mend; m += mstep) {
        f32x4 v[4]; float s = 0.f;
#pragma unroll
        for (int j = 0; j < 4; ++j) { v[j] = nx[j];
            if (addb1) { v[j] = v[j] * src_scale; const v2u a = na[j], c = nc[j];
                v[j].x += bflo(a.x) + bflo(c.x); v[j].y += bfhi(a.x) + bfhi(c.x); v[j].z += bflo(a.y) + bflo(c.y); v[j].w += bfhi(a.y) + bfhi(c.y); }
            s += (v[j].x + v[j].y) + (v[j].z + v[j].w); }
        if (m + mstep < mend) LN_LOAD(m + mstep);
        float lm = s * (1.f / 16.f), m2 = 0.f;
#pragma unroll
        for (int j = 0; j < 4; ++j) { const f32x4 d = v[j] - lm; m2 += (d.x * d.x + d.y * d.y) + (d.z * d.z + d.w * d.w); }
        { float cnt2 = 8.f;
#pragma unroll
          for (int o = 1; o < 64; o <<= 1) { const float om = __shfl_xor(lm, o), o2 = __shfl_xor(m2, o); const float dl = om - lm; m2 = m2 + o2 + dl * dl * cnt2; lm = 0.5f * (lm + om); cnt2 *= 2.f; } }
        const float mean = lm;
#pragma unroll
        for (int j = 0; j < 4; ++j) v[j] = v[j] - mean;
        const float rstd = 1.f / sqrtf(m2 * (1.f / D) + LN_EPS);
#pragma unroll
        for (int j = 0; j < 4; ++j) v[j] = v[j] * rstd * gv[j] + bv[j];
        if (outf) {
#pragma unroll
            for (int j = 0; j < 4; ++j) *((GAS f32x4*)(outf + (size_t)m * D) + F.lane + 64 * j) = v[j]; }
        if (outb) { GAS unsigned long long* o8 = (GAS unsigned long long*)(outb + (size_t)m * D) + F.lane;
#pragma unroll
            for (int j = 0; j < 4; ++j) o8[64 * j] = (unsigned long long)pk2(v[j].x, v[j].y) | ((unsigned long long)pk2(v[j].z, v[j].w) << 32); }
        if (out8) {
            if (o8s < 0.f) {
#pragma unroll
                for (int j = 0; j < 4; ++j) *((GAS unsigned*)(out8 + (size_t)m * D) + F.lane + 64 * j) = pk4_i8(v[j].x * -o8s, v[j].y * -o8s, v[j].z * -o8s, v[j].w * -o8s);
            } else {
#pragma unroll
            for (int j = 0; j < 4; ++j) *((GAS unsigned*)(out8 + (size_t)m * D) + F.lane + 64 * j) = pk4_fp8(v[j].x * SC_X8, v[j].y * SC_X8, v[j].z * SC_X8, v[j].w * SC_X8); } }
        if (AUX == 1) {
            const float r = row_dot8(v, wT, F.lane);
            if (F.lane < 8) ((float*)(F.ws + WS_LOGF))[(size_t)m * 8 + F.lane] = log_sigmoid(r + fox_b[F.lane]);
        }
        if (AUX == 2) {
            const float rl = row_dot8(v, wT, F.lane); float lg[8];
#pragma unroll
            for (int e = 0; e < 8; ++e) lg[e] = __shfl(rl, e);
            int i1 = 0; float v1 = lg[0];
#pragma unroll
            for (int e = 1; e < 8; ++e) if (lg[e] > v1) { v1 = lg[e]; i1 = e; }
            int i2 = -1; float v2 = -INFINITY;
#pragma unroll
            for (int e = 0; e < 8; ++e) if (e != i1 && lg[e] > v2) { v2 = lg[e]; i2 = e; }
            const float w1 = 1.0f / (1.0f + expf(v2 - v1));
            if (F.lane == nbuf) { r_i1 = i1; r_i2 = i2; r_w1 = w1; r_m = m; }
            if (++nbuf == 64) { ROUTER_FLUSH(); nbuf = 0; }
        }
    }
    if (AUX == 2) { if (nbuf) { ROUTER_FLUSH(); } }
#undef ROUTER_FLUSH
#undef LN_LOAD
    __syncthreads();
}

__device__ __forceinline__ void split3(float b, unsigned& h, unsigned& m, unsigned& l) { h = f2bf(b); const float r1 = b - bf2f((unsigned short)h); m = f2bf(r1); const float r2 = r1 - bf2f((unsigned short)m); l = f2bf(r2); }
template <bool AUG>
__device__ __forceinline__ void fox_bias_table(Frame& F, int b, int h, LAS float* tab, LAS float* wtot) {
    int tid = threadIdx.x; asm volatile("" : "+v"(tid));
    const int lane = tid & 63, wave = __builtin_amdgcn_readfirstlane(tid >> 6);
    const float* lf = (const float*)(F.ws + WS_LOGF) + (size_t)b * SEQ * 8 + h;
    float v[4];
#pragma unroll
    for (int j = 0; j < 4; ++j) v[j] = lf[(size_t)(4 * tid + j) * 8];
    float sj[4]; sj[0] = v[0]; sj[1] = sj[0] + v[1]; sj[2] = sj[1] + v[2]; sj[3] = sj[2] + v[3];
    float x = sj[3];
#pragma unroll
    for (int o = 1; o < 64; o <<= 1) { const float y = __shfl_up(x, o); if (lane >= o) x += y; }
    __syncthreads();
    if (lane == 63) wtot[wave] = x;
    LDS_WAIT(); __syncthreads();
    float base = 0.f;
#pragma unroll
    for (int w = 0; w < 8; ++w) if (w < wave) base += wtot[w];
    const float ex = base + x - sj[3];
#pragma unroll
    for (int j = 0; j < 4; ++j) { const float bv = -(ex + sj[j]) * LOG2E;
        if (AUG) { unsigned hh, mm, ll; split3(bv, hh, mm, ll); v4u w; w.x = hh | (mm << 16); w.y = ll | (0x3F80u << 16); w.z = 0x3F803F80u; w.w = 0u; ((LAS v4u*)tab)[4 * tid + j] = w; }
        else tab[4 * tid + j] = bv; }
    LDS_WAIT(); __syncthreads();
}

#if 1
__device__ __forceinline__ void naive_fox_row(Frame& F, int b, int h, int t, const LAS float* tab) {
    const bf16* FQ = (const bf16*)(F.ws + WS_FQ); const bf16* FK = (const bf16*)(F.ws + WS_FK); const bf16* FV = (const bf16*)(F.ws + WS_FV); bf16* YB = (bf16*)(F.ws + WS_YB);
    const size_t rb = (size_t)b * SEQ;
    float q[64];
    { const v4u* qp = (const v4u*)(FQ + (rb + t) * 512 + h * 64);
#pragma unroll
      for (int c = 0; c < 8; ++c) { const v4u w = qp[c]; q[8 * c + 0] = bflo(w.x); q[8 * c + 1] = bfhi(w.x); q[8 * c + 2] = bflo(w.y); q[8 * c + 3] = bfhi(w.y); q[8 * c + 4] = bflo(w.z); q[8 * c + 5] = bfhi(w.z); q[8 * c + 6] = bflo(w.w); q[8 * c + 7] = bfhi(w.w); } }
    float mx = -INFINITY, l = 0.f, o = 0.f;
    for (int s0 = 0; s0 <= t; s0 += 64) {
        const int s = s0 + F.lane; float sc = -INFINITY;
        if (s <= t) { const v4u* kp = (const v4u*)(FK + (rb + s) * 512 + h * 64); float a = 0.f;
#pragma unroll
            for (int c = 0; c < 8; ++c) { const v4u w = kp[c]; a += q[8 * c + 0] * bflo(w.x) + q[8 * c + 1] * bfhi(w.x) + q[8 * c + 2] * bflo(w.y) + q[8 * c + 3] * bfhi(w.y) + q[8 * c + 4] * bflo(w.z) + q[8 * c + 5] * bfhi(w.z) + q[8 * c + 6] * bflo(w.w) + q[8 * c + 7] * bfhi(w.w); }
            sc = a + tab[s]; }
        float cm = sc;
#pragma unroll
        for (int of = 1; of < 64; of <<= 1) cm = fmaxf(cm, __shfl_xor(cm, of));
        const float nm = fmaxf(mx, cm), f = __builtin_amdgcn_exp2f(mx - nm); const float p = __builtin_amdgcn_exp2f(sc - nm);
        l = l * f + wave_sum(p); o *= f; mx = nm;
        const int ne = (t - s0 + 1) < 64 ? (t - s0 + 1) : 64;
        for (int j = 0; j < ne; ++j) { const float pj = __shfl(p, j); o += pj * bf2f(FV[(rb + s0 + j) * 512 + h * 64 + F.lane]); }
    }
    YB[(rb + t) * 1536 + 512 + h * 64 + F.lane] = (bf16)f2bf(o / l);
}
__device__ __forceinline__ void naive_ret_row(Frame& F, int b, int h, int t) {
    const bf16* RQ = (const bf16*)(F.ws + WS_RQ); const bf16* RK = (const bf16*)(F.ws + WS_RK); const bf16* RV = (const bf16*)(F.ws + WS_RV); const bf16* RG = (const bf16*)(F.ws + WS_RG); bf16* YB = (bf16*)(F.ws + WS_YB);
    const size_t rb = (size_t)b * SEQ;
    const float l2g = log2f(1.0f - exp2f(-5.0f - (float)h));
    float q[64];
    { const v4u* qp = (const v4u*)(RQ + (rb + t) * 256 + h * 64);
#pragma unroll
      for (int c = 0; c < 8; ++c) { const v4u w = qp[c]; q[8 * c + 0] = bflo(w.x); q[8 * c + 1] = bfhi(w.x); q[8 * c + 2] = bflo(w.y); q[8 * c + 3] = bfhi(w.y); q[8 * c + 4] = bflo(w.z); q[8 * c + 5] = bfhi(w.z); q[8 * c + 6] = bflo(w.w); q[8 * c + 7] = bfhi(w.w); } }
    float o0 = 0.f, o1 = 0.f;
    for (int s0 = 0; s0 <= t; s0 += 64) {
        const int s = s0 + F.lane; float sc = 0.f;
        if (s <= t) { const v4u* kp = (const v4u*)(RK + (rb + s) * 256 + h * 64); float a = 0.f;
#pragma unroll
            for (int c = 0; c < 8; ++c) { const v4u w = kp[c]; a += q[8 * c + 0] * bflo(w.x) + q[8 * c + 1] * bfhi(w.x) + q[8 * c + 2] * bflo(w.y) + q[8 * c + 3] * bfhi(w.y) + q[8 * c + 4] * bflo(w.z) + q[8 * c + 5] * bfhi(w.z) + q[8 * c + 6] * bflo(w.w) + q[8 * c + 7] * bfhi(w.w); }
            sc = a * exp2f(l2g * (float)(t - s)); }
        const int ne = (t - s0 + 1) < 64 ? (t - s0 + 1) : 64;
        for (int j = 0; j < ne; ++j) { const float pj = __shfl(sc, j); const bf16* vp = RV + (rb + s0 + j) * 512 + h * 128; o0 += pj * bf2f(vp[F.lane]); o1 += pj * bf2f(vp[F.lane + 64]); }
    }
    const float mean = wave_sum(o0 + o1) * (1.f / 128.f); const float d0 = o0 - mean, d1 = o1 - mean;
    const float rstd = 1.f / sqrtf(wave_sum(d0 * d0 + d1 * d1) * (1.f / 128.f) + GN_EPS);
    const bf16* gp = RG + (rb + t) * 512 + h * 128; bf16* yp = YB + (rb + t) * 1536 + h * 128;
    yp[F.lane] = (bf16)f2bf(bf2f(gp[F.lane]) * d0 * rstd); yp[F.lane + 64] = (bf16)f2bf(bf2f(gp[F.lane + 64]) * d1 * rstd);
}
__device__ __forceinline__ void naive_gmlp_unit(Frame& F, int b, int n, int g, const float* w_s, const float* b_s, const float* lng, const float* lnb) {
    const bf16* GU = (const bf16*)(F.ws + WS_GU); const bf16* GV = (const bf16*)(F.ws + WS_GV); bf16* YB = (bf16*)(F.ws + WS_YB);
    LAS float* st = (LAS float*)(F.lds + RING_OFF);
    const size_t r0 = (size_t)b * SEQ + n * 128;
    __syncthreads();
    for (int r = F.wave; r < 128; r += NWAVES) {
        const v4u w = *((const v4u*)(GV + (r0 + r) * 512) + F.lane);
        float x[8] = {bflo(w.x), bfhi(w.x), bflo(w.y), bfhi(w.y), bflo(w.z), bfhi(w.z), bflo(w.w), bfhi(w.w)};
        float s = 0.f;
#pragma unroll
        for (int j = 0; j < 8; ++j) s += x[j];
        const float mean = wave_sum(s) * (1.f / 512.f); float s2 = 0.f;
#pragma unroll
        for (int j = 0; j < 8; ++j) { const float d = x[j] - mean; s2 += d * d; }
        const float rstd = 1.f / sqrtf(wave_sum(s2) * (1.f / 512.f) + LN_EPS);
        if (F.lane == 0) { st[2 * r] = mean; st[2 * r + 1] = rstd; }
    }
    LDS_WAIT(); __syncthreads();
    const int c = F.tid & 127; const float gam = lng[g * 128 + c], bet = lnb[g * 128 + c];
    for (int i = F.tid >> 7; i < 128; i += 4) {
        float a = 0.f; const float* wr = w_s + ((size_t)g * 128 + i) * 128;
        for (int j = 0; j <= i; ++j) { const float vn = (bf2f(GV[(r0 + j) * 512 + g * 128 + c]) - st[2 * j]) * st[2 * j + 1] * gam + bet; a += wr[j] * vn; }
        const float sp = a + b_s[g * 128 + i];
        YB[(r0 + i) * 1536 + 1024 + g * 128 + c] = (bf16)f2bf(bf2f(GU[(r0 + i) * 512 + g * 128 + c]) * sp);
    }
    __syncthreads();
}
#endif

__device__ __forceinline__ GAS void* lds_ptr(LAS unsigned char* lds, int k) {
    const v2u w = *(const LAS v2u*)(lds + PTAB_OFF + 8 * k);
    const unsigned lo = __builtin_amdgcn_readfirstlane(w.x), hi = __builtin_amdgcn_readfirstlane(w.y);
    return (GAS void*)(((unsigned long long)hi << 32) | lo);
}

typedef short bf16x8_t __attribute__((ext_vector_type(8)));
typedef float f32x16_t __attribute__((ext_vector_type(16)));
#define MFMA32(a, b, c) __builtin_amdgcn_mfma_f32_32x32x16_bf16((a), (b), (c), 0, 0, 0)
__device__ __forceinline__ bf16x8_t ldfrag(const LAS bf16* base, int row, int pitch, int kk, int h2) { return *(const LAS bf16x8_t*)(base + row * pitch + 16 * kk + 8 * h2); }
__device__ __forceinline__ int crow32(int reg, int h2) { return (reg & 3) + 8 * (reg >> 2) + 4 * h2; }
constexpr int RP128 = 136, RP64 = 72;
constexpr int R_QS = 0, R_KS = 4608, R_KDT = 23040, R_VT = 40448, R_SS = 75264, R_ST = 83968, R_OS = 102400, R_END = 119296;
static_assert(R_END <= RING_BYTES, "retention LDS map");
__device__ __forceinline__ void unpack8(const v4u w, float (&x)[8]) { x[0] = bflo(w.x); x[1] = bfhi(w.x); x[2] = bflo(w.y); x[3] = bfhi(w.y); x[4] = bflo(w.z); x[5] = bfhi(w.z); x[6] = bflo(w.w); x[7] = bfhi(w.w); }

__device__ __forceinline__ void ret_unit(Frame& F, int b, int h, int rq) {
    int tid_ = threadIdx.x; asm volatile("" : "+v"(tid_));
    const int tid = tid_, lane = tid & 63, wid = __builtin_amdgcn_readfirstlane(tid >> 6), r = lane & 31, h2 = lane >> 5;
    const float l2g = log2f(1.0f - exp2f(-5.0f - (float)h));
    const float chunk_dec = exp2f(l2g * 128.0f);
    LAS bf16* Qs = (LAS bf16*)(F.lds + RING_OFF + R_QS); LAS bf16* Ks = (LAS bf16*)(F.lds + RING_OFF + R_KS); LAS bf16* KdT = (LAS bf16*)(F.lds + RING_OFF + R_KDT);
    LAS bf16* VT = (LAS bf16*)(F.lds + RING_OFF + R_VT); LAS bf16* Ss = (LAS bf16*)(F.lds + RING_OFF + R_SS); LAS bf16* ST = (LAS bf16*)(F.lds + RING_OFF + R_ST);
    LAS float* Os = (LAS float*)(F.lds + RING_OFF + R_OS);
    const bf16* RQ = (const bf16*)(F.ws + WS_RQ); const bf16* RK = (const bf16*)(F.ws + WS_RK); const bf16* RV = (const bf16*)(F.ws + WS_RV); const bf16* RG = (const bf16*)(F.ws + WS_RG); bf16* YB = (bf16*)(F.ws + WS_YB);
    const size_t rb = (size_t)b * SEQ;
    __syncthreads();
    for (int i = tid; i < 128 * RP64 / 2; i += NWAVES * 64) ((LAS unsigned*)ST)[i] = 0u;
    f32x16_t st = {0.f, 0.f, 0.f, 0.f, 0.f, 0.f, 0.f, 0.f, 0.f, 0.f, 0.f, 0.f, 0.f, 0.f, 0.f, 0.f};
    const int sj = tid & 127, cq = tid >> 7, qi = tid & 31, qc = tid >> 5, gi = tid >> 4, gs = tid & 15;
    v4u qreg = {0u, 0u, 0u, 0u}, kreg[2], vreg[4], greg;
#define RET_LOAD(n) do { const size_t r0_ = rb + (size_t)(n) * 128; \
        if (tid < 256) qreg = *(const v4u*)(RQ + (r0_ + 32 * rq + qi) * 256 + h * 64 + 8 * qc); \
        _Pragma("unroll") for (int c_ = 0; c_ < 2; ++c_) kreg[c_] = *(const v4u*)(RK + (r0_ + sj) * 256 + h * 64 + 16 * cq + 8 * c_); \
        _Pragma("unroll") for (int c_ = 0; c_ < 4; ++c_) vreg[c_] = *(const v4u*)(RV + (r0_ + sj) * 512 + h * 128 + 32 * cq + 8 * c_); \
        greg = *(const v4u*)(RG + (r0_ + 32 * rq + gi) * 512 + h * 128 + 8 * gs); } while (0)
    RET_LOAD(0);
    const float kdec = exp2f(l2g * (float)(127 - sj));
#pragma unroll 1
    for (int n = 0; n < 16; ++n) {
        if (tid < 256) *(LAS v4u*)(Qs + qi * RP64 + 8 * qc) = qreg;
#pragma unroll
        for (int c = 0; c < 2; ++c) { *(LAS v4u*)(Ks + sj * RP64 + 16 * cq + 8 * c) = kreg[c]; float x[8]; unpack8(kreg[c], x);
#pragma unroll
            for (int e = 0; e < 8; ++e) KdT[(16 * cq + 8 * c + e) * RP128 + sj] = (bf16)f2bf(x[e] * kdec); }
#pragma unroll
        for (int c = 0; c < 4; ++c) { const v4u w = vreg[c]; const unsigned ww[4] = {w.x, w.y, w.z, w.w};
#pragma unroll
            for (int e = 0; e < 8; ++e) VT[(32 * cq + 8 * c + e) * RP128 + sj] = (bf16)((e & 1) ? (ww[e >> 1] >> 16) : (ww[e >> 1] & 0xffffu)); }
        const v4u gcur = greg;
        LDS_WAIT(); __syncthreads();
        if (n + 1 < 16) RET_LOAD(n + 1);
        f32x16_t x = {0.f, 0.f, 0.f, 0.f, 0.f, 0.f, 0.f, 0.f, 0.f, 0.f, 0.f, 0.f, 0.f, 0.f, 0.f, 0.f};
        if (wid < 4) {
#pragma unroll
            for (int kk = 0; kk < 4; ++kk) x = MFMA32(ldfrag(Qs, r, RP64, kk, h2), ldfrag(Ks, 32 * wid + r, RP64, kk, h2), x);
            const int jabs = 32 * wid + r;
#pragma unroll
            for (int reg = 0; reg < 16; ++reg) { const int i = crow32(reg, h2), diff = 32 * rq + i - jabs;
                const float val = diff >= 0 ? x[reg] * exp2f(l2g * (float)diff) : 0.f; Ss[i * RP128 + jabs] = (bf16)f2bf(val); }
        } else {
#pragma unroll
            for (int kk = 0; kk < 4; ++kk) x = MFMA32(ldfrag(Qs, r, RP64, kk, h2), ldfrag(ST, 32 * (wid - 4) + r, RP64, kk, h2), x);
#pragma unroll
            for (int reg = 0; reg < 16; ++reg) x[reg] *= exp2f(l2g * (float)(32 * rq + crow32(reg, h2) + 1));
        }
        { const int db = wid >> 2, vb2 = wid & 3;
#pragma unroll
          for (int reg = 0; reg < 16; ++reg) st[reg] *= chunk_dec;
#pragma unroll
          for (int kk = 0; kk < 8; ++kk) st = MFMA32(ldfrag(KdT, 32 * db + r, RP128, kk, h2), ldfrag(VT, 32 * vb2 + r, RP128, kk, h2), st); }
        LDS_WAIT(); __syncthreads();
        { const int db = wid >> 2, vb2 = wid & 3;
#pragma unroll
          for (int g = 0; g < 4; ++g) { v2u w; w.x = pk2(st[4 * g], st[4 * g + 1]); w.y = pk2(st[4 * g + 2], st[4 * g + 3]); *(LAS v2u*)(ST + (32 * vb2 + r) * RP64 + 32 * db + 8 * g + 4 * h2) = w; } }
        if (wid >= 4) {
#pragma unroll
            for (int kk = 0; kk < 8; ++kk) x = MFMA32(ldfrag(Ss, r, RP128, kk, h2), ldfrag(VT, 32 * (wid - 4) + r, RP128, kk, h2), x);
#pragma unroll
            for (int reg = 0; reg < 16; ++reg) Os[crow32(reg, h2) * 132 + 32 * (wid - 4) + r] = x[reg];
        }
        LDS_WAIT(); __syncthreads();
        { const f32x4 a0 = *(const LAS f32x4*)(Os + gi * 132 + 8 * gs), a1 = *(const LAS f32x4*)(Os + gi * 132 + 8 * gs + 4);
          float sm = (a0.x + a0.y) + (a0.z + a0.w) + (a1.x + a1.y) + (a1.z + a1.w);
#pragma unroll
          for (int o = 1; o < 16; o <<= 1) sm += __shfl_xor(sm, o);
          const float mean = sm * (1.f / 128.f); const f32x4 d0 = a0 - mean, d1 = a1 - mean;
          float sq = (d0.x * d0.x + d0.y * d0.y) + (d0.z * d0.z + d0.w * d0.w) + (d1.x * d1.x + d1.y * d1.y) + (d1.z * d1.z + d1.w * d1.w);
#pragma unroll
          for (int o = 1; o < 16; o <<= 1) sq += __shfl_xor(sq, o);
          const float rstd = 1.f / sqrtf(sq * (1.f / 128.f) + GN_EPS); float gt[8]; unpack8(gcur, gt);
          v4u w; w.x = pk2(gt[0] * d0.x * rstd, gt[1] * d0.y * rstd); w.y = pk2(gt[2] * d0.z * rstd, gt[3] * d0.w * rstd); w.z = pk2(gt[4] * d1.x * rstd, gt[5] * d1.y * rstd); w.w = pk2(gt[6] * d1.z * rstd, gt[7] * d1.w * rstd);
          *(v4u*)(YB + (rb + (size_t)n * 128 + 32 * rq + gi) * 1536 + h * 128 + 8 * gs) = w; }
    }
#undef RET_LOAD
    __syncthreads();
}


#define MFMA16(a, b, c) __builtin_amdgcn_mfma_f32_16x16x32_bf16((a), (b), (c), 0, 0, 0)
__device__ __forceinline__ bf16x8_t ldfrag16(const LAS bf16* base, int row, int pitch, int ks, int q4) { return *(const LAS bf16x8_t*)(base + row * pitch + 32 * ks + 8 * q4); }
__device__ __forceinline__ void ret_kv_unit(Frame& F, int b, int h, int n) {
    int tid_ = threadIdx.x; asm volatile("" : "+v"(tid_));
    const int tid = tid_, lane = tid & 63, wid = __builtin_amdgcn_readfirstlane(tid >> 6), r = lane & 31, h2 = lane >> 5;
    const float l2g = log2f(1.0f - exp2f(-5.0f - (float)h));
    LAS bf16* KdT = (LAS bf16*)(F.lds + RING_OFF); LAS bf16* VT = (LAS bf16*)(F.lds + RING_OFF + 17408);
    const bf16* RK = (const bf16*)(F.ws + WS_RK); const bf16* RV = (const bf16*)(F.ws + WS_RV);
    const size_t r0 = (size_t)b * SEQ + (size_t)n * 128;
    const int sj = tid & 127, cq = tid >> 7; const float kdec = exp2f(l2g * (float)(127 - sj));
    v4u kreg[2], vreg[4];
#pragma unroll
    for (int c = 0; c < 2; ++c) kreg[c] = *(const v4u*)(RK + (r0 + sj) * 256 + h * 64 + 16 * cq + 8 * c);
#pragma unroll
    for (int c = 0; c < 4; ++c) vreg[c] = *(const v4u*)(RV + (r0 + sj) * 512 + h * 128 + 32 * cq + 8 * c);
    __syncthreads();
#pragma unroll
    for (int c = 0; c < 2; ++c) { float x[8]; unpack8(kreg[c], x);
#pragma unroll
        for (int e = 0; e < 8; ++e) KdT[(16 * cq + 8 * c + e) * RP128 + sj] = (bf16)f2bf(x[e] * kdec); }
#pragma unroll
    for (int c = 0; c < 4; ++c) { const v4u w = vreg[c]; const unsigned ww[4] = {w.x, w.y, w.z, w.w};
#pragma unroll
        for (int e = 0; e < 8; ++e) VT[(32 * cq + 8 * c + e) * RP128 + sj] = (bf16)((e & 1) ? (ww[e >> 1] >> 16) : (ww[e >> 1] & 0xffffu)); }
    LDS_WAIT(); __syncthreads();
    const int db = wid >> 2, vb = wid & 3;
    f32x16_t st = {0.f, 0.f, 0.f, 0.f, 0.f, 0.f, 0.f, 0.f, 0.f, 0.f, 0.f, 0.f, 0.f, 0.f, 0.f, 0.f};
#pragma unroll
    for (int kk = 0; kk < 8; ++kk) st = MFMA32(ldfrag(KdT, 32 * db + r, RP128, kk, h2), ldfrag(VT, 32 * vb + r, RP128, kk, h2), st);
    float* KV = (float*)(F.ws + WS_KV) + ((size_t)((b * 4 + h) * 16 + n)) * 8192;
#pragma unroll
    for (int reg = 0; reg < 16; ++reg) KV[(32 * db + crow32(reg, h2)) * 128 + 32 * vb + r] = st[reg];
    __syncthreads();
}
constexpr int RB_QS = 0, RB_KS = 18432, RB_VT = 36864, RB_ST = 71680, RB_SW = 90112, RB_END = 124928;
static_assert(RB_END <= RING_BYTES, "retention pass B LDS map");
__device__ __forceinline__ void ret_out_unit(Frame& F, int b, int h, int n) {
    int tid_ = threadIdx.x; asm volatile("" : "+v"(tid_));
    const int tid = tid_, lane = tid & 63, wid = __builtin_amdgcn_readfirstlane(tid >> 6), l15 = lane & 15, q4 = lane >> 4;
    const float l2g = log2f(1.0f - exp2f(-5.0f - (float)h));
    const float chunk_dec = exp2f(l2g * 128.0f);
    LAS bf16* Qs = (LAS bf16*)(F.lds + RING_OFF + RB_QS); LAS bf16* Ks = (LAS bf16*)(F.lds + RING_OFF + RB_KS); LAS bf16* VT = (LAS bf16*)(F.lds + RING_OFF + RB_VT);
    LAS bf16* ST = (LAS bf16*)(F.lds + RING_OFF + RB_ST); LAS bf16* Sw = (LAS bf16*)(F.lds + RING_OFF + RB_SW) + wid * (16 * RP128);
    const bf16* RQ = (const bf16*)(F.ws + WS_RQ); const bf16* RK = (const bf16*)(F.ws + WS_RK); const bf16* RV = (const bf16*)(F.ws + WS_RV); const bf16* RG = (const bf16*)(F.ws + WS_RG); bf16* YB = (bf16*)(F.ws + WS_YB);
    const size_t r0 = (size_t)b * SEQ + (size_t)n * 128;
    const int sj = tid & 127, cq = tid >> 7;
    v4u qreg[2], kreg[2], vreg[4];
#pragma unroll
    for (int c = 0; c < 2; ++c) { qreg[c] = *(const v4u*)(RQ + (r0 + sj) * 256 + h * 64 + 16 * cq + 8 * c); kreg[c] = *(const v4u*)(RK + (r0 + sj) * 256 + h * 64 + 16 * cq + 8 * c); }
#pragma unroll
    for (int c = 0; c < 4; ++c) vreg[c] = *(const v4u*)(RV + (r0 + sj) * 512 + h * 128 + 32 * cq + 8 * c);
    f32x4 sa[4] = {{0.f, 0.f, 0.f, 0.f}, {0.f, 0.f, 0.f, 0.f}, {0.f, 0.f, 0.f, 0.f}, {0.f, 0.f, 0.f, 0.f}};
    { const float* KV = (const float*)(F.ws + WS_KV) + ((size_t)((b * 4 + h) * 16)) * 8192 + (size_t)tid * 16;
#pragma unroll 4
      for (int m = 0; m < n; ++m) {
#pragma unroll
          for (int c = 0; c < 4; ++c) { const f32x4 kv = *(const f32x4*)(KV + (size_t)m * 8192 + 4 * c); sa[c] = sa[c] * chunk_dec + kv; } } }
    __syncthreads();
    { const int d = tid >> 3, v0 = 16 * (tid & 7);
#pragma unroll
      for (int c = 0; c < 4; ++c)
#pragma unroll
          for (int e = 0; e < 4; ++e) ST[(v0 + 4 * c + e) * RP64 + d] = (bf16)f2bf(sa[c][e]); }
#pragma unroll
    for (int c = 0; c < 2; ++c) { *(LAS v4u*)(Qs + sj * RP64 + 16 * cq + 8 * c) = qreg[c]; *(LAS v4u*)(Ks + sj * RP64 + 16 * cq + 8 * c) = kreg[c]; }
#pragma unroll
    for (int c = 0; c < 4; ++c) { const v4u w = vreg[c]; const unsigned ww[4] = {w.x, w.y, w.z, w.w};
#pragma unroll
        for (int e = 0; e < 8; ++e) VT[(32 * cq + 8 * c + e) * RP128 + sj] = (bf16)((e & 1) ? (ww[e >> 1] >> 16) : (ww[e >> 1] & 0xffffu)); }
    LDS_WAIT(); __syncthreads();
    const int i0 = 16 * wid;
    const bf16x8_t qa0 = ldfrag16(Qs, i0 + l15, RP64, 0, q4), qa1 = ldfrag16(Qs, i0 + l15, RP64, 1, q4);
#pragma unroll 1
    for (int kb = 0; kb <= (wid | 1); kb += 2) {
        f32x4 sc[2];
#pragma unroll
        for (int u = 0; u < 2; ++u) { sc[u] = (f32x4){0.f, 0.f, 0.f, 0.f};
            sc[u] = MFMA16(qa0, ldfrag16(Ks, 16 * (kb + u) + l15, RP64, 0, q4), sc[u]); sc[u] = MFMA16(qa1, ldfrag16(Ks, 16 * (kb + u) + l15, RP64, 1, q4), sc[u]); }
#pragma unroll
        for (int u = 0; u < 2; ++u) { const int j = 16 * (kb + u) + l15;
#pragma unroll
            for (int reg = 0; reg < 4; ++reg) { const int il = 4 * q4 + reg, diff = i0 + il - j; Sw[il * RP128 + j] = (bf16)f2bf(diff >= 0 ? sc[u][reg] * __builtin_amdgcn_exp2f(l2g * (float)diff) : 0.f); } }
    }
    LDS_WAIT();
    float qd[4];
#pragma unroll
    for (int reg = 0; reg < 4; ++reg) qd[reg] = __builtin_amdgcn_exp2f(l2g * (float)(i0 + 4 * q4 + reg + 1));
    f32x4 o[8];
    const int nks = (wid + 2) >> 1;
#pragma unroll
    for (int vb = 0; vb < 8; ++vb) {
        f32x4 x = {0.f, 0.f, 0.f, 0.f};
        x = MFMA16(qa0, ldfrag16(ST, 16 * vb + l15, RP64, 0, q4), x); x = MFMA16(qa1, ldfrag16(ST, 16 * vb + l15, RP64, 1, q4), x);
#pragma unroll
        for (int reg = 0; reg < 4; ++reg) x[reg] *= qd[reg];
        o[vb] = x;
    }
#pragma unroll 1
    for (int ks = 0; ks < nks; ++ks) {
        const bf16x8_t a = ldfrag16(Sw, l15, RP128, ks, q4);
#pragma unroll
        for (int vb = 0; vb < 8; ++vb) o[vb] = MFMA16(a, ldfrag16(VT, 16 * vb + l15, RP128, ks, q4), o[vb]);
    }
    float mean[4], rstd[4];
#pragma unroll
    for (int reg = 0; reg < 4; ++reg) { float sm = 0.f;
#pragma unroll
        for (int vb = 0; vb < 8; ++vb) sm += o[vb][reg];
#pragma unroll
        for (int of = 1; of < 16; of <<= 1) sm += __shfl_xor(sm, of);
        mean[reg] = sm * (1.f / 128.f); float sq = 0.f;
#pragma unroll
        for (int vb = 0; vb < 8; ++vb) { const float d = o[vb][reg] - mean[reg]; sq += d * d; }
#pragma unroll
        for (int of = 1; of < 16; of <<= 1) sq += __shfl_xor(sq, of);
        rstd[reg] = 1.f / sqrtf(sq * (1.f / 128.f) + GN_EPS); }
#pragma unroll
    for (int vb = 0; vb < 8; ++vb)
#pragma unroll
        for (int reg = 0; reg < 4; ++reg) Sw[(4 * q4 + reg) * RP128 + 16 * vb + l15] = (bf16)f2bf((o[vb][reg] - mean[reg]) * rstd[reg]);
    LDS_WAIT();
#pragma unroll
    for (int c = 0; c < 4; ++c) { const int ch = c * 64 + lane, row = ch >> 4, cc = ch & 15;
        float xn[8], gt[8]; unpack8(*(const LAS v4u*)(Sw + row * RP128 + 8 * cc), xn); unpack8(*(const v4u*)(RG + (r0 + i0 + row) * 512 + h * 128 + 8 * cc), gt);
        v4u w; w.x = pk2(xn[0] * gt[0], xn[1] * gt[1]); w.y = pk2(xn[2] * gt[2], xn[3] * gt[3]); w.z = pk2(xn[4] * gt[4], xn[5] * gt[5]); w.w = pk2(xn[6] * gt[6], xn[7] * gt[7]);
        *(v4u*)(YB + (r0 + i0 + row) * 1536 + h * 128 + 8 * cc) = w; }
    __syncthreads();
}

constexpr int G_WS = 0, G_VNT = 34816, G_STAT = 69632, G_END = 70656;
__device__ __forceinline__ void gmlp_unit(Frame& F, int b, int n, int g, const float* w_s, const float* b_s, const float* lng, const float* lnb) {
    int tid_ = threadIdx.x; asm volatile("" : "+v"(tid_));
    const int tid = tid_, lane = tid & 63, wid = __builtin_amdgcn_readfirstlane(tid >> 6), r = lane & 31, h2 = lane >> 5;
    const bf16* GU = (const bf16*)(F.ws + WS_GU); const bf16* GV = (const bf16*)(F.ws + WS_GV); bf16* YB = (bf16*)(F.ws + WS_YB);
    LAS bf16* Ws = (LAS bf16*)(F.lds + RING_OFF + G_WS); LAS bf16* VnT = (LAS bf16*)(F.lds + RING_OFF + G_VNT); LAS float* stt = (LAS float*)(F.lds + RING_OFF + G_STAT);
    const size_t r0 = (size_t)b * SEQ + (size_t)n * 128;
    __syncthreads();
    for (int rr = wid; rr < 128; rr += NWAVES) {
        float x[8]; unpack8(*((const v4u*)(GV + (r0 + rr) * 512) + lane), x);
        float s = 0.f;
#pragma unroll
        for (int j = 0; j < 8; ++j) s += x[j];
        const float mean = wave_sum(s) * (1.f / 512.f); float s2 = 0.f;
#pragma unroll
        for (int j = 0; j < 8; ++j) { const float d = x[j] - mean; s2 += d * d; }
        const float rstd = 1.f / sqrtf(wave_sum(s2) * (1.f / 512.f) + LN_EPS);
        if (lane == 0) { stt[2 * rr] = mean; stt[2 * rr + 1] = rstd; }
    }
    { const int i = tid >> 2, jq = tid & 3; const float* wr = w_s + ((size_t)g * 128 + i) * 128 + 32 * jq;
#pragma unroll
      for (int c = 0; c < 4; ++c) { const f32x4 a = *(const f32x4*)(wr + 8 * c), bq = *(const f32x4*)(wr + 8 * c + 4); const int j0 = 32 * jq + 8 * c;
          v4u w; w.x = pk2(j0 + 0 <= i ? a.x : 0.f, j0 + 1 <= i ? a.y : 0.f); w.y = pk2(j0 + 2 <= i ? a.z : 0.f, j0 + 3 <= i ? a.w : 0.f);
          w.z = pk2(j0 + 4 <= i ? bq.x : 0.f, j0 + 5 <= i ? bq.y : 0.f); w.w = pk2(j0 + 6 <= i ? bq.z : 0.f, j0 + 7 <= i ? bq.w : 0.f);
          *(LAS v4u*)(Ws + i * RP128 + j0) = w; } }
    LDS_WAIT(); __syncthreads();
    { const int sj = tid & 127, cq = tid >> 7; const float mu = stt[2 * sj], rs = stt[2 * sj + 1];
#pragma unroll
      for (int c = 0; c < 4; ++c) { float x[8]; unpack8(*(const v4u*)(GV + (r0 + sj) * 512 + g * 128 + 32 * cq + 8 * c), x);
          const f32x4 ga = *(const f32x4*)(lng + g * 128 + 32 * cq + 8 * c), gb = *(const f32x4*)(lng + g * 128 + 32 * cq + 8 * c + 4);
          const f32x4 ba = *(const f32x4*)(lnb + g * 128 + 32 * cq + 8 * c), bb = *(const f32x4*)(lnb + g * 128 + 32 * cq + 8 * c + 4);
          const float gm[8] = {ga.x, ga.y, ga.z, ga.w, gb.x, gb.y, gb.z, gb.w}, bt[8] = {ba.x, ba.y, ba.z, ba.w, bb.x, bb.y, bb.z, bb.w};
#pragma unroll
          for (int e = 0; e < 8; ++e) VnT[(32 * cq + 8 * c + e) * RP128 + sj] = (bf16)f2bf((x[e] - mu) * rs * gm[e] + bt[e]); } }
    LDS_WAIT(); __syncthreads();
    { const int ib = wid >> 1;
#pragma unroll
      for (int cc = 0; cc < 2; ++cc) { const int cb = 2 * (wid & 1) + cc;
          f32x16_t x = {0.f, 0.f, 0.f, 0.f, 0.f, 0.f, 0.f, 0.f, 0.f, 0.f, 0.f, 0.f, 0.f, 0.f, 0.f, 0.f};
#pragma unroll
          for (int kk = 0; kk < 8; ++kk) x = MFMA32(ldfrag(Ws, 32 * ib + r, RP128, kk, h2), ldfrag(VnT, 32 * cb + r, RP128, kk, h2), x);
          const int c = g * 128 + 32 * cb + r;
#pragma unroll
          for (int reg = 0; reg < 16; ++reg) { const int i = 32 * ib + crow32(reg, h2); const float sp = x[reg] + b_s[g * 128 + i];
              YB[(r0 + i) * 1536 + 1024 + c] = (bf16)f2bf(bf2f(GU[(r0 + i) * 512 + c]) * sp); } } }
    __syncthreads();
}


__device__ __forceinline__ void gmlp_stat_unit(Frame& F, int b, int n) {
    int tid_ = threadIdx.x; asm volatile("" : "+v"(tid_));
    const int tid = tid_, row = tid >> 2, qt = tid & 3;
    const bf16* GV = (const bf16*)(F.ws + WS_GV); float* GST = (float*)(F.ws + WS_GST);
    const size_t r = (size_t)b * SEQ + (size_t)n * 128 + row;
    v4u w[16];
#pragma unroll
    for (int c = 0; c < 16; ++c) w[c] = *(const v4u*)(GV + r * 512 + 128 * qt + 8 * c);
    float s = 0.f;
#pragma unroll
    for (int c = 0; c < 16; ++c) { float x[8]; unpack8(w[c], x); s += ((x[0] + x[1]) + (x[2] + x[3])) + ((x[4] + x[5]) + (x[6] + x[7])); }
    s += __shfl_xor(s, 1); s += __shfl_xor(s, 2);
    const float mean = s * (1.f / 512.f); float s2 = 0.f;
#pragma unroll
    for (int c = 0; c < 16; ++c) { float x[8]; unpack8(w[c], x);
#pragma unroll
        for (int e = 0; e < 8; ++e) { const float d = x[e] - mean; s2 += d * d; } }
    s2 += __shfl_xor(s2, 1); s2 += __shfl_xor(s2, 2);
    if (qt == 0) { GST[2 * r] = mean; GST[2 * r + 1] = 1.f / sqrtf(s2 * (1.f / 512.f) + LN_EPS); }
}
constexpr int G2_WS = 0, G2_VNT = 34816, G2_SW = 69632, G2_END = 104448;
__device__ __forceinline__ void gmlp_unit2(Frame& F, int b, int n, int g, const float* w_s, const float* b_s, const float* lng, const float* lnb) {
    int tid_ = threadIdx.x; asm volatile("" : "+v"(tid_));
    const int tid = tid_, lane = tid & 63, wid = __builtin_amdgcn_readfirstlane(tid >> 6), l15 = lane & 15, q4 = lane >> 4;
    const bf16* GU = (const bf16*)(F.ws + WS_GU); const bf16* GV = (const bf16*)(F.ws + WS_GV); bf16* YB = (bf16*)(F.ws + WS_YB); const float* GST = (const float*)(F.ws + WS_GST);
    LAS bf16* Ws = (LAS bf16*)(F.lds + RING_OFF + G2_WS); LAS bf16* VnT = (LAS bf16*)(F.lds + RING_OFF + G2_VNT); LAS bf16* Sw = (LAS bf16*)(F.lds + RING_OFF + G2_SW) + wid * (16 * RP128);
    const size_t r0 = (size_t)b * SEQ + (size_t)n * 128;
    const int sj = tid & 127, cq = tid >> 7, wi = tid >> 2, jq = tid & 3;
    v4u vreg[4]; f32x4 wreg[8];
#pragma unroll
    for (int c = 0; c < 4; ++c) vreg[c] = *(const v4u*)(GV + (r0 + sj) * 512 + g * 128 + 32 * cq + 8 * c);
    const float mu = GST[2 * (r0 + sj)], rs = GST[2 * (r0 + sj) + 1];
    { const float* wr = w_s + ((size_t)g * 128 + wi) * 128 + 32 * jq;
#pragma unroll
      for (int c = 0; c < 8; ++c) wreg[c] = *(const f32x4*)(wr + 4 * c); }
    __syncthreads();
#pragma unroll
    for (int c = 0; c < 4; ++c) { const int j0 = 32 * jq + 8 * c; const f32x4 a = wreg[2 * c], bq = wreg[2 * c + 1];
        v4u w; w.x = pk2(j0 + 0 <= wi ? a.x : 0.f, j0 + 1 <= wi ? a.y : 0.f); w.y = pk2(j0 + 2 <= wi ? a.z : 0.f, j0 + 3 <= wi ? a.w : 0.f);
        w.z = pk2(j0 + 4 <= wi ? bq.x : 0.f, j0 + 5 <= wi ? bq.y : 0.f); w.w = pk2(j0 + 6 <= wi ? bq.z : 0.f, j0 + 7 <= wi ? bq.w : 0.f);
        *(LAS v4u*)(Ws + wi * RP128 + j0) = w; }
#pragma unroll
    for (int c = 0; c < 4; ++c) { float x[8]; unpack8(vreg[c], x);
        const f32x4 ga = *(const f32x4*)(lng + g * 128 + 32 * cq + 8 * c), gb = *(const f32x4*)(lng + g * 128 + 32 * cq + 8 * c + 4);
        const f32x4 ba = *(const f32x4*)(lnb + g * 128 + 32 * cq + 8 * c), bb = *(const f32x4*)(lnb + g * 128 + 32 * cq + 8 * c + 4);
        const float gm[8] = {ga.x, ga.y, ga.z, ga.w, gb.x, gb.y, gb.z, gb.w}, bt[8] = {ba.x, ba.y, ba.z, ba.w, bb.x, bb.y, bb.z, bb.w};
#pragma unroll
        for (int e = 0; e < 8; ++e) VnT[(32 * cq + 8 * c + e) * RP128 + sj] = (bf16)f2bf((x[e] - mu) * rs * gm[e] + bt[e]); }
    LDS_WAIT(); __syncthreads();
    const int i0 = 16 * wid, nks = (wid + 2) >> 1;
    float bs[4];
#pragma unroll
    for (int reg = 0; reg < 4; ++reg) bs[reg] = b_s[g * 128 + i0 + 4 * q4 + reg];
    { f32x4 x[8];
#pragma unroll
      for (int cb = 0; cb < 8; ++cb) x[cb] = (f32x4){0.f, 0.f, 0.f, 0.f};
#pragma unroll 1
      for (int ks = 0; ks < nks; ++ks) {
          const bf16x8_t a = ldfrag16(Ws, i0 + l15, RP128, ks, q4);
#pragma unroll
          for (int cb = 0; cb < 8; ++cb) x[cb] = MFMA16(a, ldfrag16(VnT, 16 * cb + l15, RP128, ks, q4), x[cb]);
      }
#pragma unroll
      for (int cb = 0; cb < 8; ++cb)
#pragma unroll
          for (int reg = 0; reg < 4; ++reg) Sw[(4 * q4 + reg) * RP128 + 16 * cb + l15] = (bf16)f2bf(x[cb][reg] + bs[reg]);
    }
    LDS_WAIT();
#pragma unroll
    for (int c = 0; c < 4; ++c) { const int ch = c * 64 + lane, row = ch >> 4, cc = ch & 15;
        float sp[8], gu[8]; unpack8(*(const LAS v4u*)(Sw + row * RP128 + 8 * cc), sp); unpack8(*(const v4u*)(GU + (r0 + i0 + row) * 512 + g * 128 + 8 * cc), gu);
        v4u w; w.x = pk2(sp[0] * gu[0], sp[1] * gu[1]); w.y = pk2(sp[2] * gu[2], sp[3] * gu[3]); w.z = pk2(sp[4] * gu[4], sp[5] * gu[5]); w.w = pk2(sp[6] * gu[6], sp[7] * gu[7]);
        *(v4u*)(YB + (r0 + i0 + row) * 1536 + 1024 + g * 128 + 8 * cc) = w; }
    __syncthreads();
}


constexpr int GP_WS = 0, GP_VNT = 69632;
__device__ __forceinline__ void gmlp_pair(Frame& F, int b, int n, int g0, const float* w_s, const float* b_s, const float* lng, const float* lnb) {
    int tid_ = threadIdx.x; asm volatile("" : "+v"(tid_));
    const int tid = tid_, lane = tid & 63, wid = __builtin_amdgcn_readfirstlane(tid >> 6), l15 = lane & 15, q4 = lane >> 4;
    const bf16* GU = (const bf16*)(F.ws + WS_GU); const bf16* GV = (const bf16*)(F.ws + WS_GV); bf16* YB = (bf16*)(F.ws + WS_YB); const float* GST = (const float*)(F.ws + WS_GST);
    LAS bf16* WsB = (LAS bf16*)(F.lds + RING_OFF + GP_WS); LAS bf16* VnTB = (LAS bf16*)(F.lds + RING_OFF + GP_VNT);
    const size_t r0 = (size_t)b * SEQ + (size_t)n * 128;
    const int sj = tid & 127, cq = tid >> 7, wi = tid >> 2, jq = tid & 3;
    v4u vreg[2][4]; f32x4 wreg[2][8];
#pragma unroll
    for (int u = 0; u < 2; ++u)
#pragma unroll
        for (int c = 0; c < 4; ++c) vreg[u][c] = *(const v4u*)(GV + (r0 + sj) * 512 + (g0 + u) * 128 + 32 * cq + 8 * c);
    const float mu = GST[2 * (r0 + sj)], rs = GST[2 * (r0 + sj) + 1];
#pragma unroll
    for (int u = 0; u < 2; ++u) { const float* wr = w_s + ((size_t)(g0 + u) * 128 + wi) * 128 + 32 * jq;
#pragma unroll
        for (int c = 0; c < 8; ++c) wreg[u][c] = *(const f32x4*)(wr + 4 * c); }
    __syncthreads();
#pragma unroll
    for (int u = 0; u < 2; ++u) { const int g = g0 + u; LAS bf16* Ws = WsB + u * (128 * RP128); LAS bf16* VnT = VnTB + u * (128 * RP128);
#pragma unroll
        for (int c = 0; c < 4; ++c) { const int j0 = 32 * jq + 8 * c; const f32x4 a = wreg[u][2 * c], bq = wreg[u][2 * c + 1];
            v4u w; w.x = pk2(j0 + 0 <= wi ? a.x : 0.f, j0 + 1 <= wi ? a.y : 0.f); w.y = pk2(j0 + 2 <= wi ? a.z : 0.f, j0 + 3 <= wi ? a.w : 0.f);
            w.z = pk2(j0 + 4 <= wi ? bq.x : 0.f, j0 + 5 <= wi ? bq.y : 0.f); w.w = pk2(j0 + 6 <= wi ? bq.z : 0.f, j0 + 7 <= wi ? bq.w : 0.f);
            *(LAS v4u*)(Ws + wi * RP128 + j0) = w; }
#pragma unroll
        for (int c = 0; c < 4; ++c) { float x[8]; unpack8(vreg[u][c], x);
            const f32x4 ga = *(const f32x4*)(lng + g * 128 + 32 * cq + 8 * c), gb = *(const f32x4*)(lng + g * 128 + 32 * cq + 8 * c + 4);
            const f32x4 ba = *(const f32x4*)(lnb + g * 128 + 32 * cq + 8 * c), bb = *(const f32x4*)(lnb + g * 128 + 32 * cq + 8 * c + 4);
            const float gm[8] = {ga.x, ga.y, ga.z, ga.w, gb.x, gb.y, gb.z, gb.w}, bt[8] = {ba.x, ba.y, ba.z, ba.w, bb.x, bb.y, bb.z, bb.w};
#pragma unroll
            for (int e = 0; e < 8; ++e) VnT[(32 * cq + 8 * c + e) * RP128 + sj] = (bf16)f2bf((x[e] - mu) * rs * gm[e] + bt[e]); }
    }
    LDS_WAIT(); __syncthreads();
    const int i0 = 16 * wid, nks = (wid + 2) >> 1;
#pragma unroll
    for (int u = 0; u < 2; ++u) { const int g = g0 + u; LAS bf16* Ws = WsB + u * (128 * RP128); LAS bf16* VnT = VnTB + u * (128 * RP128); LAS bf16* Sw = Ws + i0 * RP128;
        float bs[4];
#pragma unroll
        for (int reg = 0; reg < 4; ++reg) bs[reg] = b_s[g * 128 + i0 + 4 * q4 + reg];
        v4u gur[4];
#pragma unroll
        for (int c = 0; c < 4; ++c) { const int ch = c * 64 + lane, row = ch >> 4, cc = ch & 15; gur[c] = *(const v4u*)(GU + (r0 + i0 + row) * 512 + g * 128 + 8 * cc); }
        f32x4 x[8];
#pragma unroll
        for (int cb = 0; cb < 8; ++cb) x[cb] = (f32x4){0.f, 0.f, 0.f, 0.f};
#pragma unroll 1
        for (int ks = 0; ks < nks; ++ks) {
            const bf16x8_t a = ldfrag16(Ws, i0 + l15, RP128, ks, q4);
#pragma unroll
            for (int cb = 0; cb < 8; ++cb) x[cb] = MFMA16(a, ldfrag16(VnT, 16 * cb + l15, RP128, ks, q4), x[cb]);
        }
#pragma unroll
        for (int cb = 0; cb < 8; ++cb)
#pragma unroll
            for (int reg = 0; reg < 4; ++reg) Sw[(4 * q4 + reg) * RP128 + 16 * cb + l15] = (bf16)f2bf(x[cb][reg] + bs[reg]);
        LDS_WAIT();
#pragma unroll
        for (int c = 0; c < 4; ++c) { const int ch = c * 64 + lane, row = ch >> 4, cc = ch & 15;
            float sp[8], gu[8]; unpack8(*(const LAS v4u*)(Sw + row * RP128 + 8 * cc), sp); unpack8(gur[c], gu);
            v4u w; w.x = pk2(sp[0] * gu[0], sp[1] * gu[1]); w.y = pk2(sp[2] * gu[2], sp[3] * gu[3]); w.z = pk2(sp[4] * gu[4], sp[5] * gu[5]); w.w = pk2(sp[6] * gu[6], sp[7] * gu[7]);
            *(v4u*)(YB + (r0 + i0 + row) * 1536 + 1024 + g * 128 + 8 * cc) = w; }
    }
    __syncthreads();
}


__device__ __forceinline__ void moe_tail_unit(Frame& F, const MoeTiles& mt, int e, int rb, int cb) {
    int cnt, t0; mt.expert(e, cnt, t0);
    const int re = cnt & 255, nfull = cnt >> 8;
    if (64 * rb >= re) return;
    int tid_ = threadIdx.x; asm volatile("" : "+v"(tid_));
    const int tid = tid_, lane = tid & 63, wid = __builtin_amdgcn_readfirstlane(tid >> 6), l15 = lane & 15, q4 = lane >> 4;
    const int rl = 16 * (wid & 3), cl = 64 * (wid >> 2), srow = tid >> 3, sch = tid & 7;
    const unsigned char* Ag = (const unsigned char*)(F.ws + WS_HID) + ((size_t)(t0 + nfull) * 256 + 64 * rb + srow) * DFF_E + 16 * sch;
    const unsigned char* Bg = (const unsigned char*)(F.ws + WS_WMD) + ((size_t)e * 1024 + 128 * cb + srow) * DFF_E + 16 * sch;
    constexpr int TP = 272;
    LAS unsigned char* As = F.lds + RING_OFF; LAS unsigned char* Bs = F.lds + RING_OFF + 2 * 64 * TP;
    f32x4 acc[4] = {{0.f, 0.f, 0.f, 0.f}, {0.f, 0.f, 0.f, 0.f}, {0.f, 0.f, 0.f, 0.f}, {0.f, 0.f, 0.f, 0.f}};
    v4u ra[2][2], rbv[2][4];
#define TAIL_LOAD(s_, kt) do { ra[s_][0] = *(const v4u*)(Ag + 256 * (kt)); ra[s_][1] = *(const v4u*)(Ag + 256 * (kt) + 128); rbv[s_][0] = *(const v4u*)(Bg + 256 * (kt)); rbv[s_][1] = *(const v4u*)(Bg + 256 * (kt) + 128); \
        rbv[s_][2] = *(const v4u*)(Bg + (size_t)64 * DFF_E + 256 * (kt)); rbv[s_][3] = *(const v4u*)(Bg + (size_t)64 * DFF_E + 256 * (kt) + 128); } while (0)
#define TAIL_STEP(s_, kt) do { LAS unsigned char* as = As + (s_) * (64 * TP); LAS unsigned char* bs = Bs + (s_) * (128 * TP); \
        *(LAS v4u*)(as + srow * TP + 16 * sch) = ra[s_][0]; *(LAS v4u*)(as + srow * TP + 128 + 16 * sch) = ra[s_][1]; \
        *(LAS v4u*)(bs + srow * TP + 16 * sch) = rbv[s_][0]; *(LAS v4u*)(bs + srow * TP + 128 + 16 * sch) = rbv[s_][1]; \
        *(LAS v4u*)(bs + (srow + 64) * TP + 16 * sch) = rbv[s_][2]; *(LAS v4u*)(bs + (srow + 64) * TP + 128 + 16 * sch) = rbv[s_][3]; \
        LDS_WAIT(); __syncthreads(); \
        if ((kt) + 2 < DFF_E / 256) TAIL_LOAD(s_, (kt) + 2); \
        _Pragma("unroll") for (int kk = 0; kk < 2; ++kk) { \
            const LAS unsigned char* ap = as + (rl + l15) * TP + 128 * kk + 32 * q4; \
            const pg8::v8i_t a = __builtin_shufflevector(*(const LAS pg8::v4i_t*)ap, *(const LAS pg8::v4i_t*)(ap + 16), 0, 1, 2, 3, 4, 5, 6, 7); \
            _Pragma("unroll") for (int j = 0; j < 4; ++j) { const LAS unsigned char* bp = bs + (cl + 16 * j + l15) * TP + 128 * kk + 32 * q4; \
                const pg8::v8i_t b = __builtin_shufflevector(*(const LAS pg8::v4i_t*)bp, *(const LAS pg8::v4i_t*)(bp + 16), 0, 1, 2, 3, 4, 5, 6, 7); \
                acc[j] = __builtin_amdgcn_mfma_scale_f32_16x16x128_f8f6f4(a, b, acc[j], 0, 0, 0, 0x7f7f7f7f, 0, (int)E8_DN); } } } while (0)
    TAIL_LOAD(0, 0); TAIL_LOAD(1, 1);
    __syncthreads();
#pragma unroll 1
    for (int kt = 0; kt < DFF_E / 256; kt += 2) { TAIL_STEP(0, kt); TAIL_STEP(1, kt + 1); }
    static_assert((DFF_E / 256) % 2 == 0, "even number of K-steps");
#undef TAIL_LOAD
#undef TAIL_STEP
    const unsigned* list = (const unsigned*)(F.ws + WS_LIST); const float* gatew = (const float*)(F.ws + WS_GATEW);
    bf16* c0 = (bf16*)(F.ws + WS_YPRE); bf16* c1 = (bf16*)(F.ws + WS_C1);
#pragma unroll
    for (int reg = 0; reg < 4; ++reg) { const int r = 64 * rb + rl + 4 * q4 + reg;
        if (r < re) { const int slot = nfull * 256 + r; const unsigned ent = list[e * 16384 + slot]; const float g = gatew[e * 16384 + slot];
            bf16* dst = ((ent >> 31) ? c1 : c0) + (size_t)(ent & 0x7fffffffu) * 1024 + 128 * cb + cl + l15;
#pragma unroll
            for (int j = 0; j < 4; ++j) dst[16 * j] = (bf16)f2bf(acc[j][reg] * g); } }
    __syncthreads();
}


constexpr int CV_I_IN = 16 * 112, CV_I_BR = 8 * 16, CV_I_OUT = 16 * 16, CV_I_DU = 16 * 88, CV_I_DD = 44 * 16, CV_I_MU = 16 * 112, CV_I_MD = 56 * 16;
constexpr int CV_I_G8 = 16 * 48;
constexpr int CV_NITEMS = 2 * CV_I_IN + 6 * CV_I_BR + 2 * CV_I_OUT + CV_I_DU + CV_I_DD + 8 * CV_I_MU + 8 * CV_I_MD + (GATES_FP8 ? 2 * CV_I_G8 : 0);
constexpr int CV_MD0 = 8 * CV_I_MU, CV_MD1 = 8 * CV_I_MU + 8 * CV_I_MD;
constexpr int CV_DEFER = 5 * CV_I_MU;
__device__ __forceinline__ void cvt_global_item(Frame& F, int it, LAS float* scr, int lane) {
    int r = it; bool done = false;
#pragma unroll 1
    for (int e = 0; e < 8 && !done; ++e) { CvtJob j{(const float*)(const GAS float*)lds_ptr(F.lds, 15) + (size_t)e * 1024 * 7168, 1024, 7168, 7168, (bf16*)(F.ws + WS_WMU + (size_t)e * 7168 * 1024), 1024, 0, 2, DFF_E, SC_WU8}; done = cvt_run(j, r, scr, lane); }
#pragma unroll 1
    for (int e = 0; e < 8 && !done; ++e) { CvtJob j{(const float*)(const GAS float*)lds_ptr(F.lds, 16) + (size_t)e * 3584 * 1024, 3584, 1024, 1024, (bf16*)(F.ws + WS_WMD + (size_t)e * 1024 * 3584), 3584, 0, 0, 0, SC_WD8}; done = cvt_run(j, r, scr, lane); }
#pragma unroll 1
    for (int l = 0; l < 2 && !done; ++l) { CvtJob j{(const float*)(const GAS float*)lds_ptr(F.lds, 1) + (size_t)l * 1024 * N_INSRC, 1024, N_INSRC, N_INV, (bf16*)(F.ws + WS_WIN) + (size_t)l * N_INV * 1024, 1024, 0, 1, 0, 0.f}; done = cvt_run(j, r, scr, lane); }
#pragma unroll 1
    for (int q = 0; q < 6 && !done; ++q) { const int l = q / 3, n = q % 3; CvtJob j{(const float*)(const GAS float*)lds_ptr(F.lds, 8) + (size_t)q * 512 * 1024, 512, 1024, 1024, (bf16*)(F.ws + WS_WBR) + (size_t)l * 1024 * 1536, 1536, n * 512, 0, 0, 0.f}; done = cvt_run(j, r, scr, lane); }
#pragma unroll 1
    for (int l = 0; l < 2 && !done; ++l) { CvtJob j{(const float*)(const GAS float*)lds_ptr(F.lds, 9) + (size_t)l * 1024 * 1024, 1024, 1024, 1024, (bf16*)(F.ws + WS_WOUT) + (size_t)l * 1024 * 1024, 1024, 0, 0, 0, 0.f}; done = cvt_run(j, r, scr, lane); }
    if (!done) { CvtJob j{(const float*)(const GAS float*)lds_ptr(F.lds, 12), 1024, 2 * DFF_D, 2 * DFF_D, (bf16*)(F.ws + WS_WDU), 1024, 0, 2, DFF_D, (DENSE_FP8 == 4) ? -SC_WI8 : (DENSE_FP8 == 1 || DENSE_FP8 == 2) ? SC_WU8 : 0.f}; done = cvt_run(j, r, scr, lane); }
    if (!done) { CvtJob j{(const float*)(const GAS float*)lds_ptr(F.lds, 13), DFF_D, 1024, 1024, (bf16*)(F.ws + WS_WDD), DFF_D, 0, 0, 0, (DENSE_FP8 == 1 || DENSE_FP8 == 3) ? SC_WD8 : 0.f}; done = cvt_run(j, r, scr, lane); }
#if GATES_FP8
#pragma unroll 1
    for (int l = 0; l < 2 && !done; ++l) { CvtJob j{(const float*)(const GAS float*)lds_ptr(F.lds, 1) + (size_t)l * 1024 * N_INSRC, 1024, N_INSRC, 3072, (bf16*)(F.ws + WS_WIN8 + (size_t)l * 3072 * 1024), 1024, 0, 1, 0, SC_WU8, 4096}; done = cvt_run(j, r, scr, lane); }
#endif
}

struct Args { const float* in[17]; float* out; unsigned char* ws; int ph_lo, ph_hi; };
constexpr int N_PHASES = 17;

__global__ void __launch_bounds__(NWAVES * 64, 2) mega_fwd(Args args) {
    extern __shared__ __attribute__((aligned(16))) unsigned char lds[];
    Frame F;
    F.lds = (LAS unsigned char*)lds;
    F.MISC = (volatile LAS unsigned*)(F.lds + MISC_OFF);
    F.tid = threadIdx.x; F.lane = F.tid & 63; F.wave = __builtin_amdgcn_readfirstlane(F.tid >> 6);
    F.G = gridDim.x; { const int bx = blockIdx.x; F.vcu = (F.G % 8 == 0) ? (bx % 8) * (F.G / 8) + bx / 8 : bx; }
    F.ws = args.ws; F.ctl = (gu32*)(args.ws + WS_CTL);
    for (int u = F.tid; u < (LDS_BYTES - LDSCTL_OFF) / 4; u += NWAVES * 64) ((LAS unsigned*)(F.lds + LDSCTL_OFF))[u] = 0u;
    __syncthreads();
    XcdBarrier bar = xcd_barrier_post((unsigned*)(F.ctl + CW_BAR), F.MISC + 8, gridDim.x, 0u);
    const bool grp = (F.G == 256);
    XcdBarrier gbar = bar;
    if (grp) gbar = xcd_barrier_post((unsigned*)(F.ctl + CW_BAR) + (1 + (blockIdx.x & 7)) * XCD_BAR_WORDS, F.MISC + 10, 32u, 1u);
#define GRID_BAR() xcd_barrier(bar)
#define GRP_BAR() do { if (grp) xcd_barrier(gbar); else xcd_barrier(bar); } while (0)
    const int lo = args.ph_lo, hi = args.ph_hi;
#ifndef PH_MASK
#define PH_MASK 0x1ff
#endif
#define IN(k) (lo <= (k) && (k) < hi)
#ifndef DUP_PHASE
#define DUP_PHASE (-1)
#endif
#define REPS(k) (((k) == DUP_PHASE) ? 2 : 1)
#ifndef P2DUP
#define P2DUP 0
#endif
#define PHASE_BEGIN() do { int t_ = threadIdx.x; asm volatile("" : "+v"(t_)); F.tid = t_; F.lane = t_ & 63; F.wave = __builtin_amdgcn_readfirstlane(t_ >> 6); } while (0)
#define ON(j) (((PH_MASK) >> (j)) & 1)
#define SEAM(k) do { if (IN(k) && IN((k) + 1)) GRID_BAR(); } while (0)
#define SEAMG(k) do { if (IN(k) && IN((k) + 1)) GRP_BAR(); } while (0)

    if (F.tid == 0) { LAS unsigned long long* pt = (LAS unsigned long long*)(F.lds + PTAB_OFF);
#pragma unroll
        for (int i = 0; i < 17; ++i) pt[i] = (unsigned long long)args.in[i];
        pt[17] = (unsigned long long)args.out; }
    LDS_WAIT(); __syncthreads();
#define INP(k) ((const float*)(const GAS float*)lds_ptr(F.lds, (k)))
    if (ON(0) && IN(0)) { for (int rep_ = 0; rep_ < REPS(0); ++rep_) { PHASE_BEGIN();
        LAS float* scr = (LAS float*)(F.lds + RING_OFF + F.wave * 17408);
        static_assert(NWAVES * 17408 <= RING_BYTES, "conversion tiles fit the phase scratch");
        const int gw = F.vcu * NWAVES + F.wave, NGW = F.G * NWAVES;
        for (int it = CV_DEFER + gw; it < CV_NITEMS - (CV_MD1 - CV_MD0); it += NGW) { const int jt = it < CV_MD0 ? it : it + (CV_MD1 - CV_MD0); cvt_global_item(F, jt, scr, F.lane); }
        __syncthreads();
        { float* cs = (float*)(F.ws + WS_CS);
          for (int i = F.vcu * 512 + F.tid; i < SEQ * 32; i += F.G * 512) { const int pos = i >> 5, d = i & 31;
              const double rev = (double)pos * exp(-(double)d / 32.0 * 9.210340371976184) * 0.15915494309189535; const float fr_ = (float)(rev - floor(rev));
              cs[i] = __builtin_amdgcn_cosf(fr_); cs[65536 + i] = __builtin_amdgcn_sinf(fr_); } }
        p0_rows(F, INP(0), INP(1), INP(2));
    } }
    SEAM(0);

#pragma unroll 1
    for (int l = 0; l < 2; ++l) {
        const int pb = 1 + 8 * l;
        const float* xres = (l == 0) ? INP(0) : ((float*)(F.ws + WS_XF));
        if (ON(1) && IN(pb + 0)) { for (int rep_ = 0; rep_ < REPS(pb + 0); ++rep_) { PHASE_BEGIN();
            const bool g8 = (GATES_FP8 == 2) || (GATES_FP8 == 1 && l == 1);
            ProjSched S; S.init(M / 256, g8 ? 16 : N_INV / 256, F.G, (int)blockIdx.x); S.A = ((bf16*)(F.ws + WS_XB)); S.Bt = (const bf16*)(F.ws + WS_WIN) + (size_t)l * N_INV * 1024; S.K = 1024;
            EpiProj E{F.ws, INP(3) + l * 3072, ((const float*)(F.ws + WS_CS))};
            pg8::gemm_phase<EpiProj, ProjSched>(F.lds + RING_OFF, 1024, S, E);
#if GATES_FP8
            if (g8) {
                pg8::PlainSched S8; S8.init(M / 256, 12, F.G, (int)blockIdx.x); S8.A = (const bf16*)(F.ws + WS_X8IN); S8.Bt = (const bf16*)(F.ws + WS_WIN8 + (size_t)l * 3072 * 1024); S8.K = 1024; S8.esz = 1;
                EpiGate8 E8{(bf16*)(F.ws + WS_GT), INP(3) + l * 3072};
                pg8::gemm_phase<EpiGate8, pg8::PlainSched, E8_UP>(F.lds + RING_OFF, 1024, S8, E8);
            }
#endif
        } }
        SEAMG(pb + 0);
        if (ON(2) && IN(pb + 1)) { for (int rep_ = 0; rep_ < REPS(pb + 1); ++rep_) { PHASE_BEGIN();
            {
#if NAIVE_FOX
            LAS float* tab = (LAS float*)(F.lds + RING_OFF + 4096); LAS float* wtot = (LAS float*)(F.lds + RING_OFF + 4096 + 8192);
            for (int uu = F.vcu; uu < 64 * 8; uu += F.G) {
                const int bh = uu >> 3, qb = uu & 7, b = bh >> 3, h = bh & 7;
                fox_bias_table<false>(F, b, h, tab, wtot);
                for (int r = F.wave; r < 256; r += NWAVES) naive_fox_row(F, b, h, qb * 256 + r, tab);
                __syncthreads();
            }
#else
            LAS float* tab = (LAS float*)(F.lds + RING_OFF + 86016); LAS float* wtot = (LAS float*)(F.lds + RING_OFF + 86016 + 32768);
            static_assert(attn_body::ATTN_LDS_BYTES <= 86016 && 86016 + 32768 + 64 <= RING_BYTES, "attention scratch below the bias rows");
            for (int d_ = 0; d_ < ((P2DUP & 1) ? 2 : 1); ++d_)
            for (int pp = F.vcu; pp < 256; pp += F.G) {
                const int bh = pp >> 2, sq = pp & 3, b = bh >> 3, h = bh & 7;
                fox_bias_table<true>(F, b, h, tab, wtot);
#pragma unroll 1
                for (int i = 0; i < 2; ++i)
                    attn_body::attn_unit<8>(b, h, i ? 7 - sq : sq, (const attn_body::bf16*)(F.ws + WS_FQ), (const attn_body::bf16*)(F.ws + WS_FK), (const attn_body::bf16*)(F.ws + WS_FV), (attn_body::bf16*)(F.ws + WS_YB), (char*)lds + RING_OFF, (attn_body::lds_tabptr)tab);
            }
            __syncthreads();
#endif
            }
#if NAIVE_RET == 1
            { const int gw = F.vcu * NWAVES + F.wave, NGW = F.G * NWAVES;
              for (int idx = gw; idx < BATCH * 4 * SEQ; idx += NGW) { const int t = idx & (SEQ - 1), bh = idx >> 11; naive_ret_row(F, bh >> 2, bh & 3, t); } }
#endif
#if NAIVE_GMLP == 1
            for (int uu = F.vcu; uu < BATCH * 16 * 4; uu += F.G) { const int g = uu & 3, n = (uu >> 2) & 15, b = uu >> 6;
                naive_gmlp_unit(F, b, n, g, INP(4) + (size_t)l * 4 * 128 * 128, INP(5) + l * 512, INP(6) + l * 512, INP(7) + l * 512); }
#endif
#if MK_N_LAUNCHES == 1 && NAIVE_RET == 0 && NAIVE_GMLP == 0
            for (int d_ = 0; d_ < ((P2DUP & 2) ? 2 : 1); ++d_)
            for (int uu = 2 * F.vcu; uu < 512; uu += 2 * F.G) {
#pragma unroll 1
                for (int q = 0; q < 2; ++q) { const int un = uu + q, bh = un >> 4; ret_kv_unit(F, bh >> 2, bh & 3, un & 15); } }
            if (grp) { if ((F.vcu & 31) < 16) gmlp_stat_unit(F, F.vcu >> 5, F.vcu & 31); }
            else for (int uu = F.vcu; uu < 128; uu += F.G) gmlp_stat_unit(F, uu >> 4, uu & 15);
            GRP_BAR();
            for (int d_ = 0; d_ < ((P2DUP & 4) ? 2 : 1); ++d_)
            for (int pp = F.vcu; pp < 256; pp += F.G) { const int bh = pp >> 3, sq = pp & 7;
#pragma unroll 1
                for (int q = 0; q < 2; ++q) ret_out_unit(F, bh >> 2, bh & 3, q ? 15 - sq : sq); }
            for (int d_ = 0; d_ < ((P2DUP & 8) ? 2 : 1); ++d_)
            for (int uu = F.vcu; uu < 256; uu += F.G) gmlp_pair(F, uu >> 5, (uu >> 1) & 15, (uu & 1) * 2, INP(4) + (size_t)l * 4 * 128 * 128, INP(5) + l * 512, INP(6) + l * 512, INP(7) + l * 512);
#else
            for (int uu = F.vcu; uu < 256; uu += F.G) {
                if (uu < 128) {
#if NAIVE_RET == 0
                    ret_unit(F, uu >> 4, (uu >> 2) & 3, uu & 3);
#endif
                } else {
#if NAIVE_GMLP == 0
#pragma unroll 1
                    for (int q = 0; q < 4; ++q) { const int gu = (uu - 128) * 4 + q; gmlp_unit(F, gu >> 6, (gu >> 2) & 15, gu & 3, INP(4) + (size_t)l * 4 * 128 * 128, INP(5) + l * 512, INP(6) + l * 512, INP(7) + l * 512); }
#endif
                }
            }
#endif
        } }
        SEAMG(pb + 1);
        if (ON(3) && IN(pb + 2)) { for (int rep_ = 0; rep_ < REPS(pb + 2); ++rep_) { PHASE_BEGIN();
            pg8::PlainSched S; S.init(M / 256, 4, F.G, (int)blockIdx.x); S.A = ((bf16*)(F.ws + WS_YB)); S.Bt = (const bf16*)(F.ws + WS_WBR) + (size_t)l * 1024 * 1536; S.K = 1536;
            EpiMerge E{(const bf16*)(F.ws + WS_GT), ((bf16*)(F.ws + WS_MRG))};
            pg8::gemm_phase<EpiMerge, pg8::PlainSched>(F.lds + RING_OFF, 1536, S, E);
        } }
        SEAMG(pb + 2);
        if (ON(4) && IN(pb + 3)) { for (int rep_ = 0; rep_ < REPS(pb + 3); ++rep_) { PHASE_BEGIN();
            pg8::PlainSched S; S.init(M / 256, 4, F.G, (int)blockIdx.x); S.A = ((bf16*)(F.ws + WS_MRG)); S.Bt = (const bf16*)(F.ws + WS_WOUT) + (size_t)l * 1024 * 1024; S.K = 1024;
            EpiResid E{xres, ((float*)(F.ws + WS_YPRE))};
            pg8::gemm_phase<EpiResid, pg8::PlainSched>(F.lds + RING_OFF, 1024, S, E);
        } }
        SEAMG(pb + 3);
        if (ON(5) && IN(pb + 4)) { for (int rep_ = 0; rep_ < REPS(pb + 4); ++rep_) { PHASE_BEGIN();
            if (l == 0) ln_pass<0>(F, ((float*)(F.ws + WS_YPRE)), 1.f, nullptr, nullptr, INP(10) + (l * 2 + 0) * 1024, INP(11) + (l * 2 + 0) * 1024, ((float*)(F.ws + WS_XF)), (DENSE_FP8 == 1 || DENSE_FP8 == 2 || DENSE_FP8 == 4) ? nullptr : ((bf16*)(F.ws + WS_XB)), (DENSE_FP8 == 1 || DENSE_FP8 == 2 || DENSE_FP8 == 4) ? (unsigned char*)(F.ws + WS_XB) : nullptr, nullptr, 0, 0, nullptr, grp, (DENSE_FP8 == 4) ? -SC_XI8 : SC_X8);
            else ln_pass<2>(F, ((float*)(F.ws + WS_YPRE)), 1.f, nullptr, nullptr, INP(10) + (l * 2 + 0) * 1024, INP(11) + (l * 2 + 0) * 1024, ((float*)(F.ws + WS_XF)), nullptr, (unsigned char*)(F.ws + WS_XB), INP(14), 8, 0, nullptr, grp);
        } }
        if (l == 0) SEAMG(pb + 4); else SEAM(pb + 4);
        if (ON(6) && IN(pb + 5)) { for (int rep_ = 0; rep_ < REPS(pb + 5); ++rep_) { PHASE_BEGIN();
            if (l == 0) {
                pg8::PlainSched S; S.init(M / 256, 2 * DFF_D / 256, F.G, (int)blockIdx.x); S.A = ((bf16*)(F.ws + WS_XB)); S.Bt = (const bf16*)(F.ws + WS_WDU); S.K = 1024;
#if DENSE_FP8 == 1
                S.esz = 1; EpiSwiglu8 E{(unsigned char*)(F.ws + WS_HID), DFF_D};
                pg8::gemm_phase<EpiSwiglu8, pg8::PlainSched, E8_UP>(F.lds + RING_OFF, 1024, S, E);
#elif DENSE_FP8 == 2
                S.esz = 1; EpiSwiglu E{((bf16*)(F.ws + WS_HID)), DFF_D};
                pg8::gemm_phase<EpiSwiglu, pg8::PlainSched, E8_UP>(F.lds + RING_OFF, 1024, S, E);
#elif DENSE_FP8 == 4
                S.esz = 1; EpiSwigluI8 E{((bf16*)(F.ws + WS_HID)), DFF_D};
                pg8::gemm_phase<EpiSwigluI8, pg8::PlainSched, 1u>(F.lds + RING_OFF, 1024, S, E);
#elif DENSE_FP8 == 3
                EpiSwiglu8 E{(unsigned char*)(F.ws + WS_HID), DFF_D};
                pg8::gemm_phase<EpiSwiglu8, pg8::PlainSched>(F.lds + RING_OFF, 1024, S, E);
#else
                EpiSwiglu E{((bf16*)(F.ws + WS_HID)), DFF_D};
                pg8::gemm_phase<EpiSwiglu, pg8::PlainSched>(F.lds + RING_OFF, 1024, S, E);
#endif
                if (F.G == 256 && blockIdx.x >= 128) {
                    LAS float* scr = (LAS float*)(F.lds + RING_OFF + F.wave * 17408);
                    for (int it = ((int)blockIdx.x - 128) * NWAVES + F.wave; it < CV_DEFER; it += 128 * NWAVES) cvt_global_item(F, it, scr, F.lane);
                } else if (F.G != 256) {
                    LAS float* scr = (LAS float*)(F.lds + RING_OFF + F.wave * 17408);
                    for (int it = F.vcu * NWAVES + F.wave; it < CV_DEFER; it += F.G * NWAVES) cvt_global_item(F, it, scr, F.lane);
                }
                __syncthreads();
            } else {
                MoeTiles mt; mt.init(F.ctl);
                MoeUpSched S; S.init(mt.toff[NEXP], 2 * DFF_E / 256, F.G, (int)blockIdx.x); S.A = (const unsigned char*)(F.ws + WS_XB); S.Bt = (const unsigned char*)(F.ws + WS_WMU); S.list = (const unsigned*)(F.ws + WS_LIST); S.mt = mt;
                EpiSwiglu8 E{(unsigned char*)(F.ws + WS_HID), DFF_E};
                pg8::gemm_phase<EpiSwiglu8, MoeUpSched, E8_UP>(F.lds + RING_OFF, 1024, S, E);
                {
                    LAS float* scr = (LAS float*)(F.lds + RING_OFF + F.wave * 17408);
                    const int nwg = mt.toff[NEXP] * (2 * DFF_E / 256), rounds = (nwg + F.G - 1) / F.G, rem = nwg - (rounds - 1) * F.G, nidle = F.G - rem;
                    constexpr int NMD = CV_MD1 - CV_MD0;
                    int q = 0; if (nidle > 0) { q = (NMD + nidle * NWAVES - 1) / (nidle * NWAVES); if (q > 6) q = 6; }
                    int first = nidle * NWAVES * q; if (first > NMD) first = NMD;
                    if ((int)blockIdx.x >= rem) for (int it = ((int)blockIdx.x - rem) * NWAVES + F.wave; it < first; it += nidle * NWAVES) cvt_global_item(F, CV_MD0 + it, scr, F.lane);
                    for (int it = first + (int)blockIdx.x * NWAVES + F.wave; it < NMD; it += F.G * NWAVES) cvt_global_item(F, CV_MD0 + it, scr, F.lane);
                    __syncthreads();
                }
            }
        } }
        if (l == 0) SEAMG(pb + 5); else SEAM(pb + 5);
        if (ON(7) && IN(pb + 6)) { for (int rep_ = 0; rep_ < REPS(pb + 6); ++rep_) { PHASE_BEGIN();
            if (l == 0) {
                pg8::PlainSched S; S.init(M / 256, 4, F.G, (int)blockIdx.x); S.A = ((bf16*)(F.ws + WS_HID)); S.Bt = (const bf16*)(F.ws + WS_WDD); S.K = DFF_D;
                EpiResid E{((float*)(F.ws + WS_XF)), ((float*)(F.ws + WS_YPRE))};
#if DENSE_FP8 == 1 || DENSE_FP8 == 3
                S.esz = 1; pg8::gemm_phase<EpiResid, pg8::PlainSched, E8_DN>(F.lds + RING_OFF, DFF_D, S, E);
#else
                pg8::gemm_phase<EpiResid, pg8::PlainSched>(F.lds + RING_OFF, DFF_D, S, E);
#endif
            } else {
                MoeTiles mt; mt.init(F.ctl);
                MoeDownSched S; S.init(mt.nfull_total(), 4, F.G, (int)blockIdx.x); S.A = (const unsigned char*)(F.ws + WS_HID); S.Bt = (const unsigned char*)(F.ws + WS_WMD); S.mt = mt;
                EpiMoeDown E{((bf16*)(F.ws + WS_YPRE)), ((bf16*)(F.ws + WS_C1)), (const unsigned*)(F.ws + WS_LIST), (const float*)(F.ws + WS_GATEW), mt};
                pg8::gemm_phase<EpiMoeDown, MoeDownSched, E8_DN>(F.lds + RING_OFF, DFF_E, S, E);
                for (int tu = F.vcu; tu < 256; tu += F.G) moe_tail_unit(F, mt, tu >> 5, (tu >> 3) & 3, tu & 7);
            }
        } }
        if (l == 0) SEAMG(pb + 6); else SEAM(pb + 6);
        if (ON(8) && IN(pb + 7)) { for (int rep_ = 0; rep_ < REPS(pb + 7); ++rep_) { PHASE_BEGIN();
            if (l == 0) ln_pass<1>(F, ((float*)(F.ws + WS_YPRE)), 1.f, nullptr, nullptr, INP(10) + (l * 2 + 1) * 1024, INP(11) + (l * 2 + 1) * 1024, ((float*)(F.ws + WS_XF)), ((bf16*)(F.ws + WS_XB)), GATES_FP8 ? (unsigned char*)(F.ws + WS_X8IN) : nullptr, INP(1) + (size_t)1 * 1024 * N_INSRC, N_INSRC, FL_COL, INP(2) + 8, grp);
            else ln_pass<0>(F, ((float*)(F.ws + WS_XF)), ALPHA, (const bf16*)(F.ws + WS_YPRE), (const bf16*)(F.ws + WS_C1), INP(10) + (l * 2 + 1) * 1024, INP(11) + (l * 2 + 1) * 1024, (float*)(GAS float*)lds_ptr(F.lds, 17), nullptr, nullptr, nullptr, 0, 0, nullptr, grp);
        } }
        if (l == 0) SEAMG(pb + 7);
    }
#undef IN
#undef SEAM
}

extern "C" void kernel_launch(void* const* d_in, const int* in_sizes, int n_in, void* d_out, int out_size, void* d_ws, size_t ws_size, hipStream_t stream) {
    static int grid = 0;
    if (grid == 0) {
        if (n_in != 17 || in_sizes[0] != M * D || out_size != M * D || ws_size < WS_END) { fprintf(stderr, "kernel_launch: unexpected shapes / workspace (%zu)\n", ws_size); grid = -1; return; }
        int dev = 0, cus = 0, per_cu = 0;
        if (hipGetDevice(&dev) != hipSuccess || hipDeviceGetAttribute(&cus, hipDeviceAttributeMultiprocessorCount, dev) != hipSuccess) { grid = -1; return; }
        if (hipFuncSetAttribute((const void*)mega_fwd, hipFuncAttributeMaxDynamicSharedMemorySize, LDS_BYTES) != hipSuccess) { grid = -1; return; }
        if (hipOccupancyMaxActiveBlocksPerMultiprocessor(&per_cu, (const void*)mega_fwd, NWAVES * 64, LDS_BYTES) != hipSuccess || per_cu < 1) { fprintf(stderr, "kernel_launch: occupancy query says %d\n", per_cu); }
        (void)hipGetLastError();
        grid = cus;
    }
    if (grid < 0) return;
    if (hipMemsetAsync((char*)d_ws + WS_CTL, 0, CTL_ZERO_BYTES, stream) != hipSuccess) return;
    Args a{};
    for (int i = 0; i < 17; ++i) a.in[i] = (const float*)d_in[i];
    a.out = (float*)d_out; a.ws = (unsigned char*)d_ws;
#if MK_N_LAUNCHES == 1
    a.ph_lo = 0; a.ph_hi = N_PHASES;
    hipLaunchKernelGGL(mega_fwd, dim3(grid), dim3(NWAVES * 64), LDS_BYTES, stream, a);
#else
    for (int p = 0; p < N_PHASES; ++p) { a.ph_lo = p; a.ph_hi = p + 1; hipLaunchKernelGGL(mega_fwd, dim3(grid), dim3(NWAVES * 64), LDS_BYTES, stream, a); }
#endif
}
```

```cpp
#include <hip/hip_runtime.h>
#include <cstdio>
#include <cstdint>
#include <hip/hip_bf16.h>
#include <cmath>

#ifndef MK_N_LAUNCHES
#define MK_N_LAUNCHES 1
#endif
#ifndef DENSE_FP8
#define DENSE_FP8 4
#endif
#ifndef P1_I8
#define P1_I8 1
#endif
#ifndef GATES_FP8
#define GATES_FP8 2
#endif
#ifndef NAIVE_FOX
#define NAIVE_FOX 0
#endif
#ifndef NAIVE_RET
#define NAIVE_RET 0
#endif
#ifndef NAIVE_GMLP
#define NAIVE_GMLP 0
#endif

namespace pg8 {
#define PG8_LAS __attribute__((address_space(3)))
typedef unsigned short bf16_t;
typedef short bf16x8 __attribute__((ext_vector_type(8)));
typedef float f32x4 __attribute__((ext_vector_type(4)));
typedef float f32x2 __attribute__((ext_vector_type(2)));
typedef unsigned u32x4 __attribute__((ext_vector_type(4)));
typedef unsigned u32x2 __attribute__((ext_vector_type(2)));
constexpr int BM = 256, BK = 64, HALF = 128, HTB = HALF * BK * 2  , STAGE_BYTES = 8 * HTB, NXCD = 8, WGM = 4;

__host__ __device__ __forceinline__ int lds_byte(int r, int c) { const int st = (r >> 4) * 2 + (c >> 5), rr = r & 15, cc = c & 31, ob = rr * 64 + cc * 2; return st * 1024 + (ob ^ (((ob >> 9) & 1) << 5)); }
__host__ __device__ __forceinline__ void stage_rc(int b, int& R, int& C) { const int st = b / 1024, sb = b % 1024, swz = sb ^ (((sb >> 9) & 1) << 5); R = (st >> 1) * 16 + swz / 64; C = (st & 1) * 32 + (swz % 64) / 2; }
__host__ __device__ __forceinline__ int perm32(int rho) { const int n = rho >> 4, i = rho & 15; return 8 * (i >> 2) + 4 * n + (i & 3); }

struct Unit { int pm, pn; };

struct TileOrder {
    int nM, nN, nwg, G, c;
    __device__ __forceinline__ void init(int nM_, int nN_, int G_, int c_) { nM = nM_; nN = nN_; nwg = nM * nN; G = G_; c = c_; }
    __device__ __forceinline__ bool next(int i, Unit& u) const {
        const long L = (long)i * G + c; if (L >= nwg) return false;
        int wgid = (int)L; { const int q = nwg / NXCD, r = nwg % NXCD, xcd = wgid % NXCD, off = wgid / NXCD; wgid = (xcd < r ? xcd * (q + 1) : r * (q + 1) + (xcd - r) * q) + off; }
        const int nig = WGM * nN, gid = wgid / nig, fm = gid * WGM, gsz = (nM - fm) < WGM ? (nM - fm) : WGM;
        u.pm = fm + ((wgid % nig) % gsz); u.pn = (wgid % nig) / gsz; return true;
    }
};
struct PlainSched : TileOrder {
    static constexpr bool GATHER = false;
    const bf16_t* A; const bf16_t* Bt; int K; int esz = 2;
    __device__ __forceinline__ const char* abase(const Unit& u) const { return (const char*)A + (size_t)u.pm * BM * K * esz; }
    __device__ __forceinline__ void aoffs_load(const Unit&, const int (&)[2], PG8_LAS unsigned*) const {}
    __device__ __forceinline__ void aoffs_fin(const Unit&, const int (&)[2], const int (&)[2], const PG8_LAS unsigned*, int, unsigned (&)[2][2]) const {}
    __device__ __forceinline__ void aoffs(const Unit&, const int (&R)[2], const int (&C)[2], unsigned (&o)[2][2]) const {
#pragma unroll
        for (int h = 0; h < 2; ++h)
#pragma unroll
            for (int i = 0; i < 2; ++i) o[h][i] = (unsigned)((R[i] + h * HALF) * K + C[i]) * 2u; }
    __device__ __forceinline__ const char* bbase(const Unit& u) const { return (const char*)Bt + (size_t)u.pn * BM * K * esz; }
};

typedef __bf16 bf16x2_v __attribute__((ext_vector_type(2)));
__device__ __forceinline__ unsigned cvt_pk_bf16(float lo, float hi) { f32x2 v = {lo, hi}; bf16x2_v b = __builtin_convertvector(v, bf16x2_v); return __builtin_bit_cast(unsigned, b); }

typedef float f32x2_pk __attribute__((ext_vector_type(2)));
__device__ __forceinline__ f32x4 zero4() { f32x2_pk lo, hi; asm volatile("v_pk_mov_b32 %0, 0, 0" : "=v"(lo)); asm volatile("v_pk_mov_b32 %0, 0, 0" : "=v"(hi)); return __builtin_shufflevector(lo, hi, 0, 1, 2, 3); }
typedef int v4i_t __attribute__((ext_vector_type(4)));
typedef int v8i_t __attribute__((ext_vector_type(8)));
__host__ __device__ __forceinline__ int lds_byte8(int r, int g) { const int st = (r >> 4) * 2 + (g >> 1), ob = (r & 15) * 64 + 32 * (g & 1); return st * 1024 + (ob ^ (((ob >> 9) & 1) << 5)); }
template <class Epi, class Sched, unsigned FP8S = 0u>
__device__ __forceinline__ void gemm_phase(PG8_LAS unsigned char* lds, const int K, const Sched& S, const Epi& E) {
    constexpr bool F8 = FP8S != 0u;
    constexpr bool I8 = FP8S == 1u;
    int tid_ = threadIdx.x; asm volatile("" : "+v"(tid_));
    const int tid = tid_, wid = __builtin_amdgcn_readfirstlane(tid >> 6), lane = tid & 63, wr = wid >> 2, wc = wid & 3, fr = lane & 15, fq = lane >> 4;
    const int nt = F8 ? K / 128 : K / BK;
    int Rs[2], Cs[2]; unsigned voffA[2], voffB[2];
#pragma unroll
    for (int i = 0; i < 2; ++i) { int R, C; stage_rc(tid * 16 + i * 8192, R, C); Rs[i] = R; Cs[i] = C; const int Rb = Epi::PERM ? ((R & ~31) + perm32(R & 31)) : R;
        voffA[i] = F8 ? (unsigned)(R * K + 2 * C) : (unsigned)(R * K + C) * 2u; voffB[i] = F8 ? (unsigned)(Rb * K + 2 * C) : (unsigned)(Rb * K + C) * 2u; }
    const size_t kstep = (size_t)(BK * 2);
    const size_t hstep = (size_t)HALF * K * (F8 ? 1 : 2);
    const unsigned ldsw = (unsigned)wid * 1024u;
    const int aoff = F8 ? lds_byte8(wr * 64 + fr, fq) : lds_byte(wr * 64 + fr, fq * 8), boff = F8 ? lds_byte8(wc * 32 + fr, fq) : lds_byte(wc * 32 + fr, fq * 8);
#define PG8_SA(b, h) (((b) * 2 + (h)) * HTB)
#define PG8_SB(b, h) ((4 + (b) * 2 + (h)) * HTB)
#define PG8_STAGE(bufoff, gbase, voff) do { _Pragma("unroll") for (int _i = 0; _i < 2; ++_i) \
        __builtin_amdgcn_global_load_lds((const unsigned*)((const char*)(gbase) + (voff)[_i]), (PG8_LAS unsigned*)(lds + (bufoff) + ldsw + _i * 8192), 16, 0, 0); } while (0)
#define PG8_STA(bufoff, gbase, h, nx) do { if constexpr (Sched::GATHER) { _Pragma("unroll") for (int _i = 0; _i < 2; ++_i) { const unsigned o_ = (nx) ? nof[h][_i] : cof[h][_i]; \
        __builtin_amdgcn_global_load_lds((const unsigned*)((const char*)(gbase) + o_), (PG8_LAS unsigned*)(lds + (bufoff) + ldsw + _i * 8192), 16, 0, 0); } } \
        else { PG8_STAGE(bufoff, (gbase) + (h) * hstep, voffA); } } while (0)
#define PG8_LDA(dst, b, h) do { _Pragma("unroll") for (int m = 0; m < 4; ++m) _Pragma("unroll") for (int k = 0; k < 2; ++k) dst[m][k] = *(const PG8_LAS bf16x8*)(lds + PG8_SA(b, h) + aoff + m * 2048 + k * 1024); } while (0)
#define PG8_LDB(dst, b, h) do { _Pragma("unroll") for (int n = 0; n < 2; ++n) _Pragma("unroll") for (int k = 0; k < 2; ++k) dst[n][k] = *(const PG8_LAS bf16x8*)(lds + PG8_SB(b, h) + boff + n * 2048 + k * 1024); } while (0)
#define PG8_MMA(ai, bj, At, Bt) do { __builtin_amdgcn_s_setprio(1); _Pragma("unroll") for (int m = 0; m < 4; ++m) _Pragma("unroll") for (int n = 0; n < 2; ++n) _Pragma("unroll") for (int k = 0; k < 2; ++k) \
        acc[ai][bj][m][n] = __builtin_amdgcn_mfma_f32_16x16x32_bf16(Bt[n][k], At[m][k], acc[ai][bj][m][n], 0, 0, 0); __builtin_amdgcn_s_setprio(0); } while (0)
#define PG8_LD32(p) __builtin_shufflevector(*(const PG8_LAS v4i_t*)(p), *(const PG8_LAS v4i_t*)((p) + 16), 0, 1, 2, 3, 4, 5, 6, 7)
#define PG8_LDA8(dst, b, h) do { _Pragma("unroll") for (int m = 0; m < 4; ++m) dst[m] = PG8_LD32(lds + PG8_SA(b, h) + aoff + m * 2048); } while (0)
#define PG8_LDB8(dst, b, h) do { _Pragma("unroll") for (int n = 0; n < 2; ++n) dst[n] = PG8_LD32(lds + PG8_SB(b, h) + boff + n * 2048); } while (0)
#define PG8_MMA8(ai, bj, At, Bt) do { __builtin_amdgcn_s_setprio(1); \
        if constexpr (I8) {   \
            _Pragma("unroll") for (int m = 0; m < 4; ++m) _Pragma("unroll") for (int n = 0; n < 2; ++n) \
                asm volatile("v_mfma_i32_16x16x64_i8 %0, %1, %2, %0" : "+v"(acc[ai][bj][m][n]) : "v"(__builtin_shufflevector(Bt[n], Bt[n], 0, 1, 2, 3)), "v"(__builtin_shufflevector(At[m], At[m], 0, 1, 2, 3))); \
            _Pragma("unroll") for (int m = 0; m < 4; ++m) _Pragma("unroll") for (int n = 0; n < 2; ++n) \
                asm volatile("v_mfma_i32_16x16x64_i8 %0, %1, %2, %0" : "+v"(acc[ai][bj][m][n]) : "v"(__builtin_shufflevector(Bt[n], Bt[n], 4, 5, 6, 7)), "v"(__builtin_shufflevector(At[m], At[m], 4, 5, 6, 7))); \
        } else { _Pragma("unroll") for (int m = 0; m < 4; ++m) _Pragma("unroll") for (int n = 0; n < 2; ++n) \
        asm volatile("v_mfma_scale_f32_16x16x128_f8f6f4 %0, %1, %2, %0, %3, %4 op_sel_hi:[0,0,0]" : "+v"(acc[ai][bj][m][n]) : "v"(Bt[n]), "v"(At[m]), "v"(scl_w), "v"(scl_1)); } __builtin_amdgcn_s_setprio(0); } while (0)
#define PG8_XLDA(b, h) do { if constexpr (F8) PG8_LDA8(At8, b, h); else PG8_LDA(At, b, h); } while (0)
#define PG8_XLDB0(b, h) do { if constexpr (F8) PG8_LDB8(B08, b, h); else PG8_LDB(B0, b, h); } while (0)
#define PG8_XLDB1(b, h) do { if constexpr (F8) PG8_LDB8(B18, b, h); else PG8_LDB(B1, b, h); } while (0)
#define PG8_XMMA0(ai, bj) do { if constexpr (F8) PG8_MMA8(ai, bj, At8, B08); else PG8_MMA(ai, bj, At, B0); } while (0)
#define PG8_XMMA1(ai, bj) do { if constexpr (F8) PG8_MMA8(ai, bj, At8, B18); else PG8_MMA(ai, bj, At, B1); } while (0)
#define PG8_WAIT_V(n) asm volatile("s_waitcnt vmcnt(" #n ")" ::: "memory")
#define PG8_WAIT_L(n) asm volatile("s_waitcnt lgkmcnt(" #n ")" ::: "memory")
#define PG8_BAR __builtin_amdgcn_s_barrier()
#define PG8_SCHED __builtin_amdgcn_sched_barrier(0)
    Unit cur, nxt; int ui = 0;
    if (!S.next(0, cur)) return;
    f32x4 acc[2][2][4][2];
#pragma unroll
    for (int a = 0; a < 2; ++a)
#pragma unroll
        for (int b = 0; b < 2; ++b)
#pragma unroll
            for (int m = 0; m < 4; ++m)
#pragma unroll
                for (int n = 0; n < 2; ++n) acc[a][b][m][n] = zero4();
    bf16x8 At[4][2], B0[2][2], B1[2][2]; v8i_t At8[4], B08[2], B18[2];
    int scl_w = (int)FP8S, scl_1 = 0x7f7f7f7f; if constexpr (F8) asm volatile("" : "+v"(scl_w), "+v"(scl_1));
    unsigned cof[2][2], nof[2][2];
    PG8_LAS unsigned* gscr = (PG8_LAS unsigned*)(lds + 8 * HTB + wid * 1024);
    const char* cA = S.abase(cur); if constexpr (Sched::GATHER) { S.aoffs_load(cur, Rs, gscr); asm volatile("s_waitcnt vmcnt(0)" ::: "memory"); S.aoffs_fin(cur, Rs, Cs, gscr, lane, cof); } const char* cB = S.bbase(cur);
    PG8_STAGE(PG8_SB(0, 0), cB, voffB); PG8_STAGE(PG8_SB(0, 1), cB + hstep, voffB); PG8_STA(PG8_SA(0, 0), cA, 0, false); PG8_STA(PG8_SA(0, 1), cA, 1, false);
    if (wr == 1) PG8_BAR;
    PG8_WAIT_V(2); PG8_BAR;
    PG8_STAGE(PG8_SB(1, 0), cB + kstep, voffB); PG8_STA(PG8_SA(1, 0), cA + kstep, 0, false); PG8_STAGE(PG8_SB(1, 1), cB + hstep + kstep, voffB);
    PG8_WAIT_V(6); PG8_BAR;
    for (;;) {
        const bool has_next = S.next(ui + 1, nxt);
        const char* nA = cA; const char* nB = cB;
        if constexpr (Sched::GATHER) {
#pragma unroll
            for (int h = 0; h < 2; ++h)
#pragma unroll
                for (int i = 0; i < 2; ++i) nof[h][i] = cof[h][i]; }
        if (has_next) { nA = S.abase(nxt); if constexpr (Sched::GATHER) S.aoffs_load(nxt, Rs, gscr); nB = S.bbase(nxt); }
#pragma unroll 1
        for (int t = 0; t < nt; t += 2) {
            const bool last = (t == nt - 2);
            const bool skipw = (t == 0) && (ui > 0) && !Sched::GATHER;
            if constexpr (Sched::GATHER) { if (last && has_next) S.aoffs_fin(nxt, Rs, Cs, gscr, lane, nof); }
            if constexpr (Epi::HOOK) { PG8_SCHED; E.khook(acc, cur, t, wr, wc, fr, fq); PG8_SCHED; }
            const char* a1 = cA + (size_t)(t + 1) * kstep;
            const char* a2 = last ? nA : cA + (size_t)(t + 2) * kstep; const char* b2 = last ? nB : cB + (size_t)(t + 2) * kstep;
            const char* a3 = a2 + kstep; const char* b3 = b2 + kstep;
            PG8_XLDB0(0, 0); PG8_XLDB1(0, 1); PG8_SCHED; PG8_XLDA(0, 0); PG8_STA(PG8_SA(1, 1), a1, 1, false);
            if (!skipw) PG8_WAIT_V(8);
            PG8_WAIT_L(0); PG8_BAR; PG8_XMMA0(0, 0); PG8_XMMA1(0, 1); PG8_BAR; PG8_SCHED;
            PG8_XLDA(0, 1); PG8_STAGE(PG8_SB(0, 0), b2, voffB); PG8_STAGE(PG8_SB(0, 1), b2 + hstep, voffB); PG8_STA(PG8_SA(0, 0), a2, 0, last);
            if (!skipw) PG8_WAIT_V(8);
            PG8_WAIT_L(0); PG8_BAR; PG8_XMMA0(1, 0); PG8_XMMA1(1, 1); PG8_BAR; PG8_SCHED;
            PG8_XLDB0(1, 0); PG8_XLDB1(1, 1); PG8_SCHED; PG8_XLDA(1, 0); PG8_STA(PG8_SA(0, 1), a2, 1, last);
            PG8_WAIT_V(8); PG8_WAIT_L(0); PG8_BAR; PG8_XMMA0(0, 0); PG8_XMMA1(0, 1); PG8_BAR; PG8_SCHED;
            PG8_XLDA(1, 1); PG8_STAGE(PG8_SB(1, 0), b3, voffB); PG8_STAGE(PG8_SB(1, 1), b3 + hstep, voffB); PG8_STA(PG8_SA(1, 0), a3, 0, last);
            PG8_WAIT_V(8); PG8_WAIT_L(0); PG8_BAR; PG8_XMMA0(1, 0); PG8_XMMA1(1, 1); PG8_BAR; PG8_SCHED;
        }
        if constexpr (!Sched::GATHER) PG8_WAIT_V(0);
        if constexpr (F8) {
            asm volatile("s_nop 15\n\ts_nop 15\n\ts_nop 15\n\ts_nop 15\n\ts_nop 15" ::: "memory");
#pragma unroll
            for (int a = 0; a < 2; ++a)
#pragma unroll
                for (int b = 0; b < 2; ++b)
#pragma unroll
                    for (int m = 0; m < 4; ++m) asm volatile("" : "+v"(acc[a][b][m][0]), "+v"(acc[a][b][m][1]));
        }
        if (wr == 0) PG8_BAR;
        E(acc, cur, wr, wc, fr, fq);
#ifdef EPI_DUP
        if (Epi::DUPME) { asm volatile("" ::: "memory"); E(acc, cur, wr, wc, fr, fq); }
#endif
        if (!has_next) break;
#pragma unroll
        for (int a = 0; a < 2; ++a)
#pragma unroll
            for (int b = 0; b < 2; ++b)
#pragma unroll
                for (int m = 0; m < 4; ++m)
#pragma unroll
                    for (int n = 0; n < 2; ++n) acc[a][b][m][n] = zero4();
        cur = nxt; cA = nA; cB = nB; ++ui;
        if constexpr (Sched::GATHER) {
#pragma unroll
            for (int h = 0; h < 2; ++h)
#pragma unroll
                for (int i = 0; i < 2; ++i) cof[h][i] = nof[h][i]; }
        if (wr == 1) PG8_BAR;
    }
    PG8_WAIT_V(0);
    PG8_BAR;
#undef PG8_SA
#undef PG8_SB
#undef PG8_STAGE
#undef PG8_STA
#undef PG8_LDA
#undef PG8_LDB
#undef PG8_MMA
#undef PG8_LD32
#undef PG8_LDA8
#undef PG8_LDB8
#undef PG8_MMA8
#undef PG8_XLDA
#undef PG8_XLDB0
#undef PG8_XLDB1
#undef PG8_XMMA0
#undef PG8_XMMA1
#undef PG8_WAIT_V
#undef PG8_WAIT_L
#undef PG8_BAR
#undef PG8_SCHED
}
}

namespace attn_body {
using bf16=__hip_bfloat16;
using bf16x8=__attribute__((ext_vector_type(8)))short;
using s16x4=__attribute__((ext_vector_type(4)))short;
using f32x16=__attribute__((ext_vector_type(16)))float;
using u32x4=__attribute__((ext_vector_type(4)))unsigned;
constexpr int BATCH=8,NHEAD=8,SEQ=2048,D=64,DM=NHEAD*D,PO=1536,OCOL=512;
constexpr int NW=8,QBLK=32,QB=QBLK*NW,KVBLK=64,NQB=SEQ/QB;
constexpr int ATTN_PITCH=DM, ATTN_UNIT_ROWS=QB;
__device__ __forceinline__ int crow(int r,int hi){return (r&3)+8*(r>>2)+4*hi;}
#define SBAR() __builtin_amdgcn_sched_barrier(0)
__device__ __forceinline__ void cmask(f32x16&p0,f32x16&p1,int jb,int qrel,int hi){
  const float NEG=-INFINITY; int kb=64*jb+4*hi;
  #pragma unroll
  for(int r=0;r<16;++r){int kv=kb+(r&3)+8*(r>>2); if(kv>qrel)p0[r]=NEG; if(kv+32>qrel)p1[r]=NEG;}
}

constexpr int NSLOT=3, SLOTB=8192;
constexpr int LDS_K=0, LDS_V=NSLOT*SLOTB, LDS_WS=2*NSLOT*SLOTB, LDS_OST=LDS_WS+NW*64*4, LDS_BYTES=LDS_OST+NW*4096;
constexpr float C2=0.125f*1.4426950408889634f;
__device__ __forceinline__ void glds16(const void*gsrc,unsigned lds_dst){unsigned keep;
  asm volatile("s_mov_b32 %0, m0\n\ts_mov_b32 m0, %2\n\ts_nop 0\n\tglobal_load_lds_dwordx4 %1, off\n\ts_mov_b32 m0, %0":"=&s"(keep):"v"(gsrc),"s"(lds_dst):"memory");}
__device__ __forceinline__ float max3f(float a,float b,float c){float r;asm("v_max3_f32 %0, %1, %2, %3":"=v"(r):"v"(a),"v"(b),"v"(c));return r;}
__device__ __forceinline__ float max2f(float a,float b){float r;asm("v_max_f32_e32 %0, %1, %2":"=v"(r):"v"(a),"v"(b));return r;}
__device__ __forceinline__ float fadd_s(float a,float b){float r;asm("v_add_f32_e32 %0, %1, %2":"=v"(r):"v"(a),"v"(b));return r;}
__device__ __forceinline__ float fsub_s(float a,float b){float r;asm("v_sub_f32_e32 %0, %1, %2":"=v"(r):"v"(a),"v"(b));return r;}
typedef float f32x2_t __attribute__((ext_vector_type(2))); typedef __bf16 bf16x2_t __attribute__((ext_vector_type(2)));
__device__ __forceinline__ unsigned cvtpk_s(float lo,float hi){f32x2_t v={lo,hi};bf16x2_t b=__builtin_convertvector(v,bf16x2_t);return __builtin_bit_cast(unsigned,b);}
#define WAIT_BAR(N) asm volatile("s_waitcnt vmcnt(" #N ") lgkmcnt(0)\n\ts_barrier":::"memory")

__device__ __forceinline__ void qkt(f32x16&p0,f32x16&p1,const char*Kslot,const bf16x8*qr,bf16x8 ka0,bf16x8 ka1,bf16x8 qaug,int r32,int hi){
  const char*kb=Kslot+hi*1024+r32*16;
  p0=__builtin_amdgcn_mfma_f32_32x32x16_bf16(ka0,qaug,f32x16{},0,0,0);p1=__builtin_amdgcn_mfma_f32_32x32x16_bf16(ka1,qaug,f32x16{},0,0,0);
  #pragma unroll
  for(int d0=0;d0<4;++d0){
    const bf16x8 b0=*reinterpret_cast<const bf16x8*>(kb+d0*2048);
    const bf16x8 b1=*reinterpret_cast<const bf16x8*>(kb+d0*2048+512);
    p0=__builtin_amdgcn_mfma_f32_32x32x16_bf16(b0,qr[d0],p0,0,0,0);p1=__builtin_amdgcn_mfma_f32_32x32x16_bf16(b1,qr[d0],p1,0,0,0);}
}
typedef __attribute__((address_space(3))) const char* lds_cptr;
typedef short v4i16_t __attribute__((ext_vector_type(4)));
__device__ __forceinline__ void kload8(bf16x8*kf,lds_cptr kp){
  kf[0]=*(const __attribute__((address_space(3))) bf16x8*)(kp);      kf[1]=*(const __attribute__((address_space(3))) bf16x8*)(kp+512);
  kf[2]=*(const __attribute__((address_space(3))) bf16x8*)(kp+2048); kf[3]=*(const __attribute__((address_space(3))) bf16x8*)(kp+2560);
  kf[4]=*(const __attribute__((address_space(3))) bf16x8*)(kp+4096); kf[5]=*(const __attribute__((address_space(3))) bf16x8*)(kp+4608);
  kf[6]=*(const __attribute__((address_space(3))) bf16x8*)(kp+6144); kf[7]=*(const __attribute__((address_space(3))) bf16x8*)(kp+6656);
}
__device__ __forceinline__ void kload2(bf16x8*kf,lds_cptr kp,int j){ kf[2*j]=*(const __attribute__((address_space(3))) bf16x8*)(kp+j*2048); kf[2*j+1]=*(const __attribute__((address_space(3))) bf16x8*)(kp+j*2048+512); }
__device__ __forceinline__ s16x4 vtr(lds_cptr p){ return __builtin_bit_cast(s16x4,__builtin_amdgcn_ds_read_tr16_b64_v4i16((__attribute__((address_space(3))) v4i16_t*)p)); }
__device__ __forceinline__ float rowmax(const f32x16&p0,const f32x16&p1){
  float a=max3f(p0[0],p0[1],p1[0]),b=max3f(p0[2],p0[3],p1[1]);a=max3f(a,p1[2],p1[3]);
  #pragma unroll
  for(int r=4;r<16;r+=4){a=max3f(a,p0[r],p0[r+1]);b=max3f(b,p0[r+2],p0[r+3]);a=max3f(a,p1[r],p1[r+1]);b=max3f(b,p1[r+2],p1[r+3]);}
  const float m=max2f(a,b);
  auto rr=__builtin_amdgcn_permlane32_swap(__float_as_uint(m),__float_as_uint(m),false,false);
  return max2f(__uint_as_float(rr[0]),__uint_as_float(rr[1]));
}
__device__ __forceinline__ void pv(f32x16*o,int vb,bf16x8 pa0,bf16x8 pa1,bf16x8 pa2,bf16x8 pa3){
  #pragma unroll
  for(int d0=0;d0<2;++d0){s16x4 lo[4],hi[4];
    #pragma unroll
    for(int ks=0;ks<4;++ks){
      asm volatile("ds_read_b64_tr_b16 %0,%1 offset:%c2":"=&v"(lo[ks]):"v"(vb),"i"(d0*4096+ks*1024):"memory");
      asm volatile("ds_read_b64_tr_b16 %0,%1 offset:%c2":"=&v"(hi[ks]):"v"(vb),"i"(d0*4096+ks*1024+512):"memory");}
    asm volatile("s_waitcnt lgkmcnt(0)":::"memory");SBAR();
    #define PK(k) (bf16x8){lo[k][0],lo[k][1],lo[k][2],lo[k][3],hi[k][0],hi[k][1],hi[k][2],hi[k][3]}
    o[d0]=__builtin_amdgcn_mfma_f32_32x32x16_bf16(pa0,PK(0),o[d0],0,0,0);
    o[d0]=__builtin_amdgcn_mfma_f32_32x32x16_bf16(pa1,PK(1),o[d0],0,0,0);
    o[d0]=__builtin_amdgcn_mfma_f32_32x32x16_bf16(pa2,PK(2),o[d0],0,0,0);
    o[d0]=__builtin_amdgcn_mfma_f32_32x32x16_bf16(pa3,PK(3),o[d0],0,0,0);
    #undef PK
  }
}

#ifndef ATTN_STORE16
#define ATTN_STORE16(p,v) (*(u32x4*)(p)=(v))
#endif
typedef __attribute__((address_space(3))) const u32x4* lds_tabptr;
__device__ __forceinline__ bf16x8 make_qaug(float mhat,int hi){
  const float nm=-mhat; const unsigned h=cvtpk_s(nm,0.f)&0xffffu; const float r1=nm-__uint_as_float(h<<16);
  const unsigned m=cvtpk_s(r1,0.f)&0xffffu; const float r2=r1-__uint_as_float(m<<16); const unsigned l=cvtpk_s(r2,0.f)&0xffffu;
  u32x4 w; w.x=hi?0u:0x3F803F80u; w.y=hi?0u:(0x3F80u|(h<<16)); w.z=hi?0u:(m|(l<<16)); w.w=0u; return __builtin_bit_cast(bf16x8,w);
}
template<int THRL> __device__ __forceinline__ void attn_unit(int b,int h,int qb,const bf16*Q,const bf16*__restrict__ K,const bf16*__restrict__ V,bf16*O,char*shm,lds_tabptr tab){
  int tid_=threadIdx.x; asm volatile("":"+v"(tid_));
  const int tid=tid_,lane=tid&63,r32=lane&31,hi=lane>>5; const int wid=__builtin_amdgcn_readfirstlane(tid>>6);
  const long rowbase=(long)b*SEQ; const int q0=qb*QB;
  const bf16*Qw=Q+(rowbase+q0+wid*QBLK)*DM+h*D;
  const bf16*Kh=K+rowbase*DM+h*D,*Vh=V+rowbase*DM+h*D;
  const unsigned lds0=(unsigned)(uintptr_t)shm;
  float*wsf=(float*)(shm+LDS_WS)+wid*64;
  const bf16*ksrc=Kh+(long)lane*DM+wid*8;
  const bf16*vsrc=Vh+(long)(16*(wid&3)+(lane>>2))*DM+(wid>>2)*32+(lane&3)*8;
  const unsigned kdst=lds0+LDS_K+wid*1024, vdst=lds0+LDS_V+wid*1024;
  #define DMA_K(t,slot) glds16(ksrc+(long)(t)*KVBLK*DM,(unsigned)__builtin_amdgcn_readfirstlane(kdst+(slot)))
  #define DMA_V(t,slot) glds16(vsrc+(long)(t)*KVBLK*DM,(unsigned)__builtin_amdgcn_readfirstlane(vdst+(slot)))
  const int vb0=(int)(lds0+LDS_V)+((lane>>4)&1)*32+(lane&3)*8+(4*hi+((lane&15)>>2))*64;
  const char*Kbase=shm+LDS_K; bf16x8 kf[8];
  const lds_cptr shm3=(lds_cptr)shm; const lds_cptr kp0=shm3+LDS_K+hi*1024+r32*16; const lds_cptr vp0=shm3+LDS_V+((lane>>4)&1)*32+(lane&3)*8+(4*hi+((lane&15)>>2))*64;
  const int NT=(q0+QB)/KVBLK;
  DMA_K(0,0);DMA_V(0,0);DMA_K(1,SLOTB);
  bf16x8 qr[4];
  #pragma unroll
  for(int d0=0;d0<4;++d0)qr[d0]=*reinterpret_cast<const bf16x8*>(&Qw[(long)r32*DM+d0*16+hi*8]);
  float mhat=0.f,l_reg=0.f;f32x16 o[2];o[0]=f32x16{};o[1]=f32x16{};bf16x8 qaug=make_qaug(0.f,hi);asm volatile("":"+v"(qaug));
  const int qrel=wid*QBLK+r32;
  #define CMASK(P0,P1,t) do{int jb_=(t)-(NT-4); if(jb_>=0)cmask(P0,P1,jb_,qrel,hi);}while(0)
  bool resc=false;
  #define START(P0,P1) do{ const float rm=rowmax(P0,P1); resc=false; \
    { const float dl=rm; mhat=fadd_s(mhat,dl); \
      _Pragma("unroll") for(int r=0;r<16;++r){P0[r]=fsub_s(P0[r],dl);P1[r]=fsub_s(P1[r],dl);} \
      qaug=make_qaug(mhat,hi); asm volatile("":"+v"(qaug)); } \
    _Pragma("unroll") for(int r=0;r<16;++r)P0[r]=__builtin_amdgcn_exp2f(P0[r]); }while(0)
  #define RESC() do{ if(resc){ asm volatile("s_waitcnt lgkmcnt(0)":::"memory"); \
      _Pragma("unroll") for(int d_=0;d_<2;++d_) _Pragma("unroll") for(int r=0;r<16;++r)o[d_][r]*=wsf[crow(r,hi)]; } }while(0)
  f32x16 pA0,pA1,pB0,pB1;
  int sl_prev=0,sl_cur=0,sl_next=SLOTB;
  #define ROT() do{sl_prev=sl_cur;sl_cur=sl_next;sl_next=(sl_next==(NSLOT-1)*SLOTB)?0:sl_next+SLOTB;}while(0)
  DMA_K(2,2*SLOTB);
  WAIT_BAR(3);
  qkt(pA0,pA1,Kbase,qr,__builtin_bit_cast(bf16x8,tab[r32]),__builtin_bit_cast(bf16x8,tab[32+r32]),qaug,r32,hi);asm volatile("s_nop 15\n\ts_nop 7":"+v"(pA0),"+v"(pA1));CMASK(pA0,pA1,0);
  START(pA0,pA1);
  _Pragma("unroll") for(int r=0;r<16;++r)pA1[r]=__builtin_amdgcn_exp2f(pA1[r]);
  WAIT_BAR(0);
  DMA_K(3,0);DMA_V(1,SLOTB);
  ROT();
  kload8(kf,kp0+sl_cur);
  WAIT_BAR(2);
  s16x4 vlo[8],vhi[8]; u32x4 pw0,pw1,pw2,pw3;
  #define PKW(P,B) cvtpk_s(P[B],P[B+1])
  #define PAF(k) __builtin_bit_cast(bf16x8,pw##k)
  #define VFR(i) (bf16x8){vlo[i][0],vlo[i][1],vlo[i][2],vlo[i][3],vhi[i][0],vhi[i][1],vhi[i][2],vhi[i][3]}
  #define PIN(x) asm volatile("":"+v"(x))
  #define MX3(a,b,c) __builtin_fmaxf(__builtin_fmaxf((a),(b)),(c))
  #define GAPA(MF,A0,A1,A2,A3,W0,W1,PW) do{ MF; sacc+=A0; sacc+=A1; sacc+=A2; sacc+=A3; PIN(sacc); W0; W1; PIN(PW); SBAR(); }while(0)
  #define EX(v) __builtin_amdgcn_exp2f(v)
  #define GAPB(MF,X,B) do{ MF; X[B]=EX(X[B]); X[B+1]=EX(X[B+1]); X[B+2]=EX(X[B+2]); X[B+3]=EX(X[B+3]); PIN(X); SBAR(); }while(0)
  #define VRD(i) do{ vlo[i]=vtr(vp_+(((i)>>2)*4096+((i)&3)*1024)); vhi[i]=vtr(vp_+(((i)>>2)*4096+((i)&3)*1024+512)); }while(0)
  #define KRD(G,j) do{ if(G){ kload2(kf,kp0+sl_next,j); SBAR(); } }while(0)
  #define STEP(C0,C1,P0,P1,t,GK,GV,GL) do{ SBAR(); \
    const lds_cptr vp_=vp0+sl_prev; \
    const bf16x8 ka0_=__builtin_bit_cast(bf16x8,tab[64*(t)+r32]), ka1_=__builtin_bit_cast(bf16x8,tab[64*(t)+32+r32]); \
    VRD(0); SBAR(); float sacc=(P0[0]+P0[1]); \
    GAPA(C0=__builtin_amdgcn_mfma_f32_32x32x16_bf16(kf[0],qr[0],f32x16{},0,0,0), P0[2],P0[3],P0[4],P0[5],     pw0[0]=PKW(P0,0), pw0[1]=PKW(P0,2), pw0); \
    VRD(4); SBAR(); GAPA(C1=__builtin_amdgcn_mfma_f32_32x32x16_bf16(kf[1],qr[0],f32x16{},0,0,0), P0[6],P0[7],P0[8],P0[9],     pw0[2]=PKW(P0,4), pw0[3]=PKW(P0,6), pw0); \
    VRD(1); SBAR(); GAPA(C0=__builtin_amdgcn_mfma_f32_32x32x16_bf16(kf[2],qr[1],C0,0,0,0),   P0[10],P0[11],P0[12],P0[13], pw1[0]=PKW(P0,8), pw1[1]=PKW(P0,10), pw1); \
    VRD(5); SBAR(); GAPA(C1=__builtin_amdgcn_mfma_f32_32x32x16_bf16(kf[3],qr[1],C1,0,0,0),   P0[14],P0[15],P1[0],P1[1],   pw1[2]=PKW(P0,12),pw1[3]=PKW(P0,14), pw1); \
    VRD(2); SBAR(); GAPA(C0=__builtin_amdgcn_mfma_f32_32x32x16_bf16(kf[4],qr[2],C0,0,0,0),   P1[2],P1[3],P1[4],P1[5],     pw2[0]=PKW(P1,0), pw2[1]=PKW(P1,2), pw2); \
    VRD(6); SBAR(); GAPA(C1=__builtin_amdgcn_mfma_f32_32x32x16_bf16(kf[5],qr[2],C1,0,0,0),   P1[6],P1[7],P1[8],P1[9],     pw2[2]=PKW(P1,4), pw2[3]=PKW(P1,6), pw2); \
    VRD(3); SBAR(); GAPA(C0=__builtin_amdgcn_mfma_f32_32x32x16_bf16(kf[6],qr[3],C0,0,0,0),   P1[10],P1[11],P1[12],P1[13], pw3[0]=PKW(P1,8), pw3[1]=PKW(P1,10), pw3); \
    VRD(7); SBAR(); GAPA(C1=__builtin_amdgcn_mfma_f32_32x32x16_bf16(kf[7],qr[3],C1,0,0,0),   P1[14],P1[15],0.f,0.f,       pw3[2]=PKW(P1,12),pw3[3]=PKW(P1,14), pw3); \
    C0=__builtin_amdgcn_mfma_f32_32x32x16_bf16(ka0_,qaug,C0,0,0,0); C1=__builtin_amdgcn_mfma_f32_32x32x16_bf16(ka1_,qaug,C1,0,0,0); SBAR(); \
    l_reg+=sacc; \
    if(GK){DMA_K((t)+3,sl_cur);} if(GV){DMA_V((t)+1,sl_next);} \
    CMASK(C0,C1,t); \
    { float a=MX3(C0[0],C0[1],C1[0]),b=MX3(C0[2],C0[3],C1[1]); a=MX3(a,C1[2],C1[3]); \
      _Pragma("unroll") for(int r=4;r<16;r+=4){a=MX3(a,C0[r],C0[r+1]);b=MX3(b,C0[r+2],C0[r+3]);a=MX3(a,C1[r],C1[r+1]);b=MX3(b,C1[r+2],C1[r+3]);} \
      float rm=__builtin_fmaxf(a,b); { auto rr=__builtin_amdgcn_permlane32_swap(__float_as_uint(rm),__float_as_uint(rm),false,false); rm=__builtin_fmaxf(__uint_as_float(rr[0]),__uint_as_float(rr[1])); } \
      resc=false; \
      if(__builtin_expect(__any(rm>(float)THRL),0)){ const float dl=__builtin_fmaxf(rm,0.f); mhat+=dl; \
        _Pragma("unroll") for(int r=0;r<16;++r){C0[r]-=dl;C1[r]-=dl;} \
        qaug=make_qaug(mhat,hi); asm volatile("":"+v"(qaug)); \
        const float f=__builtin_amdgcn_exp2f(-dl); l_reg*=f; if(hi==0)wsf[r32]=f; resc=true; } } \
    SBAR(); \
    GAPB(o[0]=__builtin_amdgcn_mfma_f32_32x32x16_bf16(PAF(0),VFR(0),o[0],0,0,0), C0,0); \
    GAPB(o[1]=__builtin_amdgcn_mfma_f32_32x32x16_bf16(PAF(0),VFR(4),o[1],0,0,0), C0,4); \
    KRD(GL,0); GAPB(o[0]=__builtin_amdgcn_mfma_f32_32x32x16_bf16(PAF(1),VFR(1),o[0],0,0,0), C0,8); \
    KRD(GL,1); GAPB(o[1]=__builtin_amdgcn_mfma_f32_32x32x16_bf16(PAF(1),VFR(5),o[1],0,0,0), C0,12); \
    KRD(GL,2); GAPB(o[0]=__builtin_amdgcn_mfma_f32_32x32x16_bf16(PAF(2),VFR(2),o[0],0,0,0), C1,0); \
    KRD(GL,3); GAPB(o[1]=__builtin_amdgcn_mfma_f32_32x32x16_bf16(PAF(2),VFR(6),o[1],0,0,0), C1,4); \
    GAPB(o[0]=__builtin_amdgcn_mfma_f32_32x32x16_bf16(PAF(3),VFR(3),o[0],0,0,0), C1,8); \
    GAPB(o[1]=__builtin_amdgcn_mfma_f32_32x32x16_bf16(PAF(3),VFR(7),o[1],0,0,0), C1,12); \
    }while(0)
  int t=1;
  #undef CMASK
  #define CMASK(P0,P1,t) do{}while(0)
  for(;t+5<NT;t+=2){
    STEP(pB0,pB1,pA0,pA1,t,true,true,true);     WAIT_BAR(2); RESC(); ROT();
    STEP(pA0,pA1,pB0,pB1,t+1,true,true,true);   WAIT_BAR(2); RESC(); ROT();
  }
  #undef CMASK
  #define CMASK(P0,P1,t) do{int jb_=(t)-(NT-4); if(jb_>=0)cmask(P0,P1,jb_,qrel,hi);}while(0)
  #define ENDW(tt) do{ if((tt)+3<NT){WAIT_BAR(2);} else if((tt)+2<NT){WAIT_BAR(1);} else {WAIT_BAR(0);} }while(0)
  for(;t+1<NT;t+=2){
    STEP(pB0,pB1,pA0,pA1,t,(t+3<NT),(t+1<NT),(t+1<NT));       ENDW(t);   RESC(); ROT();
    STEP(pA0,pA1,pB0,pB1,t+1,(t+4<NT),(t+2<NT),(t+2<NT));     ENDW(t+1); RESC(); ROT();
  }
  STEP(pB0,pB1,pA0,pA1,NT-1,false,false,false); RESC();
  { float sacc=pB0[0]+pB0[1]; _Pragma("unroll") for(int r=2;r<16;++r)sacc+=pB0[r]; _Pragma("unroll") for(int r=0;r<16;++r)sacc+=pB1[r]; l_reg+=sacc;
    pw0=(u32x4){PKW(pB0,0),PKW(pB0,2),PKW(pB0,4),PKW(pB0,6)};pw1=(u32x4){PKW(pB0,8),PKW(pB0,10),PKW(pB0,12),PKW(pB0,14)};pw2=(u32x4){PKW(pB1,0),PKW(pB1,2),PKW(pB1,4),PKW(pB1,6)};pw3=(u32x4){PKW(pB1,8),PKW(pB1,10),PKW(pB1,12),PKW(pB1,14)};
    SBAR(); pv(o,vb0+sl_cur,PAF(0),PAF(1),PAF(2),PAF(3)); }
  #undef PKW
  #undef PAF
  #undef VFR
  #undef PIN
  #undef MX3
  #undef GAPA
  #undef GAPB
  #undef EX
  #undef VRD
  #undef KRD
  #undef STEP
  #undef ENDW
  {auto rr=__builtin_amdgcn_permlane32_swap(__float_as_uint(l_reg),__float_as_uint(l_reg),false,false);l_reg=__uint_as_float(rr[0])+__uint_as_float(rr[1]);}
  if(hi==0)wsf[32+r32]=l_reg;asm volatile("s_waitcnt lgkmcnt(0)":::"memory");
  float rli[16];
  #pragma unroll
  for(int r=0;r<16;++r)rli[r]=__builtin_amdgcn_rcpf(wsf[32+crow(r,hi)]);
  bf16*Ow=O+(rowbase+q0+wid*QBLK)*PO+OCOL+h*D;
  { bf16*stg=(bf16*)(shm+LDS_OST)+wid*2048;
    #pragma unroll
    for(int r=0;r<16;++r){const int orow=crow(r,hi);
      #pragma unroll
      for(int d0=0;d0<2;++d0)stg[orow*64+d0*32+r32]=__float2bfloat16(o[d0][r]*rli[r]);}
    asm volatile("s_waitcnt lgkmcnt(0)":::"memory");
    #pragma unroll
    for(int i=0;i<4;++i){const int row=i*8+(lane>>3),ch=lane&7; const u32x4 v=*(const u32x4*)(stg+row*64+ch*8); ATTN_STORE16(Ow+(long)row*PO+ch*8,v);} }
  asm volatile("s_waitcnt lgkmcnt(0)\n\ts_barrier":::"memory");
  #undef DMA_K
  #undef DMA_V
  #undef CMASK
  #undef START
  #undef RESC
  #undef ROT
}
constexpr int ATTN_LDS_BYTES=LDS_BYTES;
#undef SBAR
#undef WAIT_BAR
}
constexpr int NWAVES = 8;
constexpr int D = 1024, BATCH = 8, SEQ = 2048, M = BATCH * SEQ;
constexpr int N_INSRC = 7176, N_INV = 7168;
constexpr int FL_COL = 3072;
constexpr int DFF_D = 2816, DFF_E = 3584, NEXP = 8;
constexpr float LN_EPS = 1e-5f, GN_EPS = 1e-6f;
constexpr float ALPHA = 1.4142135623730951f;
constexpr float LOG2E = 1.4426950408889634f;
constexpr float C2 = 0.125f * LOG2E;

constexpr size_t MiB = 1u << 20;
constexpr size_t WS_CTL = 0, CTL_ZERO_BYTES = 192 * 1024;
constexpr size_t WS_CS = 1 * MiB;
constexpr size_t WS_LIST = 2 * MiB;
constexpr size_t WS_GATEW = 2 * MiB + 512 * 1024;
constexpr size_t WS_LOGF = 3 * MiB;
constexpr size_t WS_GST = 3 * MiB + 512 * 1024;
constexpr size_t WS_WIN = 4 * MiB;
constexpr size_t WS_WBR = 32 * MiB;
constexpr size_t WS_WOUT = 38 * MiB;
constexpr size_t WS_WDU = 42 * MiB;
constexpr size_t WS_WDD = 53 * MiB;
constexpr size_t WS_WMU = 59 * MiB;
constexpr size_t WS_WMD = 171 * MiB;
constexpr size_t WS_XB = 227 * MiB;
constexpr size_t WS_XF = 259 * MiB;
constexpr size_t WS_YPRE = 323 * MiB;
constexpr size_t WS_C1 = 387 * MiB;
constexpr size_t WS_MRG = 451 * MiB;
constexpr size_t WS_RQ = 483 * MiB, WS_RK = 491 * MiB, WS_RV = 499 * MiB, WS_RG = 515 * MiB, WS_FQ = 531 * MiB, WS_FK = 547 * MiB, WS_FV = 563 * MiB,
                 WS_GU = 579 * MiB, WS_GV = 595 * MiB, WS_GT = 611 * MiB, WS_YB = 707 * MiB, WS_KV = 755 * MiB  , WS_X8IN = 771 * MiB  , WS_WIN8 = 787 * MiB  , WS_END = 793 * MiB;
constexpr size_t WS_HID = 483 * MiB;
static_assert((size_t)34816 * DFF_E <= WS_KV - WS_HID, "MoE hidden fits its overlay");
constexpr int CW_TMO = 0, CW_CODE = 1;
constexpr int CW_CNT = 64;
constexpr int CW_BAR = 4096;

constexpr int RING_OFF = 0, RING_BYTES = 141312;
constexpr int LDSCTL_OFF = RING_BYTES, MISC_OFF = LDSCTL_OFF + 320, PTAB_OFF = LDSCTL_OFF + 1024;
constexpr int LDS_BYTES = 147456;
static_assert(MISC_OFF + 128 <= PTAB_OFF && PTAB_OFF + 20 * 8 <= LDS_BYTES, "LDS map");

#define GAS __attribute__((address_space(1)))
#define LAS __attribute__((address_space(3)))
typedef unsigned short bf16;
typedef unsigned v4u __attribute__((ext_vector_type(4)));
typedef unsigned v2u __attribute__((ext_vector_type(2)));
typedef float f32x4 __attribute__((ext_vector_type(4)));
typedef GAS unsigned gu32;
#define RLX_AGENT __ATOMIC_RELAXED, __HIP_MEMORY_SCOPE_AGENT
#define LDS_WAIT() asm volatile("s_waitcnt lgkmcnt(0)" ::: "memory")
#define VM_WAIT() asm volatile("s_waitcnt vmcnt(0)" ::: "memory")
__device__ __forceinline__ unsigned f2bf(float f) { unsigned u = __builtin_bit_cast(unsigned, f); return (u + 0x7fffu + ((u >> 16) & 1u)) >> 16; }
__device__ __forceinline__ unsigned pk2(float lo, float hi) { return f2bf(lo) | (f2bf(hi) << 16); }
__device__ __forceinline__ float bf2f(unsigned short h) { return __builtin_bit_cast(float, (unsigned)h << 16); }
__device__ __forceinline__ float bflo(unsigned w) { return __builtin_bit_cast(float, w << 16); }
__device__ __forceinline__ float bfhi(unsigned w) { return __builtin_bit_cast(float, w & 0xffff0000u); }
constexpr float SC_X8 = 16.f, SC_WU8 = 32.f, SC_H8 = 8.f, SC_WD8 = 128.f;
constexpr float SWI_A = 1.4426950408889634f, SWI_B = SC_H8 / 1.4426950408889634f;
constexpr unsigned E8_UP = 0x76767676u  , E8_DN = 0x75757575u  ;
__device__ __forceinline__ float clamp448(float x) { return fminf(fmaxf(x, -448.f), 448.f); }
__device__ __forceinline__ unsigned pk4_fp8(float a, float b, float c, float d) {
    int w = __builtin_amdgcn_cvt_pk_fp8_f32(clamp448(a), clamp448(b), 0, false); w = __builtin_amdgcn_cvt_pk_fp8_f32(clamp448(c), clamp448(d), w, true); return (unsigned)w; }
constexpr float SC_XI8 = 20.f, SC_WI8 = 127.f * 32.f / 5.f;
__device__ __forceinline__ unsigned pk4_i8(float a, float b, float c, float d) {
    unsigned w = 0u;
    w = __builtin_amdgcn_cvt_pk_u8_f32(__builtin_rintf(a) + 128.f, 0u, w); w = __builtin_amdgcn_cvt_pk_u8_f32(__builtin_rintf(b) + 128.f, 1u, w);
    w = __builtin_amdgcn_cvt_pk_u8_f32(__builtin_rintf(c) + 128.f, 2u, w); w = __builtin_amdgcn_cvt_pk_u8_f32(__builtin_rintf(d) + 128.f, 3u, w);
    return w ^ 0x80808080u; }
__device__ __forceinline__ float fsigmoid(float x) { return __builtin_amdgcn_rcpf(1.0f + __builtin_amdgcn_exp2f(-x * LOG2E)); }
__device__ __forceinline__ float fsilu(float x) { return x * fsigmoid(x); }
typedef float f2v __attribute__((ext_vector_type(2)));
__device__ __forceinline__ f2v fsigmoid2(f2v x) { const f2v t = x * (-LOG2E); f2v e; e.x = __builtin_amdgcn_exp2f(t.x); e.y = __builtin_amdgcn_exp2f(t.y); const f2v d = e + 1.0f; f2v r; r.x = __builtin_amdgcn_rcpf(d.x); r.y = __builtin_amdgcn_rcpf(d.y); return r; }
__device__ __forceinline__ f2v fsilu2(f2v x) { return x * fsigmoid2(x); }
__device__ __forceinline__ f2v swi_folded2(f2v a, f2v b) { f2v e; e.x = __builtin_amdgcn_exp2f(-a.x); e.y = __builtin_amdgcn_exp2f(-a.y); const f2v d = e + 1.0f; f2v r; r.x = __builtin_amdgcn_rcpf(d.x); r.y = __builtin_amdgcn_rcpf(d.y); return (a * b) * r; }
__device__ __forceinline__ f2v fgelu_tanh2(f2v x) {
    const f2v t = x * (x * x * (-0.0713548163f * LOG2E) + (-1.5957691216f * LOG2E)); f2v e; e.x = __builtin_amdgcn_exp2f(t.x); e.y = __builtin_amdgcn_exp2f(t.y);
    const f2v d = e + 1.0f; f2v r; r.x = __builtin_amdgcn_rcpf(d.x); r.y = __builtin_amdgcn_rcpf(d.y); return x * r; }
__device__ __forceinline__ float fgelu_tanh(float x) { const float u = 0.7978845608028654f * (x + 0.044715f * x * x * x); return x * fsigmoid(2.0f * u); }

#define XB_TMO      128
#define XB_XCNT(j)  (256  + 64 * (j))
#define XB_XSUB(j)  (1280 + 64 * (j))
#define XB_XGEN(j)  (2304 + 64 * (j))
#define XB_TOP      3328
#define XB_TOPGEN   3392
#define XCD_BAR_WORDS 3456
#define XB_SPIN_CAP (1u << 18)
__device__ __forceinline__ unsigned xb_ld(unsigned* p)              { return __hip_atomic_load(p, __ATOMIC_RELAXED, __HIP_MEMORY_SCOPE_AGENT); }
__device__ __forceinline__ unsigned xb_add(unsigned* p, unsigned v) { return __hip_atomic_fetch_add(p, v, __ATOMIC_RELAXED, __HIP_MEMORY_SCOPE_AGENT); }
__device__ __forceinline__ unsigned xb_xcc_id() { return (unsigned)__builtin_amdgcn_s_getreg((3 << 11) | 20) & 0xFu; }
#define XB_SPIN(cond, bar) do { unsigned _sp = 0; while (cond) { __builtin_amdgcn_s_sleep(1); \
    if ((++_sp & 255u) == 0u) { if (xb_ld(&(bar)[XB_TMO])) break; if (_sp > XB_SPIN_CAP) { atomicAdd(&(bar)[XB_TMO], 1u); break; } } } } while (0)
struct XcdBarrier { unsigned* bar; unsigned x; volatile LAS unsigned* st; unsigned total; unsigned lite; };
__device__ __forceinline__ XcdBarrier xcd_barrier_post(unsigned* bar, volatile LAS unsigned* st, unsigned total, unsigned lite) {
    XcdBarrier b; b.bar = bar; b.x = xb_xcc_id(); b.st = st; b.total = total; b.lite = lite;
    if (threadIdx.x == 0) (void)xb_add(&bar[XB_XCNT(b.x)], 1u);
    return b;
}
__device__ __forceinline__ void xcd_barrier_complete(unsigned* bar, unsigned x, unsigned G, unsigned& nloc, unsigned& nx) {
    unsigned sum, cnt, mine, sp = 0u;
    for (;;) {
        sum = 0u; cnt = 0u; mine = 0u;
#pragma unroll
        for (unsigned j = 0; j < 16; ++j) { const unsigned c = xb_ld(&bar[XB_XCNT(j)]); sum += c; cnt += (c > 0u) ? 1u : 0u; mine = (j == x) ? c : mine; }
        if (sum == G) break;
        __builtin_amdgcn_s_sleep(1);
        if ((++sp & 255u) == 0u) { if (xb_ld(&bar[XB_TMO])) break; if (sp > XB_SPIN_CAP) { atomicAdd(&bar[XB_TMO], 1u); break; } }
    }
    nloc = mine > 0u ? mine : 1u; nx = cnt > 0u ? cnt : 1u;
}
__device__ __forceinline__ void xcd_barrier(const XcdBarrier& b) {
    asm volatile("s_waitcnt vmcnt(0)" ::: "memory");
    __syncthreads();
    if (threadIdx.x == 0) {
        unsigned* bar = b.bar;
        __builtin_amdgcn_s_waitcnt(0);
        unsigned nloc = b.st[0], nx = b.st[1];
        if (nloc == 0u) { xcd_barrier_complete(bar, b.x, b.total, nloc, nx); b.st[0] = nloc; b.st[1] = nx; }
        const unsigned old = xb_add(&bar[XB_XSUB(b.x)], 1u);
        const unsigned gen = old / nloc;
        if (old + 1u == (gen + 1u) * nloc) {
            if (!(b.lite != 0u && nx == 1u)) {
                __builtin_amdgcn_fence(__ATOMIC_RELEASE, "agent");
                asm volatile("s_waitcnt vmcnt(0)" ::: "memory");
            }
            if (nx != 1u) {
                const unsigned og = xb_add(&bar[XB_TOP], 1u);
                const unsigned tg = og / nx;
                if (og + 1u == (tg + 1u) * nx) xb_add(&bar[XB_TOPGEN], 1u);
                else XB_SPIN(xb_ld(&bar[XB_TOPGEN]) == tg, bar);
            }
            __builtin_amdgcn_fence(__ATOMIC_ACQUIRE, "agent");
            xb_add(&bar[XB_XGEN(b.x)], 1u);
            asm volatile("s_waitcnt vmcnt(0)" ::: "memory");
        } else {
            XB_SPIN(xb_ld(&bar[XB_XGEN(b.x)]) == gen, bar);
            __builtin_amdgcn_fence(__ATOMIC_ACQUIRE, "agent");
            asm volatile("s_waitcnt vmcnt(0)" ::: "memory");
        }
    }
    __syncthreads();
}

using pg8::Unit; using pg8::bf16_t;
#define ACC_T const pg8::f32x4 (&acc)[2][2][4][2]

struct ProjSched : pg8::PlainSched {
    __device__ __forceinline__ bool next(int i, Unit& u) const { if (!pg8::PlainSched::next(i, u)) return false; if (nN == 16 && ((u.pm >> 2) & 1)) u.pn = (u.pn + 4) & 15; return true; }
};
typedef int i32x4_t __attribute__((ext_vector_type(4)));
template <bool I8IN> __device__ __forceinline__ pg8::f32x4 ldacc(const pg8::f32x4& r) {
    if constexpr (I8IN) return __builtin_convertvector(__builtin_bit_cast(i32x4_t, r), pg8::f32x4) * (1.0f / (SC_XI8 * SC_WI8)); else return r; }
template <bool I8IN>
struct EpiProjT {
    static constexpr bool PERM = true, HOOK = false, DUPME = true;
    unsigned char* ws; const float* gate_b; const float* cs;
    __device__ __forceinline__ void operator()(ACC_T, const Unit& u, int wr, int wc, int fr, int fq) const {
        const int pn = u.pn, row0 = u.pm * 256 + wr * 64 + fr, lc = wc * 32 + 8 * fq;
        if (pn < 2) {
            bf16_t* dst = (bf16_t*)(ws + (pn == 0 ? WS_RQ : WS_RK)); const float sc = pn == 0 ? 1.0f : 0.125f;
            const int d1 = 16 * (wc & 1) + 4 * fq;
#pragma unroll
            for (int ai = 0; ai < 2; ++ai)
#pragma unroll
                for (int m = 0; m < 4; ++m) { const int row = row0 + ai * 128 + m * 16, pos = row & (SEQ - 1);
                    const f32x4 c4 = *(const f32x4*)(cs + pos * 32 + d1), s4 = *(const f32x4*)(cs + 65536 + pos * 32 + d1);
#pragma unroll
                    for (int bj = 0; bj < 2; ++bj) { const int head = bj * 2 + (wc >> 1); const f32x4 x1 = ldacc<I8IN>(acc[ai][bj][m][0]), x2 = ldacc<I8IN>(acc[ai][bj][m][1]);
                        const f32x4 o1 = (x1 * c4 - x2 * s4) * sc, o2 = (x1 * s4 + x2 * c4) * sc;
                        bf16_t* p = dst + (size_t)row * 256 + head * 64 + d1;
                        v2u w1, w2; w1.x = pg8::cvt_pk_bf16(o1[0], o1[1]); w1.y = pg8::cvt_pk_bf16(o1[2], o1[3]); w2.x = pg8::cvt_pk_bf16(o2[0], o2[1]); w2.y = pg8::cvt_pk_bf16(o2[2], o2[3]);
                        *(v2u*)p = w1; *(v2u*)(p + 32) = w2; } }
            return;
        }
        if (pn < 4) store_act<0>(acc, WS_RV, 512, (pn - 2) * 256, row0, lc);
        else if (pn < 6) store_act<1>(acc, WS_RG, 512, (pn - 4) * 256, row0, lc);
        else if (pn < 8) store_act<2>(acc, WS_FQ, 512, (pn - 6) * 256, row0, lc);
        else if (pn < 10) store_act<0>(acc, WS_FK, 512, (pn - 8) * 256, row0, lc);
        else if (pn < 12) store_act<0>(acc, WS_FV, 512, (pn - 10) * 256, row0, lc);
        else if (pn < 14) store_act<3>(acc, WS_GU, 512, (pn - 12) * 256, row0, lc);
        else if (GATES_FP8 == 2 || P1_I8 || pn < 16) store_act<3>(acc, WS_GV, 512, (pn - 14) * 256, row0, lc);
#if GATES_FP8 != 2 && !P1_I8
        else store_act<4>(acc, WS_GT, 3072, (pn - 16) * 256, row0, lc);
#endif
    }
    template <int ACT>
    __device__ __forceinline__ void store_act(ACC_T, size_t off, int pitch, int coff, int row0, int lc) const {
        bf16_t* dst = (bf16_t*)(ws + off);
        f32x4 bv[2][2];
#pragma unroll
        for (int bj = 0; bj < 2; ++bj)
#pragma unroll
            for (int n = 0; n < 2; ++n) bv[bj][n] = (ACT == 4) ? *(const f32x4*)(gate_b + coff + bj * 128 + lc + 4 * n) : (f32x4){0.f, 0.f, 0.f, 0.f};
#pragma unroll
        for (int ai = 0; ai < 2; ++ai)
#pragma unroll
            for (int m = 0; m < 4; ++m) { bf16_t* rowp = dst + (size_t)(row0 + ai * 128 + m * 16) * pitch + coff + lc;
#pragma unroll
                for (int bj = 0; bj < 2; ++bj) { f2v v[4];
#pragma unroll
                    for (int n = 0; n < 2; ++n) { const f32x4 a = ldacc<I8IN>(acc[ai][bj][m][n]); v[2 * n] = __builtin_shufflevector(a, a, 0, 1); v[2 * n + 1] = __builtin_shufflevector(a, a, 2, 3);
                        if (ACT == 4) { v[2 * n] += __builtin_shufflevector(bv[bj][n], bv[bj][n], 0, 1); v[2 * n + 1] += __builtin_shufflevector(bv[bj][n], bv[bj][n], 2, 3); } }
#pragma unroll
                    for (int j = 0; j < 4; ++j) { f2v x = v[j];
                        if (ACT == 1) x = fsilu2(x); else if (ACT == 2) x = x * C2; else if (ACT == 3) x = fgelu_tanh2(x); else if (ACT == 4) x = fsigmoid2(x);
                        v[j] = x; }
                    v4u w; w.x = pg8::cvt_pk_bf16(v[0].x, v[0].y); w.y = pg8::cvt_pk_bf16(v[1].x, v[1].y); w.z = pg8::cvt_pk_bf16(v[2].x, v[2].y); w.w = pg8::cvt_pk_bf16(v[3].x, v[3].y);
                    *(v4u*)(rowp + bj * 128) = w; } }
    }
};

using EpiProj = EpiProjT<false>;
template <bool I8IN>
struct EpiGate8T {
    static constexpr bool PERM = true, HOOK = false, DUPME = false;
    bf16_t* GT; const float* gate_b;
    __device__ __forceinline__ void operator()(ACC_T, const Unit& u, int wr, int wc, int fr, int fq) const {
        const int row0 = u.pm * 256 + wr * 64 + fr, lc = wc * 32 + 8 * fq, coff = u.pn * 256;
        f32x4 bv[2][2];
#pragma unroll
        for (int bj = 0; bj < 2; ++bj)
#pragma unroll
            for (int n = 0; n < 2; ++n) bv[bj][n] = *(const f32x4*)(gate_b + coff + bj * 128 + lc + 4 * n);
#pragma unroll
        for (int ai = 0; ai < 2; ++ai)
#pragma unroll
            for (int m = 0; m < 4; ++m) { bf16_t* rowp = GT + (size_t)(row0 + ai * 128 + m * 16) * 3072 + coff + lc;
#pragma unroll
                for (int bj = 0; bj < 2; ++bj) { f2v v[4];
#pragma unroll
                    for (int n = 0; n < 2; ++n) { const f32x4 a = ldacc<I8IN>(acc[ai][bj][m][n]) + bv[bj][n]; v[2 * n] = fsigmoid2(__builtin_shufflevector(a, a, 0, 1)); v[2 * n + 1] = fsigmoid2(__builtin_shufflevector(a, a, 2, 3)); }
                    v4u w; w.x = pg8::cvt_pk_bf16(v[0].x, v[0].y); w.y = pg8::cvt_pk_bf16(v[1].x, v[1].y); w.z = pg8::cvt_pk_bf16(v[2].x, v[2].y); w.w = pg8::cvt_pk_bf16(v[3].x, v[3].y);
                    *(v4u*)(rowp + bj * 128) = w; } }
    }
};

using EpiGate8 = EpiGate8T<false>;
struct EpiMerge {
    static constexpr bool PERM = true, HOOK = true, DUPME = false;
    const bf16_t* GT; bf16_t* MRG;
    __device__ __forceinline__ void unpackg(const v4u w, float (&g)[8]) const {
        g[0] = bflo(w.x); g[1] = bfhi(w.x); g[2] = bflo(w.y); g[3] = bfhi(w.y); g[4] = bflo(w.z); g[5] = bfhi(w.z); g[6] = bflo(w.w); g[7] = bfhi(w.w);
#pragma unroll
        for (int j = 0; j < 8; ++j) g[j] = fmaxf(g[j], 1e-30f);
    }
    __device__ __forceinline__ void khook(pg8::f32x4 (&acc)[2][2][4][2], const Unit& u, int t, int wr, int wc, int fr, int fq) const {
        if (t != 8 && t != 16) return;
        const int np = (t == 8) ? 0 : 1; int row0 = u.pm * 256 + wr * 64 + fr; const int col0 = u.pn * 256 + wc * 32 + 8 * fq;
        asm volatile("" : "+v"(row0));
#pragma unroll
        for (int ai = 0; ai < 2; ++ai) {
            v4u wp[4][2], wn[4][2];
#pragma unroll
            for (int m = 0; m < 4; ++m)
#pragma unroll
                for (int bj = 0; bj < 2; ++bj) { const bf16_t* p = GT + (size_t)(row0 + ai * 128 + m * 16) * 3072 + np * 1024 + col0 + bj * 128; wp[m][bj] = *(const v4u*)p; wn[m][bj] = *(const v4u*)(p + 1024); }
#pragma unroll
            for (int m = 0; m < 4; ++m)
#pragma unroll
                for (int bj = 0; bj < 2; ++bj) { const unsigned pw[4] = {wp[m][bj].x, wp[m][bj].y, wp[m][bj].z, wp[m][bj].w}, nw[4] = {wn[m][bj].x, wn[m][bj].y, wn[m][bj].z, wn[m][bj].w};
#pragma unroll
                    for (int q = 0; q < 4; ++q) {
                        f2v gp2, gn2; gp2.x = bflo(pw[q]); gp2.y = bfhi(pw[q]); gn2.x = fmaxf(bflo(nw[q]), 1e-30f); gn2.y = fmaxf(bfhi(nw[q]), 1e-30f);
                        f2v r2; r2.x = __builtin_amdgcn_rcpf(gn2.x); r2.y = __builtin_amdgcn_rcpf(gn2.y); const f2v ratio = gp2 * r2;
                        pg8::f32x4& a4 = acc[ai][bj][m][q >> 1];
                        if (q & 1) { a4.z *= ratio.x; a4.w *= ratio.y; } else { a4.x *= ratio.x; a4.y *= ratio.y; } } }
            asm volatile("" ::: "memory");
        }
    }
    __device__ __forceinline__ void operator()(ACC_T, const Unit& u, int wr, int wc, int fr, int fq) const {
        const int row0 = u.pm * 256 + wr * 64 + fr, col0 = u.pn * 256 + wc * 32 + 8 * fq;
#pragma unroll
        for (int ai = 0; ai < 2; ++ai) {
            v4u wg[4][2];
#pragma unroll
            for (int m = 0; m < 4; ++m)
#pragma unroll
                for (int bj = 0; bj < 2; ++bj) wg[m][bj] = *(const v4u*)(GT + (size_t)(row0 + ai * 128 + m * 16) * 3072 + 2048 + col0 + bj * 128);
#pragma unroll
            for (int m = 0; m < 4; ++m)
#pragma unroll
                for (int bj = 0; bj < 2; ++bj) { const unsigned gw[4] = {wg[m][bj].x, wg[m][bj].y, wg[m][bj].z, wg[m][bj].w}; unsigned o[4];
#pragma unroll
                    for (int q = 0; q < 4; ++q) { f2v g2; g2.x = bflo(gw[q]); g2.y = bfhi(gw[q]); const pg8::f32x4 a4 = acc[ai][bj][m][q >> 1];
                        f2v a2; if (q & 1) { a2.x = a4.z; a2.y = a4.w; } else { a2.x = a4.x; a2.y = a4.y; } const f2v p = a2 * g2; o[q] = pg8::cvt_pk_bf16(p.x, p.y); }
                    v4u w; w.x = o[0]; w.y = o[1]; w.z = o[2]; w.w = o[3];
                    *(v4u*)(MRG + (size_t)(row0 + ai * 128 + m * 16) * 1024 + col0 + bj * 128) = w; }
            asm volatile("" ::: "memory");
        }
    }
};

struct EpiResid {
    static constexpr bool PERM = false, HOOK = false, DUPME = false;
    const float* res; float* out;
    __device__ __forceinline__ void operator()(ACC_T, const Unit& u, int wr, int wc, int fr, int fq) const {
        const int row0 = u.pm * 256 + wr * 64 + fr, col0 = u.pn * 256 + wc * 32 + 4 * fq;
#pragma unroll
        for (int ai = 0; ai < 2; ++ai)
#pragma unroll
            for (int m = 0; m < 4; ++m) { const size_t off = (size_t)(row0 + ai * 128 + m * 16) * 1024 + col0;
#pragma unroll
                for (int bj = 0; bj < 2; ++bj)
#pragma unroll
                    for (int n = 0; n < 2; ++n) { const f32x4 r = *(const f32x4*)(res + off + bj * 128 + n * 16); *(f32x4*)(out + off + bj * 128 + n * 16) = r * ALPHA + acc[ai][bj][m][n]; } }
    }
};

struct EpiSwiglu {
    static constexpr bool PERM = true, HOOK = false, DUPME = false;
    bf16_t* H; int ldh;
    __device__ __forceinline__ void operator()(ACC_T, const Unit& u, int wr, int wc, int fr, int fq) const {
        const int row0 = u.pm * 256 + wr * 64 + fr, col0 = u.pn * 128 + wc * 16 + 4 * fq;
#pragma unroll
        for (int ai = 0; ai < 2; ++ai)
#pragma unroll
            for (int m = 0; m < 4; ++m) { bf16_t* rowp = H + (size_t)(row0 + ai * 128 + m * 16) * ldh + col0;
#pragma unroll
                for (int bj = 0; bj < 2; ++bj) { const f32x4 a = acc[ai][bj][m][0], b = acc[ai][bj][m][1];
                    const f2v o01 = fsilu2(__builtin_shufflevector(a, a, 0, 1)) * __builtin_shufflevector(b, b, 0, 1), o23 = fsilu2(__builtin_shufflevector(a, a, 2, 3)) * __builtin_shufflevector(b, b, 2, 3);
                    v2u w; w.x = pg8::cvt_pk_bf16(o01.x, o01.y); w.y = pg8::cvt_pk_bf16(o23.x, o23.y);
                    *(v2u*)(rowp + bj * 64) = w; } }
    }
};

struct EpiSwigluI8 {
    static constexpr bool PERM = true, HOOK = false, DUPME = false;
    bf16_t* H; int ldh;
    __device__ __forceinline__ void operator()(ACC_T, const Unit& u, int wr, int wc, int fr, int fq) const {
        typedef int i32x4_t __attribute__((ext_vector_type(4)));
        constexpr float CA = LOG2E / (SC_XI8 * SC_WI8), CB = 1.0f / (SC_XI8 * SC_WI8 * LOG2E);
        const int row0 = u.pm * 256 + wr * 64 + fr, col0 = u.pn * 128 + wc * 16 + 4 * fq;
#pragma unroll
        for (int ai = 0; ai < 2; ++ai)
#pragma unroll
            for (int m = 0; m < 4; ++m) { bf16_t* rowp = H + (size_t)(row0 + ai * 128 + m * 16) * ldh + col0;
#pragma unroll
                for (int bj = 0; bj < 2; ++bj) {
                    const f32x4 a = __builtin_convertvector(__builtin_bit_cast(i32x4_t, acc[ai][bj][m][0]), f32x4) * CA, b = __builtin_convertvector(__builtin_bit_cast(i32x4_t, acc[ai][bj][m][1]), f32x4) * CB;
                    const f2v o01 = swi_folded2(__builtin_shufflevector(a, a, 0, 1), __builtin_shufflevector(b, b, 0, 1)), o23 = swi_folded2(__builtin_shufflevector(a, a, 2, 3), __builtin_shufflevector(b, b, 2, 3));
                    v2u w; w.x = pg8::cvt_pk_bf16(o01.x, o01.y); w.y = pg8::cvt_pk_bf16(o23.x, o23.y);
                    *(v2u*)(rowp + bj * 64) = w; } }
    }
};

struct MoeTiles {
    int cnt[NEXP]; int toff[NEXP + 1];
    __device__ __forceinline__ void init(const gu32* ctl) {
        int t = 0;
#pragma unroll
        for (int e = 0; e < NEXP; ++e) { cnt[e] = __builtin_amdgcn_readfirstlane((int)__hip_atomic_load(ctl + CW_CNT + 64 * e, RLX_AGENT)); toff[e] = t; t += (cnt[e] + 255) >> 8; }
        toff[NEXP] = t;
    }
    __device__ __forceinline__ void find(int pm, int& e, int& slot0, int& n) const {
        int ee = 0;
#pragma unroll
        for (int j = 1; j < NEXP; ++j) if (pm >= toff[j]) ee = j;
        int c = 0, t0 = 0;
#pragma unroll
        for (int j = 0; j < NEXP; ++j) if (j == ee) { c = cnt[j]; t0 = toff[j]; }
        e = ee; slot0 = (pm - t0) * 256; n = c;
    }
    __device__ __forceinline__ int nfull_total() const { int a = 0;
#pragma unroll
        for (int j = 0; j < NEXP; ++j) a += cnt[j] >> 8;
        return a; }
    __device__ __forceinline__ void findfull(int pmf, int& e, int& lt, int& htile) const {
        int a = 0, ee = 0, ll = 0, hh = 0;
#pragma unroll
        for (int j = 0; j < NEXP; ++j) { const int nf = cnt[j] >> 8; if (pmf >= a && pmf < a + nf) { ee = j; ll = pmf - a; hh = toff[j] + ll; } a += nf; }
        e = ee; lt = ll; htile = hh;
    }
    __device__ __forceinline__ void expert(int e, int& c, int& t0) const { int cc = 0, tt = 0;
#pragma unroll
        for (int j = 0; j < NEXP; ++j) if (j == e) { cc = cnt[j]; tt = toff[j]; }
        c = cc; t0 = tt; }
};
struct MoeUpSched : pg8::TileOrder {
    static constexpr bool GATHER = true;
    const unsigned char* A; const unsigned char* Bt; const unsigned* list; MoeTiles mt;
    __device__ __forceinline__ const char* abase(const Unit&) const { return (const char*)A; }
    __device__ __forceinline__ void aoffs_load(const Unit& u, const int (&R)[2], PG8_LAS unsigned* scr) const {
        int e, s0, n; mt.find(u.pm, e, s0, n);
#pragma unroll
        for (int h = 0; h < 2; ++h)
#pragma unroll
            for (int i = 0; i < 2; ++i) { int slot = s0 + R[i] + h * 128; slot = slot < 16383 ? slot : 16383;
                __builtin_amdgcn_global_load_lds(list + e * 16384 + slot, scr + (h * 2 + i) * 64, 4, 0, 0); }
    }
    __device__ __forceinline__ void aoffs_fin(const Unit& u, const int (&R)[2], const int (&C)[2], const PG8_LAS unsigned* scr, int lane, unsigned (&o)[2][2]) const {
        int e, s0, n; mt.find(u.pm, e, s0, n);
#pragma unroll
        for (int h = 0; h < 2; ++h)
#pragma unroll
            for (int i = 0; i < 2; ++i) { const int slot = s0 + R[i] + h * 128; const unsigned w = scr[(h * 2 + i) * 64 + lane]; const unsigned tok = slot < n ? (w & 0x7fffffffu) : 0u; o[h][i] = tok * 1024u + 2u * (unsigned)C[i]; }
    }
    __device__ __forceinline__ const char* bbase(const Unit& u) const { int e, s0, n; mt.find(u.pm, e, s0, n); return (const char*)Bt + ((size_t)e * (2 * DFF_E) + (size_t)u.pn * 256) * 1024; }
};
struct MoeDownSched : pg8::TileOrder {
    static constexpr bool GATHER = false;
    const unsigned char* A; const unsigned char* Bt; MoeTiles mt;
    __device__ __forceinline__ const char* abase(const Unit& u) const { int e, lt, ht; mt.findfull(u.pm, e, lt, ht); return (const char*)A + (size_t)ht * 256 * DFF_E; }
    __device__ __forceinline__ void aoffs_load(const Unit&, const int (&)[2], PG8_LAS unsigned*) const {}
    __device__ __forceinline__ void aoffs_fin(const Unit&, const int (&)[2], const int (&)[2], const PG8_LAS unsigned*, int, unsigned (&)[2][2]) const {}
    __device__ __forceinline__ const char* bbase(const Unit& u) const { int e, lt, ht; mt.findfull(u.pm, e, lt, ht); return (const char*)Bt + ((size_t)e * 1024 + (size_t)u.pn * 256) * DFF_E; }
};
struct EpiSwiglu8 {
    static constexpr bool PERM = true, HOOK = false, DUPME = false;
    unsigned char* H; int ldh;
    static __device__ __forceinline__ f2v swi8x2(f2v a, f2v b) {
        f2v e; e.x = __builtin_amdgcn_exp2f(-a.x); e.y = __builtin_amdgcn_exp2f(-a.y); const f2v d = e + 1.0f; f2v r; r.x = __builtin_amdgcn_rcpf(d.x); r.y = __builtin_amdgcn_rcpf(d.y); return (a * b) * r; }
    static __device__ __forceinline__ float swi8(float a, float b) { return (a * b) * __builtin_amdgcn_rcpf(1.0f + __builtin_amdgcn_exp2f(-a)); }
    __device__ __forceinline__ void operator()(ACC_T, const Unit& u, int wr, int wc, int fr, int fq) const {
        const int row0 = u.pm * 256 + wr * 64 + fr, col0 = u.pn * 128 + wc * 16;
#pragma unroll
        for (int ai = 0; ai < 2; ++ai)
#pragma unroll
            for (int bj = 0; bj < 2; ++bj) { unsigned x[4];
#pragma unroll
                for (int m = 0; m < 4; ++m) { const f32x4 a = acc[ai][bj][m][0], b = acc[ai][bj][m][1];
                    const f2v o01 = swi8x2(__builtin_shufflevector(a, a, 0, 1), __builtin_shufflevector(b, b, 0, 1)), o23 = swi8x2(__builtin_shufflevector(a, a, 2, 3), __builtin_shufflevector(b, b, 2, 3));
                    x[m] = pk4_fp8(o01.x, o01.y, o23.x, o23.y); }
                const auto p01 = __builtin_amdgcn_permlane16_swap(x[0], x[1], false, false), p23 = __builtin_amdgcn_permlane16_swap(x[2], x[3], false, false);
                const auto q02 = __builtin_amdgcn_permlane32_swap(p01[0], p23[0], false, false), q13 = __builtin_amdgcn_permlane32_swap(p01[1], p23[1], false, false);
                v4u w; w.x = q02[0]; w.y = q13[0]; w.z = q02[1]; w.w = q13[1];
                *(v4u*)(H + (size_t)(row0 + ai * 128 + fq * 16) * ldh + col0 + bj * 64) = w; }
    }
};
struct EpiMoeDown {
    static constexpr bool PERM = true, HOOK = false, DUPME = false;
    bf16_t* c0; bf16_t* c1; const unsigned* list; const float* gatew; MoeTiles mt;
    __device__ __forceinline__ void operator()(ACC_T, const Unit& u, int wr, int wc, int fr, int fq) const {
        int e, lt, ht; mt.findfull(u.pm, e, lt, ht); const int s0 = lt * 256;
        const int col0 = u.pn * 256 + wc * 32 + 8 * fq;
        unsigned ent[2][4]; float gg[2][4];
#pragma unroll
        for (int ai = 0; ai < 2; ++ai)
#pragma unroll
            for (int m = 0; m < 4; ++m) { const int slot = s0 + ai * 128 + wr * 64 + m * 16 + fr; ent[ai][m] = list[e * 16384 + slot]; gg[ai][m] = gatew[e * 16384 + slot]; }
#pragma unroll
        for (int ai = 0; ai < 2; ++ai)
#pragma unroll
            for (int m = 0; m < 4; ++m) { const float g = gg[ai][m];
                bf16_t* dst = ((ent[ai][m] >> 31) ? c1 : c0) + (size_t)(ent[ai][m] & 0x7fffffffu) * 1024 + col0;
#pragma unroll
                for (int bj = 0; bj < 2; ++bj) { const pg8::f32x4 a = acc[ai][bj][m][0] * g, b = acc[ai][bj][m][1] * g;
                    v4u w; w.x = pg8::cvt_pk_bf16(a[0], a[1]); w.y = pg8::cvt_pk_bf16(a[2], a[3]); w.z = pg8::cvt_pk_bf16(b[0], b[1]); w.w = pg8::cvt_pk_bf16(b[2], b[3]);
                    *(v4u*)(dst + bj * 128) = w; } }
    }
};

struct Frame {
    LAS unsigned char* lds;
    volatile LAS unsigned* MISC;
    gu32* ctl;
    int tid, lane, wave;
    int vcu, G;
    unsigned char* ws;
};
__device__ __forceinline__ float wave_sum(float v) {
#pragma unroll
    for (int o = 1; o < 64; o <<= 1) v += __shfl_xor(v, o);
    return v;
}

__device__ __forceinline__ int mapcol(int kind, int dff, int v) {
    if (kind == 0) return v;
    if (kind == 1) {
        if (v < 512) { const int w = v & 63; return (v & ~63) + 32 * ((w >> 2) & 1) + 4 * (w >> 3) + (w & 3); }
        return v < FL_COL ? v : v + 8;
    }
    const int tile = v >> 8, vl = v & 255, n = (vl >> 2) & 1, j = tile * 128 + (vl >> 3) * 4 + (vl & 3);
    return n ? dff + j : j;
}
__device__ __forceinline__ void cvt_item(const float* W, int Nsrc, bf16* dst, int dpitch, int koff, int kind, int dff, int k0, int v0, LAS float* scr, int lane, float f8scale, int vbase) {
    const int v4 = lane & 15, kq = lane >> 4;
    const float* src = W + (size_t)(k0 + kq) * Nsrc + mapcol(kind, dff, vbase + v0 + 4 * v4);
    f32x4 t[16];
#pragma unroll
    for (int it = 0; it < 16; ++it) t[it] = *(const f32x4*)(src + (size_t)(4 * it) * Nsrc);
#pragma unroll
    for (int it = 0; it < 16; ++it) *(LAS f32x4*)(scr + (kq + 4 * it) * 68 + 4 * v4) = t[it];
    LDS_WAIT(); asm volatile("" ::: "memory");
    if (f8scale != 0.f) {
        const int c = lane & 3; unsigned char* d8 = (unsigned char*)dst;
        if (f8scale < 0.f) {
#pragma unroll
            for (int j = 0; j < 4; ++j) { const int n = (lane >> 2) + 16 * j; const LAS float* s = scr + (16 * c) * 68 + n; const float q = -f8scale;
                v4u o; o.x = pk4_i8(s[0 * 68] * q, s[1 * 68] * q, s[2 * 68] * q, s[3 * 68] * q); o.y = pk4_i8(s[4 * 68] * q, s[5 * 68] * q, s[6 * 68] * q, s[7 * 68] * q);
                o.z = pk4_i8(s[8 * 68] * q, s[9 * 68] * q, s[10 * 68] * q, s[11 * 68] * q); o.w = pk4_i8(s[12 * 68] * q, s[13 * 68] * q, s[14 * 68] * q, s[15 * 68] * q);
                *(GAS v4u*)(d8 + (size_t)(v0 + n) * dpitch + koff + k0 + 16 * c) = o; }
            LDS_WAIT(); asm volatile("" ::: "memory"); return; }
        if (kind == 2) f8scale *= (lane & 16) ? SWI_B : SWI_A;
#pragma unroll
        for (int j = 0; j < 4; ++j) { const int n = (lane >> 2) + 16 * j; const LAS float* s = scr + (16 * c) * 68 + n;
            v4u o; o.x = pk4_fp8(s[0 * 68] * f8scale, s[1 * 68] * f8scale, s[2 * 68] * f8scale, s[3 * 68] * f8scale); o.y = pk4_fp8(s[4 * 68] * f8scale, s[5 * 68] * f8scale, s[6 * 68] * f8scale, s[7 * 68] * f8scale);
            o.z = pk4_fp8(s[8 * 68] * f8scale, s[9 * 68] * f8scale, s[10 * 68] * f8scale, s[11 * 68] * f8scale); o.w = pk4_fp8(s[12 * 68] * f8scale, s[13 * 68] * f8scale, s[14 * 68] * f8scale, s[15 * 68] * f8scale);
            *(GAS v4u*)(d8 + (size_t)(v0 + n) * dpitch + koff + k0 + 16 * c) = o; }
    } else {
    const int c = lane & 7;
#pragma unroll
    for (int j = 0; j < 8; ++j) { const int n = (lane >> 3) + 8 * j; const LAS float* s = scr + (8 * c) * 68 + n;
        v4u o; o.x = pk2(s[0 * 68], s[1 * 68]); o.y = pk2(s[2 * 68], s[3 * 68]); o.z = pk2(s[4 * 68], s[5 * 68]); o.w = pk2(s[6 * 68], s[7 * 68]);
        *(GAS v4u*)(dst + (size_t)(v0 + n) * dpitch + koff + k0 + 8 * c) = o; }
    }
    LDS_WAIT(); asm volatile("" ::: "memory");
}
struct CvtJob { const float* W; int K, Nsrc, Nv; bf16* dst; int dpitch, koff, kind, dff; float f8scale; int vbase = 0; };
__device__ __forceinline__ bool cvt_run(const CvtJob& j, int& r, LAS float* scr, int lane) {
    const int nvb = j.Nv / 64, items = (j.K / 64) * nvb;
    if (r >= items) { r -= items; return false; }
    cvt_item(j.W, j.Nsrc, j.dst, j.dpitch, j.koff, j.kind, j.dff, 64 * (r / nvb), 64 * (r % nvb), scr, lane, j.f8scale, j.vbase);
    return true;
}

__device__ __forceinline__ float row_dot8(const f32x4 (&v)[4], const LAS float* wT, int lane) {
    float p[8];
#pragma unroll
    for (int h = 0; h < 8; ++h) { float s = 0.f;
#pragma unroll
        for (int j = 0; j < 4; ++j) { const f32x4 w = *(const LAS f32x4*)(wT + h * 1024 + 256 * j + 4 * lane); s += (v[j].x * w.x + v[j].y * w.y) + (v[j].z * w.z + v[j].w * w.w); }
        p[h] = s; }
    const bool b0 = lane & 1, b1 = lane & 2, b2 = lane & 4;
    float q[4], r[2];
#pragma unroll
    for (int k = 0; k < 4; ++k) { const float a = p[2 * k], b = p[2 * k + 1]; q[k] = (b0 ? b : a) + __shfl_xor(b0 ? a : b, 1); }
#pragma unroll
    for (int k = 0; k < 2; ++k) { const float a = q[2 * k], b = q[2 * k + 1]; r[k] = (b1 ? b : a) + __shfl_xor(b1 ? a : b, 2); }
    float t = (b2 ? r[1] : r[0]) + __shfl_xor(b2 ? r[0] : r[1], 4);
    t += __shfl_xor(t, 8); t += __shfl_xor(t, 16); t += __shfl_xor(t, 32);
    return t;
}
__device__ __forceinline__ void stage_w8(Frame& F, const float* W, int pitch, int col0) {
    LAS float* wT = (LAS float*)(F.lds + RING_OFF);
    float t[16];
#pragma unroll
    for (int k = 0; k < 16; ++k) { const int i = F.tid + 512 * k, d = i >> 3, h = i & 7; t[k] = W[(size_t)d * pitch + col0 + h]; }
#pragma unroll
    for (int k = 0; k < 16; ++k) { const int i = F.tid + 512 * k, d = i >> 3, h = i & 7; wT[h * 1024 + d] = t[k]; }
    LDS_WAIT(); __syncthreads();
}
__device__ __forceinline__ float log_sigmoid(float x) {
    const float y = __builtin_amdgcn_exp2f(-fabsf(x) * LOG2E); const float l = (y < 1e-2f) ? y * (1.f - y * (0.5f - y * 0.33333334f)) : __builtin_amdgcn_logf(1.f + y) * 0.6931471805599453f;
    return fminf(x, 0.f) - l; }

__device__ __forceinline__ void p0_rows(Frame& F, const float* x, const float* w_in0, const float* fox_b) {
    stage_w8(F, w_in0, N_INSRC, FL_COL);
    const LAS float* wT = (const LAS float*)(F.lds + RING_OFF);
    const int gw = F.vcu * NWAVES + F.wave, NGW = F.G * NWAVES;
    bf16* XB = (bf16*)(F.ws + WS_XB); float* LOGF = (float*)(F.ws + WS_LOGF);
    f32x4 nx[4];
    if (gw < M) {
#pragma unroll
        for (int j = 0; j < 4; ++j) nx[j] = *((const GAS f32x4*)(x + (size_t)gw * D) + F.lane + 64 * j); }
#pragma unroll 1
    for (int m = gw; m < M; m += NGW) {
        f32x4 v[4];
#pragma unroll
        for (int j = 0; j < 4; ++j) v[j] = nx[j];
        if (m + NGW < M) {
#pragma unroll
            for (int j = 0; j < 4; ++j) nx[j] = *((const GAS f32x4*)(x + (size_t)(m + NGW) * D) + F.lane + 64 * j); }
        GAS unsigned long long* o8 = (GAS unsigned long long*)(XB + (size_t)m * D) + F.lane;
#pragma unroll
        for (int j = 0; j < 4; ++j) o8[64 * j] = (unsigned long long)pk2(v[j].x, v[j].y) | ((unsigned long long)pk2(v[j].z, v[j].w) << 32);
#if GATES_FP8 == 2
#pragma unroll
        for (int j = 0; j < 4; ++j) *((GAS unsigned*)(F.ws + WS_X8IN + (size_t)m * D) + F.lane + 64 * j) = P1_I8 ? pk4_i8(v[j].x * SC_XI8, v[j].y * SC_XI8, v[j].z * SC_XI8, v[j].w * SC_XI8) : pk4_fp8(v[j].x * SC_X8, v[j].y * SC_X8, v[j].z * SC_X8, v[j].w * SC_X8);
#endif
        const float r = row_dot8(v, wT, F.lane);
        if (F.lane < 8) LOGF[(size_t)m * 8 + F.lane] = log_sigmoid(r + fox_b[F.lane]);
    }
    __syncthreads();
}

template <int AUX>
__device__ __forceinline__ void ln_pass(Frame& F, const float* src, float src_scale, const bf16* addb1, const bf16* addb2, const float* g, const float* b, float* outf, bf16* outb, unsigned char* out8,
                                        const float* w8, int w8pitch, int w8col, const float* fox_b, bool grp, float o8s = SC_X8) {
    if (AUX != 0) stage_w8(F, w8, w8pitch, w8col);
    const LAS float* wT = (const LAS float*)(F.lds + RING_OFF);
    const int gw = F.vcu * NWAVES + F.wave, NGW = F.G * NWAVES;
    f32x4 gv[4], bv[4];
#pragma unroll
    for (int j = 0; j < 4; ++j) { gv[j] = *((const f32x4*)g + F.lane + 64 * j); bv[j] = *((const f32x4*)b + F.lane + 64 * j); }
    int nbuf = 0, r_i1 = 0, r_i2 = 0, r_m = 0; float r_w1 = 0.f;
#define ROUTER_FLUSH() do { const bool vld_ = F.lane < nbuf; const unsigned long long lt_ = (1ull << F.lane) - 1ull; unsigned n_e_ = 0u, rk1_ = 0u, rk2_ = 0u; \
        _Pragma("unroll") for (int e_ = 0; e_ < 8; ++e_) { const unsigned long long b1_ = __ballot(vld_ && r_i1 == e_), b2_ = __ballot(vld_ && r_i2 == e_); \
            const unsigned c1_ = (unsigned)__popcll(b1_), c2_ = (unsigned)__popcll(b2_); if (F.lane == e_) n_e_ = c1_ + c2_; \
            if (r_i1 == e_) rk1_ = (unsigned)__popcll(b1_ & lt_); if (r_i2 == e_) rk2_ = c1_ + (unsigned)__popcll(b2_ & lt_); } \
        unsigned base_ = 0u; if (F.lane < 8 && n_e_ != 0u) base_ = __hip_atomic_fetch_add(F.ctl + CW_CNT + 64 * F.lane, n_e_, RLX_AGENT); \
        const unsigned s1_ = (unsigned)__shfl((int)base_, r_i1) + rk1_, s2_ = (unsigned)__shfl((int)base_, r_i2) + rk2_; \
        if (vld_) { unsigned* list_ = (unsigned*)(F.ws + WS_LIST); float* gw8_ = (float*)(F.ws + WS_GATEW); \
            list_[r_i1 * 16384 + s1_] = (unsigned)r_m; gw8_[r_i1 * 16384 + s1_] = r_w1; list_[r_i2 * 16384 + s2_] = (unsigned)r_m | 0x80000000u; gw8_[r_i2 * 16384 + s2_] = 1.0f - r_w1; } } while (0)
    const int m0 = grp ? (F.vcu >> 5) * SEQ + (F.vcu & 31) * NWAVES + F.wave : gw, mstep = grp ? 32 * NWAVES : NGW, mend = grp ? ((F.vcu >> 5) + 1) * SEQ : M;
    f32x4 nx[4]; v2u na[4], nc[4];
#define LN_LOAD(mm) do { _Pragma("unroll") for (int j = 0; j < 4; ++j) { nx[j] = *((const GAS f32x4*)(src + (size_t)(mm) * D) + F.lane + 64 * j); \
        if (addb1) { na[j] = *((const GAS v2u*)(addb1 + (size_t)(mm) * D) + F.lane + 64 * j); nc[j] = *((const GAS v2u*)(addb2 + (size_t)(mm) * D) + F.lane + 64 * j); } } } while (0)
    if (m0 < mend) LN_LOAD(m0);
#pragma unroll 1
    for (int m = m0; m < mend; m += mstep) {
        f32x4 v[4]; float s = 0.f;
#pragma unroll
        for (int j = 0; j < 4; ++j) { v[j] = nx[j];
            if (addb1) { v[j] = v[j] * src_scale; const v2u a = na[j], c = nc[j];
                v[j].x += bflo(a.x) + bflo(c.x); v[j].y += bfhi(a.x) + bfhi(c.x); v[j].z += bflo(a.y) + bflo(c.y); v[j].w += bfhi(a.y) + bfhi(c.y); }
            s += (v[j].x + v[j].y) + (v[j].z + v[j].w); }
        if (m + mstep < mend) LN_LOAD(m + mstep);
        float lm = s * (1.f / 16.f), m2 = 0.f;
#pragma unroll
        for (int j = 0; j < 4; ++j) { const f32x4 d = v[j] - lm; m2 += (d.x * d.x + d.y * d.y) + (d.z * d.z + d.w * d.w); }
        { float cnt2 = 8.f;
#pragma unroll
          for (int o = 1; o < 64; o <<= 1) { const float om = __shfl_xor(lm, o), o2 = __shfl_xor(m2, o); const float dl = om - lm; m2 = m2 + o2 + dl * dl * cnt2; lm = 0.5f * (lm + om); cnt2 *= 2.f; } }
        const float mean = lm;
#pragma unroll
        for (int j = 0; j < 4; ++j) v[j] = v[j] - mean;
        const float rstd = 1.f / sqrtf(m2 * (1.f / D) + LN_EPS);
#pragma unroll
        for (int j = 0; j < 4; ++j) v[j] = v[j] * rstd * gv[j] + bv[j];
        if (outf) {
#pragma unroll
            for (int j = 0; j < 4; ++j) *((GAS f32x4*)(outf + (size_t)m * D) + F.lane + 64 * j) = v[j]; }
        if (outb) { GAS unsigned long long* o8 = (GAS unsigned long long*)(outb + (size_t)m * D) + F.lane;
#pragma unroll
            for (int j = 0; j < 4; ++j) o8[64 * j] = (unsigned long long)pk2(v[j].x, v[j].y) | ((unsigned long long)pk2(v[j].z, v[j].w) << 32); }
        if (out8) {
            if (o8s < 0.f) {
#pragma unroll
                for (int j = 0; j < 4; ++j) *((GAS unsigned*)(out8 + (size_t)m * D) + F.lane + 64 * j) = pk4_i8(v[j].x * -o8s, v[j].y * -o8s, v[j].z * -o8s, v[j].w * -o8s);
            } else {
#pragma unroll
            for (int j = 0; j < 4; ++j) *((GAS unsigned*)(out8 + (size_t)m * D) + F.lane + 64 * j) = pk4_fp8(v[j].x * SC_X8, v[j].y * SC_X8, v[j].z * SC_X8, v[j].w * SC_X8); } }
        if (AUX == 1) {
            const float r = row_dot8(v, wT, F.lane);
            if (F.lane < 8) ((float*)(F.ws + WS_LOGF))[(size_t)m * 8 + F.lane] = log_sigmoid(r + fox_b[F.lane]);
        }
        if (AUX == 2) {
            const float rl = row_dot8(v, wT, F.lane); float lg[8];
#pragma unroll
            for (int e = 0; e < 8; ++e) lg[e] = __shfl(rl, e);
            int i1 = 0; float v1 = lg[0];
#pragma unroll
            for (int e = 1; e < 8; ++e) if (lg[e] > v1) { v1 = lg[e]; i1 = e; }
            int i2 = -1; float v2 = -INFINITY;
#pragma unroll
            for (int e = 0; e < 8; ++e) if (e != i1 && lg[e] > v2) { v2 = lg[e]; i2 = e; }
            const float w1 = 1.0f / (1.0f + expf(v2 - v1));
            if (F.lane == nbuf) { r_i1 = i1; r_i2 = i2; r_w1 = w1; r_m = m; }
            if (++nbuf == 64) { ROUTER_FLUSH(); nbuf = 0; }
        }
    }
    if (AUX == 2) { if (nbuf) { ROUTER_FLUSH(); } }
#undef ROUTER_FLUSH
#undef LN_LOAD
    __syncthreads();
}

__device__ __forceinline__ void split3(float b, unsigned& h, unsigned& m, unsigned& l) { h = f2bf(b); const float r1 = b - bf2f((unsigned short)h); m = f2bf(r1); const float r2 = r1 - bf2f((unsigned short)m); l = f2bf(r2); }
template <bool AUG>
__device__ __forceinline__ void fox_bias_table(Frame& F, int b, int h, LAS float* tab, LAS float* wtot) {
    int tid = threadIdx.x; asm volatile("" : "+v"(tid));
    const int lane = tid & 63, wave = __builtin_amdgcn_readfirstlane(tid >> 6);
    const float* lf = (const float*)(F.ws + WS_LOGF) + (size_t)b * SEQ * 8 + h;
    float v[4];
#pragma unroll
    for (int j = 0; j < 4; ++j) v[j] = lf[(size_t)(4 * tid + j) * 8];
    float sj[4]; sj[0] = v[0]; sj[1] = sj[0] + v[1]; sj[2] = sj[1] + v[2]; sj[3] = sj[2] + v[3];
    float x = sj[3];
#pragma unroll
    for (int o = 1; o < 64; o <<= 1) { const float y = __shfl_up(x, o); if (lane >= o) x += y; }
    __syncthreads();
    if (lane == 63) wtot[wave] = x;
    LDS_WAIT(); __syncthreads();
    float base = 0.f;
#pragma unroll
    for (int w = 0; w < 8; ++w) if (w < wave) base += wtot[w];
    const float ex = base + x - sj[3];
#pragma unroll
    for (int j = 0; j < 4; ++j) { const float bv = -(ex + sj[j]) * LOG2E;
        if (AUG) { unsigned hh, mm, ll; split3(bv, hh, mm, ll); v4u w; w.x = hh | (mm << 16); w.y = ll | (0x3F80u << 16); w.z = 0x3F803F80u; w.w = 0u; ((LAS v4u*)tab)[4 * tid + j] = w; }
        else tab[4 * tid + j] = bv; }
    LDS_WAIT(); __syncthreads();
}

#if 1
__device__ __forceinline__ void naive_fox_row(Frame& F, int b, int h, int t, const LAS float* tab) {
    const bf16* FQ = (const bf16*)(F.ws + WS_FQ); const bf16* FK = (const bf16*)(F.ws + WS_FK); const bf16* FV = (const bf16*)(F.ws + WS_FV); bf16* YB = (bf16*)(F.ws + WS_YB);
    const size_t rb = (size_t)b * SEQ;
    float q[64];
    { const v4u* qp = (const v4u*)(FQ + (rb + t) * 512 + h * 64);
#pragma unroll
      for (int c = 0; c < 8; ++c) { const v4u w = qp[c]; q[8 * c + 0] = bflo(w.x); q[8 * c + 1] = bfhi(w.x); q[8 * c + 2] = bflo(w.y); q[8 * c + 3] = bfhi(w.y); q[8 * c + 4] = bflo(w.z); q[8 * c + 5] = bfhi(w.z); q[8 * c + 6] = bflo(w.w); q[8 * c + 7] = bfhi(w.w); } }
    float mx = -INFINITY, l = 0.f, o = 0.f;
    for (int s0 = 0; s0 <= t; s0 += 64) {
        const int s = s0 + F.lane; float sc = -INFINITY;
        if (s <= t) { const v4u* kp = (const v4u*)(FK + (rb + s) * 512 + h * 64); float a = 0.f;
#pragma unroll
            for (int c = 0; c < 8; ++c) { const v4u w = kp[c]; a += q[8 * c + 0] * bflo(w.x) + q[8 * c + 1] * bfhi(w.x) + q[8 * c + 2] * bflo(w.y) + q[8 * c + 3] * bfhi(w.y) + q[8 * c + 4] * bflo(w.z) + q[8 * c + 5] * bfhi(w.z) + q[8 * c + 6] * bflo(w.w) + q[8 * c + 7] * bfhi(w.w); }
            sc = a + tab[s]; }
        float cm = sc;
#pragma unroll
        for (int of = 1; of < 64; of <<= 1) cm = fmaxf(cm, __shfl_xor(cm, of));
        const float nm = fmaxf(mx, cm), f = __builtin_amdgcn_exp2f(mx - nm); const float p = __builtin_amdgcn_exp2f(sc - nm);
        l = l * f + wave_sum(p); o *= f; mx = nm;
        const int ne = (t - s0 + 1) < 64 ? (t - s0 + 1) : 64;
        for (int j = 0; j < ne; ++j) { const float pj = __shfl(p, j); o += pj * bf2f(FV[(rb + s0 + j) * 512 + h * 64 + F.lane]); }
    }
    YB[(rb + t) * 1536 + 512 + h * 64 + F.lane] = (bf16)f2bf(o / l);
}
__device__ __forceinline__ void naive_ret_row(Frame& F, int b, int h, int t) {
    const bf16* RQ = (const bf16*)(F.ws + WS_RQ); const bf16* RK = (const bf16*)(F.ws + WS_RK); const bf16* RV = (const bf16*)(F.ws + WS_RV); const bf16* RG = (const bf16*)(F.ws + WS_RG); bf16* YB = (bf16*)(F.ws + WS_YB);
    const size_t rb = (size_t)b * SEQ;
    const float l2g = log2f(1.0f - exp2f(-5.0f - (float)h));
    float q[64];
    { const v4u* qp = (const v4u*)(RQ + (rb + t) * 256 + h * 64);
#pragma unroll
      for (int c = 0; c < 8; ++c) { const v4u w = qp[c]; q[8 * c + 0] = bflo(w.x); q[8 * c + 1] = bfhi(w.x); q[8 * c + 2] = bflo(w.y); q[8 * c + 3] = bfhi(w.y); q[8 * c + 4] = bflo(w.z); q[8 * c + 5] = bfhi(w.z); q[8 * c + 6] = bflo(w.w); q[8 * c + 7] = bfhi(w.w); } }
    float o0 = 0.f, o1 = 0.f;
    for (int s0 = 0; s0 <= t; s0 += 64) {
        const int s = s0 + F.lane; float sc = 0.f;
        if (s <= t) { const v4u* kp = (const v4u*)(RK + (rb + s) * 256 + h * 64); float a = 0.f;
#pragma unroll
            for (int c = 0; c < 8; ++c) { const v4u w = kp[c]; a += q[8 * c + 0] * bflo(w.x) + q[8 * c + 1] * bfhi(w.x) + q[8 * c + 2] * bflo(w.y) + q[8 * c + 3] * bfhi(w.y) + q[8 * c + 4] * bflo(w.z) + q[8 * c + 5] * bfhi(w.z) + q[8 * c + 6] * bflo(w.w) + q[8 * c + 7] * bfhi(w.w); }
            sc = a * exp2f(l2g * (float)(t - s)); }
        const int ne = (t - s0 + 1) < 64 ? (t - s0 + 1) : 64;
        for (int j = 0; j < ne; ++j) { const float pj = __shfl(sc, j); const bf16* vp = RV + (rb + s0 + j) * 512 + h * 128; o0 += pj * bf2f(vp[F.lane]); o1 += pj * bf2f(vp[F.lane + 64]); }
    }
    const float mean = wave_sum(o0 + o1) * (1.f / 128.f); const float d0 = o0 - mean, d1 = o1 - mean;
    const float rstd = 1.f / sqrtf(wave_sum(d0 * d0 + d1 * d1) * (1.f / 128.f) + GN_EPS);
    const bf16* gp = RG + (rb + t) * 512 + h * 128; bf16* yp = YB + (rb + t) * 1536 + h * 128;
    yp[F.lane] = (bf16)f2bf(bf2f(gp[F.lane]) * d0 * rstd); yp[F.lane + 64] = (bf16)f2bf(bf2f(gp[F.lane + 64]) * d1 * rstd);
}
__device__ __forceinline__ void naive_gmlp_unit(Frame& F, int b, int n, int g, const float* w_s, const float* b_s, const float* lng, const float* lnb) {
    const bf16* GU = (const bf16*)(F.ws + WS_GU); const bf16* GV = (const bf16*)(F.ws + WS_GV); bf16* YB = (bf16*)(F.ws + WS_YB);
    LAS float* st = (LAS float*)(F.lds + RING_OFF);
    const size_t r0 = (size_t)b * SEQ + n * 128;
    __syncthreads();
    for (int r = F.wave; r < 128; r += NWAVES) {
        const v4u w = *((const v4u*)(GV + (r0 + r) * 512) + F.lane);
        float x[8] = {bflo(w.x), bfhi(w.x), bflo(w.y), bfhi(w.y), bflo(w.z), bfhi(w.z), bflo(w.w), bfhi(w.w)};
        float s = 0.f;
#pragma unroll
        for (int j = 0; j < 8; ++j) s += x[j];
        const float mean = wave_sum(s) * (1.f / 512.f); float s2 = 0.f;
#pragma unroll
        for (int j = 0; j < 8; ++j) { const float d = x[j] - mean; s2 += d * d; }
        const float rstd = 1.f / sqrtf(wave_sum(s2) * (1.f / 512.f) + LN_EPS);
        if (F.lane == 0) { st[2 * r] = mean; st[2 * r + 1] = rstd; }
    }
    LDS_WAIT(); __syncthreads();
    const int c = F.tid & 127; const float gam = lng[g * 128 + c], bet = lnb[g * 128 + c];
    for (int i = F.tid >> 7; i < 128; i += 4) {
        float a = 0.f; const float* wr = w_s + ((size_t)g * 128 + i) * 128;
        for (int j = 0; j <= i; ++j) { const float vn = (bf2f(GV[(r0 + j) * 512 + g * 128 + c]) - st[2 * j]) * st[2 * j + 1] * gam + bet; a += wr[j] * vn; }
        const float sp = a + b_s[g * 128 + i];
        YB[(r0 + i) * 1536 + 1024 + g * 128 + c] = (bf16)f2bf(bf2f(GU[(r0 + i) * 512 + g * 128 + c]) * sp);
    }
    __syncthreads();
}
#endif

__device__ __forceinline__ GAS void* lds_ptr(LAS unsigned char* lds, int k) {
    const v2u w = *(const LAS v2u*)(lds + PTAB_OFF + 8 * k);
    const unsigned lo = __builtin_amdgcn_readfirstlane(w.x), hi = __builtin_amdgcn_readfirstlane(w.y);
    return (GAS void*)(((unsigned long long)hi << 32) | lo);
}

typedef short bf16x8_t __attribute__((ext_vector_type(8)));
typedef float f32x16_t __attribute__((ext_vector_type(16)));
#define MFMA32(a, b, c) __builtin_amdgcn_mfma_f32_32x32x16_bf16((a), (b), (c), 0, 0, 0)
__device__ __forceinline__ bf16x8_t ldfrag(const LAS bf16* base, int row, int pitch, int kk, int h2) { return *(const LAS bf16x8_t*)(base + row * pitch + 16 * kk + 8 * h2); }
__device__ __forceinline__ int crow32(int reg, int h2) { return (reg & 3) + 8 * (reg >> 2) + 4 * h2; }
constexpr int RP128 = 136, RP64 = 72;
constexpr int R_QS = 0, R_KS = 4608, R_KDT = 23040, R_VT = 40448, R_SS = 75264, R_ST = 83968, R_OS = 102400, R_END = 119296;
static_assert(R_END <= RING_BYTES, "retention LDS map");
__device__ __forceinline__ void unpack8(const v4u w, float (&x)[8]) { x[0] = bflo(w.x); x[1] = bfhi(w.x); x[2] = bflo(w.y); x[3] = bfhi(w.y); x[4] = bflo(w.z); x[5] = bfhi(w.z); x[6] = bflo(w.w); x[7] = bfhi(w.w); }

__device__ __forceinline__ void ret_unit(Frame& F, int b, int h, int rq) {
    int tid_ = threadIdx.x; asm volatile("" : "+v"(tid_));
    const int tid = tid_, lane = tid & 63, wid = __builtin_amdgcn_readfirstlane(tid >> 6), r = lane & 31, h2 = lane >> 5;
    const float l2g = log2f(1.0f - exp2f(-5.0f - (float)h));
    const float chunk_dec = exp2f(l2g * 128.0f);
    LAS bf16* Qs = (LAS bf16*)(F.lds + RING_OFF + R_QS); LAS bf16* Ks = (LAS bf16*)(F.lds + RING_OFF + R_KS); LAS bf16* KdT = (LAS bf16*)(F.lds + RING_OFF + R_KDT);
    LAS bf16* VT = (LAS bf16*)(F.lds + RING_OFF + R_VT); LAS bf16* Ss = (LAS bf16*)(F.lds + RING_OFF + R_SS); LAS bf16* ST = (LAS bf16*)(F.lds + RING_OFF + R_ST);
    LAS float* Os = (LAS float*)(F.lds + RING_OFF + R_OS);
    const bf16* RQ = (const bf16*)(F.ws + WS_RQ); const bf16* RK = (const bf16*)(F.ws + WS_RK); const bf16* RV = (const bf16*)(F.ws + WS_RV); const bf16* RG = (const bf16*)(F.ws + WS_RG); bf16* YB = (bf16*)(F.ws + WS_YB);
    const size_t rb = (size_t)b * SEQ;
    __syncthreads();
    for (int i = tid; i < 128 * RP64 / 2; i += NWAVES * 64) ((LAS unsigned*)ST)[i] = 0u;
    f32x16_t st = {0.f, 0.f, 0.f, 0.f, 0.f, 0.f, 0.f, 0.f, 0.f, 0.f, 0.f, 0.f, 0.f, 0.f, 0.f, 0.f};
    const int sj = tid & 127, cq = tid >> 7, qi = tid & 31, qc = tid >> 5, gi = tid >> 4, gs = tid & 15;
    v4u qreg = {0u, 0u, 0u, 0u}, kreg[2], vreg[4], greg;
#define RET_LOAD(n) do { const size_t r0_ = rb + (size_t)(n) * 128; \
        if (tid < 256) qreg = *(const v4u*)(RQ + (r0_ + 32 * rq + qi) * 256 + h * 64 + 8 * qc); \
        _Pragma("unroll") for (int c_ = 0; c_ < 2; ++c_) kreg[c_] = *(const v4u*)(RK + (r0_ + sj) * 256 + h * 64 + 16 * cq + 8 * c_); \
        _Pragma("unroll") for (int c_ = 0; c_ < 4; ++c_) vreg[c_] = *(const v4u*)(RV + (r0_ + sj) * 512 + h * 128 + 32 * cq + 8 * c_); \
        greg = *(const v4u*)(RG + (r0_ + 32 * rq + gi) * 512 + h * 128 + 8 * gs); } while (0)
    RET_LOAD(0);
    const float kdec = exp2f(l2g * (float)(127 - sj));
#pragma unroll 1
    for (int n = 0; n < 16; ++n) {
        if (tid < 256) *(LAS v4u*)(Qs + qi * RP64 + 8 * qc) = qreg;
#pragma unroll
        for (int c = 0; c < 2; ++c) { *(LAS v4u*)(Ks + sj * RP64 + 16 * cq + 8 * c) = kreg[c]; float x[8]; unpack8(kreg[c], x);
#pragma unroll
            for (int e = 0; e < 8; ++e) KdT[(16 * cq + 8 * c + e) * RP128 + sj] = (bf16)f2bf(x[e] * kdec); }
#pragma unroll
        for (int c = 0; c < 4; ++c) { const v4u w = vreg[c]; const unsigned ww[4] = {w.x, w.y, w.z, w.w};
#pragma unroll
            for (int e = 0; e < 8; ++e) VT[(32 * cq + 8 * c + e) * RP128 + sj] = (bf16)((e & 1) ? (ww[e >> 1] >> 16) : (ww[e >> 1] & 0xffffu)); }
        const v4u gcur = greg;
        LDS_WAIT(); __syncthreads();
        if (n + 1 < 16) RET_LOAD(n + 1);
        f32x16_t x = {0.f, 0.f, 0.f, 0.f, 0.f, 0.f, 0.f, 0.f, 0.f, 0.f, 0.f, 0.f, 0.f, 0.f, 0.f, 0.f};
        if (wid < 4) {
#pragma unroll
            for (int kk = 0; kk < 4; ++kk) x = MFMA32(ldfrag(Qs, r, RP64, kk, h2), ldfrag(Ks, 32 * wid + r, RP64, kk, h2), x);
            const int jabs = 32 * wid + r;
#pragma unroll
            for (int reg = 0; reg < 16; ++reg) { const int i = crow32(reg, h2), diff = 32 * rq + i - jabs;
                const float val = diff >= 0 ? x[reg] * exp2f(l2g * (float)diff) : 0.f; Ss[i * RP128 + jabs] = (bf16)f2bf(val); }
        } else {
#pragma unroll
            for (int kk = 0; kk < 4; ++kk) x = MFMA32(ldfrag(Qs, r, RP64, kk, h2), ldfrag(ST, 32 * (wid - 4) + r, RP64, kk, h2), x);
#pragma unroll
            for (int reg = 0; reg < 16; ++reg) x[reg] *= exp2f(l2g * (float)(32 * rq + crow32(reg, h2) + 1));
        }
        { const int db = wid >> 2, vb2 = wid & 3;
#pragma unroll
          for (int reg = 0; reg < 16; ++reg) st[reg] *= chunk_dec;
#pragma unroll
          for (int kk = 0; kk < 8; ++kk) st = MFMA32(ldfrag(KdT, 32 * db + r, RP128, kk, h2), ldfrag(VT, 32 * vb2 + r, RP128, kk, h2), st); }
        LDS_WAIT(); __syncthreads();
        { const int db = wid >> 2, vb2 = wid & 3;
#pragma unroll
          for (int g = 0; g < 4; ++g) { v2u w; w.x = pk2(st[4 * g], st[4 * g + 1]); w.y = pk2(st[4 * g + 2], st[4 * g + 3]); *(LAS v2u*)(ST + (32 * vb2 + r) * RP64 + 32 * db + 8 * g + 4 * h2) = w; } }
        if (wid >= 4) {
#pragma unroll
            for (int kk = 0; kk < 8; ++kk) x = MFMA32(ldfrag(Ss, r, RP128, kk, h2), ldfrag(VT, 32 * (wid - 4) + r, RP128, kk, h2), x);
#pragma unroll
            for (int reg = 0; reg < 16; ++reg) Os[crow32(reg, h2) * 132 + 32 * (wid - 4) + r] = x[reg];
        }
        LDS_WAIT(); __syncthreads();
        { const f32x4 a0 = *(const LAS f32x4*)(Os + gi * 132 + 8 * gs), a1 = *(const LAS f32x4*)(Os + gi * 132 + 8 * gs + 4);
          float sm = (a0.x + a0.y) + (a0.z + a0.w) + (a1.x + a1.y) + (a1.z + a1.w);
#pragma unroll
          for (int o = 1; o < 16; o <<= 1) sm += __shfl_xor(sm, o);
          const float mean = sm * (1.f / 128.f); const f32x4 d0 = a0 - mean, d1 = a1 - mean;
          float sq = (d0.x * d0.x + d0.y * d0.y) + (d0.z * d0.z + d0.w * d0.w) + (d1.x * d1.x + d1.y * d1.y) + (d1.z * d1.z + d1.w * d1.w);
#pragma unroll
          for (int o = 1; o < 16; o <<= 1) sq += __shfl_xor(sq, o);
          const float rstd = 1.f / sqrtf(sq * (1.f / 128.f) + GN_EPS); float gt[8]; unpack8(gcur, gt);
          v4u w; w.x = pk2(gt[0] * d0.x * rstd, gt[1] * d0.y * rstd); w.y = pk2(gt[2] * d0.z * rstd, gt[3] * d0.w * rstd); w.z = pk2(gt[4] * d1.x * rstd, gt[5] * d1.y * rstd); w.w = pk2(gt[6] * d1.z * rstd, gt[7] * d1.w * rstd);
          *(v4u*)(YB + (rb + (size_t)n * 128 + 32 * rq + gi) * 1536 + h * 128 + 8 * gs) = w; }
    }
#undef RET_LOAD
    __syncthreads();
}


#define MFMA16(a, b, c) __builtin_amdgcn_mfma_f32_16x16x32_bf16((a), (b), (c), 0, 0, 0)
__device__ __forceinline__ bf16x8_t ldfrag16(const LAS bf16* base, int row, int pitch, int ks, int q4) { return *(const LAS bf16x8_t*)(base + row * pitch + 32 * ks + 8 * q4); }
__device__ __forceinline__ void ret_kv_unit(Frame& F, int b, int h, int n) {
    int tid_ = threadIdx.x; asm volatile("" : "+v"(tid_));
    const int tid = tid_, lane = tid & 63, wid = __builtin_amdgcn_readfirstlane(tid >> 6), r = lane & 31, h2 = lane >> 5;
    const float l2g = log2f(1.0f - exp2f(-5.0f - (float)h));
    LAS bf16* KdT = (LAS bf16*)(F.lds + RING_OFF); LAS bf16* VT = (LAS bf16*)(F.lds + RING_OFF + 17408);
    const bf16* RK = (const bf16*)(F.ws + WS_RK); const bf16* RV = (const bf16*)(F.ws + WS_RV);
    const size_t r0 = (size_t)b * SEQ + (size_t)n * 128;
    const int sj = tid & 127, cq = tid >> 7; const float kdec = exp2f(l2g * (float)(127 - sj));
    v4u kreg[2], vreg[4];
#pragma unroll
    for (int c = 0; c < 2; ++c) kreg[c] = *(const v4u*)(RK + (r0 + sj) * 256 + h * 64 + 16 * cq + 8 * c);
#pragma unroll
    for (int c = 0; c < 4; ++c) vreg[c] = *(const v4u*)(RV + (r0 + sj) * 512 + h * 128 + 32 * cq + 8 * c);
    __syncthreads();
#pragma unroll
    for (int c = 0; c < 2; ++c) { float x[8]; unpack8(kreg[c], x);
#pragma unroll
        for (int e = 0; e < 8; ++e) KdT[(16 * cq + 8 * c + e) * RP128 + sj] = (bf16)f2bf(x[e] * kdec); }
#pragma unroll
    for (int c = 0; c < 4; ++c) { const v4u w = vreg[c]; const unsigned ww[4] = {w.x, w.y, w.z, w.w};
#pragma unroll
        for (int e = 0; e < 8; ++e) VT[(32 * cq + 8 * c + e) * RP128 + sj] = (bf16)((e & 1) ? (ww[e >> 1] >> 16) : (ww[e >> 1] & 0xffffu)); }
    LDS_WAIT(); __syncthreads();
    const int db = wid >> 2, vb = wid & 3;
    f32x16_t st = {0.f, 0.f, 0.f, 0.f, 0.f, 0.f, 0.f, 0.f, 0.f, 0.f, 0.f, 0.f, 0.f, 0.f, 0.f, 0.f};
#pragma unroll
    for (int kk = 0; kk < 8; ++kk) st = MFMA32(ldfrag(KdT, 32 * db + r, RP128, kk, h2), ldfrag(VT, 32 * vb + r, RP128, kk, h2), st);
    float* KV = (float*)(F.ws + WS_KV) + ((size_t)((b * 4 + h) * 16 + n)) * 8192;
#pragma unroll
    for (int reg = 0; reg < 16; ++reg) KV[(32 * db + crow32(reg, h2)) * 128 + 32 * vb + r] = st[reg];
    __syncthreads();
}
constexpr int RB_QS = 0, RB_KS = 18432, RB_VT = 36864, RB_ST = 71680, RB_SW = 90112, RB_END = 124928;
static_assert(RB_END <= RING_BYTES, "retention pass B LDS map");
__device__ __forceinline__ void ret_out_unit(Frame& F, int b, int h, int n) {
    int tid_ = threadIdx.x; asm volatile("" : "+v"(tid_));
    const int tid = tid_, lane = tid & 63, wid = __builtin_amdgcn_readfirstlane(tid >> 6), l15 = lane & 15, q4 = lane >> 4;
    const float l2g = log2f(1.0f - exp2f(-5.0f - (float)h));
    const float chunk_dec = exp2f(l2g * 128.0f);
    LAS bf16* Qs = (LAS bf16*)(F.lds + RING_OFF + RB_QS); LAS bf16* Ks = (LAS bf16*)(F.lds + RING_OFF + RB_KS); LAS bf16* VT = (LAS bf16*)(F.lds + RING_OFF + RB_VT);
    LAS bf16* ST = (LAS bf16*)(F.lds + RING_OFF + RB_ST); LAS bf16* Sw = (LAS bf16*)(F.lds + RING_OFF + RB_SW) + wid * (16 * RP128);
    const bf16* RQ = (const bf16*)(F.ws + WS_RQ); const bf16* RK = (const bf16*)(F.ws + WS_RK); const bf16* RV = (const bf16*)(F.ws + WS_RV); const bf16* RG = (const bf16*)(F.ws + WS_RG); bf16* YB = (bf16*)(F.ws + WS_YB);
    const size_t r0 = (size_t)b * SEQ + (size_t)n * 128;
    const int sj = tid & 127, cq = tid >> 7;
    v4u qreg[2], kreg[2], vreg[4];
#pragma unroll
    for (int c = 0; c < 2; ++c) { qreg[c] = *(const v4u*)(RQ + (r0 + sj) * 256 + h * 64 + 16 * cq + 8 * c); kreg[c] = *(const v4u*)(RK + (r0 + sj) * 256 + h * 64 + 16 * cq + 8 * c); }
#pragma unroll
    for (int c = 0; c < 4; ++c) vreg[c] = *(const v4u*)(RV + (r0 + sj) * 512 + h * 128 + 32 * cq + 8 * c);
    f32x4 sa[4] = {{0.f, 0.f, 0.f, 0.f}, {0.f, 0.f, 0.f, 0.f}, {0.f, 0.f, 0.f, 0.f}, {0.f, 0.f, 0.f, 0.f}};
    { const float* KV = (const float*)(F.ws + WS_KV) + ((size_t)((b * 4 + h) * 16)) * 8192 + (size_t)tid * 16;
#pragma unroll 4
      for (int m = 0; m < n; ++m) {
#pragma unroll
          for (int c = 0; c < 4; ++c) { const f32x4 kv = *(const f32x4*)(KV + (size_t)m * 8192 + 4 * c); sa[c] = sa[c] * chunk_dec + kv; } } }
    __syncthreads();
    { const int d = tid >> 3, v0 = 16 * (tid & 7);
#pragma unroll
      for (int c = 0; c < 4; ++c)
#pragma unroll
          for (int e = 0; e < 4; ++e) ST[(v0 + 4 * c + e) * RP64 + d] = (bf16)f2bf(sa[c][e]); }
#pragma unroll
    for (int c = 0; c < 2; ++c) { *(LAS v4u*)(Qs + sj * RP64 + 16 * cq + 8 * c) = qreg[c]; *(LAS v4u*)(Ks + sj * RP64 + 16 * cq + 8 * c) = kreg[c]; }
#pragma unroll
    for (int c = 0; c < 4; ++c) { const v4u w = vreg[c]; const unsigned ww[4] = {w.x, w.y, w.z, w.w};
#pragma unroll
        for (int e = 0; e < 8; ++e) VT[(32 * cq + 8 * c + e) * RP128 + sj] = (bf16)((e & 1) ? (ww[e >> 1] >> 16) : (ww[e >> 1] & 0xffffu)); }
    LDS_WAIT(); __syncthreads();
    const int i0 = 16 * wid;
    const bf16x8_t qa0 = ldfrag16(Qs, i0 + l15, RP64, 0, q4), qa1 = ldfrag16(Qs, i0 + l15, RP64, 1, q4);
#pragma unroll 1
    for (int kb = 0; kb <= (wid | 1); kb += 2) {
        f32x4 sc[2];
#pragma unroll
        for (int u = 0; u < 2; ++u) { sc[u] = (f32x4){0.f, 0.f, 0.f, 0.f};
            sc[u] = MFMA16(qa0, ldfrag16(Ks, 16 * (kb + u) + l15, RP64, 0, q4), sc[u]); sc[u] = MFMA16(qa1, ldfrag16(Ks, 16 * (kb + u) + l15, RP64, 1, q4), sc[u]); }
#pragma unroll
        for (int u = 0; u < 2; ++u) { const int j = 16 * (kb + u) + l15;
#pragma unroll
            for (int reg = 0; reg < 4; ++reg) { const int il = 4 * q4 + reg, diff = i0 + il - j; Sw[il * RP128 + j] = (bf16)f2bf(diff >= 0 ? sc[u][reg] * __builtin_amdgcn_exp2f(l2g * (float)diff) : 0.f); } }
    }
    LDS_WAIT();
    float qd[4];
#pragma unroll
    for (int reg = 0; reg < 4; ++reg) qd[reg] = __builtin_amdgcn_exp2f(l2g * (float)(i0 + 4 * q4 + reg + 1));
    f32x4 o[8];
    const int nks = (wid + 2) >> 1;
#pragma unroll
    for (int vb = 0; vb < 8; ++vb) {
        f32x4 x = {0.f, 0.f, 0.f, 0.f};
        x = MFMA16(qa0, ldfrag16(ST, 16 * vb + l15, RP64, 0, q4), x); x = MFMA16(qa1, ldfrag16(ST, 16 * vb + l15, RP64, 1, q4), x);
#pragma unroll
        for (int reg = 0; reg < 4; ++reg) x[reg] *= qd[reg];
        o[vb] = x;
    }
#pragma unroll 1
    for (int ks = 0; ks < nks; ++ks) {
        const bf16x8_t a = ldfrag16(Sw, l15, RP128, ks, q4);
#pragma unroll
        for (int vb = 0; vb < 8; ++vb) o[vb] = MFMA16(a, ldfrag16(VT, 16 * vb + l15, RP128, ks, q4), o[vb]);
    }
    float mean[4], rstd[4];
#pragma unroll
    for (int reg = 0; reg < 4; ++reg) { float sm = 0.f;
#pragma unroll
        for (int vb = 0; vb < 8; ++vb) sm += o[vb][reg];
#pragma unroll
        for (int of = 1; of < 16; of <<= 1) sm += __shfl_xor(sm, of);
        mean[reg] = sm * (1.f / 128.f); float sq = 0.f;
#pragma unroll
        for (int vb = 0; vb < 8; ++vb) { const float d = o[vb][reg] - mean[reg]; sq += d * d; }
#pragma unroll
        for (int of = 1; of < 16; of <<= 1) sq += __shfl_xor(sq, of);
        rstd[reg] = 1.f / sqrtf(sq * (1.f / 128.f) + GN_EPS); }
#pragma unroll
    for (int vb = 0; vb < 8; ++vb)
#pragma unroll
        for (int reg = 0; reg < 4; ++reg) Sw[(4 * q4 + reg) * RP128 + 16 * vb + l15] = (bf16)f2bf((o[vb][reg] - mean[reg]) * rstd[reg]);
    LDS_WAIT();
#pragma unroll
    for (int c = 0; c < 4; ++c) { const int ch = c * 64 + lane, row = ch >> 4, cc = ch & 15;
        float xn[8], gt[8]; unpack8(*(const LAS v4u*)(Sw + row * RP128 + 8 * cc), xn); unpack8(*(const v4u*)(RG + (r0 + i0 + row) * 512 + h * 128 + 8 * cc), gt);
        v4u w; w.x = pk2(xn[0] * gt[0], xn[1] * gt[1]); w.y = pk2(xn[2] * gt[2], xn[3] * gt[3]); w.z = pk2(xn[4] * gt[4], xn[5] * gt[5]); w.w = pk2(xn[6] * gt[6], xn[7] * gt[7]);
        *(v4u*)(YB + (r0 + i0 + row) * 1536 + h * 128 + 8 * cc) = w; }
    __syncthreads();
}

constexpr int G_WS = 0, G_VNT = 34816, G_STAT = 69632, G_END = 70656;
__device__ __forceinline__ void gmlp_unit(Frame& F, int b, int n, int g, const float* w_s, const float* b_s, const float* lng, const float* lnb) {
    int tid_ = threadIdx.x; asm volatile("" : "+v"(tid_));
    const int tid = tid_, lane = tid & 63, wid = __builtin_amdgcn_readfirstlane(tid >> 6), r = lane & 31, h2 = lane >> 5;
    const bf16* GU = (const bf16*)(F.ws + WS_GU); const bf16* GV = (const bf16*)(F.ws + WS_GV); bf16* YB = (bf16*)(F.ws + WS_YB);
    LAS bf16* Ws = (LAS bf16*)(F.lds + RING_OFF + G_WS); LAS bf16* VnT = (LAS bf16*)(F.lds + RING_OFF + G_VNT); LAS float* stt = (LAS float*)(F.lds + RING_OFF + G_STAT);
    const size_t r0 = (size_t)b * SEQ + (size_t)n * 128;
    __syncthreads();
    for (int rr = wid; rr < 128; rr += NWAVES) {
        float x[8]; unpack8(*((const v4u*)(GV + (r0 + rr) * 512) + lane), x);
        float s = 0.f;
#pragma unroll
        for (int j = 0; j < 8; ++j) s += x[j];
        const float mean = wave_sum(s) * (1.f / 512.f); float s2 = 0.f;
#pragma unroll
        for (int j = 0; j < 8; ++j) { const float d = x[j] - mean; s2 += d * d; }
        const float rstd = 1.f / sqrtf(wave_sum(s2) * (1.f / 512.f) + LN_EPS);
        if (lane == 0) { stt[2 * rr] = mean; stt[2 * rr + 1] = rstd; }
    }
    { const int i = tid >> 2, jq = tid & 3; const float* wr = w_s + ((size_t)g * 128 + i) * 128 + 32 * jq;
#pragma unroll
      for (int c = 0; c < 4; ++c) { const f32x4 a = *(const f32x4*)(wr + 8 * c), bq = *(const f32x4*)(wr + 8 * c + 4); const int j0 = 32 * jq + 8 * c;
          v4u w; w.x = pk2(j0 + 0 <= i ? a.x : 0.f, j0 + 1 <= i ? a.y : 0.f); w.y = pk2(j0 + 2 <= i ? a.z : 0.f, j0 + 3 <= i ? a.w : 0.f);
          w.z = pk2(j0 + 4 <= i ? bq.x : 0.f, j0 + 5 <= i ? bq.y : 0.f); w.w = pk2(j0 + 6 <= i ? bq.z : 0.f, j0 + 7 <= i ? bq.w : 0.f);
          *(LAS v4u*)(Ws + i * RP128 + j0) = w; } }
    LDS_WAIT(); __syncthreads();
    { const int sj = tid & 127, cq = tid >> 7; const float mu = stt[2 * sj], rs = stt[2 * sj + 1];
#pragma unroll
      for (int c = 0; c < 4; ++c) { float x[8]; unpack8(*(const v4u*)(GV + (r0 + sj) * 512 + g * 128 + 32 * cq + 8 * c), x);
          const f32x4 ga = *(const f32x4*)(lng + g * 128 + 32 * cq + 8 * c), gb = *(const f32x4*)(lng + g * 128 + 32 * cq + 8 * c + 4);
          const f32x4 ba = *(const f32x4*)(lnb + g * 128 + 32 * cq + 8 * c), bb = *(const f32x4*)(lnb + g * 128 + 32 * cq + 8 * c + 4);
          const float gm[8] = {ga.x, ga.y, ga.z, ga.w, gb.x, gb.y, gb.z, gb.w}, bt[8] = {ba.x, ba.y, ba.z, ba.w, bb.x, bb.y, bb.z, bb.w};
#pragma unroll
          for (int e = 0; e < 8; ++e) VnT[(32 * cq + 8 * c + e) * RP128 + sj] = (bf16)f2bf((x[e] - mu) * rs * gm[e] + bt[e]); } }
    LDS_WAIT(); __syncthreads();
    { const int ib = wid >> 1;
#pragma unroll
      for (int cc = 0; cc < 2; ++cc) { const int cb = 2 * (wid & 1) + cc;
          f32x16_t x = {0.f, 0.f, 0.f, 0.f, 0.f, 0.f, 0.f, 0.f, 0.f, 0.f, 0.f, 0.f, 0.f, 0.f, 0.f, 0.f};
#pragma unroll
          for (int kk = 0; kk < 8; ++kk) x = MFMA32(ldfrag(Ws, 32 * ib + r, RP128, kk, h2), ldfrag(VnT, 32 * cb + r, RP128, kk, h2), x);
          const int c = g * 128 + 32 * cb + r;
#pragma unroll
          for (int reg = 0; reg < 16; ++reg) { const int i = 32 * ib + crow32(reg, h2); const float sp = x[reg] + b_s[g * 128 + i];
              YB[(r0 + i) * 1536 + 1024 + c] = (bf16)f2bf(bf2f(GU[(r0 + i) * 512 + c]) * sp); } } }
    __syncthreads();
}


__device__ __forceinline__ void gmlp_stat_unit(Frame& F, int b, int n) {
    int tid_ = threadIdx.x; asm volatile("" : "+v"(tid_));
    const int tid = tid_, row = tid >> 2, qt = tid & 3;
    const bf16* GV = (const bf16*)(F.ws + WS_GV); float* GST = (float*)(F.ws + WS_GST);
    const size_t r = (size_t)b * SEQ + (size_t)n * 128 + row;
    v4u w[16];
#pragma unroll
    for (int c = 0; c < 16; ++c) w[c] = *(const v4u*)(GV + r * 512 + 128 * qt + 8 * c);
    float s = 0.f;
#pragma unroll
    for (int c = 0; c < 16; ++c) { float x[8]; unpack8(w[c], x); s += ((x[0] + x[1]) + (x[2] + x[3])) + ((x[4] + x[5]) + (x[6] + x[7])); }
    s += __shfl_xor(s, 1); s += __shfl_xor(s, 2);
    const float mean = s * (1.f / 512.f); float s2 = 0.f;
#pragma unroll
    for (int c = 0; c < 16; ++c) { float x[8]; unpack8(w[c], x);
#pragma unroll
        for (int e = 0; e < 8; ++e) { const float d = x[e] - mean; s2 += d * d; } }
    s2 += __shfl_xor(s2, 1); s2 += __shfl_xor(s2, 2);
    if (qt == 0) { GST[2 * r] = mean; GST[2 * r + 1] = 1.f / sqrtf(s2 * (1.f / 512.f) + LN_EPS); }
}
constexpr int G2_WS = 0, G2_VNT = 34816, G2_SW = 69632, G2_END = 104448;
__device__ __forceinline__ void gmlp_unit2(Frame& F, int b, int n, int g, const float* w_s, const float* b_s, const float* lng, const float* lnb) {
    int tid_ = threadIdx.x; asm volatile("" : "+v"(tid_));
    const int tid = tid_, lane = tid & 63, wid = __builtin_amdgcn_readfirstlane(tid >> 6), l15 = lane & 15, q4 = lane >> 4;
    const bf16* GU = (const bf16*)(F.ws + WS_GU); const bf16* GV = (const bf16*)(F.ws + WS_GV); bf16* YB = (bf16*)(F.ws + WS_YB); const float* GST = (const float*)(F.ws + WS_GST);
    LAS bf16* Ws = (LAS bf16*)(F.lds + RING_OFF + G2_WS); LAS bf16* VnT = (LAS bf16*)(F.lds + RING_OFF + G2_VNT); LAS bf16* Sw = (LAS bf16*)(F.lds + RING_OFF + G2_SW) + wid * (16 * RP128);
    const size_t r0 = (size_t)b * SEQ + (size_t)n * 128;
    const int sj = tid & 127, cq = tid >> 7, wi = tid >> 2, jq = tid & 3;
    v4u vreg[4]; f32x4 wreg[8];
#pragma unroll
    for (int c = 0; c < 4; ++c) vreg[c] = *(const v4u*)(GV + (r0 + sj) * 512 + g * 128 + 32 * cq + 8 * c);
    const float mu = GST[2 * (r0 + sj)], rs = GST[2 * (r0 + sj) + 1];
    { const float* wr = w_s + ((size_t)g * 128 + wi) * 128 + 32 * jq;
#pragma unroll
      for (int c = 0; c < 8; ++c) wreg[c] = *(const f32x4*)(wr + 4 * c); }
    __syncthreads();
#pragma unroll
    for (int c = 0; c < 4; ++c) { const int j0 = 32 * jq + 8 * c; const f32x4 a = wreg[2 * c], bq = wreg[2 * c + 1];
        v4u w; w.x = pk2(j0 + 0 <= wi ? a.x : 0.f, j0 + 1 <= wi ? a.y : 0.f); w.y = pk2(j0 + 2 <= wi ? a.z : 0.f, j0 + 3 <= wi ? a.w : 0.f);
        w.z = pk2(j0 + 4 <= wi ? bq.x : 0.f, j0 + 5 <= wi ? bq.y : 0.f); w.w = pk2(j0 + 6 <= wi ? bq.z : 0.f, j0 + 7 <= wi ? bq.w : 0.f);
        *(LAS v4u*)(Ws + wi * RP128 + j0) = w; }
#pragma unroll
    for (int c = 0; c < 4; ++c) { float x[8]; unpack8(vreg[c], x);
        const f32x4 ga = *(const f32x4*)(lng + g * 128 + 32 * cq + 8 * c), gb = *(const f32x4*)(lng + g * 128 + 32 * cq + 8 * c + 4);
        const f32x4 ba = *(const f32x4*)(lnb + g * 128 + 32 * cq + 8 * c), bb = *(const f32x4*)(lnb + g * 128 + 32 * cq + 8 * c + 4);
        const float gm[8] = {ga.x, ga.y, ga.z, ga.w, gb.x, gb.y, gb.z, gb.w}, bt[8] = {ba.x, ba.y, ba.z, ba.w, bb.x, bb.y, bb.z, bb.w};
#pragma unroll
        for (int e = 0; e < 8; ++e) VnT[(32 * cq + 8 * c + e) * RP128 + sj] = (bf16)f2bf((x[e] - mu) * rs * gm[e] + bt[e]); }
    LDS_WAIT(); __syncthreads();
    const int i0 = 16 * wid, nks = (wid + 2) >> 1;
    float bs[4];
#pragma unroll
    for (int reg = 0; reg < 4; ++reg) bs[reg] = b_s[g * 128 + i0 + 4 * q4 + reg];
    { f32x4 x[8];
#pragma unroll
      for (int cb = 0; cb < 8; ++cb) x[cb] = (f32x4){0.f, 0.f, 0.f, 0.f};
#pragma unroll 1
      for (int ks = 0; ks < nks; ++ks) {
          const bf16x8_t a = ldfrag16(Ws, i0 + l15, RP128, ks, q4);
#pragma unroll
          for (int cb = 0; cb < 8; ++cb) x[cb] = MFMA16(a, ldfrag16(VnT, 16 * cb + l15, RP128, ks, q4), x[cb]);
      }
#pragma unroll
      for (int cb = 0; cb < 8; ++cb)
#pragma unroll
          for (int reg = 0; reg < 4; ++reg) Sw[(4 * q4 + reg) * RP128 + 16 * cb + l15] = (bf16)f2bf(x[cb][reg] + bs[reg]);
    }
    LDS_WAIT();
#pragma unroll
    for (int c = 0; c < 4; ++c) { const int ch = c * 64 + lane, row = ch >> 4, cc = ch & 15;
        float sp[8], gu[8]; unpack8(*(const LAS v4u*)(Sw + row * RP128 + 8 * cc), sp); unpack8(*(const v4u*)(GU + (r0 + i0 + row) * 512 + g * 128 + 8 * cc), gu);
        v4u w; w.x = pk2(sp[0] * gu[0], sp[1] * gu[1]); w.y = pk2(sp[2] * gu[2], sp[3] * gu[3]); w.z = pk2(sp[4] * gu[4], sp[5] * gu[5]); w.w = pk2(sp[6] * gu[6], sp[7] * gu[7]);
        *(v4u*)(YB + (r0 + i0 + row) * 1536 + 1024 + g * 128 + 8 * cc) = w; }
    __syncthreads();
}


constexpr int GP_WS = 0, GP_VNT = 69632;
__device__ __forceinline__ void gmlp_pair(Frame& F, int b, int n, int g0, const float* w_s, const float* b_s, const float* lng, const float* lnb) {
    int tid_ = threadIdx.x; asm volatile("" : "+v"(tid_));
    const int tid = tid_, lane = tid & 63, wid = __builtin_amdgcn_readfirstlane(tid >> 6), l15 = lane & 15, q4 = lane >> 4;
    const bf16* GU = (const bf16*)(F.ws + WS_GU); const bf16* GV = (const bf16*)(F.ws + WS_GV); bf16* YB = (bf16*)(F.ws + WS_YB); const float* GST = (const float*)(F.ws + WS_GST);
    LAS bf16* WsB = (LAS bf16*)(F.lds + RING_OFF + GP_WS); LAS bf16* VnTB = (LAS bf16*)(F.lds + RING_OFF + GP_VNT);
    const size_t r0 = (size_t)b * SEQ + (size_t)n * 128;
    const int sj = tid & 127, cq = tid >> 7, wi = tid >> 2, jq = tid & 3;
    v4u vreg[2][4]; f32x4 wreg[2][8];
#pragma unroll
    for (int u = 0; u < 2; ++u)
#pragma unroll
        for (int c = 0; c < 4; ++c) vreg[u][c] = *(const v4u*)(GV + (r0 + sj) * 512 + (g0 + u) * 128 + 32 * cq + 8 * c);
    const float mu = GST[2 * (r0 + sj)], rs = GST[2 * (r0 + sj) + 1];
#pragma unroll
    for (int u = 0; u < 2; ++u) { const float* wr = w_s + ((size_t)(g0 + u) * 128 + wi) * 128 + 32 * jq;
#pragma unroll
        for (int c = 0; c < 8; ++c) wreg[u][c] = *(const f32x4*)(wr + 4 * c); }
    __syncthreads();
#pragma unroll
    for (int u = 0; u < 2; ++u) { const int g = g0 + u; LAS bf16* Ws = WsB + u * (128 * RP128); LAS bf16* VnT = VnTB + u * (128 * RP128);
#pragma unroll
        for (int c = 0; c < 4; ++c) { const int j0 = 32 * jq + 8 * c; const f32x4 a = wreg[u][2 * c], bq = wreg[u][2 * c + 1];
            v4u w; w.x = pk2(j0 + 0 <= wi ? a.x : 0.f, j0 + 1 <= wi ? a.y : 0.f); w.y = pk2(j0 + 2 <= wi ? a.z : 0.f, j0 + 3 <= wi ? a.w : 0.f);
            w.z = pk2(j0 + 4 <= wi ? bq.x : 0.f, j0 + 5 <= wi ? bq.y : 0.f); w.w = pk2(j0 + 6 <= wi ? bq.z : 0.f, j0 + 7 <= wi ? bq.w : 0.f);
            *(LAS v4u*)(Ws + wi * RP128 + j0) = w; }
#pragma unroll
        for (int c = 0; c < 4; ++c) { float x[8]; unpack8(vreg[u][c], x);
            const f32x4 ga = *(const f32x4*)(lng + g * 128 + 32 * cq + 8 * c), gb = *(const f32x4*)(lng + g * 128 + 32 * cq + 8 * c + 4);
            const f32x4 ba = *(const f32x4*)(lnb + g * 128 + 32 * cq + 8 * c), bb = *(const f32x4*)(lnb + g * 128 + 32 * cq + 8 * c + 4);
            const float gm[8] = {ga.x, ga.y, ga.z, ga.w, gb.x, gb.y, gb.z, gb.w}, bt[8] = {ba.x, ba.y, ba.z, ba.w, bb.x, bb.y, bb.z, bb.w};
#pragma unroll
            for (int e = 0; e < 8; ++e) VnT[(32 * cq + 8 * c + e) * RP128 + sj] = (bf16)f2bf((x[e] - mu) * rs * gm[e] + bt[e]); }
    }
    LDS_WAIT(); __syncthreads();
    const int i0 = 16 * wid, nks = (wid + 2) >> 1;
#pragma unroll
    for (int u = 0; u < 2; ++u) { const int g = g0 + u; LAS bf16* Ws = WsB + u * (128 * RP128); LAS bf16* VnT = VnTB + u * (128 * RP128); LAS bf16* Sw = Ws + i0 * RP128;
        float bs[4];
#pragma unroll
        for (int reg = 0; reg < 4; ++reg) bs[reg] = b_s[g * 128 + i0 + 4 * q4 + reg];
        v4u gur[4];
#pragma unroll
        for (int c = 0; c < 4; ++c) { const int ch = c * 64 + lane, row = ch >> 4, cc = ch & 15; gur[c] = *(const v4u*)(GU + (r0 + i0 + row) * 512 + g * 128 + 8 * cc); }
        f32x4 x[8];
#pragma unroll
        for (int cb = 0; cb < 8; ++cb) x[cb] = (f32x4){0.f, 0.f, 0.f, 0.f};
#pragma unroll 1
        for (int ks = 0; ks < nks; ++ks) {
            const bf16x8_t a = ldfrag16(Ws, i0 + l15, RP128, ks, q4);
#pragma unroll
            for (int cb = 0; cb < 8; ++cb) x[cb] = MFMA16(a, ldfrag16(VnT, 16 * cb + l15, RP128, ks, q4), x[cb]);
        }
#pragma unroll
        for (int cb = 0; cb < 8; ++cb)
#pragma unroll
            for (int reg = 0; reg < 4; ++reg) Sw[(4 * q4 + reg) * RP128 + 16 * cb + l15] = (bf16)f2bf(x[cb][reg] + bs[reg]);
        LDS_WAIT();
#pragma unroll
        for (int c = 0; c < 4; ++c) { const int ch = c * 64 + lane, row = ch >> 4, cc = ch & 15;
            float sp[8], gu[8]; unpack8(*(const LAS v4u*)(Sw + row * RP128 + 8 * cc), sp); unpack8(gur[c], gu);
            v4u w; w.x = pk2(sp[0] * gu[0], sp[1] * gu[1]); w.y = pk2(sp[2] * gu[2], sp[3] * gu[3]); w.z = pk2(sp[4] * gu[4], sp[5] * gu[5]); w.w = pk2(sp[6] * gu[6], sp[7] * gu[7]);
            *(v4u*)(YB + (r0 + i0 + row) * 1536 + 1024 + g * 128 + 8 * cc) = w; }
    }
    __syncthreads();
}


__device__ __forceinline__ void moe_tail_unit(Frame& F, const MoeTiles& mt, int e, int rb, int cb) {
    int cnt, t0; mt.expert(e, cnt, t0);
    const int re = cnt & 255, nfull = cnt >> 8;
    if (64 * rb >= re) return;
    int tid_ = threadIdx.x; asm volatile("" : "+v"(tid_));
    const int tid = tid_, lane = tid & 63, wid = __builtin_amdgcn_readfirstlane(tid >> 6), l15 = lane & 15, q4 = lane >> 4;
    const int rl = 16 * (wid & 3), cl = 64 * (wid >> 2), srow = tid >> 3, sch = tid & 7;
    const unsigned char* Ag = (const unsigned char*)(F.ws + WS_HID) + ((size_t)(t0 + nfull) * 256 + 64 * rb + srow) * DFF_E + 16 * sch;
    const unsigned char* Bg = (const unsigned char*)(F.ws + WS_WMD) + ((size_t)e * 1024 + 128 * cb + srow) * DFF_E + 16 * sch;
    constexpr int TP = 272;
    LAS unsigned char* As = F.lds + RING_OFF; LAS unsigned char* Bs = F.lds + RING_OFF + 2 * 64 * TP;
    f32x4 acc[4] = {{0.f, 0.f, 0.f, 0.f}, {0.f, 0.f, 0.f, 0.f}, {0.f, 0.f, 0.f, 0.f}, {0.f, 0.f, 0.f, 0.f}};
    v4u ra[2][2], rbv[2][4];
#define TAIL_LOAD(s_, kt) do { ra[s_][0] = *(const v4u*)(Ag + 256 * (kt)); ra[s_][1] = *(const v4u*)(Ag + 256 * (kt) + 128); rbv[s_][0] = *(const v4u*)(Bg + 256 * (kt)); rbv[s_][1] = *(const v4u*)(Bg + 256 * (kt) + 128); \
        rbv[s_][2] = *(const v4u*)(Bg + (size_t)64 * DFF_E + 256 * (kt)); rbv[s_][3] = *(const v4u*)(Bg + (size_t)64 * DFF_E + 256 * (kt) + 128); } while (0)
#define TAIL_STEP(s_, kt) do { LAS unsigned char* as = As + (s_) * (64 * TP); LAS unsigned char* bs = Bs + (s_) * (128 * TP); \
        *(LAS v4u*)(as + srow * TP + 16 * sch) = ra[s_][0]; *(LAS v4u*)(as + srow * TP + 128 + 16 * sch) = ra[s_][1]; \
        *(LAS v4u*)(bs + srow * TP + 16 * sch) = rbv[s_][0]; *(LAS v4u*)(bs + srow * TP + 128 + 16 * sch) = rbv[s_][1]; \
        *(LAS v4u*)(bs + (srow + 64) * TP + 16 * sch) = rbv[s_][2]; *(LAS v4u*)(bs + (srow + 64) * TP + 128 + 16 * sch) = rbv[s_][3]; \
        LDS_WAIT(); __syncthreads(); \
        if ((kt) + 2 < DFF_E / 256) TAIL_LOAD(s_, (kt) + 2); \
        _Pragma("unroll") for (int kk = 0; kk < 2; ++kk) { \
            const LAS unsigned char* ap = as + (rl + l15) * TP + 128 * kk + 32 * q4; \
            const pg8::v8i_t a = __builtin_shufflevector(*(const LAS pg8::v4i_t*)ap, *(const LAS pg8::v4i_t*)(ap + 16), 0, 1, 2, 3, 4, 5, 6, 7); \
            _Pragma("unroll") for (int j = 0; j < 4; ++j) { const LAS unsigned char* bp = bs + (cl + 16 * j + l15) * TP + 128 * kk + 32 * q4; \
                const pg8::v8i_t b = __builtin_shufflevector(*(const LAS pg8::v4i_t*)bp, *(const LAS pg8::v4i_t*)(bp + 16), 0, 1, 2, 3, 4, 5, 6, 7); \
                acc[j] = __builtin_amdgcn_mfma_scale_f32_16x16x128_f8f6f4(a, b, acc[j], 0, 0, 0, 0x7f7f7f7f, 0, (int)E8_DN); } } } while (0)
    TAIL_LOAD(0, 0); TAIL_LOAD(1, 1);
    __syncthreads();
#pragma unroll 1
    for (int kt = 0; kt < DFF_E / 256; kt += 2) { TAIL_STEP(0, kt); TAIL_STEP(1, kt + 1); }
    static_assert((DFF_E / 256) % 2 == 0, "even number of K-steps");
#undef TAIL_LOAD
#undef TAIL_STEP
    const unsigned* list = (const unsigned*)(F.ws + WS_LIST); const float* gatew = (const float*)(F.ws + WS_GATEW);
    bf16* c0 = (bf16*)(F.ws + WS_YPRE); bf16* c1 = (bf16*)(F.ws + WS_C1);
#pragma unroll
    for (int reg = 0; reg < 4; ++reg) { const int r = 64 * rb + rl + 4 * q4 + reg;
        if (r < re) { const int slot = nfull * 256 + r; const unsigned ent = list[e * 16384 + slot]; const float g = gatew[e * 16384 + slot];
            bf16* dst = ((ent >> 31) ? c1 : c0) + (size_t)(ent & 0x7fffffffu) * 1024 + 128 * cb + cl + l15;
#pragma unroll
            for (int j = 0; j < 4; ++j) dst[16 * j] = (bf16)f2bf(acc[j][reg] * g); } }
    __syncthreads();
}


constexpr int CV_I_IN = 16 * 112, CV_I_BR = 8 * 16, CV_I_OUT = 16 * 16, CV_I_DU = 16 * 88, CV_I_DD = 44 * 16, CV_I_MU = 16 * 112, CV_I_MD = 56 * 16;
constexpr int CV_I_G8 = 16 * 48;
constexpr int CV_NITEMS = 2 * CV_I_IN + 6 * CV_I_BR + 2 * CV_I_OUT + CV_I_DU + CV_I_DD + 8 * CV_I_MU + 8 * CV_I_MD + ((GATES_FP8 && !P1_I8) ? 2 * CV_I_G8 : 0);
constexpr int CV_MD0 = 8 * CV_I_MU, CV_MD1 = 8 * CV_I_MU + 8 * CV_I_MD;
constexpr int CV_DEFER = 5 * CV_I_MU;
__device__ __forceinline__ void cvt_global_item(Frame& F, int it, LAS float* scr, int lane) {
    int r = it; bool done = false;
#pragma unroll 1
    for (int e = 0; e < 8 && !done; ++e) { CvtJob j{(const float*)(const GAS float*)lds_ptr(F.lds, 15) + (size_t)e * 1024 * 7168, 1024, 7168, 7168, (bf16*)(F.ws + WS_WMU + (size_t)e * 7168 * 1024), 1024, 0, 2, DFF_E, SC_WU8}; done = cvt_run(j, r, scr, lane); }
#pragma unroll 1
    for (int e = 0; e < 8 && !done; ++e) { CvtJob j{(const float*)(const GAS float*)lds_ptr(F.lds, 16) + (size_t)e * 3584 * 1024, 3584, 1024, 1024, (bf16*)(F.ws + WS_WMD + (size_t)e * 1024 * 3584), 3584, 0, 0, 0, SC_WD8}; done = cvt_run(j, r, scr, lane); }
#pragma unroll 1
    for (int l = 0; l < 2 && !done; ++l) { CvtJob j{(const float*)(const GAS float*)lds_ptr(F.lds, 1) + (size_t)l * 1024 * N_INSRC, 1024, N_INSRC, N_INV, (bf16*)(F.ws + WS_WIN) + (size_t)l * N_INV * 1024, 1024, 0, 1, 0, P1_I8 ? -SC_WI8 : 0.f}; done = cvt_run(j, r, scr, lane); }
#pragma unroll 1
    for (int q = 0; q < 6 && !done; ++q) { const int l = q / 3, n = q % 3; CvtJob j{(const float*)(const GAS float*)lds_ptr(F.lds, 8) + (size_t)q * 512 * 1024, 512, 1024, 1024, (bf16*)(F.ws + WS_WBR) + (size_t)l * 1024 * 1536, 1536, n * 512, 0, 0, 0.f}; done = cvt_run(j, r, scr, lane); }
#pragma unroll 1
    for (int l = 0; l < 2 && !done; ++l) { CvtJob j{(const float*)(const GAS float*)lds_ptr(F.lds, 9) + (size_t)l * 1024 * 1024, 1024, 1024, 1024, (bf16*)(F.ws + WS_WOUT) + (size_t)l * 1024 * 1024, 1024, 0, 0, 0, 0.f}; done = cvt_run(j, r, scr, lane); }
    if (!done) { CvtJob j{(const float*)(const GAS float*)lds_ptr(F.lds, 12), 1024, 2 * DFF_D, 2 * DFF_D, (bf16*)(F.ws + WS_WDU), 1024, 0, 2, DFF_D, (DENSE_FP8 == 4) ? -SC_WI8 : (DENSE_FP8 == 1 || DENSE_FP8 == 2) ? SC_WU8 : 0.f}; done = cvt_run(j, r, scr, lane); }
    if (!done) { CvtJob j{(const float*)(const GAS float*)lds_ptr(F.lds, 13), DFF_D, 1024, 1024, (bf16*)(F.ws + WS_WDD), DFF_D, 0, 0, 0, (DENSE_FP8 == 1 || DENSE_FP8 == 3) ? SC_WD8 : 0.f}; done = cvt_run(j, r, scr, lane); }
#if GATES_FP8 && !P1_I8
#pragma unroll 1
    for (int l = 0; l < 2 && !done; ++l) { CvtJob j{(const float*)(const GAS float*)lds_ptr(F.lds, 1) + (size_t)l * 1024 * N_INSRC, 1024, N_INSRC, 3072, (bf16*)(F.ws + WS_WIN8 + (size_t)l * 3072 * 1024), 1024, 0, 1, 0, SC_WU8, 4096}; done = cvt_run(j, r, scr, lane); }
#endif
}

struct Args { const float* in[17]; float* out; unsigned char* ws; int ph_lo, ph_hi; };
constexpr int N_PHASES = 17;

__global__ void __launch_bounds__(NWAVES * 64, 2) mega_fwd(Args args) {
    extern __shared__ __attribute__((aligned(16))) unsigned char lds[];
    Frame F;
    F.lds = (LAS unsigned char*)lds;
    F.MISC = (volatile LAS unsigned*)(F.lds + MISC_OFF);
    F.tid = threadIdx.x; F.lane = F.tid & 63; F.wave = __builtin_amdgcn_readfirstlane(F.tid >> 6);
    F.G = gridDim.x; { const int bx = blockIdx.x; F.vcu = (F.G % 8 == 0) ? (bx % 8) * (F.G / 8) + bx / 8 : bx; }
    F.ws = args.ws; F.ctl = (gu32*)(args.ws + WS_CTL);
    for (int u = F.tid; u < (LDS_BYTES - LDSCTL_OFF) / 4; u += NWAVES * 64) ((LAS unsigned*)(F.lds + LDSCTL_OFF))[u] = 0u;
    __syncthreads();
    XcdBarrier bar = xcd_barrier_post((unsigned*)(F.ctl + CW_BAR), F.MISC + 8, gridDim.x, 0u);
    const bool grp = (F.G == 256);
    XcdBarrier gbar = bar;
    if (grp) gbar = xcd_barrier_post((unsigned*)(F.ctl + CW_BAR) + (1 + (blockIdx.x & 7)) * XCD_BAR_WORDS, F.MISC + 10, 32u, 1u);
#define GRID_BAR() xcd_barrier(bar)
#define GRP_BAR() do { if (grp) xcd_barrier(gbar); else xcd_barrier(bar); } while (0)
    const int lo = args.ph_lo, hi = args.ph_hi;
#ifndef PH_MASK
#define PH_MASK 0x1ff
#endif
#define IN(k) (lo <= (k) && (k) < hi)
#ifndef DUP_PHASE
#define DUP_PHASE (-1)
#endif
#define REPS(k) (((k) == DUP_PHASE) ? 2 : 1)
#ifndef P2DUP
#define P2DUP 0
#endif
#define PHASE_BEGIN() do { int t_ = threadIdx.x; asm volatile("" : "+v"(t_)); F.tid = t_; F.lane = t_ & 63; F.wave = __builtin_amdgcn_readfirstlane(t_ >> 6); } while (0)
#define ON(j) (((PH_MASK) >> (j)) & 1)
#define SEAM(k) do { if (IN(k) && IN((k) + 1)) GRID_BAR(); } while (0)
#define SEAMG(k) do { if (IN(k) && IN((k) + 1)) GRP_BAR(); } while (0)

    if (F.tid == 0) { LAS unsigned long long* pt = (LAS unsigned long long*)(F.lds + PTAB_OFF);
#pragma unroll
        for (int i = 0; i < 17; ++i) pt[i] = (unsigned long long)args.in[i];
        pt[17] = (unsigned long long)args.out; }
    LDS_WAIT(); __syncthreads();
#define INP(k) ((const float*)(const GAS float*)lds_ptr(F.lds, (k)))
    if (ON(0) && IN(0)) { for (int rep_ = 0; rep_ < REPS(0); ++rep_) { PHASE_BEGIN();
        LAS float* scr = (LAS float*)(F.lds + RING_OFF + F.wave * 17408);
        static_assert(NWAVES * 17408 <= RING_BYTES, "conversion tiles fit the phase scratch");
        const int gw = F.vcu * NWAVES + F.wave, NGW = F.G * NWAVES;
        for (int it = CV_DEFER + gw; it < CV_NITEMS - (CV_MD1 - CV_MD0); it += NGW) { const int jt = it < CV_MD0 ? it : it + (CV_MD1 - CV_MD0); cvt_global_item(F, jt, scr, F.lane); }
        __syncthreads();
        { float* cs = (float*)(F.ws + WS_CS);
          for (int i = F.vcu * 512 + F.tid; i < SEQ * 32; i += F.G * 512) { const int pos = i >> 5, d = i & 31;
              const double rev = (double)pos * exp(-(double)d / 32.0 * 9.210340371976184) * 0.15915494309189535; const float fr_ = (float)(rev - floor(rev));
              cs[i] = __builtin_amdgcn_cosf(fr_); cs[65536 + i] = __builtin_amdgcn_sinf(fr_); } }
        p0_rows(F, INP(0), INP(1), INP(2));
    } }
    SEAM(0);

#pragma unroll 1
    for (int l = 0; l < 2; ++l) {
        const int pb = 1 + 8 * l;
        const float* xres = (l == 0) ? INP(0) : ((float*)(F.ws + WS_XF));
        if (ON(1) && IN(pb + 0)) { for (int rep_ = 0; rep_ < REPS(pb + 0); ++rep_) { PHASE_BEGIN();
            const bool g8 = (GATES_FP8 == 2) || (GATES_FP8 == 1 && l == 1);
#if P1_I8
            {
                ProjSched S; S.init(M / 256, 16, F.G, (int)blockIdx.x); S.A = (const bf16*)(F.ws + WS_X8IN); S.Bt = (const bf16*)(F.ws + WS_WIN) + (size_t)l * N_INV * 1024; S.K = 1024; S.esz = 1;
                EpiProjT<true> E{F.ws, INP(3) + l * 3072, ((const float*)(F.ws + WS_CS))};
                pg8::gemm_phase<EpiProjT<true>, ProjSched, 1u>(F.lds + RING_OFF, 1024, S, E);
                pg8::PlainSched S8; S8.init(M / 256, 12, F.G, (int)blockIdx.x); S8.A = (const bf16*)(F.ws + WS_X8IN); S8.Bt = (const bf16*)((const unsigned char*)((const bf16*)(F.ws + WS_WIN) + (size_t)l * N_INV * 1024) + (size_t)4096 * 1024); S8.K = 1024; S8.esz = 1;
                EpiGate8T<true> E8{(bf16*)(F.ws + WS_GT), INP(3) + l * 3072};
                pg8::gemm_phase<EpiGate8T<true>, pg8::PlainSched, 1u>(F.lds + RING_OFF, 1024, S8, E8);
            }
#else
            ProjSched S; S.init(M / 256, g8 ? 16 : N_INV / 256, F.G, (int)blockIdx.x); S.A = ((bf16*)(F.ws + WS_XB)); S.Bt = (const bf16*)(F.ws + WS_WIN) + (size_t)l * N_INV * 1024; S.K = 1024;
            EpiProj E{F.ws, INP(3) + l * 3072, ((const float*)(F.ws + WS_CS))};
            pg8::gemm_phase<EpiProj, ProjSched>(F.lds + RING_OFF, 1024, S, E);
#if GATES_FP8
            if (g8) {
                pg8::PlainSched S8; S8.init(M / 256, 12, F.G, (int)blockIdx.x); S8.A = (const bf16*)(F.ws + WS_X8IN); S8.Bt = (const bf16*)(F.ws + WS_WIN8 + (size_t)l * 3072 * 1024); S8.K = 1024; S8.esz = 1;
                EpiGate8 E8{(bf16*)(F.ws + WS_GT), INP(3) + l * 3072};
                pg8::gemm_phase<EpiGate8, pg8::PlainSched, E8_UP>(F.lds + RING_OFF, 1024, S8, E8);
            }
#endif
#endif
        } }
        SEAMG(pb + 0);
        if (ON(2) && IN(pb + 1)) { for (int rep_ = 0; rep_ < REPS(pb + 1); ++rep_) { PHASE_BEGIN();
            {
#if NAIVE_FOX
            LAS float* tab = (LAS float*)(F.lds + RING_OFF + 4096); LAS float* wtot = (LAS float*)(F.lds + RING_OFF + 4096 + 8192);
            for (int uu = F.vcu; uu < 64 * 8; uu += F.G) {
                const int bh = uu >> 3, qb = uu & 7, b = bh >> 3, h = bh & 7;
                fox_bias_table<false>(F, b, h, tab, wtot);
                for (int r = F.wave; r < 256; r += NWAVES) naive_fox_row(F, b, h, qb * 256 + r, tab);
                __syncthreads();
            }
#else
            LAS float* tab = (LAS float*)(F.lds + RING_OFF + 86016); LAS float* wtot = (LAS float*)(F.lds + RING_OFF + 86016 + 32768);
            static_assert(attn_body::ATTN_LDS_BYTES <= 86016 && 86016 + 32768 + 64 <= RING_BYTES, "attention scratch below the bias rows");
            for (int d_ = 0; d_ < ((P2DUP & 1) ? 2 : 1); ++d_)
            for (int pp = F.vcu; pp < 256; pp += F.G) {
                const int bh = pp >> 2, sq = pp & 3, b = bh >> 3, h = bh & 7;
                fox_bias_table<true>(F, b, h, tab, wtot);
#pragma unroll 1
                for (int i = 0; i < 2; ++i)
                    attn_body::attn_unit<8>(b, h, i ? 7 - sq : sq, (const attn_body::bf16*)(F.ws + WS_FQ), (const attn_body::bf16*)(F.ws + WS_FK), (const attn_body::bf16*)(F.ws + WS_FV), (attn_body::bf16*)(F.ws + WS_YB), (char*)lds + RING_OFF, (attn_body::lds_tabptr)tab);
            }
            __syncthreads();
#endif
            }
#if NAIVE_RET == 1
            { const int gw = F.vcu * NWAVES + F.wave, NGW = F.G * NWAVES;
              for (int idx = gw; idx < BATCH * 4 * SEQ; idx += NGW) { const int t = idx & (SEQ - 1), bh = idx >> 11; naive_ret_row(F, bh >> 2, bh & 3, t); } }
#endif
#if NAIVE_GMLP == 1
            for (int uu = F.vcu; uu < BATCH * 16 * 4; uu += F.G) { const int g = uu & 3, n = (uu >> 2) & 15, b = uu >> 6;
                naive_gmlp_unit(F, b, n, g, INP(4) + (size_t)l * 4 * 128 * 128, INP(5) + l * 512, INP(6) + l * 512, INP(7) + l * 512); }
#endif
#if MK_N_LAUNCHES == 1 && NAIVE_RET == 0 && NAIVE_GMLP == 0
            for (int d_ = 0; d_ < ((P2DUP & 2) ? 2 : 1); ++d_)
            for (int uu = 2 * F.vcu; uu < 512; uu += 2 * F.G) {
#pragma unroll 1
                for (int q = 0; q < 2; ++q) { const int un = uu + q, bh = un >> 4; ret_kv_unit(F, bh >> 2, bh & 3, un & 15); } }
            if (grp) { if ((F.vcu & 31) < 16) gmlp_stat_unit(F, F.vcu >> 5, F.vcu & 31); }
            else for (int uu = F.vcu; uu < 128; uu += F.G) gmlp_stat_unit(F, uu >> 4, uu & 15);
            GRP_BAR();
            for (int d_ = 0; d_ < ((P2DUP & 4) ? 2 : 1); ++d_)
            for (int pp = F.vcu; pp < 256; pp += F.G) { const int bh = pp >> 3, sq = pp & 7;
#pragma unroll 1
                for (int q = 0; q < 2; ++q) ret_out_unit(F, bh >> 2, bh & 3, q ? 15 - sq : sq); }
            for (int d_ = 0; d_ < ((P2DUP & 8) ? 2 : 1); ++d_)
            for (int uu = F.vcu; uu < 256; uu += F.G) gmlp_pair(F, uu >> 5, (uu >> 1) & 15, (uu & 1) * 2, INP(4) + (size_t)l * 4 * 128 * 128, INP(5) + l * 512, INP(6) + l * 512, INP(7) + l * 512);
#else
            for (int uu = F.vcu; uu < 256; uu += F.G) {
                if (uu < 128) {
#if NAIVE_RET == 0
                    ret_unit(F, uu >> 4, (uu >> 2) & 3, uu & 3);
#endif
                } else {
#if NAIVE_GMLP == 0
#pragma unroll 1
                    for (int q = 0; q < 4; ++q) { const int gu = (uu - 128) * 4 + q; gmlp_unit(F, gu >> 6, (gu >> 2) & 15, gu & 3, INP(4) + (size_t)l * 4 * 128 * 128, INP(5) + l * 512, INP(6) + l * 512, INP(7) + l * 512); }
#endif
                }
            }
#endif
        } }
        SEAMG(pb + 1);
        if (ON(3) && IN(pb + 2)) { for (int rep_ = 0; rep_ < REPS(pb + 2); ++rep_) { PHASE_BEGIN();
            pg8::PlainSched S; S.init(M / 256, 4, F.G, (int)blockIdx.x); S.A = ((bf16*)(F.ws + WS_YB)); S.Bt = (const bf16*)(F.ws + WS_WBR) + (size_t)l * 1024 * 1536; S.K = 1536;
            EpiMerge E{(const bf16*)(F.ws + WS_GT), ((bf16*)(F.ws + WS_MRG))};
            pg8::gemm_phase<EpiMerge, pg8::PlainSched>(F.lds + RING_OFF, 1536, S, E);
        } }
        SEAMG(pb + 2);
        if (ON(4) && IN(pb + 3)) { for (int rep_ = 0; rep_ < REPS(pb + 3); ++rep_) { PHASE_BEGIN();
            pg8::PlainSched S; S.init(M / 256, 4, F.G, (int)blockIdx.x); S.A = ((bf16*)(F.ws + WS_MRG)); S.Bt = (const bf16*)(F.ws + WS_WOUT) + (size_t)l * 1024 * 1024; S.K = 1024;
            EpiResid E{xres, ((float*)(F.ws + WS_YPRE))};
            pg8::gemm_phase<EpiResid, pg8::PlainSched>(F.lds + RING_OFF, 1024, S, E);
        } }
        SEAMG(pb + 3);
        if (ON(5) && IN(pb + 4)) { for (int rep_ = 0; rep_ < REPS(pb + 4); ++rep_) { PHASE_BEGIN();
            if (l == 0) ln_pass<0>(F, ((float*)(F.ws + WS_YPRE)), 1.f, nullptr, nullptr, INP(10) + (l * 2 + 0) * 1024, INP(11) + (l * 2 + 0) * 1024, ((float*)(F.ws + WS_XF)), (DENSE_FP8 == 1 || DENSE_FP8 == 2 || DENSE_FP8 == 4) ? nullptr : ((bf16*)(F.ws + WS_XB)), (DENSE_FP8 == 1 || DENSE_FP8 == 2 || DENSE_FP8 == 4) ? (unsigned char*)(F.ws + WS_XB) : nullptr, nullptr, 0, 0, nullptr, grp, (DENSE_FP8 == 4) ? -SC_XI8 : SC_X8);
            else ln_pass<2>(F, ((float*)(F.ws + WS_YPRE)), 1.f, nullptr, nullptr, INP(10) + (l * 2 + 0) * 1024, INP(11) + (l * 2 + 0) * 1024, ((float*)(F.ws + WS_XF)), nullptr, (unsigned char*)(F.ws + WS_XB), INP(14), 8, 0, nullptr, grp);
        } }
        if (l == 0) SEAMG(pb + 4); else SEAM(pb + 4);
        if (ON(6) && IN(pb + 5)) { for (int rep_ = 0; rep_ < REPS(pb + 5); ++rep_) { PHASE_BEGIN();
            if (l == 0) {
                pg8::PlainSched S; S.init(M / 256, 2 * DFF_D / 256, F.G, (int)blockIdx.x); S.A = ((bf16*)(F.ws + WS_XB)); S.Bt = (const bf16*)(F.ws + WS_WDU); S.K = 1024;
#if DENSE_FP8 == 1
                S.esz = 1; EpiSwiglu8 E{(unsigned char*)(F.ws + WS_HID), DFF_D};
                pg8::gemm_phase<EpiSwiglu8, pg8::PlainSched, E8_UP>(F.lds + RING_OFF, 1024, S, E);
#elif DENSE_FP8 == 2
                S.esz = 1; EpiSwiglu E{((bf16*)(F.ws + WS_HID)), DFF_D};
                pg8::gemm_phase<EpiSwiglu, pg8::PlainSched, E8_UP>(F.lds + RING_OFF, 1024, S, E);
#elif DENSE_FP8 == 4
                S.esz = 1; EpiSwigluI8 E{((bf16*)(F.ws + WS_HID)), DFF_D};
                pg8::gemm_phase<EpiSwigluI8, pg8::PlainSched, 1u>(F.lds + RING_OFF, 1024, S, E);
#elif DENSE_FP8 == 3
                EpiSwiglu8 E{(unsigned char*)(F.ws + WS_HID), DFF_D};
                pg8::gemm_phase<EpiSwiglu8, pg8::PlainSched>(F.lds + RING_OFF, 1024, S, E);
#else
                EpiSwiglu E{((bf16*)(F.ws + WS_HID)), DFF_D};
                pg8::gemm_phase<EpiSwiglu, pg8::PlainSched>(F.lds + RING_OFF, 1024, S, E);
#endif
                if (F.G == 256 && blockIdx.x >= 128) {
                    LAS float* scr = (LAS float*)(F.lds + RING_OFF + F.wave * 17408);
                    for (int it = ((int)blockIdx.x - 128) * NWAVES + F.wave; it < CV_DEFER; it += 128 * NWAVES) cvt_global_item(F, it, scr, F.lane);
                } else if (F.G != 256) {
                    LAS float* scr = (LAS float*)(F.lds + RING_OFF + F.wave * 17408);
                    for (int it = F.vcu * NWAVES + F.wave; it < CV_DEFER; it += F.G * NWAVES) cvt_global_item(F, it, scr, F.lane);
                }
                __syncthreads();
            } else {
                MoeTiles mt; mt.init(F.ctl);
                MoeUpSched S; S.init(mt.toff[NEXP], 2 * DFF_E / 256, F.G, (int)blockIdx.x); S.A = (const unsigned char*)(F.ws + WS_XB); S.Bt = (const unsigned char*)(F.ws + WS_WMU); S.list = (const unsigned*)(F.ws + WS_LIST); S.mt = mt;
                EpiSwiglu8 E{(unsigned char*)(F.ws + WS_HID), DFF_E};
                pg8::gemm_phase<EpiSwiglu8, MoeUpSched, E8_UP>(F.lds + RING_OFF, 1024, S, E);
                {
                    LAS float* scr = (LAS float*)(F.lds + RING_OFF + F.wave * 17408);
                    const int nwg = mt.toff[NEXP] * (2 * DFF_E / 256), rounds = (nwg + F.G - 1) / F.G, rem = nwg - (rounds - 1) * F.G, nidle = F.G - rem;
                    constexpr int NMD = CV_MD1 - CV_MD0;
                    int q = 0; if (nidle > 0) { q = (NMD + nidle * NWAVES - 1) / (nidle * NWAVES); if (q > 6) q = 6; }
                    int first = nidle * NWAVES * q; if (first > NMD) first = NMD;
                    if ((int)blockIdx.x >= rem) for (int it = ((int)blockIdx.x - rem) * NWAVES + F.wave; it < first; it += nidle * NWAVES) cvt_global_item(F, CV_MD0 + it, scr, F.lane);
                    for (int it = first + (int)blockIdx.x * NWAVES + F.wave; it < NMD; it += F.G * NWAVES) cvt_global_item(F, CV_MD0 + it, scr, F.lane);
                    __syncthreads();
                }
            }
        } }
        if (l == 0) SEAMG(pb + 5); else SEAM(pb + 5);
        if (ON(7) && IN(pb + 6)) { for (int rep_ = 0; rep_ < REPS(pb + 6); ++rep_) { PHASE_BEGIN();
            if (l == 0) {
                pg8::PlainSched S; S.init(M / 256, 4, F.G, (int)blockIdx.x); S.A = ((bf16*)(F.ws + WS_HID)); S.Bt = (const bf16*)(F.ws + WS_WDD); S.K = DFF_D;
                EpiResid E{((float*)(F.ws + WS_XF)), ((float*)(F.ws + WS_YPRE))};
#if DENSE_FP8 == 1 || DENSE_FP8 == 3
                S.esz = 1; pg8::gemm_phase<EpiResid, pg8::PlainSched, E8_DN>(F.lds + RING_OFF, DFF_D, S, E);
#else
                pg8::gemm_phase<EpiResid, pg8::PlainSched>(F.lds + RING_OFF, DFF_D, S, E);
#endif
            } else {
                MoeTiles mt; mt.init(F.ctl);
                MoeDownSched S; S.init(mt.nfull_total(), 4, F.G, (int)blockIdx.x); S.A = (const unsigned char*)(F.ws + WS_HID); S.Bt = (const unsigned char*)(F.ws + WS_WMD); S.mt = mt;
                EpiMoeDown E{((bf16*)(F.ws + WS_YPRE)), ((bf16*)(F.ws + WS_C1)), (const unsigned*)(F.ws + WS_LIST), (const float*)(F.ws + WS_GATEW), mt};
                pg8::gemm_phase<EpiMoeDown, MoeDownSched, E8_DN>(F.lds + RING_OFF, DFF_E, S, E);
                for (int tu = F.vcu; tu < 256; tu += F.G) moe_tail_unit(F, mt, tu >> 5, (tu >> 3) & 3, tu & 7);
            }
        } }
        if (l == 0) SEAMG(pb + 6); else SEAM(pb + 6);
        if (ON(8) && IN(pb + 7)) { for (int rep_ = 0; rep_ < REPS(pb + 7); ++rep_) { PHASE_BEGIN();
            if (l == 0) ln_pass<1>(F, ((float*)(F.ws + WS_YPRE)), 1.f, nullptr, nullptr, INP(10) + (l * 2 + 1) * 1024, INP(11) + (l * 2 + 1) * 1024, ((float*)(F.ws + WS_XF)), ((bf16*)(F.ws + WS_XB)), GATES_FP8 ? (unsigned char*)(F.ws + WS_X8IN) : nullptr, INP(1) + (size_t)1 * 1024 * N_INSRC, N_INSRC, FL_COL, INP(2) + 8, grp, P1_I8 ? -SC_XI8 : SC_X8);
            else ln_pass<0>(F, ((float*)(F.ws + WS_XF)), ALPHA, (const bf16*)(F.ws + WS_YPRE), (const bf16*)(F.ws + WS_C1), INP(10) + (l * 2 + 1) * 1024, INP(11) + (l * 2 + 1) * 1024, (float*)(GAS float*)lds_ptr(F.lds, 17), nullptr, nullptr, nullptr, 0, 0, nullptr, grp);
        } }
        if (l == 0) SEAMG(pb + 7);
    }
#undef IN
#undef SEAM
}

extern "C" void kernel_launch(void* const* d_in, const int* in_sizes, int n_in, void* d_out, int out_size, void* d_ws, size_t ws_size, hipStream_t stream) {
    static int grid = 0;
    if (grid == 0) {
        if (n_in != 17 || in_sizes[0] != M * D || out_size != M * D || ws_size < WS_END) { fprintf(stderr, "kernel_launch: unexpected shapes / workspace (%zu)\n", ws_size); grid = -1; return; }
        int dev = 0, cus = 0, per_cu = 0;
        if (hipGetDevice(&dev) != hipSuccess || hipDeviceGetAttribute(&cus, hipDeviceAttributeMultiprocessorCount, dev) != hipSuccess) { grid = -1; return; }
        if (hipFuncSetAttribute((const void*)mega_fwd, hipFuncAttributeMaxDynamicSharedMemorySize, LDS_BYTES) != hipSuccess) { grid = -1; return; }
        if (hipOccupancyMaxActiveBlocksPerMultiprocessor(&per_cu, (const void*)mega_fwd, NWAVES * 64, LDS_BYTES) != hipSuccess || per_cu < 1) { fprintf(stderr, "kernel_launch: occupancy query says %d\n", per_cu); }
        (void)hipGetLastError();
        grid = cus;
    }
    if (grid < 0) return;
    if (hipMemsetAsync((char*)d_ws + WS_CTL, 0, CTL_ZERO_BYTES, stream) != hipSuccess) return;
    Args a{};
    for (int i = 0; i < 17; ++i) a.in[i] = (const float*)d_in[i];
    a.out = (float*)d_out; a.ws = (unsigned char*)d_ws;
#if MK_N_LAUNCHES == 1
    a.ph_lo = 0; a.ph_hi = N_PHASES;
    hipLaunchKernelGGL(mega_fwd, dim3(grid), dim3(NWAVES * 64), LDS_BYTES, stream, a);
#else
    for (int p = 0; p < N_PHASES; ++p) { a.ph_lo = p; a.ph_hi = p + 1; hipLaunchKernelGGL(mega_fwd, dim3(grid), dim3(NWAVES * 64), LDS_BYTES, stream, a); }
#endif
}
```

```cpp
#include <hip/hip_runtime.h>
#include <cstdio>
#include <cstdint>
#include <hip/hip_bf16.h>
#include <cmath>

#ifndef MK_N_LAUNCHES
#define MK_N_LAUNCHES 1
#endif
#ifndef DENSE_FP8
#define DENSE_FP8 4
#endif
#ifndef P1_I8
#define P1_I8 1
#endif
#ifndef GATES_FP8
#define GATES_FP8 2
#endif
#ifndef NAIVE_FOX
#define NAIVE_FOX 0
#endif
#ifndef NAIVE_RET
#define NAIVE_RET 0
#endif
#ifndef NAIVE_GMLP
#define NAIVE_GMLP 0
#endif

namespace pg8 {
#define PG8_LAS __attribute__((address_space(3)))
typedef unsigned short bf16_t;
typedef short bf16x8 __attribute__((ext_vector_type(8)));
typedef float f32x4 __attribute__((ext_vector_type(4)));
typedef float f32x2 __attribute__((ext_vector_type(2)));
typedef unsigned u32x4 __attribute__((ext_vector_type(4)));
typedef unsigned u32x2 __attribute__((ext_vector_type(2)));
constexpr int BM = 256, BK = 64, HALF = 128, HTB = HALF * BK * 2  , STAGE_BYTES = 8 * HTB, NXCD = 8, WGM = 4;

__host__ __device__ __forceinline__ int lds_byte(int r, int c) { const int st = (r >> 4) * 2 + (c >> 5), rr = r & 15, cc = c & 31, ob = rr * 64 + cc * 2; return st * 1024 + (ob ^ (((ob >> 9) & 1) << 5)); }
__host__ __device__ __forceinline__ void stage_rc(int b, int& R, int& C) { const int st = b / 1024, sb = b % 1024, swz = sb ^ (((sb >> 9) & 1) << 5); R = (st >> 1) * 16 + swz / 64; C = (st & 1) * 32 + (swz % 64) / 2; }
__host__ __device__ __forceinline__ int perm32(int rho) { const int n = rho >> 4, i = rho & 15; return 8 * (i >> 2) + 4 * n + (i & 3); }

struct Unit { int pm, pn; };

struct TileOrder {
    int nM, nN, nwg, G, c;
    __device__ __forceinline__ void init(int nM_, int nN_, int G_, int c_) { nM = nM_; nN = nN_; nwg = nM * nN; G = G_; c = c_; }
    __device__ __forceinline__ bool next(int i, Unit& u) const {
        const long L = (long)i * G + c; if (L >= nwg) return false;
        int wgid = (int)L; { const int q = nwg / NXCD, r = nwg % NXCD, xcd = wgid % NXCD, off = wgid / NXCD; wgid = (xcd < r ? xcd * (q + 1) : r * (q + 1) + (xcd - r) * q) + off; }
        const int nig = WGM * nN, gid = wgid / nig, fm = gid * WGM, gsz = (nM - fm) < WGM ? (nM - fm) : WGM;
        u.pm = fm + ((wgid % nig) % gsz); u.pn = (wgid % nig) / gsz; return true;
    }
};
struct PlainSched : TileOrder {
    static constexpr bool GATHER = false;
    const bf16_t* A; const bf16_t* Bt; int K; int esz = 2;
    __device__ __forceinline__ const char* abase(const Unit& u) const { return (const char*)A + (size_t)u.pm * BM * K * esz; }
    __device__ __forceinline__ void aoffs_load(const Unit&, const int (&)[2], PG8_LAS unsigned*) const {}
    __device__ __forceinline__ void aoffs_fin(const Unit&, const int (&)[2], const int (&)[2], const PG8_LAS unsigned*, int, unsigned (&)[2][2]) const {}
    __device__ __forceinline__ void aoffs(const Unit&, const int (&R)[2], const int (&C)[2], unsigned (&o)[2][2]) const {
#pragma unroll
        for (int h = 0; h < 2; ++h)
#pragma unroll
            for (int i = 0; i < 2; ++i) o[h][i] = (unsigned)((R[i] + h * HALF) * K + C[i]) * 2u; }
    __device__ __forceinline__ const char* bbase(const Unit& u) const { return (const char*)Bt + (size_t)u.pn * BM * K * esz; }
};

typedef __bf16 bf16x2_v __attribute__((ext_vector_type(2)));
__device__ __forceinline__ unsigned cvt_pk_bf16(float lo, float hi) { f32x2 v = {lo, hi}; bf16x2_v b = __builtin_convertvector(v, bf16x2_v); return __builtin_bit_cast(unsigned, b); }

typedef float f32x2_pk __attribute__((ext_vector_type(2)));
__device__ __forceinline__ f32x4 zero4() { f32x2_pk lo, hi; asm volatile("v_pk_mov_b32 %0, 0, 0" : "=v"(lo)); asm volatile("v_pk_mov_b32 %0, 0, 0" : "=v"(hi)); return __builtin_shufflevector(lo, hi, 0, 1, 2, 3); }
typedef int v4i_t __attribute__((ext_vector_type(4)));
typedef int v8i_t __attribute__((ext_vector_type(8)));
__host__ __device__ __forceinline__ int lds_byte8(int r, int g) { const int st = (r >> 4) * 2 + (g >> 1), ob = (r & 15) * 64 + 32 * (g & 1); return st * 1024 + (ob ^ (((ob >> 9) & 1) << 5)); }
template <class Epi, class Sched, unsigned FP8S = 0u>
__device__ __forceinline__ void gemm_phase(PG8_LAS unsigned char* lds, const int K, const Sched& S, const Epi& E) {
    constexpr bool F8 = FP8S != 0u;
    constexpr bool I8 = FP8S == 1u;
    int tid_ = threadIdx.x; asm volatile("" : "+v"(tid_));
    const int tid = tid_, wid = __builtin_amdgcn_readfirstlane(tid >> 6), lane = tid & 63, wr = wid >> 2, wc = wid & 3, fr = lane & 15, fq = lane >> 4;
    const int nt = F8 ? K / 128 : K / BK;
    int Rs[2], Cs[2]; unsigned voffA[2], voffB[2];
#pragma unroll
    for (int i = 0; i < 2; ++i) { int R, C; stage_rc(tid * 16 + i * 8192, R, C); Rs[i] = R; Cs[i] = C; const int Rb = Epi::PERM ? ((R & ~31) + perm32(R & 31)) : R;
        voffA[i] = F8 ? (unsigned)(R * K + 2 * C) : (unsigned)(R * K + C) * 2u; voffB[i] = F8 ? (unsigned)(Rb * K + 2 * C) : (unsigned)(Rb * K + C) * 2u; }
    const size_t kstep = (size_t)(BK * 2);
    const size_t hstep = (size_t)HALF * K * (F8 ? 1 : 2);
    const unsigned ldsw = (unsigned)wid * 1024u;
    const int aoff = F8 ? lds_byte8(wr * 64 + fr, fq) : lds_byte(wr * 64 + fr, fq * 8), boff = F8 ? lds_byte8(wc * 32 + fr, fq) : lds_byte(wc * 32 + fr, fq * 8);
#define PG8_SA(b, h) (((b) * 2 + (h)) * HTB)
#define PG8_SB(b, h) ((4 + (b) * 2 + (h)) * HTB)
#define PG8_STAGE(bufoff, gbase, voff) do { _Pragma("unroll") for (int _i = 0; _i < 2; ++_i) \
        __builtin_amdgcn_global_load_lds((const unsigned*)((const char*)(gbase) + (voff)[_i]), (PG8_LAS unsigned*)(lds + (bufoff) + ldsw + _i * 8192), 16, 0, 0); } while (0)
#define PG8_STA(bufoff, gbase, h, nx) do { if constexpr (Sched::GATHER) { _Pragma("unroll") for (int _i = 0; _i < 2; ++_i) { const unsigned o_ = (nx) ? nof[h][_i] : cof[h][_i]; \
        __builtin_amdgcn_global_load_lds((const unsigned*)((const char*)(gbase) + o_), (PG8_LAS unsigned*)(lds + (bufoff) + ldsw + _i * 8192), 16, 0, 0); } } \
        else { PG8_STAGE(bufoff, (gbase) + (h) * hstep, voffA); } } while (0)
#define PG8_LDA(dst, b, h) do { _Pragma("unroll") for (int m = 0; m < 4; ++m) _Pragma("unroll") for (int k = 0; k < 2; ++k) dst[m][k] = *(const PG8_LAS bf16x8*)(lds + PG8_SA(b, h) + aoff + m * 2048 + k * 1024); } while (0)
#define PG8_LDB(dst, b, h) do { _Pragma("unroll") for (int n = 0; n < 2; ++n) _Pragma("unroll") for (int k = 0; k < 2; ++k) dst[n][k] = *(const PG8_LAS bf16x8*)(lds + PG8_SB(b, h) + boff + n * 2048 + k * 1024); } while (0)
#define PG8_MMA(ai, bj, At, Bt) do { __builtin_amdgcn_s_setprio(1); _Pragma("unroll") for (int m = 0; m < 4; ++m) _Pragma("unroll") for (int n = 0; n < 2; ++n) _Pragma("unroll") for (int k = 0; k < 2; ++k) \
        acc[ai][bj][m][n] = __builtin_amdgcn_mfma_f32_16x16x32_bf16(Bt[n][k], At[m][k], acc[ai][bj][m][n], 0, 0, 0); __builtin_amdgcn_s_setprio(0); } while (0)
#define PG8_LD32(p) __builtin_shufflevector(*(const PG8_LAS v4i_t*)(p), *(const PG8_LAS v4i_t*)((p) + 16), 0, 1, 2, 3, 4, 5, 6, 7)
#define PG8_LDA8(dst, b, h) do { _Pragma("unroll") for (int m = 0; m < 4; ++m) dst[m] = PG8_LD32(lds + PG8_SA(b, h) + aoff + m * 2048); } while (0)
#define PG8_LDB8(dst, b, h) do { _Pragma("unroll") for (int n = 0; n < 2; ++n) dst[n] = PG8_LD32(lds + PG8_SB(b, h) + boff + n * 2048); } while (0)
#define PG8_MMA8(ai, bj, At, Bt) do { __builtin_amdgcn_s_setprio(1); \
        if constexpr (I8) {   \
            _Pragma("unroll") for (int m = 0; m < 4; ++m) _Pragma("unroll") for (int n = 0; n < 2; ++n) \
                asm volatile("v_mfma_i32_16x16x64_i8 %0, %1, %2, %0" : "+v"(acc[ai][bj][m][n]) : "v"(__builtin_shufflevector(Bt[n], Bt[n], 0, 1, 2, 3)), "v"(__builtin_shufflevector(At[m], At[m], 0, 1, 2, 3))); \
            _Pragma("unroll") for (int m = 0; m < 4; ++m) _Pragma("unroll") for (int n = 0; n < 2; ++n) \
                asm volatile("v_mfma_i32_16x16x64_i8 %0, %1, %2, %0" : "+v"(acc[ai][bj][m][n]) : "v"(__builtin_shufflevector(Bt[n], Bt[n], 4, 5, 6, 7)), "v"(__builtin_shufflevector(At[m], At[m], 4, 5, 6, 7))); \
        } else { _Pragma("unroll") for (int m = 0; m < 4; ++m) _Pragma("unroll") for (int n = 0; n < 2; ++n) \
        asm volatile("v_mfma_scale_f32_16x16x128_f8f6f4 %0, %1, %2, %0, %3, %4 op_sel_hi:[0,0,0]" : "+v"(acc[ai][bj][m][n]) : "v"(Bt[n]), "v"(At[m]), "v"(scl_w), "v"(scl_1)); } __builtin_amdgcn_s_setprio(0); } while (0)
#define PG8_XLDA(b, h) do { if constexpr (F8) PG8_LDA8(At8, b, h); else PG8_LDA(At, b, h); } while (0)
#define PG8_XLDB0(b, h) do { if constexpr (F8) PG8_LDB8(B08, b, h); else PG8_LDB(B0, b, h); } while (0)
#define PG8_XLDB1(b, h) do { if constexpr (F8) PG8_LDB8(B18, b, h); else PG8_LDB(B1, b, h); } while (0)
#define PG8_XMMA0(ai, bj) do { if constexpr (F8) PG8_MMA8(ai, bj, At8, B08); else PG8_MMA(ai, bj, At, B0); } while (0)
#define PG8_XMMA1(ai, bj) do { if constexpr (F8) PG8_MMA8(ai, bj, At8, B18); else PG8_MMA(ai, bj, At, B1); } while (0)
#define PG8_WAIT_V(n) asm volatile("s_waitcnt vmcnt(" #n ")" ::: "memory")
#define PG8_WAIT_L(n) asm volatile("s_waitcnt lgkmcnt(" #n ")" ::: "memory")
#define PG8_BAR __builtin_amdgcn_s_barrier()
#define PG8_SCHED __builtin_amdgcn_sched_barrier(0)
    Unit cur, nxt; int ui = 0;
    if (!S.next(0, cur)) return;
    f32x4 acc[2][2][4][2];
#pragma unroll
    for (int a = 0; a < 2; ++a)
#pragma unroll
        for (int b = 0; b < 2; ++b)
#pragma unroll
            for (int m = 0; m < 4; ++m)
#pragma unroll
                for (int n = 0; n < 2; ++n) acc[a][b][m][n] = zero4();
    bf16x8 At[4][2], B0[2][2], B1[2][2]; v8i_t At8[4], B08[2], B18[2];
    int scl_w = (int)FP8S, scl_1 = 0x7f7f7f7f; if constexpr (F8) asm volatile("" : "+v"(scl_w), "+v"(scl_1));
    unsigned cof[2][2], nof[2][2];
    PG8_LAS unsigned* gscr = (PG8_LAS unsigned*)(lds + 8 * HTB + wid * 1024);
    const char* cA = S.abase(cur); if constexpr (Sched::GATHER) { S.aoffs_load(cur, Rs, gscr); asm volatile("s_waitcnt vmcnt(0)" ::: "memory"); S.aoffs_fin(cur, Rs, Cs, gscr, lane, cof); } const char* cB = S.bbase(cur);
    PG8_STAGE(PG8_SB(0, 0), cB, voffB); PG8_STAGE(PG8_SB(0, 1), cB + hstep, voffB); PG8_STA(PG8_SA(0, 0), cA, 0, false); PG8_STA(PG8_SA(0, 1), cA, 1, false);
    if (wr == 1) PG8_BAR;
    PG8_WAIT_V(2); PG8_BAR;
    PG8_STAGE(PG8_SB(1, 0), cB + kstep, voffB); PG8_STA(PG8_SA(1, 0), cA + kstep, 0, false); PG8_STAGE(PG8_SB(1, 1), cB + hstep + kstep, voffB);
    PG8_WAIT_V(6); PG8_BAR;
    for (;;) {
        const bool has_next = S.next(ui + 1, nxt);
        const char* nA = cA; const char* nB = cB;
        if constexpr (Sched::GATHER) {
#pragma unroll
            for (int h = 0; h < 2; ++h)
#pragma unroll
                for (int i = 0; i < 2; ++i) nof[h][i] = cof[h][i]; }
        if (has_next) { nA = S.abase(nxt); if constexpr (Sched::GATHER) S.aoffs_load(nxt, Rs, gscr); nB = S.bbase(nxt); }
#pragma unroll 1
        for (int t = 0; t < nt; t += 2) {
            const bool last = (t == nt - 2);
            const bool skipw = (t == 0) && (ui > 0) && !Sched::GATHER;
            if constexpr (Sched::GATHER) { if (last && has_next) S.aoffs_fin(nxt, Rs, Cs, gscr, lane, nof); }
            if constexpr (Epi::HOOK) { PG8_SCHED; E.khook(acc, cur, t, wr, wc, fr, fq); PG8_SCHED; }
            const char* a1 = cA + (size_t)(t + 1) * kstep;
            const char* a2 = last ? nA : cA + (size_t)(t + 2) * kstep; const char* b2 = last ? nB : cB + (size_t)(t + 2) * kstep;
            const char* a3 = a2 + kstep; const char* b3 = b2 + kstep;
            PG8_XLDB0(0, 0); PG8_XLDB1(0, 1); PG8_SCHED; PG8_XLDA(0, 0); PG8_STA(PG8_SA(1, 1), a1, 1, false);
            if (!skipw) PG8_WAIT_V(8);
            PG8_WAIT_L(0); PG8_BAR; PG8_XMMA0(0, 0); PG8_XMMA1(0, 1); PG8_BAR; PG8_SCHED;
            PG8_XLDA(0, 1); PG8_STAGE(PG8_SB(0, 0), b2, voffB); PG8_STAGE(PG8_SB(0, 1), b2 + hstep, voffB); PG8_STA(PG8_SA(0, 0), a2, 0, last);
            if (!skipw) PG8_WAIT_V(8);
            PG8_WAIT_L(0); PG8_BAR; PG8_XMMA0(1, 0); PG8_XMMA1(1, 1); PG8_BAR; PG8_SCHED;
            PG8_XLDB0(1, 0); PG8_XLDB1(1, 1); PG8_SCHED; PG8_XLDA(1, 0); PG8_STA(PG8_SA(0, 1), a2, 1, last);
            PG8_WAIT_V(8); PG8_WAIT_L(0); PG8_BAR; PG8_XMMA0(0, 0); PG8_XMMA1(0, 1); PG8_BAR; PG8_SCHED;
            PG8_XLDA(1, 1); PG8_STAGE(PG8_SB(1, 0), b3, voffB); PG8_STAGE(PG8_SB(1, 1), b3 + hstep, voffB); PG8_STA(PG8_SA(1, 0), a3, 0, last);
            PG8_WAIT_V(8); PG8_WAIT_L(0); PG8_BAR; PG8_XMMA0(1, 0); PG8_XMMA1(1, 1); PG8_BAR; PG8_SCHED;
        }
        if constexpr (!Sched::GATHER) PG8_WAIT_V(0);
        if constexpr (F8) {
            asm volatile("s_nop 15\n\ts_nop 15\n\ts_nop 15\n\ts_nop 15\n\ts_nop 15" ::: "memory");
#pragma unroll
            for (int a = 0; a < 2; ++a)
#pragma unroll
                for (int b = 0; b < 2; ++b)
#pragma unroll
                    for (int m = 0; m < 4; ++m) asm volatile("" : "+v"(acc[a][b][m][0]), "+v"(acc[a][b][m][1]));
        }
        if (wr == 0) PG8_BAR;
        E(acc, cur, wr, wc, fr, fq);
#ifdef EPI_DUP
        if (Epi::DUPME) { asm volatile("" ::: "memory"); E(acc, cur, wr, wc, fr, fq); }
#endif
        if (!has_next) break;
#pragma unroll
        for (int a = 0; a < 2; ++a)
#pragma unroll
            for (int b = 0; b < 2; ++b)
#pragma unroll
                for (int m = 0; m < 4; ++m)
#pragma unroll
                    for (int n = 0; n < 2; ++n) acc[a][b][m][n] = zero4();
        cur = nxt; cA = nA; cB = nB; ++ui;
        if constexpr (Sched::GATHER) {
#pragma unroll
            for (int h = 0; h < 2; ++h)
#pragma unroll
                for (int i = 0; i < 2; ++i) cof[h][i] = nof[h][i]; }
        if (wr == 1) PG8_BAR;
    }
    PG8_WAIT_V(0);
    PG8_BAR;
#undef PG8_SA
#undef PG8_SB
#undef PG8_STAGE
#undef PG8_STA
#undef PG8_LDA
#undef PG8_LDB
#undef PG8_MMA
#undef PG8_LD32
#undef PG8_LDA8
#undef PG8_LDB8
#undef PG8_MMA8
#undef PG8_XLDA
#undef PG8_XLDB0
#undef PG8_XLDB1
#undef PG8_XMMA0
#undef PG8_XMMA1
#undef PG8_WAIT_V
#undef PG8_WAIT_L
#undef PG8_BAR
#undef PG8_SCHED
}
}

namespace attn_body {
using bf16=__hip_bfloat16;
using bf16x8=__attribute__((ext_vector_type(8)))short;
using s16x4=__attribute__((ext_vector_type(4)))short;
using f32x16=__attribute__((ext_vector_type(16)))float;
using u32x4=__attribute__((ext_vector_type(4)))unsigned;
constexpr int BATCH=8,NHEAD=8,SEQ=2048,D=64,DM=NHEAD*D,PO=1536,OCOL=512;
constexpr int NW=8,QBLK=32,QB=QBLK*NW,KVBLK=64,NQB=SEQ/QB;
constexpr int ATTN_PITCH=DM, ATTN_UNIT_ROWS=QB;
__device__ __forceinline__ int crow(int r,int hi){return (r&3)+8*(r>>2)+4*hi;}
#define SBAR() __builtin_amdgcn_sched_barrier(0)
__device__ __forceinline__ void cmask(f32x16&p0,f32x16&p1,int jb,int qrel,int hi){
  const float NEG=-INFINITY; int kb=64*jb+4*hi;
  #pragma unroll
  for(int r=0;r<16;++r){int kv=kb+(r&3)+8*(r>>2); if(kv>qrel)p0[r]=NEG; if(kv+32>qrel)p1[r]=NEG;}
}

constexpr int NSLOT=3, SLOTB=8192;
constexpr int LDS_K=0, LDS_V=NSLOT*SLOTB, LDS_WS=2*NSLOT*SLOTB, LDS_OST=LDS_WS+NW*64*4, LDS_BYTES=LDS_OST+NW*4096;
constexpr float C2=0.125f*1.4426950408889634f;
__device__ __forceinline__ void glds16(const void*gsrc,unsigned lds_dst){unsigned keep;
  asm volatile("s_mov_b32 %0, m0\n\ts_mov_b32 m0, %2\n\ts_nop 0\n\tglobal_load_lds_dwordx4 %1, off\n\ts_mov_b32 m0, %0":"=&s"(keep):"v"(gsrc),"s"(lds_dst):"memory");}
__device__ __forceinline__ float max3f(float a,float b,float c){float r;asm("v_max3_f32 %0, %1, %2, %3":"=v"(r):"v"(a),"v"(b),"v"(c));return r;}
__device__ __forceinline__ float max2f(float a,float b){float r;asm("v_max_f32_e32 %0, %1, %2":"=v"(r):"v"(a),"v"(b));return r;}
__device__ __forceinline__ float fadd_s(float a,float b){float r;asm("v_add_f32_e32 %0, %1, %2":"=v"(r):"v"(a),"v"(b));return r;}
__device__ __forceinline__ float fsub_s(float a,float b){float r;asm("v_sub_f32_e32 %0, %1, %2":"=v"(r):"v"(a),"v"(b));return r;}
typedef float f32x2_t __attribute__((ext_vector_type(2))); typedef __bf16 bf16x2_t __attribute__((ext_vector_type(2)));
__device__ __forceinline__ unsigned cvtpk_s(float lo,float hi){f32x2_t v={lo,hi};bf16x2_t b=__builtin_convertvector(v,bf16x2_t);return __builtin_bit_cast(unsigned,b);}
#define WAIT_BAR(N) asm volatile("s_waitcnt vmcnt(" #N ") lgkmcnt(0)\n\ts_barrier":::"memory")

__device__ __forceinline__ void qkt(f32x16&p0,f32x16&p1,const char*Kslot,const bf16x8*qr,bf16x8 ka0,bf16x8 ka1,bf16x8 qaug,int r32,int hi){
  const char*kb=Kslot+hi*1024+r32*16;
  p0=__builtin_amdgcn_mfma_f32_32x32x16_bf16(ka0,qaug,f32x16{},0,0,0);p1=__builtin_amdgcn_mfma_f32_32x32x16_bf16(ka1,qaug,f32x16{},0,0,0);
  #pragma unroll
  for(int d0=0;d0<4;++d0){
    const bf16x8 b0=*reinterpret_cast<const bf16x8*>(kb+d0*2048);
    const bf16x8 b1=*reinterpret_cast<const bf16x8*>(kb+d0*2048+512);
    p0=__builtin_amdgcn_mfma_f32_32x32x16_bf16(b0,qr[d0],p0,0,0,0);p1=__builtin_amdgcn_mfma_f32_32x32x16_bf16(b1,qr[d0],p1,0,0,0);}
}
typedef __attribute__((address_space(3))) const char* lds_cptr;
typedef short v4i16_t __attribute__((ext_vector_type(4)));
__device__ __forceinline__ void kload8(bf16x8*kf,lds_cptr kp){
  kf[0]=*(const __attribute__((address_space(3))) bf16x8*)(kp);      kf[1]=*(const __attribute__((address_space(3))) bf16x8*)(kp+512);
  kf[2]=*(const __attribute__((address_space(3))) bf16x8*)(kp+2048); kf[3]=*(const __attribute__((address_space(3))) bf16x8*)(kp+2560);
  kf[4]=*(const __attribute__((address_space(3))) bf16x8*)(kp+4096); kf[5]=*(const __attribute__((address_space(3))) bf16x8*)(kp+4608);
  kf[6]=*(const __attribute__((address_space(3))) bf16x8*)(kp+6144); kf[7]=*(const __attribute__((address_space(3))) bf16x8*)(kp+6656);
}
__device__ __forceinline__ void kload2(bf16x8*kf,lds_cptr kp,int j){ kf[2*j]=*(const __attribute__((address_space(3))) bf16x8*)(kp+j*2048); kf[2*j+1]=*(const __attribute__((address_space(3))) bf16x8*)(kp+j*2048+512); }
__device__ __forceinline__ s16x4 vtr(lds_cptr p){ return __builtin_bit_cast(s16x4,__builtin_amdgcn_ds_read_tr16_b64_v4i16((__attribute__((address_space(3))) v4i16_t*)p)); }
__device__ __forceinline__ float rowmax(const f32x16&p0,const f32x16&p1){
  float a=max3f(p0[0],p0[1],p1[0]),b=max3f(p0[2],p0[3],p1[1]);a=max3f(a,p1[2],p1[3]);
  #pragma unroll
  for(int r=4;r<16;r+=4){a=max3f(a,p0[r],p0[r+1]);b=max3f(b,p0[r+2],p0[r+3]);a=max3f(a,p1[r],p1[r+1]);b=max3f(b,p1[r+2],p1[r+3]);}
  const float m=max2f(a,b);
  auto rr=__builtin_amdgcn_permlane32_swap(__float_as_uint(m),__float_as_uint(m),false,false);
  return max2f(__uint_as_float(rr[0]),__uint_as_float(rr[1]));
}
__device__ __forceinline__ void pv(f32x16*o,int vb,bf16x8 pa0,bf16x8 pa1,bf16x8 pa2,bf16x8 pa3){
  #pragma unroll
  for(int d0=0;d0<2;++d0){s16x4 lo[4],hi[4];
    #pragma unroll
    for(int ks=0;ks<4;++ks){
      asm volatile("ds_read_b64_tr_b16 %0,%1 offset:%c2":"=&v"(lo[ks]):"v"(vb),"i"(d0*4096+ks*1024):"memory");
      asm volatile("ds_read_b64_tr_b16 %0,%1 offset:%c2":"=&v"(hi[ks]):"v"(vb),"i"(d0*4096+ks*1024+512):"memory");}
    asm volatile("s_waitcnt lgkmcnt(0)":::"memory");SBAR();
    #define PK(k) (bf16x8){lo[k][0],lo[k][1],lo[k][2],lo[k][3],hi[k][0],hi[k][1],hi[k][2],hi[k][3]}
    o[d0]=__builtin_amdgcn_mfma_f32_32x32x16_bf16(pa0,PK(0),o[d0],0,0,0);
    o[d0]=__builtin_amdgcn_mfma_f32_32x32x16_bf16(pa1,PK(1),o[d0],0,0,0);
    o[d0]=__builtin_amdgcn_mfma_f32_32x32x16_bf16(pa2,PK(2),o[d0],0,0,0);
    o[d0]=__builtin_amdgcn_mfma_f32_32x32x16_bf16(pa3,PK(3),o[d0],0,0,0);
    #undef PK
  }
}

#ifndef ATTN_STORE16
#define ATTN_STORE16(p,v) (*(u32x4*)(p)=(v))
#endif
typedef __attribute__((address_space(3))) const u32x4* lds_tabptr;
__device__ __forceinline__ bf16x8 make_qaug(float mhat,int hi){
  const float nm=-mhat; const unsigned h=cvtpk_s(nm,0.f)&0xffffu; const float r1=nm-__uint_as_float(h<<16);
  const unsigned m=cvtpk_s(r1,0.f)&0xffffu; const float r2=r1-__uint_as_float(m<<16); const unsigned l=cvtpk_s(r2,0.f)&0xffffu;
  u32x4 w; w.x=hi?0u:0x3F803F80u; w.y=hi?0u:(0x3F80u|(h<<16)); w.z=hi?0u:(m|(l<<16)); w.w=0u; return __builtin_bit_cast(bf16x8,w);
}
template<int THRL> __device__ __forceinline__ void attn_unit(int b,int h,int qb,const bf16*Q,const bf16*__restrict__ K,const bf16*__restrict__ V,bf16*O,char*shm,lds_tabptr tab){
  int tid_=threadIdx.x; asm volatile("":"+v"(tid_));
  const int tid=tid_,lane=tid&63,r32=lane&31,hi=lane>>5; const int wid=__builtin_amdgcn_readfirstlane(tid>>6);
  const long rowbase=(long)b*SEQ; const int q0=qb*QB;
  const bf16*Qw=Q+(rowbase+q0+wid*QBLK)*DM+h*D;
  const bf16*Kh=K+rowbase*DM+h*D,*Vh=V+rowbase*DM+h*D;
  const unsigned lds0=(unsigned)(uintptr_t)shm;
  float*wsf=(float*)(shm+LDS_WS)+wid*64;
  const bf16*ksrc=Kh+(long)lane*DM+wid*8;
  const bf16*vsrc=Vh+(long)(16*(wid&3)+(lane>>2))*DM+(wid>>2)*32+(lane&3)*8;
  const unsigned kdst=lds0+LDS_K+wid*1024, vdst=lds0+LDS_V+wid*1024;
  #define DMA_K(t,slot) glds16(ksrc+(long)(t)*KVBLK*DM,(unsigned)__builtin_amdgcn_readfirstlane(kdst+(slot)))
  #define DMA_V(t,slot) glds16(vsrc+(long)(t)*KVBLK*DM,(unsigned)__builtin_amdgcn_readfirstlane(vdst+(slot)))
  const int vb0=(int)(lds0+LDS_V)+((lane>>4)&1)*32+(lane&3)*8+(4*hi+((lane&15)>>2))*64;
  const char*Kbase=shm+LDS_K; bf16x8 kf[8];
  const lds_cptr shm3=(lds_cptr)shm; const lds_cptr kp0=shm3+LDS_K+hi*1024+r32*16; const lds_cptr vp0=shm3+LDS_V+((lane>>4)&1)*32+(lane&3)*8+(4*hi+((lane&15)>>2))*64;
  const int NT=(q0+QB)/KVBLK;
  DMA_K(0,0);DMA_V(0,0);DMA_K(1,SLOTB);
  bf16x8 qr[4];
  #pragma unroll
  for(int d0=0;d0<4;++d0)qr[d0]=*reinterpret_cast<const bf16x8*>(&Qw[(long)r32*DM+d0*16+hi*8]);
  float mhat=0.f,l_reg=0.f;f32x16 o[2];o[0]=f32x16{};o[1]=f32x16{};bf16x8 qaug=make_qaug(0.f,hi);asm volatile("":"+v"(qaug));
  const int qrel=wid*QBLK+r32;
  #define CMASK(P0,P1,t) do{int jb_=(t)-(NT-4); if(jb_>=0)cmask(P0,P1,jb_,qrel,hi);}while(0)
  bool resc=false;
  #define START(P0,P1) do{ const float rm=rowmax(P0,P1); resc=false; \
    { const float dl=rm; mhat=fadd_s(mhat,dl); \
      _Pragma("unroll") for(int r=0;r<16;++r){P0[r]=fsub_s(P0[r],dl);P1[r]=fsub_s(P1[r],dl);} \
      qaug=make_qaug(mhat,hi); asm volatile("":"+v"(qaug)); } \
    _Pragma("unroll") for(int r=0;r<16;++r)P0[r]=__builtin_amdgcn_exp2f(P0[r]); }while(0)
  #define RESC() do{ if(resc){ asm volatile("s_waitcnt lgkmcnt(0)":::"memory"); \
      _Pragma("unroll") for(int d_=0;d_<2;++d_) _Pragma("unroll") for(int r=0;r<16;++r)o[d_][r]*=wsf[crow(r,hi)]; } }while(0)
  f32x16 pA0,pA1,pB0,pB1;
  int sl_prev=0,sl_cur=0,sl_next=SLOTB;
  #define ROT() do{sl_prev=sl_cur;sl_cur=sl_next;sl_next=(sl_next==(NSLOT-1)*SLOTB)?0:sl_next+SLOTB;}while(0)
  DMA_K(2,2*SLOTB);
  WAIT_BAR(3);
  qkt(pA0,pA1,Kbase,qr,__builtin_bit_cast(bf16x8,tab[r32]),__builtin_bit_cast(bf16x8,tab[32+r32]),qaug,r32,hi);asm volatile("s_nop 15\n\ts_nop 7":"+v"(pA0),"+v"(pA1));CMASK(pA0,pA1,0);
  START(pA0,pA1);
  _Pragma("unroll") for(int r=0;r<16;++r)pA1[r]=__builtin_amdgcn_exp2f(pA1[r]);
  WAIT_BAR(0);
  DMA_K(3,0);DMA_V(1,SLOTB);
  ROT();
  kload8(kf,kp0+sl_cur);
  WAIT_BAR(2);
  s16x4 vlo[8],vhi[8]; u32x4 pw0,pw1,pw2,pw3;
  #define PKW(P,B) cvtpk_s(P[B],P[B+1])
  #define PAF(k) __builtin_bit_cast(bf16x8,pw##k)
  #define VFR(i) (bf16x8){vlo[i][0],vlo[i][1],vlo[i][2],vlo[i][3],vhi[i][0],vhi[i][1],vhi[i][2],vhi[i][3]}
  #define PIN(x) asm volatile("":"+v"(x))
  #define MX3(a,b,c) __builtin_fmaxf(__builtin_fmaxf((a),(b)),(c))
  #define GAPA(MF,A0,A1,A2,A3,W0,W1,PW) do{ MF; sacc+=A0; sacc+=A1; sacc+=A2; sacc+=A3; PIN(sacc); W0; W1; PIN(PW); SBAR(); }while(0)
  #define EX(v) __builtin_amdgcn_exp2f(v)
  #define GAPB(MF,X,B) do{ MF; X[B]=EX(X[B]); X[B+1]=EX(X[B+1]); X[B+2]=EX(X[B+2]); X[B+3]=EX(X[B+3]); PIN(X); SBAR(); }while(0)
  #define VRD(i) do{ vlo[i]=vtr(vp_+(((i)>>2)*4096+((i)&3)*1024)); vhi[i]=vtr(vp_+(((i)>>2)*4096+((i)&3)*1024+512)); }while(0)
  #define KRD(G,j) do{ if(G){ kload2(kf,kp0+sl_next,j); SBAR(); } }while(0)
  #define STEP(C0,C1,P0,P1,t,GK,GV,GL) do{ SBAR(); \
    const lds_cptr vp_=vp0+sl_prev; \
    const bf16x8 ka0_=__builtin_bit_cast(bf16x8,tab[64*(t)+r32]), ka1_=__builtin_bit_cast(bf16x8,tab[64*(t)+32+r32]); \
    VRD(0); SBAR(); float sacc=(P0[0]+P0[1]); \
    GAPA(C0=__builtin_amdgcn_mfma_f32_32x32x16_bf16(kf[0],qr[0],f32x16{},0,0,0), P0[2],P0[3],P0[4],P0[5],     pw0[0]=PKW(P0,0), pw0[1]=PKW(P0,2), pw0); \
    VRD(4); SBAR(); GAPA(C1=__builtin_amdgcn_mfma_f32_32x32x16_bf16(kf[1],qr[0],f32x16{},0,0,0), P0[6],P0[7],P0[8],P0[9],     pw0[2]=PKW(P0,4), pw0[3]=PKW(P0,6), pw0); \
    VRD(1); SBAR(); GAPA(C0=__builtin_amdgcn_mfma_f32_32x32x16_bf16(kf[2],qr[1],C0,0,0,0),   P0[10],P0[11],P0[12],P0[13], pw1[0]=PKW(P0,8), pw1[1]=PKW(P0,10), pw1); \
    VRD(5); SBAR(); GAPA(C1=__builtin_amdgcn_mfma_f32_32x32x16_bf16(kf[3],qr[1],C1,0,0,0),   P0[14],P0[15],P1[0],P1[1],   pw1[2]=PKW(P0,12),pw1[3]=PKW(P0,14), pw1); \
    VRD(2); SBAR(); GAPA(C0=__builtin_amdgcn_mfma_f32_32x32x16_bf16(kf[4],qr[2],C0,0,0,0),   P1[2],P1[3],P1[4],P1[5],     pw2[0]=PKW(P1,0), pw2[1]=PKW(P1,2), pw2); \
    VRD(6); SBAR(); GAPA(C1=__builtin_amdgcn_mfma_f32_32x32x16_bf16(kf[5],qr[2],C1,0,0,0),   P1[6],P1[7],P1[8],P1[9],     pw2[2]=PKW(P1,4), pw2[3]=PKW(P1,6), pw2); \
    VRD(3); SBAR(); GAPA(C0=__builtin_amdgcn_mfma_f32_32x32x16_bf16(kf[6],qr[3],C0,0,0,0),   P1[10],P1[11],P1[12],P1[13], pw3[0]=PKW(P1,8), pw3[1]=PKW(P1,10), pw3); \
    VRD(7); SBAR(); GAPA(C1=__builtin_amdgcn_mfma_f32_32x32x16_bf16(kf[7],qr[3],C1,0,0,0),   P1[14],P1[15],0.f,0.f,       pw3[2]=PKW(P1,12),pw3[3]=PKW(P1,14), pw3); \
    C0=__builtin_amdgcn_mfma_f32_32x32x16_bf16(ka0_,qaug,C0,0,0,0); C1=__builtin_amdgcn_mfma_f32_32x32x16_bf16(ka1_,qaug,C1,0,0,0); SBAR(); \
    l_reg+=sacc; \
    if(GK){DMA_K((t)+3,sl_cur);} if(GV){DMA_V((t)+1,sl_next);} \
    CMASK(C0,C1,t); \
    { float a=MX3(C0[0],C0[1],C1[0]),b=MX3(C0[2],C0[3],C1[1]); a=MX3(a,C1[2],C1[3]); \
      _Pragma("unroll") for(int r=4;r<16;r+=4){a=MX3(a,C0[r],C0[r+1]);b=MX3(b,C0[r+2],C0[r+3]);a=MX3(a,C1[r],C1[r+1]);b=MX3(b,C1[r+2],C1[r+3]);} \
      float rm=__builtin_fmaxf(a,b); { auto rr=__builtin_amdgcn_permlane32_swap(__float_as_uint(rm),__float_as_uint(rm),false,false); rm=__builtin_fmaxf(__uint_as_float(rr[0]),__uint_as_float(rr[1])); } \
      resc=false; \
      if(__builtin_expect(__any(rm>(float)THRL),0)){ const float dl=__builtin_fmaxf(rm,0.f); mhat+=dl; \
        _Pragma("unroll") for(int r=0;r<16;++r){C0[r]-=dl;C1[r]-=dl;} \
        qaug=make_qaug(mhat,hi); asm volatile("":"+v"(qaug)); \
        const float f=__builtin_amdgcn_exp2f(-dl); l_reg*=f; if(hi==0)wsf[r32]=f; resc=true; } } \
    SBAR(); \
    GAPB(o[0]=__builtin_amdgcn_mfma_f32_32x32x16_bf16(PAF(0),VFR(0),o[0],0,0,0), C0,0); \
    GAPB(o[1]=__builtin_amdgcn_mfma_f32_32x32x16_bf16(PAF(0),VFR(4),o[1],0,0,0), C0,4); \
    KRD(GL,0); GAPB(o[0]=__builtin_amdgcn_mfma_f32_32x32x16_bf16(PAF(1),VFR(1),o[0],0,0,0), C0,8); \
    KRD(GL,1); GAPB(o[1]=__builtin_amdgcn_mfma_f32_32x32x16_bf16(PAF(1),VFR(5),o[1],0,0,0), C0,12); \
    KRD(GL,2); GAPB(o[0]=__builtin_amdgcn_mfma_f32_32x32x16_bf16(PAF(2),VFR(2),o[0],0,0,0), C1,0); \
    KRD(GL,3); GAPB(o[1]=__builtin_amdgcn_mfma_f32_32x32x16_bf16(PAF(2),VFR(6),o[1],0,0,0), C1,4); \
    GAPB(o[0]=__builtin_amdgcn_mfma_f32_32x32x16_bf16(PAF(3),VFR(3),o[0],0,0,0), C1,8); \
    GAPB(o[1]=__builtin_amdgcn_mfma_f32_32x32x16_bf16(PAF(3),VFR(7),o[1],0,0,0), C1,12); \
    }while(0)
  int t=1;
  #undef CMASK
  #define CMASK(P0,P1,t) do{}while(0)
  for(;t+5<NT;t+=2){
    STEP(pB0,pB1,pA0,pA1,t,true,true,true);     WAIT_BAR(2); RESC(); ROT();
    STEP(pA0,pA1,pB0,pB1,t+1,true,true,true);   WAIT_BAR(2); RESC(); ROT();
  }
  #undef CMASK
  #define CMASK(P0,P1,t) do{int jb_=(t)-(NT-4); if(jb_>=0)cmask(P0,P1,jb_,qrel,hi);}while(0)
  #define ENDW(tt) do{ if((tt)+3<NT){WAIT_BAR(2);} else if((tt)+2<NT){WAIT_BAR(1);} else {WAIT_BAR(0);} }while(0)
  for(;t+1<NT;t+=2){
    STEP(pB0,pB1,pA0,pA1,t,(t+3<NT),(t+1<NT),(t+1<NT));       ENDW(t);   RESC(); ROT();
    STEP(pA0,pA1,pB0,pB1,t+1,(t+4<NT),(t+2<NT),(t+2<NT));     ENDW(t+1); RESC(); ROT();
  }
  STEP(pB0,pB1,pA0,pA1,NT-1,false,false,false); RESC();
  { float sacc=pB0[0]+pB0[1]; _Pragma("unroll") for(int r=2;r<16;++r)sacc+=pB0[r]; _Pragma("unroll") for(int r=0;r<16;++r)sacc+=pB1[r]; l_reg+=sacc;
    pw0=(u32x4){PKW(pB0,0),PKW(pB0,2),PKW(pB0,4),PKW(pB0,6)};pw1=(u32x4){PKW(pB0,8),PKW(pB0,10),PKW(pB0,12),PKW(pB0,14)};pw2=(u32x4){PKW(pB1,0),PKW(pB1,2),PKW(pB1,4),PKW(pB1,6)};pw3=(u32x4){PKW(pB1,8),PKW(pB1,10),PKW(pB1,12),PKW(pB1,14)};
    SBAR(); pv(o,vb0+sl_cur,PAF(0),PAF(1),PAF(2),PAF(3)); }
  #undef PKW
  #undef PAF
  #undef VFR
  #undef PIN
  #undef MX3
  #undef GAPA
  #undef GAPB
  #undef EX
  #undef VRD
  #undef KRD
  #undef STEP
  #undef ENDW
  {auto rr=__builtin_amdgcn_permlane32_swap(__float_as_uint(l_reg),__float_as_uint(l_reg),false,false);l_reg=__uint_as_float(rr[0])+__uint_as_float(rr[1]);}
  if(hi==0)wsf[32+r32]=l_reg;asm volatile("s_waitcnt lgkmcnt(0)":::"memory");
  float rli[16];
  #pragma unroll
  for(int r=0;r<16;++r)rli[r]=__builtin_amdgcn_rcpf(wsf[32+crow(r,hi)]);
  bf16*Ow=O+(rowbase+q0+wid*QBLK)*PO+OCOL+h*D;
  { bf16*stg=(bf16*)(shm+LDS_OST)+wid*2048;
    #pragma unroll
    for(int r=0;r<16;++r){const int orow=crow(r,hi);
      #pragma unroll
      for(int d0=0;d0<2;++d0)stg[orow*64+d0*32+r32]=__float2bfloat16(o[d0][r]*rli[r]);}
    asm volatile("s_waitcnt lgkmcnt(0)":::"memory");
    #pragma unroll
    for(int i=0;i<4;++i){const int row=i*8+(lane>>3),ch=lane&7; const u32x4 v=*(const u32x4*)(stg+row*64+ch*8); ATTN_STORE16(Ow+(long)row*PO+ch*8,v);} }
  asm volatile("s_waitcnt lgkmcnt(0)\n\ts_barrier":::"memory");
  #undef DMA_K
  #undef DMA_V
  #undef CMASK
  #undef START
  #undef RESC
  #undef ROT
}
constexpr int ATTN_LDS_BYTES=LDS_BYTES;
#undef SBAR
#undef WAIT_BAR
}
constexpr int NWAVES = 8;
constexpr int D = 1024, BATCH = 8, SEQ = 2048, M = BATCH * SEQ;
constexpr int N_INSRC = 7176, N_INV = 7168;
constexpr int FL_COL = 3072;
constexpr int DFF_D = 2816, DFF_E = 3584, NEXP = 8;
constexpr float LN_EPS = 1e-5f, GN_EPS = 1e-6f;
constexpr float ALPHA = 1.4142135623730951f;
constexpr float LOG2E = 1.4426950408889634f;
constexpr float C2 = 0.125f * LOG2E;

constexpr size_t MiB = 1u << 20;
constexpr size_t WS_CTL = 0, CTL_ZERO_BYTES = 192 * 1024;
constexpr size_t WS_CS = 1 * MiB;
constexpr size_t WS_LIST = 2 * MiB;
constexpr size_t WS_GATEW = 2 * MiB + 512 * 1024;
constexpr size_t WS_LOGF = 3 * MiB;
constexpr size_t WS_GST = 3 * MiB + 512 * 1024;
constexpr size_t WS_WIN = 4 * MiB;
constexpr size_t WS_WBR = 32 * MiB;
constexpr size_t WS_WOUT = 38 * MiB;
constexpr size_t WS_WDU = 42 * MiB;
constexpr size_t WS_WDD = 53 * MiB;
constexpr size_t WS_WMU = 59 * MiB;
constexpr size_t WS_WMD = 171 * MiB;
constexpr size_t WS_XB = 227 * MiB;
constexpr size_t WS_XF = 259 * MiB;
constexpr size_t WS_YPRE = 323 * MiB;
constexpr size_t WS_C1 = 387 * MiB;
constexpr size_t WS_MRG = 451 * MiB;
constexpr size_t WS_RQ = 483 * MiB, WS_RK = 491 * MiB, WS_RV = 499 * MiB, WS_RG = 515 * MiB, WS_FQ = 531 * MiB, WS_FK = 547 * MiB, WS_FV = 563 * MiB,
                 WS_GU = 579 * MiB, WS_GV = 595 * MiB, WS_GT = 611 * MiB, WS_YB = 707 * MiB, WS_KV = 755 * MiB  , WS_X8IN = 771 * MiB  , WS_WIN8 = 787 * MiB  , WS_END = 793 * MiB;
constexpr size_t WS_HID = 483 * MiB;
static_assert((size_t)34816 * DFF_E <= WS_KV - WS_HID, "MoE hidden fits its overlay");
constexpr int CW_TMO = 0, CW_CODE = 1;
constexpr int CW_CNT = 64;
constexpr int CW_BAR = 4096;

constexpr int RING_OFF = 0, RING_BYTES = 141312;
constexpr int LDSCTL_OFF = RING_BYTES, MISC_OFF = LDSCTL_OFF + 320, PTAB_OFF = LDSCTL_OFF + 1024;
constexpr int LDS_BYTES = 147456;
static_assert(MISC_OFF + 128 <= PTAB_OFF && PTAB_OFF + 20 * 8 <= LDS_BYTES, "LDS map");

#define GAS __attribute__((address_space(1)))
#define LAS __attribute__((address_space(3)))
typedef unsigned short bf16;
typedef unsigned v4u __attribute__((ext_vector_type(4)));
typedef unsigned v2u __attribute__((ext_vector_type(2)));
typedef float f32x4 __attribute__((ext_vector_type(4)));
typedef GAS unsigned gu32;
#define RLX_AGENT __ATOMIC_RELAXED, __HIP_MEMORY_SCOPE_AGENT
#define LDS_WAIT() asm volatile("s_waitcnt lgkmcnt(0)" ::: "memory")
#define VM_WAIT() asm volatile("s_waitcnt vmcnt(0)" ::: "memory")
__device__ __forceinline__ unsigned f2bf(float f) { unsigned u = __builtin_bit_cast(unsigned, f); return (u + 0x7fffu + ((u >> 16) & 1u)) >> 16; }
__device__ __forceinline__ unsigned pk2(float lo, float hi) { return f2bf(lo) | (f2bf(hi) << 16); }
__device__ __forceinline__ float bf2f(unsigned short h) { return __builtin_bit_cast(float, (unsigned)h << 16); }
__device__ __forceinline__ float bflo(unsigned w) { return __builtin_bit_cast(float, w << 16); }
__device__ __forceinline__ float bfhi(unsigned w) { return __builtin_bit_cast(float, w & 0xffff0000u); }
constexpr float SC_X8 = 16.f, SC_WU8 = 32.f, SC_H8 = 8.f, SC_WD8 = 128.f;
constexpr float SWI_A = 1.4426950408889634f, SWI_B = SC_H8 / 1.4426950408889634f;
constexpr unsigned E8_UP = 0x76767676u  , E8_DN = 0x75757575u  ;
__device__ __forceinline__ float clamp448(float x) { return fminf(fmaxf(x, -448.f), 448.f); }
__device__ __forceinline__ unsigned pk4_fp8(float a, float b, float c, float d) {
    int w = __builtin_amdgcn_cvt_pk_fp8_f32(clamp448(a), clamp448(b), 0, false); w = __builtin_amdgcn_cvt_pk_fp8_f32(clamp448(c), clamp448(d), w, true); return (unsigned)w; }
constexpr float SC_XI8 = 127.f / 4.5f, SC_WI8 = 127.f * 32.f / 4.f;
__device__ __forceinline__ unsigned pk4_i8(float a, float b, float c, float d) {
    unsigned w = 0u;
    w = __builtin_amdgcn_cvt_pk_u8_f32(__builtin_rintf(a) + 128.f, 0u, w); w = __builtin_amdgcn_cvt_pk_u8_f32(__builtin_rintf(b) + 128.f, 1u, w);
    w = __builtin_amdgcn_cvt_pk_u8_f32(__builtin_rintf(c) + 128.f, 2u, w); w = __builtin_amdgcn_cvt_pk_u8_f32(__builtin_rintf(d) + 128.f, 3u, w);
    return w ^ 0x80808080u; }
__device__ __forceinline__ float fsigmoid(float x) { return __builtin_amdgcn_rcpf(1.0f + __builtin_amdgcn_exp2f(-x * LOG2E)); }
__device__ __forceinline__ float fsilu(float x) { return x * fsigmoid(x); }
typedef float f2v __attribute__((ext_vector_type(2)));
__device__ __forceinline__ f2v fsigmoid2(f2v x) { const f2v t = x * (-LOG2E); f2v e; e.x = __builtin_amdgcn_exp2f(t.x); e.y = __builtin_amdgcn_exp2f(t.y); const f2v d = e + 1.0f; f2v r; r.x = __builtin_amdgcn_rcpf(d.x); r.y = __builtin_amdgcn_rcpf(d.y); return r; }
__device__ __forceinline__ f2v fsilu2(f2v x) { return x * fsigmoid2(x); }
__device__ __forceinline__ f2v swi_folded2(f2v a, f2v b) { f2v e; e.x = __builtin_amdgcn_exp2f(-a.x); e.y = __builtin_amdgcn_exp2f(-a.y); const f2v d = e + 1.0f; f2v r; r.x = __builtin_amdgcn_rcpf(d.x); r.y = __builtin_amdgcn_rcpf(d.y); return (a * b) * r; }
__device__ __forceinline__ f2v fgelu_tanh2(f2v x) {
    const f2v t = x * (x * x * (-0.0713548163f * LOG2E) + (-1.5957691216f * LOG2E)); f2v e; e.x = __builtin_amdgcn_exp2f(t.x); e.y = __builtin_amdgcn_exp2f(t.y);
    const f2v d = e + 1.0f; f2v r; r.x = __builtin_amdgcn_rcpf(d.x); r.y = __builtin_amdgcn_rcpf(d.y); return x * r; }
__device__ __forceinline__ float fgelu_tanh(float x) { const float u = 0.7978845608028654f * (x + 0.044715f * x * x * x); return x * fsigmoid(2.0f * u); }

#define XB_TMO      128
#define XB_XCNT(j)  (256  + 64 * (j))
#define XB_XSUB(j)  (1280 + 64 * (j))
#define XB_XGEN(j)  (2304 + 64 * (j))
#define XB_TOP      3328
#define XB_TOPGEN   3392
#define XCD_BAR_WORDS 3456
#define XB_SPIN_CAP (1u << 18)
__device__ __forceinline__ unsigned xb_ld(unsigned* p)              { return __hip_atomic_load(p, __ATOMIC_RELAXED, __HIP_MEMORY_SCOPE_AGENT); }
__device__ __forceinline__ unsigned xb_add(unsigned* p, unsigned v) { return __hip_atomic_fetch_add(p, v, __ATOMIC_RELAXED, __HIP_MEMORY_SCOPE_AGENT); }
__device__ __forceinline__ unsigned xb_xcc_id() { return (unsigned)__builtin_amdgcn_s_getreg((3 << 11) | 20) & 0xFu; }
#define XB_SPIN(cond, bar) do { unsigned _sp = 0; while (cond) { __builtin_amdgcn_s_sleep(1); \
    if ((++_sp & 255u) == 0u) { if (xb_ld(&(bar)[XB_TMO])) break; if (_sp > XB_SPIN_CAP) { atomicAdd(&(bar)[XB_TMO], 1u); break; } } } } while (0)
struct XcdBarrier { unsigned* bar; unsigned x; volatile LAS unsigned* st; unsigned total; unsigned lite; };
__device__ __forceinline__ XcdBarrier xcd_barrier_post(unsigned* bar, volatile LAS unsigned* st, unsigned total, unsigned lite) {
    XcdBarrier b; b.bar = bar; b.x = xb_xcc_id(); b.st = st; b.total = total; b.lite = lite;
    if (threadIdx.x == 0) (void)xb_add(&bar[XB_XCNT(b.x)], 1u);
    return b;
}
__device__ __forceinline__ void xcd_barrier_complete(unsigned* bar, unsigned x, unsigned G, unsigned& nloc, unsigned& nx) {
    unsigned sum, cnt, mine, sp = 0u;
    for (;;) {
        sum = 0u; cnt = 0u; mine = 0u;
#pragma unroll
        for (unsigned j = 0; j < 16; ++j) { const unsigned c = xb_ld(&bar[XB_XCNT(j)]); sum += c; cnt += (c > 0u) ? 1u : 0u; mine = (j == x) ? c : mine; }
        if (sum == G) break;
        __builtin_amdgcn_s_sleep(1);
        if ((++sp & 255u) == 0u) { if (xb_ld(&bar[XB_TMO])) break; if (sp > XB_SPIN_CAP) { atomicAdd(&bar[XB_TMO], 1u); break; } }
    }
    nloc = mine > 0u ? mine : 1u; nx = cnt > 0u ? cnt : 1u;
}
__device__ __forceinline__ void xcd_barrier(const XcdBarrier& b) {
    asm volatile("s_waitcnt vmcnt(0)" ::: "memory");
    __syncthreads();
    if (threadIdx.x == 0) {
        unsigned* bar = b.bar;
        __builtin_amdgcn_s_waitcnt(0);
        unsigned nloc = b.st[0], nx = b.st[1];
        if (nloc == 0u) { xcd_barrier_complete(bar, b.x, b.total, nloc, nx); b.st[0] = nloc; b.st[1] = nx; }
        const unsigned old = xb_add(&bar[XB_XSUB(b.x)], 1u);
        const unsigned gen = old / nloc;
        if (old + 1u == (gen + 1u) * nloc) {
            if (!(b.lite != 0u && nx == 1u)) {
                __builtin_amdgcn_fence(__ATOMIC_RELEASE, "agent");
                asm volatile("s_waitcnt vmcnt(0)" ::: "memory");
            }
            if (nx != 1u) {
                const unsigned og = xb_add(&bar[XB_TOP], 1u);
                const unsigned tg = og / nx;
                if (og + 1u == (tg + 1u) * nx) xb_add(&bar[XB_TOPGEN], 1u);
                else XB_SPIN(xb_ld(&bar[XB_TOPGEN]) == tg, bar);
            }
            __builtin_amdgcn_fence(__ATOMIC_ACQUIRE, "agent");
            xb_add(&bar[XB_XGEN(b.x)], 1u);
            asm volatile("s_waitcnt vmcnt(0)" ::: "memory");
        } else {
            XB_SPIN(xb_ld(&bar[XB_XGEN(b.x)]) == gen, bar);
            __builtin_amdgcn_fence(__ATOMIC_ACQUIRE, "agent");
            asm volatile("s_waitcnt vmcnt(0)" ::: "memory");
        }
    }
    __syncthreads();
}

using pg8::Unit; using pg8::bf16_t;
#define ACC_T const pg8::f32x4 (&acc)[2][2][4][2]

struct ProjSched : pg8::PlainSched {
    __device__ __forceinline__ bool next(int i, Unit& u) const { if (!pg8::PlainSched::next(i, u)) return false; if (nN == 16 && ((u.pm >> 2) & 1)) u.pn = (u.pn + 4) & 15; return true; }
};
typedef int i32x4_t __attribute__((ext_vector_type(4)));
template <bool I8IN> __device__ __forceinline__ pg8::f32x4 ldacc(const pg8::f32x4& r) {
    if constexpr (I8IN) return __builtin_convertvector(__builtin_bit_cast(i32x4_t, r), pg8::f32x4) * (1.0f / (SC_XI8 * SC_WI8)); else return r; }
template <bool I8IN>
struct EpiProjT {
    static constexpr bool PERM = true, HOOK = false, DUPME = true;
    unsigned char* ws; const float* gate_b; const float* cs;
    __device__ __forceinline__ void operator()(ACC_T, const Unit& u, int wr, int wc, int fr, int fq) const {
        const int pn = u.pn, row0 = u.pm * 256 + wr * 64 + fr, lc = wc * 32 + 8 * fq;
        if (pn < 2) {
            bf16_t* dst = (bf16_t*)(ws + (pn == 0 ? WS_RQ : WS_RK)); const float sc = pn == 0 ? 1.0f : 0.125f;
            const int d1 = 16 * (wc & 1) + 4 * fq;
#pragma unroll
            for (int ai = 0; ai < 2; ++ai)
#pragma unroll
                for (int m = 0; m < 4; ++m) { const int row = row0 + ai * 128 + m * 16, pos = row & (SEQ - 1);
                    const f32x4 c4 = *(const f32x4*)(cs + pos * 32 + d1), s4 = *(const f32x4*)(cs + 65536 + pos * 32 + d1);
#pragma unroll
                    for (int bj = 0; bj < 2; ++bj) { const int head = bj * 2 + (wc >> 1); const f32x4 x1 = ldacc<I8IN>(acc[ai][bj][m][0]), x2 = ldacc<I8IN>(acc[ai][bj][m][1]);
                        const f32x4 o1 = (x1 * c4 - x2 * s4) * sc, o2 = (x1 * s4 + x2 * c4) * sc;
                        bf16_t* p = dst + (size_t)row * 256 + head * 64 + d1;
                        v2u w1, w2; w1.x = pg8::cvt_pk_bf16(o1[0], o1[1]); w1.y = pg8::cvt_pk_bf16(o1[2], o1[3]); w2.x = pg8::cvt_pk_bf16(o2[0], o2[1]); w2.y = pg8::cvt_pk_bf16(o2[2], o2[3]);
                        *(v2u*)p = w1; *(v2u*)(p + 32) = w2; } }
            return;
        }
        if (pn < 4) store_act<0>(acc, WS_RV, 512, (pn - 2) * 256, row0, lc);
        else if (pn < 6) store_act<1>(acc, WS_RG, 512, (pn - 4) * 256, row0, lc);
        else if (pn < 8) store_act<2>(acc, WS_FQ, 512, (pn - 6) * 256, row0, lc);
        else if (pn < 10) store_act<0>(acc, WS_FK, 512, (pn - 8) * 256, row0, lc);
        else if (pn < 12) store_act<0>(acc, WS_FV, 512, (pn - 10) * 256, row0, lc);
        else if (pn < 14) store_act<3>(acc, WS_GU, 512, (pn - 12) * 256, row0, lc);
        else if (GATES_FP8 == 2 || P1_I8 || pn < 16) store_act<3>(acc, WS_GV, 512, (pn - 14) * 256, row0, lc);
#if GATES_FP8 != 2 && !P1_I8
        else store_act<4>(acc, WS_GT, 3072, (pn - 16) * 256, row0, lc);
#endif
    }
    template <int ACT>
    __device__ __forceinline__ void store_act(ACC_T, size_t off, int pitch, int coff, int row0, int lc) const {
        bf16_t* dst = (bf16_t*)(ws + off);
        f32x4 bv[2][2];
#pragma unroll
        for (int bj = 0; bj < 2; ++bj)
#pragma unroll
            for (int n = 0; n < 2; ++n) bv[bj][n] = (ACT == 4) ? *(const f32x4*)(gate_b + coff + bj * 128 + lc + 4 * n) : (f32x4){0.f, 0.f, 0.f, 0.f};
#pragma unroll
        for (int ai = 0; ai < 2; ++ai)
#pragma unroll
            for (int m = 0; m < 4; ++m) { bf16_t* rowp = dst + (size_t)(row0 + ai * 128 + m * 16) * pitch + coff + lc;
#pragma unroll
                for (int bj = 0; bj < 2; ++bj) { f2v v[4];
#pragma unroll
                    for (int n = 0; n < 2; ++n) { const f32x4 a = ldacc<I8IN>(acc[ai][bj][m][n]); v[2 * n] = __builtin_shufflevector(a, a, 0, 1); v[2 * n + 1] = __builtin_shufflevector(a, a, 2, 3);
                        if (ACT == 4) { v[2 * n] += __builtin_shufflevector(bv[bj][n], bv[bj][n], 0, 1); v[2 * n + 1] += __builtin_shufflevector(bv[bj][n], bv[bj][n], 2, 3); } }
#pragma unroll
                    for (int j = 0; j < 4; ++j) { f2v x = v[j];
                        if (ACT == 1) x = fsilu2(x); else if (ACT == 2) x = x * C2; else if (ACT == 3) x = fgelu_tanh2(x); else if (ACT == 4) x = fsigmoid2(x);
                        v[j] = x; }
                    v4u w; w.x = pg8::cvt_pk_bf16(v[0].x, v[0].y); w.y = pg8::cvt_pk_bf16(v[1].x, v[1].y); w.z = pg8::cvt_pk_bf16(v[2].x, v[2].y); w.w = pg8::cvt_pk_bf16(v[3].x, v[3].y);
                    *(v4u*)(rowp + bj * 128) = w; } }
    }
};

using EpiProj = EpiProjT<false>;
template <bool I8IN>
struct EpiGate8T {
    static constexpr bool PERM = true, HOOK = false, DUPME = false;
    bf16_t* GT; const float* gate_b;
    __device__ __forceinline__ void operator()(ACC_T, const Unit& u, int wr, int wc, int fr, int fq) const {
        const int row0 = u.pm * 256 + wr * 64 + fr, lc = wc * 32 + 8 * fq, coff = u.pn * 256;
        f32x4 bv[2][2];
#pragma unroll
        for (int bj = 0; bj < 2; ++bj)
#pragma unroll
            for (int n = 0; n < 2; ++n) bv[bj][n] = *(const f32x4*)(gate_b + coff + bj * 128 + lc + 4 * n);
#pragma unroll
        for (int ai = 0; ai < 2; ++ai)
#pragma unroll
            for (int m = 0; m < 4; ++m) { bf16_t* rowp = GT + (size_t)(row0 + ai * 128 + m * 16) * 3072 + coff + lc;
#pragma unroll
                for (int bj = 0; bj < 2; ++bj) { f2v v[4];
#pragma unroll
                    for (int n = 0; n < 2; ++n) { const f32x4 a = ldacc<I8IN>(acc[ai][bj][m][n]) + bv[bj][n]; v[2 * n] = fsigmoid2(__builtin_shufflevector(a, a, 0, 1)); v[2 * n + 1] = fsigmoid2(__builtin_shufflevector(a, a, 2, 3)); }
                    v4u w; w.x = pg8::cvt_pk_bf16(v[0].x, v[0].y); w.y = pg8::cvt_pk_bf16(v[1].x, v[1].y); w.z = pg8::cvt_pk_bf16(v[2].x, v[2].y); w.w = pg8::cvt_pk_bf16(v[3].x, v[3].y);
                    *(v4u*)(rowp + bj * 128) = w; } }
    }
};

using EpiGate8 = EpiGate8T<false>;
struct EpiMerge {
    static constexpr bool PERM = true, HOOK = true, DUPME = false;
    const bf16_t* GT; bf16_t* MRG;
    __device__ __forceinline__ void unpackg(const v4u w, float (&g)[8]) const {
        g[0] = bflo(w.x); g[1] = bfhi(w.x); g[2] = bflo(w.y); g[3] = bfhi(w.y); g[4] = bflo(w.z); g[5] = bfhi(w.z); g[6] = bflo(w.w); g[7] = bfhi(w.w);
#pragma unroll
        for (int j = 0; j < 8; ++j) g[j] = fmaxf(g[j], 1e-30f);
    }
    __device__ __forceinline__ void khook(pg8::f32x4 (&acc)[2][2][4][2], const Unit& u, int t, int wr, int wc, int fr, int fq) const {
        if (t != 8 && t != 16) return;
        const int np = (t == 8) ? 0 : 1; int row0 = u.pm * 256 + wr * 64 + fr; const int col0 = u.pn * 256 + wc * 32 + 8 * fq;
        asm volatile("" : "+v"(row0));
#pragma unroll
        for (int ai = 0; ai < 2; ++ai) {
            v4u wp[4][2], wn[4][2];
#pragma unroll
            for (int m = 0; m < 4; ++m)
#pragma unroll
                for (int bj = 0; bj < 2; ++bj) { const bf16_t* p = GT + (size_t)(row0 + ai * 128 + m * 16) * 3072 + np * 1024 + col0 + bj * 128; wp[m][bj] = *(const v4u*)p; wn[m][bj] = *(const v4u*)(p + 1024); }
#pragma unroll
            for (int m = 0; m < 4; ++m)
#pragma unroll
                for (int bj = 0; bj < 2; ++bj) { const unsigned pw[4] = {wp[m][bj].x, wp[m][bj].y, wp[m][bj].z, wp[m][bj].w}, nw[4] = {wn[m][bj].x, wn[m][bj].y, wn[m][bj].z, wn[m][bj].w};
#pragma unroll
                    for (int q = 0; q < 4; ++q) {
                        f2v gp2, gn2; gp2.x = bflo(pw[q]); gp2.y = bfhi(pw[q]); gn2.x = fmaxf(bflo(nw[q]), 1e-30f); gn2.y = fmaxf(bfhi(nw[q]), 1e-30f);
                        f2v r2; r2.x = __builtin_amdgcn_rcpf(gn2.x); r2.y = __builtin_amdgcn_rcpf(gn2.y); const f2v ratio = gp2 * r2;
                        pg8::f32x4& a4 = acc[ai][bj][m][q >> 1];
                        if (q & 1) { a4.z *= ratio.x; a4.w *= ratio.y; } else { a4.x *= ratio.x; a4.y *= ratio.y; } } }
            asm volatile("" ::: "memory");
        }
    }
    __device__ __forceinline__ void operator()(ACC_T, const Unit& u, int wr, int wc, int fr, int fq) const {
        const int row0 = u.pm * 256 + wr * 64 + fr, col0 = u.pn * 256 + wc * 32 + 8 * fq;
#pragma unroll
        for (int ai = 0; ai < 2; ++ai) {
            v4u wg[4][2];
#pragma unroll
            for (int m = 0; m < 4; ++m)
#pragma unroll
                for (int bj = 0; bj < 2; ++bj) wg[m][bj] = *(const v4u*)(GT + (size_t)(row0 + ai * 128 + m * 16) * 3072 + 2048 + col0 + bj * 128);
#pragma unroll
            for (int m = 0; m < 4; ++m)
#pragma unroll
                for (int bj = 0; bj < 2; ++bj) { const unsigned gw[4] = {wg[m][bj].x, wg[m][bj].y, wg[m][bj].z, wg[m][bj].w}; unsigned o[4];
#pragma unroll
                    for (int q = 0; q < 4; ++q) { f2v g2; g2.x = bflo(gw[q]); g2.y = bfhi(gw[q]); const pg8::f32x4 a4 = acc[ai][bj][m][q >> 1];
                        f2v a2; if (q & 1) { a2.x = a4.z; a2.y = a4.w; } else { a2.x = a4.x; a2.y = a4.y; } const f2v p = a2 * g2; o[q] = pg8::cvt_pk_bf16(p.x, p.y); }
                    v4u w; w.x = o[0]; w.y = o[1]; w.z = o[2]; w.w = o[3];
                    *(v4u*)(MRG + (size_t)(row0 + ai * 128 + m * 16) * 1024 + col0 + bj * 128) = w; }
            asm volatile("" ::: "memory");
        }
    }
};

struct EpiResid {
    static constexpr bool PERM = false, HOOK = false, DUPME = false;
    const float* res; float* out;
    __device__ __forceinline__ void operator()(ACC_T, const Unit& u, int wr, int wc, int fr, int fq) const {
        const int row0 = u.pm * 256 + wr * 64 + fr, col0 = u.pn * 256 + wc * 32 + 4 * fq;
#pragma unroll
        for (int ai = 0; ai < 2; ++ai)
#pragma unroll
            for (int m = 0; m < 4; ++m) { const size_t off = (size_t)(row0 + ai * 128 + m * 16) * 1024 + col0;
#pragma unroll
                for (int bj = 0; bj < 2; ++bj)
#pragma unroll
                    for (int n = 0; n < 2; ++n) { const f32x4 r = *(const f32x4*)(res + off + bj * 128 + n * 16); *(f32x4*)(out + off + bj * 128 + n * 16) = r * ALPHA + acc[ai][bj][m][n]; } }
    }
};

struct EpiSwiglu {
    static constexpr bool PERM = true, HOOK = false, DUPME = false;
    bf16_t* H; int ldh;
    __device__ __forceinline__ void operator()(ACC_T, const Unit& u, int wr, int wc, int fr, int fq) const {
        const int row0 = u.pm * 256 + wr * 64 + fr, col0 = u.pn * 128 + wc * 16 + 4 * fq;
#pragma unroll
        for (int ai = 0; ai < 2; ++ai)
#pragma unroll
            for (int m = 0; m < 4; ++m) { bf16_t* rowp = H + (size_t)(row0 + ai * 128 + m * 16) * ldh + col0;
#pragma unroll
                for (int bj = 0; bj < 2; ++bj) { const f32x4 a = acc[ai][bj][m][0], b = acc[ai][bj][m][1];
                    const f2v o01 = fsilu2(__builtin_shufflevector(a, a, 0, 1)) * __builtin_shufflevector(b, b, 0, 1), o23 = fsilu2(__builtin_shufflevector(a, a, 2, 3)) * __builtin_shufflevector(b, b, 2, 3);
                    v2u w; w.x = pg8::cvt_pk_bf16(o01.x, o01.y); w.y = pg8::cvt_pk_bf16(o23.x, o23.y);
                    *(v2u*)(rowp + bj * 64) = w; } }
    }
};

struct EpiSwigluI8 {
    static constexpr bool PERM = true, HOOK = false, DUPME = false;
    bf16_t* H; int ldh;
    __device__ __forceinline__ void operator()(ACC_T, const Unit& u, int wr, int wc, int fr, int fq) const {
        typedef int i32x4_t __attribute__((ext_vector_type(4)));
        constexpr float CA = LOG2E / (SC_XI8 * SC_WI8), CB = 1.0f / (SC_XI8 * SC_WI8 * LOG2E);
        const int row0 = u.pm * 256 + wr * 64 + fr, col0 = u.pn * 128 + wc * 16 + 4 * fq;
#pragma unroll
        for (int ai = 0; ai < 2; ++ai)
#pragma unroll
            for (int m = 0; m < 4; ++m) { bf16_t* rowp = H + (size_t)(row0 + ai * 128 + m * 16) * ldh + col0;
#pragma unroll
                for (int bj = 0; bj < 2; ++bj) {
                    const f32x4 a = __builtin_convertvector(__builtin_bit_cast(i32x4_t, acc[ai][bj][m][0]), f32x4) * CA, b = __builtin_convertvector(__builtin_bit_cast(i32x4_t, acc[ai][bj][m][1]), f32x4) * CB;
                    const f2v o01 = swi_folded2(__builtin_shufflevector(a, a, 0, 1), __builtin_shufflevector(b, b, 0, 1)), o23 = swi_folded2(__builtin_shufflevector(a, a, 2, 3), __builtin_shufflevector(b, b, 2, 3));
                    v2u w; w.x = pg8::cvt_pk_bf16(o01.x, o01.y); w.y = pg8::cvt_pk_bf16(o23.x, o23.y);
                    *(v2u*)(rowp + bj * 64) = w; } }
    }
};

struct MoeTiles {
    int cnt[NEXP]; int toff[NEXP + 1];
    __device__ __forceinline__ void init(const gu32* ctl) {
        int t = 0;
#pragma unroll
        for (int e = 0; e < NEXP; ++e) { cnt[e] = __builtin_amdgcn_readfirstlane((int)__hip_atomic_load(ctl + CW_CNT + 64 * e, RLX_AGENT)); toff[e] = t; t += (cnt[e] + 255) >> 8; }
        toff[NEXP] = t;
    }
    __device__ __forceinline__ void find(int pm, int& e, int& slot0, int& n) const {
        int ee = 0;
#pragma unroll
        for (int j = 1; j < NEXP; ++j) if (pm >= toff[j]) ee = j;
        int c = 0, t0 = 0;
#pragma unroll
        for (int j = 0; j < NEXP; ++j) if (j == ee) { c = cnt[j]; t0 = toff[j]; }
        e = ee; slot0 = (pm - t0) * 256; n = c;
    }
    __device__ __forceinline__ int nfull_total() const { int a = 0;
#pragma unroll
        for (int j = 0; j < NEXP; ++j) a += cnt[j] >> 8;
        return a; }
    __device__ __forceinline__ void findfull(int pmf, int& e, int& lt, int& htile) const {
        int a = 0, ee = 0, ll = 0, hh = 0;
#pragma unroll
        for (int j = 0; j < NEXP; ++j) { const int nf = cnt[j] >> 8; if (pmf >= a && pmf < a + nf) { ee = j; ll = pmf - a; hh = toff[j] + ll; } a += nf; }
        e = ee; lt = ll; htile = hh;
    }
    __device__ __forceinline__ void expert(int e, int& c, int& t0) const { int cc = 0, tt = 0;
#pragma unroll
        for (int j = 0; j < NEXP; ++j) if (j == e) { cc = cnt[j]; tt = toff[j]; }
        c = cc; t0 = tt; }
};
struct MoeUpSched : pg8::TileOrder {
    static constexpr bool GATHER = true;
    const unsigned char* A; const unsigned char* Bt; const unsigned* list; MoeTiles mt;
    __device__ __forceinline__ const char* abase(const Unit&) const { return (const char*)A; }
    __device__ __forceinline__ void aoffs_load(const Unit& u, const int (&R)[2], PG8_LAS unsigned* scr) const {
        int e, s0, n; mt.find(u.pm, e, s0, n);
#pragma unroll
        for (int h = 0; h < 2; ++h)
#pragma unroll
            for (int i = 0; i < 2; ++i) { int slot = s0 + R[i] + h * 128; slot = slot < 16383 ? slot : 16383;
                __builtin_amdgcn_global_load_lds(list + e * 16384 + slot, scr + (h * 2 + i) * 64, 4, 0, 0); }
    }
    __device__ __forceinline__ void aoffs_fin(const Unit& u, const int (&R)[2], const int (&C)[2], const PG8_LAS unsigned* scr, int lane, unsigned (&o)[2][2]) const {
        int e, s0, n; mt.find(u.pm, e, s0, n);
#pragma unroll
        for (int h = 0; h < 2; ++h)
#pragma unroll
            for (int i = 0; i < 2; ++i) { const int slot = s0 + R[i] + h * 128; const unsigned w = scr[(h * 2 + i) * 64 + lane]; const unsigned tok = slot < n ? (w & 0x7fffffffu) : 0u; o[h][i] = tok * 1024u + 2u * (unsigned)C[i]; }
    }
    __device__ __forceinline__ const char* bbase(const Unit& u) const { int e, s0, n; mt.find(u.pm, e, s0, n); return (const char*)Bt + ((size_t)e * (2 * DFF_E) + (size_t)u.pn * 256) * 1024; }
};
struct MoeDownSched : pg8::TileOrder {
    static constexpr bool GATHER = false;
    const unsigned char* A; const unsigned char* Bt; MoeTiles mt;
    __device__ __forceinline__ const char* abase(const Unit& u) const { int e, lt, ht; mt.findfull(u.pm, e, lt, ht); return (const char*)A + (size_t)ht * 256 * DFF_E; }
    __device__ __forceinline__ void aoffs_load(const Unit&, const int (&)[2], PG8_LAS unsigned*) const {}
    __device__ __forceinline__ void aoffs_fin(const Unit&, const int (&)[2], const int (&)[2], const PG8_LAS unsigned*, int, unsigned (&)[2][2]) const {}
    __device__ __forceinline__ const char* bbase(const Unit& u) const { int e, lt, ht; mt.findfull(u.pm, e, lt, ht); return (const char*)Bt + ((size_t)e * 1024 + (size_t)u.pn * 256) * DFF_E; }
};
struct EpiSwiglu8 {
    static constexpr bool PERM = true, HOOK = false, DUPME = false;
    unsigned char* H; int ldh;
    static __device__ __forceinline__ f2v swi8x2(f2v a, f2v b) {
        f2v e; e.x = __builtin_amdgcn_exp2f(-a.x); e.y = __builtin_amdgcn_exp2f(-a.y); const f2v d = e + 1.0f; f2v r; r.x = __builtin_amdgcn_rcpf(d.x); r.y = __builtin_amdgcn_rcpf(d.y); return (a * b) * r; }
    static __device__ __forceinline__ float swi8(float a, float b) { return (a * b) * __builtin_amdgcn_rcpf(1.0f + __builtin_amdgcn_exp2f(-a)); }
    __device__ __forceinline__ void operator()(ACC_T, const Unit& u, int wr, int wc, int fr, int fq) const {
        const int row0 = u.pm * 256 + wr * 64 + fr, col0 = u.pn * 128 + wc * 16;
#pragma unroll
        for (int ai = 0; ai < 2; ++ai)
#pragma unroll
            for (int bj = 0; bj < 2; ++bj) { unsigned x[4];
#pragma unroll
                for (int m = 0; m < 4; ++m) { const f32x4 a = acc[ai][bj][m][0], b = acc[ai][bj][m][1];
                    const f2v o01 = swi8x2(__builtin_shufflevector(a, a, 0, 1), __builtin_shufflevector(b, b, 0, 1)), o23 = swi8x2(__builtin_shufflevector(a, a, 2, 3), __builtin_shufflevector(b, b, 2, 3));
                    x[m] = pk4_fp8(o01.x, o01.y, o23.x, o23.y); }
                const auto p01 = __builtin_amdgcn_permlane16_swap(x[0], x[1], false, false), p23 = __builtin_amdgcn_permlane16_swap(x[2], x[3], false, false);
                const auto q02 = __builtin_amdgcn_permlane32_swap(p01[0], p23[0], false, false), q13 = __builtin_amdgcn_permlane32_swap(p01[1], p23[1], false, false);
                v4u w; w.x = q02[0]; w.y = q13[0]; w.z = q02[1]; w.w = q13[1];
                *(v4u*)(H + (size_t)(row0 + ai * 128 + fq * 16) * ldh + col0 + bj * 64) = w; }
    }
};
struct EpiMoeDown {
    static constexpr bool PERM = true, HOOK = false, DUPME = false;
    bf16_t* c0; bf16_t* c1; const unsigned* list; const float* gatew; MoeTiles mt;
    __device__ __forceinline__ void operator()(ACC_T, const Unit& u, int wr, int wc, int fr, int fq) const {
        int e, lt, ht; mt.findfull(u.pm, e, lt, ht); const int s0 = lt * 256;
        const int col0 = u.pn * 256 + wc * 32 + 8 * fq;
        unsigned ent[2][4]; float gg[2][4];
#pragma unroll
        for (int ai = 0; ai < 2; ++ai)
#pragma unroll
            for (int m = 0; m < 4; ++m) { const int slot = s0 + ai * 128 + wr * 64 + m * 16 + fr; ent[ai][m] = list[e * 16384 + slot]; gg[ai][m] = gatew[e * 16384 + slot]; }
#pragma unroll
        for (int ai = 0; ai < 2; ++ai)
#pragma unroll
            for (int m = 0; m < 4; ++m) { const float g = gg[ai][m];
                bf16_t* dst = ((ent[ai][m] >> 31) ? c1 : c0) + (size_t)(ent[ai][m] & 0x7fffffffu) * 1024 + col0;
#pragma unroll
                for (int bj = 0; bj < 2; ++bj) { const pg8::f32x4 a = acc[ai][bj][m][0] * g, b = acc[ai][bj][m][1] * g;
                    v4u w; w.x = pg8::cvt_pk_bf16(a[0], a[1]); w.y = pg8::cvt_pk_bf16(a[2], a[3]); w.z = pg8::cvt_pk_bf16(b[0], b[1]); w.w = pg8::cvt_pk_bf16(b[2], b[3]);
                    *(v4u*)(dst + bj * 128) = w; } }
    }
};

struct Frame {
    LAS unsigned char* lds;
    volatile LAS unsigned* MISC;
    gu32* ctl;
    int tid, lane, wave;
    int vcu, G;
    unsigned char* ws;
};
__device__ __forceinline__ float wave_sum(float v) {
#pragma unroll
    for (int o = 1; o < 64; o <<= 1) v += __shfl_xor(v, o);
    return v;
}

__device__ __forceinline__ int mapcol(int kind, int dff, int v) {
    if (kind == 0) return v;
    if (kind == 1) {
        if (v < 512) { const int w = v & 63; return (v & ~63) + 32 * ((w >> 2) & 1) + 4 * (w >> 3) + (w & 3); }
        return v < FL_COL ? v : v + 8;
    }
    const int tile = v >> 8, vl = v & 255, n = (vl >> 2) & 1, j = tile * 128 + (vl >> 3) * 4 + (vl & 3);
    return n ? dff + j : j;
}
__device__ __forceinline__ void cvt_item(const float* W, int Nsrc, bf16* dst, int dpitch, int koff, int kind, int dff, int k0, int v0, LAS float* scr, int lane, float f8scale, int vbase) {
    const int v4 = lane & 15, kq = lane >> 4;
    const float* src = W + (size_t)(k0 + kq) * Nsrc + mapcol(kind, dff, vbase + v0 + 4 * v4);
    f32x4 t[16];
#pragma unroll
    for (int it = 0; it < 16; ++it) t[it] = *(const f32x4*)(src + (size_t)(4 * it) * Nsrc);
#pragma unroll
    for (int it = 0; it < 16; ++it) *(LAS f32x4*)(scr + (kq + 4 * it) * 68 + 4 * v4) = t[it];
    LDS_WAIT(); asm volatile("" ::: "memory");
    if (f8scale != 0.f) {
        const int c = lane & 3; unsigned char* d8 = (unsigned char*)dst;
        if (f8scale < 0.f) {
#pragma unroll
            for (int j = 0; j < 4; ++j) { const int n = (lane >> 2) + 16 * j; const LAS float* s = scr + (16 * c) * 68 + n; const float q = -f8scale;
                v4u o; o.x = pk4_i8(s[0 * 68] * q, s[1 * 68] * q, s[2 * 68] * q, s[3 * 68] * q); o.y = pk4_i8(s[4 * 68] * q, s[5 * 68] * q, s[6 * 68] * q, s[7 * 68] * q);
                o.z = pk4_i8(s[8 * 68] * q, s[9 * 68] * q, s[10 * 68] * q, s[11 * 68] * q); o.w = pk4_i8(s[12 * 68] * q, s[13 * 68] * q, s[14 * 68] * q, s[15 * 68] * q);
                *(GAS v4u*)(d8 + (size_t)(v0 + n) * dpitch + koff + k0 + 16 * c) = o; }
            LDS_WAIT(); asm volatile("" ::: "memory"); return; }
        if (kind == 2) f8scale *= (lane & 16) ? SWI_B : SWI_A;
#pragma unroll
        for (int j = 0; j < 4; ++j) { const int n = (lane >> 2) + 16 * j; const LAS float* s = scr + (16 * c) * 68 + n;
            v4u o; o.x = pk4_fp8(s[0 * 68] * f8scale, s[1 * 68] * f8scale, s[2 * 68] * f8scale, s[3 * 68] * f8scale); o.y = pk4_fp8(s[4 * 68] * f8scale, s[5 * 68] * f8scale, s[6 * 68] * f8scale, s[7 * 68] * f8scale);
            o.z = pk4_fp8(s[8 * 68] * f8scale, s[9 * 68] * f8scale, s[10 * 68] * f8scale, s[11 * 68] * f8scale); o.w = pk4_fp8(s[12 * 68] * f8scale, s[13 * 68] * f8scale, s[14 * 68] * f8scale, s[15 * 68] * f8scale);
            *(GAS v4u*)(d8 + (size_t)(v0 + n) * dpitch + koff + k0 + 16 * c) = o; }
    } else {
    const int c = lane & 7;
#pragma unroll
    for (int j = 0; j < 8; ++j) { const int n = (lane >> 3) + 8 * j; const LAS float* s = scr + (8 * c) * 68 + n;
        v4u o; o.x = pk2(s[0 * 68], s[1 * 68]); o.y = pk2(s[2 * 68], s[3 * 68]); o.z = pk2(s[4 * 68], s[5 * 68]); o.w = pk2(s[6 * 68], s[7 * 68]);
        *(GAS v4u*)(dst + (size_t)(v0 + n) * dpitch + koff + k0 + 8 * c) = o; }
    }
    LDS_WAIT(); asm volatile("" ::: "memory");
}
struct CvtJob { const float* W; int K, Nsrc, Nv; bf16* dst; int dpitch, koff, kind, dff; float f8scale; int vbase = 0; };
__device__ __forceinline__ bool cvt_run(const CvtJob& j, int& r, LAS float* scr, int lane) {
    const int nvb = j.Nv / 64, items = (j.K / 64) * nvb;
    if (r >= items) { r -= items; return false; }
    cvt_item(j.W, j.Nsrc, j.dst, j.dpitch, j.koff, j.kind, j.dff, 64 * (r / nvb), 64 * (r % nvb), scr, lane, j.f8scale, j.vbase);
    return true;
}

__device__ __forceinline__ float row_dot8(const f32x4 (&v)[4], const LAS float* wT, int lane) {
    float p[8];
#pragma unroll
    for (int h = 0; h < 8; ++h) { float s = 0.f;
#pragma unroll
        for (int j = 0; j < 4; ++j) { const f32x4 w = *(const LAS f32x4*)(wT + h * 1024 + 256 * j + 4 * lane); s += (v[j].x * w.x + v[j].y * w.y) + (v[j].z * w.z + v[j].w * w.w); }
        p[h] = s; }
    const bool b0 = lane & 1, b1 = lane & 2, b2 = lane & 4;
    float q[4], r[2];
#pragma unroll
    for (int k = 0; k < 4; ++k) { const float a = p[2 * k], b = p[2 * k + 1]; q[k] = (b0 ? b : a) + __shfl_xor(b0 ? a : b, 1); }
#pragma unroll
    for (int k = 0; k < 2; ++k) { const float a = q[2 * k], b = q[2 * k + 1]; r[k] = (b1 ? b : a) + __shfl_xor(b1 ? a : b, 2); }
    float t = (b2 ? r[1] : r[0]) + __shfl_xor(b2 ? r[0] : r[1], 4);
    t += __shfl_xor(t, 8); t += __shfl_xor(t, 16); t += __shfl_xor(t, 32);
    return t;
}
__device__ __forceinline__ void stage_w8(Frame& F, const float* W, int pitch, int col0) {
    LAS float* wT = (LAS float*)(F.lds + RING_OFF);
    float t[16];
#pragma unroll
    for (int k = 0; k < 16; ++k) { const int i = F.tid + 512 * k, d = i >> 3, h = i & 7; t[k] = W[(size_t)d * pitch + col0 + h]; }
#pragma unroll
    for (int k = 0; k < 16; ++k) { const int i = F.tid + 512 * k, d = i >> 3, h = i & 7; wT[h * 1024 + d] = t[k]; }
    LDS_WAIT(); __syncthreads();
}
__device__ __forceinline__ float log_sigmoid(float x) {
    const float y = __builtin_amdgcn_exp2f(-fabsf(x) * LOG2E); const float l = (y < 1e-2f) ? y * (1.f - y * (0.5f - y * 0.33333334f)) : __builtin_amdgcn_logf(1.f + y) * 0.6931471805599453f;
    return fminf(x, 0.f) - l; }

__device__ __forceinline__ void p0_rows(Frame& F, const float* x, const float* w_in0, const float* fox_b) {
    stage_w8(F, w_in0, N_INSRC, FL_COL);
    const LAS float* wT = (const LAS float*)(F.lds + RING_OFF);
    const int gw = F.vcu * NWAVES + F.wave, NGW = F.G * NWAVES;
    bf16* XB = (bf16*)(F.ws + WS_XB); float* LOGF = (float*)(F.ws + WS_LOGF);
    f32x4 nx[4];
    if (gw < M) {
#pragma unroll
        for (int j = 0; j < 4; ++j) nx[j] = *((const GAS f32x4*)(x + (size_t)gw * D) + F.lane + 64 * j); }
#pragma unroll 1
    for (int m = gw; m < M; m += NGW) {
        f32x4 v[4];
#pragma unroll
        for (int j = 0; j < 4; ++j) v[j] = nx[j];
        if (m + NGW < M) {
#pragma unroll
            for (int j = 0; j < 4; ++j) nx[j] = *((const GAS f32x4*)(x + (size_t)(m + NGW) * D) + F.lane + 64 * j); }
        GAS unsigned long long* o8 = (GAS unsigned long long*)(XB + (size_t)m * D) + F.lane;
#pragma unroll
        for (int j = 0; j < 4; ++j) o8[64 * j] = (unsigned long long)pk2(v[j].x, v[j].y) | ((unsigned long long)pk2(v[j].z, v[j].w) << 32);
#if GATES_FP8 == 2
#pragma unroll
        for (int j = 0; j < 4; ++j) *((GAS unsigned*)(F.ws + WS_X8IN + (size_t)m * D) + F.lane + 64 * j) = P1_I8 ? pk4_i8(v[j].x * SC_XI8, v[j].y * SC_XI8, v[j].z * SC_XI8, v[j].w * SC_XI8) : pk4_fp8(v[j].x * SC_X8, v[j].y * SC_X8, v[j].z * SC_X8, v[j].w * SC_X8);
#endif
        const float r = row_dot8(v, wT, F.lane);
        if (F.lane < 8) LOGF[(size_t)m * 8 + F.lane] = log_sigmoid(r + fox_b[F.lane]);
    }
    __syncthreads();
}

template <int AUX>
__device__ __forceinline__ void ln_pass(Frame& F, const float* src, float src_scale, const bf16* addb1, const bf16* addb2, const float* g, const float* b, float* outf, bf16* outb, unsigned char* out8,
                                        const float* w8, int w8pitch, int w8col, const float* fox_b, bool grp, float o8s = SC_X8) {
    if (AUX != 0) stage_w8(F, w8, w8pitch, w8col);
    const LAS float* wT = (const LAS float*)(F.lds + RING_OFF);
    const int gw = F.vcu * NWAVES + F.wave, NGW = F.G * NWAVES;
    f32x4 gv[4], bv[4];
#pragma unroll
    for (int j = 0; j < 4; ++j) { gv[j] = *((const f32x4*)g + F.lane + 64 * j); bv[j] = *((const f32x4*)b + F.lane + 64 * j); }
    int nbuf = 0, r_i1 = 0, r_i2 = 0, r_m = 0; float r_w1 = 0.f;
#define ROUTER_FLUSH() do { const bool vld_ = F.lane < nbuf; const unsigned long long lt_ = (1ull << F.lane) - 1ull; unsigned n_e_ = 0u, rk1_ = 0u, rk2_ = 0u; \
        _Pragma("unroll") for (int e_ = 0; e_ < 8; ++e_) { const unsigned long long b1_ = __ballot(vld_ && r_i1 == e_), b2_ = __ballot(vld_ && r_i2 == e_); \
            const unsigned c1_ = (unsigned)__popcll(b1_), c2_ = (unsigned)__popcll(b2_); if (F.lane == e_) n_e_ = c1_ + c2_; \
            if (r_i1 == e_) rk1_ = (unsigned)__popcll(b1_ & lt_); if (r_i2 == e_) rk2_ = c1_ + (unsigned)__popcll(b2_ & lt_); } \
        unsigned base_ = 0u; if (F.lane < 8 && n_e_ != 0u) base_ = __hip_atomic_fetch_add(F.ctl + CW_CNT + 64 * F.lane, n_e_, RLX_AGENT); \
        const unsigned s1_ = (unsigned)__shfl((int)base_, r_i1) + rk1_, s2_ = (unsigned)__shfl((int)base_, r_i2) + rk2_; \
        if (vld_) { unsigned* list_ = (unsigned*)(F.ws + WS_LIST); float* gw8_ = (float*)(F.ws + WS_GATEW); \
            list_[r_i1 * 16384 + s1_] = (unsigned)r_m; gw8_[r_i1 * 16384 + s1_] = r_w1; list_[r_i2 * 16384 + s2_] = (unsigned)r_m | 0x80000000u; gw8_[r_i2 * 16384 + s2_] = 1.0f - r_w1; } } while (0)
    const int m0 = grp ? (F.vcu >> 5) * SEQ + (F.vcu & 31) * NWAVES + F.wave : gw, mstep = grp ? 32 * NWAVES : NGW, mend = grp ? ((F.vcu >> 5) + 1) * SEQ : M;
    f32x4 nx[4]; v2u na[4], nc[4];
#define LN_LOAD(mm) do { _Pragma("unroll") for (int j = 0; j < 4; ++j) { nx[j] = *((const GAS f32x4*)(src + (size_t)(mm) * D) + F.lane + 64 * j); \
        if (addb1) { na[j] = *((const GAS v2u*)(addb1 + (size_t)(mm) * D) + F.lane + 64 * j); nc[j] = *((const GAS v2u*)(addb2 + (size_t)(mm) * D) + F.lane + 64 * j); } } } while (0)
    if (m0 < mend) LN_LOAD(m0);
#pragma unroll 1
    for (int m = m0; m < mend; m += mstep) {
        f32x4 v[4]; float s = 0.f;
#pragma unroll
        for (int j = 0; j < 4; ++j) { v[j] = nx[j];
            if (addb1) { v[j] = v[j] * src_scale; const v2u a = na[j], c = nc[j];
                v[j].x += bflo(a.x) + bflo(c.x); v[j].y += bfhi(a.x) + bfhi(c.x); v[j].z += bflo(a.y) + bflo(c.y); v[j].w += bfhi(a.y) + bfhi(c.y); }
            s += (v[j].x + v[j].y) + (v[j].z + v[j].w); }
        if (m + mstep < mend) LN_LOAD(m + mstep);
        float lm = s * (1.f / 16.f), m2 = 0.f;
#pragma unroll
        for (int j = 0; j < 4; ++j) { const f32x4 d = v[j] - lm; m2 += (d.x * d.x + d.y * d.y) + (d.z * d.z + d.w * d.w); }
        { float cnt2 = 8.f;
#pragma unroll
          for (int o = 1; o < 64; o <<= 1) { const float om = __shfl_xor(lm, o), o2 = __shfl_xor(m2, o); const float dl = om - lm; m2 = m2 + o2 + dl * dl * cnt2; lm = 0.5f * (lm + om); cnt2 *= 2.f; } }
        const float mean = lm;
#pragma unroll
        for (int j = 0; j < 4; ++j) v[j] = v[j] - mean;
        const float rstd = 1.f / sqrtf(m2 * (1.f / D) + LN_EPS);
#pragma unroll
        for (int j = 0; j < 4; ++j) v[j] = v[j] * rstd * gv[j] + bv[j];
        if (outf) {
#pragma unroll
            for (int j = 0; j < 4; ++j) *((GAS f32x4*)(outf + (size_t)m * D) + F.lane + 64 * j) = v[j]; }
        if (outb) { GAS unsigned long long* o8 = (GAS unsigned long long*)(outb + (size_t)m * D) + F.lane;
#pragma unroll
            for (int j = 0; j < 4; ++j) o8[64 * j] = (unsigned long long)pk2(v[j].x, v[j].y) | ((unsigned long long)pk2(v[j].z, v[j].w) << 32); }
        if (out8) {
            if (o8s < 0.f) {
#pragma unroll
                for (int j = 0; j < 4; ++j) *((GAS unsigned*)(out8 + (size_t)m * D) + F.lane + 64 * j) = pk4_i8(v[j].x * -o8s, v[j].y * -o8s, v[j].z * -o8s, v[j].w * -o8s);
            } else {
#pragma unroll
            for (int j = 0; j < 4; ++j) *((GAS unsigned*)(out8 + (size_t)m * D) + F.lane + 64 * j) = pk4_fp8(v[j].x * SC_X8, v[j].y * SC_X8, v[j].z * SC_X8, v[j].w * SC_X8); } }
        if (AUX == 1) {
            const float r = row_dot8(v, wT, F.lane);
            if (F.lane < 8) ((float*)(F.ws + WS_LOGF))[(size_t)m * 8 + F.lane] = log_sigmoid(r + fox_b[F.lane]);
        }
        if (AUX == 2) {
            const float rl = row_dot8(v, wT, F.lane); float lg[8];
#pragma unroll
            for (int e = 0; e < 8; ++e) lg[e] = __shfl(rl, e);
            int i1 = 0; float v1 = lg[0];
#pragma unroll
            for (int e = 1; e < 8; ++e) if (lg[e] > v1) { v1 = lg[e]; i1 = e; }
            int i2 = -1; float v2 = -INFINITY;
#pragma unroll
            for (int e = 0; e < 8; ++e) if (e != i1 && lg[e] > v2) { v2 = lg[e]; i2 = e; }
            const float w1 = 1.0f / (1.0f + expf(v2 - v1));
            if (F.lane == nbuf) { r_i1 = i1; r_i2 = i2; r_w1 = w1; r_m = m; }
            if (++nbuf == 64) { ROUTER_FLUSH(); nbuf = 0; }
        }
    }
    if (AUX == 2) { if (nbuf) { ROUTER_FLUSH(); } }
#undef ROUTER_FLUSH
#undef LN_LOAD
    __syncthreads();
}

__device__ __forceinline__ void split3(float b, unsigned& h, unsigned& m, unsigned& l) { h = f2bf(b); const float r1 = b - bf2f((unsigned short)h); m = f2bf(r1); const float r2 = r1 - bf2f((unsigned short)m); l = f2bf(r2); }
template <bool AUG>
__device__ __forceinline__ void fox_bias_table(Frame& F, int b, int h, LAS float* tab, LAS float* wtot) {
    int tid = threadIdx.x; asm volatile("" : "+v"(tid));
    const int lane = tid & 63, wave = __builtin_amdgcn_readfirstlane(tid >> 6);
    const float* lf = (const float*)(F.ws + WS_LOGF) + (size_t)b * SEQ * 8 + h;
    float v[4];
#pragma unroll
    for (int j = 0; j < 4; ++j) v[j] = lf[(size_t)(4 * tid + j) * 8];
    float sj[4]; sj[0] = v[0]; sj[1] = sj[0] + v[1]; sj[2] = sj[1] + v[2]; sj[3] = sj[2] + v[3];
    float x = sj[3];
#pragma unroll
    for (int o = 1; o < 64; o <<= 1) { const float y = __shfl_up(x, o); if (lane >= o) x += y; }
    __syncthreads();
    if (lane == 63) wtot[wave] = x;
    LDS_WAIT(); __syncthreads();
    float base = 0.f;
#pragma unroll
    for (int w = 0; w < 8; ++w) if (w < wave) base += wtot[w];
    const float ex = base + x - sj[3];
#pragma unroll
    for (int j = 0; j < 4; ++j) { const float bv = -(ex + sj[j]) * LOG2E;
        if (AUG) { unsigned hh, mm, ll; split3(bv, hh, mm, ll); v4u w; w.x = hh | (mm << 16); w.y = ll | (0x3F80u << 16); w.z = 0x3F803F80u; w.w = 0u; ((LAS v4u*)tab)[4 * tid + j] = w; }
        else tab[4 * tid + j] = bv; }
    LDS_WAIT(); __syncthreads();
}

#if 1
__device__ __forceinline__ void naive_fox_row(Frame& F, int b, int h, int t, const LAS float* tab) {
    const bf16* FQ = (const bf16*)(F.ws + WS_FQ); const bf16* FK = (const bf16*)(F.ws + WS_FK); const bf16* FV = (const bf16*)(F.ws + WS_FV); bf16* YB = (bf16*)(F.ws + WS_YB);
    const size_t rb = (size_t)b * SEQ;
    float q[64];
    { const v4u* qp = (const v4u*)(FQ + (rb + t) * 512 + h * 64);
#pragma unroll
      for (int c = 0; c < 8; ++c) { const v4u w = qp[c]; q[8 * c + 0] = bflo(w.x); q[8 * c + 1] = bfhi(w.x); q[8 * c + 2] = bflo(w.y); q[8 * c + 3] = bfhi(w.y); q[8 * c + 4] = bflo(w.z); q[8 * c + 5] = bfhi(w.z); q[8 * c + 6] = bflo(w.w); q[8 * c + 7] = bfhi(w.w); } }
    float mx = -INFINITY, l = 0.f, o = 0.f;
    for (int s0 = 0; s0 <= t; s0 += 64) {
        const int s = s0 + F.lane; float sc = -INFINITY;
        if (s <= t) { const v4u* kp = (const v4u*)(FK + (rb + s) * 512 + h * 64); float a = 0.f;
#pragma unroll
            for (int c = 0; c < 8; ++c) { const v4u w = kp[c]; a += q[8 * c + 0] * bflo(w.x) + q[8 * c + 1] * bfhi(w.x) + q[8 * c + 2] * bflo(w.y) + q[8 * c + 3] * bfhi(w.y) + q[8 * c + 4] * bflo(w.z) + q[8 * c + 5] * bfhi(w.z) + q[8 * c + 6] * bflo(w.w) + q[8 * c + 7] * bfhi(w.w); }
            sc = a + tab[s]; }
        float cm = sc;
#pragma unroll
        for (int of = 1; of < 64; of <<= 1) cm = fmaxf(cm, __shfl_xor(cm, of));
        const float nm = fmaxf(mx, cm), f = __builtin_amdgcn_exp2f(mx - nm); const float p = __builtin_amdgcn_exp2f(sc - nm);
        l = l * f + wave_sum(p); o *= f; mx = nm;
        const int ne = (t - s0 + 1) < 64 ? (t - s0 + 1) : 64;
        for (int j = 0; j < ne; ++j) { const float pj = __shfl(p, j); o += pj * bf2f(FV[(rb + s0 + j) * 512 + h * 64 + F.lane]); }
    }
    YB[(rb + t) * 1536 + 512 + h * 64 + F.lane] = (bf16)f2bf(o / l);
}
__device__ __forceinline__ void naive_ret_row(Frame& F, int b, int h, int t) {
    const bf16* RQ = (const bf16*)(F.ws + WS_RQ); const bf16* RK = (const bf16*)(F.ws + WS_RK); const bf16* RV = (const bf16*)(F.ws + WS_RV); const bf16* RG = (const bf16*)(F.ws + WS_RG); bf16* YB = (bf16*)(F.ws + WS_YB);
    const size_t rb = (size_t)b * SEQ;
    const float l2g = log2f(1.0f - exp2f(-5.0f - (float)h));
    float q[64];
    { const v4u* qp = (const v4u*)(RQ + (rb + t) * 256 + h * 64);
#pragma unroll
      for (int c = 0; c < 8; ++c) { const v4u w = qp[c]; q[8 * c + 0] = bflo(w.x); q[8 * c + 1] = bfhi(w.x); q[8 * c + 2] = bflo(w.y); q[8 * c + 3] = bfhi(w.y); q[8 * c + 4] = bflo(w.z); q[8 * c + 5] = bfhi(w.z); q[8 * c + 6] = bflo(w.w); q[8 * c + 7] = bfhi(w.w); } }
    float o0 = 0.f, o1 = 0.f;
    for (int s0 = 0; s0 <= t; s0 += 64) {
        const int s = s0 + F.lane; float sc = 0.f;
        if (s <= t) { const v4u* kp = (const v4u*)(RK + (rb + s) * 256 + h * 64); float a = 0.f;
#pragma unroll
            for (int c = 0; c < 8; ++c) { const v4u w = kp[c]; a += q[8 * c + 0] * bflo(w.x) + q[8 * c + 1] * bfhi(w.x) + q[8 * c + 2] * bflo(w.y) + q[8 * c + 3] * bfhi(w.y) + q[8 * c + 4] * bflo(w.z) + q[8 * c + 5] * bfhi(w.z) + q[8 * c + 6] * bflo(w.w) + q[8 * c + 7] * bfhi(w.w); }
            sc = a * exp2f(l2g * (float)(t - s)); }
        const int ne = (t - s0 + 1) < 64 ? (t - s0 + 1) : 64;
        for (int j = 0; j < ne; ++j) { const float pj = __shfl(sc, j); const bf16* vp = RV + (rb + s0 + j) * 512 + h * 128; o0 += pj * bf2f(vp[F.lane]); o1 += pj * bf2f(vp[F.lane + 64]); }
    }
    const float mean = wave_sum(o0 + o1) * (1.f / 128.f); const float d0 = o0 - mean, d1 = o1 - mean;
    const float rstd = 1.f / sqrtf(wave_sum(d0 * d0 + d1 * d1) * (1.f / 128.f) + GN_EPS);
    const bf16* gp = RG + (rb + t) * 512 + h * 128; bf16* yp = YB + (rb + t) * 1536 + h * 128;
    yp[F.lane] = (bf16)f2bf(bf2f(gp[F.lane]) * d0 * rstd); yp[F.lane + 64] = (bf16)f2bf(bf2f(gp[F.lane + 64]) * d1 * rstd);
}
__device__ __forceinline__ void naive_gmlp_unit(Frame& F, int b, int n, int g, const float* w_s, const float* b_s, const float* lng, const float* lnb) {
    const bf16* GU = (const bf16*)(F.ws + WS_GU); const bf16* GV = (const bf16*)(F.ws + WS_GV); bf16* YB = (bf16*)(F.ws + WS_YB);
    LAS float* st = (LAS float*)(F.lds + RING_OFF);
    const size_t r0 = (size_t)b * SEQ + n * 128;
    __syncthreads();
    for (int r = F.wave; r < 128; r += NWAVES) {
        const v4u w = *((const v4u*)(GV + (r0 + r) * 512) + F.lane);
        float x[8] = {bflo(w.x), bfhi(w.x), bflo(w.y), bfhi(w.y), bflo(w.z), bfhi(w.z), bflo(w.w), bfhi(w.w)};
        float s = 0.f;
#pragma unroll
        for (int j = 0; j < 8; ++j) s += x[j];
        const float mean = wave_sum(s) * (1.f / 512.f); float s2 = 0.f;
#pragma unroll
        for (int j = 0; j < 8; ++j) { const float d = x[j] - mean; s2 += d * d; }
        const float rstd = 1.f / sqrtf(wave_sum(s2) * (1.f / 512.f) + LN_EPS);
        if (F.lane == 0) { st[2 * r] = mean; st[2 * r + 1] = rstd; }
    }
    LDS_WAIT(); __syncthreads();
    const int c = F.tid & 127; const float gam = lng[g * 128 + c], bet = lnb[g * 128 + c];
    for (int i = F.tid >> 7; i < 128; i += 4) {
        float a = 0.f; const float* wr = w_s + ((size_t)g * 128 + i) * 128;
        for (int j = 0; j <= i; ++j) { const float vn = (bf2f(GV[(r0 + j) * 512 + g * 128 + c]) - st[2 * j]) * st[2 * j + 1] * gam + bet; a += wr[j] * vn; }
        const float sp = a + b_s[g * 128 + i];
        YB[(r0 + i) * 1536 + 1024 + g * 128 + c] = (bf16)f2bf(bf2f(GU[(r0 + i) * 512 + g * 128 + c]) * sp);
    }
    __syncthreads();
}
#endif

__device__ __forceinline__ GAS void* lds_ptr(LAS unsigned char* lds, int k) {
    const v2u w = *(const LAS v2u*)(lds + PTAB_OFF + 8 * k);
    const unsigned lo = __builtin_amdgcn_readfirstlane(w.x), hi = __builtin_amdgcn_readfirstlane(w.y);
    return (GAS void*)(((unsigned long long)hi << 32) | lo);
}

typedef short bf16x8_t __attribute__((ext_vector_type(8)));
typedef float f32x16_t __attribute__((ext_vector_type(16)));
#define MFMA32(a, b, c) __builtin_amdgcn_mfma_f32_32x32x16_bf16((a), (b), (c), 0, 0, 0)
__device__ __forceinline__ bf16x8_t ldfrag(const LAS bf16* base, int row, int pitch, int kk, int h2) { return *(const LAS bf16x8_t*)(base + row * pitch + 16 * kk + 8 * h2); }
__device__ __forceinline__ int crow32(int reg, int h2) { return (reg & 3) + 8 * (reg >> 2) + 4 * h2; }
constexpr int RP128 = 136, RP64 = 72;
constexpr int R_QS = 0, R_KS = 4608, R_KDT = 23040, R_VT = 40448, R_SS = 75264, R_ST = 83968, R_OS = 102400, R_END = 119296;
static_assert(R_END <= RING_BYTES, "retention LDS map");
__device__ __forceinline__ void unpack8(const v4u w, float (&x)[8]) { x[0] = bflo(w.x); x[1] = bfhi(w.x); x[2] = bflo(w.y); x[3] = bfhi(w.y); x[4] = bflo(w.z); x[5] = bfhi(w.z); x[6] = bflo(w.w); x[7] = bfhi(w.w); }

__device__ __forceinline__ void ret_unit(Frame& F, int b, int h, int rq) {
    int tid_ = threadIdx.x; asm volatile("" : "+v"(tid_));
    const int tid = tid_, lane = tid & 63, wid = __builtin_amdgcn_readfirstlane(tid >> 6), r = lane & 31, h2 = lane >> 5;
    const float l2g = log2f(1.0f - exp2f(-5.0f - (float)h));
    const float chunk_dec = exp2f(l2g * 128.0f);
    LAS bf16* Qs = (LAS bf16*)(F.lds + RING_OFF + R_QS); LAS bf16* Ks = (LAS bf16*)(F.lds + RING_OFF + R_KS); LAS bf16* KdT = (LAS bf16*)(F.lds + RING_OFF + R_KDT);
    LAS bf16* VT = (LAS bf16*)(F.lds + RING_OFF + R_VT); LAS bf16* Ss = (LAS bf16*)(F.lds + RING_OFF + R_SS); LAS bf16* ST = (LAS bf16*)(F.lds + RING_OFF + R_ST);
    LAS float* Os = (LAS float*)(F.lds + RING_OFF + R_OS);
    const bf16* RQ = (const bf16*)(F.ws + WS_RQ); const bf16* RK = (const bf16*)(F.ws + WS_RK); const bf16* RV = (const bf16*)(F.ws + WS_RV); const bf16* RG = (const bf16*)(F.ws + WS_RG); bf16* YB = (bf16*)(F.ws + WS_YB);
    const size_t rb = (size_t)b * SEQ;
    __syncthreads();
    for (int i = tid; i < 128 * RP64 / 2; i += NWAVES * 64) ((LAS unsigned*)ST)[i] = 0u;
    f32x16_t st = {0.f, 0.f, 0.f, 0.f, 0.f, 0.f, 0.f, 0.f, 0.f, 0.f, 0.f, 0.f, 0.f, 0.f, 0.f, 0.f};
    const int sj = tid & 127, cq = tid >> 7, qi = tid & 31, qc = tid >> 5, gi = tid >> 4, gs = tid & 15;
    v4u qreg = {0u, 0u, 0u, 0u}, kreg[2], vreg[4], greg;
#define RET_LOAD(n) do { const size_t r0_ = rb + (size_t)(n) * 128; \
        if (tid < 256) qreg = *(const v4u*)(RQ + (r0_ + 32 * rq + qi) * 256 + h * 64 + 8 * qc); \
        _Pragma("unroll") for (int c_ = 0; c_ < 2; ++c_) kreg[c_] = *(const v4u*)(RK + (r0_ + sj) * 256 + h * 64 + 16 * cq + 8 * c_); \
        _Pragma("unroll") for (int c_ = 0; c_ < 4; ++c_) vreg[c_] = *(const v4u*)(RV + (r0_ + sj) * 512 + h * 128 + 32 * cq + 8 * c_); \
        greg = *(const v4u*)(RG + (r0_ + 32 * rq + gi) * 512 + h * 128 + 8 * gs); } while (0)
    RET_LOAD(0);
    const float kdec = exp2f(l2g * (float)(127 - sj));
#pragma unroll 1
    for (int n = 0; n < 16; ++n) {
        if (tid < 256) *(LAS v4u*)(Qs + qi * RP64 + 8 * qc) = qreg;
#pragma unroll
        for (int c = 0; c < 2; ++c) { *(LAS v4u*)(Ks + sj * RP64 + 16 * cq + 8 * c) = kreg[c]; float x[8]; unpack8(kreg[c], x);
#pragma unroll
            for (int e = 0; e < 8; ++e) KdT[(16 * cq + 8 * c + e) * RP128 + sj] = (bf16)f2bf(x[e] * kdec); }
#pragma unroll
        for (int c = 0; c < 4; ++c) { const v4u w = vreg[c]; const unsigned ww[4] = {w.x, w.y, w.z, w.w};
#pragma unroll
            for (int e = 0; e < 8; ++e) VT[(32 * cq + 8 * c + e) * RP128 + sj] = (bf16)((e & 1) ? (ww[e >> 1] >> 16) : (ww[e >> 1] & 0xffffu)); }
        const v4u gcur = greg;
        LDS_WAIT(); __syncthreads();
        if (n + 1 < 16) RET_LOAD(n + 1);
        f32x16_t x = {0.f, 0.f, 0.f, 0.f, 0.f, 0.f, 0.f, 0.f, 0.f, 0.f, 0.f, 0.f, 0.f, 0.f, 0.f, 0.f};
        if (wid < 4) {
#pragma unroll
            for (int kk = 0; kk < 4; ++kk) x = MFMA32(ldfrag(Qs, r, RP64, kk, h2), ldfrag(Ks, 32 * wid + r, RP64, kk, h2), x);
            const int jabs = 32 * wid + r;
#pragma unroll
            for (int reg = 0; reg < 16; ++reg) { const int i = crow32(reg, h2), diff = 32 * rq + i - jabs;
                const float val = diff >= 0 ? x[reg] * exp2f(l2g * (float)diff) : 0.f; Ss[i * RP128 + jabs] = (bf16)f2bf(val); }
        } else {
#pragma unroll
            for (int kk = 0; kk < 4; ++kk) x = MFMA32(ldfrag(Qs, r, RP64, kk, h2), ldfrag(ST, 32 * (wid - 4) + r, RP64, kk, h2), x);
#pragma unroll
            for (int reg = 0; reg < 16; ++reg) x[reg] *= exp2f(l2g * (float)(32 * rq + crow32(reg, h2) + 1));
        }
        { const int db = wid >> 2, vb2 = wid & 3;
#pragma unroll
          for (int reg = 0; reg < 16; ++reg) st[reg] *= chunk_dec;
#pragma unroll
          for (int kk = 0; kk < 8; ++kk) st = MFMA32(ldfrag(KdT, 32 * db + r, RP128, kk, h2), ldfrag(VT, 32 * vb2 + r, RP128, kk, h2), st); }
        LDS_WAIT(); __syncthreads();
        { const int db = wid >> 2, vb2 = wid & 3;
#pragma unroll
          for (int g = 0; g < 4; ++g) { v2u w; w.x = pk2(st[4 * g], st[4 * g + 1]); w.y = pk2(st[4 * g + 2], st[4 * g + 3]); *(LAS v2u*)(ST + (32 * vb2 + r) * RP64 + 32 * db + 8 * g + 4 * h2) = w; } }
        if (wid >= 4) {
#pragma unroll
            for (int kk = 0; kk < 8; ++kk) x = MFMA32(ldfrag(Ss, r, RP128, kk, h2), ldfrag(VT, 32 * (wid - 4) + r, RP128, kk, h2), x);
#pragma unroll
            for (int reg = 0; reg < 16; ++reg) Os[crow32(reg, h2) * 132 + 32 * (wid - 4) + r] = x[reg];
        }
        LDS_WAIT(); __syncthreads();
        { const f32x4 a0 = *(const LAS f32x4*)(Os + gi * 132 + 8 * gs), a1 = *(const LAS f32x4*)(Os + gi * 132 + 8 * gs + 4);
          float sm = (a0.x + a0.y) + (a0.z + a0.w) + (a1.x + a1.y) + (a1.z + a1.w);
#pragma unroll
          for (int o = 1; o < 16; o <<= 1) sm += __shfl_xor(sm, o);
          const float mean = sm * (1.f / 128.f); const f32x4 d0 = a0 - mean, d1 = a1 - mean;
          float sq = (d0.x * d0.x + d0.y * d0.y) + (d0.z * d0.z + d0.w * d0.w) + (d1.x * d1.x + d1.y * d1.y) + (d1.z * d1.z + d1.w * d1.w);
#pragma unroll
          for (int o = 1; o < 16; o <<= 1) sq += __shfl_xor(sq, o);
          const float rstd = 1.f / sqrtf(sq * (1.f / 128.f) + GN_EPS); float gt[8]; unpack8(gcur, gt);
          v4u w; w.x = pk2(gt[0] * d0.x * rstd, gt[1] * d0.y * rstd); w.y = pk2(gt[2] * d0.z * rstd, gt[3] * d0.w * rstd); w.z = pk2(gt[4] * d1.x * rstd, gt[5] * d1.y * rstd); w.w = pk2(gt[6] * d1.z * rstd, gt[7] * d1.w * rstd);
          *(v4u*)(YB + (rb + (size_t)n * 128 + 32 * rq + gi) * 1536 + h * 128 + 8 * gs) = w; }
    }
#undef RET_LOAD
    __syncthreads();
}


#define MFMA16(a, b, c) __builtin_amdgcn_mfma_f32_16x16x32_bf16((a), (b), (c), 0, 0, 0)
__device__ __forceinline__ bf16x8_t ldfrag16(const LAS bf16* base, int row, int pitch, int ks, int q4) { return *(const LAS bf16x8_t*)(base + row * pitch + 32 * ks + 8 * q4); }
__device__ __forceinline__ void ret_kv_unit(Frame& F, int b, int h, int n) {
    int tid_ = threadIdx.x; asm volatile("" : "+v"(tid_));
    const int tid = tid_, lane = tid & 63, wid = __builtin_amdgcn_readfirstlane(tid >> 6), r = lane & 31, h2 = lane >> 5;
    const float l2g = log2f(1.0f - exp2f(-5.0f - (float)h));
    LAS bf16* KdT = (LAS bf16*)(F.lds + RING_OFF); LAS bf16* VT = (LAS bf16*)(F.lds + RING_OFF + 17408);
    const bf16* RK = (const bf16*)(F.ws + WS_RK); const bf16* RV = (const bf16*)(F.ws + WS_RV);
    const size_t r0 = (size_t)b * SEQ + (size_t)n * 128;
    const int sj = tid & 127, cq = tid >> 7; const float kdec = exp2f(l2g * (float)(127 - sj));
    v4u kreg[2], vreg[4];
#pragma unroll
    for (int c = 0; c < 2; ++c) kreg[c] = *(const v4u*)(RK + (r0 + sj) * 256 + h * 64 + 16 * cq + 8 * c);
#pragma unroll
    for (int c = 0; c < 4; ++c) vreg[c] = *(const v4u*)(RV + (r0 + sj) * 512 + h * 128 + 32 * cq + 8 * c);
    __syncthreads();
#pragma unroll
    for (int c = 0; c < 2; ++c) { float x[8]; unpack8(kreg[c], x);
#pragma unroll
        for (int e = 0; e < 8; ++e) KdT[(16 * cq + 8 * c + e) * RP128 + sj] = (bf16)f2bf(x[e] * kdec); }
#pragma unroll
    for (int c = 0; c < 4; ++c) { const v4u w = vreg[c]; const unsigned ww[4] = {w.x, w.y, w.z, w.w};
#pragma unroll
        for (int e = 0; e < 8; ++e) VT[(32 * cq + 8 * c + e) * RP128 + sj] = (bf16)((e & 1) ? (ww[e >> 1] >> 16) : (ww[e >> 1] & 0xffffu)); }
    LDS_WAIT(); __syncthreads();
    const int db = wid >> 2, vb = wid & 3;
    f32x16_t st = {0.f, 0.f, 0.f, 0.f, 0.f, 0.f, 0.f, 0.f, 0.f, 0.f, 0.f, 0.f, 0.f, 0.f, 0.f, 0.f};
#pragma unroll
    for (int kk = 0; kk < 8; ++kk) st = MFMA32(ldfrag(KdT, 32 * db + r, RP128, kk, h2), ldfrag(VT, 32 * vb + r, RP128, kk, h2), st);
    float* KV = (float*)(F.ws + WS_KV) + ((size_t)((b * 4 + h) * 16 + n)) * 8192;
#pragma unroll
    for (int reg = 0; reg < 16; ++reg) KV[(32 * db + crow32(reg, h2)) * 128 + 32 * vb + r] = st[reg];
    __syncthreads();
}
constexpr int RB_QS = 0, RB_KS = 18432, RB_VT = 36864, RB_ST = 71680, RB_SW = 90112, RB_END = 124928;
static_assert(RB_END <= RING_BYTES, "retention pass B LDS map");
__device__ __forceinline__ void ret_out_unit(Frame& F, int b, int h, int n) {
    int tid_ = threadIdx.x; asm volatile("" : "+v"(tid_));
    const int tid = tid_, lane = tid & 63, wid = __builtin_amdgcn_readfirstlane(tid >> 6), l15 = lane & 15, q4 = lane >> 4;
    const float l2g = log2f(1.0f - exp2f(-5.0f - (float)h));
    const float chunk_dec = exp2f(l2g * 128.0f);
    LAS bf16* Qs = (LAS bf16*)(F.lds + RING_OFF + RB_QS); LAS bf16* Ks = (LAS bf16*)(F.lds + RING_OFF + RB_KS); LAS bf16* VT = (LAS bf16*)(F.lds + RING_OFF + RB_VT);
    LAS bf16* ST = (LAS bf16*)(F.lds + RING_OFF + RB_ST); LAS bf16* Sw = (LAS bf16*)(F.lds + RING_OFF + RB_SW) + wid * (16 * RP128);
    const bf16* RQ = (const bf16*)(F.ws + WS_RQ); const bf16* RK = (const bf16*)(F.ws + WS_RK); const bf16* RV = (const bf16*)(F.ws + WS_RV); const bf16* RG = (const bf16*)(F.ws + WS_RG); bf16* YB = (bf16*)(F.ws + WS_YB);
    const size_t r0 = (size_t)b * SEQ + (size_t)n * 128;
    const int sj = tid & 127, cq = tid >> 7;
    v4u qreg[2], kreg[2], vreg[4];
#pragma unroll
    for (int c = 0; c < 2; ++c) { qreg[c] = *(const v4u*)(RQ + (r0 + sj) * 256 + h * 64 + 16 * cq + 8 * c); kreg[c] = *(const v4u*)(RK + (r0 + sj) * 256 + h * 64 + 16 * cq + 8 * c); }
#pragma unroll
    for (int c = 0; c < 4; ++c) vreg[c] = *(const v4u*)(RV + (r0 + sj) * 512 + h * 128 + 32 * cq + 8 * c);
    f32x4 sa[4] = {{0.f, 0.f, 0.f, 0.f}, {0.f, 0.f, 0.f, 0.f}, {0.f, 0.f, 0.f, 0.f}, {0.f, 0.f, 0.f, 0.f}};
    { const float* KV = (const float*)(F.ws + WS_KV) + ((size_t)((b * 4 + h) * 16)) * 8192 + (size_t)tid * 16;
#pragma unroll 4
      for (int m = 0; m < n; ++m) {
#pragma unroll
          for (int c = 0; c < 4; ++c) { const f32x4 kv = *(const f32x4*)(KV + (size_t)m * 8192 + 4 * c); sa[c] = sa[c] * chunk_dec + kv; } } }
    __syncthreads();
    { const int d = tid >> 3, v0 = 16 * (tid & 7);
#pragma unroll
      for (int c = 0; c < 4; ++c)
#pragma unroll
          for (int e = 0; e < 4; ++e) ST[(v0 + 4 * c + e) * RP64 + d] = (bf16)f2bf(sa[c][e]); }
#pragma unroll
    for (int c = 0; c < 2; ++c) { *(LAS v4u*)(Qs + sj * RP64 + 16 * cq + 8 * c) = qreg[c]; *(LAS v4u*)(Ks + sj * RP64 + 16 * cq + 8 * c) = kreg[c]; }
#pragma unroll
    for (int c = 0; c < 4; ++c) { const v4u w = vreg[c]; const unsigned ww[4] = {w.x, w.y, w.z, w.w};
#pragma unroll
        for (int e = 0; e < 8; ++e) VT[(32 * cq + 8 * c + e) * RP128 + sj] = (bf16)((e & 1) ? (ww[e >> 1] >> 16) : (ww[e >> 1] & 0xffffu)); }
    LDS_WAIT(); __syncthreads();
    const int i0 = 16 * wid;
    const bf16x8_t qa0 = ldfrag16(Qs, i0 + l15, RP64, 0, q4), qa1 = ldfrag16(Qs, i0 + l15, RP64, 1, q4);
#pragma unroll 1
    for (int kb = 0; kb <= (wid | 1); kb += 2) {
        f32x4 sc[2];
#pragma unroll
        for (int u = 0; u < 2; ++u) { sc[u] = (f32x4){0.f, 0.f, 0.f, 0.f};
            sc[u] = MFMA16(qa0, ldfrag16(Ks, 16 * (kb + u) + l15, RP64, 0, q4), sc[u]); sc[u] = MFMA16(qa1, ldfrag16(Ks, 16 * (kb + u) + l15, RP64, 1, q4), sc[u]); }
#pragma unroll
        for (int u = 0; u < 2; ++u) { const int j = 16 * (kb + u) + l15;
#pragma unroll
            for (int reg = 0; reg < 4; ++reg) { const int il = 4 * q4 + reg, diff = i0 + il - j; Sw[il * RP128 + j] = (bf16)f2bf(diff >= 0 ? sc[u][reg] * __builtin_amdgcn_exp2f(l2g * (float)diff) : 0.f); } }
    }
    LDS_WAIT();
    float qd[4];
#pragma unroll
    for (int reg = 0; reg < 4; ++reg) qd[reg] = __builtin_amdgcn_exp2f(l2g * (float)(i0 + 4 * q4 + reg + 1));
    f32x4 o[8];
    const int nks = (wid + 2) >> 1;
#pragma unroll
    for (int vb = 0; vb < 8; ++vb) {
        f32x4 x = {0.f, 0.f, 0.f, 0.f};
        x = MFMA16(qa0, ldfrag16(ST, 16 * vb + l15, RP64, 0, q4), x); x = MFMA16(qa1, ldfrag16(ST, 16 * vb + l15, RP64, 1, q4), x);
#pragma unroll
        for (int reg = 0; reg < 4; ++reg) x[reg] *= qd[reg];
        o[vb] = x;
    }
#pragma unroll 1
    for (int ks = 0; ks < nks; ++ks) {
        const bf16x8_t a = ldfrag16(Sw, l15, RP128, ks, q4);
#pragma unroll
        for (int vb = 0; vb < 8; ++vb) o[vb] = MFMA16(a, ldfrag16(VT, 16 * vb + l15, RP128, ks, q4), o[vb]);
    }
    float mean[4], rstd[4];
#pragma unroll
    for (int reg = 0; reg < 4; ++reg) { float sm = 0.f;
#pragma unroll
        for (int vb = 0; vb < 8; ++vb) sm += o[vb][reg];
#pragma unroll
        for (int of = 1; of < 16; of <<= 1) sm += __shfl_xor(sm, of);
        mean[reg] = sm * (1.f / 128.f); float sq = 0.f;
#pragma unroll
        for (int vb = 0; vb < 8; ++vb) { const float d = o[vb][reg] - mean[reg]; sq += d * d; }
#pragma unroll
        for (int of = 1; of < 16; of <<= 1) sq += __shfl_xor(sq, of);
        rstd[reg] = 1.f / sqrtf(sq * (1.f / 128.f) + GN_EPS); }
#pragma unroll
    for (int vb = 0; vb < 8; ++vb)
#pragma unroll
        for (int reg = 0; reg < 4; ++reg) Sw[(4 * q4 + reg) * RP128 + 16 * vb + l15] = (bf16)f2bf((o[vb][reg] - mean[reg]) * rstd[reg]);
    LDS_WAIT();
#pragma unroll
    for (int c = 0; c < 4; ++c) { const int ch = c * 64 + lane, row = ch >> 4, cc = ch & 15;
        float xn[8], gt[8]; unpack8(*(const LAS v4u*)(Sw + row * RP128 + 8 * cc), xn); unpack8(*(const v4u*)(RG + (r0 + i0 + row) * 512 + h * 128 + 8 * cc), gt);
        v4u w; w.x = pk2(xn[0] * gt[0], xn[1] * gt[1]); w.y = pk2(xn[2] * gt[2], xn[3] * gt[3]); w.z = pk2(xn[4] * gt[4], xn[5] * gt[5]); w.w = pk2(xn[6] * gt[6], xn[7] * gt[7]);
        *(v4u*)(YB + (r0 + i0 + row) * 1536 + h * 128 + 8 * cc) = w; }
    __syncthreads();
}

constexpr int G_WS = 0, G_VNT = 34816, G_STAT = 69632, G_END = 70656;
__device__ __forceinline__ void gmlp_unit(Frame& F, int b, int n, int g, const float* w_s, const float* b_s, const float* lng, const float* lnb) {
    int tid_ = threadIdx.x; asm volatile("" : "+v"(tid_));
    const int tid = tid_, lane = tid & 63, wid = __builtin_amdgcn_readfirstlane(tid >> 6), r = lane & 31, h2 = lane >> 5;
    const bf16* GU = (const bf16*)(F.ws + WS_GU); const bf16* GV = (const bf16*)(F.ws + WS_GV); bf16* YB = (bf16*)(F.ws + WS_YB);
    LAS bf16* Ws = (LAS bf16*)(F.lds + RING_OFF + G_WS); LAS bf16* VnT = (LAS bf16*)(F.lds + RING_OFF + G_VNT); LAS float* stt = (LAS float*)(F.lds + RING_OFF + G_STAT);
    const size_t r0 = (size_t)b * SEQ + (size_t)n * 128;
    __syncthreads();
    for (int rr = wid; rr < 128; rr += NWAVES) {
        float x[8]; unpack8(*((const v4u*)(GV + (r0 + rr) * 512) + lane), x);
        float s = 0.f;
#pragma unroll
        for (int j = 0; j < 8; ++j) s += x[j];
        const float mean = wave_sum(s) * (1.f / 512.f); float s2 = 0.f;
#pragma unroll
        for (int j = 0; j < 8; ++j) { const float d = x[j] - mean; s2 += d * d; }
        const float rstd = 1.f / sqrtf(wave_sum(s2) * (1.f / 512.f) + LN_EPS);
        if (lane == 0) { stt[2 * rr] = mean; stt[2 * rr + 1] = rstd; }
    }
    { const int i = tid >> 2, jq = tid & 3; const float* wr = w_s + ((size_t)g * 128 + i) * 128 + 32 * jq;
#pragma unroll
      for (int c = 0; c < 4; ++c) { const f32x4 a = *(const f32x4*)(wr + 8 * c), bq = *(const f32x4*)(wr + 8 * c + 4); const int j0 = 32 * jq + 8 * c;
          v4u w; w.x = pk2(j0 + 0 <= i ? a.x : 0.f, j0 + 1 <= i ? a.y : 0.f); w.y = pk2(j0 + 2 <= i ? a.z : 0.f, j0 + 3 <= i ? a.w : 0.f);
          w.z = pk2(j0 + 4 <= i ? bq.x : 0.f, j0 + 5 <= i ? bq.y : 0.f); w.w = pk2(j0 + 6 <= i ? bq.z : 0.f, j0 + 7 <= i ? bq.w : 0.f);
          *(LAS v4u*)(Ws + i * RP128 + j0) = w; } }
    LDS_WAIT(); __syncthreads();
    { const int sj = tid & 127, cq = tid >> 7; const float mu = stt[2 * sj], rs = stt[2 * sj + 1];
#pragma unroll
      for (int c = 0; c < 4; ++c) { float x[8]; unpack8(*(const v4u*)(GV + (r0 + sj) * 512 + g * 128 + 32 * cq + 8 * c), x);
          const f32x4 ga = *(const f32x4*)(lng + g * 128 + 32 * cq + 8 * c), gb = *(const f32x4*)(lng + g * 128 + 32 * cq + 8 * c + 4);
          const f32x4 ba = *(const f32x4*)(lnb + g * 128 + 32 * cq + 8 * c), bb = *(const f32x4*)(lnb + g * 128 + 32 * cq + 8 * c + 4);
          const float gm[8] = {ga.x, ga.y, ga.z, ga.w, gb.x, gb.y, gb.z, gb.w}, bt[8] = {ba.x, ba.y, ba.z, ba.w, bb.x, bb.y, bb.z, bb.w};
#pragma unroll
          for (int e = 0; e < 8; ++e) VnT[(32 * cq + 8 * c + e) * RP128 + sj] = (bf16)f2bf((x[e] - mu) * rs * gm[e] + bt[e]); } }
    LDS_WAIT(); __syncthreads();
    { const int ib = wid >> 1;
#pragma unroll
      for (int cc = 0; cc < 2; ++cc) { const int cb = 2 * (wid & 1) + cc;
          f32x16_t x = {0.f, 0.f, 0.f, 0.f, 0.f, 0.f, 0.f, 0.f, 0.f, 0.f, 0.f, 0.f, 0.f, 0.f, 0.f, 0.f};
#pragma unroll
          for (int kk = 0; kk < 8; ++kk) x = MFMA32(ldfrag(Ws, 32 * ib + r, RP128, kk, h2), ldfrag(VnT, 32 * cb + r, RP128, kk, h2), x);
          const int c = g * 128 + 32 * cb + r;
#pragma unroll
          for (int reg = 0; reg < 16; ++reg) { const int i = 32 * ib + crow32(reg, h2); const float sp = x[reg] + b_s[g * 128 + i];
              YB[(r0 + i) * 1536 + 1024 + c] = (bf16)f2bf(bf2f(GU[(r0 + i) * 512 + c]) * sp); } } }
    __syncthreads();
}


__device__ __forceinline__ void gmlp_stat_unit(Frame& F, int b, int n) {
    int tid_ = threadIdx.x; asm volatile("" : "+v"(tid_));
    const int tid = tid_, row = tid >> 2, qt = tid & 3;
    const bf16* GV = (const bf16*)(F.ws + WS_GV); float* GST = (float*)(F.ws + WS_GST);
    const size_t r = (size_t)b * SEQ + (size_t)n * 128 + row;
    v4u w[16];
#pragma unroll
    for (int c = 0; c < 16; ++c) w[c] = *(const v4u*)(GV + r * 512 + 128 * qt + 8 * c);
    float s = 0.f;
#pragma unroll
    for (int c = 0; c < 16; ++c) { float x[8]; unpack8(w[c], x); s += ((x[0] + x[1]) + (x[2] + x[3])) + ((x[4] + x[5]) + (x[6] + x[7])); }
    s += __shfl_xor(s, 1); s += __shfl_xor(s, 2);
    const float mean = s * (1.f / 512.f); float s2 = 0.f;
#pragma unroll
    for (int c = 0; c < 16; ++c) { float x[8]; unpack8(w[c], x);
#pragma unroll
        for (int e = 0; e < 8; ++e) { const float d = x[e] - mean; s2 += d * d; } }
    s2 += __shfl_xor(s2, 1); s2 += __shfl_xor(s2, 2);
    if (qt == 0) { GST[2 * r] = mean; GST[2 * r + 1] = 1.f / sqrtf(s2 * (1.f / 512.f) + LN_EPS); }
}
constexpr int G2_WS = 0, G2_VNT = 34816, G2_SW = 69632, G2_END = 104448;
__device__ __forceinline__ void gmlp_unit2(Frame& F, int b, int n, int g, const float* w_s, const float* b_s, const float* lng, const float* lnb) {
    int tid_ = threadIdx.x; asm volatile("" : "+v"(tid_));
    const int tid = tid_, lane = tid & 63, wid = __builtin_amdgcn_readfirstlane(tid >> 6), l15 = lane & 15, q4 = lane >> 4;
    const bf16* GU = (const bf16*)(F.ws + WS_GU); const bf16* GV = (const bf16*)(F.ws + WS_GV); bf16* YB = (bf16*)(F.ws + WS_YB); const float* GST = (const float*)(F.ws + WS_GST);
    LAS bf16* Ws = (LAS bf16*)(F.lds + RING_OFF + G2_WS); LAS bf16* VnT = (LAS bf16*)(F.lds + RING_OFF + G2_VNT); LAS bf16* Sw = (LAS bf16*)(F.lds + RING_OFF + G2_SW) + wid * (16 * RP128);
    const size_t r0 = (size_t)b * SEQ + (size_t)n * 128;
    const int sj = tid & 127, cq = tid >> 7, wi = tid >> 2, jq = tid & 3;
    v4u vreg[4]; f32x4 wreg[8];
#pragma unroll
    for (int c = 0; c < 4; ++c) vreg[c] = *(const v4u*)(GV + (r0 + sj) * 512 + g * 128 + 32 * cq + 8 * c);
    const float mu = GST[2 * (r0 + sj)], rs = GST[2 * (r0 + sj) + 1];
    { const float* wr = w_s + ((size_t)g * 128 + wi) * 128 + 32 * jq;
#pragma unroll
      for (int c = 0; c < 8; ++c) wreg[c] = *(const f32x4*)(wr + 4 * c); }
    __syncthreads();
#pragma unroll
    for (int c = 0; c < 4; ++c) { const int j0 = 32 * jq + 8 * c; const f32x4 a = wreg[2 * c], bq = wreg[2 * c + 1];
        v4u w; w.x = pk2(j0 + 0 <= wi ? a.x : 0.f, j0 + 1 <= wi ? a.y : 0.f); w.y = pk2(j0 + 2 <= wi ? a.z : 0.f, j0 + 3 <= wi ? a.w : 0.f);
        w.z = pk2(j0 + 4 <= wi ? bq.x : 0.f, j0 + 5 <= wi ? bq.y : 0.f); w.w = pk2(j0 + 6 <= wi ? bq.z : 0.f, j0 + 7 <= wi ? bq.w : 0.f);
        *(LAS v4u*)(Ws + wi * RP128 + j0) = w; }
#pragma unroll
    for (int c = 0; c < 4; ++c) { float x[8]; unpack8(vreg[c], x);
        const f32x4 ga = *(const f32x4*)(lng + g * 128 + 32 * cq + 8 * c), gb = *(const f32x4*)(lng + g * 128 + 32 * cq + 8 * c + 4);
        const f32x4 ba = *(const f32x4*)(lnb + g * 128 + 32 * cq + 8 * c), bb = *(const f32x4*)(lnb + g * 128 + 32 * cq + 8 * c + 4);
        const float gm[8] = {ga.x, ga.y, ga.z, ga.w, gb.x, gb.y, gb.z, gb.w}, bt[8] = {ba.x, ba.y, ba.z, ba.w, bb.x, bb.y, bb.z, bb.w};
#pragma unroll
        for (int e = 0; e < 8; ++e) VnT[(32 * cq + 8 * c + e) * RP128 + sj] = (bf16)f2bf((x[e] - mu) * rs * gm[e] + bt[e]); }
    LDS_WAIT(); __syncthreads();
    const int i0 = 16 * wid, nks = (wid + 2) >> 1;
    float bs[4];
#pragma unroll
    for (int reg = 0; reg < 4; ++reg) bs[reg] = b_s[g * 128 + i0 + 4 * q4 + reg];
    { f32x4 x[8];
#pragma unroll
      for (int cb = 0; cb < 8; ++cb) x[cb] = (f32x4){0.f, 0.f, 0.f, 0.f};
#pragma unroll 1
      for (int ks = 0; ks < nks; ++ks) {
          const bf16x8_t a = ldfrag16(Ws, i0 + l15, RP128, ks, q4);
#pragma unroll
          for (int cb = 0; cb < 8; ++cb) x[cb] = MFMA16(a, ldfrag16(VnT, 16 * cb + l15, RP128, ks, q4), x[cb]);
      }
#pragma unroll
      for (int cb = 0; cb < 8; ++cb)
#pragma unroll
          for (int reg = 0; reg < 4; ++reg) Sw[(4 * q4 + reg) * RP128 + 16 * cb + l15] = (bf16)f2bf(x[cb][reg] + bs[reg]);
    }
    LDS_WAIT();
#pragma unroll
    for (int c = 0; c < 4; ++c) { const int ch = c * 64 + lane, row = ch >> 4, cc = ch & 15;
        float sp[8], gu[8]; unpack8(*(const LAS v4u*)(Sw + row * RP128 + 8 * cc), sp); unpack8(*(const v4u*)(GU + (r0 + i0 + row) * 512 + g * 128 + 8 * cc), gu);
        v4u w; w.x = pk2(sp[0] * gu[0], sp[1] * gu[1]); w.y = pk2(sp[2] * gu[2], sp[3] * gu[3]); w.z = pk2(sp[4] * gu[4], sp[5] * gu[5]); w.w = pk2(sp[6] * gu[6], sp[7] * gu[7]);
        *(v4u*)(YB + (r0 + i0 + row) * 1536 + 1024 + g * 128 + 8 * cc) = w; }
    __syncthreads();
}


constexpr int GP_WS = 0, GP_VNT = 69632;
__device__ __forceinline__ void gmlp_pair(Frame& F, int b, int n, int g0, const float* w_s, const float* b_s, const float* lng, const float* lnb) {
    int tid_ = threadIdx.x; asm volatile("" : "+v"(tid_));
    const int tid = tid_, lane = tid & 63, wid = __builtin_amdgcn_readfirstlane(tid >> 6), l15 = lane & 15, q4 = lane >> 4;
    const bf16* GU = (const bf16*)(F.ws + WS_GU); const bf16* GV = (const bf16*)(F.ws + WS_GV); bf16* YB = (bf16*)(F.ws + WS_YB); const float* GST = (const float*)(F.ws + WS_GST);
    LAS bf16* WsB = (LAS bf16*)(F.lds + RING_OFF + GP_WS); LAS bf16* VnTB = (LAS bf16*)(F.lds + RING_OFF + GP_VNT);
    const size_t r0 = (size_t)b * SEQ + (size_t)n * 128;
    const int sj = tid & 127, cq = tid >> 7, wi = tid >> 2, jq = tid & 3;
    v4u vreg[2][4]; f32x4 wreg[2][8];
#pragma unroll
    for (int u = 0; u < 2; ++u)
#pragma unroll
        for (int c = 0; c < 4; ++c) vreg[u][c] = *(const v4u*)(GV + (r0 + sj) * 512 + (g0 + u) * 128 + 32 * cq + 8 * c);
    const float mu = GST[2 * (r0 + sj)], rs = GST[2 * (r0 + sj) + 1];
#pragma unroll
    for (int u = 0; u < 2; ++u) { const float* wr = w_s + ((size_t)(g0 + u) * 128 + wi) * 128 + 32 * jq;
#pragma unroll
        for (int c = 0; c < 8; ++c) wreg[u][c] = *(const f32x4*)(wr + 4 * c); }
    __syncthreads();
#pragma unroll
    for (int u = 0; u < 2; ++u) { const int g = g0 + u; LAS bf16* Ws = WsB + u * (128 * RP128); LAS bf16* VnT = VnTB + u * (128 * RP128);
#pragma unroll
        for (int c = 0; c < 4; ++c) { const int j0 = 32 * jq + 8 * c; const f32x4 a = wreg[u][2 * c], bq = wreg[u][2 * c + 1];
            v4u w; w.x = pk2(j0 + 0 <= wi ? a.x : 0.f, j0 + 1 <= wi ? a.y : 0.f); w.y = pk2(j0 + 2 <= wi ? a.z : 0.f, j0 + 3 <= wi ? a.w : 0.f);
            w.z = pk2(j0 + 4 <= wi ? bq.x : 0.f, j0 + 5 <= wi ? bq.y : 0.f); w.w = pk2(j0 + 6 <= wi ? bq.z : 0.f, j0 + 7 <= wi ? bq.w : 0.f);
            *(LAS v4u*)(Ws + wi * RP128 + j0) = w; }
#pragma unroll
        for (int c = 0; c < 4; ++c) { float x[8]; unpack8(vreg[u][c], x);
            const f32x4 ga = *(const f32x4*)(lng + g * 128 + 32 * cq + 8 * c), gb = *(const f32x4*)(lng + g * 128 + 32 * cq + 8 * c + 4);
            const f32x4 ba = *(const f32x4*)(lnb + g * 128 + 32 * cq + 8 * c), bb = *(const f32x4*)(lnb + g * 128 + 32 * cq + 8 * c + 4);
            const float gm[8] = {ga.x, ga.y, ga.z, ga.w, gb.x, gb.y, gb.z, gb.w}, bt[8] = {ba.x, ba.y, ba.z, ba.w, bb.x, bb.y, bb.z, bb.w};
#pragma unroll
            for (int e = 0; e < 8; ++e) VnT[(32 * cq + 8 * c + e) * RP128 + sj] = (bf16)f2bf((x[e] - mu) * rs * gm[e] + bt[e]); }
    }
    LDS_WAIT(); __syncthreads();
    const int i0 = 16 * wid, nks = (wid + 2) >> 1;
#pragma unroll
    for (int u = 0; u < 2; ++u) { const int g = g0 + u; LAS bf16* Ws = WsB + u * (128 * RP128); LAS bf16* VnT = VnTB + u * (128 * RP128); LAS bf16* Sw = Ws + i0 * RP128;
        float bs[4];
#pragma unroll
        for (int reg = 0; reg < 4; ++reg) bs[reg] = b_s[g * 128 + i0 + 4 * q4 + reg];
        v4u gur[4];
#pragma unroll
        for (int c = 0; c < 4; ++c) { const int ch = c * 64 + lane, row = ch >> 4, cc = ch & 15; gur[c] = *(const v4u*)(GU + (r0 + i0 + row) * 512 + g * 128 + 8 * cc); }
        f32x4 x[8];
#pragma unroll
        for (int cb = 0; cb < 8; ++cb) x[cb] = (f32x4){0.f, 0.f, 0.f, 0.f};
#pragma unroll 1
        for (int ks = 0; ks < nks; ++ks) {
            const bf16x8_t a = ldfrag16(Ws, i0 + l15, RP128, ks, q4);
#pragma unroll
            for (int cb = 0; cb < 8; ++cb) x[cb] = MFMA16(a, ldfrag16(VnT, 16 * cb + l15, RP128, ks, q4), x[cb]);
        }
#pragma unroll
        for (int cb = 0; cb < 8; ++cb)
#pragma unroll
            for (int reg = 0; reg < 4; ++reg) Sw[(4 * q4 + reg) * RP128 + 16 * cb + l15] = (bf16)f2bf(x[cb][reg] + bs[reg]);
        LDS_WAIT();
#pragma unroll
        for (int c = 0; c < 4; ++c) { const int ch = c * 64 + lane, row = ch >> 4, cc = ch & 15;
            float sp[8], gu[8]; unpack8(*(const LAS v4u*)(Sw + row * RP128 + 8 * cc), sp); unpack8(gur[c], gu);
            v4u w; w.x = pk2(sp[0] * gu[0], sp[1] * gu[1]); w.y = pk2(sp[2] * gu[2], sp[3] * gu[3]); w.z = pk2(sp[4] * gu[4], sp[5] * gu[5]); w.w = pk2(sp[6] * gu[6], sp[7] * gu[7]);
            *(v4u*)(YB + (r0 + i0 + row) * 1536 + 1024 + g * 128 + 8 * cc) = w; }
    }
    __syncthreads();
}


__device__ __forceinline__ void moe_tail_unit(Frame& F, const MoeTiles& mt, int e, int rb, int cb) {
    int cnt, t0; mt.expert(e, cnt, t0);
    const int re = cnt & 255, nfull = cnt >> 8;
    if (64 * rb >= re) return;
    int tid_ = threadIdx.x; asm volatile("" : "+v"(tid_));
    const int tid = tid_, lane = tid & 63, wid = __builtin_amdgcn_readfirstlane(tid >> 6), l15 = lane & 15, q4 = lane >> 4;
    const int rl = 16 * (wid & 3), cl = 64 * (wid >> 2), srow = tid >> 3, sch = tid & 7;
    const unsigned char* Ag = (const unsigned char*)(F.ws + WS_HID) + ((size_t)(t0 + nfull) * 256 + 64 * rb + srow) * DFF_E + 16 * sch;
    const unsigned char* Bg = (const unsigned char*)(F.ws + WS_WMD) + ((size_t)e * 1024 + 128 * cb + srow) * DFF_E + 16 * sch;
    constexpr int TP = 272;
    LAS unsigned char* As = F.lds + RING_OFF; LAS unsigned char* Bs = F.lds + RING_OFF + 2 * 64 * TP;
    f32x4 acc[4] = {{0.f, 0.f, 0.f, 0.f}, {0.f, 0.f, 0.f, 0.f}, {0.f, 0.f, 0.f, 0.f}, {0.f, 0.f, 0.f, 0.f}};
    v4u ra[2][2], rbv[2][4];
#define TAIL_LOAD(s_, kt) do { ra[s_][0] = *(const v4u*)(Ag + 256 * (kt)); ra[s_][1] = *(const v4u*)(Ag + 256 * (kt) + 128); rbv[s_][0] = *(const v4u*)(Bg + 256 * (kt)); rbv[s_][1] = *(const v4u*)(Bg + 256 * (kt) + 128); \
        rbv[s_][2] = *(const v4u*)(Bg + (size_t)64 * DFF_E + 256 * (kt)); rbv[s_][3] = *(const v4u*)(Bg + (size_t)64 * DFF_E + 256 * (kt) + 128); } while (0)
#define TAIL_STEP(s_, kt) do { LAS unsigned char* as = As + (s_) * (64 * TP); LAS unsigned char* bs = Bs + (s_) * (128 * TP); \
        *(LAS v4u*)(as + srow * TP + 16 * sch) = ra[s_][0]; *(LAS v4u*)(as + srow * TP + 128 + 16 * sch) = ra[s_][1]; \
        *(LAS v4u*)(bs + srow * TP + 16 * sch) = rbv[s_][0]; *(LAS v4u*)(bs + srow * TP + 128 + 16 * sch) = rbv[s_][1]; \
        *(LAS v4u*)(bs + (srow + 64) * TP + 16 * sch) = rbv[s_][2]; *(LAS v4u*)(bs + (srow + 64) * TP + 128 + 16 * sch) = rbv[s_][3]; \
        LDS_WAIT(); __syncthreads(); \
        if ((kt) + 2 < DFF_E / 256) TAIL_LOAD(s_, (kt) + 2); \
        _Pragma("unroll") for (int kk = 0; kk < 2; ++kk) { \
            const LAS unsigned char* ap = as + (rl + l15) * TP + 128 * kk + 32 * q4; \
            const pg8::v8i_t a = __builtin_shufflevector(*(const LAS pg8::v4i_t*)ap, *(const LAS pg8::v4i_t*)(ap + 16), 0, 1, 2, 3, 4, 5, 6, 7); \
            _Pragma("unroll") for (int j = 0; j < 4; ++j) { const LAS unsigned char* bp = bs + (cl + 16 * j + l15) * TP + 128 * kk + 32 * q4; \
                const pg8::v8i_t b = __builtin_shufflevector(*(const LAS pg8::v4i_t*)bp, *(const LAS pg8::v4i_t*)(bp + 16), 0, 1, 2, 3, 4, 5, 6, 7); \
                acc[j] = __builtin_amdgcn_mfma_scale_f32_16x16x128_f8f6f4(a, b, acc[j], 0, 0, 0, 0x7f7f7f7f, 0, (int)E8_DN); } } } while (0)
    TAIL_LOAD(0, 0); TAIL_LOAD(1, 1);
    __syncthreads();
#pragma unroll 1
    for (int kt = 0; kt < DFF_E / 256; kt += 2) { TAIL_STEP(0, kt); TAIL_STEP(1, kt + 1); }
    static_assert((DFF_E / 256) % 2 == 0, "even number of K-steps");
#undef TAIL_LOAD
#undef TAIL_STEP
    const unsigned* list = (const unsigned*)(F.ws + WS_LIST); const float* gatew = (const float*)(F.ws + WS_GATEW);
    bf16* c0 = (bf16*)(F.ws + WS_YPRE); bf16* c1 = (bf16*)(F.ws + WS_C1);
#pragma unroll
    for (int reg = 0; reg < 4; ++reg) { const int r = 64 * rb + rl + 4 * q4 + reg;
        if (r < re) { const int slot = nfull * 256 + r; const unsigned ent = list[e * 16384 + slot]; const float g = gatew[e * 16384 + slot];
            bf16* dst = ((ent >> 31) ? c1 : c0) + (size_t)(ent & 0x7fffffffu) * 1024 + 128 * cb + cl + l15;
#pragma unroll
            for (int j = 0; j < 4; ++j) dst[16 * j] = (bf16)f2bf(acc[j][reg] * g); } }
    __syncthreads();
}


constexpr int CV_I_IN = 16 * 112, CV_I_BR = 8 * 16, CV_I_OUT = 16 * 16, CV_I_DU = 16 * 88, CV_I_DD = 44 * 16, CV_I_MU = 16 * 112, CV_I_MD = 56 * 16;
constexpr int CV_I_G8 = 16 * 48;
constexpr int CV_NITEMS = 2 * CV_I_IN + 6 * CV_I_BR + 2 * CV_I_OUT + CV_I_DU + CV_I_DD + 8 * CV_I_MU + 8 * CV_I_MD + ((GATES_FP8 && !P1_I8) ? 2 * CV_I_G8 : 0);
constexpr int CV_MD0 = 8 * CV_I_MU, CV_MD1 = 8 * CV_I_MU + 8 * CV_I_MD;
constexpr int CV_DEFER = 5 * CV_I_MU;
__device__ __forceinline__ void cvt_global_item(Frame& F, int it, LAS float* scr, int lane) {
    int r = it; bool done = false;
#pragma unroll 1
    for (int e = 0; e < 8 && !done; ++e) { CvtJob j{(const float*)(const GAS float*)lds_ptr(F.lds, 15) + (size_t)e * 1024 * 7168, 1024, 7168, 7168, (bf16*)(F.ws + WS_WMU + (size_t)e * 7168 * 1024), 1024, 0, 2, DFF_E, SC_WU8}; done = cvt_run(j, r, scr, lane); }
#pragma unroll 1
    for (int e = 0; e < 8 && !done; ++e) { CvtJob j{(const float*)(const GAS float*)lds_ptr(F.lds, 16) + (size_t)e * 3584 * 1024, 3584, 1024, 1024, (bf16*)(F.ws + WS_WMD + (size_t)e * 1024 * 3584), 3584, 0, 0, 0, SC_WD8}; done = cvt_run(j, r, scr, lane); }
#pragma unroll 1
    for (int l = 0; l < 2 && !done; ++l) { CvtJob j{(const float*)(const GAS float*)lds_ptr(F.lds, 1) + (size_t)l * 1024 * N_INSRC, 1024, N_INSRC, N_INV, (bf16*)(F.ws + WS_WIN) + (size_t)l * N_INV * 1024, 1024, 0, 1, 0, P1_I8 ? -SC_WI8 : 0.f}; done = cvt_run(j, r, scr, lane); }
#pragma unroll 1
    for (int q = 0; q < 6 && !done; ++q) { const int l = q / 3, n = q % 3; CvtJob j{(const float*)(const GAS float*)lds_ptr(F.lds, 8) + (size_t)q * 512 * 1024, 512, 1024, 1024, (bf16*)(F.ws + WS_WBR) + (size_t)l * 1024 * 1536, 1536, n * 512, 0, 0, 0.f}; done = cvt_run(j, r, scr, lane); }
#pragma unroll 1
    for (int l = 0; l < 2 && !done; ++l) { CvtJob j{(const float*)(const GAS float*)lds_ptr(F.lds, 9) + (size_t)l * 1024 * 1024, 1024, 1024, 1024, (bf16*)(F.ws + WS_WOUT) + (size_t)l * 1024 * 1024, 1024, 0, 0, 0, 0.f}; done = cvt_run(j, r, scr, lane); }
    if (!done) { CvtJob j{(const float*)(const GAS float*)lds_ptr(F.lds, 12), 1024, 2 * DFF_D, 2 * DFF_D, (bf16*)(F.ws + WS_WDU), 1024, 0, 2, DFF_D, (DENSE_FP8 == 4) ? -SC_WI8 : (DENSE_FP8 == 1 || DENSE_FP8 == 2) ? SC_WU8 : 0.f}; done = cvt_run(j, r, scr, lane); }
    if (!done) { CvtJob j{(const float*)(const GAS float*)lds_ptr(F.lds, 13), DFF_D, 1024, 1024, (bf16*)(F.ws + WS_WDD), DFF_D, 0, 0, 0, (DENSE_FP8 == 1 || DENSE_FP8 == 3) ? SC_WD8 : 0.f}; done = cvt_run(j, r, scr, lane); }
#if GATES_FP8 && !P1_I8
#pragma unroll 1
    for (int l = 0; l < 2 && !done; ++l) { CvtJob j{(const float*)(const GAS float*)lds_ptr(F.lds, 1) + (size_t)l * 1024 * N_INSRC, 1024, N_INSRC, 3072, (bf16*)(F.ws + WS_WIN8 + (size_t)l * 3072 * 1024), 1024, 0, 1, 0, SC_WU8, 4096}; done = cvt_run(j, r, scr, lane); }
#endif
}

struct Args { const float* in[17]; float* out; unsigned char* ws; int ph_lo, ph_hi; };
constexpr int N_PHASES = 17;

__global__ void __launch_bounds__(NWAVES * 64, 2) mega_fwd(Args args) {
    extern __shared__ __attribute__((aligned(16))) unsigned char lds[];
    Frame F;
    F.lds = (LAS unsigned char*)lds;
    F.MISC = (volatile LAS unsigned*)(F.lds + MISC_OFF);
    F.tid = threadIdx.x; F.lane = F.tid & 63; F.wave = __builtin_amdgcn_readfirstlane(F.tid >> 6);
    F.G = gridDim.x; { const int bx = blockIdx.x; F.vcu = (F.G % 8 == 0) ? (bx % 8) * (F.G / 8) + bx / 8 : bx; }
    F.ws = args.ws; F.ctl = (gu32*)(args.ws + WS_CTL);
    for (int u = F.tid; u < (LDS_BYTES - LDSCTL_OFF) / 4; u += NWAVES * 64) ((LAS unsigned*)(F.lds + LDSCTL_OFF))[u] = 0u;
    __syncthreads();
    XcdBarrier bar = xcd_barrier_post((unsigned*)(F.ctl + CW_BAR), F.MISC + 8, gridDim.x, 0u);
    const bool grp = (F.G == 256);
    XcdBarrier gbar = bar;
    if (grp) gbar = xcd_barrier_post((unsigned*)(F.ctl + CW_BAR) + (1 + (blockIdx.x & 7)) * XCD_BAR_WORDS, F.MISC + 10, 32u, 1u);
#define GRID_BAR() xcd_barrier(bar)
#define GRP_BAR() do { if (grp) xcd_barrier(gbar); else xcd_barrier(bar); } while (0)
    const int lo = args.ph_lo, hi = args.ph_hi;
#ifndef PH_MASK
#define PH_MASK 0x1ff
#endif
#define IN(k) (lo <= (k) && (k) < hi)
#ifndef DUP_PHASE
#define DUP_PHASE (-1)
#endif
#define REPS(k) (((k) == DUP_PHASE) ? 2 : 1)
#ifndef P2DUP
#define P2DUP 0
#endif
#define PHASE_BEGIN() do { int t_ = threadIdx.x; asm volatile("" : "+v"(t_)); F.tid = t_; F.lane = t_ & 63; F.wave = __builtin_amdgcn_readfirstlane(t_ >> 6); } while (0)
#define ON(j) (((PH_MASK) >> (j)) & 1)
#define SEAM(k) do { if (IN(k) && IN((k) + 1)) GRID_BAR(); } while (0)
#define SEAMG(k) do { if (IN(k) && IN((k) + 1)) GRP_BAR(); } while (0)

    if (F.tid == 0) { LAS unsigned long long* pt = (LAS unsigned long long*)(F.lds + PTAB_OFF);
#pragma unroll
        for (int i = 0; i < 17; ++i) pt[i] = (unsigned long long)args.in[i];
        pt[17] = (unsigned long long)args.out; }
    LDS_WAIT(); __syncthreads();
#define INP(k) ((const float*)(const GAS float*)lds_ptr(F.lds, (k)))
    if (ON(0) && IN(0)) { for (int rep_ = 0; rep_ < REPS(0); ++rep_) { PHASE_BEGIN();
        LAS float* scr = (LAS float*)(F.lds + RING_OFF + F.wave * 17408);
        static_assert(NWAVES * 17408 <= RING_BYTES, "conversion tiles fit the phase scratch");
        const int gw = F.vcu * NWAVES + F.wave, NGW = F.G * NWAVES;
        for (int it = CV_DEFER + gw; it < CV_NITEMS - (CV_MD1 - CV_MD0); it += NGW) { const int jt = it < CV_MD0 ? it : it + (CV_MD1 - CV_MD0); cvt_global_item(F, jt, scr, F.lane); }
        __syncthreads();
        { float* cs = (float*)(F.ws + WS_CS);
          for (int i = F.vcu * 512 + F.tid; i < SEQ * 32; i += F.G * 512) { const int pos = i >> 5, d = i & 31;
              const double rev = (double)pos * exp(-(double)d / 32.0 * 9.210340371976184) * 0.15915494309189535; const float fr_ = (float)(rev - floor(rev));
              cs[i] = __builtin_amdgcn_cosf(fr_); cs[65536 + i] = __builtin_amdgcn_sinf(fr_); } }
        p0_rows(F, INP(0), INP(1), INP(2));
    } }
    SEAM(0);

#pragma unroll 1
    for (int l = 0; l < 2; ++l) {
        const int pb = 1 + 8 * l;
        const float* xres = (l == 0) ? INP(0) : ((float*)(F.ws + WS_XF));
        if (ON(1) && IN(pb + 0)) { for (int rep_ = 0; rep_ < REPS(pb + 0); ++rep_) { PHASE_BEGIN();
            const bool g8 = (GATES_FP8 == 2) || (GATES_FP8 == 1 && l == 1);
#if P1_I8
            {
                ProjSched S; S.init(M / 256, 16, F.G, (int)blockIdx.x); S.A = (const bf16*)(F.ws + WS_X8IN); S.Bt = (const bf16*)(F.ws + WS_WIN) + (size_t)l * N_INV * 1024; S.K = 1024; S.esz = 1;
                EpiProjT<true> E{F.ws, INP(3) + l * 3072, ((const float*)(F.ws + WS_CS))};
                pg8::gemm_phase<EpiProjT<true>, ProjSched, 1u>(F.lds + RING_OFF, 1024, S, E);
                pg8::PlainSched S8; S8.init(M / 256, 12, F.G, (int)blockIdx.x); S8.A = (const bf16*)(F.ws + WS_X8IN); S8.Bt = (const bf16*)((const unsigned char*)((const bf16*)(F.ws + WS_WIN) + (size_t)l * N_INV * 1024) + (size_t)4096 * 1024); S8.K = 1024; S8.esz = 1;
                EpiGate8T<true> E8{(bf16*)(F.ws + WS_GT), INP(3) + l * 3072};
                pg8::gemm_phase<EpiGate8T<true>, pg8::PlainSched, 1u>(F.lds + RING_OFF, 1024, S8, E8);
            }
#else
            ProjSched S; S.init(M / 256, g8 ? 16 : N_INV / 256, F.G, (int)blockIdx.x); S.A = ((bf16*)(F.ws + WS_XB)); S.Bt = (const bf16*)(F.ws + WS_WIN) + (size_t)l * N_INV * 1024; S.K = 1024;
            EpiProj E{F.ws, INP(3) + l * 3072, ((const float*)(F.ws + WS_CS))};
            pg8::gemm_phase<EpiProj, ProjSched>(F.lds + RING_OFF, 1024, S, E);
#if GATES_FP8
            if (g8) {
                pg8::PlainSched S8; S8.init(M / 256, 12, F.G, (int)blockIdx.x); S8.A = (const bf16*)(F.ws + WS_X8IN); S8.Bt = (const bf16*)(F.ws + WS_WIN8 + (size_t)l * 3072 * 1024); S8.K = 1024; S8.esz = 1;
                EpiGate8 E8{(bf16*)(F.ws + WS_GT), INP(3) + l * 3072};
                pg8::gemm_phase<EpiGate8, pg8::PlainSched, E8_UP>(F.lds + RING_OFF, 1024, S8, E8);
            }
#endif
#endif
        } }
        SEAMG(pb + 0);
        if (ON(2) && IN(pb + 1)) { for (int rep_ = 0; rep_ < REPS(pb + 1); ++rep_) { PHASE_BEGIN();
            {
#if NAIVE_FOX
            LAS float* tab = (LAS float*)(F.lds + RING_OFF + 4096); LAS float* wtot = (LAS float*)(F.lds + RING_OFF + 4096 + 8192);
            for (int uu = F.vcu; uu < 64 * 8; uu += F.G) {
                const int bh = uu >> 3, qb = uu & 7, b = bh >> 3, h = bh & 7;
                fox_bias_table<false>(F, b, h, tab, wtot);
                for (int r = F.wave; r < 256; r += NWAVES) naive_fox_row(F, b, h, qb * 256 + r, tab);
                __syncthreads();
            }
#else
            LAS float* tab = (LAS float*)(F.lds + RING_OFF + 86016); LAS float* wtot = (LAS float*)(F.lds + RING_OFF + 86016 + 32768);
            static_assert(attn_body::ATTN_LDS_BYTES <= 86016 && 86016 + 32768 + 64 <= RING_BYTES, "attention scratch below the bias rows");
            for (int d_ = 0; d_ < ((P2DUP & 1) ? 2 : 1); ++d_)
            for (int pp = F.vcu; pp < 256; pp += F.G) {
                const int bh = pp >> 2, sq = pp & 3, b = bh >> 3, h = bh & 7;
                fox_bias_table<true>(F, b, h, tab, wtot);
#pragma unroll 1
                for (int i = 0; i < 2; ++i)
                    attn_body::attn_unit<8>(b, h, i ? 7 - sq : sq, (const attn_body::bf16*)(F.ws + WS_FQ), (const attn_body::bf16*)(F.ws + WS_FK), (const attn_body::bf16*)(F.ws + WS_FV), (attn_body::bf16*)(F.ws + WS_YB), (char*)lds + RING_OFF, (attn_body::lds_tabptr)tab);
            }
            __syncthreads();
#endif
            }
#if NAIVE_RET == 1
            { const int gw = F.vcu * NWAVES + F.wave, NGW = F.G * NWAVES;
              for (int idx = gw; idx < BATCH * 4 * SEQ; idx += NGW) { const int t = idx & (SEQ - 1), bh = idx >> 11; naive_ret_row(F, bh >> 2, bh & 3, t); } }
#endif
#if NAIVE_GMLP == 1
            for (int uu = F.vcu; uu < BATCH * 16 * 4; uu += F.G) { const int g = uu & 3, n = (uu >> 2) & 15, b = uu >> 6;
                naive_gmlp_unit(F, b, n, g, INP(4) + (size_t)l * 4 * 128 * 128, INP(5) + l * 512, INP(6) + l * 512, INP(7) + l * 512); }
#endif
#if MK_N_LAUNCHES == 1 && NAIVE_RET == 0 && NAIVE_GMLP == 0
            for (int d_ = 0; d_ < ((P2DUP & 2) ? 2 : 1); ++d_)
            for (int uu = 2 * F.vcu; uu < 512; uu += 2 * F.G) {
#pragma unroll 1
                for (int q = 0; q < 2; ++q) { const int un = uu + q, bh = un >> 4; ret_kv_unit(F, bh >> 2, bh & 3, un & 15); } }
            if (grp) { if ((F.vcu & 31) < 16) gmlp_stat_unit(F, F.vcu >> 5, F.vcu & 31); }
            else for (int uu = F.vcu; uu < 128; uu += F.G) gmlp_stat_unit(F, uu >> 4, uu & 15);
            GRP_BAR();
            for (int d_ = 0; d_ < ((P2DUP & 4) ? 2 : 1); ++d_)
            for (int pp = F.vcu; pp < 256; pp += F.G) { const int bh = pp >> 3, sq = pp & 7;
#pragma unroll 1
                for (int q = 0; q < 2; ++q) ret_out_unit(F, bh >> 2, bh & 3, q ? 15 - sq : sq); }
            for (int d_ = 0; d_ < ((P2DUP & 8) ? 2 : 1); ++d_)
            for (int uu = F.vcu; uu < 256; uu += F.G) gmlp_pair(F, uu >> 5, (uu >> 1) & 15, (uu & 1) * 2, INP(4) + (size_t)l * 4 * 128 * 128, INP(5) + l * 512, INP(6) + l * 512, INP(7) + l * 512);
#else
            for (int uu = F.vcu; uu < 256; uu += F.G) {
                if (uu < 128) {
#if NAIVE_RET == 0
                    ret_unit(F, uu >> 4, (uu >> 2) & 3, uu & 3);
#endif
                } else {
#if NAIVE_GMLP == 0
#pragma unroll 1
                    for (int q = 0; q < 4; ++q) { const int gu = (uu - 128) * 4 + q; gmlp_unit(F, gu >> 6, (gu >> 2) & 15, gu & 3, INP(4) + (size_t)l * 4 * 128 * 128, INP(5) + l * 512, INP(6) + l * 512, INP(7) + l * 512); }
#endif
                }
            }
#endif
        } }
        SEAMG(pb + 1);
        if (ON(3) && IN(pb + 2)) { for (int rep_ = 0; rep_ < REPS(pb + 2); ++rep_) { PHASE_BEGIN();
            pg8::PlainSched S; S.init(M / 256, 4, F.G, (int)blockIdx.x); S.A = ((bf16*)(F.ws + WS_YB)); S.Bt = (const bf16*)(F.ws + WS_WBR) + (size_t)l * 1024 * 1536; S.K = 1536;
            EpiMerge E{(const bf16*)(F.ws + WS_GT), ((bf16*)(F.ws + WS_MRG))};
            pg8::gemm_phase<EpiMerge, pg8::PlainSched>(F.lds + RING_OFF, 1536, S, E);
        } }
        SEAMG(pb + 2);
        if (ON(4) && IN(pb + 3)) { for (int rep_ = 0; rep_ < REPS(pb + 3); ++rep_) { PHASE_BEGIN();
            pg8::PlainSched S; S.init(M / 256, 4, F.G, (int)blockIdx.x); S.A = ((bf16*)(F.ws + WS_MRG)); S.Bt = (const bf16*)(F.ws + WS_WOUT) + (size_t)l * 1024 * 1024; S.K = 1024;
            EpiResid E{xres, ((float*)(F.ws + WS_YPRE))};
            pg8::gemm_phase<EpiResid, pg8::PlainSched>(F.lds + RING_OFF, 1024, S, E);
        } }
        SEAMG(pb + 3);
        if (ON(5) && IN(pb + 4)) { for (int rep_ = 0; rep_ < REPS(pb + 4); ++rep_) { PHASE_BEGIN();
            if (l == 0) ln_pass<0>(F, ((float*)(F.ws + WS_YPRE)), 1.f, nullptr, nullptr, INP(10) + (l * 2 + 0) * 1024, INP(11) + (l * 2 + 0) * 1024, ((float*)(F.ws + WS_XF)), (DENSE_FP8 == 1 || DENSE_FP8 == 2 || DENSE_FP8 == 4) ? nullptr : ((bf16*)(F.ws + WS_XB)), (DENSE_FP8 == 1 || DENSE_FP8 == 2 || DENSE_FP8 == 4) ? (unsigned char*)(F.ws + WS_XB) : nullptr, nullptr, 0, 0, nullptr, grp, (DENSE_FP8 == 4) ? -SC_XI8 : SC_X8);
            else ln_pass<2>(F, ((float*)(F.ws + WS_YPRE)), 1.f, nullptr, nullptr, INP(10) + (l * 2 + 0) * 1024, INP(11) + (l * 2 + 0) * 1024, ((float*)(F.ws + WS_XF)), nullptr, (unsigned char*)(F.ws + WS_XB), INP(14), 8, 0, nullptr, grp);
        } }
        if (l == 0) SEAMG(pb + 4); else SEAM(pb + 4);
        if (ON(6) && IN(pb + 5)) { for (int rep_ = 0; rep_ < REPS(pb + 5); ++rep_) { PHASE_BEGIN();
            if (l == 0) {
                pg8::PlainSched S; S.init(M / 256, 2 * DFF_D / 256, F.G, (int)blockIdx.x); S.A = ((bf16*)(F.ws + WS_XB)); S.Bt = (const bf16*)(F.ws + WS_WDU); S.K = 1024;
#if DENSE_FP8 == 1
                S.esz = 1; EpiSwiglu8 E{(unsigned char*)(F.ws + WS_HID), DFF_D};
                pg8::gemm_phase<EpiSwiglu8, pg8::PlainSched, E8_UP>(F.lds + RING_OFF, 1024, S, E);
#elif DENSE_FP8 == 2
                S.esz = 1; EpiSwiglu E{((bf16*)(F.ws + WS_HID)), DFF_D};
                pg8::gemm_phase<EpiSwiglu, pg8::PlainSched, E8_UP>(F.lds + RING_OFF, 1024, S, E);
#elif DENSE_FP8 == 4
                S.esz = 1; EpiSwigluI8 E{((bf16*)(F.ws + WS_HID)), DFF_D};
                pg8::gemm_phase<EpiSwigluI8, pg8::PlainSched, 1u>(F.lds + RING_OFF, 1024, S, E);
#elif DENSE_FP8 == 3
                EpiSwiglu8 E{(unsigned char*)(F.ws + WS_HID), DFF_D};
                pg8::gemm_phase<EpiSwiglu8, pg8::PlainSched>(F.lds + RING_OFF, 1024, S, E);
#else
                EpiSwiglu E{((bf16*)(F.ws + WS_HID)), DFF_D};
                pg8::gemm_phase<EpiSwiglu, pg8::PlainSched>(F.lds + RING_OFF, 1024, S, E);
#endif
                if (F.G == 256 && blockIdx.x >= 128) {
                    LAS float* scr = (LAS float*)(F.lds + RING_OFF + F.wave * 17408);
                    for (int it = ((int)blockIdx.x - 128) * NWAVES + F.wave; it < CV_DEFER; it += 128 * NWAVES) cvt_global_item(F, it, scr, F.lane);
                } else if (F.G != 256) {
                    LAS float* scr = (LAS float*)(F.lds + RING_OFF + F.wave * 17408);
                    for (int it = F.vcu * NWAVES + F.wave; it < CV_DEFER; it += F.G * NWAVES) cvt_global_item(F, it, scr, F.lane);
                }
                __syncthreads();
            } else {
                MoeTiles mt; mt.init(F.ctl);
                MoeUpSched S; S.init(mt.toff[NEXP], 2 * DFF_E / 256, F.G, (int)blockIdx.x); S.A = (const unsigned char*)(F.ws + WS_XB); S.Bt = (const unsigned char*)(F.ws + WS_WMU); S.list = (const unsigned*)(F.ws + WS_LIST); S.mt = mt;
                EpiSwiglu8 E{(unsigned char*)(F.ws + WS_HID), DFF_E};
                pg8::gemm_phase<EpiSwiglu8, MoeUpSched, E8_UP>(F.lds + RING_OFF, 1024, S, E);
                {
                    LAS float* scr = (LAS float*)(F.lds + RING_OFF + F.wave * 17408);
                    const int nwg = mt.toff[NEXP] * (2 * DFF_E / 256), rounds = (nwg + F.G - 1) / F.G, rem = nwg - (rounds - 1) * F.G, nidle = F.G - rem;
                    constexpr int NMD = CV_MD1 - CV_MD0;
                    int q = 0; if (nidle > 0) { q = (NMD + nidle * NWAVES - 1) / (nidle * NWAVES); if (q > 6) q = 6; }
                    int first = nidle * NWAVES * q; if (first > NMD) first = NMD;
                    if ((int)blockIdx.x >= rem) for (int it = ((int)blockIdx.x - rem) * NWAVES + F.wave; it < first; it += nidle * NWAVES) cvt_global_item(F, CV_MD0 + it, scr, F.lane);
                    for (int it = first + (int)blockIdx.x * NWAVES + F.wave; it < NMD; it += F.G * NWAVES) cvt_global_item(F, CV_MD0 + it, scr, F.lane);
                    __syncthreads();
                }
            }
        } }
        if (l == 0) SEAMG(pb + 5); else SEAM(pb + 5);
        if (ON(7) && IN(pb + 6)) { for (int rep_ = 0; rep_ < REPS(pb + 6); ++rep_) { PHASE_BEGIN();
            if (l == 0) {
                pg8::PlainSched S; S.init(M / 256, 4, F.G, (int)blockIdx.x); S.A = ((bf16*)(F.ws + WS_HID)); S.Bt = (const bf16*)(F.ws + WS_WDD); S.K = DFF_D;
                EpiResid E{((float*)(F.ws + WS_XF)), ((float*)(F.ws + WS_YPRE))};
#if DENSE_FP8 == 1 || DENSE_FP8 == 3
                S.esz = 1; pg8::gemm_phase<EpiResid, pg8::PlainSched, E8_DN>(F.lds + RING_OFF, DFF_D, S, E);
#else
                pg8::gemm_phase<EpiResid, pg8::PlainSched>(F.lds + RING_OFF, DFF_D, S, E);
#endif
            } else {
                MoeTiles mt; mt.init(F.ctl);
                MoeDownSched S; S.init(mt.nfull_total(), 4, F.G, (int)blockIdx.x); S.A = (const unsigned char*)(F.ws + WS_HID); S.Bt = (const unsigned char*)(F.ws + WS_WMD); S.mt = mt;
                EpiMoeDown E{((bf16*)(F.ws + WS_YPRE)), ((bf16*)(F.ws + WS_C1)), (const unsigned*)(F.ws + WS_LIST), (const float*)(F.ws + WS_GATEW), mt};
                pg8::gemm_phase<EpiMoeDown, MoeDownSched, E8_DN>(F.lds + RING_OFF, DFF_E, S, E);
                for (int tu = F.vcu; tu < 256; tu += F.G) moe_tail_unit(F, mt, tu >> 5, (tu >> 3) & 3, tu & 7);
            }
        } }
        if (l == 0) SEAMG(pb + 6); else SEAM(pb + 6);
        if (ON(8) && IN(pb + 7)) { for (int rep_ = 0; rep_ < REPS(pb + 7); ++rep_) { PHASE_BEGIN();
            if (l == 0) ln_pass<1>(F, ((float*)(F.ws + WS_YPRE)), 1.f, nullptr, nullptr, INP(10) + (l * 2 + 1) * 1024, INP(11) + (l * 2 + 1) * 1024, ((float*)(F.ws + WS_XF)), ((bf16*)(F.ws + WS_XB)), GATES_FP8 ? (unsigned char*)(F.ws + WS_X8IN) : nullptr, INP(1) + (size_t)1 * 1024 * N_INSRC, N_INSRC, FL_COL, INP(2) + 8, grp, P1_I8 ? -SC_XI8 : SC_X8);
            else ln_pass<0>(F, ((float*)(F.ws + WS_XF)), ALPHA, (const bf16*)(F.ws + WS_YPRE), (const bf16*)(F.ws + WS_C1), INP(10) + (l * 2 + 1) * 1024, INP(11) + (l * 2 + 1) * 1024, (float*)(GAS float*)lds_ptr(F.lds, 17), nullptr, nullptr, nullptr, 0, 0, nullptr, grp);
        } }
        if (l == 0) SEAMG(pb + 7);
    }
#undef IN
#undef SEAM
}

extern "C" void kernel_launch(void* const* d_in, const int* in_sizes, int n_in, void* d_out, int out_size, void* d_ws, size_t ws_size, hipStream_t stream) {
    static int grid = 0;
    if (grid == 0) {
        if (n_in != 17 || in_sizes[0] != M * D || out_size != M * D || ws_size < WS_END) { fprintf(stderr, "kernel_launch: unexpected shapes / workspace (%zu)\n", ws_size); grid = -1; return; }
        int dev = 0, cus = 0, per_cu = 0;
        if (hipGetDevice(&dev) != hipSuccess || hipDeviceGetAttribute(&cus, hipDeviceAttributeMultiprocessorCount, dev) != hipSuccess) { grid = -1; return; }
        if (hipFuncSetAttribute((const void*)mega_fwd, hipFuncAttributeMaxDynamicSharedMemorySize, LDS_BYTES) != hipSuccess) { grid = -1; return; }
        if (hipOccupancyMaxActiveBlocksPerMultiprocessor(&per_cu, (const void*)mega_fwd, NWAVES * 64, LDS_BYTES) != hipSuccess || per_cu < 1) { fprintf(stderr, "kernel_launch: occupancy query says %d\n", per_cu); }
        (void)hipGetLastError();
        grid = cus;
    }
    if (grid < 0) return;
    if (hipMemsetAsync((char*)d_ws + WS_CTL, 0, CTL_ZERO_BYTES, stream) != hipSuccess) return;
    Args a{};
    for (int i = 0; i < 17; ++i) a.in[i] = (const float*)d_in[i];
    a.out = (float*)d_out; a.ws = (unsigned char*)d_ws;
#if MK_N_LAUNCHES == 1
    a.ph_lo = 0; a.ph_hi = N_PHASES;
    hipLaunchKernelGGL(mega_fwd, dim3(grid), dim3(NWAVES * 64), LDS_BYTES, stream, a);
#else
    for (int p = 0; p < N_PHASES; ++p) { a.ph_lo = p; a.ph_hi = p + 1; hipLaunchKernelGGL(mega_fwd, dim3(grid), dim3(NWAVES * 64), LDS_BYTES, stream, a); }
#endif
}
```

```cpp
#include <hip/hip_runtime.h>
#include <cstdio>
#include <cstdint>
#include <hip/hip_bf16.h>
#include <cmath>

#ifndef MK_N_LAUNCHES
#define MK_N_LAUNCHES 1
#endif
#ifndef DENSE_FP8
#define DENSE_FP8 4
#endif
#ifndef P1_I8
#define P1_I8 1
#endif
#ifndef GATES_FP8
#define GATES_FP8 2
#endif
#ifndef NAIVE_FOX
#define NAIVE_FOX 0
#endif
#ifndef NAIVE_RET
#define NAIVE_RET 0
#endif
#ifndef NAIVE_GMLP
#define NAIVE_GMLP 0
#endif

namespace pg8 {
#define PG8_LAS __attribute__((address_space(3)))
typedef unsigned short bf16_t;
typedef short bf16x8 __attribute__((ext_vector_type(8)));
typedef float f32x4 __attribute__((ext_vector_type(4)));
typedef float f32x2 __attribute__((ext_vector_type(2)));
typedef unsigned u32x4 __attribute__((ext_vector_type(4)));
typedef unsigned u32x2 __attribute__((ext_vector_type(2)));
constexpr int BM = 256, BK = 64, HALF = 128, HTB = HALF * BK * 2  , STAGE_BYTES = 8 * HTB, NXCD = 8, WGM = 4;

__host__ __device__ __forceinline__ int lds_byte(int r, int c) { const int st = (r >> 4) * 2 + (c >> 5), rr = r & 15, cc = c & 31, ob = rr * 64 + cc * 2; return st * 1024 + (ob ^ (((ob >> 9) & 1) << 5)); }
__host__ __device__ __forceinline__ void stage_rc(int b, int& R, int& C) { const int st = b / 1024, sb = b % 1024, swz = sb ^ (((sb >> 9) & 1) << 5); R = (st >> 1) * 16 + swz / 64; C = (st & 1) * 32 + (swz % 64) / 2; }
__host__ __device__ __forceinline__ int perm32(int rho) { const int n = rho >> 4, i = rho & 15; return 8 * (i >> 2) + 4 * n + (i & 3); }

struct Unit { int pm, pn; };

struct TileOrder {
    int nM, nN, nwg, G, c;
    __device__ __forceinline__ void init(int nM_, int nN_, int G_, int c_) { nM = nM_; nN = nN_; nwg = nM * nN; G = G_; c = c_; }
    __device__ __forceinline__ bool next(int i, Unit& u) const {
        const long L = (long)i * G + c; if (L >= nwg) return false;
        int wgid = (int)L; { const int q = nwg / NXCD, r = nwg % NXCD, xcd = wgid % NXCD, off = wgid / NXCD; wgid = (xcd < r ? xcd * (q + 1) : r * (q + 1) + (xcd - r) * q) + off; }
        const int nig = WGM * nN, gid = wgid / nig, fm = gid * WGM, gsz = (nM - fm) < WGM ? (nM - fm) : WGM;
        u.pm = fm + ((wgid % nig) % gsz); u.pn = (wgid % nig) / gsz; return true;
    }
};
struct PlainSched : TileOrder {
    static constexpr bool GATHER = false;
    const bf16_t* A; const bf16_t* Bt; int K; int esz = 2;
    __device__ __forceinline__ const char* abase(const Unit& u) const { return (const char*)A + (size_t)u.pm * BM * K * esz; }
    __device__ __forceinline__ void aoffs_load(const Unit&, const int (&)[2], PG8_LAS unsigned*) const {}
    __device__ __forceinline__ void aoffs_fin(const Unit&, const int (&)[2], const int (&)[2], const PG8_LAS unsigned*, int, unsigned (&)[2][2]) const {}
    __device__ __forceinline__ void aoffs(const Unit&, const int (&R)[2], const int (&C)[2], unsigned (&o)[2][2]) const {
#pragma unroll
        for (int h = 0; h < 2; ++h)
#pragma unroll
            for (int i = 0; i < 2; ++i) o[h][i] = (unsigned)((R[i] + h * HALF) * K + C[i]) * 2u; }
    __device__ __forceinline__ const char* bbase(const Unit& u) const { return (const char*)Bt + (size_t)u.pn * BM * K * esz; }
};

typedef __bf16 bf16x2_v __attribute__((ext_vector_type(2)));
__device__ __forceinline__ unsigned cvt_pk_bf16(float lo, float hi) { f32x2 v = {lo, hi}; bf16x2_v b = __builtin_convertvector(v, bf16x2_v); return __builtin_bit_cast(unsigned, b); }

typedef float f32x2_pk __attribute__((ext_vector_type(2)));
__device__ __forceinline__ f32x4 zero4() { f32x2_pk lo, hi; asm volatile("v_pk_mov_b32 %0, 0, 0" : "=v"(lo)); asm volatile("v_pk_mov_b32 %0, 0, 0" : "=v"(hi)); return __builtin_shufflevector(lo, hi, 0, 1, 2, 3); }
typedef int v4i_t __attribute__((ext_vector_type(4)));
typedef int v8i_t __attribute__((ext_vector_type(8)));
__host__ __device__ __forceinline__ int lds_byte8(int r, int g) { const int st = (r >> 4) * 2 + (g >> 1), ob = (r & 15) * 64 + 32 * (g & 1); return st * 1024 + (ob ^ (((ob >> 9) & 1) << 5)); }
template <class Epi, class Sched, unsigned FP8S = 0u>
__device__ __forceinline__ void gemm_phase(PG8_LAS unsigned char* lds, const int K, const Sched& S, const Epi& E) {
    constexpr bool F8 = FP8S != 0u;
    constexpr bool I8 = FP8S == 1u;
    int tid_ = threadIdx.x; asm volatile("" : "+v"(tid_));
    const int tid = tid_, wid = __builtin_amdgcn_readfirstlane(tid >> 6), lane = tid & 63, wr = wid >> 2, wc = wid & 3, fr = lane & 15, fq = lane >> 4;
    const int nt = F8 ? K / 128 : K / BK;
    int Rs[2], Cs[2]; unsigned voffA[2], voffB[2];
#pragma unroll
    for (int i = 0; i < 2; ++i) { int R, C; stage_rc(tid * 16 + i * 8192, R, C); Rs[i] = R; Cs[i] = C; const int Rb = Epi::PERM ? ((R & ~31) + perm32(R & 31)) : R;
        voffA[i] = F8 ? (unsigned)(R * K + 2 * C) : (unsigned)(R * K + C) * 2u; voffB[i] = F8 ? (unsigned)(Rb * K + 2 * C) : (unsigned)(Rb * K + C) * 2u; }
    const size_t kstep = (size_t)(BK * 2);
    const size_t hstep = (size_t)HALF * K * (F8 ? 1 : 2);
    const unsigned ldsw = (unsigned)wid * 1024u;
    const int aoff = F8 ? lds_byte8(wr * 64 + fr, fq) : lds_byte(wr * 64 + fr, fq * 8), boff = F8 ? lds_byte8(wc * 32 + fr, fq) : lds_byte(wc * 32 + fr, fq * 8);
#define PG8_SA(b, h) (((b) * 2 + (h)) * HTB)
#define PG8_SB(b, h) ((4 + (b) * 2 + (h)) * HTB)
#define PG8_STAGE(bufoff, gbase, voff) do { _Pragma("unroll") for (int _i = 0; _i < 2; ++_i) \
        __builtin_amdgcn_global_load_lds((const unsigned*)((const char*)(gbase) + (voff)[_i]), (PG8_LAS unsigned*)(lds + (bufoff) + ldsw + _i * 8192), 16, 0, 0); } while (0)
#define PG8_STA(bufoff, gbase, h, nx) do { if constexpr (Sched::GATHER) { _Pragma("unroll") for (int _i = 0; _i < 2; ++_i) { const unsigned o_ = (nx) ? nof[h][_i] : cof[h][_i]; \
        __builtin_amdgcn_global_load_lds((const unsigned*)((const char*)(gbase) + o_), (PG8_LAS unsigned*)(lds + (bufoff) + ldsw + _i * 8192), 16, 0, 0); } } \
        else { PG8_STAGE(bufoff, (gbase) + (h) * hstep, voffA); } } while (0)
#define PG8_LDA(dst, b, h) do { _Pragma("unroll") for (int m = 0; m < 4; ++m) _Pragma("unroll") for (int k = 0; k < 2; ++k) dst[m][k] = *(const PG8_LAS bf16x8*)(lds + PG8_SA(b, h) + aoff + m * 2048 + k * 1024); } while (0)
#define PG8_LDB(dst, b, h) do { _Pragma("unroll") for (int n = 0; n < 2; ++n) _Pragma("unroll") for (int k = 0; k < 2; ++k) dst[n][k] = *(const PG8_LAS bf16x8*)(lds + PG8_SB(b, h) + boff + n * 2048 + k * 1024); } while (0)
#define PG8_MMA(ai, bj, At, Bt) do { __builtin_amdgcn_s_setprio(1); _Pragma("unroll") for (int m = 0; m < 4; ++m) _Pragma("unroll") for (int n = 0; n < 2; ++n) _Pragma("unroll") for (int k = 0; k < 2; ++k) \
        acc[ai][bj][m][n] = __builtin_amdgcn_mfma_f32_16x16x32_bf16(Bt[n][k], At[m][k], acc[ai][bj][m][n], 0, 0, 0); __builtin_amdgcn_s_setprio(0); } while (0)
#define PG8_LD32(p) __builtin_shufflevector(*(const PG8_LAS v4i_t*)(p), *(const PG8_LAS v4i_t*)((p) + 16), 0, 1, 2, 3, 4, 5, 6, 7)
#define PG8_LDA8(dst, b, h) do { _Pragma("unroll") for (int m = 0; m < 4; ++m) dst[m] = PG8_LD32(lds + PG8_SA(b, h) + aoff + m * 2048); } while (0)
#define PG8_LDB8(dst, b, h) do { _Pragma("unroll") for (int n = 0; n < 2; ++n) dst[n] = PG8_LD32(lds + PG8_SB(b, h) + boff + n * 2048); } while (0)
#define PG8_MMA8(ai, bj, At, Bt) do { __builtin_amdgcn_s_setprio(1); \
        if constexpr (I8) {   \
            _Pragma("unroll") for (int m = 0; m < 4; ++m) _Pragma("unroll") for (int n = 0; n < 2; ++n) \
                asm volatile("v_mfma_i32_16x16x64_i8 %0, %1, %2, %0" : "+v"(acc[ai][bj][m][n]) : "v"(__builtin_shufflevector(Bt[n], Bt[n], 0, 1, 2, 3)), "v"(__builtin_shufflevector(At[m], At[m], 0, 1, 2, 3))); \
            _Pragma("unroll") for (int m = 0; m < 4; ++m) _Pragma("unroll") for (int n = 0; n < 2; ++n) \
                asm volatile("v_mfma_i32_16x16x64_i8 %0, %1, %2, %0" : "+v"(acc[ai][bj][m][n]) : "v"(__builtin_shufflevector(Bt[n], Bt[n], 4, 5, 6, 7)), "v"(__builtin_shufflevector(At[m], At[m], 4, 5, 6, 7))); \
        } else { _Pragma("unroll") for (int m = 0; m < 4; ++m) _Pragma("unroll") for (int n = 0; n < 2; ++n) \
        asm volatile("v_mfma_scale_f32_16x16x128_f8f6f4 %0, %1, %2, %0, %3, %4 op_sel_hi:[0,0,0]" : "+v"(acc[ai][bj][m][n]) : "v"(Bt[n]), "v"(At[m]), "v"(scl_w), "v"(scl_1)); } __builtin_amdgcn_s_setprio(0); } while (0)
#define PG8_XLDA(b, h) do { if constexpr (F8) PG8_LDA8(At8, b, h); else PG8_LDA(At, b, h); } while (0)
#define PG8_XLDB0(b, h) do { if constexpr (F8) PG8_LDB8(B08, b, h); else PG8_LDB(B0, b, h); } while (0)
#define PG8_XLDB1(b, h) do { if constexpr (F8) PG8_LDB8(B18, b, h); else PG8_LDB(B1, b, h); } while (0)
#define PG8_XMMA0(ai, bj) do { if constexpr (F8) PG8_MMA8(ai, bj, At8, B08); else PG8_MMA(ai, bj, At, B0); } while (0)
#define PG8_XMMA1(ai, bj) do { if constexpr (F8) PG8_MMA8(ai, bj, At8, B18); else PG8_MMA(ai, bj, At, B1); } while (0)
#define PG8_WAIT_V(n) asm volatile("s_waitcnt vmcnt(" #n ")" ::: "memory")
#define PG8_WAIT_L(n) asm volatile("s_waitcnt lgkmcnt(" #n ")" ::: "memory")
#define PG8_BAR __builtin_amdgcn_s_barrier()
#define PG8_SCHED __builtin_amdgcn_sched_barrier(0)
    Unit cur, nxt; int ui = 0;
    if (!S.next(0, cur)) return;
    f32x4 acc[2][2][4][2];
#pragma unroll
    for (int a = 0; a < 2; ++a)
#pragma unroll
        for (int b = 0; b < 2; ++b)
#pragma unroll
            for (int m = 0; m < 4; ++m)
#pragma unroll
                for (int n = 0; n < 2; ++n) acc[a][b][m][n] = zero4();
    bf16x8 At[4][2], B0[2][2], B1[2][2]; v8i_t At8[4], B08[2], B18[2];
    int scl_w = (int)FP8S, scl_1 = 0x7f7f7f7f; if constexpr (F8) asm volatile("" : "+v"(scl_w), "+v"(scl_1));
    unsigned cof[2][2], nof[2][2];
    PG8_LAS unsigned* gscr = (PG8_LAS unsigned*)(lds + 8 * HTB + wid * 1024);
    const char* cA = S.abase(cur); if constexpr (Sched::GATHER) { S.aoffs_load(cur, Rs, gscr); asm volatile("s_waitcnt vmcnt(0)" ::: "memory"); S.aoffs_fin(cur, Rs, Cs, gscr, lane, cof); } const char* cB = S.bbase(cur);
    PG8_STAGE(PG8_SB(0, 0), cB, voffB); PG8_STAGE(PG8_SB(0, 1), cB + hstep, voffB); PG8_STA(PG8_SA(0, 0), cA, 0, false); PG8_STA(PG8_SA(0, 1), cA, 1, false);
    if (wr == 1) PG8_BAR;
    PG8_WAIT_V(2); PG8_BAR;
    PG8_STAGE(PG8_SB(1, 0), cB + kstep, voffB); PG8_STA(PG8_SA(1, 0), cA + kstep, 0, false); PG8_STAGE(PG8_SB(1, 1), cB + hstep + kstep, voffB);
    PG8_WAIT_V(6); PG8_BAR;
    for (;;) {
        const bool has_next = S.next(ui + 1, nxt);
        const char* nA = cA; const char* nB = cB;
        if constexpr (Sched::GATHER) {
#pragma unroll
            for (int h = 0; h < 2; ++h)
#pragma unroll
                for (int i = 0; i < 2; ++i) nof[h][i] = cof[h][i]; }
        if (has_next) { nA = S.abase(nxt); if constexpr (Sched::GATHER) S.aoffs_load(nxt, Rs, gscr); nB = S.bbase(nxt); }
#pragma unroll 1
        for (int t = 0; t < nt; t += 2) {
            const bool last = (t == nt - 2);
            const bool skipw = (t == 0) && (ui > 0) && !Sched::GATHER;
            if constexpr (Sched::GATHER) { if (last && has_next) S.aoffs_fin(nxt, Rs, Cs, gscr, lane, nof); }
            if constexpr (Epi::HOOK) { PG8_SCHED; E.khook(acc, cur, t, wr, wc, fr, fq); PG8_SCHED; }
            const char* a1 = cA + (size_t)(t + 1) * kstep;
            const char* a2 = last ? nA : cA + (size_t)(t + 2) * kstep; const char* b2 = last ? nB : cB + (size_t)(t + 2) * kstep;
            const char* a3 = a2 + kstep; const char* b3 = b2 + kstep;
            PG8_XLDB0(0, 0); PG8_XLDB1(0, 1); PG8_SCHED; PG8_XLDA(0, 0); PG8_STA(PG8_SA(1, 1), a1, 1, false);
            if (!skipw) PG8_WAIT_V(8);
            PG8_WAIT_L(0); PG8_BAR; PG8_XMMA0(0, 0); PG8_XMMA1(0, 1); PG8_BAR; PG8_SCHED;
            PG8_XLDA(0, 1); PG8_STAGE(PG8_SB(0, 0), b2, voffB); PG8_STAGE(PG8_SB(0, 1), b2 + hstep, voffB); PG8_STA(PG8_SA(0, 0), a2, 0, last);
            if (!skipw) PG8_WAIT_V(8);
            PG8_WAIT_L(0); PG8_BAR; PG8_XMMA0(1, 0); PG8_XMMA1(1, 1); PG8_BAR; PG8_SCHED;
            PG8_XLDB0(1, 0); PG8_XLDB1(1, 1); PG8_SCHED; PG8_XLDA(1, 0); PG8_STA(PG8_SA(0, 1), a2, 1, last);
            PG8_WAIT_V(8); PG8_WAIT_L(0); PG8_BAR; PG8_XMMA0(0, 0); PG8_XMMA1(0, 1); PG8_BAR; PG8_SCHED;
            PG8_XLDA(1, 1); PG8_STAGE(PG8_SB(1, 0), b3, voffB); PG8_STAGE(PG8_SB(1, 1), b3 + hstep, voffB); PG8_STA(PG8_SA(1, 0), a3, 0, last);
            PG8_WAIT_V(8); PG8_WAIT_L(0); PG8_BAR; PG8_XMMA0(1, 0); PG8_XMMA1(1, 1); PG8_BAR; PG8_SCHED;
        }
        if constexpr (!Sched::GATHER) PG8_WAIT_V(0);
        if constexpr (F8) {
            asm volatile("s_nop 15\n\ts_nop 15\n\ts_nop 15\n\ts_nop 15\n\ts_nop 15" ::: "memory");
#pragma unroll
            for (int a = 0; a < 2; ++a)
#pragma unroll
                for (int b = 0; b < 2; ++b)
#pragma unroll
                    for (int m = 0; m < 4; ++m) asm volatile("" : "+v"(acc[a][b][m][0]), "+v"(acc[a][b][m][1]));
        }
        if (wr == 0) PG8_BAR;
        E(acc, cur, wr, wc, fr, fq);
#ifdef EPI_DUP
        if (Epi::DUPME) { asm volatile("" ::: "memory"); E(acc, cur, wr, wc, fr, fq); }
#endif
        if (!has_next) break;
#pragma unroll
        for (int a = 0; a < 2; ++a)
#pragma unroll
            for (int b = 0; b < 2; ++b)
#pragma unroll
                for (int m = 0; m < 4; ++m)
#pragma unroll
                    for (int n = 0; n < 2; ++n) acc[a][b][m][n] = zero4();
        cur = nxt; cA = nA; cB = nB; ++ui;
        if constexpr (Sched::GATHER) {
#pragma unroll
            for (int h = 0; h < 2; ++h)
#pragma unroll
                for (int i = 0; i < 2; ++i) cof[h][i] = nof[h][i]; }
        if (wr == 1) PG8_BAR;
    }
    PG8_WAIT_V(0);
    PG8_BAR;
#undef PG8_SA
#undef PG8_SB
#undef PG8_STAGE
#undef PG8_STA
#undef PG8_LDA
#undef PG8_LDB
#undef PG8_MMA
#undef PG8_LD32
#undef PG8_LDA8
#undef PG8_LDB8
#undef PG8_MMA8
#undef PG8_XLDA
#undef PG8_XLDB0
#undef PG8_XLDB1
#undef PG8_XMMA0
#undef PG8_XMMA1
#undef PG8_WAIT_V
#undef PG8_WAIT_L
#undef PG8_BAR
#undef PG8_SCHED
}
}

namespace attn_body {
using bf16=__hip_bfloat16;
using bf16x8=__attribute__((ext_vector_type(8)))short;
using s16x4=__attribute__((ext_vector_type(4)))short;
using f32x16=__attribute__((ext_vector_type(16)))float;
using u32x4=__attribute__((ext_vector_type(4)))unsigned;
constexpr int BATCH=8,NHEAD=8,SEQ=2048,D=64,DM=NHEAD*D,PO=1536,OCOL=512;
constexpr int NW=8,QBLK=32,QB=QBLK*NW,KVBLK=64,NQB=SEQ/QB;
constexpr int ATTN_PITCH=DM, ATTN_UNIT_ROWS=QB;
__device__ __forceinline__ int crow(int r,int hi){return (r&3)+8*(r>>2)+4*hi;}
#define SBAR() __builtin_amdgcn_sched_barrier(0)
__device__ __forceinline__ void cmask(f32x16&p0,f32x16&p1,int jb,int qrel,int hi){
  const float NEG=-INFINITY; int kb=64*jb+4*hi;
  #pragma unroll
  for(int r=0;r<16;++r){int kv=kb+(r&3)+8*(r>>2); if(kv>qrel)p0[r]=NEG; if(kv+32>qrel)p1[r]=NEG;}
}

constexpr int NSLOT=3, SLOTB=8192;
constexpr int LDS_K=0, LDS_V=NSLOT*SLOTB, LDS_WS=2*NSLOT*SLOTB, LDS_OST=LDS_WS+NW*64*4, LDS_BYTES=LDS_OST+NW*4096;
constexpr float C2=0.125f*1.4426950408889634f;
__device__ __forceinline__ void glds16(const void*gsrc,unsigned lds_dst){unsigned keep;
  asm volatile("s_mov_b32 %0, m0\n\ts_mov_b32 m0, %2\n\ts_nop 0\n\tglobal_load_lds_dwordx4 %1, off\n\ts_mov_b32 m0, %0":"=&s"(keep):"v"(gsrc),"s"(lds_dst):"memory");}
__device__ __forceinline__ float max3f(float a,float b,float c){float r;asm("v_max3_f32 %0, %1, %2, %3":"=v"(r):"v"(a),"v"(b),"v"(c));return r;}
__device__ __forceinline__ float max2f(float a,float b){float r;asm("v_max_f32_e32 %0, %1, %2":"=v"(r):"v"(a),"v"(b));return r;}
__device__ __forceinline__ float fadd_s(float a,float b){float r;asm("v_add_f32_e32 %0, %1, %2":"=v"(r):"v"(a),"v"(b));return r;}
__device__ __forceinline__ float fsub_s(float a,float b){float r;asm("v_sub_f32_e32 %0, %1, %2":"=v"(r):"v"(a),"v"(b));return r;}
typedef float f32x2_t __attribute__((ext_vector_type(2))); typedef __bf16 bf16x2_t __attribute__((ext_vector_type(2)));
__device__ __forceinline__ unsigned cvtpk_s(float lo,float hi){f32x2_t v={lo,hi};bf16x2_t b=__builtin_convertvector(v,bf16x2_t);return __builtin_bit_cast(unsigned,b);}
#define WAIT_BAR(N) asm volatile("s_waitcnt vmcnt(" #N ") lgkmcnt(0)\n\ts_barrier":::"memory")

__device__ __forceinline__ void qkt(f32x16&p0,f32x16&p1,const char*Kslot,const bf16x8*qr,bf16x8 ka0,bf16x8 ka1,bf16x8 qaug,int r32,int hi){
  const char*kb=Kslot+hi*1024+r32*16;
  p0=__builtin_amdgcn_mfma_f32_32x32x16_bf16(ka0,qaug,f32x16{},0,0,0);p1=__builtin_amdgcn_mfma_f32_32x32x16_bf16(ka1,qaug,f32x16{},0,0,0);
  #pragma unroll
  for(int d0=0;d0<4;++d0){
    const bf16x8 b0=*reinterpret_cast<const bf16x8*>(kb+d0*2048);
    const bf16x8 b1=*reinterpret_cast<const bf16x8*>(kb+d0*2048+512);
    p0=__builtin_amdgcn_mfma_f32_32x32x16_bf16(b0,qr[d0],p0,0,0,0);p1=__builtin_amdgcn_mfma_f32_32x32x16_bf16(b1,qr[d0],p1,0,0,0);}
}
typedef __attribute__((address_space(3))) const char* lds_cptr;
typedef short v4i16_t __attribute__((ext_vector_type(4)));
__device__ __forceinline__ void kload8(bf16x8*kf,lds_cptr kp){
  kf[0]=*(const __attribute__((address_space(3))) bf16x8*)(kp);      kf[1]=*(const __attribute__((address_space(3))) bf16x8*)(kp+512);
  kf[2]=*(const __attribute__((address_space(3))) bf16x8*)(kp+2048); kf[3]=*(const __attribute__((address_space(3))) bf16x8*)(kp+2560);
  kf[4]=*(const __attribute__((address_space(3))) bf16x8*)(kp+4096); kf[5]=*(const __attribute__((address_space(3))) bf16x8*)(kp+4608);
  kf[6]=*(const __attribute__((address_space(3))) bf16x8*)(kp+6144); kf[7]=*(const __attribute__((address_space(3))) bf16x8*)(kp+6656);
}
__device__ __forceinline__ void kload2(bf16x8*kf,lds_cptr kp,int j){ kf[2*j]=*(const __attribute__((address_space(3))) bf16x8*)(kp+j*2048); kf[2*j+1]=*(const __attribute__((address_space(3))) bf16x8*)(kp+j*2048+512); }
__device__ __forceinline__ s16x4 vtr(lds_cptr p){ return __builtin_bit_cast(s16x4,__builtin_amdgcn_ds_read_tr16_b64_v4i16((__attribute__((address_space(3))) v4i16_t*)p)); }
__device__ __forceinline__ float rowmax(const f32x16&p0,const f32x16&p1){
  float a=max3f(p0[0],p0[1],p1[0]),b=max3f(p0[2],p0[3],p1[1]);a=max3f(a,p1[2],p1[3]);
  #pragma unroll
  for(int r=4;r<16;r+=4){a=max3f(a,p0[r],p0[r+1]);b=max3f(b,p0[r+2],p0[r+3]);a=max3f(a,p1[r],p1[r+1]);b=max3f(b,p1[r+2],p1[r+3]);}
  const float m=max2f(a,b);
  auto rr=__builtin_amdgcn_permlane32_swap(__float_as_uint(m),__float_as_uint(m),false,false);
  return max2f(__uint_as_float(rr[0]),__uint_as_float(rr[1]));
}
__device__ __forceinline__ void pv(f32x16*o,int vb,bf16x8 pa0,bf16x8 pa1,bf16x8 pa2,bf16x8 pa3){
  #pragma unroll
  for(int d0=0;d0<2;++d0){s16x4 lo[4],hi[4];
    #pragma unroll
    for(int ks=0;ks<4;++ks){
      asm volatile("ds_read_b64_tr_b16 %0,%1 offset:%c2":"=&v"(lo[ks]):"v"(vb),"i"(d0*4096+ks*1024):"memory");
      asm volatile("ds_read_b64_tr_b16 %0,%1 offset:%c2":"=&v"(hi[ks]):"v"(vb),"i"(d0*4096+ks*1024+512):"memory");}
    asm volatile("s_waitcnt lgkmcnt(0)":::"memory");SBAR();
    #define PK(k) (bf16x8){lo[k][0],lo[k][1],lo[k][2],lo[k][3],hi[k][0],hi[k][1],hi[k][2],hi[k][3]}
    o[d0]=__builtin_amdgcn_mfma_f32_32x32x16_bf16(pa0,PK(0),o[d0],0,0,0);
    o[d0]=__builtin_amdgcn_mfma_f32_32x32x16_bf16(pa1,PK(1),o[d0],0,0,0);
    o[d0]=__builtin_amdgcn_mfma_f32_32x32x16_bf16(pa2,PK(2),o[d0],0,0,0);
    o[d0]=__builtin_amdgcn_mfma_f32_32x32x16_bf16(pa3,PK(3),o[d0],0,0,0);
    #undef PK
  }
}

#ifndef ATTN_STORE16
#define ATTN_STORE16(p,v) (*(u32x4*)(p)=(v))
#endif
typedef __attribute__((address_space(3))) const u32x4* lds_tabptr;
__device__ __forceinline__ bf16x8 make_qaug(float mhat,int hi){
  const float nm=-mhat; const unsigned h=cvtpk_s(nm,0.f)&0xffffu; const float r1=nm-__uint_as_float(h<<16);
  const unsigned m=cvtpk_s(r1,0.f)&0xffffu; const float r2=r1-__uint_as_float(m<<16); const unsigned l=cvtpk_s(r2,0.f)&0xffffu;
  u32x4 w; w.x=hi?0u:0x3F803F80u; w.y=hi?0u:(0x3F80u|(h<<16)); w.z=hi?0u:(m|(l<<16)); w.w=0u; return __builtin_bit_cast(bf16x8,w);
}
template<int THRL> __device__ __forceinline__ void attn_unit(int b,int h,int qb,const bf16*Q,const bf16*__restrict__ K,const bf16*__restrict__ V,bf16*O,char*shm,lds_tabptr tab){
  int tid_=threadIdx.x; asm volatile("":"+v"(tid_));
  const int tid=tid_,lane=tid&63,r32=lane&31,hi=lane>>5; const int wid=__builtin_amdgcn_readfirstlane(tid>>6);
  const long rowbase=(long)b*SEQ; const int q0=qb*QB;
  const bf16*Qw=Q+(rowbase+q0+wid*QBLK)*DM+h*D;
  const bf16*Kh=K+rowbase*DM+h*D,*Vh=V+rowbase*DM+h*D;
  const unsigned lds0=(unsigned)(uintptr_t)shm;
  float*wsf=(float*)(shm+LDS_WS)+wid*64;
  const bf16*ksrc=Kh+(long)lane*DM+wid*8;
  const bf16*vsrc=Vh+(long)(16*(wid&3)+(lane>>2))*DM+(wid>>2)*32+(lane&3)*8;
  const unsigned kdst=lds0+LDS_K+wid*1024, vdst=lds0+LDS_V+wid*1024;
  #define DMA_K(t,slot) glds16(ksrc+(long)(t)*KVBLK*DM,(unsigned)__builtin_amdgcn_readfirstlane(kdst+(slot)))
  #define DMA_V(t,slot) glds16(vsrc+(long)(t)*KVBLK*DM,(unsigned)__builtin_amdgcn_readfirstlane(vdst+(slot)))
  const int vb0=(int)(lds0+LDS_V)+((lane>>4)&1)*32+(lane&3)*8+(4*hi+((lane&15)>>2))*64;
  const char*Kbase=shm+LDS_K; bf16x8 kf[8];
  const lds_cptr shm3=(lds_cptr)shm; const lds_cptr kp0=shm3+LDS_K+hi*1024+r32*16; const lds_cptr vp0=shm3+LDS_V+((lane>>4)&1)*32+(lane&3)*8+(4*hi+((lane&15)>>2))*64;
  const int NT=(q0+QB)/KVBLK;
  DMA_K(0,0);DMA_V(0,0);DMA_K(1,SLOTB);
  bf16x8 qr[4];
  #pragma unroll
  for(int d0=0;d0<4;++d0)qr[d0]=*reinterpret_cast<const bf16x8*>(&Qw[(long)r32*DM+d0*16+hi*8]);
  float mhat=0.f,l_reg=0.f;f32x16 o[2];o[0]=f32x16{};o[1]=f32x16{};bf16x8 qaug=make_qaug(0.f,hi);asm volatile("":"+v"(qaug));
  const int qrel=wid*QBLK+r32;
  #define CMASK(P0,P1,t) do{int jb_=(t)-(NT-4); if(jb_>=0)cmask(P0,P1,jb_,qrel,hi);}while(0)
  bool resc=false;
  #define START(P0,P1) do{ const float rm=rowmax(P0,P1); resc=false; \
    { const float dl=rm; mhat=fadd_s(mhat,dl); \
      _Pragma("unroll") for(int r=0;r<16;++r){P0[r]=fsub_s(P0[r],dl);P1[r]=fsub_s(P1[r],dl);} \
      qaug=make_qaug(mhat,hi); asm volatile("":"+v"(qaug)); } \
    _Pragma("unroll") for(int r=0;r<16;++r)P0[r]=__builtin_amdgcn_exp2f(P0[r]); }while(0)
  #define RESC() do{ if(resc){ asm volatile("s_waitcnt lgkmcnt(0)":::"memory"); \
      _Pragma("unroll") for(int d_=0;d_<2;++d_) _Pragma("unroll") for(int r=0;r<16;++r)o[d_][r]*=wsf[crow(r,hi)]; } }while(0)
  f32x16 pA0,pA1,pB0,pB1;
  int sl_prev=0,sl_cur=0,sl_next=SLOTB;
  #define ROT() do{sl_prev=sl_cur;sl_cur=sl_next;sl_next=(sl_next==(NSLOT-1)*SLOTB)?0:sl_next+SLOTB;}while(0)
  DMA_K(2,2*SLOTB);
  WAIT_BAR(3);
  qkt(pA0,pA1,Kbase,qr,__builtin_bit_cast(bf16x8,tab[r32]),__builtin_bit_cast(bf16x8,tab[32+r32]),qaug,r32,hi);asm volatile("s_nop 15\n\ts_nop 7":"+v"(pA0),"+v"(pA1));CMASK(pA0,pA1,0);
  START(pA0,pA1);
  _Pragma("unroll") for(int r=0;r<16;++r)pA1[r]=__builtin_amdgcn_exp2f(pA1[r]);
  WAIT_BAR(0);
  DMA_K(3,0);DMA_V(1,SLOTB);
  ROT();
  kload8(kf,kp0+sl_cur);
  WAIT_BAR(2);
  s16x4 vlo[8],vhi[8]; u32x4 pw0,pw1,pw2,pw3;
  #define PKW(P,B) cvtpk_s(P[B],P[B+1])
  #define PAF(k) __builtin_bit_cast(bf16x8,pw##k)
  #define VFR(i) (bf16x8){vlo[i][0],vlo[i][1],vlo[i][2],vlo[i][3],vhi[i][0],vhi[i][1],vhi[i][2],vhi[i][3]}
  #define PIN(x) asm volatile("":"+v"(x))
  #define MX3(a,b,c) __builtin_fmaxf(__builtin_fmaxf((a),(b)),(c))
  #define GAPA(MF,A0,A1,A2,A3,W0,W1,PW) do{ MF; sacc+=A0; sacc+=A1; sacc+=A2; sacc+=A3; PIN(sacc); W0; W1; PIN(PW); SBAR(); }while(0)
  #define EX(v) __builtin_amdgcn_exp2f(v)
  #define GAPB(MF,X,B) do{ MF; X[B]=EX(X[B]); X[B+1]=EX(X[B+1]); X[B+2]=EX(X[B+2]); X[B+3]=EX(X[B+3]); PIN(X); SBAR(); }while(0)
  #define VRD(i) do{ vlo[i]=vtr(vp_+(((i)>>2)*4096+((i)&3)*1024)); vhi[i]=vtr(vp_+(((i)>>2)*4096+((i)&3)*1024+512)); }while(0)
  #define KRD(G,j) do{ if(G){ kload2(kf,kp0+sl_next,j); SBAR(); } }while(0)
  #define STEP(C0,C1,P0,P1,t,GK,GV,GL) do{ SBAR(); \
    const lds_cptr vp_=vp0+sl_prev; \
    const bf16x8 ka0_=__builtin_bit_cast(bf16x8,tab[64*(t)+r32]), ka1_=__builtin_bit_cast(bf16x8,tab[64*(t)+32+r32]); \
    VRD(0); SBAR(); float sacc=(P0[0]+P0[1]); \
    GAPA(C0=__builtin_amdgcn_mfma_f32_32x32x16_bf16(kf[0],qr[0],f32x16{},0,0,0), P0[2],P0[3],P0[4],P0[5],     pw0[0]=PKW(P0,0), pw0[1]=PKW(P0,2), pw0); \
    VRD(4); SBAR(); GAPA(C1=__builtin_amdgcn_mfma_f32_32x32x16_bf16(kf[1],qr[0],f32x16{},0,0,0), P0[6],P0[7],P0[8],P0[9],     pw0[2]=PKW(P0,4), pw0[3]=PKW(P0,6), pw0); \
    VRD(1); SBAR(); GAPA(C0=__builtin_amdgcn_mfma_f32_32x32x16_bf16(kf[2],qr[1],C0,0,0,0),   P0[10],P0[11],P0[12],P0[13], pw1[0]=PKW(P0,8), pw1[1]=PKW(P0,10), pw1); \
    VRD(5); SBAR(); GAPA(C1=__builtin_amdgcn_mfma_f32_32x32x16_bf16(kf[3],qr[1],C1,0,0,0),   P0[14],P0[15],P1[0],P1[1],   pw1[2]=PKW(P0,12),pw1[3]=PKW(P0,14), pw1); \
    VRD(2); SBAR(); GAPA(C0=__builtin_amdgcn_mfma_f32_32x32x16_bf16(kf[4],qr[2],C0,0,0,0),   P1[2],P1[3],P1[4],P1[5],     pw2[0]=PKW(P1,0), pw2[1]=PKW(P1,2), pw2); \
    VRD(6); SBAR(); GAPA(C1=__builtin_amdgcn_mfma_f32_32x32x16_bf16(kf[5],qr[2],C1,0,0,0),   P1[6],P1[7],P1[8],P1[9],     pw2[2]=PKW(P1,4), pw2[3]=PKW(P1,6), pw2); \
    VRD(3); SBAR(); GAPA(C0=__builtin_amdgcn_mfma_f32_32x32x16_bf16(kf[6],qr[3],C0,0,0,0),   P1[10],P1[11],P1[12],P1[13], pw3[0]=PKW(P1,8), pw3[1]=PKW(P1,10), pw3); \
    VRD(7); SBAR(); GAPA(C1=__builtin_amdgcn_mfma_f32_32x32x16_bf16(kf[7],qr[3],C1,0,0,0),   P1[14],P1[15],0.f,0.f,       pw3[2]=PKW(P1,12),pw3[3]=PKW(P1,14), pw3); \
    C0=__builtin_amdgcn_mfma_f32_32x32x16_bf16(ka0_,qaug,C0,0,0,0); C1=__builtin_amdgcn_mfma_f32_32x32x16_bf16(ka1_,qaug,C1,0,0,0); SBAR(); \
    l_reg+=sacc; \
    if(GK){DMA_K((t)+3,sl_cur);} if(GV){DMA_V((t)+1,sl_next);} \
    CMASK(C0,C1,t); \
    { float a=MX3(C0[0],C0[1],C1[0]),b=MX3(C0[2],C0[3],C1[1]); a=MX3(a,C1[2],C1[3]); \
      _Pragma("unroll") for(int r=4;r<16;r+=4){a=MX3(a,C0[r],C0[r+1]);b=MX3(b,C0[r+2],C0[r+3]);a=MX3(a,C1[r],C1[r+1]);b=MX3(b,C1[r+2],C1[r+3]);} \
      float rm=__builtin_fmaxf(a,b); { auto rr=__builtin_amdgcn_permlane32_swap(__float_as_uint(rm),__float_as_uint(rm),false,false); rm=__builtin_fmaxf(__uint_as_float(rr[0]),__uint_as_float(rr[1])); } \
      resc=false; \
      if(__builtin_expect(__any(rm>(float)THRL),0)){ const float dl=__builtin_fmaxf(rm,0.f); mhat+=dl; \
        _Pragma("unroll") for(int r=0;r<16;++r){C0[r]-=dl;C1[r]-=dl;} \
        qaug=make_qaug(mhat,hi); asm volatile("":"+v"(qaug)); \
        const float f=__builtin_amdgcn_exp2f(-dl); l_reg*=f; if(hi==0)wsf[r32]=f; resc=true; } } \
    SBAR(); \
    GAPB(o[0]=__builtin_amdgcn_mfma_f32_32x32x16_bf16(PAF(0),VFR(0),o[0],0,0,0), C0,0); \
    GAPB(o[1]=__builtin_amdgcn_mfma_f32_32x32x16_bf16(PAF(0),VFR(4),o[1],0,0,0), C0,4); \
    KRD(GL,0); GAPB(o[0]=__builtin_amdgcn_mfma_f32_32x32x16_bf16(PAF(1),VFR(1),o[0],0,0,0), C0,8); \
    KRD(GL,1); GAPB(o[1]=__builtin_amdgcn_mfma_f32_32x32x16_bf16(PAF(1),VFR(5),o[1],0,0,0), C0,12); \
    KRD(GL,2); GAPB(o[0]=__builtin_amdgcn_mfma_f32_32x32x16_bf16(PAF(2),VFR(2),o[0],0,0,0), C1,0); \
    KRD(GL,3); GAPB(o[1]=__builtin_amdgcn_mfma_f32_32x32x16_bf16(PAF(2),VFR(6),o[1],0,0,0), C1,4); \
    GAPB(o[0]=__builtin_amdgcn_mfma_f32_32x32x16_bf16(PAF(3),VFR(3),o[0],0,0,0), C1,8); \
    GAPB(o[1]=__builtin_amdgcn_mfma_f32_32x32x16_bf16(PAF(3),VFR(7),o[1],0,0,0), C1,12); \
    }while(0)
  int t=1;
  #undef CMASK
  #define CMASK(P0,P1,t) do{}while(0)
  for(;t+5<NT;t+=2){
    STEP(pB0,pB1,pA0,pA1,t,true,true,true);     WAIT_BAR(2); RESC(); ROT();
    STEP(pA0,pA1,pB0,pB1,t+1,true,true,true);   WAIT_BAR(2); RESC(); ROT();
  }
  #undef CMASK
  #define CMASK(P0,P1,t) do{int jb_=(t)-(NT-4); if(jb_>=0)cmask(P0,P1,jb_,qrel,hi);}while(0)
  #define ENDW(tt) do{ if((tt)+3<NT){WAIT_BAR(2);} else if((tt)+2<NT){WAIT_BAR(1);} else {WAIT_BAR(0);} }while(0)
  for(;t+1<NT;t+=2){
    STEP(pB0,pB1,pA0,pA1,t,(t+3<NT),(t+1<NT),(t+1<NT));       ENDW(t);   RESC(); ROT();
    STEP(pA0,pA1,pB0,pB1,t+1,(t+4<NT),(t+2<NT),(t+2<NT));     ENDW(t+1); RESC(); ROT();
  }
  STEP(pB0,pB1,pA0,pA1,NT-1,false,false,false); RESC();
  { float sacc=pB0[0]+pB0[1]; _Pragma("unroll") for(int r=2;r<16;++r)sacc+=pB0[r]; _Pragma("unroll") for(int r=0;r<16;++r)sacc+=pB1[r]; l_reg+=sacc;
    pw0=(u32x4){PKW(pB0,0),PKW(pB0,2),PKW(pB0,4),PKW(pB0,6)};pw1=(u32x4){PKW(pB0,8),PKW(pB0,10),PKW(pB0,12),PKW(pB0,14)};pw2=(u32x4){PKW(pB1,0),PKW(pB1,2),PKW(pB1,4),PKW(pB1,6)};pw3=(u32x4){PKW(pB1,8),PKW(pB1,10),PKW(pB1,12),PKW(pB1,14)};
    SBAR(); pv(o,vb0+sl_cur,PAF(0),PAF(1),PAF(2),PAF(3)); }
  #undef PKW
  #undef PAF
  #undef VFR
  #undef PIN
  #undef MX3
  #undef GAPA
  #undef GAPB
  #undef EX
  #undef VRD
  #undef KRD
  #undef STEP
  #undef ENDW
  {auto rr=__builtin_amdgcn_permlane32_swap(__float_as_uint(l_reg),__float_as_uint(l_reg),false,false);l_reg=__uint_as_float(rr[0])+__uint_as_float(rr[1]);}
  if(hi==0)wsf[32+r32]=l_reg;asm volatile("s_waitcnt lgkmcnt(0)":::"memory");
  float rli[16];
  #pragma unroll
  for(int r=0;r<16;++r)rli[r]=__builtin_amdgcn_rcpf(wsf[32+crow(r,hi)]);
  bf16*Ow=O+(rowbase+q0+wid*QBLK)*PO+OCOL+h*D;
  { bf16*stg=(bf16*)(shm+LDS_OST)+wid*2048;
    #pragma unroll
    for(int r=0;r<16;++r){const int orow=crow(r,hi);
      #pragma unroll
      for(int d0=0;d0<2;++d0)stg[orow*64+d0*32+r32]=__float2bfloat16(o[d0][r]*rli[r]);}
    asm volatile("s_waitcnt lgkmcnt(0)":::"memory");
    #pragma unroll
    for(int i=0;i<4;++i){const int row=i*8+(lane>>3),ch=lane&7; const u32x4 v=*(const u32x4*)(stg+row*64+ch*8); ATTN_STORE16(Ow+(long)row*PO+ch*8,v);} }
  asm volatile("s_waitcnt lgkmcnt(0)\n\ts_barrier":::"memory");
  #undef DMA_K
  #undef DMA_V
  #undef CMASK
  #undef START
  #undef RESC
  #undef ROT
}
constexpr int ATTN_LDS_BYTES=LDS_BYTES;
#undef SBAR
#undef WAIT_BAR
}
constexpr int NWAVES = 8;
constexpr int D = 1024, BATCH = 8, SEQ = 2048, M = BATCH * SEQ;
constexpr int N_INSRC = 7176, N_INV = 7168;
constexpr int FL_COL = 3072;
constexpr int DFF_D = 2816, DFF_E = 3584, NEXP = 8;
constexpr float LN_EPS = 1e-5f, GN_EPS = 1e-6f;
constexpr float ALPHA = 1.4142135623730951f;
constexpr float LOG2E = 1.4426950408889634f;
constexpr float C2 = 0.125f * LOG2E;

constexpr size_t MiB = 1u << 20;
constexpr size_t WS_CTL = 0, CTL_ZERO_BYTES = 192 * 1024;
constexpr size_t WS_CS = 1 * MiB;
constexpr size_t WS_LIST = 2 * MiB;
constexpr size_t WS_GATEW = 2 * MiB + 512 * 1024;
constexpr size_t WS_LOGF = 3 * MiB;
constexpr size_t WS_GST = 3 * MiB + 512 * 1024;
constexpr size_t WS_WIN = 4 * MiB;
constexpr size_t WS_WBR = 32 * MiB;
constexpr size_t WS_WOUT = 38 * MiB;
constexpr size_t WS_WDU = 42 * MiB;
constexpr size_t WS_WDD = 53 * MiB;
constexpr size_t WS_WMU = 59 * MiB;
constexpr size_t WS_WMD = 171 * MiB;
constexpr size_t WS_XB = 227 * MiB;
constexpr size_t WS_XF = 259 * MiB;
constexpr size_t WS_YPRE = 323 * MiB;
constexpr size_t WS_C1 = 387 * MiB;
constexpr size_t WS_MRG = 451 * MiB;
constexpr size_t WS_RQ = 483 * MiB, WS_RK = 491 * MiB, WS_RV = 499 * MiB, WS_RG = 515 * MiB, WS_FQ = 531 * MiB, WS_FK = 547 * MiB, WS_FV = 563 * MiB,
                 WS_GU = 579 * MiB, WS_GV = 595 * MiB, WS_GT = 611 * MiB, WS_YB = 707 * MiB, WS_KV = 755 * MiB  , WS_X8IN = 771 * MiB  , WS_WIN8 = 787 * MiB  , WS_END = 793 * MiB;
constexpr size_t WS_HID = 483 * MiB;
static_assert((size_t)34816 * DFF_E <= WS_KV - WS_HID, "MoE hidden fits its overlay");
constexpr int CW_TMO = 0, CW_CODE = 1;
constexpr int CW_CNT = 64;
constexpr int CW_BAR = 4096;

constexpr int RING_OFF = 0, RING_BYTES = 141312;
constexpr int LDSCTL_OFF = RING_BYTES, MISC_OFF = LDSCTL_OFF + 320, PTAB_OFF = LDSCTL_OFF + 1024;
constexpr int LDS_BYTES = 147456;
static_assert(MISC_OFF + 128 <= PTAB_OFF && PTAB_OFF + 20 * 8 <= LDS_BYTES, "LDS map");

#define GAS __attribute__((address_space(1)))
#define LAS __attribute__((address_space(3)))
typedef unsigned short bf16;
typedef unsigned v4u __attribute__((ext_vector_type(4)));
typedef unsigned v2u __attribute__((ext_vector_type(2)));
typedef float f32x4 __attribute__((ext_vector_type(4)));
typedef GAS unsigned gu32;
#define RLX_AGENT __ATOMIC_RELAXED, __HIP_MEMORY_SCOPE_AGENT
#define LDS_WAIT() asm volatile("s_waitcnt lgkmcnt(0)" ::: "memory")
#define VM_WAIT() asm volatile("s_waitcnt vmcnt(0)" ::: "memory")
__device__ __forceinline__ unsigned f2bf(float f) { unsigned u = __builtin_bit_cast(unsigned, f); return (u + 0x7fffu + ((u >> 16) & 1u)) >> 16; }
__device__ __forceinline__ unsigned pk2(float lo, float hi) { return f2bf(lo) | (f2bf(hi) << 16); }
__device__ __forceinline__ float bf2f(unsigned short h) { return __builtin_bit_cast(float, (unsigned)h << 16); }
__device__ __forceinline__ float bflo(unsigned w) { return __builtin_bit_cast(float, w << 16); }
__device__ __forceinline__ float bfhi(unsigned w) { return __builtin_bit_cast(float, w & 0xffff0000u); }
constexpr float SC_X8 = 16.f, SC_WU8 = 32.f, SC_H8 = 8.f, SC_WD8 = 128.f;
constexpr float SWI_A = 1.4426950408889634f, SWI_B = SC_H8 / 1.4426950408889634f;
constexpr unsigned E8_UP = 0x76767676u  , E8_DN = 0x75757575u  ;
__device__ __forceinline__ float clamp448(float x) { return fminf(fmaxf(x, -448.f), 448.f); }
__device__ __forceinline__ unsigned pk4_fp8(float a, float b, float c, float d) {
    int w = __builtin_amdgcn_cvt_pk_fp8_f32(clamp448(a), clamp448(b), 0, false); w = __builtin_amdgcn_cvt_pk_fp8_f32(clamp448(c), clamp448(d), w, true); return (unsigned)w; }
constexpr float SC_XI8 = 127.f / 4.5f, SC_WI8 = 127.f * 32.f / 4.f;
__device__ __forceinline__ unsigned pk4_i8(float a, float b, float c, float d) {
    unsigned w = 0u;
    w = __builtin_amdgcn_cvt_pk_u8_f32(__builtin_rintf(a) + 128.f, 0u, w); w = __builtin_amdgcn_cvt_pk_u8_f32(__builtin_rintf(b) + 128.f, 1u, w);
    w = __builtin_amdgcn_cvt_pk_u8_f32(__builtin_rintf(c) + 128.f, 2u, w); w = __builtin_amdgcn_cvt_pk_u8_f32(__builtin_rintf(d) + 128.f, 3u, w);
    return w ^ 0x80808080u; }
__device__ __forceinline__ float fsigmoid(float x) { return __builtin_amdgcn_rcpf(1.0f + __builtin_amdgcn_exp2f(-x * LOG2E)); }
__device__ __forceinline__ float fsilu(float x) { return x * fsigmoid(x); }
typedef float f2v __attribute__((ext_vector_type(2)));
__device__ __forceinline__ f2v fsigmoid2(f2v x) { const f2v t = x * (-LOG2E); f2v e; e.x = __builtin_amdgcn_exp2f(t.x); e.y = __builtin_amdgcn_exp2f(t.y); const f2v d = e + 1.0f; f2v r; r.x = __builtin_amdgcn_rcpf(d.x); r.y = __builtin_amdgcn_rcpf(d.y); return r; }
__device__ __forceinline__ f2v fsilu2(f2v x) { return x * fsigmoid2(x); }
__device__ __forceinline__ f2v swi_folded2(f2v a, f2v b) { f2v e; e.x = __builtin_amdgcn_exp2f(-a.x); e.y = __builtin_amdgcn_exp2f(-a.y); const f2v d = e + 1.0f; f2v r; r.x = __builtin_amdgcn_rcpf(d.x); r.y = __builtin_amdgcn_rcpf(d.y); return (a * b) * r; }
__device__ __forceinline__ f2v fgelu_tanh2(f2v x) {
    const f2v t = x * (x * x * (-0.0713548163f * LOG2E) + (-1.5957691216f * LOG2E)); f2v e; e.x = __builtin_amdgcn_exp2f(t.x); e.y = __builtin_amdgcn_exp2f(t.y);
    const f2v d = e + 1.0f; f2v r; r.x = __builtin_amdgcn_rcpf(d.x); r.y = __builtin_amdgcn_rcpf(d.y); return x * r; }
__device__ __forceinline__ float fgelu_tanh(float x) { const float u = 0.7978845608028654f * (x + 0.044715f * x * x * x); return x * fsigmoid(2.0f * u); }

#define XB_TMO      128
#define XB_XCNT(j)  (256  + 64 * (j))
#define XB_XSUB(j)  (1280 + 64 * (j))
#define XB_XGEN(j)  (2304 + 64 * (j))
#define XB_TOP      3328
#define XB_TOPGEN   3392
#define XCD_BAR_WORDS 3456
#define XB_SPIN_CAP (1u << 18)
__device__ __forceinline__ unsigned xb_ld(unsigned* p)              { return __hip_atomic_load(p, __ATOMIC_RELAXED, __HIP_MEMORY_SCOPE_AGENT); }
__device__ __forceinline__ unsigned xb_add(unsigned* p, unsigned v) { return __hip_atomic_fetch_add(p, v, __ATOMIC_RELAXED, __HIP_MEMORY_SCOPE_AGENT); }
__device__ __forceinline__ unsigned xb_xcc_id() { return (unsigned)__builtin_amdgcn_s_getreg((3 << 11) | 20) & 0xFu; }
#define XB_SPIN(cond, bar) do { unsigned _sp = 0; while (cond) { __builtin_amdgcn_s_sleep(1); \
    if ((++_sp & 255u) == 0u) { if (xb_ld(&(bar)[XB_TMO])) break; if (_sp > XB_SPIN_CAP) { atomicAdd(&(bar)[XB_TMO], 1u); break; } } } } while (0)
struct XcdBarrier { unsigned* bar; unsigned x; volatile LAS unsigned* st; unsigned total; unsigned lite; };
__device__ __forceinline__ XcdBarrier xcd_barrier_post(unsigned* bar, volatile LAS unsigned* st, unsigned total, unsigned lite) {
    XcdBarrier b; b.bar = bar; b.x = xb_xcc_id(); b.st = st; b.total = total; b.lite = lite;
    if (threadIdx.x == 0) (void)xb_add(&bar[XB_XCNT(b.x)], 1u);
    return b;
}
__device__ __forceinline__ void xcd_barrier_complete(unsigned* bar, unsigned x, unsigned G, unsigned& nloc, unsigned& nx) {
    unsigned sum, cnt, mine, sp = 0u;
    for (;;) {
        sum = 0u; cnt = 0u; mine = 0u;
#pragma unroll
        for (unsigned j = 0; j < 16; ++j) { const unsigned c = xb_ld(&bar[XB_XCNT(j)]); sum += c; cnt += (c > 0u) ? 1u : 0u; mine = (j == x) ? c : mine; }
        if (sum == G) break;
        __builtin_amdgcn_s_sleep(1);
        if ((++sp & 255u) == 0u) { if (xb_ld(&bar[XB_TMO])) break; if (sp > XB_SPIN_CAP) { atomicAdd(&bar[XB_TMO], 1u); break; } }
    }
    nloc = mine > 0u ? mine : 1u; nx = cnt > 0u ? cnt : 1u;
}
__device__ __forceinline__ void xcd_barrier(const XcdBarrier& b) {
    asm volatile("s_waitcnt vmcnt(0)" ::: "memory");
    __syncthreads();
    if (threadIdx.x == 0) {
        unsigned* bar = b.bar;
        __builtin_amdgcn_s_waitcnt(0);
        unsigned nloc = b.st[0], nx = b.st[1];
        if (nloc == 0u) { xcd_barrier_complete(bar, b.x, b.total, nloc, nx); b.st[0] = nloc; b.st[1] = nx; }
        const unsigned old = xb_add(&bar[XB_XSUB(b.x)], 1u);
        const unsigned gen = old / nloc;
        if (old + 1u == (gen + 1u) * nloc) {
            if (!(b.lite != 0u && nx == 1u)) {
                __builtin_amdgcn_fence(__ATOMIC_RELEASE, "agent");
                asm volatile("s_waitcnt vmcnt(0)" ::: "memory");
            }
            if (nx != 1u) {
                const unsigned og = xb_add(&bar[XB_TOP], 1u);
                const unsigned tg = og / nx;
                if (og + 1u == (tg + 1u) * nx) xb_add(&bar[XB_TOPGEN], 1u);
                else XB_SPIN(xb_ld(&bar[XB_TOPGEN]) == tg, bar);
            }
            __builtin_amdgcn_fence(__ATOMIC_ACQUIRE, "agent");
            xb_add(&bar[XB_XGEN(b.x)], 1u);
            asm volatile("s_waitcnt vmcnt(0)" ::: "memory");
        } else {
            XB_SPIN(xb_ld(&bar[XB_XGEN(b.x)]) == gen, bar);
            __builtin_amdgcn_fence(__ATOMIC_ACQUIRE, "agent");
            asm volatile("s_waitcnt vmcnt(0)" ::: "memory");
        }
    }
    __syncthreads();
}

using pg8::Unit; using pg8::bf16_t;
#define ACC_T const pg8::f32x4 (&acc)[2][2][4][2]

struct ProjSched : pg8::PlainSched {
    __device__ __forceinline__ bool next(int i, Unit& u) const { if (!pg8::PlainSched::next(i, u)) return false; if (nN == 16 && ((u.pm >> 2) & 1)) u.pn = (u.pn + 4) & 15; return true; }
};
typedef int i32x4_t __attribute__((ext_vector_type(4)));
template <bool I8IN> __device__ __forceinline__ pg8::f32x4 ldacc(const pg8::f32x4& r) {
    if constexpr (I8IN) return __builtin_convertvector(__builtin_bit_cast(i32x4_t, r), pg8::f32x4) * (1.0f / (SC_XI8 * SC_WI8)); else return r; }
template <bool I8IN>
struct EpiProjT {
    static constexpr bool PERM = true, HOOK = false, DUPME = true;
    unsigned char* ws; const float* gate_b; const float* cs;
    __device__ __forceinline__ void operator()(ACC_T, const Unit& u, int wr, int wc, int fr, int fq) const {
        const int pn = u.pn, row0 = u.pm * 256 + wr * 64 + fr, lc = wc * 32 + 8 * fq;
        if (pn < 2) {
            bf16_t* dst = (bf16_t*)(ws + (pn == 0 ? WS_RQ : WS_RK)); const float sc = pn == 0 ? 1.0f : 0.125f;
            const int d1 = 16 * (wc & 1) + 4 * fq;
#pragma unroll
            for (int ai = 0; ai < 2; ++ai)
#pragma unroll
                for (int m = 0; m < 4; ++m) { const int row = row0 + ai * 128 + m * 16, pos = row & (SEQ - 1);
                    const f32x4 c4 = *(const f32x4*)(cs + pos * 32 + d1), s4 = *(const f32x4*)(cs + 65536 + pos * 32 + d1);
#pragma unroll
                    for (int bj = 0; bj < 2; ++bj) { const int head = bj * 2 + (wc >> 1); const f32x4 x1 = ldacc<I8IN>(acc[ai][bj][m][0]), x2 = ldacc<I8IN>(acc[ai][bj][m][1]);
                        const f32x4 o1 = (x1 * c4 - x2 * s4) * sc, o2 = (x1 * s4 + x2 * c4) * sc;
                        bf16_t* p = dst + (size_t)row * 256 + head * 64 + d1;
                        v2u w1, w2; w1.x = pg8::cvt_pk_bf16(o1[0], o1[1]); w1.y = pg8::cvt_pk_bf16(o1[2], o1[3]); w2.x = pg8::cvt_pk_bf16(o2[0], o2[1]); w2.y = pg8::cvt_pk_bf16(o2[2], o2[3]);
                        *(v2u*)p = w1; *(v2u*)(p + 32) = w2; } }
            return;
        }
        if (pn < 4) store_act<0>(acc, WS_RV, 512, (pn - 2) * 256, row0, lc);
        else if (pn < 6) store_act<1>(acc, WS_RG, 512, (pn - 4) * 256, row0, lc);
        else if (pn < 8) store_act<2>(acc, WS_FQ, 512, (pn - 6) * 256, row0, lc);
        else if (pn < 10) store_act<0>(acc, WS_FK, 512, (pn - 8) * 256, row0, lc);
        else if (pn < 12) store_act<0>(acc, WS_FV, 512, (pn - 10) * 256, row0, lc);
        else if (pn < 14) store_act<3>(acc, WS_GU, 512, (pn - 12) * 256, row0, lc);
        else if (GATES_FP8 == 2 || P1_I8 || pn < 16) store_act<3>(acc, WS_GV, 512, (pn - 14) * 256, row0, lc);
#if GATES_FP8 != 2 && !P1_I8
        else store_act<4>(acc, WS_GT, 3072, (pn - 16) * 256, row0, lc);
#endif
    }
    template <int ACT>
    __device__ __forceinline__ void store_act(ACC_T, size_t off, int pitch, int coff, int row0, int lc) const {
        bf16_t* dst = (bf16_t*)(ws + off);
        f32x4 bv[2][2];
#pragma unroll
        for (int bj = 0; bj < 2; ++bj)
#pragma unroll
            for (int n = 0; n < 2; ++n) bv[bj][n] = (ACT == 4) ? *(const f32x4*)(gate_b + coff + bj * 128 + lc + 4 * n) : (f32x4){0.f, 0.f, 0.f, 0.f};
#pragma unroll
        for (int ai = 0; ai < 2; ++ai)
#pragma unroll
            for (int m = 0; m < 4; ++m) { bf16_t* rowp = dst + (size_t)(row0 + ai * 128 + m * 16) * pitch + coff + lc;
#pragma unroll
                for (int bj = 0; bj < 2; ++bj) { f2v v[4];
#pragma unroll
                    for (int n = 0; n < 2; ++n) { const f32x4 a = ldacc<I8IN>(acc[ai][bj][m][n]); v[2 * n] = __builtin_shufflevector(a, a, 0, 1); v[2 * n + 1] = __builtin_shufflevector(a, a, 2, 3);
                        if (ACT == 4) { v[2 * n] += __builtin_shufflevector(bv[bj][n], bv[bj][n], 0, 1); v[2 * n + 1] += __builtin_shufflevector(bv[bj][n], bv[bj][n], 2, 3); } }
#pragma unroll
                    for (int j = 0; j < 4; ++j) { f2v x = v[j];
                        if (ACT == 1) x = fsilu2(x); else if (ACT == 2) x = x * C2; else if (ACT == 3) x = fgelu_tanh2(x); else if (ACT == 4) x = fsigmoid2(x);
                        v[j] = x; }
                    v4u w; w.x = pg8::cvt_pk_bf16(v[0].x, v[0].y); w.y = pg8::cvt_pk_bf16(v[1].x, v[1].y); w.z = pg8::cvt_pk_bf16(v[2].x, v[2].y); w.w = pg8::cvt_pk_bf16(v[3].x, v[3].y);
                    *(v4u*)(rowp + bj * 128) = w; } }
    }
};

using EpiProj = EpiProjT<false>;
template <bool I8IN>
struct EpiGate8T {
    static constexpr bool PERM = true, HOOK = false, DUPME = false;
    bf16_t* GT; const float* gate_b;
    __device__ __forceinline__ void operator()(ACC_T, const Unit& u, int wr, int wc, int fr, int fq) const {
        const int row0 = u.pm * 256 + wr * 64 + fr, lc = wc * 32 + 8 * fq, coff = u.pn * 256;
        f32x4 bv[2][2];
#pragma unroll
        for (int bj = 0; bj < 2; ++bj)
#pragma unroll
            for (int n = 0; n < 2; ++n) bv[bj][n] = *(const f32x4*)(gate_b + coff + bj * 128 + lc + 4 * n);
#pragma unroll
        for (int ai = 0; ai < 2; ++ai)
#pragma unroll
            for (int m = 0; m < 4; ++m) { bf16_t* rowp = GT + (size_t)(row0 + ai * 128 + m * 16) * 3072 + coff + lc;
#pragma unroll
                for (int bj = 0; bj < 2; ++bj) { f2v v[4];
#pragma unroll
                    for (int n = 0; n < 2; ++n) { const f32x4 a = ldacc<I8IN>(acc[ai][bj][m][n]) + bv[bj][n]; v[2 * n] = fsigmoid2(__builtin_shufflevector(a, a, 0, 1)); v[2 * n + 1] = fsigmoid2(__builtin_shufflevector(a, a, 2, 3)); }
                    v4u w; w.x = pg8::cvt_pk_bf16(v[0].x, v[0].y); w.y = pg8::cvt_pk_bf16(v[1].x, v[1].y); w.z = pg8::cvt_pk_bf16(v[2].x, v[2].y); w.w = pg8::cvt_pk_bf16(v[3].x, v[3].y);
                    *(v4u*)(rowp + bj * 128) = w; } }
    }
};

using EpiGate8 = EpiGate8T<false>;
struct EpiMerge {
    static constexpr bool PERM = true, HOOK = true, DUPME = false;
    const bf16_t* GT; bf16_t* MRG;
    __device__ __forceinline__ void unpackg(const v4u w, float (&g)[8]) const {
        g[0] = bflo(w.x); g[1] = bfhi(w.x); g[2] = bflo(w.y); g[3] = bfhi(w.y); g[4] = bflo(w.z); g[5] = bfhi(w.z); g[6] = bflo(w.w); g[7] = bfhi(w.w);
#pragma unroll
        for (int j = 0; j < 8; ++j) g[j] = fmaxf(g[j], 1e-30f);
    }
    __device__ __forceinline__ void khook(pg8::f32x4 (&acc)[2][2][4][2], const Unit& u, int t, int wr, int wc, int fr, int fq) const {
        if (t != 8 && t != 16) return;
        const int np = (t == 8) ? 0 : 1; int row0 = u.pm * 256 + wr * 64 + fr; const int col0 = u.pn * 256 + wc * 32 + 8 * fq;
        asm volatile("" : "+v"(row0));
#pragma unroll
        for (int ai = 0; ai < 2; ++ai) {
            v4u wp[4][2], wn[4][2];
#pragma unroll
            for (int m = 0; m < 4; ++m)
#pragma unroll
                for (int bj = 0; bj < 2; ++bj) { const bf16_t* p = GT + (size_t)(row0 + ai * 128 + m * 16) * 3072 + np * 1024 + col0 + bj * 128; wp[m][bj] = *(const v4u*)p; wn[m][bj] = *(const v4u*)(p + 1024); }
#pragma unroll
            for (int m = 0; m < 4; ++m)
#pragma unroll
                for (int bj = 0; bj < 2; ++bj) { const unsigned pw[4] = {wp[m][bj].x, wp[m][bj].y, wp[m][bj].z, wp[m][bj].w}, nw[4] = {wn[m][bj].x, wn[m][bj].y, wn[m][bj].z, wn[m][bj].w};
#pragma unroll
                    for (int q = 0; q < 4; ++q) {
                        f2v gp2, gn2; gp2.x = bflo(pw[q]); gp2.y = bfhi(pw[q]); gn2.x = fmaxf(bflo(nw[q]), 1e-30f); gn2.y = fmaxf(bfhi(nw[q]), 1e-30f);
                        f2v r2; r2.x = __builtin_amdgcn_rcpf(gn2.x); r2.y = __builtin_amdgcn_rcpf(gn2.y); const f2v ratio = gp2 * r2;
                        pg8::f32x4& a4 = acc[ai][bj][m][q >> 1];
                        if (q & 1) { a4.z *= ratio.x; a4.w *= ratio.y; } else { a4.x *= ratio.x; a4.y *= ratio.y; } } }
            asm volatile("" ::: "memory");
        }
    }
    __device__ __forceinline__ void operator()(ACC_T, const Unit& u, int wr, int wc, int fr, int fq) const {
        const int row0 = u.pm * 256 + wr * 64 + fr, col0 = u.pn * 256 + wc * 32 + 8 * fq;
#pragma unroll
        for (int ai = 0; ai < 2; ++ai) {
            v4u wg[4][2];
#pragma unroll
            for (int m = 0; m < 4; ++m)
#pragma unroll
                for (int bj = 0; bj < 2; ++bj) wg[m][bj] = *(const v4u*)(GT + (size_t)(row0 + ai * 128 + m * 16) * 3072 + 2048 + col0 + bj * 128);
#pragma unroll
            for (int m = 0; m < 4; ++m)
#pragma unroll
                for (int bj = 0; bj < 2; ++bj) { const unsigned gw[4] = {wg[m][bj].x, wg[m][bj].y, wg[m][bj].z, wg[m][bj].w}; unsigned o[4];
#pragma unroll
                    for (int q = 0; q < 4; ++q) { f2v g2; g2.x = bflo(gw[q]); g2.y = bfhi(gw[q]); const pg8::f32x4 a4 = acc[ai][bj][m][q >> 1];
                        f2v a2; if (q & 1) { a2.x = a4.z; a2.y = a4.w; } else { a2.x = a4.x; a2.y = a4.y; } const f2v p = a2 * g2; o[q] = pg8::cvt_pk_bf16(p.x, p.y); }
                    v4u w; w.x = o[0]; w.y = o[1]; w.z = o[2]; w.w = o[3];
                    *(v4u*)(MRG + (size_t)(row0 + ai * 128 + m * 16) * 1024 + col0 + bj * 128) = w; }
            asm volatile("" ::: "memory");
        }
    }
};

struct EpiResid {
    static constexpr bool PERM = false, HOOK = false, DUPME = false;
    const float* res; float* out;
    __device__ __forceinline__ void operator()(ACC_T, const Unit& u, int wr, int wc, int fr, int fq) const {
        const int row0 = u.pm * 256 + wr * 64 + fr, col0 = u.pn * 256 + wc * 32 + 4 * fq;
#pragma unroll
        for (int ai = 0; ai < 2; ++ai)
#pragma unroll
            for (int m = 0; m < 4; ++m) { const size_t off = (size_t)(row0 + ai * 128 + m * 16) * 1024 + col0;
#pragma unroll
                for (int bj = 0; bj < 2; ++bj)
#pragma unroll
                    for (int n = 0; n < 2; ++n) { const f32x4 r = *(const f32x4*)(res + off + bj * 128 + n * 16); *(f32x4*)(out + off + bj * 128 + n * 16) = r * ALPHA + acc[ai][bj][m][n]; } }
    }
};

struct EpiSwiglu {
    static constexpr bool PERM = true, HOOK = false, DUPME = false;
    bf16_t* H; int ldh;
    __device__ __forceinline__ void operator()(ACC_T, const Unit& u, int wr, int wc, int fr, int fq) const {
        const int row0 = u.pm * 256 + wr * 64 + fr, col0 = u.pn * 128 + wc * 16 + 4 * fq;
#pragma unroll
        for (int ai = 0; ai < 2; ++ai)
#pragma unroll
            for (int m = 0; m < 4; ++m) { bf16_t* rowp = H + (size_t)(row0 + ai * 128 + m * 16) * ldh + col0;
#pragma unroll
                for (int bj = 0; bj < 2; ++bj) { const f32x4 a = acc[ai][bj][m][0], b = acc[ai][bj][m][1];
                    const f2v o01 = fsilu2(__builtin_shufflevector(a, a, 0, 1)) * __builtin_shufflevector(b, b, 0, 1), o23 = fsilu2(__builtin_shufflevector(a, a, 2, 3)) * __builtin_shufflevector(b, b, 2, 3);
                    v2u w; w.x = pg8::cvt_pk_bf16(o01.x, o01.y); w.y = pg8::cvt_pk_bf16(o23.x, o23.y);
                    *(v2u*)(rowp + bj * 64) = w; } }
    }
};

struct EpiSwigluI8 {
    static constexpr bool PERM = true, HOOK = false, DUPME = false;
    bf16_t* H; int ldh;
    __device__ __forceinline__ void operator()(ACC_T, const Unit& u, int wr, int wc, int fr, int fq) const {
        typedef int i32x4_t __attribute__((ext_vector_type(4)));
        constexpr float CA = LOG2E / (SC_XI8 * SC_WI8), CB = 1.0f / (SC_XI8 * SC_WI8 * LOG2E);
        const int row0 = u.pm * 256 + wr * 64 + fr, col0 = u.pn * 128 + wc * 16 + 4 * fq;
#pragma unroll
        for (int ai = 0; ai < 2; ++ai)
#pragma unroll
            for (int m = 0; m < 4; ++m) { bf16_t* rowp = H + (size_t)(row0 + ai * 128 + m * 16) * ldh + col0;
#pragma unroll
                for (int bj = 0; bj < 2; ++bj) {
                    const f32x4 a = __builtin_convertvector(__builtin_bit_cast(i32x4_t, acc[ai][bj][m][0]), f32x4) * CA, b = __builtin_convertvector(__builtin_bit_cast(i32x4_t, acc[ai][bj][m][1]), f32x4) * CB;
                    const f2v o01 = swi_folded2(__builtin_shufflevector(a, a, 0, 1), __builtin_shufflevector(b, b, 0, 1)), o23 = swi_folded2(__builtin_shufflevector(a, a, 2, 3), __builtin_shufflevector(b, b, 2, 3));
                    v2u w; w.x = pg8::cvt_pk_bf16(o01.x, o01.y); w.y = pg8::cvt_pk_bf16(o23.x, o23.y);
                    *(v2u*)(rowp + bj * 64) = w; } }
    }
};

struct MoeTiles {
    int cnt[NEXP]; int toff[NEXP + 1];
    __device__ __forceinline__ void init(const gu32* ctl) {
        int t = 0;
#pragma unroll
        for (int e = 0; e < NEXP; ++e) { cnt[e] = __builtin_amdgcn_readfirstlane((int)__hip_atomic_load(ctl + CW_CNT + 64 * e, RLX_AGENT)); toff[e] = t; t += (cnt[e] + 255) >> 8; }
        toff[NEXP] = t;
    }
    __device__ __forceinline__ void find(int pm, int& e, int& slot0, int& n) const {
        int ee = 0;
#pragma unroll
        for (int j = 1; j < NEXP; ++j) if (pm >= toff[j]) ee = j;
        int c = 0, t0 = 0;
#pragma unroll
        for (int j = 0; j < NEXP; ++j) if (j == ee) { c = cnt[j]; t0 = toff[j]; }
        e = ee; slot0 = (pm - t0) * 256; n = c;
    }
    __device__ __forceinline__ int nfull_total() const { int a = 0;
#pragma unroll
        for (int j = 0; j < NEXP; ++j) a += cnt[j] >> 8;
        return a; }
    __device__ __forceinline__ void findfull(int pmf, int& e, int& lt, int& htile) const {
        int a = 0, ee = 0, ll = 0, hh = 0;
#pragma unroll
        for (int j = 0; j < NEXP; ++j) { const int nf = cnt[j] >> 8; if (pmf >= a && pmf < a + nf) { ee = j; ll = pmf - a; hh = toff[j] + ll; } a += nf; }
        e = ee; lt = ll; htile = hh;
    }
    __device__ __forceinline__ void expert(int e, int& c, int& t0) const { int cc = 0, tt = 0;
#pragma unroll
        for (int j = 0; j < NEXP; ++j) if (j == e) { cc = cnt[j]; tt = toff[j]; }
        c = cc; t0 = tt; }
};
struct MoeUpSched : pg8::TileOrder {
    static constexpr bool GATHER = true;
    const unsigned char* A; const unsigned char* Bt; const unsigned* list; MoeTiles mt;
    __device__ __forceinline__ const char* abase(const Unit&) const { return (const char*)A; }
    __device__ __forceinline__ void aoffs_load(const Unit& u, const int (&R)[2], PG8_LAS unsigned* scr) const {
        int e, s0, n; mt.find(u.pm, e, s0, n);
#pragma unroll
        for (int h = 0; h < 2; ++h)
#pragma unroll
            for (int i = 0; i < 2; ++i) { int slot = s0 + R[i] + h * 128; slot = slot < 16383 ? slot : 16383;
                __builtin_amdgcn_global_load_lds(list + e * 16384 + slot, scr + (h * 2 + i) * 64, 4, 0, 0); }
    }
    __device__ __forceinline__ void aoffs_fin(const Unit& u, const int (&R)[2], const int (&C)[2], const PG8_LAS unsigned* scr, int lane, unsigned (&o)[2][2]) const {
        int e, s0, n; mt.find(u.pm, e, s0, n);
#pragma unroll
        for (int h = 0; h < 2; ++h)
#pragma unroll
            for (int i = 0; i < 2; ++i) { const int slot = s0 + R[i] + h * 128; const unsigned w = scr[(h * 2 + i) * 64 + lane]; const unsigned tok = slot < n ? (w & 0x7fffffffu) : 0u; o[h][i] = tok * 1024u + 2u * (unsigned)C[i]; }
    }
    __device__ __forceinline__ const char* bbase(const Unit& u) const { int e, s0, n; mt.find(u.pm, e, s0, n); return (const char*)Bt + ((size_t)e * (2 * DFF_E) + (size_t)u.pn * 256) * 1024; }
};
struct MoeDownSched : pg8::TileOrder {
    static constexpr bool GATHER = false;
    const unsigned char* A; const unsigned char* Bt; MoeTiles mt;
    __device__ __forceinline__ const char* abase(const Unit& u) const { int e, lt, ht; mt.findfull(u.pm, e, lt, ht); return (const char*)A + (size_t)ht * 256 * DFF_E; }
    __device__ __forceinline__ void aoffs_load(const Unit&, const int (&)[2], PG8_LAS unsigned*) const {}
    __device__ __forceinline__ void aoffs_fin(const Unit&, const int (&)[2], const int (&)[2], const PG8_LAS unsigned*, int, unsigned (&)[2][2]) const {}
    __device__ __forceinline__ const char* bbase(const Unit& u) const { int e, lt, ht; mt.findfull(u.pm, e, lt, ht); return (const char*)Bt + ((size_t)e * 1024 + (size_t)u.pn * 256) * DFF_E; }
};
struct EpiSwiglu8 {
    static constexpr bool PERM = true, HOOK = false, DUPME = false;
    unsigned char* H; int ldh;
    static __device__ __forceinline__ f2v swi8x2(f2v a, f2v b) {
        f2v e; e.x = __builtin_amdgcn_exp2f(-a.x); e.y = __builtin_amdgcn_exp2f(-a.y); const f2v d = e + 1.0f; f2v r; r.x = __builtin_amdgcn_rcpf(d.x); r.y = __builtin_amdgcn_rcpf(d.y); return (a * b) * r; }
    static __device__ __forceinline__ float swi8(float a, float b) { return (a * b) * __builtin_amdgcn_rcpf(1.0f + __builtin_amdgcn_exp2f(-a)); }
    __device__ __forceinline__ void operator()(ACC_T, const Unit& u, int wr, int wc, int fr, int fq) const {
        const int row0 = u.pm * 256 + wr * 64 + fr, col0 = u.pn * 128 + wc * 16;
#pragma unroll
        for (int ai = 0; ai < 2; ++ai)
#pragma unroll
            for (int bj = 0; bj < 2; ++bj) { unsigned x[4];
#pragma unroll
                for (int m = 0; m < 4; ++m) { const f32x4 a = acc[ai][bj][m][0], b = acc[ai][bj][m][1];
                    const f2v o01 = swi8x2(__builtin_shufflevector(a, a, 0, 1), __builtin_shufflevector(b, b, 0, 1)), o23 = swi8x2(__builtin_shufflevector(a, a, 2, 3), __builtin_shufflevector(b, b, 2, 3));
                    x[m] = pk4_fp8(o01.x, o01.y, o23.x, o23.y); }
                const auto p01 = __builtin_amdgcn_permlane16_swap(x[0], x[1], false, false), p23 = __builtin_amdgcn_permlane16_swap(x[2], x[3], false, false);
                const auto q02 = __builtin_amdgcn_permlane32_swap(p01[0], p23[0], false, false), q13 = __builtin_amdgcn_permlane32_swap(p01[1], p23[1], false, false);
                v4u w; w.x = q02[0]; w.y = q13[0]; w.z = q02[1]; w.w = q13[1];
                *(v4u*)(H + (size_t)(row0 + ai * 128 + fq * 16) * ldh + col0 + bj * 64) = w; }
    }
};
struct EpiMoeDown {
    static constexpr bool PERM = true, HOOK = false, DUPME = false;
    bf16_t* c0; bf16_t* c1; const unsigned* list; const float* gatew; MoeTiles mt;
    __device__ __forceinline__ void operator()(ACC_T, const Unit& u, int wr, int wc, int fr, int fq) const {
        int e, lt, ht; mt.findfull(u.pm, e, lt, ht); const int s0 = lt * 256;
        const int col0 = u.pn * 256 + wc * 32 + 8 * fq;
        unsigned ent[2][4]; float gg[2][4];
#pragma unroll
        for (int ai = 0; ai < 2; ++ai)
#pragma unroll
            for (int m = 0; m < 4; ++m) { const int slot = s0 + ai * 128 + wr * 64 + m * 16 + fr; ent[ai][m] = list[e * 16384 + slot]; gg[ai][m] = gatew[e * 16384 + slot]; }
#pragma unroll
        for (int ai = 0; ai < 2; ++ai)
#pragma unroll
            for (int m = 0; m < 4; ++m) { const float g = gg[ai][m];
                bf16_t* dst = ((ent[ai][m] >> 31) ? c1 : c0) + (size_t)(ent[ai][m] & 0x7fffffffu) * 1024 + col0;
#pragma unroll
                for (int bj = 0; bj < 2; ++bj) { const pg8::f32x4 a = acc[ai][bj][m][0] * g, b = acc[ai][bj][m][1] * g;
                    v4u w; w.x = pg8::cvt_pk_bf16(a[0], a[1]); w.y = pg8::cvt_pk_bf16(a[2], a[3]); w.z = pg8::cvt_pk_bf16(b[0], b[1]); w.w = pg8::cvt_pk_bf16(b[2], b[3]);
                    *(v4u*)(dst + bj * 128) = w; } }
    }
};

struct Frame {
    LAS unsigned char* lds;
    volatile LAS unsigned* MISC;
    gu32* ctl;
    int tid, lane, wave;
    int vcu, G;
    unsigned char* ws;
};
__device__ __forceinline__ float wave_sum(float v) {
#pragma unroll
    for (int o = 1; o < 64; o <<= 1) v += __shfl_xor(v, o);
    return v;
}

__device__ __forceinline__ int mapcol(int kind, int dff, int v) {
    if (kind == 0) return v;
    if (kind == 1) {
        if (v < 512) { const int w = v & 63; return (v & ~63) + 32 * ((w >> 2) & 1) + 4 * (w >> 3) + (w & 3); }
        return v < FL_COL ? v : v + 8;
    }
    const int tile = v >> 8, vl = v & 255, n = (vl >> 2) & 1, j = tile * 128 + (vl >> 3) * 4 + (vl & 3);
    return n ? dff + j : j;
}
__device__ __forceinline__ void cvt_item(const float* W, int Nsrc, bf16* dst, int dpitch, int koff, int kind, int dff, int k0, int v0, LAS float* scr, int lane, float f8scale, int vbase) {
    const int v4 = lane & 15, kq = lane >> 4;
    const float* src = W + (size_t)(k0 + kq) * Nsrc + mapcol(kind, dff, vbase + v0 + 4 * v4);
    f32x4 t[16];
#pragma unroll
    for (int it = 0; it < 16; ++it) t[it] = *(const f32x4*)(src + (size_t)(4 * it) * Nsrc);
#pragma unroll
    for (int it = 0; it < 16; ++it) *(LAS f32x4*)(scr + (kq + 4 * it) * 68 + 4 * v4) = t[it];
    LDS_WAIT(); asm volatile("" ::: "memory");
    if (f8scale != 0.f) {
        const int c = lane & 3; unsigned char* d8 = (unsigned char*)dst;
        if (f8scale < 0.f) {
#pragma unroll
            for (int j = 0; j < 4; ++j) { const int n = (lane >> 2) + 16 * j; const LAS float* s = scr + (16 * c) * 68 + n; const float q = -f8scale;
                v4u o; o.x = pk4_i8(s[0 * 68] * q, s[1 * 68] * q, s[2 * 68] * q, s[3 * 68] * q); o.y = pk4_i8(s[4 * 68] * q, s[5 * 68] * q, s[6 * 68] * q, s[7 * 68] * q);
                o.z = pk4_i8(s[8 * 68] * q, s[9 * 68] * q, s[10 * 68] * q, s[11 * 68] * q); o.w = pk4_i8(s[12 * 68] * q, s[13 * 68] * q, s[14 * 68] * q, s[15 * 68] * q);
                *(GAS v4u*)(d8 + (size_t)(v0 + n) * dpitch + koff + k0 + 16 * c) = o; }
            LDS_WAIT(); asm volatile("" ::: "memory"); return; }
        if (kind == 2) f8scale *= (lane & 16) ? SWI_B : SWI_A;
#pragma unroll
        for (int j = 0; j < 4; ++j) { const int n = (lane >> 2) + 16 * j; const LAS float* s = scr + (16 * c) * 68 + n;
            v4u o; o.x = pk4_fp8(s[0 * 68] * f8scale, s[1 * 68] * f8scale, s[2 * 68] * f8scale, s[3 * 68] * f8scale); o.y = pk4_fp8(s[4 * 68] * f8scale, s[5 * 68] * f8scale, s[6 * 68] * f8scale, s[7 * 68] * f8scale);
            o.z = pk4_fp8(s[8 * 68] * f8scale, s[9 * 68] * f8scale, s[10 * 68] * f8scale, s[11 * 68] * f8scale); o.w = pk4_fp8(s[12 * 68] * f8scale, s[13 * 68] * f8scale, s[14 * 68] * f8scale, s[15 * 68] * f8scale);
            *(GAS v4u*)(d8 + (size_t)(v0 + n) * dpitch + koff + k0 + 16 * c) = o; }
    } else {
    const int c = lane & 7;
#pragma unroll
    for (int j = 0; j < 8; ++j) { const int n = (lane >> 3) + 8 * j; const LAS float* s = scr + (8 * c) * 68 + n;
        v4u o; o.x = pk2(s[0 * 68], s[1 * 68]); o.y = pk2(s[2 * 68], s[3 * 68]); o.z = pk2(s[4 * 68], s[5 * 68]); o.w = pk2(s[6 * 68], s[7 * 68]);
        *(GAS v4u*)(dst + (size_t)(v0 + n) * dpitch + koff + k0 + 8 * c) = o; }
    }
    LDS_WAIT(); asm volatile("" ::: "memory");
}
struct CvtJob { const float* W; int K, Nsrc, Nv; bf16* dst; int dpitch, koff, kind, dff; float f8scale; int vbase = 0; };
__device__ __forceinline__ bool cvt_run(const CvtJob& j, int& r, LAS float* scr, int lane) {
    const int nvb = j.Nv / 64, items = (j.K / 64) * nvb;
    if (r >= items) { r -= items; return false; }
    cvt_item(j.W, j.Nsrc, j.dst, j.dpitch, j.koff, j.kind, j.dff, 64 * (r / nvb), 64 * (r % nvb), scr, lane, j.f8scale, j.vbase);
    return true;
}

__device__ __forceinline__ float row_dot8(const f32x4 (&v)[4], const LAS float* wT, int lane) {
    float p[8];
#pragma unroll
    for (int h = 0; h < 8; ++h) { float s = 0.f;
#pragma unroll
        for (int j = 0; j < 4; ++j) { const f32x4 w = *(const LAS f32x4*)(wT + h * 1024 + 256 * j + 4 * lane); s += (v[j].x * w.x + v[j].y * w.y) + (v[j].z * w.z + v[j].w * w.w); }
        p[h] = s; }
    const bool b0 = lane & 1, b1 = lane & 2, b2 = lane & 4;
    float q[4], r[2];
#pragma unroll
    for (int k = 0; k < 4; ++k) { const float a = p[2 * k], b = p[2 * k + 1]; q[k] = (b0 ? b : a) + __shfl_xor(b0 ? a : b, 1); }
#pragma unroll
    for (int k = 0; k < 2; ++k) { const float a = q[2 * k], b = q[2 * k + 1]; r[k] = (b1 ? b : a) + __shfl_xor(b1 ? a : b, 2); }
    float t = (b2 ? r[1] : r[0]) + __shfl_xor(b2 ? r[0] : r[1], 4);
    t += __shfl_xor(t, 8); t += __shfl_xor(t, 16); t += __shfl_xor(t, 32);
    return t;
}
__device__ __forceinline__ void stage_w8(Frame& F, const float* W, int pitch, int col0) {
    LAS float* wT = (LAS float*)(F.lds + RING_OFF);
    float t[16];
#pragma unroll
    for (int k = 0; k < 16; ++k) { const int i = F.tid + 512 * k, d = i >> 3, h = i & 7; t[k] = W[(size_t)d * pitch + col0 + h]; }
#pragma unroll
    for (int k = 0; k < 16; ++k) { const int i = F.tid + 512 * k, d = i >> 3, h = i & 7; wT[h * 1024 + d] = t[k]; }
    LDS_WAIT(); __syncthreads();
}
__device__ __forceinline__ float log_sigmoid(float x) {
    const float y = __builtin_amdgcn_exp2f(-fabsf(x) * LOG2E); const float l = (y < 1e-2f) ? y * (1.f - y * (0.5f - y * 0.33333334f)) : __builtin_amdgcn_logf(1.f + y) * 0.6931471805599453f;
    return fminf(x, 0.f) - l; }

__device__ __forceinline__ void p0_rows(Frame& F, const float* x, const float* w_in0, const float* fox_b) {
    stage_w8(F, w_in0, N_INSRC, FL_COL);
    const LAS float* wT = (const LAS float*)(F.lds + RING_OFF);
    const int gw = F.vcu * NWAVES + F.wave, NGW = F.G * NWAVES;
    bf16* XB = (bf16*)(F.ws + WS_XB); float* LOGF = (float*)(F.ws + WS_LOGF);
    f32x4 nx[4];
    if (gw < M) {
#pragma unroll
        for (int j = 0; j < 4; ++j) nx[j] = *((const GAS f32x4*)(x + (size_t)gw * D) + F.lane + 64 * j); }
#pragma unroll 1
    for (int m = gw; m < M; m += NGW) {
        f32x4 v[4];
#pragma unroll
        for (int j = 0; j < 4; ++j) v[j] = nx[j];
        if (m + NGW < M) {
#pragma unroll
            for (int j = 0; j < 4; ++j) nx[j] = *((const GAS f32x4*)(x + (size_t)(m + NGW) * D) + F.lane + 64 * j); }
#if !P1_I8
        GAS unsigned long long* o8 = (GAS unsigned long long*)(XB + (size_t)m * D) + F.lane;
#pragma unroll
        for (int j = 0; j < 4; ++j) o8[64 * j] = (unsigned long long)pk2(v[j].x, v[j].y) | ((unsigned long long)pk2(v[j].z, v[j].w) << 32);
#endif
#if GATES_FP8 == 2
#pragma unroll
        for (int j = 0; j < 4; ++j) *((GAS unsigned*)(F.ws + WS_X8IN + (size_t)m * D) + F.lane + 64 * j) = P1_I8 ? pk4_i8(v[j].x * SC_XI8, v[j].y * SC_XI8, v[j].z * SC_XI8, v[j].w * SC_XI8) : pk4_fp8(v[j].x * SC_X8, v[j].y * SC_X8, v[j].z * SC_X8, v[j].w * SC_X8);
#endif
        const float r = row_dot8(v, wT, F.lane);
        if (F.lane < 8) LOGF[(size_t)m * 8 + F.lane] = log_sigmoid(r + fox_b[F.lane]);
    }
    __syncthreads();
}

template <int AUX>
__device__ __forceinline__ void ln_pass(Frame& F, const float* src, float src_scale, const bf16* addb1, const bf16* addb2, const float* g, const float* b, float* outf, bf16* outb, unsigned char* out8,
                                        const float* w8, int w8pitch, int w8col, const float* fox_b, bool grp, float o8s = SC_X8) {
    if (AUX != 0) stage_w8(F, w8, w8pitch, w8col);
    const LAS float* wT = (const LAS float*)(F.lds + RING_OFF);
    const int gw = F.vcu * NWAVES + F.wave, NGW = F.G * NWAVES;
    f32x4 gv[4], bv[4];
#pragma unroll
    for (int j = 0; j < 4; ++j) { gv[j] = *((const f32x4*)g + F.lane + 64 * j); bv[j] = *((const f32x4*)b + F.lane + 64 * j); }
    int nbuf = 0, r_i1 = 0, r_i2 = 0, r_m = 0; float r_w1 = 0.f;
#define ROUTER_FLUSH() do { const bool vld_ = F.lane < nbuf; const unsigned long long lt_ = (1ull << F.lane) - 1ull; unsigned n_e_ = 0u, rk1_ = 0u, rk2_ = 0u; \
        _Pragma("unroll") for (int e_ = 0; e_ < 8; ++e_) { const unsigned long long b1_ = __ballot(vld_ && r_i1 == e_), b2_ = __ballot(vld_ && r_i2 == e_); \
            const unsigned c1_ = (unsigned)__popcll(b1_), c2_ = (unsigned)__popcll(b2_); if (F.lane == e_) n_e_ = c1_ + c2_; \
            if (r_i1 == e_) rk1_ = (unsigned)__popcll(b1_ & lt_); if (r_i2 == e_) rk2_ = c1_ + (unsigned)__popcll(b2_ & lt_); } \
        unsigned base_ = 0u; if (F.lane < 8 && n_e_ != 0u) base_ = __hip_atomic_fetch_add(F.ctl + CW_CNT + 64 * F.lane, n_e_, RLX_AGENT); \
        const unsigned s1_ = (unsigned)__shfl((int)base_, r_i1) + rk1_, s2_ = (unsigned)__shfl((int)base_, r_i2) + rk2_; \
        if (vld_) { unsigned* list_ = (unsigned*)(F.ws + WS_LIST); float* gw8_ = (float*)(F.ws + WS_GATEW); \
            list_[r_i1 * 16384 + s1_] = (unsigned)r_m; gw8_[r_i1 * 16384 + s1_] = r_w1; list_[r_i2 * 16384 + s2_] = (unsigned)r_m | 0x80000000u; gw8_[r_i2 * 16384 + s2_] = 1.0f - r_w1; } } while (0)
    const int m0 = grp ? (F.vcu >> 5) * SEQ + (F.vcu & 31) * NWAVES + F.wave : gw, mstep = grp ? 32 * NWAVES : NGW, mend = grp ? ((F.vcu >> 5) + 1) * SEQ : M;
    f32x4 nx[4]; v2u na[4], nc[4];
#define LN_LOAD(mm) do { _Pragma("unroll") for (int j = 0; j < 4; ++j) { nx[j] = *((const GAS f32x4*)(src + (size_t)(mm) * D) + F.lane + 64 * j); \
        if (addb1) { na[j] = *((const GAS v2u*)(addb1 + (size_t)(mm) * D) + F.lane + 64 * j); nc[j] = *((const GAS v2u*)(addb2 + (size_t)(mm) * D) + F.lane + 64 * j); } } } while (0)
    if (m0 < mend) LN_LOAD(m0);
#pragma unroll 1
    for (int m = m0; m < mend; m += mstep) {
        f32x4 v[4]; float s = 0.f;
#pragma unroll
        for (int j = 0; j < 4; ++j) { v[j] = nx[j];
            if (addb1) { v[j] = v[j] * src_scale; const v2u a = na[j], c = nc[j];
                v[j].x += bflo(a.x) + bflo(c.x); v[j].y += bfhi(a.x) + bfhi(c.x); v[j].z += bflo(a.y) + bflo(c.y); v[j].w += bfhi(a.y) + bfhi(c.y); }
            s += (v[j].x + v[j].y) + (v[j].z + v[j].w); }
        if (m + mstep < mend) LN_LOAD(m + mstep);
        float lm = s * (1.f / 16.f), m2 = 0.f;
#pragma unroll
        for (int j = 0; j < 4; ++j) { const f32x4 d = v[j] - lm; m2 += (d.x * d.x + d.y * d.y) + (d.z * d.z + d.w * d.w); }
        { float cnt2 = 8.f;
#pragma unroll
          for (int o = 1; o < 64; o <<= 1) { const float om = __shfl_xor(lm, o), o2 = __shfl_xor(m2, o); const float dl = om - lm; m2 = m2 + o2 + dl * dl * cnt2; lm = 0.5f * (lm + om); cnt2 *= 2.f; } }
        const float mean = lm;
#pragma unroll
        for (int j = 0; j < 4; ++j) v[j] = v[j] - mean;
        const float rstd = 1.f / sqrtf(m2 * (1.f / D) + LN_EPS);
#pragma unroll
        for (int j = 0; j < 4; ++j) v[j] = v[j] * rstd * gv[j] + bv[j];
        if (outf) {
#pragma unroll
            for (int j = 0; j < 4; ++j) *((GAS f32x4*)(outf + (size_t)m * D) + F.lane + 64 * j) = v[j]; }
        if (outb) { GAS unsigned long long* o8 = (GAS unsigned long long*)(outb + (size_t)m * D) + F.lane;
#pragma unroll
            for (int j = 0; j < 4; ++j) o8[64 * j] = (unsigned long long)pk2(v[j].x, v[j].y) | ((unsigned long long)pk2(v[j].z, v[j].w) << 32); }
        if (out8) {
            if (o8s < 0.f) {
#pragma unroll
                for (int j = 0; j < 4; ++j) *((GAS unsigned*)(out8 + (size_t)m * D) + F.lane + 64 * j) = pk4_i8(v[j].x * -o8s, v[j].y * -o8s, v[j].z * -o8s, v[j].w * -o8s);
            } else {
#pragma unroll
            for (int j = 0; j < 4; ++j) *((GAS unsigned*)(out8 + (size_t)m * D) + F.lane + 64 * j) = pk4_fp8(v[j].x * SC_X8, v[j].y * SC_X8, v[j].z * SC_X8, v[j].w * SC_X8); } }
        if (AUX == 1) {
            const float r = row_dot8(v, wT, F.lane);
            if (F.lane < 8) ((float*)(F.ws + WS_LOGF))[(size_t)m * 8 + F.lane] = log_sigmoid(r + fox_b[F.lane]);
        }
        if (AUX == 2) {
            const float rl = row_dot8(v, wT, F.lane); float lg[8];
#pragma unroll
            for (int e = 0; e < 8; ++e) lg[e] = __shfl(rl, e);
            int i1 = 0; float v1 = lg[0];
#pragma unroll
            for (int e = 1; e < 8; ++e) if (lg[e] > v1) { v1 = lg[e]; i1 = e; }
            int i2 = -1; float v2 = -INFINITY;
#pragma unroll
            for (int e = 0; e < 8; ++e) if (e != i1 && lg[e] > v2) { v2 = lg[e]; i2 = e; }
            const float w1 = 1.0f / (1.0f + expf(v2 - v1));
            if (F.lane == nbuf) { r_i1 = i1; r_i2 = i2; r_w1 = w1; r_m = m; }
            if (++nbuf == 64) { ROUTER_FLUSH(); nbuf = 0; }
        }
    }
    if (AUX == 2) { if (nbuf) { ROUTER_FLUSH(); } }
#undef ROUTER_FLUSH
#undef LN_LOAD
    __syncthreads();
}

__device__ __forceinline__ void split3(float b, unsigned& h, unsigned& m, unsigned& l) { h = f2bf(b); const float r1 = b - bf2f((unsigned short)h); m = f2bf(r1); const float r2 = r1 - bf2f((unsigned short)m); l = f2bf(r2); }
template <bool AUG>
__device__ __forceinline__ void fox_bias_table(Frame& F, int b, int h, LAS float* tab, LAS float* wtot) {
    int tid = threadIdx.x; asm volatile("" : "+v"(tid));
    const int lane = tid & 63, wave = __builtin_amdgcn_readfirstlane(tid >> 6);
    const float* lf = (const float*)(F.ws + WS_LOGF) + (size_t)b * SEQ * 8 + h;
    float v[4];
#pragma unroll
    for (int j = 0; j < 4; ++j) v[j] = lf[(size_t)(4 * tid + j) * 8];
    float sj[4]; sj[0] = v[0]; sj[1] = sj[0] + v[1]; sj[2] = sj[1] + v[2]; sj[3] = sj[2] + v[3];
    float x = sj[3];
#pragma unroll
    for (int o = 1; o < 64; o <<= 1) { const float y = __shfl_up(x, o); if (lane >= o) x += y; }
    __syncthreads();
    if (lane == 63) wtot[wave] = x;
    LDS_WAIT(); __syncthreads();
    float base = 0.f;
#pragma unroll
    for (int w = 0; w < 8; ++w) if (w < wave) base += wtot[w];
    const float ex = base + x - sj[3];
#pragma unroll
    for (int j = 0; j < 4; ++j) { const float bv = -(ex + sj[j]) * LOG2E;
        if (AUG) { unsigned hh, mm, ll; split3(bv, hh, mm, ll); v4u w; w.x = hh | (mm << 16); w.y = ll | (0x3F80u << 16); w.z = 0x3F803F80u; w.w = 0u; ((LAS v4u*)tab)[4 * tid + j] = w; }
        else tab[4 * tid + j] = bv; }
    LDS_WAIT(); __syncthreads();
}

#if 1
__device__ __forceinline__ void naive_fox_row(Frame& F, int b, int h, int t, const LAS float* tab) {
    const bf16* FQ = (const bf16*)(F.ws + WS_FQ); const bf16* FK = (const bf16*)(F.ws + WS_FK); const bf16* FV = (const bf16*)(F.ws + WS_FV); bf16* YB = (bf16*)(F.ws + WS_YB);
    const size_t rb = (size_t)b * SEQ;
    float q[64];
    { const v4u* qp = (const v4u*)(FQ + (rb + t) * 512 + h * 64);
#pragma unroll
      for (int c = 0; c < 8; ++c) { const v4u w = qp[c]; q[8 * c + 0] = bflo(w.x); q[8 * c + 1] = bfhi(w.x); q[8 * c + 2] = bflo(w.y); q[8 * c + 3] = bfhi(w.y); q[8 * c + 4] = bflo(w.z); q[8 * c + 5] = bfhi(w.z); q[8 * c + 6] = bflo(w.w); q[8 * c + 7] = bfhi(w.w); } }
    float mx = -INFINITY, l = 0.f, o = 0.f;
    for (int s0 = 0; s0 <= t; s0 += 64) {
        const int s = s0 + F.lane; float sc = -INFINITY;
        if (s <= t) { const v4u* kp = (const v4u*)(FK + (rb + s) * 512 + h * 64); float a = 0.f;
#pragma unroll
            for (int c = 0; c < 8; ++c) { const v4u w = kp[c]; a += q[8 * c + 0] * bflo(w.x) + q[8 * c + 1] * bfhi(w.x) + q[8 * c + 2] * bflo(w.y) + q[8 * c + 3] * bfhi(w.y) + q[8 * c + 4] * bflo(w.z) + q[8 * c + 5] * bfhi(w.z) + q[8 * c + 6] * bflo(w.w) + q[8 * c + 7] * bfhi(w.w); }
            sc = a + tab[s]; }
        float cm = sc;
#pragma unroll
        for (int of = 1; of < 64; of <<= 1) cm = fmaxf(cm, __shfl_xor(cm, of));
        const float nm = fmaxf(mx, cm), f = __builtin_amdgcn_exp2f(mx - nm); const float p = __builtin_amdgcn_exp2f(sc - nm);
        l = l * f + wave_sum(p); o *= f; mx = nm;
        const int ne = (t - s0 + 1) < 64 ? (t - s0 + 1) : 64;
        for (int j = 0; j < ne; ++j) { const float pj = __shfl(p, j); o += pj * bf2f(FV[(rb + s0 + j) * 512 + h * 64 + F.lane]); }
    }
    YB[(rb + t) * 1536 + 512 + h * 64 + F.lane] = (bf16)f2bf(o / l);
}
__device__ __forceinline__ void naive_ret_row(Frame& F, int b, int h, int t) {
    const bf16* RQ = (const bf16*)(F.ws + WS_RQ); const bf16* RK = (const bf16*)(F.ws + WS_RK); const bf16* RV = (const bf16*)(F.ws + WS_RV); const bf16* RG = (const bf16*)(F.ws + WS_RG); bf16* YB = (bf16*)(F.ws + WS_YB);
    const size_t rb = (size_t)b * SEQ;
    const float l2g = log2f(1.0f - exp2f(-5.0f - (float)h));
    float q[64];
    { const v4u* qp = (const v4u*)(RQ + (rb + t) * 256 + h * 64);
#pragma unroll
      for (int c = 0; c < 8; ++c) { const v4u w = qp[c]; q[8 * c + 0] = bflo(w.x); q[8 * c + 1] = bfhi(w.x); q[8 * c + 2] = bflo(w.y); q[8 * c + 3] = bfhi(w.y); q[8 * c + 4] = bflo(w.z); q[8 * c + 5] = bfhi(w.z); q[8 * c + 6] = bflo(w.w); q[8 * c + 7] = bfhi(w.w); } }
    float o0 = 0.f, o1 = 0.f;
    for (int s0 = 0; s0 <= t; s0 += 64) {
        const int s = s0 + F.lane; float sc = 0.f;
        if (s <= t) { const v4u* kp = (const v4u*)(RK + (rb + s) * 256 + h * 64); float a = 0.f;
#pragma unroll
            for (int c = 0; c < 8; ++c) { const v4u w = kp[c]; a += q[8 * c + 0] * bflo(w.x) + q[8 * c + 1] * bfhi(w.x) + q[8 * c + 2] * bflo(w.y) + q[8 * c + 3] * bfhi(w.y) + q[8 * c + 4] * bflo(w.z) + q[8 * c + 5] * bfhi(w.z) + q[8 * c + 6] * bflo(w.w) + q[8 * c + 7] * bfhi(w.w); }
            sc = a * exp2f(l2g * (float)(t - s)); }
        const int ne = (t - s0 + 1) < 64 ? (t - s0 + 1) : 64;
        for (int j = 0; j < ne; ++j) { const float pj = __shfl(sc, j); const bf16* vp = RV + (rb + s0 + j) * 512 + h * 128; o0 += pj * bf2f(vp[F.lane]); o1 += pj * bf2f(vp[F.lane + 64]); }
    }
    const float mean = wave_sum(o0 + o1) * (1.f / 128.f); const float d0 = o0 - mean, d1 = o1 - mean;
    const float rstd = 1.f / sqrtf(wave_sum(d0 * d0 + d1 * d1) * (1.f / 128.f) + GN_EPS);
    const bf16* gp = RG + (rb + t) * 512 + h * 128; bf16* yp = YB + (rb + t) * 1536 + h * 128;
    yp[F.lane] = (bf16)f2bf(bf2f(gp[F.lane]) * d0 * rstd); yp[F.lane + 64] = (bf16)f2bf(bf2f(gp[F.lane + 64]) * d1 * rstd);
}
__device__ __forceinline__ void naive_gmlp_unit(Frame& F, int b, int n, int g, const float* w_s, const float* b_s, const float* lng, const float* lnb) {
    const bf16* GU = (const bf16*)(F.ws + WS_GU); const bf16* GV = (const bf16*)(F.ws + WS_GV); bf16* YB = (bf16*)(F.ws + WS_YB);
    LAS float* st = (LAS float*)(F.lds + RING_OFF);
    const size_t r0 = (size_t)b * SEQ + n * 128;
    __syncthreads();
    for (int r = F.wave; r < 128; r += NWAVES) {
        const v4u w = *((const v4u*)(GV + (r0 + r) * 512) + F.lane);
        float x[8] = {bflo(w.x), bfhi(w.x), bflo(w.y), bfhi(w.y), bflo(w.z), bfhi(w.z), bflo(w.w), bfhi(w.w)};
        float s = 0.f;
#pragma unroll
        for (int j = 0; j < 8; ++j) s += x[j];
        const float mean = wave_sum(s) * (1.f / 512.f); float s2 = 0.f;
#pragma unroll
        for (int j = 0; j < 8; ++j) { const float d = x[j] - mean; s2 += d * d; }
        const float rstd = 1.f / sqrtf(wave_sum(s2) * (1.f / 512.f) + LN_EPS);
        if (F.lane == 0) { st[2 * r] = mean; st[2 * r + 1] = rstd; }
    }
    LDS_WAIT(); __syncthreads();
    const int c = F.tid & 127; const float gam = lng[g * 128 + c], bet = lnb[g * 128 + c];
    for (int i = F.tid >> 7; i < 128; i += 4) {
        float a = 0.f; const float* wr = w_s + ((size_t)g * 128 + i) * 128;
        for (int j = 0; j <= i; ++j) { const float vn = (bf2f(GV[(r0 + j) * 512 + g * 128 + c]) - st[2 * j]) * st[2 * j + 1] * gam + bet; a += wr[j] * vn; }
        const float sp = a + b_s[g * 128 + i];
        YB[(r0 + i) * 1536 + 1024 + g * 128 + c] = (bf16)f2bf(bf2f(GU[(r0 + i) * 512 + g * 128 + c]) * sp);
    }
    __syncthreads();
}
#endif

__device__ __forceinline__ GAS void* lds_ptr(LAS unsigned char* lds, int k) {
    const v2u w = *(const LAS v2u*)(lds + PTAB_OFF + 8 * k);
    const unsigned lo = __builtin_amdgcn_readfirstlane(w.x), hi = __builtin_amdgcn_readfirstlane(w.y);
    return (GAS void*)(((unsigned long long)hi << 32) | lo);
}

typedef short bf16x8_t __attribute__((ext_vector_type(8)));
typedef float f32x16_t __attribute__((ext_vector_type(16)));
#define MFMA32(a, b, c) __builtin_amdgcn_mfma_f32_32x32x16_bf16((a), (b), (c), 0, 0, 0)
__device__ __forceinline__ bf16x8_t ldfrag(const LAS bf16* base, int row, int pitch, int kk, int h2) { return *(const LAS bf16x8_t*)(base + row * pitch + 16 * kk + 8 * h2); }
__device__ __forceinline__ int crow32(int reg, int h2) { return (reg & 3) + 8 * (reg >> 2) + 4 * h2; }
constexpr int RP128 = 136, RP64 = 72;
constexpr int R_QS = 0, R_KS = 4608, R_KDT = 23040, R_VT = 40448, R_SS = 75264, R_ST = 83968, R_OS = 102400, R_END = 119296;
static_assert(R_END <= RING_BYTES, "retention LDS map");
__device__ __forceinline__ void unpack8(const v4u w, float (&x)[8]) { x[0] = bflo(w.x); x[1] = bfhi(w.x); x[2] = bflo(w.y); x[3] = bfhi(w.y); x[4] = bflo(w.z); x[5] = bfhi(w.z); x[6] = bflo(w.w); x[7] = bfhi(w.w); }

__device__ __forceinline__ void ret_unit(Frame& F, int b, int h, int rq) {
    int tid_ = threadIdx.x; asm volatile("" : "+v"(tid_));
    const int tid = tid_, lane = tid & 63, wid = __builtin_amdgcn_readfirstlane(tid >> 6), r = lane & 31, h2 = lane >> 5;
    const float l2g = log2f(1.0f - exp2f(-5.0f - (float)h));
    const float chunk_dec = exp2f(l2g * 128.0f);
    LAS bf16* Qs = (LAS bf16*)(F.lds + RING_OFF + R_QS); LAS bf16* Ks = (LAS bf16*)(F.lds + RING_OFF + R_KS); LAS bf16* KdT = (LAS bf16*)(F.lds + RING_OFF + R_KDT);
    LAS bf16* VT = (LAS bf16*)(F.lds + RING_OFF + R_VT); LAS bf16* Ss = (LAS bf16*)(F.lds + RING_OFF + R_SS); LAS bf16* ST = (LAS bf16*)(F.lds + RING_OFF + R_ST);
    LAS float* Os = (LAS float*)(F.lds + RING_OFF + R_OS);
    const bf16* RQ = (const bf16*)(F.ws + WS_RQ); const bf16* RK = (const bf16*)(F.ws + WS_RK); const bf16* RV = (const bf16*)(F.ws + WS_RV); const bf16* RG = (const bf16*)(F.ws + WS_RG); bf16* YB = (bf16*)(F.ws + WS_YB);
    const size_t rb = (size_t)b * SEQ;
    __syncthreads();
    for (int i = tid; i < 128 * RP64 / 2; i += NWAVES * 64) ((LAS unsigned*)ST)[i] = 0u;
    f32x16_t st = {0.f, 0.f, 0.f, 0.f, 0.f, 0.f, 0.f, 0.f, 0.f, 0.f, 0.f, 0.f, 0.f, 0.f, 0.f, 0.f};
    const int sj = tid & 127, cq = tid >> 7, qi = tid & 31, qc = tid >> 5, gi = tid >> 4, gs = tid & 15;
    v4u qreg = {0u, 0u, 0u, 0u}, kreg[2], vreg[4], greg;
#define RET_LOAD(n) do { const size_t r0_ = rb + (size_t)(n) * 128; \
        if (tid < 256) qreg = *(const v4u*)(RQ + (r0_ + 32 * rq + qi) * 256 + h * 64 + 8 * qc); \
        _Pragma("unroll") for (int c_ = 0; c_ < 2; ++c_) kreg[c_] = *(const v4u*)(RK + (r0_ + sj) * 256 + h * 64 + 16 * cq + 8 * c_); \
        _Pragma("unroll") for (int c_ = 0; c_ < 4; ++c_) vreg[c_] = *(const v4u*)(RV + (r0_ + sj) * 512 + h * 128 + 32 * cq + 8 * c_); \
        greg = *(const v4u*)(RG + (r0_ + 32 * rq + gi) * 512 + h * 128 + 8 * gs); } while (0)
    RET_LOAD(0);
    const float kdec = exp2f(l2g * (float)(127 - sj));
#pragma unroll 1
    for (int n = 0; n < 16; ++n) {
        if (tid < 256) *(LAS v4u*)(Qs + qi * RP64 + 8 * qc) = qreg;
#pragma unroll
        for (int c = 0; c < 2; ++c) { *(LAS v4u*)(Ks + sj * RP64 + 16 * cq + 8 * c) = kreg[c]; float x[8]; unpack8(kreg[c], x);
#pragma unroll
            for (int e = 0; e < 8; ++e) KdT[(16 * cq + 8 * c + e) * RP128 + sj] = (bf16)f2bf(x[e] * kdec); }
#pragma unroll
        for (int c = 0; c < 4; ++c) { const v4u w = vreg[c]; const unsigned ww[4] = {w.x, w.y, w.z, w.w};
#pragma unroll
            for (int e = 0; e < 8; ++e) VT[(32 * cq + 8 * c + e) * RP128 + sj] = (bf16)((e & 1) ? (ww[e >> 1] >> 16) : (ww[e >> 1] & 0xffffu)); }
        const v4u gcur = greg;
        LDS_WAIT(); __syncthreads();
        if (n + 1 < 16) RET_LOAD(n + 1);
        f32x16_t x = {0.f, 0.f, 0.f, 0.f, 0.f, 0.f, 0.f, 0.f, 0.f, 0.f, 0.f, 0.f, 0.f, 0.f, 0.f, 0.f};
        if (wid < 4) {
#pragma unroll
            for (int kk = 0; kk < 4; ++kk) x = MFMA32(ldfrag(Qs, r, RP64, kk, h2), ldfrag(Ks, 32 * wid + r, RP64, kk, h2), x);
            const int jabs = 32 * wid + r;
#pragma unroll
            for (int reg = 0; reg < 16; ++reg) { const int i = crow32(reg, h2), diff = 32 * rq + i - jabs;
                const float val = diff >= 0 ? x[reg] * exp2f(l2g * (float)diff) : 0.f; Ss[i * RP128 + jabs] = (bf16)f2bf(val); }
        } else {
#pragma unroll
            for (int kk = 0; kk < 4; ++kk) x = MFMA32(ldfrag(Qs, r, RP64, kk, h2), ldfrag(ST, 32 * (wid - 4) + r, RP64, kk, h2), x);
#pragma unroll
            for (int reg = 0; reg < 16; ++reg) x[reg] *= exp2f(l2g * (float)(32 * rq + crow32(reg, h2) + 1));
        }
        { const int db = wid >> 2, vb2 = wid & 3;
#pragma unroll
          for (int reg = 0; reg < 16; ++reg) st[reg] *= chunk_dec;
#pragma unroll
          for (int kk = 0; kk < 8; ++kk) st = MFMA32(ldfrag(KdT, 32 * db + r, RP128, kk, h2), ldfrag(VT, 32 * vb2 + r, RP128, kk, h2), st); }
        LDS_WAIT(); __syncthreads();
        { const int db = wid >> 2, vb2 = wid & 3;
#pragma unroll
          for (int g = 0; g < 4; ++g) { v2u w; w.x = pk2(st[4 * g], st[4 * g + 1]); w.y = pk2(st[4 * g + 2], st[4 * g + 3]); *(LAS v2u*)(ST + (32 * vb2 + r) * RP64 + 32 * db + 8 * g + 4 * h2) = w; } }
        if (wid >= 4) {
#pragma unroll
            for (int kk = 0; kk < 8; ++kk) x = MFMA32(ldfrag(Ss, r, RP128, kk, h2), ldfrag(VT, 32 * (wid - 4) + r, RP128, kk, h2), x);
#pragma unroll
            for (int reg = 0; reg < 16; ++reg) Os[crow32(reg, h2) * 132 + 32 * (wid - 4) + r] = x[reg];
        }
        LDS_WAIT(); __syncthreads();
        { const f32x4 a0 = *(const LAS f32x4*)(Os + gi * 132 + 8 * gs), a1 = *(const LAS f32x4*)(Os + gi * 132 + 8 * gs + 4);
          float sm = (a0.x + a0.y) + (a0.z + a0.w) + (a1.x + a1.y) + (a1.z + a1.w);
#pragma unroll
          for (int o = 1; o < 16; o <<= 1) sm += __shfl_xor(sm, o);
          const float mean = sm * (1.f / 128.f); const f32x4 d0 = a0 - mean, d1 = a1 - mean;
          float sq = (d0.x * d0.x + d0.y * d0.y) + (d0.z * d0.z + d0.w * d0.w) + (d1.x * d1.x + d1.y * d1.y) + (d1.z * d1.z + d1.w * d1.w);
#pragma unroll
          for (int o = 1; o < 16; o <<= 1) sq += __shfl_xor(sq, o);
          const float rstd = 1.f / sqrtf(sq * (1.f / 128.f) + GN_EPS); float gt[8]; unpack8(gcur, gt);
          v4u w; w.x = pk2(gt[0] * d0.x * rstd, gt[1] * d0.y * rstd); w.y = pk2(gt[2] * d0.z * rstd, gt[3] * d0.w * rstd); w.z = pk2(gt[4] * d1.x * rstd, gt[5] * d1.y * rstd); w.w = pk2(gt[6] * d1.z * rstd, gt[7] * d1.w * rstd);
          *(v4u*)(YB + (rb + (size_t)n * 128 + 32 * rq + gi) * 1536 + h * 128 + 8 * gs) = w; }
    }
#undef RET_LOAD
    __syncthreads();
}


#define MFMA16(a, b, c) __builtin_amdgcn_mfma_f32_16x16x32_bf16((a), (b), (c), 0, 0, 0)
__device__ __forceinline__ bf16x8_t ldfrag16(const LAS bf16* base, int row, int pitch, int ks, int q4) { return *(const LAS bf16x8_t*)(base + row * pitch + 32 * ks + 8 * q4); }
__device__ __forceinline__ void ret_kv_unit(Frame& F, int b, int h, int n) {
    int tid_ = threadIdx.x; asm volatile("" : "+v"(tid_));
    const int tid = tid_, lane = tid & 63, wid = __builtin_amdgcn_readfirstlane(tid >> 6), r = lane & 31, h2 = lane >> 5;
    const float l2g = log2f(1.0f - exp2f(-5.0f - (float)h));
    LAS bf16* KdT = (LAS bf16*)(F.lds + RING_OFF); LAS bf16* VT = (LAS bf16*)(F.lds + RING_OFF + 17408);
    const bf16* RK = (const bf16*)(F.ws + WS_RK); const bf16* RV = (const bf16*)(F.ws + WS_RV);
    const size_t r0 = (size_t)b * SEQ + (size_t)n * 128;
    const int sj = tid & 127, cq = tid >> 7; const float kdec = exp2f(l2g * (float)(127 - sj));
    v4u kreg[2], vreg[4];
#pragma unroll
    for (int c = 0; c < 2; ++c) kreg[c] = *(const v4u*)(RK + (r0 + sj) * 256 + h * 64 + 16 * cq + 8 * c);
#pragma unroll
    for (int c = 0; c < 4; ++c) vreg[c] = *(const v4u*)(RV + (r0 + sj) * 512 + h * 128 + 32 * cq + 8 * c);
    __syncthreads();
#pragma unroll
    for (int c = 0; c < 2; ++c) { float x[8]; unpack8(kreg[c], x);
#pragma unroll
        for (int e = 0; e < 8; ++e) KdT[(16 * cq + 8 * c + e) * RP128 + sj] = (bf16)f2bf(x[e] * kdec); }
#pragma unroll
    for (int c = 0; c < 4; ++c) { const v4u w = vreg[c]; const unsigned ww[4] = {w.x, w.y, w.z, w.w};
#pragma unroll
        for (int e = 0; e < 8; ++e) VT[(32 * cq + 8 * c + e) * RP128 + sj] = (bf16)((e & 1) ? (ww[e >> 1] >> 16) : (ww[e >> 1] & 0xffffu)); }
    LDS_WAIT(); __syncthreads();
    const int db = wid >> 2, vb = wid & 3;
    f32x16_t st = {0.f, 0.f, 0.f, 0.f, 0.f, 0.f, 0.f, 0.f, 0.f, 0.f, 0.f, 0.f, 0.f, 0.f, 0.f, 0.f};
#pragma unroll
    for (int kk = 0; kk < 8; ++kk) st = MFMA32(ldfrag(KdT, 32 * db + r, RP128, kk, h2), ldfrag(VT, 32 * vb + r, RP128, kk, h2), st);
    float* KV = (float*)(F.ws + WS_KV) + ((size_t)((b * 4 + h) * 16 + n)) * 8192;
#pragma unroll
    for (int reg = 0; reg < 16; ++reg) KV[(32 * db + crow32(reg, h2)) * 128 + 32 * vb + r] = st[reg];
    __syncthreads();
}
constexpr int RB_QS = 0, RB_KS = 18432, RB_VT = 36864, RB_ST = 71680, RB_SW = 90112, RB_END = 124928;
static_assert(RB_END <= RING_BYTES, "retention pass B LDS map");
__device__ __forceinline__ void ret_out_unit(Frame& F, int b, int h, int n) {
    int tid_ = threadIdx.x; asm volatile("" : "+v"(tid_));
    const int tid = tid_, lane = tid & 63, wid = __builtin_amdgcn_readfirstlane(tid >> 6), l15 = lane & 15, q4 = lane >> 4;
    const float l2g = log2f(1.0f - exp2f(-5.0f - (float)h));
    const float chunk_dec = exp2f(l2g * 128.0f);
    LAS bf16* Qs = (LAS bf16*)(F.lds + RING_OFF + RB_QS); LAS bf16* Ks = (LAS bf16*)(F.lds + RING_OFF + RB_KS); LAS bf16* VT = (LAS bf16*)(F.lds + RING_OFF + RB_VT);
    LAS bf16* ST = (LAS bf16*)(F.lds + RING_OFF + RB_ST); LAS bf16* Sw = (LAS bf16*)(F.lds + RING_OFF + RB_SW) + wid * (16 * RP128);
    const bf16* RQ = (const bf16*)(F.ws + WS_RQ); const bf16* RK = (const bf16*)(F.ws + WS_RK); const bf16* RV = (const bf16*)(F.ws + WS_RV); const bf16* RG = (const bf16*)(F.ws + WS_RG); bf16* YB = (bf16*)(F.ws + WS_YB);
    const size_t r0 = (size_t)b * SEQ + (size_t)n * 128;
    const int sj = tid & 127, cq = tid >> 7;
    v4u qreg[2], kreg[2], vreg[4];
#pragma unroll
    for (int c = 0; c < 2; ++c) { qreg[c] = *(const v4u*)(RQ + (r0 + sj) * 256 + h * 64 + 16 * cq + 8 * c); kreg[c] = *(const v4u*)(RK + (r0 + sj) * 256 + h * 64 + 16 * cq + 8 * c); }
#pragma unroll
    for (int c = 0; c < 4; ++c) vreg[c] = *(const v4u*)(RV + (r0 + sj) * 512 + h * 128 + 32 * cq + 8 * c);
    f32x4 sa[4] = {{0.f, 0.f, 0.f, 0.f}, {0.f, 0.f, 0.f, 0.f}, {0.f, 0.f, 0.f, 0.f}, {0.f, 0.f, 0.f, 0.f}};
    { const float* KV = (const float*)(F.ws + WS_KV) + ((size_t)((b * 4 + h) * 16)) * 8192 + (size_t)tid * 16;
#pragma unroll 4
      for (int m = 0; m < n; ++m) {
#pragma unroll
          for (int c = 0; c < 4; ++c) { const f32x4 kv = *(const f32x4*)(KV + (size_t)m * 8192 + 4 * c); sa[c] = sa[c] * chunk_dec + kv; } } }
    __syncthreads();
    { const int d = tid >> 3, v0 = 16 * (tid & 7);
#pragma unroll
      for (int c = 0; c < 4; ++c)
#pragma unroll
          for (int e = 0; e < 4; ++e) ST[(v0 + 4 * c + e) * RP64 + d] = (bf16)f2bf(sa[c][e]); }
#pragma unroll
    for (int c = 0; c < 2; ++c) { *(LAS v4u*)(Qs + sj * RP64 + 16 * cq + 8 * c) = qreg[c]; *(LAS v4u*)(Ks + sj * RP64 + 16 * cq + 8 * c) = kreg[c]; }
#pragma unroll
    for (int c = 0; c < 4; ++c) { const v4u w = vreg[c]; const unsigned ww[4] = {w.x, w.y, w.z, w.w};
#pragma unroll
        for (int e = 0; e < 8; ++e) VT[(32 * cq + 8 * c + e) * RP128 + sj] = (bf16)((e & 1) ? (ww[e >> 1] >> 16) : (ww[e >> 1] & 0xffffu)); }
    LDS_WAIT(); __syncthreads();
    const int i0 = 16 * wid;
    const bf16x8_t qa0 = ldfrag16(Qs, i0 + l15, RP64, 0, q4), qa1 = ldfrag16(Qs, i0 + l15, RP64, 1, q4);
#pragma unroll 1
    for (int kb = 0; kb <= (wid | 1); kb += 2) {
        f32x4 sc[2];
#pragma unroll
        for (int u = 0; u < 2; ++u) { sc[u] = (f32x4){0.f, 0.f, 0.f, 0.f};
            sc[u] = MFMA16(qa0, ldfrag16(Ks, 16 * (kb + u) + l15, RP64, 0, q4), sc[u]); sc[u] = MFMA16(qa1, ldfrag16(Ks, 16 * (kb + u) + l15, RP64, 1, q4), sc[u]); }
#pragma unroll
        for (int u = 0; u < 2; ++u) { const int j = 16 * (kb + u) + l15;
#pragma unroll
            for (int reg = 0; reg < 4; ++reg) { const int il = 4 * q4 + reg, diff = i0 + il - j; Sw[il * RP128 + j] = (bf16)f2bf(diff >= 0 ? sc[u][reg] * __builtin_amdgcn_exp2f(l2g * (float)diff) : 0.f); } }
    }
    LDS_WAIT();
    float qd[4];
#pragma unroll
    for (int reg = 0; reg < 4; ++reg) qd[reg] = __builtin_amdgcn_exp2f(l2g * (float)(i0 + 4 * q4 + reg + 1));
    f32x4 o[8];
    const int nks = (wid + 2) >> 1;
#pragma unroll
    for (int vb = 0; vb < 8; ++vb) {
        f32x4 x = {0.f, 0.f, 0.f, 0.f};
        x = MFMA16(qa0, ldfrag16(ST, 16 * vb + l15, RP64, 0, q4), x); x = MFMA16(qa1, ldfrag16(ST, 16 * vb + l15, RP64, 1, q4), x);
#pragma unroll
        for (int reg = 0; reg < 4; ++reg) x[reg] *= qd[reg];
        o[vb] = x;
    }
#pragma unroll 1
    for (int ks = 0; ks < nks; ++ks) {
        const bf16x8_t a = ldfrag16(Sw, l15, RP128, ks, q4);
#pragma unroll
        for (int vb = 0; vb < 8; ++vb) o[vb] = MFMA16(a, ldfrag16(VT, 16 * vb + l15, RP128, ks, q4), o[vb]);
    }
    float mean[4], rstd[4];
#pragma unroll
    for (int reg = 0; reg < 4; ++reg) { float sm = 0.f;
#pragma unroll
        for (int vb = 0; vb < 8; ++vb) sm += o[vb][reg];
#pragma unroll
        for (int of = 1; of < 16; of <<= 1) sm += __shfl_xor(sm, of);
        mean[reg] = sm * (1.f / 128.f); float sq = 0.f;
#pragma unroll
        for (int vb = 0; vb < 8; ++vb) { const float d = o[vb][reg] - mean[reg]; sq += d * d; }
#pragma unroll
        for (int of = 1; of < 16; of <<= 1) sq += __shfl_xor(sq, of);
        rstd[reg] = 1.f / sqrtf(sq * (1.f / 128.f) + GN_EPS); }
#pragma unroll
    for (int vb = 0; vb < 8; ++vb)
#pragma unroll
        for (int reg = 0; reg < 4; ++reg) Sw[(4 * q4 + reg) * RP128 + 16 * vb + l15] = (bf16)f2bf((o[vb][reg] - mean[reg]) * rstd[reg]);
    LDS_WAIT();
#pragma unroll
    for (int c = 0; c < 4; ++c) { const int ch = c * 64 + lane, row = ch >> 4, cc = ch & 15;
        float xn[8], gt[8]; unpack8(*(const LAS v4u*)(Sw + row * RP128 + 8 * cc), xn); unpack8(*(const v4u*)(RG + (r0 + i0 + row) * 512 + h * 128 + 8 * cc), gt);
        v4u w; w.x = pk2(xn[0] * gt[0], xn[1] * gt[1]); w.y = pk2(xn[2] * gt[2], xn[3] * gt[3]); w.z = pk2(xn[4] * gt[4], xn[5] * gt[5]); w.w = pk2(xn[6] * gt[6], xn[7] * gt[7]);
        *(v4u*)(YB + (r0 + i0 + row) * 1536 + h * 128 + 8 * cc) = w; }
    __syncthreads();
}

constexpr int G_WS = 0, G_VNT = 34816, G_STAT = 69632, G_END = 70656;
__device__ __forceinline__ void gmlp_unit(Frame& F, int b, int n, int g, const float* w_s, const float* b_s, const float* lng, const float* lnb) {
    int tid_ = threadIdx.x; asm volatile("" : "+v"(tid_));
    const int tid = tid_, lane = tid & 63, wid = __builtin_amdgcn_readfirstlane(tid >> 6), r = lane & 31, h2 = lane >> 5;
    const bf16* GU = (const bf16*)(F.ws + WS_GU); const bf16* GV = (const bf16*)(F.ws + WS_GV); bf16* YB = (bf16*)(F.ws + WS_YB);
    LAS bf16* Ws = (LAS bf16*)(F.lds + RING_OFF + G_WS); LAS bf16* VnT = (LAS bf16*)(F.lds + RING_OFF + G_VNT); LAS float* stt = (LAS float*)(F.lds + RING_OFF + G_STAT);
    const size_t r0 = (size_t)b * SEQ + (size_t)n * 128;
    __syncthreads();
    for (int rr = wid; rr < 128; rr += NWAVES) {
        float x[8]; unpack8(*((const v4u*)(GV + (r0 + rr) * 512) + lane), x);
        float s = 0.f;
#pragma unroll
        for (int j = 0; j < 8; ++j) s += x[j];
        const float mean = wave_sum(s) * (1.f / 512.f); float s2 = 0.f;
#pragma unroll
        for (int j = 0; j < 8; ++j) { const float d = x[j] - mean; s2 += d * d; }
        const float rstd = 1.f / sqrtf(wave_sum(s2) * (1.f / 512.f) + LN_EPS);
        if (lane == 0) { stt[2 * rr] = mean; stt[2 * rr + 1] = rstd; }
    }
    { const int i = tid >> 2, jq = tid & 3; const float* wr = w_s + ((size_t)g * 128 + i) * 128 + 32 * jq;
#pragma unroll
      for (int c = 0; c < 4; ++c) { const f32x4 a = *(const f32x4*)(wr + 8 * c), bq = *(const f32x4*)(wr + 8 * c + 4); const int j0 = 32 * jq + 8 * c;
          v4u w; w.x = pk2(j0 + 0 <= i ? a.x : 0.f, j0 + 1 <= i ? a.y : 0.f); w.y = pk2(j0 + 2 <= i ? a.z : 0.f, j0 + 3 <= i ? a.w : 0.f);
          w.z = pk2(j0 + 4 <= i ? bq.x : 0.f, j0 + 5 <= i ? bq.y : 0.f); w.w = pk2(j0 + 6 <= i ? bq.z : 0.f, j0 + 7 <= i ? bq.w : 0.f);
          *(LAS v4u*)(Ws + i * RP128 + j0) = w; } }
    LDS_WAIT(); __syncthreads();
    { const int sj = tid & 127, cq = tid >> 7; const float mu = stt[2 * sj], rs = stt[2 * sj + 1];
#pragma unroll
      for (int c = 0; c < 4; ++c) { float x[8]; unpack8(*(const v4u*)(GV + (r0 + sj) * 512 + g * 128 + 32 * cq + 8 * c), x);
          const f32x4 ga = *(const f32x4*)(lng + g * 128 + 32 * cq + 8 * c), gb = *(const f32x4*)(lng + g * 128 + 32 * cq + 8 * c + 4);
          const f32x4 ba = *(const f32x4*)(lnb + g * 128 + 32 * cq + 8 * c), bb = *(const f32x4*)(lnb + g * 128 + 32 * cq + 8 * c + 4);
          const float gm[8] = {ga.x, ga.y, ga.z, ga.w, gb.x, gb.y, gb.z, gb.w}, bt[8] = {ba.x, ba.y, ba.z, ba.w, bb.x, bb.y, bb.z, bb.w};
#pragma unroll
          for (int e = 0; e < 8; ++e) VnT[(32 * cq + 8 * c + e) * RP128 + sj] = (bf16)f2bf((x[e] - mu) * rs * gm[e] + bt[e]); } }
    LDS_WAIT(); __syncthreads();
    { const int ib = wid >> 1;
#pragma unroll
      for (int cc = 0; cc < 2; ++cc) { const int cb = 2 * (wid & 1) + cc;
          f32x16_t x = {0.f, 0.f, 0.f, 0.f, 0.f, 0.f, 0.f, 0.f, 0.f, 0.f, 0.f, 0.f, 0.f, 0.f, 0.f, 0.f};
#pragma unroll
          for (int kk = 0; kk < 8; ++kk) x = MFMA32(ldfrag(Ws, 32 * ib + r, RP128, kk, h2), ldfrag(VnT, 32 * cb + r, RP128, kk, h2), x);
          const int c = g * 128 + 32 * cb + r;
#pragma unroll
          for (int reg = 0; reg < 16; ++reg) { const int i = 32 * ib + crow32(reg, h2); const float sp = x[reg] + b_s[g * 128 + i];
              YB[(r0 + i) * 1536 + 1024 + c] = (bf16)f2bf(bf2f(GU[(r0 + i) * 512 + c]) * sp); } } }
    __syncthreads();
}


__device__ __forceinline__ void gmlp_stat_unit(Frame& F, int b, int n) {
    int tid_ = threadIdx.x; asm volatile("" : "+v"(tid_));
    const int tid = tid_, row = tid >> 2, qt = tid & 3;
    const bf16* GV = (const bf16*)(F.ws + WS_GV); float* GST = (float*)(F.ws + WS_GST);
    const size_t r = (size_t)b * SEQ + (size_t)n * 128 + row;
    v4u w[16];
#pragma unroll
    for (int c = 0; c < 16; ++c) w[c] = *(const v4u*)(GV + r * 512 + 128 * qt + 8 * c);
    float s = 0.f;
#pragma unroll
    for (int c = 0; c < 16; ++c) { float x[8]; unpack8(w[c], x); s += ((x[0] + x[1]) + (x[2] + x[3])) + ((x[4] + x[5]) + (x[6] + x[7])); }
    s += __shfl_xor(s, 1); s += __shfl_xor(s, 2);
    const float mean = s * (1.f / 512.f); float s2 = 0.f;
#pragma unroll
    for (int c = 0; c < 16; ++c) { float x[8]; unpack8(w[c], x);
#pragma unroll
        for (int e = 0; e < 8; ++e) { const float d = x[e] - mean; s2 += d * d; } }
    s2 += __shfl_xor(s2, 1); s2 += __shfl_xor(s2, 2);
    if (qt == 0) { GST[2 * r] = mean; GST[2 * r + 1] = 1.f / sqrtf(s2 * (1.f / 512.f) + LN_EPS); }
}
constexpr int G2_WS = 0, G2_VNT = 34816, G2_SW = 69632, G2_END = 104448;
__device__ __forceinline__ void gmlp_unit2(Frame& F, int b, int n, int g, const float* w_s, const float* b_s, const float* lng, const float* lnb) {
    int tid_ = threadIdx.x; asm volatile("" : "+v"(tid_));
    const int tid = tid_, lane = tid & 63, wid = __builtin_amdgcn_readfirstlane(tid >> 6), l15 = lane & 15, q4 = lane >> 4;
    const bf16* GU = (const bf16*)(F.ws + WS_GU); const bf16* GV = (const bf16*)(F.ws + WS_GV); bf16* YB = (bf16*)(F.ws + WS_YB); const float* GST = (const float*)(F.ws + WS_GST);
    LAS bf16* Ws = (LAS bf16*)(F.lds + RING_OFF + G2_WS); LAS bf16* VnT = (LAS bf16*)(F.lds + RING_OFF + G2_VNT); LAS bf16* Sw = (LAS bf16*)(F.lds + RING_OFF + G2_SW) + wid * (16 * RP128);
    const size_t r0 = (size_t)b * SEQ + (size_t)n * 128;
    const int sj = tid & 127, cq = tid >> 7, wi = tid >> 2, jq = tid & 3;
    v4u vreg[4]; f32x4 wreg[8];
#pragma unroll
    for (int c = 0; c < 4; ++c) vreg[c] = *(const v4u*)(GV + (r0 + sj) * 512 + g * 128 + 32 * cq + 8 * c);
    const float mu = GST[2 * (r0 + sj)], rs = GST[2 * (r0 + sj) + 1];
    { const float* wr = w_s + ((size_t)g * 128 + wi) * 128 + 32 * jq;
#pragma unroll
      for (int c = 0; c < 8; ++c) wreg[c] = *(const f32x4*)(wr + 4 * c); }
    __syncthreads();
#pragma unroll
    for (int c = 0; c < 4; ++c) { const int j0 = 32 * jq + 8 * c; const f32x4 a = wreg[2 * c], bq = wreg[2 * c + 1];
        v4u w; w.x = pk2(j0 + 0 <= wi ? a.x : 0.f, j0 + 1 <= wi ? a.y : 0.f); w.y = pk2(j0 + 2 <= wi ? a.z : 0.f, j0 + 3 <= wi ? a.w : 0.f);
        w.z = pk2(j0 + 4 <= wi ? bq.x : 0.f, j0 + 5 <= wi ? bq.y : 0.f); w.w = pk2(j0 + 6 <= wi ? bq.z : 0.f, j0 + 7 <= wi ? bq.w : 0.f);
        *(LAS v4u*)(Ws + wi * RP128 + j0) = w; }
#pragma unroll
    for (int c = 0; c < 4; ++c) { float x[8]; unpack8(vreg[c], x);
        const f32x4 ga = *(const f32x4*)(lng + g * 128 + 32 * cq + 8 * c), gb = *(const f32x4*)(lng + g * 128 + 32 * cq + 8 * c + 4);
        const f32x4 ba = *(const f32x4*)(lnb + g * 128 + 32 * cq + 8 * c), bb = *(const f32x4*)(lnb + g * 128 + 32 * cq + 8 * c + 4);
        const float gm[8] = {ga.x, ga.y, ga.z, ga.w, gb.x, gb.y, gb.z, gb.w}, bt[8] = {ba.x, ba.y, ba.z, ba.w, bb.x, bb.y, bb.z, bb.w};
#pragma unroll
        for (int e = 0; e < 8; ++e) VnT[(32 * cq + 8 * c + e) * RP128 + sj] = (bf16)f2bf((x[e] - mu) * rs * gm[e] + bt[e]); }
    LDS_WAIT(); __syncthreads();
    const int i0 = 16 * wid, nks = (wid + 2) >> 1;
    float bs[4];
#pragma unroll
    for (int reg = 0; reg < 4; ++reg) bs[reg] = b_s[g * 128 + i0 + 4 * q4 + reg];
    { f32x4 x[8];
#pragma unroll
      for (int cb = 0; cb < 8; ++cb) x[cb] = (f32x4){0.f, 0.f, 0.f, 0.f};
#pragma unroll 1
      for (int ks = 0; ks < nks; ++ks) {
          const bf16x8_t a = ldfrag16(Ws, i0 + l15, RP128, ks, q4);
#pragma unroll
          for (int cb = 0; cb < 8; ++cb) x[cb] = MFMA16(a, ldfrag16(VnT, 16 * cb + l15, RP128, ks, q4), x[cb]);
      }
#pragma unroll
      for (int cb = 0; cb < 8; ++cb)
#pragma unroll
          for (int reg = 0; reg < 4; ++reg) Sw[(4 * q4 + reg) * RP128 + 16 * cb + l15] = (bf16)f2bf(x[cb][reg] + bs[reg]);
    }
    LDS_WAIT();
#pragma unroll
    for (int c = 0; c < 4; ++c) { const int ch = c * 64 + lane, row = ch >> 4, cc = ch & 15;
        float sp[8], gu[8]; unpack8(*(const LAS v4u*)(Sw + row * RP128 + 8 * cc), sp); unpack8(*(const v4u*)(GU + (r0 + i0 + row) * 512 + g * 128 + 8 * cc), gu);
        v4u w; w.x = pk2(sp[0] * gu[0], sp[1] * gu[1]); w.y = pk2(sp[2] * gu[2], sp[3] * gu[3]); w.z = pk2(sp[4] * gu[4], sp[5] * gu[5]); w.w = pk2(sp[6] * gu[6], sp[7] * gu[7]);
        *(v4u*)(YB + (r0 + i0 + row) * 1536 + 1024 + g * 128 + 8 * cc) = w; }
    __syncthreads();
}


constexpr int GP_WS = 0, GP_VNT = 69632;
__device__ __forceinline__ void gmlp_pair(Frame& F, int b, int n, int g0, const float* w_s, const float* b_s, const float* lng, const float* lnb) {
    int tid_ = threadIdx.x; asm volatile("" : "+v"(tid_));
    const int tid = tid_, lane = tid & 63, wid = __builtin_amdgcn_readfirstlane(tid >> 6), l15 = lane & 15, q4 = lane >> 4;
    const bf16* GU = (const bf16*)(F.ws + WS_GU); const bf16* GV = (const bf16*)(F.ws + WS_GV); bf16* YB = (bf16*)(F.ws + WS_YB); const float* GST = (const float*)(F.ws + WS_GST);
    LAS bf16* WsB = (LAS bf16*)(F.lds + RING_OFF + GP_WS); LAS bf16* VnTB = (LAS bf16*)(F.lds + RING_OFF + GP_VNT);
    const size_t r0 = (size_t)b * SEQ + (size_t)n * 128;
    const int sj = tid & 127, cq = tid >> 7, wi = tid >> 2, jq = tid & 3;
    v4u vreg[2][4]; f32x4 wreg[2][8];
#pragma unroll
    for (int u = 0; u < 2; ++u)
#pragma unroll
        for (int c = 0; c < 4; ++c) vreg[u][c] = *(const v4u*)(GV + (r0 + sj) * 512 + (g0 + u) * 128 + 32 * cq + 8 * c);
    const float mu = GST[2 * (r0 + sj)], rs = GST[2 * (r0 + sj) + 1];
#pragma unroll
    for (int u = 0; u < 2; ++u) { const float* wr = w_s + ((size_t)(g0 + u) * 128 + wi) * 128 + 32 * jq;
#pragma unroll
        for (int c = 0; c < 8; ++c) wreg[u][c] = *(const f32x4*)(wr + 4 * c); }
    __syncthreads();
#pragma unroll
    for (int u = 0; u < 2; ++u) { const int g = g0 + u; LAS bf16* Ws = WsB + u * (128 * RP128); LAS bf16* VnT = VnTB + u * (128 * RP128);
#pragma unroll
        for (int c = 0; c < 4; ++c) { const int j0 = 32 * jq + 8 * c; const f32x4 a = wreg[u][2 * c], bq = wreg[u][2 * c + 1];
            v4u w; w.x = pk2(j0 + 0 <= wi ? a.x : 0.f, j0 + 1 <= wi ? a.y : 0.f); w.y = pk2(j0 + 2 <= wi ? a.z : 0.f, j0 + 3 <= wi ? a.w : 0.f);
            w.z = pk2(j0 + 4 <= wi ? bq.x : 0.f, j0 + 5 <= wi ? bq.y : 0.f); w.w = pk2(j0 + 6 <= wi ? bq.z : 0.f, j0 + 7 <= wi ? bq.w : 0.f);
            *(LAS v4u*)(Ws + wi * RP128 + j0) = w; }
#pragma unroll
        for (int c = 0; c < 4; ++c) { float x[8]; unpack8(vreg[u][c], x);
            const f32x4 ga = *(const f32x4*)(lng + g * 128 + 32 * cq + 8 * c), gb = *(const f32x4*)(lng + g * 128 + 32 * cq + 8 * c + 4);
            const f32x4 ba = *(const f32x4*)(lnb + g * 128 + 32 * cq + 8 * c), bb = *(const f32x4*)(lnb + g * 128 + 32 * cq + 8 * c + 4);
            const float gm[8] = {ga.x, ga.y, ga.z, ga.w, gb.x, gb.y, gb.z, gb.w}, bt[8] = {ba.x, ba.y, ba.z, ba.w, bb.x, bb.y, bb.z, bb.w};
#pragma unroll
            for (int e = 0; e < 8; ++e) VnT[(32 * cq + 8 * c + e) * RP128 + sj] = (bf16)f2bf((x[e] - mu) * rs * gm[e] + bt[e]); }
    }
    LDS_WAIT(); __syncthreads();
    const int i0 = 16 * wid, nks = (wid + 2) >> 1;
#pragma unroll
    for (int u = 0; u < 2; ++u) { const int g = g0 + u; LAS bf16* Ws = WsB + u * (128 * RP128); LAS bf16* VnT = VnTB + u * (128 * RP128); LAS bf16* Sw = Ws + i0 * RP128;
        float bs[4];
#pragma unroll
        for (int reg = 0; reg < 4; ++reg) bs[reg] = b_s[g * 128 + i0 + 4 * q4 + reg];
        v4u gur[4];
#pragma unroll
        for (int c = 0; c < 4; ++c) { const int ch = c * 64 + lane, row = ch >> 4, cc = ch & 15; gur[c] = *(const v4u*)(GU + (r0 + i0 + row) * 512 + g * 128 + 8 * cc); }
        f32x4 x[8];
#pragma unroll
        for (int cb = 0; cb < 8; ++cb) x[cb] = (f32x4){0.f, 0.f, 0.f, 0.f};
#pragma unroll 1
        for (int ks = 0; ks < nks; ++ks) {
            const bf16x8_t a = ldfrag16(Ws, i0 + l15, RP128, ks, q4);
#pragma unroll
            for (int cb = 0; cb < 8; ++cb) x[cb] = MFMA16(a, ldfrag16(VnT, 16 * cb + l15, RP128, ks, q4), x[cb]);
        }
#pragma unroll
        for (int cb = 0; cb < 8; ++cb)
#pragma unroll
            for (int reg = 0; reg < 4; ++reg) Sw[(4 * q4 + reg) * RP128 + 16 * cb + l15] = (bf16)f2bf(x[cb][reg] + bs[reg]);
        LDS_WAIT();
#pragma unroll
        for (int c = 0; c < 4; ++c) { const int ch = c * 64 + lane, row = ch >> 4, cc = ch & 15;
            float sp[8], gu[8]; unpack8(*(const LAS v4u*)(Sw + row * RP128 + 8 * cc), sp); unpack8(gur[c], gu);
            v4u w; w.x = pk2(sp[0] * gu[0], sp[1] * gu[1]); w.y = pk2(sp[2] * gu[2], sp[3] * gu[3]); w.z = pk2(sp[4] * gu[4], sp[5] * gu[5]); w.w = pk2(sp[6] * gu[6], sp[7] * gu[7]);
            *(v4u*)(YB + (r0 + i0 + row) * 1536 + 1024 + g * 128 + 8 * cc) = w; }
    }
    __syncthreads();
}


__device__ __forceinline__ void moe_tail_unit(Frame& F, const MoeTiles& mt, int e, int rb, int cb) {
    int cnt, t0; mt.expert(e, cnt, t0);
    const int re = cnt & 255, nfull = cnt >> 8;
    if (64 * rb >= re) return;
    int tid_ = threadIdx.x; asm volatile("" : "+v"(tid_));
    const int tid = tid_, lane = tid & 63, wid = __builtin_amdgcn_readfirstlane(tid >> 6), l15 = lane & 15, q4 = lane >> 4;
    const int rl = 16 * (wid & 3), cl = 64 * (wid >> 2), srow = tid >> 3, sch = tid & 7;
    const unsigned char* Ag = (const unsigned char*)(F.ws + WS_HID) + ((size_t)(t0 + nfull) * 256 + 64 * rb + srow) * DFF_E + 16 * sch;
    const unsigned char* Bg = (const unsigned char*)(F.ws + WS_WMD) + ((size_t)e * 1024 + 128 * cb + srow) * DFF_E + 16 * sch;
    constexpr int TP = 272;
    LAS unsigned char* As = F.lds + RING_OFF; LAS unsigned char* Bs = F.lds + RING_OFF + 2 * 64 * TP;
    f32x4 acc[4] = {{0.f, 0.f, 0.f, 0.f}, {0.f, 0.f, 0.f, 0.f}, {0.f, 0.f, 0.f, 0.f}, {0.f, 0.f, 0.f, 0.f}};
    v4u ra[2][2], rbv[2][4];
#define TAIL_LOAD(s_, kt) do { ra[s_][0] = *(const v4u*)(Ag + 256 * (kt)); ra[s_][1] = *(const v4u*)(Ag + 256 * (kt) + 128); rbv[s_][0] = *(const v4u*)(Bg + 256 * (kt)); rbv[s_][1] = *(const v4u*)(Bg + 256 * (kt) + 128); \
        rbv[s_][2] = *(const v4u*)(Bg + (size_t)64 * DFF_E + 256 * (kt)); rbv[s_][3] = *(const v4u*)(Bg + (size_t)64 * DFF_E + 256 * (kt) + 128); } while (0)
#define TAIL_STEP(s_, kt) do { LAS unsigned char* as = As + (s_) * (64 * TP); LAS unsigned char* bs = Bs + (s_) * (128 * TP); \
        *(LAS v4u*)(as + srow * TP + 16 * sch) = ra[s_][0]; *(LAS v4u*)(as + srow * TP + 128 + 16 * sch) = ra[s_][1]; \
        *(LAS v4u*)(bs + srow * TP + 16 * sch) = rbv[s_][0]; *(LAS v4u*)(bs + srow * TP + 128 + 16 * sch) = rbv[s_][1]; \
        *(LAS v4u*)(bs + (srow + 64) * TP + 16 * sch) = rbv[s_][2]; *(LAS v4u*)(bs + (srow + 64) * TP + 128 + 16 * sch) = rbv[s_][3]; \
        LDS_WAIT(); __syncthreads(); \
        if ((kt) + 2 < DFF_E / 256) TAIL_LOAD(s_, (kt) + 2); \
        _Pragma("unroll") for (int kk = 0; kk < 2; ++kk) { \
            const LAS unsigned char* ap = as + (rl + l15) * TP + 128 * kk + 32 * q4; \
            const pg8::v8i_t a = __builtin_shufflevector(*(const LAS pg8::v4i_t*)ap, *(const LAS pg8::v4i_t*)(ap + 16), 0, 1, 2, 3, 4, 5, 6, 7); \
            _Pragma("unroll") for (int j = 0; j < 4; ++j) { const LAS unsigned char* bp = bs + (cl + 16 * j + l15) * TP + 128 * kk + 32 * q4; \
                const pg8::v8i_t b = __builtin_shufflevector(*(const LAS pg8::v4i_t*)bp, *(const LAS pg8::v4i_t*)(bp + 16), 0, 1, 2, 3, 4, 5, 6, 7); \
                acc[j] = __builtin_amdgcn_mfma_scale_f32_16x16x128_f8f6f4(a, b, acc[j], 0, 0, 0, 0x7f7f7f7f, 0, (int)E8_DN); } } } while (0)
    TAIL_LOAD(0, 0); TAIL_LOAD(1, 1);
    __syncthreads();
#pragma unroll 1
    for (int kt = 0; kt < DFF_E / 256; kt += 2) { TAIL_STEP(0, kt); TAIL_STEP(1, kt + 1); }
    static_assert((DFF_E / 256) % 2 == 0, "even number of K-steps");
#undef TAIL_LOAD
#undef TAIL_STEP
    const unsigned* list = (const unsigned*)(F.ws + WS_LIST); const float* gatew = (const float*)(F.ws + WS_GATEW);
    bf16* c0 = (bf16*)(F.ws + WS_YPRE); bf16* c1 = (bf16*)(F.ws + WS_C1);
#pragma unroll
    for (int reg = 0; reg < 4; ++reg) { const int r = 64 * rb + rl + 4 * q4 + reg;
        if (r < re) { const int slot = nfull * 256 + r; const unsigned ent = list[e * 16384 + slot]; const float g = gatew[e * 16384 + slot];
            bf16* dst = ((ent >> 31) ? c1 : c0) + (size_t)(ent & 0x7fffffffu) * 1024 + 128 * cb + cl + l15;
#pragma unroll
            for (int j = 0; j < 4; ++j) dst[16 * j] = (bf16)f2bf(acc[j][reg] * g); } }
    __syncthreads();
}


constexpr int CV_I_IN = 16 * 112, CV_I_BR = 8 * 16, CV_I_OUT = 16 * 16, CV_I_DU = 16 * 88, CV_I_DD = 44 * 16, CV_I_MU = 16 * 112, CV_I_MD = 56 * 16;
constexpr int CV_I_G8 = 16 * 48;
constexpr int CV_NITEMS = 2 * CV_I_IN + 6 * CV_I_BR + 2 * CV_I_OUT + CV_I_DU + CV_I_DD + 8 * CV_I_MU + 8 * CV_I_MD + ((GATES_FP8 && !P1_I8) ? 2 * CV_I_G8 : 0);
constexpr int CV_MD0 = 8 * CV_I_MU, CV_MD1 = 8 * CV_I_MU + 8 * CV_I_MD;
constexpr int CV_DEFER = 5 * CV_I_MU;
__device__ __forceinline__ void cvt_global_item(Frame& F, int it, LAS float* scr, int lane) {
    int r = it; bool done = false;
#pragma unroll 1
    for (int e = 0; e < 8 && !done; ++e) { CvtJob j{(const float*)(const GAS float*)lds_ptr(F.lds, 15) + (size_t)e * 1024 * 7168, 1024, 7168, 7168, (bf16*)(F.ws + WS_WMU + (size_t)e * 7168 * 1024), 1024, 0, 2, DFF_E, SC_WU8}; done = cvt_run(j, r, scr, lane); }
#pragma unroll 1
    for (int e = 0; e < 8 && !done; ++e) { CvtJob j{(const float*)(const GAS float*)lds_ptr(F.lds, 16) + (size_t)e * 3584 * 1024, 3584, 1024, 1024, (bf16*)(F.ws + WS_WMD + (size_t)e * 1024 * 3584), 3584, 0, 0, 0, SC_WD8}; done = cvt_run(j, r, scr, lane); }
#pragma unroll 1
    for (int l = 0; l < 2 && !done; ++l) { CvtJob j{(const float*)(const GAS float*)lds_ptr(F.lds, 1) + (size_t)l * 1024 * N_INSRC, 1024, N_INSRC, N_INV, (bf16*)(F.ws + WS_WIN) + (size_t)l * N_INV * 1024, 1024, 0, 1, 0, P1_I8 ? -SC_WI8 : 0.f}; done = cvt_run(j, r, scr, lane); }
#pragma unroll 1
    for (int q = 0; q < 6 && !done; ++q) { const int l = q / 3, n = q % 3; CvtJob j{(const float*)(const GAS float*)lds_ptr(F.lds, 8) + (size_t)q * 512 * 1024, 512, 1024, 1024, (bf16*)(F.ws + WS_WBR) + (size_t)l * 1024 * 1536, 1536, n * 512, 0, 0, 0.f}; done = cvt_run(j, r, scr, lane); }
#pragma unroll 1
    for (int l = 0; l < 2 && !done; ++l) { CvtJob j{(const float*)(const GAS float*)lds_ptr(F.lds, 9) + (size_t)l * 1024 * 1024, 1024, 1024, 1024, (bf16*)(F.ws + WS_WOUT) + (size_t)l * 1024 * 1024, 1024, 0, 0, 0, 0.f}; done = cvt_run(j, r, scr, lane); }
    if (!done) { CvtJob j{(const float*)(const GAS float*)lds_ptr(F.lds, 12), 1024, 2 * DFF_D, 2 * DFF_D, (bf16*)(F.ws + WS_WDU), 1024, 0, 2, DFF_D, (DENSE_FP8 == 4) ? -SC_WI8 : (DENSE_FP8 == 1 || DENSE_FP8 == 2) ? SC_WU8 : 0.f}; done = cvt_run(j, r, scr, lane); }
    if (!done) { CvtJob j{(const float*)(const GAS float*)lds_ptr(F.lds, 13), DFF_D, 1024, 1024, (bf16*)(F.ws + WS_WDD), DFF_D, 0, 0, 0, (DENSE_FP8 == 1 || DENSE_FP8 == 3) ? SC_WD8 : 0.f}; done = cvt_run(j, r, scr, lane); }
#if GATES_FP8 && !P1_I8
#pragma unroll 1
    for (int l = 0; l < 2 && !done; ++l) { CvtJob j{(const float*)(const GAS float*)lds_ptr(F.lds, 1) + (size_t)l * 1024 * N_INSRC, 1024, N_INSRC, 3072, (bf16*)(F.ws + WS_WIN8 + (size_t)l * 3072 * 1024), 1024, 0, 1, 0, SC_WU8, 4096}; done = cvt_run(j, r, scr, lane); }
#endif
}

struct Args { const float* in[17]; float* out; unsigned char* ws; int ph_lo, ph_hi; };
constexpr int N_PHASES = 17;

__global__ void __launch_bounds__(NWAVES * 64, 2) mega_fwd(Args args) {
    extern __shared__ __attribute__((aligned(16))) unsigned char lds[];
    Frame F;
    F.lds = (LAS unsigned char*)lds;
    F.MISC = (volatile LAS unsigned*)(F.lds + MISC_OFF);
    F.tid = threadIdx.x; F.lane = F.tid & 63; F.wave = __builtin_amdgcn_readfirstlane(F.tid >> 6);
    F.G = gridDim.x; { const int bx = blockIdx.x; F.vcu = (F.G % 8 == 0) ? (bx % 8) * (F.G / 8) + bx / 8 : bx; }
    F.ws = args.ws; F.ctl = (gu32*)(args.ws + WS_CTL);
    for (int u = F.tid; u < (LDS_BYTES - LDSCTL_OFF) / 4; u += NWAVES * 64) ((LAS unsigned*)(F.lds + LDSCTL_OFF))[u] = 0u;
    __syncthreads();
    XcdBarrier bar = xcd_barrier_post((unsigned*)(F.ctl + CW_BAR), F.MISC + 8, gridDim.x, 0u);
    const bool grp = (F.G == 256);
    XcdBarrier gbar = bar;
    if (grp) gbar = xcd_barrier_post((unsigned*)(F.ctl + CW_BAR) + (1 + (blockIdx.x & 7)) * XCD_BAR_WORDS, F.MISC + 10, 32u, 1u);
#define GRID_BAR() xcd_barrier(bar)
#define GRP_BAR() do { if (grp) xcd_barrier(gbar); else xcd_barrier(bar); } while (0)
    const int lo = args.ph_lo, hi = args.ph_hi;
#ifndef PH_MASK
#define PH_MASK 0x1ff
#endif
#define IN(k) (lo <= (k) && (k) < hi)
#ifndef DUP_PHASE
#define DUP_PHASE (-1)
#endif
#define REPS(k) (((k) == DUP_PHASE) ? 2 : 1)
#ifndef P2DUP
#define P2DUP 0
#endif
#define PHASE_BEGIN() do { int t_ = threadIdx.x; asm volatile("" : "+v"(t_)); F.tid = t_; F.lane = t_ & 63; F.wave = __builtin_amdgcn_readfirstlane(t_ >> 6); } while (0)
#define ON(j) (((PH_MASK) >> (j)) & 1)
#define SEAM(k) do { if (IN(k) && IN((k) + 1)) GRID_BAR(); } while (0)
#define SEAMG(k) do { if (IN(k) && IN((k) + 1)) GRP_BAR(); } while (0)

    if (F.tid == 0) { LAS unsigned long long* pt = (LAS unsigned long long*)(F.lds + PTAB_OFF);
#pragma unroll
        for (int i = 0; i < 17; ++i) pt[i] = (unsigned long long)args.in[i];
        pt[17] = (unsigned long long)args.out; }
    LDS_WAIT(); __syncthreads();
#define INP(k) ((const float*)(const GAS float*)lds_ptr(F.lds, (k)))
    if (ON(0) && IN(0)) { for (int rep_ = 0; rep_ < REPS(0); ++rep_) { PHASE_BEGIN();
        LAS float* scr = (LAS float*)(F.lds + RING_OFF + F.wave * 17408);
        static_assert(NWAVES * 17408 <= RING_BYTES, "conversion tiles fit the phase scratch");
        const int gw = F.vcu * NWAVES + F.wave, NGW = F.G * NWAVES;
        for (int it = CV_DEFER + gw; it < CV_NITEMS - (CV_MD1 - CV_MD0); it += NGW) { const int jt = it < CV_MD0 ? it : it + (CV_MD1 - CV_MD0); cvt_global_item(F, jt, scr, F.lane); }
        __syncthreads();
        { float* cs = (float*)(F.ws + WS_CS);
          for (int i = F.vcu * 512 + F.tid; i < SEQ * 32; i += F.G * 512) { const int pos = i >> 5, d = i & 31;
              const double rev = (double)pos * exp(-(double)d / 32.0 * 9.210340371976184) * 0.15915494309189535; const float fr_ = (float)(rev - floor(rev));
              cs[i] = __builtin_amdgcn_cosf(fr_); cs[65536 + i] = __builtin_amdgcn_sinf(fr_); } }
        p0_rows(F, INP(0), INP(1), INP(2));
    } }
    SEAM(0);

#pragma unroll 1
    for (int l = 0; l < 2; ++l) {
        const int pb = 1 + 8 * l;
        const float* xres = (l == 0) ? INP(0) : ((float*)(F.ws + WS_XF));
        if (ON(1) && IN(pb + 0)) { for (int rep_ = 0; rep_ < REPS(pb + 0); ++rep_) { PHASE_BEGIN();
            const bool g8 = (GATES_FP8 == 2) || (GATES_FP8 == 1 && l == 1);
#if P1_I8
            {
                ProjSched S; S.init(M / 256, 16, F.G, (int)blockIdx.x); S.A = (const bf16*)(F.ws + WS_X8IN); S.Bt = (const bf16*)(F.ws + WS_WIN) + (size_t)l * N_INV * 1024; S.K = 1024; S.esz = 1;
                EpiProjT<true> E{F.ws, INP(3) + l * 3072, ((const float*)(F.ws + WS_CS))};
                pg8::gemm_phase<EpiProjT<true>, ProjSched, 1u>(F.lds + RING_OFF, 1024, S, E);
                pg8::PlainSched S8; S8.init(M / 256, 12, F.G, (int)blockIdx.x); S8.A = (const bf16*)(F.ws + WS_X8IN); S8.Bt = (const bf16*)((const unsigned char*)((const bf16*)(F.ws + WS_WIN) + (size_t)l * N_INV * 1024) + (size_t)4096 * 1024); S8.K = 1024; S8.esz = 1;
                EpiGate8T<true> E8{(bf16*)(F.ws + WS_GT), INP(3) + l * 3072};
                pg8::gemm_phase<EpiGate8T<true>, pg8::PlainSched, 1u>(F.lds + RING_OFF, 1024, S8, E8);
            }
#else
            ProjSched S; S.init(M / 256, g8 ? 16 : N_INV / 256, F.G, (int)blockIdx.x); S.A = ((bf16*)(F.ws + WS_XB)); S.Bt = (const bf16*)(F.ws + WS_WIN) + (size_t)l * N_INV * 1024; S.K = 1024;
            EpiProj E{F.ws, INP(3) + l * 3072, ((const float*)(F.ws + WS_CS))};
            pg8::gemm_phase<EpiProj, ProjSched>(F.lds + RING_OFF, 1024, S, E);
#if GATES_FP8
            if (g8) {
                pg8::PlainSched S8; S8.init(M / 256, 12, F.G, (int)blockIdx.x); S8.A = (const bf16*)(F.ws + WS_X8IN); S8.Bt = (const bf16*)(F.ws + WS_WIN8 + (size_t)l * 3072 * 1024); S8.K = 1024; S8.esz = 1;
                EpiGate8 E8{(bf16*)(F.ws + WS_GT), INP(3) + l * 3072};
                pg8::gemm_phase<EpiGate8, pg8::PlainSched, E8_UP>(F.lds + RING_OFF, 1024, S8, E8);
            }
#endif
#endif
        } }
        SEAMG(pb + 0);
        if (ON(2) && IN(pb + 1)) { for (int rep_ = 0; rep_ < REPS(pb + 1); ++rep_) { PHASE_BEGIN();
            {
#if NAIVE_FOX
            LAS float* tab = (LAS float*)(F.lds + RING_OFF + 4096); LAS float* wtot = (LAS float*)(F.lds + RING_OFF + 4096 + 8192);
            for (int uu = F.vcu; uu < 64 * 8; uu += F.G) {
                const int bh = uu >> 3, qb = uu & 7, b = bh >> 3, h = bh & 7;
                fox_bias_table<false>(F, b, h, tab, wtot);
                for (int r = F.wave; r < 256; r += NWAVES) naive_fox_row(F, b, h, qb * 256 + r, tab);
                __syncthreads();
            }
#else
            LAS float* tab = (LAS float*)(F.lds + RING_OFF + 86016); LAS float* wtot = (LAS float*)(F.lds + RING_OFF + 86016 + 32768);
            static_assert(attn_body::ATTN_LDS_BYTES <= 86016 && 86016 + 32768 + 64 <= RING_BYTES, "attention scratch below the bias rows");
            for (int d_ = 0; d_ < ((P2DUP & 1) ? 2 : 1); ++d_)
            for (int pp = F.vcu; pp < 256; pp += F.G) {
                const int bh = pp >> 2, sq = pp & 3, b = bh >> 3, h = bh & 7;
                fox_bias_table<true>(F, b, h, tab, wtot);
#pragma unroll 1
                for (int i = 0; i < 2; ++i)
                    attn_body::attn_unit<8>(b, h, i ? 7 - sq : sq, (const attn_body::bf16*)(F.ws + WS_FQ), (const attn_body::bf16*)(F.ws + WS_FK), (const attn_body::bf16*)(F.ws + WS_FV), (attn_body::bf16*)(F.ws + WS_YB), (char*)lds + RING_OFF, (attn_body::lds_tabptr)tab);
            }
            __syncthreads();
#endif
            }
#if NAIVE_RET == 1
            { const int gw = F.vcu * NWAVES + F.wave, NGW = F.G * NWAVES;
              for (int idx = gw; idx < BATCH * 4 * SEQ; idx += NGW) { const int t = idx & (SEQ - 1), bh = idx >> 11; naive_ret_row(F, bh >> 2, bh & 3, t); } }
#endif
#if NAIVE_GMLP == 1
            for (int uu = F.vcu; uu < BATCH * 16 * 4; uu += F.G) { const int g = uu & 3, n = (uu >> 2) & 15, b = uu >> 6;
                naive_gmlp_unit(F, b, n, g, INP(4) + (size_t)l * 4 * 128 * 128, INP(5) + l * 512, INP(6) + l * 512, INP(7) + l * 512); }
#endif
#if MK_N_LAUNCHES == 1 && NAIVE_RET == 0 && NAIVE_GMLP == 0
            for (int d_ = 0; d_ < ((P2DUP & 2) ? 2 : 1); ++d_)
            for (int uu = 2 * F.vcu; uu < 512; uu += 2 * F.G) {
#pragma unroll 1
                for (int q = 0; q < 2; ++q) { const int un = uu + q, bh = un >> 4; ret_kv_unit(F, bh >> 2, bh & 3, un & 15); } }
            if (grp) { if ((F.vcu & 31) < 16) gmlp_stat_unit(F, F.vcu >> 5, F.vcu & 31); }
            else for (int uu = F.vcu; uu < 128; uu += F.G) gmlp_stat_unit(F, uu >> 4, uu & 15);
            GRP_BAR();
            for (int d_ = 0; d_ < ((P2DUP & 4) ? 2 : 1); ++d_)
            for (int pp = F.vcu; pp < 256; pp += F.G) { const int bh = pp >> 3, sq = pp & 7;
#pragma unroll 1
                for (int q = 0; q < 2; ++q) ret_out_unit(F, bh >> 2, bh & 3, q ? 15 - sq : sq); }
            for (int d_ = 0; d_ < ((P2DUP & 8) ? 2 : 1); ++d_)
            for (int uu = F.vcu; uu < 256; uu += F.G) gmlp_pair(F, uu >> 5, (uu >> 1) & 15, (uu & 1) * 2, INP(4) + (size_t)l * 4 * 128 * 128, INP(5) + l * 512, INP(6) + l * 512, INP(7) + l * 512);
#else
            for (int uu = F.vcu; uu < 256; uu += F.G) {
                if (uu < 128) {
#if NAIVE_RET == 0
                    ret_unit(F, uu >> 4, (uu >> 2) & 3, uu & 3);
#endif
                } else {
#if NAIVE_GMLP == 0
#pragma unroll 1
                    for (int q = 0; q < 4; ++q) { const int gu = (uu - 128) * 4 + q; gmlp_unit(F, gu >> 6, (gu >> 2) & 15, gu & 3, INP(4) + (size_t)l * 4 * 128 * 128, INP(5) + l * 512, INP(6) + l * 512, INP(7) + l * 512); }
#endif
                }
            }
#endif
        } }
        SEAMG(pb + 1);
        if (ON(3) && IN(pb + 2)) { for (int rep_ = 0; rep_ < REPS(pb + 2); ++rep_) { PHASE_BEGIN();
            pg8::PlainSched S; S.init(M / 256, 4, F.G, (int)blockIdx.x); S.A = ((bf16*)(F.ws + WS_YB)); S.Bt = (const bf16*)(F.ws + WS_WBR) + (size_t)l * 1024 * 1536; S.K = 1536;
            EpiMerge E{(const bf16*)(F.ws + WS_GT), ((bf16*)(F.ws + WS_MRG))};
            pg8::gemm_phase<EpiMerge, pg8::PlainSched>(F.lds + RING_OFF, 1536, S, E);
        } }
        SEAMG(pb + 2);
        if (ON(4) && IN(pb + 3)) { for (int rep_ = 0; rep_ < REPS(pb + 3); ++rep_) { PHASE_BEGIN();
            pg8::PlainSched S; S.init(M / 256, 4, F.G, (int)blockIdx.x); S.A = ((bf16*)(F.ws + WS_MRG)); S.Bt = (const bf16*)(F.ws + WS_WOUT) + (size_t)l * 1024 * 1024; S.K = 1024;
            EpiResid E{xres, ((float*)(F.ws + WS_YPRE))};
            pg8::gemm_phase<EpiResid, pg8::PlainSched>(F.lds + RING_OFF, 1024, S, E);
        } }
        SEAMG(pb + 3);
        if (ON(5) && IN(pb + 4)) { for (int rep_ = 0; rep_ < REPS(pb + 4); ++rep_) { PHASE_BEGIN();
            if (l == 0) ln_pass<0>(F, ((float*)(F.ws + WS_YPRE)), 1.f, nullptr, nullptr, INP(10) + (l * 2 + 0) * 1024, INP(11) + (l * 2 + 0) * 1024, ((float*)(F.ws + WS_XF)), (DENSE_FP8 == 1 || DENSE_FP8 == 2 || DENSE_FP8 == 4) ? nullptr : ((bf16*)(F.ws + WS_XB)), (DENSE_FP8 == 1 || DENSE_FP8 == 2 || DENSE_FP8 == 4) ? (unsigned char*)(F.ws + WS_XB) : nullptr, nullptr, 0, 0, nullptr, grp, (DENSE_FP8 == 4) ? -SC_XI8 : SC_X8);
            else ln_pass<2>(F, ((float*)(F.ws + WS_YPRE)), 1.f, nullptr, nullptr, INP(10) + (l * 2 + 0) * 1024, INP(11) + (l * 2 + 0) * 1024, ((float*)(F.ws + WS_XF)), nullptr, (unsigned char*)(F.ws + WS_XB), INP(14), 8, 0, nullptr, grp);
        } }
        if (l == 0) SEAMG(pb + 4); else SEAM(pb + 4);
        if (ON(6) && IN(pb + 5)) { for (int rep_ = 0; rep_ < REPS(pb + 5); ++rep_) { PHASE_BEGIN();
            if (l == 0) {
                pg8::PlainSched S; S.init(M / 256, 2 * DFF_D / 256, F.G, (int)blockIdx.x); S.A = ((bf16*)(F.ws + WS_XB)); S.Bt = (const bf16*)(F.ws + WS_WDU); S.K = 1024;
#if DENSE_FP8 == 1
                S.esz = 1; EpiSwiglu8 E{(unsigned char*)(F.ws + WS_HID), DFF_D};
                pg8::gemm_phase<EpiSwiglu8, pg8::PlainSched, E8_UP>(F.lds + RING_OFF, 1024, S, E);
#elif DENSE_FP8 == 2
                S.esz = 1; EpiSwiglu E{((bf16*)(F.ws + WS_HID)), DFF_D};
                pg8::gemm_phase<EpiSwiglu, pg8::PlainSched, E8_UP>(F.lds + RING_OFF, 1024, S, E);
#elif DENSE_FP8 == 4
                S.esz = 1; EpiSwigluI8 E{((bf16*)(F.ws + WS_HID)), DFF_D};
                pg8::gemm_phase<EpiSwigluI8, pg8::PlainSched, 1u>(F.lds + RING_OFF, 1024, S, E);
#elif DENSE_FP8 == 3
                EpiSwiglu8 E{(unsigned char*)(F.ws + WS_HID), DFF_D};
                pg8::gemm_phase<EpiSwiglu8, pg8::PlainSched>(F.lds + RING_OFF, 1024, S, E);
#else
                EpiSwiglu E{((bf16*)(F.ws + WS_HID)), DFF_D};
                pg8::gemm_phase<EpiSwiglu, pg8::PlainSched>(F.lds + RING_OFF, 1024, S, E);
#endif
                if (F.G == 256 && blockIdx.x >= 128) {
                    LAS float* scr = (LAS float*)(F.lds + RING_OFF + F.wave * 17408);
                    for (int it = ((int)blockIdx.x - 128) * NWAVES + F.wave; it < CV_DEFER; it += 128 * NWAVES) cvt_global_item(F, it, scr, F.lane);
                } else if (F.G != 256) {
                    LAS float* scr = (LAS float*)(F.lds + RING_OFF + F.wave * 17408);
                    for (int it = F.vcu * NWAVES + F.wave; it < CV_DEFER; it += F.G * NWAVES) cvt_global_item(F, it, scr, F.lane);
                }
                __syncthreads();
            } else {
                MoeTiles mt; mt.init(F.ctl);
                MoeUpSched S; S.init(mt.toff[NEXP], 2 * DFF_E / 256, F.G, (int)blockIdx.x); S.A = (const unsigned char*)(F.ws + WS_XB); S.Bt = (const unsigned char*)(F.ws + WS_WMU); S.list = (const unsigned*)(F.ws + WS_LIST); S.mt = mt;
                EpiSwiglu8 E{(unsigned char*)(F.ws + WS_HID), DFF_E};
                pg8::gemm_phase<EpiSwiglu8, MoeUpSched, E8_UP>(F.lds + RING_OFF, 1024, S, E);
                {
                    LAS float* scr = (LAS float*)(F.lds + RING_OFF + F.wave * 17408);
                    const int nwg = mt.toff[NEXP] * (2 * DFF_E / 256), rounds = (nwg + F.G - 1) / F.G, rem = nwg - (rounds - 1) * F.G, nidle = F.G - rem;
                    constexpr int NMD = CV_MD1 - CV_MD0;
                    int q = 0; if (nidle > 0) { q = (NMD + nidle * NWAVES - 1) / (nidle * NWAVES); if (q > 6) q = 6; }
                    int first = nidle * NWAVES * q; if (first > NMD) first = NMD;
                    if ((int)blockIdx.x >= rem) for (int it = ((int)blockIdx.x - rem) * NWAVES + F.wave; it < first; it += nidle * NWAVES) cvt_global_item(F, CV_MD0 + it, scr, F.lane);
                    for (int it = first + (int)blockIdx.x * NWAVES + F.wave; it < NMD; it += F.G * NWAVES) cvt_global_item(F, CV_MD0 + it, scr, F.lane);
                    __syncthreads();
                }
            }
        } }
        if (l == 0) SEAMG(pb + 5); else SEAM(pb + 5);
        if (ON(7) && IN(pb + 6)) { for (int rep_ = 0; rep_ < REPS(pb + 6); ++rep_) { PHASE_BEGIN();
            if (l == 0) {
                pg8::PlainSched S; S.init(M / 256, 4, F.G, (int)blockIdx.x); S.A = ((bf16*)(F.ws + WS_HID)); S.Bt = (const bf16*)(F.ws + WS_WDD); S.K = DFF_D;
                EpiResid E{((float*)(F.ws + WS_XF)), ((float*)(F.ws + WS_YPRE))};
#if DENSE_FP8 == 1 || DENSE_FP8 == 3
                S.esz = 1; pg8::gemm_phase<EpiResid, pg8::PlainSched, E8_DN>(F.lds + RING_OFF, DFF_D, S, E);
#else
                pg8::gemm_phase<EpiResid, pg8::PlainSched>(F.lds + RING_OFF, DFF_D, S, E);
#endif
            } else {
                MoeTiles mt; mt.init(F.ctl);
                MoeDownSched S; S.init(mt.nfull_total(), 4, F.G, (int)blockIdx.x); S.A = (const unsigned char*)(F.ws + WS_HID); S.Bt = (const unsigned char*)(F.ws + WS_WMD); S.mt = mt;
                EpiMoeDown E{((bf16*)(F.ws + WS_YPRE)), ((bf16*)(F.ws + WS_C1)), (const unsigned*)(F.ws + WS_LIST), (const float*)(F.ws + WS_GATEW), mt};
                pg8::gemm_phase<EpiMoeDown, MoeDownSched, E8_DN>(F.lds + RING_OFF, DFF_E, S, E);
                for (int tu = F.vcu; tu < 256; tu += F.G) moe_tail_unit(F, mt, tu >> 5, (tu >> 3) & 3, tu & 7);
            }
        } }
        if (l == 0) SEAMG(pb + 6); else SEAM(pb + 6);
        if (ON(8) && IN(pb + 7)) { for (int rep_ = 0; rep_ < REPS(pb + 7); ++rep_) { PHASE_BEGIN();
            if (l == 0) ln_pass<1>(F, ((float*)(F.ws + WS_YPRE)), 1.f, nullptr, nullptr, INP(10) + (l * 2 + 1) * 1024, INP(11) + (l * 2 + 1) * 1024, ((float*)(F.ws + WS_XF)), P1_I8 ? nullptr : ((bf16*)(F.ws + WS_XB)), GATES_FP8 ? (unsigned char*)(F.ws + WS_X8IN) : nullptr, INP(1) + (size_t)1 * 1024 * N_INSRC, N_INSRC, FL_COL, INP(2) + 8, grp, P1_I8 ? -SC_XI8 : SC_X8);
            else ln_pass<0>(F, ((float*)(F.ws + WS_XF)), ALPHA, (const bf16*)(F.ws + WS_YPRE), (const bf16*)(F.ws + WS_C1), INP(10) + (l * 2 + 1) * 1024, INP(11) + (l * 2 + 1) * 1024, (float*)(GAS float*)lds_ptr(F.lds, 17), nullptr, nullptr, nullptr, 0, 0, nullptr, grp);
        } }
        if (l == 0) SEAMG(pb + 7);
    }
#undef IN
#undef SEAM
}

extern "C" void kernel_launch(void* const* d_in, const int* in_sizes, int n_in, void* d_out, int out_size, void* d_ws, size_t ws_size, hipStream_t stream) {
    static int grid = 0;
    if (grid == 0) {
        if (n_in != 17 || in_sizes[0] != M * D || out_size != M * D || ws_size < WS_END) { fprintf(stderr, "kernel_launch: unexpected shapes / workspace (%zu)\n", ws_size); grid = -1; return; }
        int dev = 0, cus = 0, per_cu = 0;
        if (hipGetDevice(&dev) != hipSuccess || hipDeviceGetAttribute(&cus, hipDeviceAttributeMultiprocessorCount, dev) != hipSuccess) { grid = -1; return; }
        if (hipFuncSetAttribute((const void*)mega_fwd, hipFuncAttributeMaxDynamicSharedMemorySize, LDS_BYTES) != hipSuccess) { grid = -1; return; }
        if (hipOccupancyMaxActiveBlocksPerMultiprocessor(&per_cu, (const void*)mega_fwd, NWAVES * 64, LDS_BYTES) != hipSuccess || per_cu < 1) { fprintf(stderr, "kernel_launch: occupancy query says %d\n", per_cu); }
        (void)hipGetLastError();
        grid = cus;
    }
    if (grid < 0) return;
    if (hipMemsetAsync((char*)d_ws + WS_CTL, 0, CTL_ZERO_BYTES, stream) != hipSuccess) return;
    Args a{};
    for (int i = 0; i < 17; ++i) a.in[i] = (const float*)d_in[i];
    a.out = (float*)d_out; a.ws = (unsigned char*)d_ws;
#if MK_N_LAUNCHES == 1
    a.ph_lo = 0; a.ph_hi = N_PHASES;
    hipLaunchKernelGGL(mega_fwd, dim3(grid), dim3(NWAVES * 64), LDS_BYTES, stream, a);
#else
    for (int p = 0; p < N_PHASES; ++p) { a.ph_lo = p; a.ph_hi = p + 1; hipLaunchKernelGGL(mega_fwd, dim3(grid), dim3(NWAVES * 64), LDS_BYTES, stream, a); }
#endif
}
```

```cpp
#include <hip/hip_runtime.h>
#include <cstdio>
#include <cstdint>
#include <hip/hip_bf16.h>
#include <cmath>

#ifndef MK_N_LAUNCHES
#define MK_N_LAUNCHES 1
#endif
#ifndef DENSE_FP8
#define DENSE_FP8 4
#endif
#ifndef P1_I8
#define P1_I8 1
#endif
#ifndef P4_I8
#define P4_I8 1
#endif
#ifndef GATES_FP8
#define GATES_FP8 2
#endif
#ifndef NAIVE_FOX
#define NAIVE_FOX 0
#endif
#ifndef NAIVE_RET
#define NAIVE_RET 0
#endif
#ifndef NAIVE_GMLP
#define NAIVE_GMLP 0
#endif

namespace pg8 {
#define PG8_LAS __attribute__((address_space(3)))
typedef unsigned short bf16_t;
typedef short bf16x8 __attribute__((ext_vector_type(8)));
typedef float f32x4 __attribute__((ext_vector_type(4)));
typedef float f32x2 __attribute__((ext_vector_type(2)));
typedef unsigned u32x4 __attribute__((ext_vector_type(4)));
typedef unsigned u32x2 __attribute__((ext_vector_type(2)));
constexpr int BM = 256, BK = 64, HALF = 128, HTB = HALF * BK * 2  , STAGE_BYTES = 8 * HTB, NXCD = 8, WGM = 4;

__host__ __device__ __forceinline__ int lds_byte(int r, int c) { const int st = (r >> 4) * 2 + (c >> 5), rr = r & 15, cc = c & 31, ob = rr * 64 + cc * 2; return st * 1024 + (ob ^ (((ob >> 9) & 1) << 5)); }
__host__ __device__ __forceinline__ void stage_rc(int b, int& R, int& C) { const int st = b / 1024, sb = b % 1024, swz = sb ^ (((sb >> 9) & 1) << 5); R = (st >> 1) * 16 + swz / 64; C = (st & 1) * 32 + (swz % 64) / 2; }
__host__ __device__ __forceinline__ int perm32(int rho) { const int n = rho >> 4, i = rho & 15; return 8 * (i >> 2) + 4 * n + (i & 3); }

struct Unit { int pm, pn; };

struct TileOrder {
    int nM, nN, nwg, G, c;
    __device__ __forceinline__ void init(int nM_, int nN_, int G_, int c_) { nM = nM_; nN = nN_; nwg = nM * nN; G = G_; c = c_; }
    __device__ __forceinline__ bool next(int i, Unit& u) const {
        const long L = (long)i * G + c; if (L >= nwg) return false;
        int wgid = (int)L; { const int q = nwg / NXCD, r = nwg % NXCD, xcd = wgid % NXCD, off = wgid / NXCD; wgid = (xcd < r ? xcd * (q + 1) : r * (q + 1) + (xcd - r) * q) + off; }
        const int nig = WGM * nN, gid = wgid / nig, fm = gid * WGM, gsz = (nM - fm) < WGM ? (nM - fm) : WGM;
        u.pm = fm + ((wgid % nig) % gsz); u.pn = (wgid % nig) / gsz; return true;
    }
};
struct PlainSched : TileOrder {
    static constexpr bool GATHER = false;
    const bf16_t* A; const bf16_t* Bt; int K; int esz = 2;
    __device__ __forceinline__ const char* abase(const Unit& u) const { return (const char*)A + (size_t)u.pm * BM * K * esz; }
    __device__ __forceinline__ void aoffs_load(const Unit&, const int (&)[2], PG8_LAS unsigned*) const {}
    __device__ __forceinline__ void aoffs_fin(const Unit&, const int (&)[2], const int (&)[2], const PG8_LAS unsigned*, int, unsigned (&)[2][2]) const {}
    __device__ __forceinline__ void aoffs(const Unit&, const int (&R)[2], const int (&C)[2], unsigned (&o)[2][2]) const {
#pragma unroll
        for (int h = 0; h < 2; ++h)
#pragma unroll
            for (int i = 0; i < 2; ++i) o[h][i] = (unsigned)((R[i] + h * HALF) * K + C[i]) * 2u; }
    __device__ __forceinline__ const char* bbase(const Unit& u) const { return (const char*)Bt + (size_t)u.pn * BM * K * esz; }
};

typedef __bf16 bf16x2_v __attribute__((ext_vector_type(2)));
__device__ __forceinline__ unsigned cvt_pk_bf16(float lo, float hi) { f32x2 v = {lo, hi}; bf16x2_v b = __builtin_convertvector(v, bf16x2_v); return __builtin_bit_cast(unsigned, b); }

typedef float f32x2_pk __attribute__((ext_vector_type(2)));
__device__ __forceinline__ f32x4 zero4() { f32x2_pk lo, hi; asm volatile("v_pk_mov_b32 %0, 0, 0" : "=v"(lo)); asm volatile("v_pk_mov_b32 %0, 0, 0" : "=v"(hi)); return __builtin_shufflevector(lo, hi, 0, 1, 2, 3); }
typedef int v4i_t __attribute__((ext_vector_type(4)));
typedef int v8i_t __attribute__((ext_vector_type(8)));
__host__ __device__ __forceinline__ int lds_byte8(int r, int g) { const int st = (r >> 4) * 2 + (g >> 1), ob = (r & 15) * 64 + 32 * (g & 1); return st * 1024 + (ob ^ (((ob >> 9) & 1) << 5)); }
template <class Epi, class Sched, unsigned FP8S = 0u>
__device__ __forceinline__ void gemm_phase(PG8_LAS unsigned char* lds, const int K, const Sched& S, const Epi& E) {
    constexpr bool F8 = FP8S != 0u;
    constexpr bool I8 = FP8S == 1u;
    int tid_ = threadIdx.x; asm volatile("" : "+v"(tid_));
    const int tid = tid_, wid = __builtin_amdgcn_readfirstlane(tid >> 6), lane = tid & 63, wr = wid >> 2, wc = wid & 3, fr = lane & 15, fq = lane >> 4;
    const int nt = F8 ? K / 128 : K / BK;
    int Rs[2], Cs[2]; unsigned voffA[2], voffB[2];
#pragma unroll
    for (int i = 0; i < 2; ++i) { int R, C; stage_rc(tid * 16 + i * 8192, R, C); Rs[i] = R; Cs[i] = C; const int Rb = Epi::PERM ? ((R & ~31) + perm32(R & 31)) : R;
        voffA[i] = F8 ? (unsigned)(R * K + 2 * C) : (unsigned)(R * K + C) * 2u; voffB[i] = F8 ? (unsigned)(Rb * K + 2 * C) : (unsigned)(Rb * K + C) * 2u; }
    const size_t kstep = (size_t)(BK * 2);
    const size_t hstep = (size_t)HALF * K * (F8 ? 1 : 2);
    const unsigned ldsw = (unsigned)wid * 1024u;
    const int aoff = lds_byte(wr * 64 + fr, fq * 8), boff = lds_byte(wc * 32 + fr, fq * 8);
#define PG8_SA(b, h) (((b) * 2 + (h)) * HTB)
#define PG8_SB(b, h) ((4 + (b) * 2 + (h)) * HTB)
#define PG8_STAGE(bufoff, gbase, voff) do { _Pragma("unroll") for (int _i = 0; _i < 2; ++_i) \
        __builtin_amdgcn_global_load_lds((const unsigned*)((const char*)(gbase) + (voff)[_i]), (PG8_LAS unsigned*)(lds + (bufoff) + ldsw + _i * 8192), 16, 0, 0); } while (0)
#define PG8_STA(bufoff, gbase, h, nx) do { if constexpr (Sched::GATHER) { _Pragma("unroll") for (int _i = 0; _i < 2; ++_i) { const unsigned o_ = (nx) ? nof[h][_i] : cof[h][_i]; \
        __builtin_amdgcn_global_load_lds((const unsigned*)((const char*)(gbase) + o_), (PG8_LAS unsigned*)(lds + (bufoff) + ldsw + _i * 8192), 16, 0, 0); } } \
        else { PG8_STAGE(bufoff, (gbase) + (h) * hstep, voffA); } } while (0)
#define PG8_LDA(dst, b, h) do { _Pragma("unroll") for (int m = 0; m < 4; ++m) _Pragma("unroll") for (int k = 0; k < 2; ++k) dst[m][k] = *(const PG8_LAS bf16x8*)(lds + PG8_SA(b, h) + aoff + m * 2048 + k * 1024); } while (0)
#define PG8_LDB(dst, b, h) do { _Pragma("unroll") for (int n = 0; n < 2; ++n) _Pragma("unroll") for (int k = 0; k < 2; ++k) dst[n][k] = *(const PG8_LAS bf16x8*)(lds + PG8_SB(b, h) + boff + n * 2048 + k * 1024); } while (0)
#define PG8_MMA(ai, bj, At, Bt) do { __builtin_amdgcn_s_setprio(1); _Pragma("unroll") for (int m = 0; m < 4; ++m) _Pragma("unroll") for (int n = 0; n < 2; ++n) _Pragma("unroll") for (int k = 0; k < 2; ++k) \
        acc[ai][bj][m][n] = __builtin_amdgcn_mfma_f32_16x16x32_bf16(Bt[n][k], At[m][k], acc[ai][bj][m][n], 0, 0, 0); __builtin_amdgcn_s_setprio(0); } while (0)
#define PG8_LD32(p) __builtin_shufflevector(*(const PG8_LAS v4i_t*)(p), *(const PG8_LAS v4i_t*)((p) + 1024), 0, 1, 2, 3, 4, 5, 6, 7)
#define PG8_LDA8(dst, b, h) do { _Pragma("unroll") for (int m = 0; m < 4; ++m) dst[m] = PG8_LD32(lds + PG8_SA(b, h) + aoff + m * 2048); } while (0)
#define PG8_LDB8(dst, b, h) do { _Pragma("unroll") for (int n = 0; n < 2; ++n) dst[n] = PG8_LD32(lds + PG8_SB(b, h) + boff + n * 2048); } while (0)
#define PG8_MMA8(ai, bj, At, Bt) do { __builtin_amdgcn_s_setprio(1); \
        if constexpr (I8) {   \
            _Pragma("unroll") for (int m = 0; m < 4; ++m) _Pragma("unroll") for (int n = 0; n < 2; ++n) \
                asm volatile("v_mfma_i32_16x16x64_i8 %0, %1, %2, %0" : "+v"(acc[ai][bj][m][n]) : "v"(__builtin_shufflevector(Bt[n], Bt[n], 0, 1, 2, 3)), "v"(__builtin_shufflevector(At[m], At[m], 0, 1, 2, 3))); \
            _Pragma("unroll") for (int m = 0; m < 4; ++m) _Pragma("unroll") for (int n = 0; n < 2; ++n) \
                asm volatile("v_mfma_i32_16x16x64_i8 %0, %1, %2, %0" : "+v"(acc[ai][bj][m][n]) : "v"(__builtin_shufflevector(Bt[n], Bt[n], 4, 5, 6, 7)), "v"(__builtin_shufflevector(At[m], At[m], 4, 5, 6, 7))); \
        } else { _Pragma("unroll") for (int m = 0; m < 4; ++m) _Pragma("unroll") for (int n = 0; n < 2; ++n) \
        asm volatile("v_mfma_scale_f32_16x16x128_f8f6f4 %0, %1, %2, %0, %3, %4 op_sel_hi:[0,0,0]" : "+v"(acc[ai][bj][m][n]) : "v"(Bt[n]), "v"(At[m]), "v"(scl_w), "v"(scl_1)); } __builtin_amdgcn_s_setprio(0); } while (0)
#define PG8_XLDA(b, h) do { if constexpr (F8) PG8_LDA8(At8, b, h); else PG8_LDA(At, b, h); } while (0)
#define PG8_XLDB0(b, h) do { if constexpr (F8) PG8_LDB8(B08, b, h); else PG8_LDB(B0, b, h); } while (0)
#define PG8_XLDB1(b, h) do { if constexpr (F8) PG8_LDB8(B18, b, h); else PG8_LDB(B1, b, h); } while (0)
#define PG8_XMMA0(ai, bj) do { if constexpr (F8) PG8_MMA8(ai, bj, At8, B08); else PG8_MMA(ai, bj, At, B0); } while (0)
#define PG8_XMMA1(ai, bj) do { if constexpr (F8) PG8_MMA8(ai, bj, At8, B18); else PG8_MMA(ai, bj, At, B1); } while (0)
#define PG8_WAIT_V(n) asm volatile("s_waitcnt vmcnt(" #n ")" ::: "memory")
#define PG8_WAIT_L(n) asm volatile("s_waitcnt lgkmcnt(" #n ")" ::: "memory")
#define PG8_BAR __builtin_amdgcn_s_barrier()
#define PG8_SCHED __builtin_amdgcn_sched_barrier(0)
    Unit cur, nxt; int ui = 0;
    if (!S.next(0, cur)) return;
    f32x4 acc[2][2][4][2];
#pragma unroll
    for (int a = 0; a < 2; ++a)
#pragma unroll
        for (int b = 0; b < 2; ++b)
#pragma unroll
            for (int m = 0; m < 4; ++m)
#pragma unroll
                for (int n = 0; n < 2; ++n) acc[a][b][m][n] = zero4();
    bf16x8 At[4][2], B0[2][2], B1[2][2]; v8i_t At8[4], B08[2], B18[2];
    int scl_w = (int)FP8S, scl_1 = 0x7f7f7f7f; if constexpr (F8) asm volatile("" : "+v"(scl_w), "+v"(scl_1));
    unsigned cof[2][2], nof[2][2];
    PG8_LAS unsigned* gscr = (PG8_LAS unsigned*)(lds + 8 * HTB + wid * 1024);
    const char* cA = S.abase(cur); if constexpr (Sched::GATHER) { S.aoffs_load(cur, Rs, gscr); asm volatile("s_waitcnt vmcnt(0)" ::: "memory"); S.aoffs_fin(cur, Rs, Cs, gscr, lane, cof); } const char* cB = S.bbase(cur);
    PG8_STAGE(PG8_SB(0, 0), cB, voffB); PG8_STAGE(PG8_SB(0, 1), cB + hstep, voffB); PG8_STA(PG8_SA(0, 0), cA, 0, false); PG8_STA(PG8_SA(0, 1), cA, 1, false);
    if (wr == 1) PG8_BAR;
    PG8_WAIT_V(2); PG8_BAR;
    PG8_STAGE(PG8_SB(1, 0), cB + kstep, voffB); PG8_STA(PG8_SA(1, 0), cA + kstep, 0, false); PG8_STAGE(PG8_SB(1, 1), cB + hstep + kstep, voffB);
    PG8_WAIT_V(6); PG8_BAR;
    for (;;) {
        const bool has_next = S.next(ui + 1, nxt);
        const char* nA = cA; const char* nB = cB;
        if constexpr (Sched::GATHER) {
#pragma unroll
            for (int h = 0; h < 2; ++h)
#pragma unroll
                for (int i = 0; i < 2; ++i) nof[h][i] = cof[h][i]; }
        if (has_next) { nA = S.abase(nxt); if constexpr (Sched::GATHER) S.aoffs_load(nxt, Rs, gscr); nB = S.bbase(nxt); }
#pragma unroll 1
        for (int t = 0; t < nt; t += 2) {
            const bool last = (t == nt - 2);
            const bool skipw = (t == 0) && (ui > 0) && !Sched::GATHER;
            if constexpr (Sched::GATHER) { if (last && has_next) S.aoffs_fin(nxt, Rs, Cs, gscr, lane, nof); }
            if constexpr (Epi::HOOK) { PG8_SCHED; E.khook(acc, cur, t, wr, wc, fr, fq); PG8_SCHED; }
            const char* a1 = cA + (size_t)(t + 1) * kstep;
            const char* a2 = last ? nA : cA + (size_t)(t + 2) * kstep; const char* b2 = last ? nB : cB + (size_t)(t + 2) * kstep;
            const char* a3 = a2 + kstep; const char* b3 = b2 + kstep;
            PG8_XLDB0(0, 0); PG8_XLDB1(0, 1); PG8_SCHED; PG8_XLDA(0, 0); PG8_STA(PG8_SA(1, 1), a1, 1, false);
            if (!skipw) PG8_WAIT_V(8);
            PG8_WAIT_L(0); PG8_BAR; PG8_XMMA0(0, 0); PG8_XMMA1(0, 1); PG8_BAR; PG8_SCHED;
            PG8_XLDA(0, 1); PG8_STAGE(PG8_SB(0, 0), b2, voffB); PG8_STAGE(PG8_SB(0, 1), b2 + hstep, voffB); PG8_STA(PG8_SA(0, 0), a2, 0, last);
            if (!skipw) PG8_WAIT_V(8);
            PG8_WAIT_L(0); PG8_BAR; PG8_XMMA0(1, 0); PG8_XMMA1(1, 1); PG8_BAR; PG8_SCHED;
            PG8_XLDB0(1, 0); PG8_XLDB1(1, 1); PG8_SCHED; PG8_XLDA(1, 0); PG8_STA(PG8_SA(0, 1), a2, 1, last);
            PG8_WAIT_V(8); PG8_WAIT_L(0); PG8_BAR; PG8_XMMA0(0, 0); PG8_XMMA1(0, 1); PG8_BAR; PG8_SCHED;
            PG8_XLDA(1, 1); PG8_STAGE(PG8_SB(1, 0), b3, voffB); PG8_STAGE(PG8_SB(1, 1), b3 + hstep, voffB); PG8_STA(PG8_SA(1, 0), a3, 0, last);
            PG8_WAIT_V(8); PG8_WAIT_L(0); PG8_BAR; PG8_XMMA0(1, 0); PG8_XMMA1(1, 1); PG8_BAR; PG8_SCHED;
        }
        if constexpr (!Sched::GATHER) PG8_WAIT_V(0);
        if constexpr (F8) {
            asm volatile("s_nop 15\n\ts_nop 15\n\ts_nop 15\n\ts_nop 15\n\ts_nop 15" ::: "memory");
#pragma unroll
            for (int a = 0; a < 2; ++a)
#pragma unroll
                for (int b = 0; b < 2; ++b)
#pragma unroll
                    for (int m = 0; m < 4; ++m) asm volatile("" : "+v"(acc[a][b][m][0]), "+v"(acc[a][b][m][1]));
        }
        if (wr == 0) PG8_BAR;
        E(acc, cur, wr, wc, fr, fq);
#ifdef EPI_DUP
        if (Epi::DUPME) { asm volatile("" ::: "memory"); E(acc, cur, wr, wc, fr, fq); }
#endif
        if (!has_next) break;
#pragma unroll
        for (int a = 0; a < 2; ++a)
#pragma unroll
            for (int b = 0; b < 2; ++b)
#pragma unroll
                for (int m = 0; m < 4; ++m)
#pragma unroll
                    for (int n = 0; n < 2; ++n) acc[a][b][m][n] = zero4();
        cur = nxt; cA = nA; cB = nB; ++ui;
        if constexpr (Sched::GATHER) {
#pragma unroll
            for (int h = 0; h < 2; ++h)
#pragma unroll
                for (int i = 0; i < 2; ++i) cof[h][i] = nof[h][i]; }
        if (wr == 1) PG8_BAR;
    }
    PG8_WAIT_V(0);
    PG8_BAR;
#undef PG8_SA
#undef PG8_SB
#undef PG8_STAGE
#undef PG8_STA
#undef PG8_LDA
#undef PG8_LDB
#undef PG8_MMA
#undef PG8_LD32
#undef PG8_LDA8
#undef PG8_LDB8
#undef PG8_MMA8
#undef PG8_XLDA
#undef PG8_XLDB0
#undef PG8_XLDB1
#undef PG8_XMMA0
#undef PG8_XMMA1
#undef PG8_WAIT_V
#undef PG8_WAIT_L
#undef PG8_BAR
#undef PG8_SCHED
}
}

namespace attn_body {
using bf16=__hip_bfloat16;
using bf16x8=__attribute__((ext_vector_type(8)))short;
using s16x4=__attribute__((ext_vector_type(4)))short;
using f32x16=__attribute__((ext_vector_type(16)))float;
using u32x4=__attribute__((ext_vector_type(4)))unsigned;
constexpr int BATCH=8,NHEAD=8,SEQ=2048,D=64,DM=NHEAD*D,PO=1536,OCOL=512;
constexpr int NW=8,QBLK=32,QB=QBLK*NW,KVBLK=64,NQB=SEQ/QB;
constexpr int ATTN_PITCH=DM, ATTN_UNIT_ROWS=QB;
__device__ __forceinline__ int crow(int r,int hi){return (r&3)+8*(r>>2)+4*hi;}
#define SBAR() __builtin_amdgcn_sched_barrier(0)
__device__ __forceinline__ void cmask(f32x16&p0,f32x16&p1,int jb,int qrel,int hi){
  const float NEG=-INFINITY; int kb=64*jb+4*hi;
  #pragma unroll
  for(int r=0;r<16;++r){int kv=kb+(r&3)+8*(r>>2); if(kv>qrel)p0[r]=NEG; if(kv+32>qrel)p1[r]=NEG;}
}

constexpr int NSLOT=3, SLOTB=8192;
constexpr int LDS_K=0, LDS_V=NSLOT*SLOTB, LDS_WS=2*NSLOT*SLOTB, LDS_OST=LDS_WS+NW*64*4, LDS_BYTES=LDS_OST+NW*4096;
constexpr float C2=0.125f*1.4426950408889634f;
__device__ __forceinline__ void glds16(const void*gsrc,unsigned lds_dst){unsigned keep;
  asm volatile("s_mov_b32 %0, m0\n\ts_mov_b32 m0, %2\n\ts_nop 0\n\tglobal_load_lds_dwordx4 %1, off\n\ts_mov_b32 m0, %0":"=&s"(keep):"v"(gsrc),"s"(lds_dst):"memory");}
__device__ __forceinline__ float max3f(float a,float b,float c){float r;asm("v_max3_f32 %0, %1, %2, %3":"=v"(r):"v"(a),"v"(b),"v"(c));return r;}
__device__ __forceinline__ float max2f(float a,float b){float r;asm("v_max_f32_e32 %0, %1, %2":"=v"(r):"v"(a),"v"(b));return r;}
__device__ __forceinline__ float fadd_s(float a,float b){float r;asm("v_add_f32_e32 %0, %1, %2":"=v"(r):"v"(a),"v"(b));return r;}
__device__ __forceinline__ float fsub_s(float a,float b){float r;asm("v_sub_f32_e32 %0, %1, %2":"=v"(r):"v"(a),"v"(b));return r;}
typedef float f32x2_t __attribute__((ext_vector_type(2))); typedef __bf16 bf16x2_t __attribute__((ext_vector_type(2)));
__device__ __forceinline__ unsigned cvtpk_s(float lo,float hi){f32x2_t v={lo,hi};bf16x2_t b=__builtin_convertvector(v,bf16x2_t);return __builtin_bit_cast(unsigned,b);}
#define WAIT_BAR(N) asm volatile("s_waitcnt vmcnt(" #N ") lgkmcnt(0)\n\ts_barrier":::"memory")

__device__ __forceinline__ void qkt(f32x16&p0,f32x16&p1,const char*Kslot,const bf16x8*qr,bf16x8 ka0,bf16x8 ka1,bf16x8 qaug,int r32,int hi){
  const char*kb=Kslot+hi*1024+r32*16;
  p0=__builtin_amdgcn_mfma_f32_32x32x16_bf16(ka0,qaug,f32x16{},0,0,0);p1=__builtin_amdgcn_mfma_f32_32x32x16_bf16(ka1,qaug,f32x16{},0,0,0);
  #pragma unroll
  for(int d0=0;d0<4;++d0){
    const bf16x8 b0=*reinterpret_cast<const bf16x8*>(kb+d0*2048);
    const bf16x8 b1=*reinterpret_cast<const bf16x8*>(kb+d0*2048+512);
    p0=__builtin_amdgcn_mfma_f32_32x32x16_bf16(b0,qr[d0],p0,0,0,0);p1=__builtin_amdgcn_mfma_f32_32x32x16_bf16(b1,qr[d0],p1,0,0,0);}
}
typedef __attribute__((address_space(3))) const char* lds_cptr;
typedef short v4i16_t __attribute__((ext_vector_type(4)));
__device__ __forceinline__ void kload8(bf16x8*kf,lds_cptr kp){
  kf[0]=*(const __attribute__((address_space(3))) bf16x8*)(kp);      kf[1]=*(const __attribute__((address_space(3))) bf16x8*)(kp+512);
  kf[2]=*(const __attribute__((address_space(3))) bf16x8*)(kp+2048); kf[3]=*(const __attribute__((address_space(3))) bf16x8*)(kp+2560);
  kf[4]=*(const __attribute__((address_space(3))) bf16x8*)(kp+4096); kf[5]=*(const __attribute__((address_space(3))) bf16x8*)(kp+4608);
  kf[6]=*(const __attribute__((address_space(3))) bf16x8*)(kp+6144); kf[7]=*(const __attribute__((address_space(3))) bf16x8*)(kp+6656);
}
__device__ __forceinline__ void kload2(bf16x8*kf,lds_cptr kp,int j){ kf[2*j]=*(const __attribute__((address_space(3))) bf16x8*)(kp+j*2048); kf[2*j+1]=*(const __attribute__((address_space(3))) bf16x8*)(kp+j*2048+512); }
__device__ __forceinline__ s16x4 vtr(lds_cptr p){ return __builtin_bit_cast(s16x4,__builtin_amdgcn_ds_read_tr16_b64_v4i16((__attribute__((address_space(3))) v4i16_t*)p)); }
__device__ __forceinline__ float rowmax(const f32x16&p0,const f32x16&p1){
  float a=max3f(p0[0],p0[1],p1[0]),b=max3f(p0[2],p0[3],p1[1]);a=max3f(a,p1[2],p1[3]);
  #pragma unroll
  for(int r=4;r<16;r+=4){a=max3f(a,p0[r],p0[r+1]);b=max3f(b,p0[r+2],p0[r+3]);a=max3f(a,p1[r],p1[r+1]);b=max3f(b,p1[r+2],p1[r+3]);}
  const float m=max2f(a,b);
  auto rr=__builtin_amdgcn_permlane32_swap(__float_as_uint(m),__float_as_uint(m),false,false);
  return max2f(__uint_as_float(rr[0]),__uint_as_float(rr[1]));
}
__device__ __forceinline__ void pv(f32x16*o,int vb,bf16x8 pa0,bf16x8 pa1,bf16x8 pa2,bf16x8 pa3){
  #pragma unroll
  for(int d0=0;d0<2;++d0){s16x4 lo[4],hi[4];
    #pragma unroll
    for(int ks=0;ks<4;++ks){
      asm volatile("ds_read_b64_tr_b16 %0,%1 offset:%c2":"=&v"(lo[ks]):"v"(vb),"i"(d0*4096+ks*1024):"memory");
      asm volatile("ds_read_b64_tr_b16 %0,%1 offset:%c2":"=&v"(hi[ks]):"v"(vb),"i"(d0*4096+ks*1024+512):"memory");}
    asm volatile("s_waitcnt lgkmcnt(0)":::"memory");SBAR();
    #define PK(k) (bf16x8){lo[k][0],lo[k][1],lo[k][2],lo[k][3],hi[k][0],hi[k][1],hi[k][2],hi[k][3]}
    o[d0]=__builtin_amdgcn_mfma_f32_32x32x16_bf16(pa0,PK(0),o[d0],0,0,0);
    o[d0]=__builtin_amdgcn_mfma_f32_32x32x16_bf16(pa1,PK(1),o[d0],0,0,0);
    o[d0]=__builtin_amdgcn_mfma_f32_32x32x16_bf16(pa2,PK(2),o[d0],0,0,0);
    o[d0]=__builtin_amdgcn_mfma_f32_32x32x16_bf16(pa3,PK(3),o[d0],0,0,0);
    #undef PK
  }
}

#ifndef ATTN_STORE16
#define ATTN_STORE16(p,v) (*(u32x4*)(p)=(v))
#endif
typedef __attribute__((address_space(3))) const u32x4* lds_tabptr;
__device__ __forceinline__ bf16x8 make_qaug(float mhat,int hi){
  const float nm=-mhat; const unsigned h=cvtpk_s(nm,0.f)&0xffffu; const float r1=nm-__uint_as_float(h<<16);
  const unsigned m=cvtpk_s(r1,0.f)&0xffffu; const float r2=r1-__uint_as_float(m<<16); const unsigned l=cvtpk_s(r2,0.f)&0xffffu;
  u32x4 w; w.x=hi?0u:0x3F803F80u; w.y=hi?0u:(0x3F80u|(h<<16)); w.z=hi?0u:(m|(l<<16)); w.w=0u; return __builtin_bit_cast(bf16x8,w);
}
template<int THRL> __device__ __forceinline__ void attn_unit(int b,int h,int qb,const bf16*Q,const bf16*__restrict__ K,const bf16*__restrict__ V,bf16*O,char*shm,lds_tabptr tab){
  int tid_=threadIdx.x; asm volatile("":"+v"(tid_));
  const int tid=tid_,lane=tid&63,r32=lane&31,hi=lane>>5; const int wid=__builtin_amdgcn_readfirstlane(tid>>6);
  const long rowbase=(long)b*SEQ; const int q0=qb*QB;
  const bf16*Qw=Q+(rowbase+q0+wid*QBLK)*DM+h*D;
  const bf16*Kh=K+rowbase*DM+h*D,*Vh=V+rowbase*DM+h*D;
  const unsigned lds0=(unsigned)(uintptr_t)shm;
  float*wsf=(float*)(shm+LDS_WS)+wid*64;
  const bf16*ksrc=Kh+(long)lane*DM+wid*8;
  const bf16*vsrc=Vh+(long)(16*(wid&3)+(lane>>2))*DM+(wid>>2)*32+(lane&3)*8;
  const unsigned kdst=lds0+LDS_K+wid*1024, vdst=lds0+LDS_V+wid*1024;
  #define DMA_K(t,slot) glds16(ksrc+(long)(t)*KVBLK*DM,(unsigned)__builtin_amdgcn_readfirstlane(kdst+(slot)))
  #define DMA_V(t,slot) glds16(vsrc+(long)(t)*KVBLK*DM,(unsigned)__builtin_amdgcn_readfirstlane(vdst+(slot)))
  const int vb0=(int)(lds0+LDS_V)+((lane>>4)&1)*32+(lane&3)*8+(4*hi+((lane&15)>>2))*64;
  const char*Kbase=shm+LDS_K; bf16x8 kf[8];
  const lds_cptr shm3=(lds_cptr)shm; const lds_cptr kp0=shm3+LDS_K+hi*1024+r32*16; const lds_cptr vp0=shm3+LDS_V+((lane>>4)&1)*32+(lane&3)*8+(4*hi+((lane&15)>>2))*64;
  const int NT=(q0+QB)/KVBLK;
  DMA_K(0,0);DMA_V(0,0);DMA_K(1,SLOTB);
  bf16x8 qr[4];
  #pragma unroll
  for(int d0=0;d0<4;++d0)qr[d0]=*reinterpret_cast<const bf16x8*>(&Qw[(long)r32*DM+d0*16+hi*8]);
  float mhat=0.f,l_reg=0.f;f32x16 o[2];o[0]=f32x16{};o[1]=f32x16{};bf16x8 qaug=make_qaug(0.f,hi);asm volatile("":"+v"(qaug));
  const int qrel=wid*QBLK+r32;
  #define CMASK(P0,P1,t) do{int jb_=(t)-(NT-4); if(jb_>=0)cmask(P0,P1,jb_,qrel,hi);}while(0)
  bool resc=false;
  #define START(P0,P1) do{ const float rm=rowmax(P0,P1); resc=false; \
    { const float dl=rm; mhat=fadd_s(mhat,dl); \
      _Pragma("unroll") for(int r=0;r<16;++r){P0[r]=fsub_s(P0[r],dl);P1[r]=fsub_s(P1[r],dl);} \
      qaug=make_qaug(mhat,hi); asm volatile("":"+v"(qaug)); } \
    _Pragma("unroll") for(int r=0;r<16;++r)P0[r]=__builtin_amdgcn_exp2f(P0[r]); }while(0)
  #define RESC() do{ if(resc){ asm volatile("s_waitcnt lgkmcnt(0)":::"memory"); \
      _Pragma("unroll") for(int d_=0;d_<2;++d_) _Pragma("unroll") for(int r=0;r<16;++r)o[d_][r]*=wsf[crow(r,hi)]; } }while(0)
  f32x16 pA0,pA1,pB0,pB1;
  int sl_prev=0,sl_cur=0,sl_next=SLOTB;
  #define ROT() do{sl_prev=sl_cur;sl_cur=sl_next;sl_next=(sl_next==(NSLOT-1)*SLOTB)?0:sl_next+SLOTB;}while(0)
  DMA_K(2,2*SLOTB);
  WAIT_BAR(3);
  qkt(pA0,pA1,Kbase,qr,__builtin_bit_cast(bf16x8,tab[r32]),__builtin_bit_cast(bf16x8,tab[32+r32]),qaug,r32,hi);asm volatile("s_nop 15\n\ts_nop 7":"+v"(pA0),"+v"(pA1));CMASK(pA0,pA1,0);
  START(pA0,pA1);
  _Pragma("unroll") for(int r=0;r<16;++r)pA1[r]=__builtin_amdgcn_exp2f(pA1[r]);
  WAIT_BAR(0);
  DMA_K(3,0);DMA_V(1,SLOTB);
  ROT();
  kload8(kf,kp0+sl_cur);
  WAIT_BAR(2);
  s16x4 vlo[8],vhi[8]; u32x4 pw0,pw1,pw2,pw3;
  #define PKW(P,B) cvtpk_s(P[B],P[B+1])
  #define PAF(k) __builtin_bit_cast(bf16x8,pw##k)
  #define VFR(i) (bf16x8){vlo[i][0],vlo[i][1],vlo[i][2],vlo[i][3],vhi[i][0],vhi[i][1],vhi[i][2],vhi[i][3]}
  #define PIN(x) asm volatile("":"+v"(x))
  #define MX3(a,b,c) __builtin_fmaxf(__builtin_fmaxf((a),(b)),(c))
  #define GAPA(MF,A0,A1,A2,A3,W0,W1,PW) do{ MF; sacc+=A0; sacc+=A1; sacc+=A2; sacc+=A3; PIN(sacc); W0; W1; PIN(PW); SBAR(); }while(0)
  #define EX(v) __builtin_amdgcn_exp2f(v)
  #define GAPB(MF,X,B) do{ MF; X[B]=EX(X[B]); X[B+1]=EX(X[B+1]); X[B+2]=EX(X[B+2]); X[B+3]=EX(X[B+3]); PIN(X); SBAR(); }while(0)
  #define VRD(i) do{ vlo[i]=vtr(vp_+(((i)>>2)*4096+((i)&3)*1024)); vhi[i]=vtr(vp_+(((i)>>2)*4096+((i)&3)*1024+512)); }while(0)
  #define KRD(G,j) do{ if(G){ kload2(kf,kp0+sl_next,j); SBAR(); } }while(0)
  #define STEP(C0,C1,P0,P1,t,GK,GV,GL) do{ SBAR(); \
    const lds_cptr vp_=vp0+sl_prev; \
    const bf16x8 ka0_=__builtin_bit_cast(bf16x8,tab[64*(t)+r32]), ka1_=__builtin_bit_cast(bf16x8,tab[64*(t)+32+r32]); \
    VRD(0); SBAR(); float sacc=(P0[0]+P0[1]); \
    GAPA(C0=__builtin_amdgcn_mfma_f32_32x32x16_bf16(kf[0],qr[0],f32x16{},0,0,0), P0[2],P0[3],P0[4],P0[5],     pw0[0]=PKW(P0,0), pw0[1]=PKW(P0,2), pw0); \
    VRD(4); SBAR(); GAPA(C1=__builtin_amdgcn_mfma_f32_32x32x16_bf16(kf[1],qr[0],f32x16{},0,0,0), P0[6],P0[7],P0[8],P0[9],     pw0[2]=PKW(P0,4), pw0[3]=PKW(P0,6), pw0); \
    VRD(1); SBAR(); GAPA(C0=__builtin_amdgcn_mfma_f32_32x32x16_bf16(kf[2],qr[1],C0,0,0,0),   P0[10],P0[11],P0[12],P0[13], pw1[0]=PKW(P0,8), pw1[1]=PKW(P0,10), pw1); \
    VRD(5); SBAR(); GAPA(C1=__builtin_amdgcn_mfma_f32_32x32x16_bf16(kf[3],qr[1],C1,0,0,0),   P0[14],P0[15],P1[0],P1[1],   pw1[2]=PKW(P0,12),pw1[3]=PKW(P0,14), pw1); \
    VRD(2); SBAR(); GAPA(C0=__builtin_amdgcn_mfma_f32_32x32x16_bf16(kf[4],qr[2],C0,0,0,0),   P1[2],P1[3],P1[4],P1[5],     pw2[0]=PKW(P1,0), pw2[1]=PKW(P1,2), pw2); \
    VRD(6); SBAR(); GAPA(C1=__builtin_amdgcn_mfma_f32_32x32x16_bf16(kf[5],qr[2],C1,0,0,0),   P1[6],P1[7],P1[8],P1[9],     pw2[2]=PKW(P1,4), pw2[3]=PKW(P1,6), pw2); \
    VRD(3); SBAR(); GAPA(C0=__builtin_amdgcn_mfma_f32_32x32x16_bf16(kf[6],qr[3],C0,0,0,0),   P1[10],P1[11],P1[12],P1[13], pw3[0]=PKW(P1,8), pw3[1]=PKW(P1,10), pw3); \
    VRD(7); SBAR(); GAPA(C1=__builtin_amdgcn_mfma_f32_32x32x16_bf16(kf[7],qr[3],C1,0,0,0),   P1[14],P1[15],0.f,0.f,       pw3[2]=PKW(P1,12),pw3[3]=PKW(P1,14), pw3); \
    C0=__builtin_amdgcn_mfma_f32_32x32x16_bf16(ka0_,qaug,C0,0,0,0); C1=__builtin_amdgcn_mfma_f32_32x32x16_bf16(ka1_,qaug,C1,0,0,0); SBAR(); \
    l_reg+=sacc; \
    if(GK){DMA_K((t)+3,sl_cur);} if(GV){DMA_V((t)+1,sl_next);} \
    CMASK(C0,C1,t); \
    { float a=MX3(C0[0],C0[1],C1[0]),b=MX3(C0[2],C0[3],C1[1]); a=MX3(a,C1[2],C1[3]); \
      _Pragma("unroll") for(int r=4;r<16;r+=4){a=MX3(a,C0[r],C0[r+1]);b=MX3(b,C0[r+2],C0[r+3]);a=MX3(a,C1[r],C1[r+1]);b=MX3(b,C1[r+2],C1[r+3]);} \
      float rm=__builtin_fmaxf(a,b); { auto rr=__builtin_amdgcn_permlane32_swap(__float_as_uint(rm),__float_as_uint(rm),false,false); rm=__builtin_fmaxf(__uint_as_float(rr[0]),__uint_as_float(rr[1])); } \
      resc=false; \
      if(__builtin_expect(__any(rm>(float)THRL),0)){ const float dl=__builtin_fmaxf(rm,0.f); mhat+=dl; \
        _Pragma("unroll") for(int r=0;r<16;++r){C0[r]-=dl;C1[r]-=dl;} \
        qaug=make_qaug(mhat,hi); asm volatile("":"+v"(qaug)); \
        const float f=__builtin_amdgcn_exp2f(-dl); l_reg*=f; if(hi==0)wsf[r32]=f; resc=true; } } \
    SBAR(); \
    GAPB(o[0]=__builtin_amdgcn_mfma_f32_32x32x16_bf16(PAF(0),VFR(0),o[0],0,0,0), C0,0); \
    GAPB(o[1]=__builtin_amdgcn_mfma_f32_32x32x16_bf16(PAF(0),VFR(4),o[1],0,0,0), C0,4); \
    KRD(GL,0); GAPB(o[0]=__builtin_amdgcn_mfma_f32_32x32x16_bf16(PAF(1),VFR(1),o[0],0,0,0), C0,8); \
    KRD(GL,1); GAPB(o[1]=__builtin_amdgcn_mfma_f32_32x32x16_bf16(PAF(1),VFR(5),o[1],0,0,0), C0,12); \
    KRD(GL,2); GAPB(o[0]=__builtin_amdgcn_mfma_f32_32x32x16_bf16(PAF(2),VFR(2),o[0],0,0,0), C1,0); \
    KRD(GL,3); GAPB(o[1]=__builtin_amdgcn_mfma_f32_32x32x16_bf16(PAF(2),VFR(6),o[1],0,0,0), C1,4); \
    GAPB(o[0]=__builtin_amdgcn_mfma_f32_32x32x16_bf16(PAF(3),VFR(3),o[0],0,0,0), C1,8); \
    GAPB(o[1]=__builtin_amdgcn_mfma_f32_32x32x16_bf16(PAF(3),VFR(7),o[1],0,0,0), C1,12); \
    }while(0)
  int t=1;
  #undef CMASK
  #define CMASK(P0,P1,t) do{}while(0)
  for(;t+5<NT;t+=2){
    STEP(pB0,pB1,pA0,pA1,t,true,true,true);     WAIT_BAR(2); RESC(); ROT();
    STEP(pA0,pA1,pB0,pB1,t+1,true,true,true);   WAIT_BAR(2); RESC(); ROT();
  }
  #undef CMASK
  #define CMASK(P0,P1,t) do{int jb_=(t)-(NT-4); if(jb_>=0)cmask(P0,P1,jb_,qrel,hi);}while(0)
  #define ENDW(tt) do{ if((tt)+3<NT){WAIT_BAR(2);} else if((tt)+2<NT){WAIT_BAR(1);} else {WAIT_BAR(0);} }while(0)
  for(;t+1<NT;t+=2){
    STEP(pB0,pB1,pA0,pA1,t,(t+3<NT),(t+1<NT),(t+1<NT));       ENDW(t);   RESC(); ROT();
    STEP(pA0,pA1,pB0,pB1,t+1,(t+4<NT),(t+2<NT),(t+2<NT));     ENDW(t+1); RESC(); ROT();
  }
  STEP(pB0,pB1,pA0,pA1,NT-1,false,false,false); RESC();
  { float sacc=pB0[0]+pB0[1]; _Pragma("unroll") for(int r=2;r<16;++r)sacc+=pB0[r]; _Pragma("unroll") for(int r=0;r<16;++r)sacc+=pB1[r]; l_reg+=sacc;
    pw0=(u32x4){PKW(pB0,0),PKW(pB0,2),PKW(pB0,4),PKW(pB0,6)};pw1=(u32x4){PKW(pB0,8),PKW(pB0,10),PKW(pB0,12),PKW(pB0,14)};pw2=(u32x4){PKW(pB1,0),PKW(pB1,2),PKW(pB1,4),PKW(pB1,6)};pw3=(u32x4){PKW(pB1,8),PKW(pB1,10),PKW(pB1,12),PKW(pB1,14)};
    SBAR(); pv(o,vb0+sl_cur,PAF(0),PAF(1),PAF(2),PAF(3)); }
  #undef PKW
  #undef PAF
  #undef VFR
  #undef PIN
  #undef MX3
  #undef GAPA
  #undef GAPB
  #undef EX
  #undef VRD
  #undef KRD
  #undef STEP
  #undef ENDW
  {auto rr=__builtin_amdgcn_permlane32_swap(__float_as_uint(l_reg),__float_as_uint(l_reg),false,false);l_reg=__uint_as_float(rr[0])+__uint_as_float(rr[1]);}
  if(hi==0)wsf[32+r32]=l_reg;asm volatile("s_waitcnt lgkmcnt(0)":::"memory");
  float rli[16];
  #pragma unroll
  for(int r=0;r<16;++r)rli[r]=__builtin_amdgcn_rcpf(wsf[32+crow(r,hi)]);
  bf16*Ow=O+(rowbase+q0+wid*QBLK)*PO+OCOL+h*D;
  { bf16*stg=(bf16*)(shm+LDS_OST)+wid*2048;
    #pragma unroll
    for(int r=0;r<16;++r){const int orow=crow(r,hi);
      #pragma unroll
      for(int d0=0;d0<2;++d0)stg[orow*64+d0*32+r32]=__float2bfloat16(o[d0][r]*rli[r]);}
    asm volatile("s_waitcnt lgkmcnt(0)":::"memory");
    #pragma unroll
    for(int i=0;i<4;++i){const int row=i*8+(lane>>3),ch=lane&7; const u32x4 v=*(const u32x4*)(stg+row*64+ch*8); ATTN_STORE16(Ow+(long)row*PO+ch*8,v);} }
  asm volatile("s_waitcnt lgkmcnt(0)\n\ts_barrier":::"memory");
  #undef DMA_K
  #undef DMA_V
  #undef CMASK
  #undef START
  #undef RESC
  #undef ROT
}
constexpr int ATTN_LDS_BYTES=LDS_BYTES;
#undef SBAR
#undef WAIT_BAR
}
constexpr int NWAVES = 8;
constexpr int D = 1024, BATCH = 8, SEQ = 2048, M = BATCH * SEQ;
constexpr int N_INSRC = 7176, N_INV = 7168;
constexpr int FL_COL = 3072;
constexpr int DFF_D = 2816, DFF_E = 3584, NEXP = 8;
constexpr float LN_EPS = 1e-5f, GN_EPS = 1e-6f;
constexpr float ALPHA = 1.4142135623730951f;
constexpr float LOG2E = 1.4426950408889634f;
constexpr float C2 = 0.125f * LOG2E;

constexpr size_t MiB = 1u << 20;
constexpr size_t WS_CTL = 0, CTL_ZERO_BYTES = 192 * 1024;
constexpr size_t WS_CS = 1 * MiB;
constexpr size_t WS_LIST = 2 * MiB;
constexpr size_t WS_GATEW = 2 * MiB + 512 * 1024;
constexpr size_t WS_LOGF = 3 * MiB;
constexpr size_t WS_GST = 3 * MiB + 512 * 1024;
constexpr size_t WS_WIN = 4 * MiB;
constexpr size_t WS_WBR = 32 * MiB;
constexpr size_t WS_WOUT = 38 * MiB;
constexpr size_t WS_WDU = 42 * MiB;
constexpr size_t WS_WDD = 53 * MiB;
constexpr size_t WS_WMU = 59 * MiB;
constexpr size_t WS_WMD = 171 * MiB;
constexpr size_t WS_XB = 227 * MiB;
constexpr size_t WS_XF = 259 * MiB;
constexpr size_t WS_YPRE = 323 * MiB;
constexpr size_t WS_C1 = 387 * MiB;
constexpr size_t WS_MRG = 451 * MiB;
constexpr size_t WS_RQ = 483 * MiB, WS_RK = 491 * MiB, WS_RV = 499 * MiB, WS_RG = 515 * MiB, WS_FQ = 531 * MiB, WS_FK = 547 * MiB, WS_FV = 563 * MiB,
                 WS_GU = 579 * MiB, WS_GV = 595 * MiB, WS_GT = 611 * MiB, WS_YB = 707 * MiB, WS_KV = 755 * MiB  , WS_X8IN = 771 * MiB  , WS_WIN8 = 787 * MiB  , WS_END = 793 * MiB;
constexpr size_t WS_HID = 483 * MiB;
static_assert((size_t)34816 * DFF_E <= WS_KV - WS_HID, "MoE hidden fits its overlay");
constexpr int CW_TMO = 0, CW_CODE = 1;
constexpr int CW_CNT = 64;
constexpr int CW_BAR = 4096;

constexpr int RING_OFF = 0, RING_BYTES = 141312;
constexpr int LDSCTL_OFF = RING_BYTES, MISC_OFF = LDSCTL_OFF + 320, PTAB_OFF = LDSCTL_OFF + 1024;
constexpr int LDS_BYTES = 147456;
static_assert(MISC_OFF + 128 <= PTAB_OFF && PTAB_OFF + 20 * 8 <= LDS_BYTES, "LDS map");

#define GAS __attribute__((address_space(1)))
#define LAS __attribute__((address_space(3)))
typedef unsigned short bf16;
typedef unsigned v4u __attribute__((ext_vector_type(4)));
typedef unsigned v2u __attribute__((ext_vector_type(2)));
typedef float f32x4 __attribute__((ext_vector_type(4)));
typedef GAS unsigned gu32;
#define RLX_AGENT __ATOMIC_RELAXED, __HIP_MEMORY_SCOPE_AGENT
#define LDS_WAIT() asm volatile("s_waitcnt lgkmcnt(0)" ::: "memory")
#define VM_WAIT() asm volatile("s_waitcnt vmcnt(0)" ::: "memory")
__device__ __forceinline__ unsigned f2bf(float f) { unsigned u = __builtin_bit_cast(unsigned, f); return (u + 0x7fffu + ((u >> 16) & 1u)) >> 16; }
__device__ __forceinline__ unsigned pk2(float lo, float hi) { return f2bf(lo) | (f2bf(hi) << 16); }
__device__ __forceinline__ float bf2f(unsigned short h) { return __builtin_bit_cast(float, (unsigned)h << 16); }
__device__ __forceinline__ float bflo(unsigned w) { return __builtin_bit_cast(float, w << 16); }
__device__ __forceinline__ float bfhi(unsigned w) { return __builtin_bit_cast(float, w & 0xffff0000u); }
constexpr float SC_X8 = 16.f, SC_WU8 = 32.f, SC_H8 = 8.f, SC_WD8 = 128.f;
constexpr float SWI_A = 1.4426950408889634f, SWI_B = SC_H8 / 1.4426950408889634f;
constexpr unsigned E8_UP = 0x76767676u  , E8_DN = 0x75757575u  ;
__device__ __forceinline__ float clamp448(float x) { return fminf(fmaxf(x, -448.f), 448.f); }
__device__ __forceinline__ unsigned pk4_fp8(float a, float b, float c, float d) {
    int w = __builtin_amdgcn_cvt_pk_fp8_f32(clamp448(a), clamp448(b), 0, false); w = __builtin_amdgcn_cvt_pk_fp8_f32(clamp448(c), clamp448(d), w, true); return (unsigned)w; }
constexpr float SC_XI8 = 127.f / 4.5f, SC_WI8 = 127.f * 32.f / 4.f;
constexpr float SC_MI8 = 127.f / 4.f, SC_WOI8 = 127.f * 64.f / 4.f;
__device__ __forceinline__ unsigned pk4_i8(float a, float b, float c, float d) {
    unsigned w = 0u;
    w = __builtin_amdgcn_cvt_pk_u8_f32(__builtin_rintf(a) + 128.f, 0u, w); w = __builtin_amdgcn_cvt_pk_u8_f32(__builtin_rintf(b) + 128.f, 1u, w);
    w = __builtin_amdgcn_cvt_pk_u8_f32(__builtin_rintf(c) + 128.f, 2u, w); w = __builtin_amdgcn_cvt_pk_u8_f32(__builtin_rintf(d) + 128.f, 3u, w);
    return w ^ 0x80808080u; }
__device__ __forceinline__ float fsigmoid(float x) { return __builtin_amdgcn_rcpf(1.0f + __builtin_amdgcn_exp2f(-x * LOG2E)); }
__device__ __forceinline__ float fsilu(float x) { return x * fsigmoid(x); }
typedef float f2v __attribute__((ext_vector_type(2)));
__device__ __forceinline__ f2v fsigmoid2(f2v x) { const f2v t = x * (-LOG2E); f2v e; e.x = __builtin_amdgcn_exp2f(t.x); e.y = __builtin_amdgcn_exp2f(t.y); const f2v d = e + 1.0f; f2v r; r.x = __builtin_amdgcn_rcpf(d.x); r.y = __builtin_amdgcn_rcpf(d.y); return r; }
__device__ __forceinline__ f2v fsilu2(f2v x) { return x * fsigmoid2(x); }
__device__ __forceinline__ f2v swi_folded2(f2v a, f2v b) { f2v e; e.x = __builtin_amdgcn_exp2f(-a.x); e.y = __builtin_amdgcn_exp2f(-a.y); const f2v d = e + 1.0f; f2v r; r.x = __builtin_amdgcn_rcpf(d.x); r.y = __builtin_amdgcn_rcpf(d.y); return (a * b) * r; }
__device__ __forceinline__ f2v fgelu_tanh2(f2v x) {
    const f2v t = x * (x * x * (-0.0713548163f * LOG2E) + (-1.5957691216f * LOG2E)); f2v e; e.x = __builtin_amdgcn_exp2f(t.x); e.y = __builtin_amdgcn_exp2f(t.y);
    const f2v d = e + 1.0f; f2v r; r.x = __builtin_amdgcn_rcpf(d.x); r.y = __builtin_amdgcn_rcpf(d.y); return x * r; }
__device__ __forceinline__ float fgelu_tanh(float x) { const float u = 0.7978845608028654f * (x + 0.044715f * x * x * x); return x * fsigmoid(2.0f * u); }

#define XB_TMO      128
#define XB_XCNT(j)  (256  + 64 * (j))
#define XB_XSUB(j)  (1280 + 64 * (j))
#define XB_XGEN(j)  (2304 + 64 * (j))
#define XB_TOP      3328
#define XB_TOPGEN   3392
#define XCD_BAR_WORDS 3456
#define XB_SPIN_CAP (1u << 18)
__device__ __forceinline__ unsigned xb_ld(unsigned* p)              { return __hip_atomic_load(p, __ATOMIC_RELAXED, __HIP_MEMORY_SCOPE_AGENT); }
__device__ __forceinline__ unsigned xb_add(unsigned* p, unsigned v) { return __hip_atomic_fetch_add(p, v, __ATOMIC_RELAXED, __HIP_MEMORY_SCOPE_AGENT); }
__device__ __forceinline__ unsigned xb_xcc_id() { return (unsigned)__builtin_amdgcn_s_getreg((3 << 11) | 20) & 0xFu; }
#define XB_SPIN(cond, bar) do { unsigned _sp = 0; while (cond) { __builtin_amdgcn_s_sleep(1); \
    if ((++_sp & 255u) == 0u) { if (xb_ld(&(bar)[XB_TMO])) break; if (_sp > XB_SPIN_CAP) { atomicAdd(&(bar)[XB_TMO], 1u); break; } } } } while (0)
struct XcdBarrier { unsigned* bar; unsigned x; volatile LAS unsigned* st; unsigned total; unsigned lite; };
__device__ __forceinline__ XcdBarrier xcd_barrier_post(unsigned* bar, volatile LAS unsigned* st, unsigned total, unsigned lite) {
    XcdBarrier b; b.bar = bar; b.x = xb_xcc_id(); b.st = st; b.total = total; b.lite = lite;
    if (threadIdx.x == 0) (void)xb_add(&bar[XB_XCNT(b.x)], 1u);
    return b;
}
__device__ __forceinline__ void xcd_barrier_complete(unsigned* bar, unsigned x, unsigned G, unsigned& nloc, unsigned& nx) {
    unsigned sum, cnt, mine, sp = 0u;
    for (;;) {
        sum = 0u; cnt = 0u; mine = 0u;
#pragma unroll
        for (unsigned j = 0; j < 16; ++j) { const unsigned c = xb_ld(&bar[XB_XCNT(j)]); sum += c; cnt += (c > 0u) ? 1u : 0u; mine = (j == x) ? c : mine; }
        if (sum == G) break;
        __builtin_amdgcn_s_sleep(1);
        if ((++sp & 255u) == 0u) { if (xb_ld(&bar[XB_TMO])) break; if (sp > XB_SPIN_CAP) { atomicAdd(&bar[XB_TMO], 1u); break; } }
    }
    nloc = mine > 0u ? mine : 1u; nx = cnt > 0u ? cnt : 1u;
}
__device__ __forceinline__ void xcd_barrier(const XcdBarrier& b) {
    asm volatile("s_waitcnt vmcnt(0)" ::: "memory");
    __syncthreads();
    if (threadIdx.x == 0) {
        unsigned* bar = b.bar;
        __builtin_amdgcn_s_waitcnt(0);
        unsigned nloc = b.st[0], nx = b.st[1];
        if (nloc == 0u) { xcd_barrier_complete(bar, b.x, b.total, nloc, nx); b.st[0] = nloc; b.st[1] = nx; }
        const unsigned old = xb_add(&bar[XB_XSUB(b.x)], 1u);
        const unsigned gen = old / nloc;
        if (old + 1u == (gen + 1u) * nloc) {
            if (!(b.lite != 0u && nx == 1u)) {
                __builtin_amdgcn_fence(__ATOMIC_RELEASE, "agent");
                asm volatile("s_waitcnt vmcnt(0)" ::: "memory");
            }
            if (nx != 1u) {
                const unsigned og = xb_add(&bar[XB_TOP], 1u);
                const unsigned tg = og / nx;
                if (og + 1u == (tg + 1u) * nx) xb_add(&bar[XB_TOPGEN], 1u);
                else XB_SPIN(xb_ld(&bar[XB_TOPGEN]) == tg, bar);
            }
            __builtin_amdgcn_fence(__ATOMIC_ACQUIRE, "agent");
            xb_add(&bar[XB_XGEN(b.x)], 1u);
            asm volatile("s_waitcnt vmcnt(0)" ::: "memory");
        } else {
            XB_SPIN(xb_ld(&bar[XB_XGEN(b.x)]) == gen, bar);
            __builtin_amdgcn_fence(__ATOMIC_ACQUIRE, "agent");
            asm volatile("s_waitcnt vmcnt(0)" ::: "memory");
        }
    }
    __syncthreads();
}

using pg8::Unit; using pg8::bf16_t;
#define ACC_T const pg8::f32x4 (&acc)[2][2][4][2]

struct ProjSched : pg8::PlainSched {
    __device__ __forceinline__ bool next(int i, Unit& u) const { if (!pg8::PlainSched::next(i, u)) return false; if (nN == 16 && ((u.pm >> 2) & 1)) u.pn = (u.pn + 4) & 15; return true; }
};
typedef int i32x4_t __attribute__((ext_vector_type(4)));
template <bool I8IN> __device__ __forceinline__ pg8::f32x4 ldacc(const pg8::f32x4& r) {
    if constexpr (I8IN) return __builtin_convertvector(__builtin_bit_cast(i32x4_t, r), pg8::f32x4) * (1.0f / (SC_XI8 * SC_WI8)); else return r; }
template <bool I8IN>
struct EpiProjT {
    static constexpr bool PERM = true, HOOK = false, DUPME = true;
    unsigned char* ws; const float* gate_b; const float* cs;
    __device__ __forceinline__ void operator()(ACC_T, const Unit& u, int wr, int wc, int fr, int fq) const {
        const int pn = u.pn, row0 = u.pm * 256 + wr * 64 + fr, lc = wc * 32 + 8 * fq;
        if (pn < 2) {
            bf16_t* dst = (bf16_t*)(ws + (pn == 0 ? WS_RQ : WS_RK)); const float sc = pn == 0 ? 1.0f : 0.125f;
            const int d1 = 16 * (wc & 1) + 4 * fq;
#pragma unroll
            for (int ai = 0; ai < 2; ++ai)
#pragma unroll
                for (int m = 0; m < 4; ++m) { const int row = row0 + ai * 128 + m * 16, pos = row & (SEQ - 1);
                    const f32x4 c4 = *(const f32x4*)(cs + pos * 32 + d1), s4 = *(const f32x4*)(cs + 65536 + pos * 32 + d1);
#pragma unroll
                    for (int bj = 0; bj < 2; ++bj) { const int head = bj * 2 + (wc >> 1); const f32x4 x1 = ldacc<I8IN>(acc[ai][bj][m][0]), x2 = ldacc<I8IN>(acc[ai][bj][m][1]);
                        const f32x4 o1 = (x1 * c4 - x2 * s4) * sc, o2 = (x1 * s4 + x2 * c4) * sc;
                        bf16_t* p = dst + (size_t)row * 256 + head * 64 + d1;
                        v2u w1, w2; w1.x = pg8::cvt_pk_bf16(o1[0], o1[1]); w1.y = pg8::cvt_pk_bf16(o1[2], o1[3]); w2.x = pg8::cvt_pk_bf16(o2[0], o2[1]); w2.y = pg8::cvt_pk_bf16(o2[2], o2[3]);
                        *(v2u*)p = w1; *(v2u*)(p + 32) = w2; } }
            return;
        }
        if (pn < 4) store_act<0>(acc, WS_RV, 512, (pn - 2) * 256, row0, lc);
        else if (pn < 6) store_act<1>(acc, WS_RG, 512, (pn - 4) * 256, row0, lc);
        else if (pn < 8) store_act<2>(acc, WS_FQ, 512, (pn - 6) * 256, row0, lc);
        else if (pn < 10) store_act<0>(acc, WS_FK, 512, (pn - 8) * 256, row0, lc);
        else if (pn < 12) store_act<0>(acc, WS_FV, 512, (pn - 10) * 256, row0, lc);
        else if (pn < 14) store_act<3>(acc, WS_GU, 512, (pn - 12) * 256, row0, lc);
        else if (GATES_FP8 == 2 || P1_I8 || pn < 16) store_act<3>(acc, WS_GV, 512, (pn - 14) * 256, row0, lc);
#if GATES_FP8 != 2 && !P1_I8
        else store_act<4>(acc, WS_GT, 3072, (pn - 16) * 256, row0, lc);
#endif
    }
    template <int ACT>
    __device__ __forceinline__ void store_act(ACC_T, size_t off, int pitch, int coff, int row0, int lc) const {
        bf16_t* dst = (bf16_t*)(ws + off);
        f32x4 bv[2][2];
#pragma unroll
        for (int bj = 0; bj < 2; ++bj)
#pragma unroll
            for (int n = 0; n < 2; ++n) bv[bj][n] = (ACT == 4) ? *(const f32x4*)(gate_b + coff + bj * 128 + lc + 4 * n) : (f32x4){0.f, 0.f, 0.f, 0.f};
#pragma unroll
        for (int ai = 0; ai < 2; ++ai)
#pragma unroll
            for (int m = 0; m < 4; ++m) { bf16_t* rowp = dst + (size_t)(row0 + ai * 128 + m * 16) * pitch + coff + lc;
#pragma unroll
                for (int bj = 0; bj < 2; ++bj) { f2v v[4];
#pragma unroll
                    for (int n = 0; n < 2; ++n) { const f32x4 a = ldacc<I8IN>(acc[ai][bj][m][n]); v[2 * n] = __builtin_shufflevector(a, a, 0, 1); v[2 * n + 1] = __builtin_shufflevector(a, a, 2, 3);
                        if (ACT == 4) { v[2 * n] += __builtin_shufflevector(bv[bj][n], bv[bj][n], 0, 1); v[2 * n + 1] += __builtin_shufflevector(bv[bj][n], bv[bj][n], 2, 3); } }
#pragma unroll
                    for (int j = 0; j < 4; ++j) { f2v x = v[j];
                        if (ACT == 1) x = fsilu2(x); else if (ACT == 2) x = x * C2; else if (ACT == 3) x = fgelu_tanh2(x); else if (ACT == 4) x = fsigmoid2(x);
                        v[j] = x; }
                    v4u w; w.x = pg8::cvt_pk_bf16(v[0].x, v[0].y); w.y = pg8::cvt_pk_bf16(v[1].x, v[1].y); w.z = pg8::cvt_pk_bf16(v[2].x, v[2].y); w.w = pg8::cvt_pk_bf16(v[3].x, v[3].y);
                    *(v4u*)(rowp + bj * 128) = w; } }
    }
};

using EpiProj = EpiProjT<false>;
template <bool I8IN>
struct EpiGate8T {
    static constexpr bool PERM = true, HOOK = false, DUPME = false;
    bf16_t* GT; const float* gate_b;
    __device__ __forceinline__ void operator()(ACC_T, const Unit& u, int wr, int wc, int fr, int fq) const {
        const int row0 = u.pm * 256 + wr * 64 + fr, lc = wc * 32 + 8 * fq, coff = u.pn * 256;
        f32x4 bv[2][2];
#pragma unroll
        for (int bj = 0; bj < 2; ++bj)
#pragma unroll
            for (int n = 0; n < 2; ++n) bv[bj][n] = *(const f32x4*)(gate_b + coff + bj * 128 + lc + 4 * n);
#pragma unroll
        for (int ai = 0; ai < 2; ++ai)
#pragma unroll
            for (int m = 0; m < 4; ++m) { bf16_t* rowp = GT + (size_t)(row0 + ai * 128 + m * 16) * 3072 + coff + lc;
#pragma unroll
                for (int bj = 0; bj < 2; ++bj) { f2v v[4];
#pragma unroll
                    for (int n = 0; n < 2; ++n) { const f32x4 a = ldacc<I8IN>(acc[ai][bj][m][n]) + bv[bj][n]; v[2 * n] = fsigmoid2(__builtin_shufflevector(a, a, 0, 1)); v[2 * n + 1] = fsigmoid2(__builtin_shufflevector(a, a, 2, 3)); }
                    v4u w; w.x = pg8::cvt_pk_bf16(v[0].x, v[0].y); w.y = pg8::cvt_pk_bf16(v[1].x, v[1].y); w.z = pg8::cvt_pk_bf16(v[2].x, v[2].y); w.w = pg8::cvt_pk_bf16(v[3].x, v[3].y);
                    *(v4u*)(rowp + bj * 128) = w; } }
    }
};

using EpiGate8 = EpiGate8T<false>;
template <bool OUT8>
struct EpiMergeT {
    static constexpr bool PERM = true, HOOK = true, DUPME = false;
    const bf16_t* GT; bf16_t* MRG;
    __device__ __forceinline__ void unpackg(const v4u w, float (&g)[8]) const {
        g[0] = bflo(w.x); g[1] = bfhi(w.x); g[2] = bflo(w.y); g[3] = bfhi(w.y); g[4] = bflo(w.z); g[5] = bfhi(w.z); g[6] = bflo(w.w); g[7] = bfhi(w.w);
#pragma unroll
        for (int j = 0; j < 8; ++j) g[j] = fmaxf(g[j], 1e-30f);
    }
    __device__ __forceinline__ void khook(pg8::f32x4 (&acc)[2][2][4][2], const Unit& u, int t, int wr, int wc, int fr, int fq) const {
        if (t != 8 && t != 16) return;
        const int np = (t == 8) ? 0 : 1; int row0 = u.pm * 256 + wr * 64 + fr; const int col0 = u.pn * 256 + wc * 32 + 8 * fq;
        asm volatile("" : "+v"(row0));
#pragma unroll
        for (int ai = 0; ai < 2; ++ai) {
            v4u wp[4][2], wn[4][2];
#pragma unroll
            for (int m = 0; m < 4; ++m)
#pragma unroll
                for (int bj = 0; bj < 2; ++bj) { const bf16_t* p = GT + (size_t)(row0 + ai * 128 + m * 16) * 3072 + np * 1024 + col0 + bj * 128; wp[m][bj] = *(const v4u*)p; wn[m][bj] = *(const v4u*)(p + 1024); }
#pragma unroll
            for (int m = 0; m < 4; ++m)
#pragma unroll
                for (int bj = 0; bj < 2; ++bj) { const unsigned pw[4] = {wp[m][bj].x, wp[m][bj].y, wp[m][bj].z, wp[m][bj].w}, nw[4] = {wn[m][bj].x, wn[m][bj].y, wn[m][bj].z, wn[m][bj].w};
#pragma unroll
                    for (int q = 0; q < 4; ++q) {
                        f2v gp2, gn2; gp2.x = bflo(pw[q]); gp2.y = bfhi(pw[q]); gn2.x = fmaxf(bflo(nw[q]), 1e-30f); gn2.y = fmaxf(bfhi(nw[q]), 1e-30f);
                        f2v r2; r2.x = __builtin_amdgcn_rcpf(gn2.x); r2.y = __builtin_amdgcn_rcpf(gn2.y); const f2v ratio = gp2 * r2;
                        pg8::f32x4& a4 = acc[ai][bj][m][q >> 1];
                        if (q & 1) { a4.z *= ratio.x; a4.w *= ratio.y; } else { a4.x *= ratio.x; a4.y *= ratio.y; } } }
            asm volatile("" ::: "memory");
        }
    }
    __device__ __forceinline__ void operator()(ACC_T, const Unit& u, int wr, int wc, int fr, int fq) const {
        const int row0 = u.pm * 256 + wr * 64 + fr, col0 = u.pn * 256 + wc * 32 + 8 * fq;
#pragma unroll
        for (int ai = 0; ai < 2; ++ai) {
            v4u wg[4][2];
#pragma unroll
            for (int m = 0; m < 4; ++m)
#pragma unroll
                for (int bj = 0; bj < 2; ++bj) wg[m][bj] = *(const v4u*)(GT + (size_t)(row0 + ai * 128 + m * 16) * 3072 + 2048 + col0 + bj * 128);
#pragma unroll
            for (int m = 0; m < 4; ++m)
#pragma unroll
                for (int bj = 0; bj < 2; ++bj) { const unsigned gw[4] = {wg[m][bj].x, wg[m][bj].y, wg[m][bj].z, wg[m][bj].w}; unsigned o[4]; float pf[8];
#pragma unroll
                    for (int q = 0; q < 4; ++q) { f2v g2; g2.x = bflo(gw[q]); g2.y = bfhi(gw[q]); const pg8::f32x4 a4 = acc[ai][bj][m][q >> 1];
                        f2v a2; if (q & 1) { a2.x = a4.z; a2.y = a4.w; } else { a2.x = a4.x; a2.y = a4.y; } const f2v p = a2 * g2;
                        if constexpr (OUT8) { pf[2 * q] = p.x * SC_MI8; pf[2 * q + 1] = p.y * SC_MI8; } else o[q] = pg8::cvt_pk_bf16(p.x, p.y); }
                    if constexpr (OUT8) { v2u w; w.x = pk4_i8(pf[0], pf[1], pf[2], pf[3]); w.y = pk4_i8(pf[4], pf[5], pf[6], pf[7]);
                        *(v2u*)((unsigned char*)MRG + (size_t)(row0 + ai * 128 + m * 16) * 1024 + col0 + bj * 128) = w; }
                    else { v4u w; w.x = o[0]; w.y = o[1]; w.z = o[2]; w.w = o[3];
                    *(v4u*)(MRG + (size_t)(row0 + ai * 128 + m * 16) * 1024 + col0 + bj * 128) = w; } }
            asm volatile("" ::: "memory");
        }
    }
};

struct EpiResid {
    static constexpr bool PERM = false, HOOK = false, DUPME = false;
    const float* res; float* out;
    __device__ __forceinline__ void operator()(ACC_T, const Unit& u, int wr, int wc, int fr, int fq) const {
        const int row0 = u.pm * 256 + wr * 64 + fr, col0 = u.pn * 256 + wc * 32 + 4 * fq;
#pragma unroll
        for (int ai = 0; ai < 2; ++ai)
#pragma unroll
            for (int m = 0; m < 4; ++m) { const size_t off = (size_t)(row0 + ai * 128 + m * 16) * 1024 + col0;
#pragma unroll
                for (int bj = 0; bj < 2; ++bj)
#pragma unroll
                    for (int n = 0; n < 2; ++n) { const f32x4 r = *(const f32x4*)(res + off + bj * 128 + n * 16); *(f32x4*)(out + off + bj * 128 + n * 16) = r * ALPHA + acc[ai][bj][m][n]; } }
    }
};

struct EpiResidI8 {
    static constexpr bool PERM = false, HOOK = false, DUPME = false;
    const float* res; float* out; float inv;
    __device__ __forceinline__ void operator()(ACC_T, const Unit& u, int wr, int wc, int fr, int fq) const {
        const int row0 = u.pm * 256 + wr * 64 + fr, col0 = u.pn * 256 + wc * 32 + 4 * fq;
#pragma unroll
        for (int ai = 0; ai < 2; ++ai)
#pragma unroll
            for (int m = 0; m < 4; ++m) { const size_t off = (size_t)(row0 + ai * 128 + m * 16) * 1024 + col0;
#pragma unroll
                for (int bj = 0; bj < 2; ++bj)
#pragma unroll
                    for (int n = 0; n < 2; ++n) { const f32x4 r = *(const f32x4*)(res + off + bj * 128 + n * 16);
                        *(f32x4*)(out + off + bj * 128 + n * 16) = r * ALPHA + __builtin_convertvector(__builtin_bit_cast(i32x4_t, acc[ai][bj][m][n]), f32x4) * inv; } }
    }
};

struct EpiSwiglu {
    static constexpr bool PERM = true, HOOK = false, DUPME = false;
    bf16_t* H; int ldh;
    __device__ __forceinline__ void operator()(ACC_T, const Unit& u, int wr, int wc, int fr, int fq) const {
        const int row0 = u.pm * 256 + wr * 64 + fr, col0 = u.pn * 128 + wc * 16 + 4 * fq;
#pragma unroll
        for (int ai = 0; ai < 2; ++ai)
#pragma unroll
            for (int m = 0; m < 4; ++m) { bf16_t* rowp = H + (size_t)(row0 + ai * 128 + m * 16) * ldh + col0;
#pragma unroll
                for (int bj = 0; bj < 2; ++bj) { const f32x4 a = acc[ai][bj][m][0], b = acc[ai][bj][m][1];
                    const f2v o01 = fsilu2(__builtin_shufflevector(a, a, 0, 1)) * __builtin_shufflevector(b, b, 0, 1), o23 = fsilu2(__builtin_shufflevector(a, a, 2, 3)) * __builtin_shufflevector(b, b, 2, 3);
                    v2u w; w.x = pg8::cvt_pk_bf16(o01.x, o01.y); w.y = pg8::cvt_pk_bf16(o23.x, o23.y);
                    *(v2u*)(rowp + bj * 64) = w; } }
    }
};

struct EpiSwigluI8 {
    static constexpr bool PERM = true, HOOK = false, DUPME = false;
    bf16_t* H; int ldh;
    __device__ __forceinline__ void operator()(ACC_T, const Unit& u, int wr, int wc, int fr, int fq) const {
        typedef int i32x4_t __attribute__((ext_vector_type(4)));
        constexpr float CA = LOG2E / (SC_XI8 * SC_WI8), CB = 1.0f / (SC_XI8 * SC_WI8 * LOG2E);
        const int row0 = u.pm * 256 + wr * 64 + fr, col0 = u.pn * 128 + wc * 16 + 4 * fq;
#pragma unroll
        for (int ai = 0; ai < 2; ++ai)
#pragma unroll
            for (int m = 0; m < 4; ++m) { bf16_t* rowp = H + (size_t)(row0 + ai * 128 + m * 16) * ldh + col0;
#pragma unroll
                for (int bj = 0; bj < 2; ++bj) {
                    const f32x4 a = __builtin_convertvector(__builtin_bit_cast(i32x4_t, acc[ai][bj][m][0]), f32x4) * CA, b = __builtin_convertvector(__builtin_bit_cast(i32x4_t, acc[ai][bj][m][1]), f32x4) * CB;
                    const f2v o01 = swi_folded2(__builtin_shufflevector(a, a, 0, 1), __builtin_shufflevector(b, b, 0, 1)), o23 = swi_folded2(__builtin_shufflevector(a, a, 2, 3), __builtin_shufflevector(b, b, 2, 3));
                    v2u w; w.x = pg8::cvt_pk_bf16(o01.x, o01.y); w.y = pg8::cvt_pk_bf16(o23.x, o23.y);
                    *(v2u*)(rowp + bj * 64) = w; } }
    }
};

struct MoeTiles {
    int cnt[NEXP]; int toff[NEXP + 1];
    __device__ __forceinline__ void init(const gu32* ctl) {
        int t = 0;
#pragma unroll
        for (int e = 0; e < NEXP; ++e) { cnt[e] = __builtin_amdgcn_readfirstlane((int)__hip_atomic_load(ctl + CW_CNT + 64 * e, RLX_AGENT)); toff[e] = t; t += (cnt[e] + 255) >> 8; }
        toff[NEXP] = t;
    }
    __device__ __forceinline__ void find(int pm, int& e, int& slot0, int& n) const {
        int ee = 0;
#pragma unroll
        for (int j = 1; j < NEXP; ++j) if (pm >= toff[j]) ee = j;
        int c = 0, t0 = 0;
#pragma unroll
        for (int j = 0; j < NEXP; ++j) if (j == ee) { c = cnt[j]; t0 = toff[j]; }
        e = ee; slot0 = (pm - t0) * 256; n = c;
    }
    __device__ __forceinline__ int nfull_total() const { int a = 0;
#pragma unroll
        for (int j = 0; j < NEXP; ++j) a += cnt[j] >> 8;
        return a; }
    __device__ __forceinline__ void findfull(int pmf, int& e, int& lt, int& htile) const {
        int a = 0, ee = 0, ll = 0, hh = 0;
#pragma unroll
        for (int j = 0; j < NEXP; ++j) { const int nf = cnt[j] >> 8; if (pmf >= a && pmf < a + nf) { ee = j; ll = pmf - a; hh = toff[j] + ll; } a += nf; }
        e = ee; lt = ll; htile = hh;
    }
    __device__ __forceinline__ void expert(int e, int& c, int& t0) const { int cc = 0, tt = 0;
#pragma unroll
        for (int j = 0; j < NEXP; ++j) if (j == e) { cc = cnt[j]; tt = toff[j]; }
        c = cc; t0 = tt; }
};
struct MoeUpSched : pg8::TileOrder {
    static constexpr bool GATHER = true;
    const unsigned char* A; const unsigned char* Bt; const unsigned* list; MoeTiles mt;
    __device__ __forceinline__ const char* abase(const Unit&) const { return (const char*)A; }
    __device__ __forceinline__ void aoffs_load(const Unit& u, const int (&R)[2], PG8_LAS unsigned* scr) const {
        int e, s0, n; mt.find(u.pm, e, s0, n);
#pragma unroll
        for (int h = 0; h < 2; ++h)
#pragma unroll
            for (int i = 0; i < 2; ++i) { int slot = s0 + R[i] + h * 128; slot = slot < 16383 ? slot : 16383;
                __builtin_amdgcn_global_load_lds(list + e * 16384 + slot, scr + (h * 2 + i) * 64, 4, 0, 0); }
    }
    __device__ __forceinline__ void aoffs_fin(const Unit& u, const int (&R)[2], const int (&C)[2], const PG8_LAS unsigned* scr, int lane, unsigned (&o)[2][2]) const {
        int e, s0, n; mt.find(u.pm, e, s0, n);
#pragma unroll
        for (int h = 0; h < 2; ++h)
#pragma unroll
            for (int i = 0; i < 2; ++i) { const int slot = s0 + R[i] + h * 128; const unsigned w = scr[(h * 2 + i) * 64 + lane]; const unsigned tok = slot < n ? (w & 0x7fffffffu) : 0u; o[h][i] = tok * 1024u + 2u * (unsigned)C[i]; }
    }
    __device__ __forceinline__ const char* bbase(const Unit& u) const { int e, s0, n; mt.find(u.pm, e, s0, n); return (const char*)Bt + ((size_t)e * (2 * DFF_E) + (size_t)u.pn * 256) * 1024; }
};
struct MoeDownSched : pg8::TileOrder {
    static constexpr bool GATHER = false;
    const unsigned char* A; const unsigned char* Bt; MoeTiles mt;
    __device__ __forceinline__ const char* abase(const Unit& u) const { int e, lt, ht; mt.findfull(u.pm, e, lt, ht); return (const char*)A + (size_t)ht * 256 * DFF_E; }
    __device__ __forceinline__ void aoffs_load(const Unit&, const int (&)[2], PG8_LAS unsigned*) const {}
    __device__ __forceinline__ void aoffs_fin(const Unit&, const int (&)[2], const int (&)[2], const PG8_LAS unsigned*, int, unsigned (&)[2][2]) const {}
    __device__ __forceinline__ const char* bbase(const Unit& u) const { int e, lt, ht; mt.findfull(u.pm, e, lt, ht); return (const char*)Bt + ((size_t)e * 1024 + (size_t)u.pn * 256) * DFF_E; }
};
struct EpiSwiglu8 {
    static constexpr bool PERM = true, HOOK = false, DUPME = false;
    unsigned char* H; int ldh;
    static __device__ __forceinline__ f2v swi8x2(f2v a, f2v b) {
        f2v e; e.x = __builtin_amdgcn_exp2f(-a.x); e.y = __builtin_amdgcn_exp2f(-a.y); const f2v d = e + 1.0f; f2v r; r.x = __builtin_amdgcn_rcpf(d.x); r.y = __builtin_amdgcn_rcpf(d.y); return (a * b) * r; }
    static __device__ __forceinline__ float swi8(float a, float b) { return (a * b) * __builtin_amdgcn_rcpf(1.0f + __builtin_amdgcn_exp2f(-a)); }
    __device__ __forceinline__ void operator()(ACC_T, const Unit& u, int wr, int wc, int fr, int fq) const {
        const int row0 = u.pm * 256 + wr * 64 + fr, col0 = u.pn * 128 + wc * 16;
#pragma unroll
        for (int ai = 0; ai < 2; ++ai)
#pragma unroll
            for (int bj = 0; bj < 2; ++bj) { unsigned x[4];
#pragma unroll
                for (int m = 0; m < 4; ++m) { const f32x4 a = acc[ai][bj][m][0], b = acc[ai][bj][m][1];
                    const f2v o01 = swi8x2(__builtin_shufflevector(a, a, 0, 1), __builtin_shufflevector(b, b, 0, 1)), o23 = swi8x2(__builtin_shufflevector(a, a, 2, 3), __builtin_shufflevector(b, b, 2, 3));
                    x[m] = pk4_fp8(o01.x, o01.y, o23.x, o23.y); }
                const auto p01 = __builtin_amdgcn_permlane16_swap(x[0], x[1], false, false), p23 = __builtin_amdgcn_permlane16_swap(x[2], x[3], false, false);
                const auto q02 = __builtin_amdgcn_permlane32_swap(p01[0], p23[0], false, false), q13 = __builtin_amdgcn_permlane32_swap(p01[1], p23[1], false, false);
                v4u w; w.x = q02[0]; w.y = q13[0]; w.z = q02[1]; w.w = q13[1];
                *(v4u*)(H + (size_t)(row0 + ai * 128 + fq * 16) * ldh + col0 + bj * 64) = w; }
    }
};
struct EpiMoeDown {
    static constexpr bool PERM = true, HOOK = false, DUPME = false;
    bf16_t* c0; bf16_t* c1; const unsigned* list; const float* gatew; MoeTiles mt;
    __device__ __forceinline__ void operator()(ACC_T, const Unit& u, int wr, int wc, int fr, int fq) const {
        int e, lt, ht; mt.findfull(u.pm, e, lt, ht); const int s0 = lt * 256;
        const int col0 = u.pn * 256 + wc * 32 + 8 * fq;
        unsigned ent[2][4]; float gg[2][4];
#pragma unroll
        for (int ai = 0; ai < 2; ++ai)
#pragma unroll
            for (int m = 0; m < 4; ++m) { const int slot = s0 + ai * 128 + wr * 64 + m * 16 + fr; ent[ai][m] = list[e * 16384 + slot]; gg[ai][m] = gatew[e * 16384 + slot]; }
#pragma unroll
        for (int ai = 0; ai < 2; ++ai)
#pragma unroll
            for (int m = 0; m < 4; ++m) { const float g = gg[ai][m];
                bf16_t* dst = ((ent[ai][m] >> 31) ? c1 : c0) + (size_t)(ent[ai][m] & 0x7fffffffu) * 1024 + col0;
#pragma unroll
                for (int bj = 0; bj < 2; ++bj) { const pg8::f32x4 a = acc[ai][bj][m][0] * g, b = acc[ai][bj][m][1] * g;
                    v4u w; w.x = pg8::cvt_pk_bf16(a[0], a[1]); w.y = pg8::cvt_pk_bf16(a[2], a[3]); w.z = pg8::cvt_pk_bf16(b[0], b[1]); w.w = pg8::cvt_pk_bf16(b[2], b[3]);
                    *(v4u*)(dst + bj * 128) = w; } }
    }
};

struct Frame {
    LAS unsigned char* lds;
    volatile LAS unsigned* MISC;
    gu32* ctl;
    int tid, lane, wave;
    int vcu, G;
    unsigned char* ws;
};
__device__ __forceinline__ float wave_sum(float v) {
#pragma unroll
    for (int o = 1; o < 64; o <<= 1) v += __shfl_xor(v, o);
    return v;
}

__device__ __forceinline__ int mapcol(int kind, int dff, int v) {
    if (kind == 0) return v;
    if (kind == 1) {
        if (v < 512) { const int w = v & 63; return (v & ~63) + 32 * ((w >> 2) & 1) + 4 * (w >> 3) + (w & 3); }
        return v < FL_COL ? v : v + 8;
    }
    const int tile = v >> 8, vl = v & 255, n = (vl >> 2) & 1, j = tile * 128 + (vl >> 3) * 4 + (vl & 3);
    return n ? dff + j : j;
}
__device__ __forceinline__ void cvt_item(const float* W, int Nsrc, bf16* dst, int dpitch, int koff, int kind, int dff, int k0, int v0, LAS float* scr, int lane, float f8scale, int vbase) {
    const int v4 = lane & 15, kq = lane >> 4;
    const float* src = W + (size_t)(k0 + kq) * Nsrc + mapcol(kind, dff, vbase + v0 + 4 * v4);
    f32x4 t[16];
#pragma unroll
    for (int it = 0; it < 16; ++it) t[it] = __builtin_nontemporal_load((const f32x4*)(src + (size_t)(4 * it) * Nsrc));
#pragma unroll
    for (int it = 0; it < 16; ++it) *(LAS f32x4*)(scr + (kq + 4 * it) * 68 + 4 * v4) = t[it];
    LDS_WAIT(); asm volatile("" ::: "memory");
    if (f8scale != 0.f) {
        const int c = lane & 3; unsigned char* d8 = (unsigned char*)dst;
        if (f8scale < 0.f) {
#pragma unroll
            for (int j = 0; j < 4; ++j) { const int n = (lane >> 2) + 16 * j; const LAS float* s = scr + (16 * c) * 68 + n; const float q = -f8scale;
                v4u o; o.x = pk4_i8(s[0 * 68] * q, s[1 * 68] * q, s[2 * 68] * q, s[3 * 68] * q); o.y = pk4_i8(s[4 * 68] * q, s[5 * 68] * q, s[6 * 68] * q, s[7 * 68] * q);
                o.z = pk4_i8(s[8 * 68] * q, s[9 * 68] * q, s[10 * 68] * q, s[11 * 68] * q); o.w = pk4_i8(s[12 * 68] * q, s[13 * 68] * q, s[14 * 68] * q, s[15 * 68] * q);
                *(GAS v4u*)(d8 + (size_t)(v0 + n) * dpitch + koff + k0 + 16 * c) = o; }
            LDS_WAIT(); asm volatile("" ::: "memory"); return; }
        if (kind == 2) f8scale *= (lane & 16) ? SWI_B : SWI_A;
#pragma unroll
        for (int j = 0; j < 4; ++j) { const int n = (lane >> 2) + 16 * j; const LAS float* s = scr + (16 * c) * 68 + n;
            v4u o; o.x = pk4_fp8(s[0 * 68] * f8scale, s[1 * 68] * f8scale, s[2 * 68] * f8scale, s[3 * 68] * f8scale); o.y = pk4_fp8(s[4 * 68] * f8scale, s[5 * 68] * f8scale, s[6 * 68] * f8scale, s[7 * 68] * f8scale);
            o.z = pk4_fp8(s[8 * 68] * f8scale, s[9 * 68] * f8scale, s[10 * 68] * f8scale, s[11 * 68] * f8scale); o.w = pk4_fp8(s[12 * 68] * f8scale, s[13 * 68] * f8scale, s[14 * 68] * f8scale, s[15 * 68] * f8scale);
            *(GAS v4u*)(d8 + (size_t)(v0 + n) * dpitch + koff + k0 + 16 * c) = o; }
    } else {
    const int c = lane & 7;
#pragma unroll
    for (int j = 0; j < 8; ++j) { const int n = (lane >> 3) + 8 * j; const LAS float* s = scr + (8 * c) * 68 + n;
        v4u o; o.x = pk2(s[0 * 68], s[1 * 68]); o.y = pk2(s[2 * 68], s[3 * 68]); o.z = pk2(s[4 * 68], s[5 * 68]); o.w = pk2(s[6 * 68], s[7 * 68]);
        *(GAS v4u*)(dst + (size_t)(v0 + n) * dpitch + koff + k0 + 8 * c) = o; }
    }
    LDS_WAIT(); asm volatile("" ::: "memory");
}
struct CvtJob { const float* W; int K, Nsrc, Nv; bf16* dst; int dpitch, koff, kind, dff; float f8scale; int vbase = 0; };
__device__ __forceinline__ bool cvt_run(const CvtJob& j, int& r, LAS float* scr, int lane) {
    const int nvb = j.Nv / 64, items = (j.K / 64) * nvb;
    if (r >= items) { r -= items; return false; }
    cvt_item(j.W, j.Nsrc, j.dst, j.dpitch, j.koff, j.kind, j.dff, 64 * (r / nvb), 64 * (r % nvb), scr, lane, j.f8scale, j.vbase);
    return true;
}

__device__ __forceinline__ float row_dot8(const f32x4 (&v)[4], const LAS float* wT, int lane) {
    float p[8];
#pragma unroll
    for (int h = 0; h < 8; ++h) { float s = 0.f;
#pragma unroll
        for (int j = 0; j < 4; ++j) { const f32x4 w = *(const LAS f32x4*)(wT + h * 1024 + 256 * j + 4 * lane); s += (v[j].x * w.x + v[j].y * w.y) + (v[j].z * w.z + v[j].w * w.w); }
        p[h] = s; }
    const bool b0 = lane & 1, b1 = lane & 2, b2 = lane & 4;
    float q[4], r[2];
#pragma unroll
    for (int k = 0; k < 4; ++k) { const float a = p[2 * k], b = p[2 * k + 1]; q[k] = (b0 ? b : a) + __shfl_xor(b0 ? a : b, 1); }
#pragma unroll
    for (int k = 0; k < 2; ++k) { const float a = q[2 * k], b = q[2 * k + 1]; r[k] = (b1 ? b : a) + __shfl_xor(b1 ? a : b, 2); }
    float t = (b2 ? r[1] : r[0]) + __shfl_xor(b2 ? r[0] : r[1], 4);
    t += __shfl_xor(t, 8); t += __shfl_xor(t, 16); t += __shfl_xor(t, 32);
    return t;
}
__device__ __forceinline__ void stage_w8(Frame& F, const float* W, int pitch, int col0) {
    LAS float* wT = (LAS float*)(F.lds + RING_OFF);
    float t[16];
#pragma unroll
    for (int k = 0; k < 16; ++k) { const int i = F.tid + 512 * k, d = i >> 3, h = i & 7; t[k] = W[(size_t)d * pitch + col0 + h]; }
#pragma unroll
    for (int k = 0; k < 16; ++k) { const int i = F.tid + 512 * k, d = i >> 3, h = i & 7; wT[h * 1024 + d] = t[k]; }
    LDS_WAIT(); __syncthreads();
}
__device__ __forceinline__ float log_sigmoid(float x) {
    const float y = __builtin_amdgcn_exp2f(-fabsf(x) * LOG2E); const float l = (y < 1e-2f) ? y * (1.f - y * (0.5f - y * 0.33333334f)) : __builtin_amdgcn_logf(1.f + y) * 0.6931471805599453f;
    return fminf(x, 0.f) - l; }

__device__ __forceinline__ void p0_rows(Frame& F, const float* x, const float* w_in0, const float* fox_b) {
    stage_w8(F, w_in0, N_INSRC, FL_COL);
    const LAS float* wT = (const LAS float*)(F.lds + RING_OFF);
    const int gw = F.vcu * NWAVES + F.wave, NGW = F.G * NWAVES;
    bf16* XB = (bf16*)(F.ws + WS_XB); float* LOGF = (float*)(F.ws + WS_LOGF);
    f32x4 nx[4];
    if (gw < M) {
#pragma unroll
        for (int j = 0; j < 4; ++j) nx[j] = __builtin_nontemporal_load((const GAS f32x4*)(x + (size_t)gw * D) + F.lane + 64 * j); }
#pragma unroll 1
    for (int m = gw; m < M; m += NGW) {
        f32x4 v[4];
#pragma unroll
        for (int j = 0; j < 4; ++j) v[j] = nx[j];
        if (m + NGW < M) {
#pragma unroll
            for (int j = 0; j < 4; ++j) nx[j] = __builtin_nontemporal_load((const GAS f32x4*)(x + (size_t)(m + NGW) * D) + F.lane + 64 * j); }
#if !P1_I8
        GAS unsigned long long* o8 = (GAS unsigned long long*)(XB + (size_t)m * D) + F.lane;
#pragma unroll
        for (int j = 0; j < 4; ++j) o8[64 * j] = (unsigned long long)pk2(v[j].x, v[j].y) | ((unsigned long long)pk2(v[j].z, v[j].w) << 32);
#endif
#if GATES_FP8 == 2
#pragma unroll
        for (int j = 0; j < 4; ++j) *((GAS unsigned*)(F.ws + WS_X8IN + (size_t)m * D) + F.lane + 64 * j) = P1_I8 ? pk4_i8(v[j].x * SC_XI8, v[j].y * SC_XI8, v[j].z * SC_XI8, v[j].w * SC_XI8) : pk4_fp8(v[j].x * SC_X8, v[j].y * SC_X8, v[j].z * SC_X8, v[j].w * SC_X8);
#endif
        const float r = row_dot8(v, wT, F.lane);
        if (F.lane < 8) LOGF[(size_t)m * 8 + F.lane] = log_sigmoid(r + fox_b[F.lane]);
    }
    __syncthreads();
}

template <int AUX>
__device__ __forceinline__ void ln_pass(Frame& F, const float* src, float src_scale, const bf16* addb1, const bf16* addb2, const float* g, const float* b, float* outf, bf16* outb, unsigned char* out8,
                                        const float* w8, int w8pitch, int w8col, const float* fox_b, bool grp, float o8s = SC_X8) {
    if (AUX != 0) stage_w8(F, w8, w8pitch, w8col);
    const LAS float* wT = (const LAS float*)(F.lds + RING_OFF);
    const int gw = F.vcu * NWAVES + F.wave, NGW = F.G * NWAVES;
    f32x4 gv[4], bv[4];
#pragma unroll
    for (int j = 0; j < 4; ++j) { gv[j] = *((const f32x4*)g + F.lane + 64 * j); bv[j] = *((const f32x4*)b + F.lane + 64 * j); }
    int nbuf = 0, r_i1 = 0, r_i2 = 0, r_m = 0; float r_w1 = 0.f;
#define ROUTER_FLUSH() do { const bool vld_ = F.lane < nbuf; const unsigned long long lt_ = (1ull << F.lane) - 1ull; unsigned n_e_ = 0u, rk1_ = 0u, rk2_ = 0u; \
        _Pragma("unroll") for (int e_ = 0; e_ < 8; ++e_) { const unsigned long long b1_ = __ballot(vld_ && r_i1 == e_), b2_ = __ballot(vld_ && r_i2 == e_); \
            const unsigned c1_ = (unsigned)__popcll(b1_), c2_ = (unsigned)__popcll(b2_); if (F.lane == e_) n_e_ = c1_ + c2_; \
            if (r_i1 == e_) rk1_ = (unsigned)__popcll(b1_ & lt_); if (r_i2 == e_) rk2_ = c1_ + (unsigned)__popcll(b2_ & lt_); } \
        unsigned base_ = 0u; if (F.lane < 8 && n_e_ != 0u) base_ = __hip_atomic_fetch_add(F.ctl + CW_CNT + 64 * F.lane, n_e_, RLX_AGENT); \
        const unsigned s1_ = (unsigned)__shfl((int)base_, r_i1) + rk1_, s2_ = (unsigned)__shfl((int)base_, r_i2) + rk2_; \
        if (vld_) { unsigned* list_ = (unsigned*)(F.ws + WS_LIST); float* gw8_ = (float*)(F.ws + WS_GATEW); \
            list_[r_i1 * 16384 + s1_] = (unsigned)r_m; gw8_[r_i1 * 16384 + s1_] = r_w1; list_[r_i2 * 16384 + s2_] = (unsigned)r_m | 0x80000000u; gw8_[r_i2 * 16384 + s2_] = 1.0f - r_w1; } } while (0)
    const int m0 = grp ? (F.vcu >> 5) * SEQ + (F.vcu & 31) * NWAVES + F.wave : gw, mstep = grp ? 32 * NWAVES : NGW, mend = grp ? ((F.vcu >> 5) + 1) * SEQ : M;
    f32x4 nx[4]; v2u na[4], nc[4];
#define LN_LOAD(mm) do { _Pragma("unroll") for (int j = 0; j < 4; ++j) { nx[j] = __builtin_nontemporal_load((const GAS f32x4*)(src + (size_t)(mm) * D) + F.lane + 64 * j); \
        if (addb1) { na[j] = *((const GAS v2u*)(addb1 + (size_t)(mm) * D) + F.lane + 64 * j); nc[j] = *((const GAS v2u*)(addb2 + (size_t)(mm) * D) + F.lane + 64 * j); } } } while (0)
    if (m0 < mend) LN_LOAD(m0);
#pragma unroll 1
    for (int m = m0; m < mend; m += mstep) {
        f32x4 v[4]; float s = 0.f;
#pragma unroll
        for (int j = 0; j < 4; ++j) { v[j] = nx[j];
            if (addb1) { v[j] = v[j] * src_scale; const v2u a = na[j], c = nc[j];
                v[j].x += bflo(a.x) + bflo(c.x); v[j].y += bfhi(a.x) + bfhi(c.x); v[j].z += bflo(a.y) + bflo(c.y); v[j].w += bfhi(a.y) + bfhi(c.y); }
            s += (v[j].x + v[j].y) + (v[j].z + v[j].w); }
        if (m + mstep < mend) LN_LOAD(m + mstep);
        float lm = s * (1.f / 16.f), m2 = 0.f;
#pragma unroll
        for (int j = 0; j < 4; ++j) { const f32x4 d = v[j] - lm; m2 += (d.x * d.x + d.y * d.y) + (d.z * d.z + d.w * d.w); }
        { float cnt2 = 8.f;
#pragma unroll
          for (int o = 1; o < 64; o <<= 1) { const float om = __shfl_xor(lm, o), o2 = __shfl_xor(m2, o); const float dl = om - lm; m2 = m2 + o2 + dl * dl * cnt2; lm = 0.5f * (lm + om); cnt2 *= 2.f; } }
        const float mean = lm;
#pragma unroll
        for (int j = 0; j < 4; ++j) v[j] = v[j] - mean;
        const float rstd = 1.f / sqrtf(m2 * (1.f / D) + LN_EPS);
#pragma unroll
        for (int j = 0; j < 4; ++j) v[j] = v[j] * rstd * gv[j] + bv[j];
        if (outf) {
#pragma unroll
            for (int j = 0; j < 4; ++j) __builtin_nontemporal_store(v[j], (GAS f32x4*)(outf + (size_t)m * D) + F.lane + 64 * j); }
        if (outb) { GAS unsigned long long* o8 = (GAS unsigned long long*)(outb + (size_t)m * D) + F.lane;
#pragma unroll
            for (int j = 0; j < 4; ++j) o8[64 * j] = (unsigned long long)pk2(v[j].x, v[j].y) | ((unsigned long long)pk2(v[j].z, v[j].w) << 32); }
        if (out8) {
            if (o8s < 0.f) {
#pragma unroll
                for (int j = 0; j < 4; ++j) *((GAS unsigned*)(out8 + (size_t)m * D) + F.lane + 64 * j) = pk4_i8(v[j].x * -o8s, v[j].y * -o8s, v[j].z * -o8s, v[j].w * -o8s);
            } else {
#pragma unroll
            for (int j = 0; j < 4; ++j) *((GAS unsigned*)(out8 + (size_t)m * D) + F.lane + 64 * j) = pk4_fp8(v[j].x * SC_X8, v[j].y * SC_X8, v[j].z * SC_X8, v[j].w * SC_X8); } }
        if (AUX == 1) {
            const float r = row_dot8(v, wT, F.lane);
            if (F.lane < 8) ((float*)(F.ws + WS_LOGF))[(size_t)m * 8 + F.lane] = log_sigmoid(r + fox_b[F.lane]);
        }
        if (AUX == 2) {
            const float rl = row_dot8(v, wT, F.lane); float lg[8];
#pragma unroll
            for (int e = 0; e < 8; ++e) lg[e] = __shfl(rl, e);
            int i1 = 0; float v1 = lg[0];
#pragma unroll
            for (int e = 1; e < 8; ++e) if (lg[e] > v1) { v1 = lg[e]; i1 = e; }
            int i2 = -1; float v2 = -INFINITY;
#pragma unroll
            for (int e = 0; e < 8; ++e) if (e != i1 && lg[e] > v2) { v2 = lg[e]; i2 = e; }
            const float w1 = 1.0f / (1.0f + expf(v2 - v1));
            if (F.lane == nbuf) { r_i1 = i1; r_i2 = i2; r_w1 = w1; r_m = m; }
            if (++nbuf == 64) { ROUTER_FLUSH(); nbuf = 0; }
        }
    }
    if (AUX == 2) { if (nbuf) { ROUTER_FLUSH(); } }
#undef ROUTER_FLUSH
#undef LN_LOAD
    __syncthreads();
}

__device__ __forceinline__ void split3(float b, unsigned& h, unsigned& m, unsigned& l) { h = f2bf(b); const float r1 = b - bf2f((unsigned short)h); m = f2bf(r1); const float r2 = r1 - bf2f((unsigned short)m); l = f2bf(r2); }
template <bool AUG>
__device__ __forceinline__ void fox_bias_table(Frame& F, int b, int h, LAS float* tab, LAS float* wtot) {
    int tid = threadIdx.x; asm volatile("" : "+v"(tid));
    const int lane = tid & 63, wave = __builtin_amdgcn_readfirstlane(tid >> 6);
    const float* lf = (const float*)(F.ws + WS_LOGF) + (size_t)b * SEQ * 8 + h;
    float v[4];
#pragma unroll
    for (int j = 0; j < 4; ++j) v[j] = lf[(size_t)(4 * tid + j) * 8];
    float sj[4]; sj[0] = v[0]; sj[1] = sj[0] + v[1]; sj[2] = sj[1] + v[2]; sj[3] = sj[2] + v[3];
    float x = sj[3];
#pragma unroll
    for (int o = 1; o < 64; o <<= 1) { const float y = __shfl_up(x, o); if (lane >= o) x += y; }
    __syncthreads();
    if (lane == 63) wtot[wave] = x;
    LDS_WAIT(); __syncthreads();
    float base = 0.f;
#pragma unroll
    for (int w = 0; w < 8; ++w) if (w < wave) base += wtot[w];
    const float ex = base + x - sj[3];
#pragma unroll
    for (int j = 0; j < 4; ++j) { const float bv = -(ex + sj[j]) * LOG2E;
        if (AUG) { unsigned hh, mm, ll; split3(bv, hh, mm, ll); v4u w; w.x = hh | (mm << 16); w.y = ll | (0x3F80u << 16); w.z = 0x3F803F80u; w.w = 0u; ((LAS v4u*)tab)[4 * tid + j] = w; }
        else tab[4 * tid + j] = bv; }
    LDS_WAIT(); __syncthreads();
}

#if 1
__device__ __forceinline__ void naive_fox_row(Frame& F, int b, int h, int t, const LAS float* tab) {
    const bf16* FQ = (const bf16*)(F.ws + WS_FQ); const bf16* FK = (const bf16*)(F.ws + WS_FK); const bf16* FV = (const bf16*)(F.ws + WS_FV); bf16* YB = (bf16*)(F.ws + WS_YB);
    const size_t rb = (size_t)b * SEQ;
    float q[64];
    { const v4u* qp = (const v4u*)(FQ + (rb + t) * 512 + h * 64);
#pragma unroll
      for (int c = 0; c < 8; ++c) { const v4u w = qp[c]; q[8 * c + 0] = bflo(w.x); q[8 * c + 1] = bfhi(w.x); q[8 * c + 2] = bflo(w.y); q[8 * c + 3] = bfhi(w.y); q[8 * c + 4] = bflo(w.z); q[8 * c + 5] = bfhi(w.z); q[8 * c + 6] = bflo(w.w); q[8 * c + 7] = bfhi(w.w); } }
    float mx = -INFINITY, l = 0.f, o = 0.f;
    for (int s0 = 0; s0 <= t; s0 += 64) {
        const int s = s0 + F.lane; float sc = -INFINITY;
        if (s <= t) { const v4u* kp = (const v4u*)(FK + (rb + s) * 512 + h * 64); float a = 0.f;
#pragma unroll
            for (int c = 0; c < 8; ++c) { const v4u w = kp[c]; a += q[8 * c + 0] * bflo(w.x) + q[8 * c + 1] * bfhi(w.x) + q[8 * c + 2] * bflo(w.y) + q[8 * c + 3] * bfhi(w.y) + q[8 * c + 4] * bflo(w.z) + q[8 * c + 5] * bfhi(w.z) + q[8 * c + 6] * bflo(w.w) + q[8 * c + 7] * bfhi(w.w); }
            sc = a + tab[s]; }
        float cm = sc;
#pragma unroll
        for (int of = 1; of < 64; of <<= 1) cm = fmaxf(cm, __shfl_xor(cm, of));
        const float nm = fmaxf(mx, cm), f = __builtin_amdgcn_exp2f(mx - nm); const float p = __builtin_amdgcn_exp2f(sc - nm);
        l = l * f + wave_sum(p); o *= f; mx = nm;
        const int ne = (t - s0 + 1) < 64 ? (t - s0 + 1) : 64;
        for (int j = 0; j < ne; ++j) { const float pj = __shfl(p, j); o += pj * bf2f(FV[(rb + s0 + j) * 512 + h * 64 + F.lane]); }
    }
    YB[(rb + t) * 1536 + 512 + h * 64 + F.lane] = (bf16)f2bf(o / l);
}
__device__ __forceinline__ void naive_ret_row(Frame& F, int b, int h, int t) {
    const bf16* RQ = (const bf16*)(F.ws + WS_RQ); const bf16* RK = (const bf16*)(F.ws + WS_RK); const bf16* RV = (const bf16*)(F.ws + WS_RV); const bf16* RG = (const bf16*)(F.ws + WS_RG); bf16* YB = (bf16*)(F.ws + WS_YB);
    const size_t rb = (size_t)b * SEQ;
    const float l2g = log2f(1.0f - exp2f(-5.0f - (float)h));
    float q[64];
    { const v4u* qp = (const v4u*)(RQ + (rb + t) * 256 + h * 64);
#pragma unroll
      for (int c = 0; c < 8; ++c) { const v4u w = qp[c]; q[8 * c + 0] = bflo(w.x); q[8 * c + 1] = bfhi(w.x); q[8 * c + 2] = bflo(w.y); q[8 * c + 3] = bfhi(w.y); q[8 * c + 4] = bflo(w.z); q[8 * c + 5] = bfhi(w.z); q[8 * c + 6] = bflo(w.w); q[8 * c + 7] = bfhi(w.w); } }
    float o0 = 0.f, o1 = 0.f;
    for (int s0 = 0; s0 <= t; s0 += 64) {
        const int s = s0 + F.lane; float sc = 0.f;
        if (s <= t) { const v4u* kp = (const v4u*)(RK + (rb + s) * 256 + h * 64); float a = 0.f;
#pragma unroll
            for (int c = 0; c < 8; ++c) { const v4u w = kp[c]; a += q[8 * c + 0] * bflo(w.x) + q[8 * c + 1] * bfhi(w.x) + q[8 * c + 2] * bflo(w.y) + q[8 * c + 3] * bfhi(w.y) + q[8 * c + 4] * bflo(w.z) + q[8 * c + 5] * bfhi(w.z) + q[8 * c + 6] * bflo(w.w) + q[8 * c + 7] * bfhi(w.w); }
            sc = a * exp2f(l2g * (float)(t - s)); }
        const int ne = (t - s0 + 1) < 64 ? (t - s0 + 1) : 64;
        for (int j = 0; j < ne; ++j) { const float pj = __shfl(sc, j); const bf16* vp = RV + (rb + s0 + j) * 512 + h * 128; o0 += pj * bf2f(vp[F.lane]); o1 += pj * bf2f(vp[F.lane + 64]); }
    }
    const float mean = wave_sum(o0 + o1) * (1.f / 128.f); const float d0 = o0 - mean, d1 = o1 - mean;
    const float rstd = 1.f / sqrtf(wave_sum(d0 * d0 + d1 * d1) * (1.f / 128.f) + GN_EPS);
    const bf16* gp = RG + (rb + t) * 512 + h * 128; bf16* yp = YB + (rb + t) * 1536 + h * 128;
    yp[F.lane] = (bf16)f2bf(bf2f(gp[F.lane]) * d0 * rstd); yp[F.lane + 64] = (bf16)f2bf(bf2f(gp[F.lane + 64]) * d1 * rstd);
}
__device__ __forceinline__ void naive_gmlp_unit(Frame& F, int b, int n, int g, const float* w_s, const float* b_s, const float* lng, const float* lnb) {
    const bf16* GU = (const bf16*)(F.ws + WS_GU); const bf16* GV = (const bf16*)(F.ws + WS_GV); bf16* YB = (bf16*)(F.ws + WS_YB);
    LAS float* st = (LAS float*)(F.lds + RING_OFF);
    const size_t r0 = (size_t)b * SEQ + n * 128;
    __syncthreads();
    for (int r = F.wave; r < 128; r += NWAVES) {
        const v4u w = *((const v4u*)(GV + (r0 + r) * 512) + F.lane);
        float x[8] = {bflo(w.x), bfhi(w.x), bflo(w.y), bfhi(w.y), bflo(w.z), bfhi(w.z), bflo(w.w), bfhi(w.w)};
        float s = 0.f;
#pragma unroll
        for (int j = 0; j < 8; ++j) s += x[j];
        const float mean = wave_sum(s) * (1.f / 512.f); float s2 = 0.f;
#pragma unroll
        for (int j = 0; j < 8; ++j) { const float d = x[j] - mean; s2 += d * d; }
        const float rstd = 1.f / sqrtf(wave_sum(s2) * (1.f / 512.f) + LN_EPS);
        if (F.lane == 0) { st[2 * r] = mean; st[2 * r + 1] = rstd; }
    }
    LDS_WAIT(); __syncthreads();
    const int c = F.tid & 127; const float gam = lng[g * 128 + c], bet = lnb[g * 128 + c];
    for (int i = F.tid >> 7; i < 128; i += 4) {
        float a = 0.f; const float* wr = w_s + ((size_t)g * 128 + i) * 128;
        for (int j = 0; j <= i; ++j) { const float vn = (bf2f(GV[(r0 + j) * 512 + g * 128 + c]) - st[2 * j]) * st[2 * j + 1] * gam + bet; a += wr[j] * vn; }
        const float sp = a + b_s[g * 128 + i];
        YB[(r0 + i) * 1536 + 1024 + g * 128 + c] = (bf16)f2bf(bf2f(GU[(r0 + i) * 512 + g * 128 + c]) * sp);
    }
    __syncthreads();
}
#endif

__device__ __forceinline__ GAS void* lds_ptr(LAS unsigned char* lds, int k) {
    const v2u w = *(const LAS v2u*)(lds + PTAB_OFF + 8 * k);
    const unsigned lo = __builtin_amdgcn_readfirstlane(w.x), hi = __builtin_amdgcn_readfirstlane(w.y);
    return (GAS void*)(((unsigned long long)hi << 32) | lo);
}

typedef short bf16x8_t __attribute__((ext_vector_type(8)));
typedef float f32x16_t __attribute__((ext_vector_type(16)));
#define MFMA32(a, b, c) __builtin_amdgcn_mfma_f32_32x32x16_bf16((a), (b), (c), 0, 0, 0)
__device__ __forceinline__ bf16x8_t ldfrag(const LAS bf16* base, int row, int pitch, int kk, int h2) { return *(const LAS bf16x8_t*)(base + row * pitch + 16 * kk + 8 * h2); }
__device__ __forceinline__ int crow32(int reg, int h2) { return (reg & 3) + 8 * (reg >> 2) + 4 * h2; }
constexpr int RP128 = 136, RP64 = 72;
constexpr int R_QS = 0, R_KS = 4608, R_KDT = 23040, R_VT = 40448, R_SS = 75264, R_ST = 83968, R_OS = 102400, R_END = 119296;
static_assert(R_END <= RING_BYTES, "retention LDS map");
__device__ __forceinline__ void unpack8(const v4u w, float (&x)[8]) { x[0] = bflo(w.x); x[1] = bfhi(w.x); x[2] = bflo(w.y); x[3] = bfhi(w.y); x[4] = bflo(w.z); x[5] = bfhi(w.z); x[6] = bflo(w.w); x[7] = bfhi(w.w); }

__device__ __forceinline__ void ret_unit(Frame& F, int b, int h, int rq) {
    int tid_ = threadIdx.x; asm volatile("" : "+v"(tid_));
    const int tid = tid_, lane = tid & 63, wid = __builtin_amdgcn_readfirstlane(tid >> 6), r = lane & 31, h2 = lane >> 5;
    const float l2g = log2f(1.0f - exp2f(-5.0f - (float)h));
    const float chunk_dec = exp2f(l2g * 128.0f);
    LAS bf16* Qs = (LAS bf16*)(F.lds + RING_OFF + R_QS); LAS bf16* Ks = (LAS bf16*)(F.lds + RING_OFF + R_KS); LAS bf16* KdT = (LAS bf16*)(F.lds + RING_OFF + R_KDT);
    LAS bf16* VT = (LAS bf16*)(F.lds + RING_OFF + R_VT); LAS bf16* Ss = (LAS bf16*)(F.lds + RING_OFF + R_SS); LAS bf16* ST = (LAS bf16*)(F.lds + RING_OFF + R_ST);
    LAS float* Os = (LAS float*)(F.lds + RING_OFF + R_OS);
    const bf16* RQ = (const bf16*)(F.ws + WS_RQ); const bf16* RK = (const bf16*)(F.ws + WS_RK); const bf16* RV = (const bf16*)(F.ws + WS_RV); const bf16* RG = (const bf16*)(F.ws + WS_RG); bf16* YB = (bf16*)(F.ws + WS_YB);
    const size_t rb = (size_t)b * SEQ;
    __syncthreads();
    for (int i = tid; i < 128 * RP64 / 2; i += NWAVES * 64) ((LAS unsigned*)ST)[i] = 0u;
    f32x16_t st = {0.f, 0.f, 0.f, 0.f, 0.f, 0.f, 0.f, 0.f, 0.f, 0.f, 0.f, 0.f, 0.f, 0.f, 0.f, 0.f};
    const int sj = tid & 127, cq = tid >> 7, qi = tid & 31, qc = tid >> 5, gi = tid >> 4, gs = tid & 15;
    v4u qreg = {0u, 0u, 0u, 0u}, kreg[2], vreg[4], greg;
#define RET_LOAD(n) do { const size_t r0_ = rb + (size_t)(n) * 128; \
        if (tid < 256) qreg = *(const v4u*)(RQ + (r0_ + 32 * rq + qi) * 256 + h * 64 + 8 * qc); \
        _Pragma("unroll") for (int c_ = 0; c_ < 2; ++c_) kreg[c_] = *(const v4u*)(RK + (r0_ + sj) * 256 + h * 64 + 16 * cq + 8 * c_); \
        _Pragma("unroll") for (int c_ = 0; c_ < 4; ++c_) vreg[c_] = *(const v4u*)(RV + (r0_ + sj) * 512 + h * 128 + 32 * cq + 8 * c_); \
        greg = *(const v4u*)(RG + (r0_ + 32 * rq + gi) * 512 + h * 128 + 8 * gs); } while (0)
    RET_LOAD(0);
    const float kdec = exp2f(l2g * (float)(127 - sj));
#pragma unroll 1
    for (int n = 0; n < 16; ++n) {
        if (tid < 256) *(LAS v4u*)(Qs + qi * RP64 + 8 * qc) = qreg;
#pragma unroll
        for (int c = 0; c < 2; ++c) { *(LAS v4u*)(Ks + sj * RP64 + 16 * cq + 8 * c) = kreg[c]; float x[8]; unpack8(kreg[c], x);
#pragma unroll
            for (int e = 0; e < 8; ++e) KdT[(16 * cq + 8 * c + e) * RP128 + sj] = (bf16)f2bf(x[e] * kdec); }
#pragma unroll
        for (int c = 0; c < 4; ++c) { const v4u w = vreg[c]; const unsigned ww[4] = {w.x, w.y, w.z, w.w};
#pragma unroll
            for (int e = 0; e < 8; ++e) VT[(32 * cq + 8 * c + e) * RP128 + sj] = (bf16)((e & 1) ? (ww[e >> 1] >> 16) : (ww[e >> 1] & 0xffffu)); }
        const v4u gcur = greg;
        LDS_WAIT(); __syncthreads();
        if (n + 1 < 16) RET_LOAD(n + 1);
        f32x16_t x = {0.f, 0.f, 0.f, 0.f, 0.f, 0.f, 0.f, 0.f, 0.f, 0.f, 0.f, 0.f, 0.f, 0.f, 0.f, 0.f};
        if (wid < 4) {
#pragma unroll
            for (int kk = 0; kk < 4; ++kk) x = MFMA32(ldfrag(Qs, r, RP64, kk, h2), ldfrag(Ks, 32 * wid + r, RP64, kk, h2), x);
            const int jabs = 32 * wid + r;
#pragma unroll
            for (int reg = 0; reg < 16; ++reg) { const int i = crow32(reg, h2), diff = 32 * rq + i - jabs;
                const float val = diff >= 0 ? x[reg] * exp2f(l2g * (float)diff) : 0.f; Ss[i * RP128 + jabs] = (bf16)f2bf(val); }
        } else {
#pragma unroll
            for (int kk = 0; kk < 4; ++kk) x = MFMA32(ldfrag(Qs, r, RP64, kk, h2), ldfrag(ST, 32 * (wid - 4) + r, RP64, kk, h2), x);
#pragma unroll
            for (int reg = 0; reg < 16; ++reg) x[reg] *= exp2f(l2g * (float)(32 * rq + crow32(reg, h2) + 1));
        }
        { const int db = wid >> 2, vb2 = wid & 3;
#pragma unroll
          for (int reg = 0; reg < 16; ++reg) st[reg] *= chunk_dec;
#pragma unroll
          for (int kk = 0; kk < 8; ++kk) st = MFMA32(ldfrag(KdT, 32 * db + r, RP128, kk, h2), ldfrag(VT, 32 * vb2 + r, RP128, kk, h2), st); }
        LDS_WAIT(); __syncthreads();
        { const int db = wid >> 2, vb2 = wid & 3;
#pragma unroll
          for (int g = 0; g < 4; ++g) { v2u w; w.x = pk2(st[4 * g], st[4 * g + 1]); w.y = pk2(st[4 * g + 2], st[4 * g + 3]); *(LAS v2u*)(ST + (32 * vb2 + r) * RP64 + 32 * db + 8 * g + 4 * h2) = w; } }
        if (wid >= 4) {
#pragma unroll
            for (int kk = 0; kk < 8; ++kk) x = MFMA32(ldfrag(Ss, r, RP128, kk, h2), ldfrag(VT, 32 * (wid - 4) + r, RP128, kk, h2), x);
#pragma unroll
            for (int reg = 0; reg < 16; ++reg) Os[crow32(reg, h2) * 132 + 32 * (wid - 4) + r] = x[reg];
        }
        LDS_WAIT(); __syncthreads();
        { const f32x4 a0 = *(const LAS f32x4*)(Os + gi * 132 + 8 * gs), a1 = *(const LAS f32x4*)(Os + gi * 132 + 8 * gs + 4);
          float sm = (a0.x + a0.y) + (a0.z + a0.w) + (a1.x + a1.y) + (a1.z + a1.w);
#pragma unroll
          for (int o = 1; o < 16; o <<= 1) sm += __shfl_xor(sm, o);
          const float mean = sm * (1.f / 128.f); const f32x4 d0 = a0 - mean, d1 = a1 - mean;
          float sq = (d0.x * d0.x + d0.y * d0.y) + (d0.z * d0.z + d0.w * d0.w) + (d1.x * d1.x + d1.y * d1.y) + (d1.z * d1.z + d1.w * d1.w);
#pragma unroll
          for (int o = 1; o < 16; o <<= 1) sq += __shfl_xor(sq, o);
          const float rstd = 1.f / sqrtf(sq * (1.f / 128.f) + GN_EPS); float gt[8]; unpack8(gcur, gt);
          v4u w; w.x = pk2(gt[0] * d0.x * rstd, gt[1] * d0.y * rstd); w.y = pk2(gt[2] * d0.z * rstd, gt[3] * d0.w * rstd); w.z = pk2(gt[4] * d1.x * rstd, gt[5] * d1.y * rstd); w.w = pk2(gt[6] * d1.z * rstd, gt[7] * d1.w * rstd);
          *(v4u*)(YB + (rb + (size_t)n * 128 + 32 * rq + gi) * 1536 + h * 128 + 8 * gs) = w; }
    }
#undef RET_LOAD
    __syncthreads();
}


#define MFMA16(a, b, c) __builtin_amdgcn_mfma_f32_16x16x32_bf16((a), (b), (c), 0, 0, 0)
__device__ __forceinline__ bf16x8_t ldfrag16(const LAS bf16* base, int row, int pitch, int ks, int q4) { return *(const LAS bf16x8_t*)(base + row * pitch + 32 * ks + 8 * q4); }
__device__ __forceinline__ void ret_kv_unit(Frame& F, int b, int h, int n) {
    int tid_ = threadIdx.x; asm volatile("" : "+v"(tid_));
    const int tid = tid_, lane = tid & 63, wid = __builtin_amdgcn_readfirstlane(tid >> 6), r = lane & 31, h2 = lane >> 5;
    const float l2g = log2f(1.0f - exp2f(-5.0f - (float)h));
    LAS bf16* KdT = (LAS bf16*)(F.lds + RING_OFF); LAS bf16* VT = (LAS bf16*)(F.lds + RING_OFF + 17408);
    const bf16* RK = (const bf16*)(F.ws + WS_RK); const bf16* RV = (const bf16*)(F.ws + WS_RV);
    const size_t r0 = (size_t)b * SEQ + (size_t)n * 128;
    const int sj = tid & 127, cq = tid >> 7; const float kdec = exp2f(l2g * (float)(127 - sj));
    v4u kreg[2], vreg[4];
#pragma unroll
    for (int c = 0; c < 2; ++c) kreg[c] = *(const v4u*)(RK + (r0 + sj) * 256 + h * 64 + 16 * cq + 8 * c);
#pragma unroll
    for (int c = 0; c < 4; ++c) vreg[c] = *(const v4u*)(RV + (r0 + sj) * 512 + h * 128 + 32 * cq + 8 * c);
    __syncthreads();
#pragma unroll
    for (int c = 0; c < 2; ++c) { float x[8]; unpack8(kreg[c], x);
#pragma unroll
        for (int e = 0; e < 8; ++e) KdT[(16 * cq + 8 * c + e) * RP128 + sj] = (bf16)f2bf(x[e] * kdec); }
#pragma unroll
    for (int c = 0; c < 4; ++c) { const v4u w = vreg[c]; const unsigned ww[4] = {w.x, w.y, w.z, w.w};
#pragma unroll
        for (int e = 0; e < 8; ++e) VT[(32 * cq + 8 * c + e) * RP128 + sj] = (bf16)((e & 1) ? (ww[e >> 1] >> 16) : (ww[e >> 1] & 0xffffu)); }
    LDS_WAIT(); __syncthreads();
    const int db = wid >> 2, vb = wid & 3;
    f32x16_t st = {0.f, 0.f, 0.f, 0.f, 0.f, 0.f, 0.f, 0.f, 0.f, 0.f, 0.f, 0.f, 0.f, 0.f, 0.f, 0.f};
#pragma unroll
    for (int kk = 0; kk < 8; ++kk) st = MFMA32(ldfrag(KdT, 32 * db + r, RP128, kk, h2), ldfrag(VT, 32 * vb + r, RP128, kk, h2), st);
    float* KV = (float*)(F.ws + WS_KV) + ((size_t)((b * 4 + h) * 16 + n)) * 8192;
#pragma unroll
    for (int reg = 0; reg < 16; ++reg) KV[(32 * db + crow32(reg, h2)) * 128 + 32 * vb + r] = st[reg];
    __syncthreads();
}
constexpr int RB_QS = 0, RB_KS = 18432, RB_VT = 36864, RB_ST = 71680, RB_SW = 90112, RB_END = 124928;
static_assert(RB_END <= RING_BYTES, "retention pass B LDS map");
__device__ __forceinline__ void ret_out_unit(Frame& F, int b, int h, int n) {
    int tid_ = threadIdx.x; asm volatile("" : "+v"(tid_));
    const int tid = tid_, lane = tid & 63, wid = __builtin_amdgcn_readfirstlane(tid >> 6), l15 = lane & 15, q4 = lane >> 4;
    const float l2g = log2f(1.0f - exp2f(-5.0f - (float)h));
    const float chunk_dec = exp2f(l2g * 128.0f);
    LAS bf16* Qs = (LAS bf16*)(F.lds + RING_OFF + RB_QS); LAS bf16* Ks = (LAS bf16*)(F.lds + RING_OFF + RB_KS); LAS bf16* VT = (LAS bf16*)(F.lds + RING_OFF + RB_VT);
    LAS bf16* ST = (LAS bf16*)(F.lds + RING_OFF + RB_ST); LAS bf16* Sw = (LAS bf16*)(F.lds + RING_OFF + RB_SW) + wid * (16 * RP128);
    const bf16* RQ = (const bf16*)(F.ws + WS_RQ); const bf16* RK = (const bf16*)(F.ws + WS_RK); const bf16* RV = (const bf16*)(F.ws + WS_RV); const bf16* RG = (const bf16*)(F.ws + WS_RG); bf16* YB = (bf16*)(F.ws + WS_YB);
    const size_t r0 = (size_t)b * SEQ + (size_t)n * 128;
    const int sj = tid & 127, cq = tid >> 7;
    v4u qreg[2], kreg[2], vreg[4];
#pragma unroll
    for (int c = 0; c < 2; ++c) { qreg[c] = *(const v4u*)(RQ + (r0 + sj) * 256 + h * 64 + 16 * cq + 8 * c); kreg[c] = *(const v4u*)(RK + (r0 + sj) * 256 + h * 64 + 16 * cq + 8 * c); }
#pragma unroll
    for (int c = 0; c < 4; ++c) vreg[c] = *(const v4u*)(RV + (r0 + sj) * 512 + h * 128 + 32 * cq + 8 * c);
    f32x4 sa[4] = {{0.f, 0.f, 0.f, 0.f}, {0.f, 0.f, 0.f, 0.f}, {0.f, 0.f, 0.f, 0.f}, {0.f, 0.f, 0.f, 0.f}};
    { const float* KV = (const float*)(F.ws + WS_KV) + ((size_t)((b * 4 + h) * 16)) * 8192 + (size_t)tid * 16;
#pragma unroll 4
      for (int m = 0; m < n; ++m) {
#pragma unroll
          for (int c = 0; c < 4; ++c) { const f32x4 kv = *(const f32x4*)(KV + (size_t)m * 8192 + 4 * c); sa[c] = sa[c] * chunk_dec + kv; } } }
    __syncthreads();
    { const int d = tid >> 3, v0 = 16 * (tid & 7);
#pragma unroll
      for (int c = 0; c < 4; ++c)
#pragma unroll
          for (int e = 0; e < 4; ++e) ST[(v0 + 4 * c + e) * RP64 + d] = (bf16)f2bf(sa[c][e]); }
#pragma unroll
    for (int c = 0; c < 2; ++c) { *(LAS v4u*)(Qs + sj * RP64 + 16 * cq + 8 * c) = qreg[c]; *(LAS v4u*)(Ks + sj * RP64 + 16 * cq + 8 * c) = kreg[c]; }
#pragma unroll
    for (int c = 0; c < 4; ++c) { const v4u w = vreg[c]; const unsigned ww[4] = {w.x, w.y, w.z, w.w};
#pragma unroll
        for (int e = 0; e < 8; ++e) VT[(32 * cq + 8 * c + e) * RP128 + sj] = (bf16)((e & 1) ? (ww[e >> 1] >> 16) : (ww[e >> 1] & 0xffffu)); }
    LDS_WAIT(); __syncthreads();
    const int i0 = 16 * wid;
    const bf16x8_t qa0 = ldfrag16(Qs, i0 + l15, RP64, 0, q4), qa1 = ldfrag16(Qs, i0 + l15, RP64, 1, q4);
#pragma unroll 1
    for (int kb = 0; kb <= (wid | 1); kb += 2) {
        f32x4 sc[2];
#pragma unroll
        for (int u = 0; u < 2; ++u) { sc[u] = (f32x4){0.f, 0.f, 0.f, 0.f};
            sc[u] = MFMA16(qa0, ldfrag16(Ks, 16 * (kb + u) + l15, RP64, 0, q4), sc[u]); sc[u] = MFMA16(qa1, ldfrag16(Ks, 16 * (kb + u) + l15, RP64, 1, q4), sc[u]); }
#pragma unroll
        for (int u = 0; u < 2; ++u) { const int j = 16 * (kb + u) + l15;
#pragma unroll
            for (int reg = 0; reg < 4; ++reg) { const int il = 4 * q4 + reg, diff = i0 + il - j; Sw[il * RP128 + j] = (bf16)f2bf(diff >= 0 ? sc[u][reg] * __builtin_amdgcn_exp2f(l2g * (float)diff) : 0.f); } }
    }
    LDS_WAIT();
    float qd[4];
#pragma unroll
    for (int reg = 0; reg < 4; ++reg) qd[reg] = __builtin_amdgcn_exp2f(l2g * (float)(i0 + 4 * q4 + reg + 1));
    f32x4 o[8];
    const int nks = (wid + 2) >> 1;
#pragma unroll
    for (int vb = 0; vb < 8; ++vb) {
        f32x4 x = {0.f, 0.f, 0.f, 0.f};
        x = MFMA16(qa0, ldfrag16(ST, 16 * vb + l15, RP64, 0, q4), x); x = MFMA16(qa1, ldfrag16(ST, 16 * vb + l15, RP64, 1, q4), x);
#pragma unroll
        for (int reg = 0; reg < 4; ++reg) x[reg] *= qd[reg];
        o[vb] = x;
    }
#pragma unroll 1
    for (int ks = 0; ks < nks; ++ks) {
        const bf16x8_t a = ldfrag16(Sw, l15, RP128, ks, q4);
#pragma unroll
        for (int vb = 0; vb < 8; ++vb) o[vb] = MFMA16(a, ldfrag16(VT, 16 * vb + l15, RP128, ks, q4), o[vb]);
    }
    float mean[4], rstd[4];
#pragma unroll
    for (int reg = 0; reg < 4; ++reg) { float sm = 0.f;
#pragma unroll
        for (int vb = 0; vb < 8; ++vb) sm += o[vb][reg];
#pragma unroll
        for (int of = 1; of < 16; of <<= 1) sm += __shfl_xor(sm, of);
        mean[reg] = sm * (1.f / 128.f); float sq = 0.f;
#pragma unroll
        for (int vb = 0; vb < 8; ++vb) { const float d = o[vb][reg] - mean[reg]; sq += d * d; }
#pragma unroll
        for (int of = 1; of < 16; of <<= 1) sq += __shfl_xor(sq, of);
        rstd[reg] = 1.f / sqrtf(sq * (1.f / 128.f) + GN_EPS); }
#pragma unroll
    for (int vb = 0; vb < 8; ++vb)
#pragma unroll
        for (int reg = 0; reg < 4; ++reg) Sw[(4 * q4 + reg) * RP128 + 16 * vb + l15] = (bf16)f2bf((o[vb][reg] - mean[reg]) * rstd[reg]);
    LDS_WAIT();
#pragma unroll
    for (int c = 0; c < 4; ++c) { const int ch = c * 64 + lane, row = ch >> 4, cc = ch & 15;
        float xn[8], gt[8]; unpack8(*(const LAS v4u*)(Sw + row * RP128 + 8 * cc), xn); unpack8(*(const v4u*)(RG + (r0 + i0 + row) * 512 + h * 128 + 8 * cc), gt);
        v4u w; w.x = pk2(xn[0] * gt[0], xn[1] * gt[1]); w.y = pk2(xn[2] * gt[2], xn[3] * gt[3]); w.z = pk2(xn[4] * gt[4], xn[5] * gt[5]); w.w = pk2(xn[6] * gt[6], xn[7] * gt[7]);
        *(v4u*)(YB + (r0 + i0 + row) * 1536 + h * 128 + 8 * cc) = w; }
    __syncthreads();
}

constexpr int G_WS = 0, G_VNT = 34816, G_STAT = 69632, G_END = 70656;
__device__ __forceinline__ void gmlp_unit(Frame& F, int b, int n, int g, const float* w_s, const float* b_s, const float* lng, const float* lnb) {
    int tid_ = threadIdx.x; asm volatile("" : "+v"(tid_));
    const int tid = tid_, lane = tid & 63, wid = __builtin_amdgcn_readfirstlane(tid >> 6), r = lane & 31, h2 = lane >> 5;
    const bf16* GU = (const bf16*)(F.ws + WS_GU); const bf16* GV = (const bf16*)(F.ws + WS_GV); bf16* YB = (bf16*)(F.ws + WS_YB);
    LAS bf16* Ws = (LAS bf16*)(F.lds + RING_OFF + G_WS); LAS bf16* VnT = (LAS bf16*)(F.lds + RING_OFF + G_VNT); LAS float* stt = (LAS float*)(F.lds + RING_OFF + G_STAT);
    const size_t r0 = (size_t)b * SEQ + (size_t)n * 128;
    __syncthreads();
    for (int rr = wid; rr < 128; rr += NWAVES) {
        float x[8]; unpack8(*((const v4u*)(GV + (r0 + rr) * 512) + lane), x);
        float s = 0.f;
#pragma unroll
        for (int j = 0; j < 8; ++j) s += x[j];
        const float mean = wave_sum(s) * (1.f / 512.f); float s2 = 0.f;
#pragma unroll
        for (int j = 0; j < 8; ++j) { const float d = x[j] - mean; s2 += d * d; }
        const float rstd = 1.f / sqrtf(wave_sum(s2) * (1.f / 512.f) + LN_EPS);
        if (lane == 0) { stt[2 * rr] = mean; stt[2 * rr + 1] = rstd; }
    }
    { const int i = tid >> 2, jq = tid & 3; const float* wr = w_s + ((size_t)g * 128 + i) * 128 + 32 * jq;
#pragma unroll
      for (int c = 0; c < 4; ++c) { const f32x4 a = *(const f32x4*)(wr + 8 * c), bq = *(const f32x4*)(wr + 8 * c + 4); const int j0 = 32 * jq + 8 * c;
          v4u w; w.x = pk2(j0 + 0 <= i ? a.x : 0.f, j0 + 1 <= i ? a.y : 0.f); w.y = pk2(j0 + 2 <= i ? a.z : 0.f, j0 + 3 <= i ? a.w : 0.f);
          w.z = pk2(j0 + 4 <= i ? bq.x : 0.f, j0 + 5 <= i ? bq.y : 0.f); w.w = pk2(j0 + 6 <= i ? bq.z : 0.f, j0 + 7 <= i ? bq.w : 0.f);
          *(LAS v4u*)(Ws + i * RP128 + j0) = w; } }
    LDS_WAIT(); __syncthreads();
    { const int sj = tid & 127, cq = tid >> 7; const float mu = stt[2 * sj], rs = stt[2 * sj + 1];
#pragma unroll
      for (int c = 0; c < 4; ++c) { float x[8]; unpack8(*(const v4u*)(GV + (r0 + sj) * 512 + g * 128 + 32 * cq + 8 * c), x);
          const f32x4 ga = *(const f32x4*)(lng + g * 128 + 32 * cq + 8 * c), gb = *(const f32x4*)(lng + g * 128 + 32 * cq + 8 * c + 4);
          const f32x4 ba = *(const f32x4*)(lnb + g * 128 + 32 * cq + 8 * c), bb = *(const f32x4*)(lnb + g * 128 + 32 * cq + 8 * c + 4);
          const float gm[8] = {ga.x, ga.y, ga.z, ga.w, gb.x, gb.y, gb.z, gb.w}, bt[8] = {ba.x, ba.y, ba.z, ba.w, bb.x, bb.y, bb.z, bb.w};
#pragma unroll
          for (int e = 0; e < 8; ++e) VnT[(32 * cq + 8 * c + e) * RP128 + sj] = (bf16)f2bf((x[e] - mu) * rs * gm[e] + bt[e]); } }
    LDS_WAIT(); __syncthreads();
    { const int ib = wid >> 1;
#pragma unroll
      for (int cc = 0; cc < 2; ++cc) { const int cb = 2 * (wid & 1) + cc;
          f32x16_t x = {0.f, 0.f, 0.f, 0.f, 0.f, 0.f, 0.f, 0.f, 0.f, 0.f, 0.f, 0.f, 0.f, 0.f, 0.f, 0.f};
#pragma unroll
          for (int kk = 0; kk < 8; ++kk) x = MFMA32(ldfrag(Ws, 32 * ib + r, RP128, kk, h2), ldfrag(VnT, 32 * cb + r, RP128, kk, h2), x);
          const int c = g * 128 + 32 * cb + r;
#pragma unroll
          for (int reg = 0; reg < 16; ++reg) { const int i = 32 * ib + crow32(reg, h2); const float sp = x[reg] + b_s[g * 128 + i];
              YB[(r0 + i) * 1536 + 1024 + c] = (bf16)f2bf(bf2f(GU[(r0 + i) * 512 + c]) * sp); } } }
    __syncthreads();
}


__device__ __forceinline__ void gmlp_stat_unit(Frame& F, int b, int n) {
    int tid_ = threadIdx.x; asm volatile("" : "+v"(tid_));
    const int tid = tid_, row = tid >> 2, qt = tid & 3;
    const bf16* GV = (const bf16*)(F.ws + WS_GV); float* GST = (float*)(F.ws + WS_GST);
    const size_t r = (size_t)b * SEQ + (size_t)n * 128 + row;
    v4u w[16];
#pragma unroll
    for (int c = 0; c < 16; ++c) w[c] = *(const v4u*)(GV + r * 512 + 128 * qt + 8 * c);
    float s = 0.f;
#pragma unroll
    for (int c = 0; c < 16; ++c) { float x[8]; unpack8(w[c], x); s += ((x[0] + x[1]) + (x[2] + x[3])) + ((x[4] + x[5]) + (x[6] + x[7])); }
    s += __shfl_xor(s, 1); s += __shfl_xor(s, 2);
    const float mean = s * (1.f / 512.f); float s2 = 0.f;
#pragma unroll
    for (int c = 0; c < 16; ++c) { float x[8]; unpack8(w[c], x);
#pragma unroll
        for (int e = 0; e < 8; ++e) { const float d = x[e] - mean; s2 += d * d; } }
    s2 += __shfl_xor(s2, 1); s2 += __shfl_xor(s2, 2);
    if (qt == 0) { GST[2 * r] = mean; GST[2 * r + 1] = 1.f / sqrtf(s2 * (1.f / 512.f) + LN_EPS); }
}
constexpr int G2_WS = 0, G2_VNT = 34816, G2_SW = 69632, G2_END = 104448;
__device__ __forceinline__ void gmlp_unit2(Frame& F, int b, int n, int g, const float* w_s, const float* b_s, const float* lng, const float* lnb) {
    int tid_ = threadIdx.x; asm volatile("" : "+v"(tid_));
    const int tid = tid_, lane = tid & 63, wid = __builtin_amdgcn_readfirstlane(tid >> 6), l15 = lane & 15, q4 = lane >> 4;
    const bf16* GU = (const bf16*)(F.ws + WS_GU); const bf16* GV = (const bf16*)(F.ws + WS_GV); bf16* YB = (bf16*)(F.ws + WS_YB); const float* GST = (const float*)(F.ws + WS_GST);
    LAS bf16* Ws = (LAS bf16*)(F.lds + RING_OFF + G2_WS); LAS bf16* VnT = (LAS bf16*)(F.lds + RING_OFF + G2_VNT); LAS bf16* Sw = (LAS bf16*)(F.lds + RING_OFF + G2_SW) + wid * (16 * RP128);
    const size_t r0 = (size_t)b * SEQ + (size_t)n * 128;
    const int sj = tid & 127, cq = tid >> 7, wi = tid >> 2, jq = tid & 3;
    v4u vreg[4]; f32x4 wreg[8];
#pragma unroll
    for (int c = 0; c < 4; ++c) vreg[c] = *(const v4u*)(GV + (r0 + sj) * 512 + g * 128 + 32 * cq + 8 * c);
    const float mu = GST[2 * (r0 + sj)], rs = GST[2 * (r0 + sj) + 1];
    { const float* wr = w_s + ((size_t)g * 128 + wi) * 128 + 32 * jq;
#pragma unroll
      for (int c = 0; c < 8; ++c) wreg[c] = *(const f32x4*)(wr + 4 * c); }
    __syncthreads();
#pragma unroll
    for (int c = 0; c < 4; ++c) { const int j0 = 32 * jq + 8 * c; const f32x4 a = wreg[2 * c], bq = wreg[2 * c + 1];
        v4u w; w.x = pk2(j0 + 0 <= wi ? a.x : 0.f, j0 + 1 <= wi ? a.y : 0.f); w.y = pk2(j0 + 2 <= wi ? a.z : 0.f, j0 + 3 <= wi ? a.w : 0.f);
        w.z = pk2(j0 + 4 <= wi ? bq.x : 0.f, j0 + 5 <= wi ? bq.y : 0.f); w.w = pk2(j0 + 6 <= wi ? bq.z : 0.f, j0 + 7 <= wi ? bq.w : 0.f);
        *(LAS v4u*)(Ws + wi * RP128 + j0) = w; }
#pragma unroll
    for (int c = 0; c < 4; ++c) { float x[8]; unpack8(vreg[c], x);
        const f32x4 ga = *(const f32x4*)(lng + g * 128 + 32 * cq + 8 * c), gb = *(const f32x4*)(lng + g * 128 + 32 * cq + 8 * c + 4);
        const f32x4 ba = *(const f32x4*)(lnb + g * 128 + 32 * cq + 8 * c), bb = *(const f32x4*)(lnb + g * 128 + 32 * cq + 8 * c + 4);
        const float gm[8] = {ga.x, ga.y, ga.z, ga.w, gb.x, gb.y, gb.z, gb.w}, bt[8] = {ba.x, ba.y, ba.z, ba.w, bb.x, bb.y, bb.z, bb.w};
#pragma unroll
        for (int e = 0; e < 8; ++e) VnT[(32 * cq + 8 * c + e) * RP128 + sj] = (bf16)f2bf((x[e] - mu) * rs * gm[e] + bt[e]); }
    LDS_WAIT(); __syncthreads();
    const int i0 = 16 * wid, nks = (wid + 2) >> 1;
    float bs[4];
#pragma unroll
    for (int reg = 0; reg < 4; ++reg) bs[reg] = b_s[g * 128 + i0 + 4 * q4 + reg];
    { f32x4 x[8];
#pragma unroll
      for (int cb = 0; cb < 8; ++cb) x[cb] = (f32x4){0.f, 0.f, 0.f, 0.f};
#pragma unroll 1
      for (int ks = 0; ks < nks; ++ks) {
          const bf16x8_t a = ldfrag16(Ws, i0 + l15, RP128, ks, q4);
#pragma unroll
          for (int cb = 0; cb < 8; ++cb) x[cb] = MFMA16(a, ldfrag16(VnT, 16 * cb + l15, RP128, ks, q4), x[cb]);
      }
#pragma unroll
      for (int cb = 0; cb < 8; ++cb)
#pragma unroll
          for (int reg = 0; reg < 4; ++reg) Sw[(4 * q4 + reg) * RP128 + 16 * cb + l15] = (bf16)f2bf(x[cb][reg] + bs[reg]);
    }
    LDS_WAIT();
#pragma unroll
    for (int c = 0; c < 4; ++c) { const int ch = c * 64 + lane, row = ch >> 4, cc = ch & 15;
        float sp[8], gu[8]; unpack8(*(const LAS v4u*)(Sw + row * RP128 + 8 * cc), sp); unpack8(*(const v4u*)(GU + (r0 + i0 + row) * 512 + g * 128 + 8 * cc), gu);
        v4u w; w.x = pk2(sp[0] * gu[0], sp[1] * gu[1]); w.y = pk2(sp[2] * gu[2], sp[3] * gu[3]); w.z = pk2(sp[4] * gu[4], sp[5] * gu[5]); w.w = pk2(sp[6] * gu[6], sp[7] * gu[7]);
        *(v4u*)(YB + (r0 + i0 + row) * 1536 + 1024 + g * 128 + 8 * cc) = w; }
    __syncthreads();
}


constexpr int GP_WS = 0, GP_VNT = 69632;
__device__ __forceinline__ void gmlp_pair(Frame& F, int b, int n, int g0, const float* w_s, const float* b_s, const float* lng, const float* lnb) {
    int tid_ = threadIdx.x; asm volatile("" : "+v"(tid_));
    const int tid = tid_, lane = tid & 63, wid = __builtin_amdgcn_readfirstlane(tid >> 6), l15 = lane & 15, q4 = lane >> 4;
    const bf16* GU = (const bf16*)(F.ws + WS_GU); const bf16* GV = (const bf16*)(F.ws + WS_GV); bf16* YB = (bf16*)(F.ws + WS_YB); const float* GST = (const float*)(F.ws + WS_GST);
    LAS bf16* WsB = (LAS bf16*)(F.lds + RING_OFF + GP_WS); LAS bf16* VnTB = (LAS bf16*)(F.lds + RING_OFF + GP_VNT);
    const size_t r0 = (size_t)b * SEQ + (size_t)n * 128;
    const int sj = tid & 127, cq = tid >> 7, wi = tid >> 2, jq = tid & 3;
    v4u vreg[2][4]; f32x4 wreg[2][8];
#pragma unroll
    for (int u = 0; u < 2; ++u)
#pragma unroll
        for (int c = 0; c < 4; ++c) vreg[u][c] = *(const v4u*)(GV + (r0 + sj) * 512 + (g0 + u) * 128 + 32 * cq + 8 * c);
    const float mu = GST[2 * (r0 + sj)], rs = GST[2 * (r0 + sj) + 1];
#pragma unroll
    for (int u = 0; u < 2; ++u) { const float* wr = w_s + ((size_t)(g0 + u) * 128 + wi) * 128 + 32 * jq;
#pragma unroll
        for (int c = 0; c < 8; ++c) wreg[u][c] = *(const f32x4*)(wr + 4 * c); }
    __syncthreads();
#pragma unroll
    for (int u = 0; u < 2; ++u) { const int g = g0 + u; LAS bf16* Ws = WsB + u * (128 * RP128); LAS bf16* VnT = VnTB + u * (128 * RP128);
#pragma unroll
        for (int c = 0; c < 4; ++c) { const int j0 = 32 * jq + 8 * c; const f32x4 a = wreg[u][2 * c], bq = wreg[u][2 * c + 1];
            v4u w; w.x = pk2(j0 + 0 <= wi ? a.x : 0.f, j0 + 1 <= wi ? a.y : 0.f); w.y = pk2(j0 + 2 <= wi ? a.z : 0.f, j0 + 3 <= wi ? a.w : 0.f);
            w.z = pk2(j0 + 4 <= wi ? bq.x : 0.f, j0 + 5 <= wi ? bq.y : 0.f); w.w = pk2(j0 + 6 <= wi ? bq.z : 0.f, j0 + 7 <= wi ? bq.w : 0.f);
            *(LAS v4u*)(Ws + wi * RP128 + j0) = w; }
#pragma unroll
        for (int c = 0; c < 4; ++c) { float x[8]; unpack8(vreg[u][c], x);
            const f32x4 ga = *(const f32x4*)(lng + g * 128 + 32 * cq + 8 * c), gb = *(const f32x4*)(lng + g * 128 + 32 * cq + 8 * c + 4);
            const f32x4 ba = *(const f32x4*)(lnb + g * 128 + 32 * cq + 8 * c), bb = *(const f32x4*)(lnb + g * 128 + 32 * cq + 8 * c + 4);
            const float gm[8] = {ga.x, ga.y, ga.z, ga.w, gb.x, gb.y, gb.z, gb.w}, bt[8] = {ba.x, ba.y, ba.z, ba.w, bb.x, bb.y, bb.z, bb.w};
#pragma unroll
            for (int e = 0; e < 8; ++e) VnT[(32 * cq + 8 * c + e) * RP128 + sj] = (bf16)f2bf((x[e] - mu) * rs * gm[e] + bt[e]); }
    }
    LDS_WAIT(); __syncthreads();
    const int i0 = 16 * wid, nks = (wid + 2) >> 1;
#pragma unroll
    for (int u = 0; u < 2; ++u) { const int g = g0 + u; LAS bf16* Ws = WsB + u * (128 * RP128); LAS bf16* VnT = VnTB + u * (128 * RP128); LAS bf16* Sw = Ws + i0 * RP128;
        float bs[4];
#pragma unroll
        for (int reg = 0; reg < 4; ++reg) bs[reg] = b_s[g * 128 + i0 + 4 * q4 + reg];
        v4u gur[4];
#pragma unroll
        for (int c = 0; c < 4; ++c) { const int ch = c * 64 + lane, row = ch >> 4, cc = ch & 15; gur[c] = *(const v4u*)(GU + (r0 + i0 + row) * 512 + g * 128 + 8 * cc); }
        f32x4 x[8];
#pragma unroll
        for (int cb = 0; cb < 8; ++cb) x[cb] = (f32x4){0.f, 0.f, 0.f, 0.f};
#pragma unroll 1
        for (int ks = 0; ks < nks; ++ks) {
            const bf16x8_t a = ldfrag16(Ws, i0 + l15, RP128, ks, q4);
#pragma unroll
            for (int cb = 0; cb < 8; ++cb) x[cb] = MFMA16(a, ldfrag16(VnT, 16 * cb + l15, RP128, ks, q4), x[cb]);
        }
#pragma unroll
        for (int cb = 0; cb < 8; ++cb)
#pragma unroll
            for (int reg = 0; reg < 4; ++reg) Sw[(4 * q4 + reg) * RP128 + 16 * cb + l15] = (bf16)f2bf(x[cb][reg] + bs[reg]);
        LDS_WAIT();
#pragma unroll
        for (int c = 0; c < 4; ++c) { const int ch = c * 64 + lane, row = ch >> 4, cc = ch & 15;
            float sp[8], gu[8]; unpack8(*(const LAS v4u*)(Sw + row * RP128 + 8 * cc), sp); unpack8(gur[c], gu);
            v4u w; w.x = pk2(sp[0] * gu[0], sp[1] * gu[1]); w.y = pk2(sp[2] * gu[2], sp[3] * gu[3]); w.z = pk2(sp[4] * gu[4], sp[5] * gu[5]); w.w = pk2(sp[6] * gu[6], sp[7] * gu[7]);
            *(v4u*)(YB + (r0 + i0 + row) * 1536 + 1024 + g * 128 + 8 * cc) = w; }
    }
    __syncthreads();
}


__device__ __forceinline__ void moe_tail_unit(Frame& F, const MoeTiles& mt, int e, int rb, int cb) {
    int cnt, t0; mt.expert(e, cnt, t0);
    const int re = cnt & 255, nfull = cnt >> 8;
    if (64 * rb >= re) return;
    int tid_ = threadIdx.x; asm volatile("" : "+v"(tid_));
    const int tid = tid_, lane = tid & 63, wid = __builtin_amdgcn_readfirstlane(tid >> 6), l15 = lane & 15, q4 = lane >> 4;
    const int rl = 16 * (wid & 3), cl = 64 * (wid >> 2), srow = tid >> 3, sch = tid & 7;
    const unsigned char* Ag = (const unsigned char*)(F.ws + WS_HID) + ((size_t)(t0 + nfull) * 256 + 64 * rb + srow) * DFF_E + 16 * sch;
    const unsigned char* Bg = (const unsigned char*)(F.ws + WS_WMD) + ((size_t)e * 1024 + 128 * cb + srow) * DFF_E + 16 * sch;
    constexpr int TP = 272;
    LAS unsigned char* As = F.lds + RING_OFF; LAS unsigned char* Bs = F.lds + RING_OFF + 2 * 64 * TP;
    f32x4 acc[4] = {{0.f, 0.f, 0.f, 0.f}, {0.f, 0.f, 0.f, 0.f}, {0.f, 0.f, 0.f, 0.f}, {0.f, 0.f, 0.f, 0.f}};
    v4u ra[2][2], rbv[2][4];
#define TAIL_LOAD(s_, kt) do { ra[s_][0] = *(const v4u*)(Ag + 256 * (kt)); ra[s_][1] = *(const v4u*)(Ag + 256 * (kt) + 128); rbv[s_][0] = *(const v4u*)(Bg + 256 * (kt)); rbv[s_][1] = *(const v4u*)(Bg + 256 * (kt) + 128); \
        rbv[s_][2] = *(const v4u*)(Bg + (size_t)64 * DFF_E + 256 * (kt)); rbv[s_][3] = *(const v4u*)(Bg + (size_t)64 * DFF_E + 256 * (kt) + 128); } while (0)
#define TAIL_STEP(s_, kt) do { LAS unsigned char* as = As + (s_) * (64 * TP); LAS unsigned char* bs = Bs + (s_) * (128 * TP); \
        *(LAS v4u*)(as + srow * TP + 16 * sch) = ra[s_][0]; *(LAS v4u*)(as + srow * TP + 128 + 16 * sch) = ra[s_][1]; \
        *(LAS v4u*)(bs + srow * TP + 16 * sch) = rbv[s_][0]; *(LAS v4u*)(bs + srow * TP + 128 + 16 * sch) = rbv[s_][1]; \
        *(LAS v4u*)(bs + (srow + 64) * TP + 16 * sch) = rbv[s_][2]; *(LAS v4u*)(bs + (srow + 64) * TP + 128 + 16 * sch) = rbv[s_][3]; \
        LDS_WAIT(); __syncthreads(); \
        if ((kt) + 2 < DFF_E / 256) TAIL_LOAD(s_, (kt) + 2); \
        _Pragma("unroll") for (int kk = 0; kk < 2; ++kk) { \
            const LAS unsigned char* ap = as + (rl + l15) * TP + 128 * kk + 32 * q4; \
            const pg8::v8i_t a = __builtin_shufflevector(*(const LAS pg8::v4i_t*)ap, *(const LAS pg8::v4i_t*)(ap + 16), 0, 1, 2, 3, 4, 5, 6, 7); \
            _Pragma("unroll") for (int j = 0; j < 4; ++j) { const LAS unsigned char* bp = bs + (cl + 16 * j + l15) * TP + 128 * kk + 32 * q4; \
                const pg8::v8i_t b = __builtin_shufflevector(*(const LAS pg8::v4i_t*)bp, *(const LAS pg8::v4i_t*)(bp + 16), 0, 1, 2, 3, 4, 5, 6, 7); \
                acc[j] = __builtin_amdgcn_mfma_scale_f32_16x16x128_f8f6f4(a, b, acc[j], 0, 0, 0, 0x7f7f7f7f, 0, (int)E8_DN); } } } while (0)
    TAIL_LOAD(0, 0); TAIL_LOAD(1, 1);
    __syncthreads();
#pragma unroll 1
    for (int kt = 0; kt < DFF_E / 256; kt += 2) { TAIL_STEP(0, kt); TAIL_STEP(1, kt + 1); }
    static_assert((DFF_E / 256) % 2 == 0, "even number of K-steps");
#undef TAIL_LOAD
#undef TAIL_STEP
    const unsigned* list = (const unsigned*)(F.ws + WS_LIST); const float* gatew = (const float*)(F.ws + WS_GATEW);
    bf16* c0 = (bf16*)(F.ws + WS_YPRE); bf16* c1 = (bf16*)(F.ws + WS_C1);
#pragma unroll
    for (int reg = 0; reg < 4; ++reg) { const int r = 64 * rb + rl + 4 * q4 + reg;
        if (r < re) { const int slot = nfull * 256 + r; const unsigned ent = list[e * 16384 + slot]; const float g = gatew[e * 16384 + slot];
            bf16* dst = ((ent >> 31) ? c1 : c0) + (size_t)(ent & 0x7fffffffu) * 1024 + 128 * cb + cl + l15;
#pragma unroll
            for (int j = 0; j < 4; ++j) dst[16 * j] = (bf16)f2bf(acc[j][reg] * g); } }
    __syncthreads();
}


constexpr int CV_I_IN = 16 * 112, CV_I_BR = 8 * 16, CV_I_OUT = 16 * 16, CV_I_DU = 16 * 88, CV_I_DD = 44 * 16, CV_I_MU = 16 * 112, CV_I_MD = 56 * 16;
constexpr int CV_I_G8 = 16 * 48;
constexpr int CV_NITEMS = 2 * CV_I_IN + 6 * CV_I_BR + 2 * CV_I_OUT + CV_I_DU + CV_I_DD + 8 * CV_I_MU + 8 * CV_I_MD + ((GATES_FP8 && !P1_I8) ? 2 * CV_I_G8 : 0);
constexpr int CV_MD0 = 8 * CV_I_MU, CV_MD1 = 8 * CV_I_MU + 8 * CV_I_MD;
constexpr int CV_DEFER = 5 * CV_I_MU;
__device__ __forceinline__ void cvt_global_item(Frame& F, int it, LAS float* scr, int lane) {
    int r = it; bool done = false;
#pragma unroll 1
    for (int e = 0; e < 8 && !done; ++e) { CvtJob j{(const float*)(const GAS float*)lds_ptr(F.lds, 15) + (size_t)e * 1024 * 7168, 1024, 7168, 7168, (bf16*)(F.ws + WS_WMU + (size_t)e * 7168 * 1024), 1024, 0, 2, DFF_E, SC_WU8}; done = cvt_run(j, r, scr, lane); }
#pragma unroll 1
    for (int e = 0; e < 8 && !done; ++e) { CvtJob j{(const float*)(const GAS float*)lds_ptr(F.lds, 16) + (size_t)e * 3584 * 1024, 3584, 1024, 1024, (bf16*)(F.ws + WS_WMD + (size_t)e * 1024 * 3584), 3584, 0, 0, 0, SC_WD8}; done = cvt_run(j, r, scr, lane); }
#pragma unroll 1
    for (int l = 0; l < 2 && !done; ++l) { CvtJob j{(const float*)(const GAS float*)lds_ptr(F.lds, 1) + (size_t)l * 1024 * N_INSRC, 1024, N_INSRC, N_INV, (bf16*)(F.ws + WS_WIN) + (size_t)l * N_INV * 1024, 1024, 0, 1, 0, P1_I8 ? -SC_WI8 : 0.f}; done = cvt_run(j, r, scr, lane); }
#pragma unroll 1
    for (int q = 0; q < 6 && !done; ++q) { const int l = q / 3, n = q % 3; CvtJob j{(const float*)(const GAS float*)lds_ptr(F.lds, 8) + (size_t)q * 512 * 1024, 512, 1024, 1024, (bf16*)(F.ws + WS_WBR) + (size_t)l * 1024 * 1536, 1536, n * 512, 0, 0, 0.f}; done = cvt_run(j, r, scr, lane); }
#pragma unroll 1
    for (int l = 0; l < 2 && !done; ++l) { CvtJob j{(const float*)(const GAS float*)lds_ptr(F.lds, 9) + (size_t)l * 1024 * 1024, 1024, 1024, 1024, (bf16*)(F.ws + WS_WOUT) + (size_t)l * 1024 * 1024, 1024, 0, 0, 0, P4_I8 ? -SC_WOI8 : 0.f}; done = cvt_run(j, r, scr, lane); }
    if (!done) { CvtJob j{(const float*)(const GAS float*)lds_ptr(F.lds, 12), 1024, 2 * DFF_D, 2 * DFF_D, (bf16*)(F.ws + WS_WDU), 1024, 0, 2, DFF_D, (DENSE_FP8 == 4) ? -SC_WI8 : (DENSE_FP8 == 1 || DENSE_FP8 == 2) ? SC_WU8 : 0.f}; done = cvt_run(j, r, scr, lane); }
    if (!done) { CvtJob j{(const float*)(const GAS float*)lds_ptr(F.lds, 13), DFF_D, 1024, 1024, (bf16*)(F.ws + WS_WDD), DFF_D, 0, 0, 0, (DENSE_FP8 == 1 || DENSE_FP8 == 3) ? SC_WD8 : 0.f}; done = cvt_run(j, r, scr, lane); }
#if GATES_FP8 && !P1_I8
#pragma unroll 1
    for (int l = 0; l < 2 && !done; ++l) { CvtJob j{(const float*)(const GAS float*)lds_ptr(F.lds, 1) + (size_t)l * 1024 * N_INSRC, 1024, N_INSRC, 3072, (bf16*)(F.ws + WS_WIN8 + (size_t)l * 3072 * 1024), 1024, 0, 1, 0, SC_WU8, 4096}; done = cvt_run(j, r, scr, lane); }
#endif
}

struct Args { const float* in[17]; float* out; unsigned char* ws; int ph_lo, ph_hi; };
constexpr int N_PHASES = 17;

__global__ void __launch_bounds__(NWAVES * 64, 2) mega_fwd(Args args) {
    extern __shared__ __attribute__((aligned(16))) unsigned char lds[];
    asm volatile("s_nop 0\n\ts_nop 0\n\ts_nop 0\n\ts_nop 0\n\ts_nop 0\n\ts_nop 0");
    Frame F;
    F.lds = (LAS unsigned char*)lds;
    F.MISC = (volatile LAS unsigned*)(F.lds + MISC_OFF);
    F.tid = threadIdx.x; F.lane = F.tid & 63; F.wave = __builtin_amdgcn_readfirstlane(F.tid >> 6);
    F.G = gridDim.x; { const int bx = blockIdx.x; F.vcu = (F.G % 8 == 0) ? (bx % 8) * (F.G / 8) + bx / 8 : bx; }
    F.ws = args.ws; F.ctl = (gu32*)(args.ws + WS_CTL);
    for (int u = F.tid; u < (LDS_BYTES - LDSCTL_OFF) / 4; u += NWAVES * 64) ((LAS unsigned*)(F.lds + LDSCTL_OFF))[u] = 0u;
    __syncthreads();
    XcdBarrier bar = xcd_barrier_post((unsigned*)(F.ctl + CW_BAR), F.MISC + 8, gridDim.x, 0u);
    const bool grp = (F.G == 256);
    XcdBarrier gbar = bar;
    if (grp) gbar = xcd_barrier_post((unsigned*)(F.ctl + CW_BAR) + (1 + (blockIdx.x & 7)) * XCD_BAR_WORDS, F.MISC + 10, 32u, 1u);
#define GRID_BAR() xcd_barrier(bar)
#define GRP_BAR() do { if (grp) xcd_barrier(gbar); else xcd_barrier(bar); } while (0)
    const int lo = args.ph_lo, hi = args.ph_hi;
#ifndef PH_MASK
#define PH_MASK 0x1ff
#endif
#define IN(k) (lo <= (k) && (k) < hi)
#ifndef DUP_PHASE
#define DUP_PHASE (-1)
#endif
#define REPS(k) (((k) == DUP_PHASE) ? 2 : 1)
#ifndef P2DUP
#define P2DUP 0
#endif
#define PHASE_BEGIN() do { int t_ = threadIdx.x; asm volatile("" : "+v"(t_)); F.tid = t_; F.lane = t_ & 63; F.wave = __builtin_amdgcn_readfirstlane(t_ >> 6); } while (0)
#define ON(j) (((PH_MASK) >> (j)) & 1)
#define SEAM(k) do { if (IN(k) && IN((k) + 1)) GRID_BAR(); } while (0)
#define SEAMG(k) do { if (IN(k) && IN((k) + 1)) GRP_BAR(); } while (0)

    if (F.tid == 0) { LAS unsigned long long* pt = (LAS unsigned long long*)(F.lds + PTAB_OFF);
#pragma unroll
        for (int i = 0; i < 17; ++i) pt[i] = (unsigned long long)args.in[i];
        pt[17] = (unsigned long long)args.out; }
    LDS_WAIT(); __syncthreads();
#define INP(k) ((const float*)(const GAS float*)lds_ptr(F.lds, (k)))
    if (ON(0) && IN(0)) { for (int rep_ = 0; rep_ < REPS(0); ++rep_) { PHASE_BEGIN();
        LAS float* scr = (LAS float*)(F.lds + RING_OFF + F.wave * 17408);
        static_assert(NWAVES * 17408 <= RING_BYTES, "conversion tiles fit the phase scratch");
        const int gw = F.vcu * NWAVES + F.wave, NGW = F.G * NWAVES;
        for (int it = CV_DEFER + gw; it < CV_NITEMS - (CV_MD1 - CV_MD0); it += NGW) { const int jt = it < CV_MD0 ? it : it + (CV_MD1 - CV_MD0); cvt_global_item(F, jt, scr, F.lane); }
        __syncthreads();
        { float* cs = (float*)(F.ws + WS_CS);
          for (int i = F.vcu * 512 + F.tid; i < SEQ * 32; i += F.G * 512) { const int pos = i >> 5, d = i & 31;
              const double rev = (double)pos * exp(-(double)d / 32.0 * 9.210340371976184) * 0.15915494309189535; const float fr_ = (float)(rev - floor(rev));
              cs[i] = __builtin_amdgcn_cosf(fr_); cs[65536 + i] = __builtin_amdgcn_sinf(fr_); } }
        p0_rows(F, INP(0), INP(1), INP(2));
    } }
    SEAM(0);

#pragma unroll 1
    for (int l = 0; l < 2; ++l) {
        const int pb = 1 + 8 * l;
        const float* xres = (l == 0) ? INP(0) : ((float*)(F.ws + WS_XF));
        if (ON(1) && IN(pb + 0)) { for (int rep_ = 0; rep_ < REPS(pb + 0); ++rep_) { PHASE_BEGIN();
            const bool g8 = (GATES_FP8 == 2) || (GATES_FP8 == 1 && l == 1);
#if P1_I8
            {
                ProjSched S; S.init(M / 256, 16, F.G, (int)blockIdx.x); S.A = (const bf16*)(F.ws + WS_X8IN); S.Bt = (const bf16*)(F.ws + WS_WIN) + (size_t)l * N_INV * 1024; S.K = 1024; S.esz = 1;
                EpiProjT<true> E{F.ws, INP(3) + l * 3072, ((const float*)(F.ws + WS_CS))};
                pg8::gemm_phase<EpiProjT<true>, ProjSched, 1u>(F.lds + RING_OFF, 1024, S, E);
                pg8::PlainSched S8; S8.init(M / 256, 12, F.G, (int)blockIdx.x); S8.A = (const bf16*)(F.ws + WS_X8IN); S8.Bt = (const bf16*)((const unsigned char*)((const bf16*)(F.ws + WS_WIN) + (size_t)l * N_INV * 1024) + (size_t)4096 * 1024); S8.K = 1024; S8.esz = 1;
                EpiGate8T<true> E8{(bf16*)(F.ws + WS_GT), INP(3) + l * 3072};
                pg8::gemm_phase<EpiGate8T<true>, pg8::PlainSched, 1u>(F.lds + RING_OFF, 1024, S8, E8);
            }
#else
            ProjSched S; S.init(M / 256, g8 ? 16 : N_INV / 256, F.G, (int)blockIdx.x); S.A = ((bf16*)(F.ws + WS_XB)); S.Bt = (const bf16*)(F.ws + WS_WIN) + (size_t)l * N_INV * 1024; S.K = 1024;
            EpiProj E{F.ws, INP(3) + l * 3072, ((const float*)(F.ws + WS_CS))};
            pg8::gemm_phase<EpiProj, ProjSched>(F.lds + RING_OFF, 1024, S, E);
#if GATES_FP8
            if (g8) {
                pg8::PlainSched S8; S8.init(M / 256, 12, F.G, (int)blockIdx.x); S8.A = (const bf16*)(F.ws + WS_X8IN); S8.Bt = (const bf16*)(F.ws + WS_WIN8 + (size_t)l * 3072 * 1024); S8.K = 1024; S8.esz = 1;
                EpiGate8 E8{(bf16*)(F.ws + WS_GT), INP(3) + l * 3072};
                pg8::gemm_phase<EpiGate8, pg8::PlainSched, E8_UP>(F.lds + RING_OFF, 1024, S8, E8);
            }
#endif
#endif
        } }
        SEAMG(pb + 0);
        if (ON(2) && IN(pb + 1)) { for (int rep_ = 0; rep_ < REPS(pb + 1); ++rep_) { PHASE_BEGIN();
            {
#if NAIVE_FOX
            LAS float* tab = (LAS float*)(F.lds + RING_OFF + 4096); LAS float* wtot = (LAS float*)(F.lds + RING_OFF + 4096 + 8192);
            for (int uu = F.vcu; uu < 64 * 8; uu += F.G) {
                const int bh = uu >> 3, qb = uu & 7, b = bh >> 3, h = bh & 7;
                fox_bias_table<false>(F, b, h, tab, wtot);
                for (int r = F.wave; r < 256; r += NWAVES) naive_fox_row(F, b, h, qb * 256 + r, tab);
                __syncthreads();
            }
#else
            LAS float* tab = (LAS float*)(F.lds + RING_OFF + 86016); LAS float* wtot = (LAS float*)(F.lds + RING_OFF + 86016 + 32768);
            static_assert(attn_body::ATTN_LDS_BYTES <= 86016 && 86016 + 32768 + 64 <= RING_BYTES, "attention scratch below the bias rows");
            for (int d_ = 0; d_ < ((P2DUP & 1) ? 2 : 1); ++d_)
            for (int pp = F.vcu; pp < 256; pp += F.G) {
                const int bh = pp >> 2, sq = pp & 3, b = bh >> 3, h = bh & 7;
                fox_bias_table<true>(F, b, h, tab, wtot);
#pragma unroll 1
                for (int i = 0; i < 2; ++i)
                    attn_body::attn_unit<8>(b, h, i ? 7 - sq : sq, (const attn_body::bf16*)(F.ws + WS_FQ), (const attn_body::bf16*)(F.ws + WS_FK), (const attn_body::bf16*)(F.ws + WS_FV), (attn_body::bf16*)(F.ws + WS_YB), (char*)lds + RING_OFF, (attn_body::lds_tabptr)tab);
            }
            __syncthreads();
#endif
            }
#if NAIVE_RET == 1
            { const int gw = F.vcu * NWAVES + F.wave, NGW = F.G * NWAVES;
              for (int idx = gw; idx < BATCH * 4 * SEQ; idx += NGW) { const int t = idx & (SEQ - 1), bh = idx >> 11; naive_ret_row(F, bh >> 2, bh & 3, t); } }
#endif
#if NAIVE_GMLP == 1
            for (int uu = F.vcu; uu < BATCH * 16 * 4; uu += F.G) { const int g = uu & 3, n = (uu >> 2) & 15, b = uu >> 6;
                naive_gmlp_unit(F, b, n, g, INP(4) + (size_t)l * 4 * 128 * 128, INP(5) + l * 512, INP(6) + l * 512, INP(7) + l * 512); }
#endif
#if MK_N_LAUNCHES == 1 && NAIVE_RET == 0 && NAIVE_GMLP == 0
            for (int d_ = 0; d_ < ((P2DUP & 2) ? 2 : 1); ++d_)
            for (int uu = 2 * F.vcu; uu < 512; uu += 2 * F.G) {
#pragma unroll 1
                for (int q = 0; q < 2; ++q) { const int un = uu + q, bh = un >> 4; ret_kv_unit(F, bh >> 2, bh & 3, un & 15); } }
            if (grp) { if ((F.vcu & 31) < 16) gmlp_stat_unit(F, F.vcu >> 5, F.vcu & 31); }
            else for (int uu = F.vcu; uu < 128; uu += F.G) gmlp_stat_unit(F, uu >> 4, uu & 15);
            GRP_BAR();
            for (int d_ = 0; d_ < ((P2DUP & 4) ? 2 : 1); ++d_)
            for (int pp = F.vcu; pp < 256; pp += F.G) { const int bh = pp >> 3, sq = pp & 7;
#pragma unroll 1
                for (int q = 0; q < 2; ++q) ret_out_unit(F, bh >> 2, bh & 3, q ? 15 - sq : sq); }
            for (int d_ = 0; d_ < ((P2DUP & 8) ? 2 : 1); ++d_)
            for (int uu = F.vcu; uu < 256; uu += F.G) gmlp_pair(F, uu >> 5, (uu >> 1) & 15, (uu & 1) * 2, INP(4) + (size_t)l * 4 * 128 * 128, INP(5) + l * 512, INP(6) + l * 512, INP(7) + l * 512);
#else
            for (int uu = F.vcu; uu < 256; uu += F.G) {
                if (uu < 128) {
#if NAIVE_RET == 0
                    ret_unit(F, uu >> 4, (uu >> 2) & 3, uu & 3);
#endif
                } else {
#if NAIVE_GMLP == 0
#pragma unroll 1
                    for (int q = 0; q < 4; ++q) { const int gu = (uu - 128) * 4 + q; gmlp_unit(F, gu >> 6, (gu >> 2) & 15, gu & 3, INP(4) + (size_t)l * 4 * 128 * 128, INP(5) + l * 512, INP(6) + l * 512, INP(7) + l * 512); }
#endif
                }
            }
#endif
        } }
        SEAMG(pb + 1);
        if (ON(3) && IN(pb + 2)) { for (int rep_ = 0; rep_ < REPS(pb + 2); ++rep_) { PHASE_BEGIN();
            pg8::PlainSched S; S.init(M / 256, 4, F.G, (int)blockIdx.x); S.A = ((bf16*)(F.ws + WS_YB)); S.Bt = (const bf16*)(F.ws + WS_WBR) + (size_t)l * 1024 * 1536; S.K = 1536;
            EpiMergeT<P4_I8 != 0> E{(const bf16*)(F.ws + WS_GT), ((bf16*)(F.ws + WS_MRG))};
            pg8::gemm_phase<EpiMergeT<P4_I8 != 0>, pg8::PlainSched>(F.lds + RING_OFF, 1536, S, E);
        } }
        SEAMG(pb + 2);
        if (ON(4) && IN(pb + 3)) { for (int rep_ = 0; rep_ < REPS(pb + 3); ++rep_) { PHASE_BEGIN();
            pg8::PlainSched S; S.init(M / 256, 4, F.G, (int)blockIdx.x); S.A = ((bf16*)(F.ws + WS_MRG)); S.Bt = (const bf16*)(F.ws + WS_WOUT) + (size_t)l * 1024 * 1024; S.K = 1024;
#if P4_I8
            S.esz = 1; EpiResidI8 E{xres, ((float*)(F.ws + WS_YPRE)), 1.0f / (SC_MI8 * SC_WOI8)};
            pg8::gemm_phase<EpiResidI8, pg8::PlainSched, 1u>(F.lds + RING_OFF, 1024, S, E);
#else
            EpiResid E{xres, ((float*)(F.ws + WS_YPRE))};
            pg8::gemm_phase<EpiResid, pg8::PlainSched>(F.lds + RING_OFF, 1024, S, E);
#endif
        } }
        SEAMG(pb + 3);
        if (ON(5) && IN(pb + 4)) { for (int rep_ = 0; rep_ < REPS(pb + 4); ++rep_) { PHASE_BEGIN();
            if (l == 0) ln_pass<0>(F, ((float*)(F.ws + WS_YPRE)), 1.f, nullptr, nullptr, INP(10) + (l * 2 + 0) * 1024, INP(11) + (l * 2 + 0) * 1024, ((float*)(F.ws + WS_XF)), (DENSE_FP8 == 1 || DENSE_FP8 == 2 || DENSE_FP8 == 4) ? nullptr : ((bf16*)(F.ws + WS_XB)), (DENSE_FP8 == 1 || DENSE_FP8 == 2 || DENSE_FP8 == 4) ? (unsigned char*)(F.ws + WS_XB) : nullptr, nullptr, 0, 0, nullptr, grp, (DENSE_FP8 == 4) ? -SC_XI8 : SC_X8);
            else ln_pass<2>(F, ((float*)(F.ws + WS_YPRE)), 1.f, nullptr, nullptr, INP(10) + (l * 2 + 0) * 1024, INP(11) + (l * 2 + 0) * 1024, ((float*)(F.ws + WS_XF)), nullptr, (unsigned char*)(F.ws + WS_XB), INP(14), 8, 0, nullptr, grp);
        } }
        if (l == 0) SEAMG(pb + 4); else SEAM(pb + 4);
        if (ON(6) && IN(pb + 5)) { for (int rep_ = 0; rep_ < REPS(pb + 5); ++rep_) { PHASE_BEGIN();
            if (l == 0) {
                pg8::PlainSched S; S.init(M / 256, 2 * DFF_D / 256, F.G, (int)blockIdx.x); S.A = ((bf16*)(F.ws + WS_XB)); S.Bt = (const bf16*)(F.ws + WS_WDU); S.K = 1024;
#if DENSE_FP8 == 1
                S.esz = 1; EpiSwiglu8 E{(unsigned char*)(F.ws + WS_HID), DFF_D};
                pg8::gemm_phase<EpiSwiglu8, pg8::PlainSched, E8_UP>(F.lds + RING_OFF, 1024, S, E);
#elif DENSE_FP8 == 2
                S.esz = 1; EpiSwiglu E{((bf16*)(F.ws + WS_HID)), DFF_D};
                pg8::gemm_phase<EpiSwiglu, pg8::PlainSched, E8_UP>(F.lds + RING_OFF, 1024, S, E);
#elif DENSE_FP8 == 4
                S.esz = 1; EpiSwigluI8 E{((bf16*)(F.ws + WS_HID)), DFF_D};
                pg8::gemm_phase<EpiSwigluI8, pg8::PlainSched, 1u>(F.lds + RING_OFF, 1024, S, E);
#elif DENSE_FP8 == 3
                EpiSwiglu8 E{(unsigned char*)(F.ws + WS_HID), DFF_D};
                pg8::gemm_phase<EpiSwiglu8, pg8::PlainSched>(F.lds + RING_OFF, 1024, S, E);
#else
                EpiSwiglu E{((bf16*)(F.ws + WS_HID)), DFF_D};
                pg8::gemm_phase<EpiSwiglu, pg8::PlainSched>(F.lds + RING_OFF, 1024, S, E);
#endif
                if (F.G == 256 && blockIdx.x >= 128) {
                    LAS float* scr = (LAS float*)(F.lds + RING_OFF + F.wave * 17408);
                    for (int it = ((int)blockIdx.x - 128) * NWAVES + F.wave; it < CV_DEFER; it += 128 * NWAVES) cvt_global_item(F, it, scr, F.lane);
                } else if (F.G != 256) {
                    LAS float* scr = (LAS float*)(F.lds + RING_OFF + F.wave * 17408);
                    for (int it = F.vcu * NWAVES + F.wave; it < CV_DEFER; it += F.G * NWAVES) cvt_global_item(F, it, scr, F.lane);
                }
                __syncthreads();
            } else {
                MoeTiles mt; mt.init(F.ctl);
                MoeUpSched S; S.init(mt.toff[NEXP], 2 * DFF_E / 256, F.G, (int)blockIdx.x); S.A = (const unsigned char*)(F.ws + WS_XB); S.Bt = (const unsigned char*)(F.ws + WS_WMU); S.list = (const unsigned*)(F.ws + WS_LIST); S.mt = mt;
                EpiSwiglu8 E{(unsigned char*)(F.ws + WS_HID), DFF_E};
                pg8::gemm_phase<EpiSwiglu8, MoeUpSched, E8_UP>(F.lds + RING_OFF, 1024, S, E);
                {
                    LAS float* scr = (LAS float*)(F.lds + RING_OFF + F.wave * 17408);
                    const int nwg = mt.toff[NEXP] * (2 * DFF_E / 256), rounds = (nwg + F.G - 1) / F.G, rem = nwg - (rounds - 1) * F.G, nidle = F.G - rem;
                    constexpr int NMD = CV_MD1 - CV_MD0;
                    int q = 0; if (nidle > 0) { q = (NMD + nidle * NWAVES - 1) / (nidle * NWAVES); if (q > 6) q = 6; }
                    int first = nidle * NWAVES * q; if (first > NMD) first = NMD;
                    if ((int)blockIdx.x >= rem) for (int it = ((int)blockIdx.x - rem) * NWAVES + F.wave; it < first; it += nidle * NWAVES) cvt_global_item(F, CV_MD0 + it, scr, F.lane);
                    for (int it = first + (int)blockIdx.x * NWAVES + F.wave; it < NMD; it += F.G * NWAVES) cvt_global_item(F, CV_MD0 + it, scr, F.lane);
                    __syncthreads();
                }
            }
        } }
        if (l == 0) SEAMG(pb + 5); else SEAM(pb + 5);
        if (ON(7) && IN(pb + 6)) { for (int rep_ = 0; rep_ < REPS(pb + 6); ++rep_) { PHASE_BEGIN();
            if (l == 0) {
                pg8::PlainSched S; S.init(M / 256, 4, F.G, (int)blockIdx.x); S.A = ((bf16*)(F.ws + WS_HID)); S.Bt = (const bf16*)(F.ws + WS_WDD); S.K = DFF_D;
                EpiResid E{((float*)(F.ws + WS_XF)), ((float*)(F.ws + WS_YPRE))};
#if DENSE_FP8 == 1 || DENSE_FP8 == 3
                S.esz = 1; pg8::gemm_phase<EpiResid, pg8::PlainSched, E8_DN>(F.lds + RING_OFF, DFF_D, S, E);
#else
                pg8::gemm_phase<EpiResid, pg8::PlainSched>(F.lds + RING_OFF, DFF_D, S, E);
#endif
            } else {
                MoeTiles mt; mt.init(F.ctl);
                MoeDownSched S; S.init(mt.nfull_total(), 4, F.G, (int)blockIdx.x); S.A = (const unsigned char*)(F.ws + WS_HID); S.Bt = (const unsigned char*)(F.ws + WS_WMD); S.mt = mt;
                EpiMoeDown E{((bf16*)(F.ws + WS_YPRE)), ((bf16*)(F.ws + WS_C1)), (const unsigned*)(F.ws + WS_LIST), (const float*)(F.ws + WS_GATEW), mt};
                pg8::gemm_phase<EpiMoeDown, MoeDownSched, E8_DN>(F.lds + RING_OFF, DFF_E, S, E);
                for (int tu = F.vcu; tu < 256; tu += F.G) moe_tail_unit(F, mt, tu >> 5, (tu >> 3) & 3, tu & 7);
            }
        } }
        if (l == 0) SEAMG(pb + 6); else SEAM(pb + 6);
        if (ON(8) && IN(pb + 7)) { for (int rep_ = 0; rep_ < REPS(pb + 7); ++rep_) { PHASE_BEGIN();
            if (l == 0) ln_pass<1>(F, ((float*)(F.ws + WS_YPRE)), 1.f, nullptr, nullptr, INP(10) + (l * 2 + 1) * 1024, INP(11) + (l * 2 + 1) * 1024, ((float*)(F.ws + WS_XF)), P1_I8 ? nullptr : ((bf16*)(F.ws + WS_XB)), GATES_FP8 ? (unsigned char*)(F.ws + WS_X8IN) : nullptr, INP(1) + (size_t)1 * 1024 * N_INSRC, N_INSRC, FL_COL, INP(2) + 8, grp, P1_I8 ? -SC_XI8 : SC_X8);
            else ln_pass<0>(F, ((float*)(F.ws + WS_XF)), ALPHA, (const bf16*)(F.ws + WS_YPRE), (const bf16*)(F.ws + WS_C1), INP(10) + (l * 2 + 1) * 1024, INP(11) + (l * 2 + 1) * 1024, (float*)(GAS float*)lds_ptr(F.lds, 17), nullptr, nullptr, nullptr, 0, 0, nullptr, grp);
        } }
        if (l == 0) SEAMG(pb + 7);
    }
#undef IN
#undef SEAM
}

extern "C" void kernel_launch(void* const* d_in, const int* in_sizes, int n_in, void* d_out, int out_size, void* d_ws, size_t ws_size, hipStream_t stream) {
    static int grid = 0;
    if (grid == 0) {
        if (n_in != 17 || in_sizes[0] != M * D || out_size != M * D || ws_size < WS_END) { fprintf(stderr, "kernel_launch: unexpected shapes / workspace (%zu)\n", ws_size); grid = -1; return; }
        int dev = 0, cus = 0, per_cu = 0;
        if (hipGetDevice(&dev) != hipSuccess || hipDeviceGetAttribute(&cus, hipDeviceAttributeMultiprocessorCount, dev) != hipSuccess) { grid = -1; return; }
        if (hipFuncSetAttribute((const void*)mega_fwd, hipFuncAttributeMaxDynamicSharedMemorySize, LDS_BYTES) != hipSuccess) { grid = -1; return; }
        if (hipOccupancyMaxActiveBlocksPerMultiprocessor(&per_cu, (const void*)mega_fwd, NWAVES * 64, LDS_BYTES) != hipSuccess || per_cu < 1) { fprintf(stderr, "kernel_launch: occupancy query says %d\n", per_cu); }
        (void)hipGetLastError();
        grid = cus;
    }
    if (grid < 0) return;
    if (hipMemsetAsync((char*)d_ws + WS_CTL, 0, CTL_ZERO_BYTES, stream) != hipSuccess) return;
    Args a{};
    for (int i = 0; i < 17; ++i) a.in[i] = (const float*)d_in[i];
    a.out = (float*)d_out; a.ws = (unsigned char*)d_ws;
#if MK_N_LAUNCHES == 1
    a.ph_lo = 0; a.ph_hi = N_PHASES;
    hipLaunchKernelGGL(mega_fwd, dim3(grid), dim3(NWAVES * 64), LDS_BYTES, stream, a);
#else
    for (int p = 0; p < N_PHASES; ++p) { a.ph_lo = p; a.ph_hi = p + 1; hipLaunchKernelGGL(mega_fwd, dim3(grid), dim3(NWAVES * 64), LDS_BYTES, stream, a); }
#endif
}
```
